# Optimizing an MI355X kernel written in HIP

```python
import jax, jax.numpy as jnp
from jax import lax
import numpy as np

D_MODEL = 4096
BATCH = 4
SEQ = 4096
DEPTH = 2
DEC_BATCH = 8
DEC_SEQ = 64
PAST_LEN = 1024

CHUNK = 64
Q_BLOCK = 128
MLA_HEADS = D_MODEL // 256
Q_LORA = D_MODEL // 4
KV_LORA = 512
NOPE_DIM = 128
ROPE_DIM = 64
V_DIM = 128
ROPE_THETA = 10000.0
SB_HEADS = D_MODEL // 256
SB_DIM = 128
MLA_WIDTH = MLA_HEADS * V_DIM
SB_WIDTH = SB_HEADS * SB_DIM
MIX_WIDTH = MLA_WIDTH + SB_WIDTH
D_FF = 4 * D_MODEL
IN_SPLITS = (Q_LORA,
             Q_LORA + KV_LORA,
             Q_LORA + KV_LORA + ROPE_DIM,
             Q_LORA + KV_LORA + ROPE_DIM + SB_WIDTH,
             Q_LORA + KV_LORA + ROPE_DIM + 2 * SB_WIDTH)
IN_WIDTH = Q_LORA + KV_LORA + ROPE_DIM + 3 * SB_WIDTH
EPS = 1e-6
NEG_INF = -1e30

kernel_name = "hymba_mla_stickbreaking_stream_step"


def rms_norm(x, g):
    xf = x.astype(jnp.float32)
    y = xf * lax.rsqrt(jnp.mean(xf * xf, axis=-1, keepdims=True) + EPS)
    return (y * g.astype(jnp.float32)).astype(x.dtype)


def apply_rope(x, pos):
    half = ROPE_DIM // 2
    inv_freq = jnp.power(ROPE_THETA, -jnp.arange(half, dtype=jnp.float32) / half)
    ang = pos.astype(jnp.float32)[:, None] * inv_freq[None, :]
    cos = jnp.cos(ang)[None, :, None, :]
    sin = jnp.sin(ang)[None, :, None, :]
    xf = x.astype(jnp.float32)
    x1, x2 = xf[..., :half], xf[..., half:]
    return jnp.concatenate([x1 * cos - x2 * sin, x1 * sin + x2 * cos], axis=-1).astype(x.dtype)


def sweep_query_blocks(fn, q, q_pos):
    B, T = q.shape[0], q.shape[1]
    if T <= Q_BLOCK:
        return fn(q, q_pos)
    nb = T // Q_BLOCK
    qb = q.reshape(B, nb, Q_BLOCK, *q.shape[2:]).swapaxes(0, 1)
    pb = q_pos.reshape(nb, Q_BLOCK)
    out = lax.map(lambda a: fn(a[0], a[1]), (qb, pb))
    return out.swapaxes(0, 1).reshape(B, T, *out.shape[3:])


def chunk_causal_softmax(q, q_pos, k, v, k_pos):
    scale = (NOPE_DIM + ROPE_DIM) ** -0.5
    s = jnp.einsum("bqhd,bkhd->bhqk", q, k).astype(jnp.float32) * scale
    visible = (k_pos[None, :] // CHUNK) <= (q_pos[:, None] // CHUNK)
    s = jnp.where(visible[None, None], s, NEG_INF)
    p = jax.nn.softmax(s, axis=-1)
    return jnp.einsum("bhqk,bkhd->bqhd", p.astype(v.dtype), v)


def stick_breaking(q, q_pos, k, v, k_pos):
    z = jnp.einsum("bqhd,bkhd->bhqk", q, k).astype(jnp.float32) * (SB_DIM ** -0.5)
    before = k_pos[None, :] < q_pos[:, None]
    log_beta = jax.nn.log_sigmoid(z)
    log_fail = jnp.where(before[None, None], jax.nn.log_sigmoid(-z), 0.0)
    later_fail = lax.cumsum(log_fail, axis=3, reverse=True) - log_fail
    w = jnp.where(before[None, None], jnp.exp(log_beta + later_fail), 0.0)
    return jnp.einsum("bhqk,bkhd->bqhd", w.astype(v.dtype), v)


def token_mixers(xn, pos, past, p):
    B, T, _ = xn.shape
    proj = xn @ p["w_in"]
    q_lat, kv_lat, kr_raw, sq, sk, sv = jnp.split(proj, IN_SPLITS, axis=-1)
    q = (rms_norm(q_lat, p["g_q_a"]) @ p["w_q_b"]).reshape(B, T, MLA_HEADS, NOPE_DIM + ROPE_DIM)
    q_mla = jnp.concatenate([rms_norm(q[..., :NOPE_DIM], p["g_q_nope"]),
                             apply_rope(rms_norm(q[..., NOPE_DIM:], p["g_q_rope"]), pos)], axis=-1)
    c_kv = rms_norm(kv_lat, p["g_kv_a"])
    k_rope = apply_rope(rms_norm(kr_raw, p["g_k_rope"])[:, :, None, :], pos)[:, :, 0, :]
    sb_q = sq.reshape(B, T, SB_HEADS, SB_DIM)
    sb_k = sk.reshape(B, T, SB_HEADS, SB_DIM)
    sb_v = sv.reshape(B, T, SB_HEADS, SB_DIM)
    if past is None:
        c_all, kr_all, sbk_all, sbv_all, k_pos = c_kv, k_rope, sb_k, sb_v, pos
    else:
        p_ckv, p_kr, p_sbk, p_sbv = past
        c_all = jnp.concatenate([p_ckv, c_kv], axis=1)
        kr_all = jnp.concatenate([p_kr, k_rope], axis=1)
        sbk_all = jnp.concatenate([p_sbk, sb_k], axis=1)
        sbv_all = jnp.concatenate([p_sbv, sb_v], axis=1)
        k_pos = jnp.concatenate([jnp.arange(p_ckv.shape[1], dtype=jnp.int32), pos])
    S = c_all.shape[1]
    kv = (c_all @ p["w_kv_b"]).reshape(B, S, MLA_HEADS, NOPE_DIM + V_DIM)
    k_mla = jnp.concatenate([rms_norm(kv[..., :NOPE_DIM], p["g_k_nope"]),
                             jnp.broadcast_to(kr_all[:, :, None, :], (B, S, MLA_HEADS, ROPE_DIM))], axis=-1)
    v_mla = kv[..., NOPE_DIM:]
    mla_out = sweep_query_blocks(lambda qb, pb: chunk_causal_softmax(qb, pb, k_mla, v_mla, k_pos), q_mla, pos)
    sb_out = sweep_query_blocks(lambda qb, pb: stick_breaking(qb, pb, sbk_all, sbv_all, k_pos), sb_q, pos)
    merged = jnp.concatenate([rms_norm(mla_out.reshape(B, T, MLA_WIDTH), p["g_out_mla"]),
                              rms_norm(sb_out.reshape(B, T, SB_WIDTH), p["g_out_sb"])], axis=-1)
    return merged @ p["w_o"], (c_kv, k_rope, sb_k, sb_v)


def trunk_layer(x, pos, past, p):
    mix, new_rows = token_mixers(rms_norm(x, p["g_attn"]), pos, past, p)
    h = x + mix
    u = jnp.maximum(rms_norm(h, p["g_mlp"]) @ p["w_up"], 0.0)
    return h + (u * u) @ p["w_down"], new_rows


def setup_inputs(seed: int = 0) -> dict:
    key = jax.random.key(seed)
    ks = jax.random.split(key, 26)

    def nrm(k, shape, scale=1.0):
        return jax.random.normal(k, shape, jnp.float32) * scale

    def gain(k, shape):
        return 1.0 + 0.02 * jax.random.normal(k, shape, jnp.float32)

    return {
        "x_prompt": nrm(ks[0], (BATCH, SEQ, D_MODEL)),
        "x_sample": nrm(ks[1], (DEC_BATCH, DEC_SEQ, D_MODEL)),
        "cache_mla_ckv": nrm(ks[2], (DEPTH, DEC_BATCH, PAST_LEN, KV_LORA)),
        "cache_mla_krope": nrm(ks[3], (DEPTH, DEC_BATCH, PAST_LEN, ROPE_DIM)),
        "cache_sb_k": nrm(ks[4], (DEPTH, DEC_BATCH, PAST_LEN, SB_HEADS, SB_DIM)),
        "cache_sb_v": nrm(ks[5], (DEPTH, DEC_BATCH, PAST_LEN, SB_HEADS, SB_DIM)),
        "g_attn": gain(ks[6], (DEPTH, D_MODEL)),
        "w_in": nrm(ks[7], (DEPTH, D_MODEL, IN_WIDTH), D_MODEL ** -0.5),
        "g_q_a": gain(ks[8], (DEPTH, Q_LORA)),
        "w_q_b": nrm(ks[9], (DEPTH, Q_LORA, MLA_HEADS * (NOPE_DIM + ROPE_DIM)), Q_LORA ** -0.5),
        "g_kv_a": gain(ks[10], (DEPTH, KV_LORA)),
        "w_kv_b": nrm(ks[11], (DEPTH, KV_LORA, MLA_HEADS * (NOPE_DIM + V_DIM)), KV_LORA ** -0.5),
        "g_q_nope": gain(ks[12], (DEPTH, NOPE_DIM)),
        "g_q_rope": gain(ks[13], (DEPTH, ROPE_DIM)),
        "g_k_nope": gain(ks[14], (DEPTH, NOPE_DIM)),
        "g_k_rope": gain(ks[15], (DEPTH, ROPE_DIM)),
        "g_out_mla": gain(ks[16], (DEPTH, MLA_WIDTH)),
        "g_out_sb": gain(ks[17], (DEPTH, SB_WIDTH)),
        "w_o": nrm(ks[18], (DEPTH, MIX_WIDTH, D_MODEL), MIX_WIDTH ** -0.5),
        "g_mlp": gain(ks[19], (DEPTH, D_MODEL)),
        "w_up": nrm(ks[20], (DEPTH, D_MODEL, D_FF), D_MODEL ** -0.5),
        "w_down": nrm(ks[21], (DEPTH, D_FF, D_MODEL), D_FF ** -0.5),
    }


def reference(x_prompt, x_sample, cache_mla_ckv, cache_mla_krope, cache_sb_k, cache_sb_v,
              g_attn, w_in, g_q_a, w_q_b, g_kv_a, w_kv_b, g_q_nope, g_q_rope, g_k_nope, g_k_rope,
              g_out_mla, g_out_sb, w_o, g_mlp, w_up, w_down):
    past_len = cache_mla_ckv.shape[2]
    pos_prompt = jnp.arange(x_prompt.shape[1], dtype=jnp.int32)
    pos_sample = past_len + jnp.arange(x_sample.shape[1], dtype=jnp.int32)
    hp, hs = x_prompt, x_sample
    rows_p = ([], [], [], [])
    rows_s = ([], [], [], [])
    for l in range(DEPTH):
        p = {"g_attn": g_attn[l], "w_in": w_in[l], "g_q_a": g_q_a[l], "w_q_b": w_q_b[l],
             "g_kv_a": g_kv_a[l], "w_kv_b": w_kv_b[l], "g_q_nope": g_q_nope[l], "g_q_rope": g_q_rope[l],
             "g_k_nope": g_k_nope[l], "g_k_rope": g_k_rope[l], "g_out_mla": g_out_mla[l],
             "g_out_sb": g_out_sb[l], "w_o": w_o[l], "g_mlp": g_mlp[l], "w_up": w_up[l],
             "w_down": w_down[l]}
        hp, new_p = trunk_layer(hp, pos_prompt, None, p)
        past = (cache_mla_ckv[l], cache_mla_krope[l], cache_sb_k[l], cache_sb_v[l])
        hs, new_s = trunk_layer(hs, pos_sample, past, p)
        for i in range(4):
            rows_p[i].append(new_p[i])
            rows_s[i].append(new_s[i])
    return (hp, hs,
            jnp.stack(rows_p[0]), jnp.stack(rows_p[1]), jnp.stack(rows_p[2]), jnp.stack(rows_p[3]),
            jnp.stack(rows_s[0]), jnp.stack(rows_s[1]), jnp.stack(rows_s[2]), jnp.stack(rows_s[3]))
```

```cpp
#include <hip/hip_runtime.h>
#include <cstdio>
#include <cstdint>
namespace pg8 {
#define PG8_LAS __attribute__((address_space(3)))
typedef unsigned short bf16_t;
typedef short bf16x8 __attribute__((ext_vector_type(8)));
typedef float f32x4 __attribute__((ext_vector_type(4)));
typedef unsigned u32x4 __attribute__((ext_vector_type(4)));
constexpr int BM = 256, BK = 64, HALF = 128, HTB = HALF * BK * 2  , STAGE_BYTES = 8 * HTB, NXCD = 8, WGM = 8;

__host__ __device__ __forceinline__ int lds_byte(int r, int c) { const int st = (r >> 4) * 2 + (c >> 5), rr = r & 15, cc = c & 31, ob = rr * 64 + cc * 2; return st * 1024 + (ob ^ (((ob >> 9) & 1) << 5)); }
__host__ __device__ __forceinline__ void stage_rc(int b, int& R, int& C) { const int st = b / 1024, sb = b % 1024, swz = sb ^ (((sb >> 9) & 1) << 5); R = (st >> 1) * 16 + swz / 64; C = (st & 1) * 32 + (swz % 64) / 2; }
__host__ __device__ __forceinline__ int perm32(int rho) { const int n = rho >> 4, i = rho & 15; return 8 * (i >> 2) + 4 * n + (i & 3); }

struct Unit { int pm, pn; };
struct Gemm { const bf16_t* A; const bf16_t* Bt; int M, N, K; };

struct StaticOrder {
    int nM, nN, nwg, G, c;
    __host__ __device__ void init(int M, int N, int G_, int c_) { nM = M / BM; nN = N / BM; nwg = nM * nN; G = G_; c = c_; }
    __host__ __device__ bool next(int i, Unit& u) const {
        const long L = (long)i * G + c; if (L >= nwg) return false;
        int wgid = (int)L; { const int q = nwg / NXCD, r = nwg % NXCD, xcd = wgid % NXCD, off = wgid / NXCD; wgid = (xcd < r ? xcd * (q + 1) : r * (q + 1) + (xcd - r) * q) + off; }
        const int nig = WGM * nN, gid = wgid / nig, fm = gid * WGM, gsz = (nM - fm) < WGM ? (nM - fm) : WGM;
        u.pm = fm + ((wgid % nig) % gsz); u.pn = (wgid % nig) / gsz; return true;
    }
    __device__ __forceinline__ void a_ready(const Unit&) const {}
    __device__ __forceinline__ void done(const Unit&) const {}
};

__device__ __forceinline__ unsigned cvt_pk_bf16(float lo, float hi) { unsigned r; asm volatile("v_cvt_pk_bf16_f32 %0, %1, %2" : "=v"(r) : "v"(lo), "v"(hi)); return r; }
typedef unsigned u32x2 __attribute__((ext_vector_type(2)));
constexpr int HY_NP = 16384;
__device__ __forceinline__ int hy_kvrow(int m) { return m < HY_NP ? m : HY_NP + ((m - HY_NP) >> 6) * 1088 + 1024 + ((m - HY_NP) & 63); }

struct EpiIn {
    static constexpr bool PERM = true, AFTER_DRAIN = false;
    float* LAT; bf16_t* SBQ; bf16_t* SBK; bf16_t* SBV; float* outK_p; float* outV_p; float* outK_s; float* outV_s; float qscale;
    __device__ __forceinline__ void operator()(const f32x4 (&acc)[2][2][4][2], const Unit& u, int wr, int wc, int fr, int fq) const {
        const int row0 = u.pm * BM + wr * 64 + fr, colw = wc * 32 + 8 * fq, pn = u.pn;
        if (pn < 7) {
#pragma unroll
            for (int ai = 0; ai < 2; ++ai)
#pragma unroll
                for (int m = 0; m < 4; ++m) { float* rp = LAT + (size_t)(row0 + ai * HALF + m * 16) * 1792 + pn * BM + colw;
#pragma unroll
                    for (int bj = 0; bj < 2; ++bj) { *(f32x4*)(rp + bj * HALF) = acc[ai][bj][m][0]; *(f32x4*)(rp + bj * HALF + 4) = acc[ai][bj][m][1]; } }
        } else if (pn < 15) {
            const float sc = qscale;
#pragma unroll
            for (int ai = 0; ai < 2; ++ai)
#pragma unroll
                for (int m = 0; m < 4; ++m) { bf16_t* rp = SBQ + (size_t)(row0 + ai * HALF + m * 16) * 2048 + (pn - 7) * BM + colw;
#pragma unroll
                    for (int bj = 0; bj < 2; ++bj) { const f32x4 v0 = acc[ai][bj][m][0] * sc, v1 = acc[ai][bj][m][1] * sc;
                        u32x4 w; w.x = cvt_pk_bf16(v0[0], v0[1]); w.y = cvt_pk_bf16(v0[2], v0[3]); w.z = cvt_pk_bf16(v1[0], v1[1]); w.w = cvt_pk_bf16(v1[2], v1[3]);
                        *(u32x4*)(rp + bj * HALF) = w; } }
        } else {
            const bool isv = pn >= 23; const int c0 = (pn - (isv ? 23 : 15)) * BM + colw;
            float* fop = isv ? outV_p : outK_p; float* fos = isv ? outV_s : outK_s; bf16_t* bb = isv ? SBV : SBK;
#pragma unroll
            for (int ai = 0; ai < 2; ++ai)
#pragma unroll
                for (int m = 0; m < 4; ++m) { const int row = row0 + ai * HALF + m * 16;
                    float* fo = (row < HY_NP) ? fop + (size_t)row * 2048 : fos + (size_t)(row - HY_NP) * 2048;
                    bf16_t* bo = bb + (size_t)hy_kvrow(row) * 2048 + c0; fo += c0;
#pragma unroll
                    for (int bj = 0; bj < 2; ++bj) { const f32x4 v0 = acc[ai][bj][m][0], v1 = acc[ai][bj][m][1];
                        *(f32x4*)(fo + bj * HALF) = v0; *(f32x4*)(fo + bj * HALF + 4) = v1;
                        u32x4 w; w.x = cvt_pk_bf16(v0[0], v0[1]); w.y = cvt_pk_bf16(v0[2], v0[3]); w.z = cvt_pk_bf16(v1[0], v1[1]); w.w = cvt_pk_bf16(v1[2], v1[3]);
                        *(u32x4*)(bo + bj * HALF) = w; } }
        }
    }
};
struct EpiF32 {
    static constexpr bool PERM = false, AFTER_DRAIN = false;
    float* C; int ldc;
    __device__ __forceinline__ void operator()(const f32x4 (&acc)[2][2][4][2], const Unit& u, int wr, int wc, int fr, int fq) const {
        const int row0 = u.pm * BM + wr * 64 + fr, col0 = u.pn * BM + wc * 32 + 4 * fq;
#pragma unroll
        for (int ai = 0; ai < 2; ++ai)
#pragma unroll
            for (int m = 0; m < 4; ++m) { float* rowp = C + (size_t)(row0 + ai * HALF + m * 16) * ldc + col0;
#pragma unroll
                for (int bj = 0; bj < 2; ++bj)
#pragma unroll
                    for (int n = 0; n < 2; ++n) *(f32x4*)(rowp + bj * HALF + n * 16) = acc[ai][bj][m][n]; }
    }
};
struct EpiKvb {
    static constexpr bool PERM = true, AFTER_DRAIN = false;
    float* KNRAW; bf16_t* VB;
    __device__ __forceinline__ void operator()(const f32x4 (&acc)[2][2][4][2], const Unit& u, int wr, int wc, int fr, int fq) const {
        const int row0 = u.pm * BM + wr * 64 + fr, colw = wc * 32 + 8 * fq, pn = u.pn;
        if (pn < 8) {
#pragma unroll
            for (int ai = 0; ai < 2; ++ai)
#pragma unroll
                for (int m = 0; m < 4; ++m) { float* rp = KNRAW + (size_t)(row0 + ai * HALF + m * 16) * 2048 + pn * BM + colw;
#pragma unroll
                    for (int bj = 0; bj < 2; ++bj) { *(f32x4*)(rp + bj * HALF) = acc[ai][bj][m][0]; *(f32x4*)(rp + bj * HALF + 4) = acc[ai][bj][m][1]; } }
        } else {
#pragma unroll
            for (int ai = 0; ai < 2; ++ai)
#pragma unroll
                for (int m = 0; m < 4; ++m) { bf16_t* rp = VB + (size_t)(row0 + ai * HALF + m * 16) * 2048 + (pn - 8) * BM + colw;
#pragma unroll
                    for (int bj = 0; bj < 2; ++bj) { const f32x4 v0 = acc[ai][bj][m][0], v1 = acc[ai][bj][m][1];
                        u32x4 w; w.x = cvt_pk_bf16(v0[0], v0[1]); w.y = cvt_pk_bf16(v0[2], v0[3]); w.z = cvt_pk_bf16(v1[0], v1[1]); w.w = cvt_pk_bf16(v1[2], v1[3]);
                        *(u32x4*)(rp + bj * HALF) = w; } }
        }
    }
};
struct EpiRes {
    static constexpr bool PERM = false, AFTER_DRAIN = false;
    const float* resP; const float* resS; float* out;
    __device__ __forceinline__ void operator()(const f32x4 (&acc)[2][2][4][2], const Unit& u, int wr, int wc, int fr, int fq) const {
        const int row0 = u.pm * BM + wr * 64 + fr, col0 = u.pn * BM + wc * 32 + 4 * fq;
        const bool samp = u.pm >= HY_NP / BM;
#pragma unroll
        for (int ai = 0; ai < 2; ++ai)
#pragma unroll
            for (int m = 0; m < 4; ++m) { const int row = row0 + ai * HALF + m * 16;
                const float* rp = samp ? resS + (size_t)(row - HY_NP) * 4096 + col0 : resP + (size_t)row * 4096 + col0;
                float* op = out + (size_t)row * 4096 + col0;
#pragma unroll
                for (int bj = 0; bj < 2; ++bj)
#pragma unroll
                    for (int n = 0; n < 2; ++n) { const f32x4 r = *(const f32x4*)(rp + bj * HALF + n * 16); *(f32x4*)(op + bj * HALF + n * 16) = r + acc[ai][bj][m][n]; } }
    }
};
struct EpiRelu2 {
    static constexpr bool PERM = true, AFTER_DRAIN = false;
    bf16_t* O; int ldc;
    __device__ __forceinline__ void operator()(const f32x4 (&acc)[2][2][4][2], const Unit& u, int wr, int wc, int fr, int fq) const {
        const int row0 = u.pm * BM + wr * 64 + fr, col0 = u.pn * BM + wc * 32 + 8 * fq;
#pragma unroll
        for (int ai = 0; ai < 2; ++ai)
#pragma unroll
            for (int m = 0; m < 4; ++m) { bf16_t* rowp = O + (size_t)(row0 + ai * HALF + m * 16) * ldc + col0;
#pragma unroll
                for (int bj = 0; bj < 2; ++bj) { f32x4 v0 = acc[ai][bj][m][0], v1 = acc[ai][bj][m][1];
#pragma unroll
                    for (int e = 0; e < 4; ++e) { const float a = fmaxf(v0[e], 0.f), b = fmaxf(v1[e], 0.f); v0[e] = a * a; v1[e] = b * b; }
                    u32x4 w; w.x = cvt_pk_bf16(v0[0], v0[1]); w.y = cvt_pk_bf16(v0[2], v0[3]); w.z = cvt_pk_bf16(v1[0], v1[1]); w.w = cvt_pk_bf16(v1[2], v1[3]);
                    *(u32x4*)(rowp + bj * HALF) = w; } }
    }
};
template <class Epi, class Sched, bool ALIGN_EPI = false, bool SP2 = false>
__device__ __forceinline__ void gemm_phase(PG8_LAS unsigned char* lds, const Gemm g, const Sched& S, const Epi& E) {
    int tid_o = threadIdx.x; asm volatile("" : "+v"(tid_o));
    const int tid = tid_o, wid = __builtin_amdgcn_readfirstlane(tid >> 6), lane = tid & 63, wr = wid >> 2, wc = wid & 3, fr = lane & 15, fq = lane >> 4;
    const int K = g.K, nt = K / BK;
    unsigned voffA[2], voffB[2];
#pragma unroll
    for (int i = 0; i < 2; ++i) { int R, C; stage_rc(tid * 16 + i * 8192, R, C); const int Rb = Epi::PERM ? ((R & ~31) + perm32(R & 31)) : R;
        voffA[i] = (unsigned)(R * K + C) * 2u; voffB[i] = (unsigned)(Rb * K + C) * 2u; }
    const size_t kstep = (size_t)(BK * 2);
    const size_t hstep = (size_t)HALF * K * 2;
    const size_t tstep = 2 * hstep;
    const unsigned ldsw = (unsigned)wid * 1024u;
    const int aoff = lds_byte(wr * 64 + fr, fq * 8), boff = lds_byte(wc * 32 + fr, fq * 8);
#define PG8_SA(b, h) (((b) * 2 + (h)) * HTB)
#define PG8_SB(b, h) ((4 + (b) * 2 + (h)) * HTB)
#define PG8_STAGE(bufoff, gbase, voff) do { _Pragma("unroll") for (int _i = 0; _i < 2; ++_i) \
        __builtin_amdgcn_global_load_lds((const unsigned*)((const char*)(gbase) + (voff)[_i]), (PG8_LAS unsigned*)(lds + (bufoff) + ldsw + _i * 8192), 16, 0, 0); } while (0)
#define PG8_LDA(dst, b, h) do { _Pragma("unroll") for (int m = 0; m < 4; ++m) _Pragma("unroll") for (int k = 0; k < 2; ++k) dst[m][k] = *(const PG8_LAS bf16x8*)(lds + PG8_SA(b, h) + aoff + m * 2048 + k * 1024); } while (0)
#define PG8_LDB(dst, b, h) do { _Pragma("unroll") for (int n = 0; n < 2; ++n) _Pragma("unroll") for (int k = 0; k < 2; ++k) dst[n][k] = *(const PG8_LAS bf16x8*)(lds + PG8_SB(b, h) + boff + n * 2048 + k * 1024); } while (0)
#define PG8_MMA(ai, bj, At, Bt) do { __builtin_amdgcn_s_setprio(1); _Pragma("unroll") for (int m = 0; m < 4; ++m) _Pragma("unroll") for (int n = 0; n < 2; ++n) _Pragma("unroll") for (int k = 0; k < 2; ++k) \
        acc[ai][bj][m][n] = __builtin_amdgcn_mfma_f32_16x16x32_bf16(Bt[n][k], At[m][k], acc[ai][bj][m][n], 0, 0, 0); __builtin_amdgcn_s_setprio(0); } while (0)
#define PG8_WAIT_V(n) asm volatile("s_waitcnt vmcnt(" #n ")" ::: "memory")
#define PG8_WAIT_L(n) asm volatile("s_waitcnt lgkmcnt(" #n ")" ::: "memory")
#define PG8_BAR __builtin_amdgcn_s_barrier()
#define PG8_SCHED __builtin_amdgcn_sched_barrier(0)
    Unit cur, nxt; int ui = 0;
    if (!S.next(0, cur)) return;
    f32x4 acc[2][2][4][2];
#pragma unroll
    for (int a = 0; a < 2; ++a)
#pragma unroll
        for (int b = 0; b < 2; ++b)
#pragma unroll
            for (int m = 0; m < 4; ++m)
#pragma unroll
                for (int n = 0; n < 2; ++n) acc[a][b][m][n] = (f32x4){0.f, 0.f, 0.f, 0.f};
    bf16x8 At[4][2], B0[2][2], B1[2][2];
    const char* cA = (const char*)g.A + (size_t)cur.pm * tstep; const char* cB = (const char*)g.Bt + (size_t)cur.pn * tstep;
    S.a_ready(cur);
    if constexpr (SP2) {
        PG8_STAGE(PG8_SB(0, 0), cB, voffB); PG8_STAGE(PG8_SB(0, 1), cB + hstep, voffB); PG8_STAGE(PG8_SA(0, 0), cA, voffA); PG8_STAGE(PG8_SA(0, 1), cA + hstep, voffA);
        if (wr == 1) PG8_BAR;
        PG8_WAIT_V(2); PG8_BAR;
        PG8_STAGE(PG8_SB(1, 0), cB + kstep, voffB); PG8_STAGE(PG8_SA(1, 0), cA + kstep, voffA); PG8_STAGE(PG8_SB(1, 1), cB + hstep + kstep, voffB);
        PG8_WAIT_V(6); PG8_BAR;
    } else {
        PG8_STAGE(PG8_SB(0, 0), cB, voffB); PG8_STAGE(PG8_SA(0, 0), cA, voffA); PG8_STAGE(PG8_SB(0, 1), cB + hstep, voffB); PG8_STAGE(PG8_SA(0, 1), cA + hstep, voffA);
        if (wr == 1) PG8_BAR;
        PG8_WAIT_V(4); PG8_BAR;
        PG8_STAGE(PG8_SB(1, 0), cB + kstep, voffB); PG8_STAGE(PG8_SA(1, 0), cA + kstep, voffA); PG8_STAGE(PG8_SB(1, 1), cB + hstep + kstep, voffB);
        PG8_WAIT_V(6); PG8_BAR;
    }
    for (;;) {
        const bool has_next = S.next(ui + 1, nxt);
        const char* nA = has_next ? (const char*)g.A + (size_t)nxt.pm * tstep : cA; const char* nB = has_next ? (const char*)g.Bt + (size_t)nxt.pn * tstep : cB;
        for (int t = 0; t < nt; t += 2) {
            const bool last = (t == nt - 2);
            const char* a1 = cA + (size_t)(t + 1) * kstep;
            const char* a2 = last ? nA : cA + (size_t)(t + 2) * kstep; const char* b2 = last ? nB : cB + (size_t)(t + 2) * kstep;
            const char* a3 = a2 + kstep; const char* b3 = b2 + kstep;
            if (last && has_next) S.a_ready(nxt);
            if constexpr (SP2) {
            PG8_LDB(B0, 0, 0); PG8_LDB(B1, 0, 1); PG8_SCHED; PG8_LDA(At, 0, 0); PG8_STAGE(PG8_SA(1, 1), a1 + hstep, voffA);
            PG8_WAIT_V(8); PG8_WAIT_L(0); PG8_BAR; PG8_MMA(0, 0, At, B0); PG8_MMA(0, 1, At, B1); PG8_BAR; PG8_SCHED;
            PG8_LDA(At, 0, 1); PG8_STAGE(PG8_SB(0, 0), b2, voffB); PG8_STAGE(PG8_SB(0, 1), b2 + hstep, voffB); PG8_STAGE(PG8_SA(0, 0), a2, voffA);
            PG8_WAIT_V(8); PG8_WAIT_L(0); PG8_BAR; PG8_MMA(1, 0, At, B0); PG8_MMA(1, 1, At, B1); PG8_BAR; PG8_SCHED;
            PG8_LDB(B0, 1, 0); PG8_LDB(B1, 1, 1); PG8_SCHED; PG8_LDA(At, 1, 0); PG8_STAGE(PG8_SA(0, 1), a2 + hstep, voffA);
            PG8_WAIT_V(8); PG8_WAIT_L(0); PG8_BAR; PG8_MMA(0, 0, At, B0); PG8_MMA(0, 1, At, B1); PG8_BAR; PG8_SCHED;
            PG8_LDA(At, 1, 1); PG8_STAGE(PG8_SB(1, 0), b3, voffB); PG8_STAGE(PG8_SB(1, 1), b3 + hstep, voffB); PG8_STAGE(PG8_SA(1, 0), a3, voffA);
            PG8_WAIT_V(8); PG8_WAIT_L(0); PG8_BAR; PG8_MMA(1, 0, At, B0); PG8_MMA(1, 1, At, B1); PG8_BAR; PG8_SCHED;
            } else {
            PG8_LDB(B0, 0, 0); PG8_SCHED; PG8_LDA(At, 0, 0); PG8_STAGE(PG8_SA(1, 1), a1 + hstep, voffA);
            PG8_WAIT_L(8); PG8_BAR; PG8_WAIT_L(0); PG8_MMA(0, 0, At, B0); PG8_BAR; PG8_SCHED;
            PG8_LDB(B1, 0, 1); PG8_STAGE(PG8_SB(0, 0), b2, voffB);
            PG8_BAR; PG8_WAIT_L(0); PG8_MMA(0, 1, At, B1); PG8_BAR;
            PG8_LDA(At, 0, 1); PG8_STAGE(PG8_SA(0, 0), a2, voffA);
            PG8_BAR; PG8_WAIT_L(0); PG8_MMA(1, 0, At, B0); PG8_BAR; PG8_SCHED;
            PG8_STAGE(PG8_SB(0, 1), b2 + hstep, voffB);
            PG8_WAIT_V(6); PG8_BAR; PG8_MMA(1, 1, At, B1); PG8_BAR;
            PG8_LDB(B0, 1, 0); PG8_SCHED; PG8_LDA(At, 1, 0); PG8_STAGE(PG8_SA(0, 1), a2 + hstep, voffA);
            PG8_WAIT_L(8); PG8_BAR; PG8_WAIT_L(0); PG8_MMA(0, 0, At, B0); PG8_BAR; PG8_SCHED;
            PG8_LDB(B1, 1, 1); PG8_STAGE(PG8_SB(1, 0), b3, voffB);
            PG8_BAR; PG8_WAIT_L(0); PG8_MMA(0, 1, At, B1); PG8_BAR;
            PG8_LDA(At, 1, 1); PG8_STAGE(PG8_SA(1, 0), a3, voffA);
            PG8_BAR; PG8_WAIT_L(0); PG8_MMA(1, 0, At, B0); PG8_BAR; PG8_SCHED;
            PG8_STAGE(PG8_SB(1, 1), b3 + hstep, voffB);
            PG8_WAIT_V(6); PG8_BAR; PG8_MMA(1, 1, At, B1); PG8_BAR;
            }
        }
        if constexpr (ALIGN_EPI) { if (wr == 0) PG8_BAR; }
        if constexpr (!Epi::AFTER_DRAIN) { E(acc, cur, wr, wc, fr, fq); S.done(cur); }
        if (!has_next) break;
#pragma unroll
        for (int a = 0; a < 2; ++a)
#pragma unroll
            for (int b = 0; b < 2; ++b)
#pragma unroll
                for (int m = 0; m < 4; ++m)
#pragma unroll
                    for (int n = 0; n < 2; ++n) acc[a][b][m][n] = (f32x4){0.f, 0.f, 0.f, 0.f};
        cur = nxt; cA = nA; cB = nB; ++ui;
        if constexpr (ALIGN_EPI) { if (wr == 1) PG8_BAR; }
    }
    PG8_WAIT_V(0);
    if constexpr (!ALIGN_EPI) { if (wr == 0) PG8_BAR; }
    PG8_BAR;
    if constexpr (Epi::AFTER_DRAIN) { E.fused(acc, cur, wr, wc, fr, fq, lds, wid, lane); S.done(cur); }
#undef PG8_SA
#undef PG8_SB
#undef PG8_STAGE
#undef PG8_LDA
#undef PG8_LDB
#undef PG8_MMA
#undef PG8_WAIT_V
#undef PG8_WAIT_L
#undef PG8_BAR
#undef PG8_SCHED
}
}
namespace att {
typedef short bf16x8 __attribute__((ext_vector_type(8)));
typedef short s16x4 __attribute__((ext_vector_type(4)));
typedef float f32x16 __attribute__((ext_vector_type(16)));
typedef unsigned u32x4 __attribute__((ext_vector_type(4)));
typedef unsigned short bf16;
#define ALAS __attribute__((address_space(3)))
constexpr int OFF_V = 0, OFF_K = 32768, OFF_R = 65536, OFF_WS = 81920, ATT_LDS_BYTES = 81920 + 8 * 256;
#define KSWZ(row, colB) ((row) * 256 + ((colB) ^ (((row) & 7) << 4)))
#define RSWZ(row, colB) ((row) * 128 + ((colB) ^ ((((row) >> 1) & 7) << 4)))
__device__ __forceinline__ int v_st(int k, int c) { const int kk = (k & ~0xC) | ((k & 4) << 1) | ((k & 8) >> 1); return ((kk >> 3) * 4 + (c >> 5)) * 512 + ((kk & 7) * 32 + (c & 31)) * 2; }
__device__ __forceinline__ int v_rd_base(int lane) { return ((lane & 3) << 3) | (((lane >> 2) & 3) << 6) | (((lane >> 4) & 1) << 5) | (((lane >> 5) & 1) << 8); }
__device__ __forceinline__ int crow(int r, int hi) { return (r & 3) + 8 * (r >> 2) + 4 * hi; }
__device__ __forceinline__ unsigned cvtpk(float lo, float hi) { unsigned r; asm volatile("v_cvt_pk_bf16_f32 %0, %1, %2" : "=v"(r) : "v"(lo), "v"(hi)); return r; }

struct Unit { const bf16* Q; int ldq; const bf16* K; const bf16* Kr; const bf16* V; bf16* O; int P0; int NT; int nact; };

__device__ __forceinline__ void qk128(f32x16& p0, f32x16& p1, ALAS const char* Kt, int r32, int hi, const bf16x8* qr) {
#pragma unroll
    for (int d0 = 0; d0 < 8; ++d0) { ALAS const char* a = Kt + KSWZ(r32, ((d0 & 3) * 16 + hi * 8) * 2) + (d0 >> 2) * 128;
        const bf16x8 b0 = *(ALAS const bf16x8*)a; const bf16x8 b1 = *(ALAS const bf16x8*)(a + 32 * 256);
        p0 = __builtin_amdgcn_mfma_f32_32x32x16_bf16(b0, qr[d0], p0, 0, 0, 0);
        p1 = __builtin_amdgcn_mfma_f32_32x32x16_bf16(b1, qr[d0], p1, 0, 0, 0); }
}
__device__ __forceinline__ void qk64(f32x16& p0, f32x16& p1, ALAS const char* Kt, int r32, int hi, const bf16x8* qr) {
#pragma unroll
    for (int d0 = 0; d0 < 4; ++d0) { ALAS const char* a = Kt + RSWZ(r32, (d0 * 16 + hi * 8) * 2);
        const bf16x8 b0 = *(ALAS const bf16x8*)a; const bf16x8 b1 = *(ALAS const bf16x8*)(a + 32 * 128);
        p0 = __builtin_amdgcn_mfma_f32_32x32x16_bf16(b0, qr[d0], p0, 0, 0, 0);
        p1 = __builtin_amdgcn_mfma_f32_32x32x16_bf16(b1, qr[d0], p1, 0, 0, 0); }
}
__device__ __forceinline__ void pv_tile(f32x16* o, unsigned vb0, bf16x8 pa0, bf16x8 pa1, bf16x8 pa2, bf16x8 pa3) {
#define TRRD(dst, off) asm volatile("ds_read_b64_tr_b16 %0, %1 offset:%2" : "=&v"(dst) : "v"(vb0), "i"(off) : "memory")
#define PV_D0(d0) do { s16x4 l0, l1, l2, l3, h0, h1, h2, h3; constexpr int b_ = (d0) * 512; \
        TRRD(l0, b_); TRRD(h0, b_ + 2048); TRRD(l1, b_ + 4096); TRRD(h1, b_ + 6144); TRRD(l2, b_ + 8192); TRRD(h2, b_ + 10240); TRRD(l3, b_ + 12288); TRRD(h3, b_ + 14336); \
        asm volatile("s_waitcnt lgkmcnt(0)" ::: "memory"); __builtin_amdgcn_sched_barrier(0); \
        o[d0] = __builtin_amdgcn_mfma_f32_32x32x16_bf16(pa0, (bf16x8){l0[0], l0[1], l0[2], l0[3], h0[0], h0[1], h0[2], h0[3]}, o[d0], 0, 0, 0); \
        o[d0] = __builtin_amdgcn_mfma_f32_32x32x16_bf16(pa1, (bf16x8){l1[0], l1[1], l1[2], l1[3], h1[0], h1[1], h1[2], h1[3]}, o[d0], 0, 0, 0); \
        o[d0] = __builtin_amdgcn_mfma_f32_32x32x16_bf16(pa2, (bf16x8){l2[0], l2[1], l2[2], l2[3], h2[0], h2[1], h2[2], h2[3]}, o[d0], 0, 0, 0); \
        o[d0] = __builtin_amdgcn_mfma_f32_32x32x16_bf16(pa3, (bf16x8){l3[0], l3[1], l3[2], l3[3], h3[0], h3[1], h3[2], h3[3]}, o[d0], 0, 0, 0); } while (0)
    PV_D0(0); PV_D0(1); PV_D0(2); PV_D0(3);
#undef PV_D0
#undef TRRD
}
#define PK4(P, B_, OUT) do { const unsigned a0_ = cvtpk(P[B_ + 0], P[B_ + 1]), a1_ = cvtpk(P[B_ + 2], P[B_ + 3]); \
        const unsigned b0_ = cvtpk(P[B_ + 4], P[B_ + 5]), b1_ = cvtpk(P[B_ + 6], P[B_ + 7]); \
        auto r0_ = __builtin_amdgcn_permlane32_swap(a0_, b0_, false, false); auto r1_ = __builtin_amdgcn_permlane32_swap(a1_, b1_, false, false); \
        u32x4 w_ = {r0_[0], r1_[0], r0_[1], r1_[1]}; OUT = __builtin_bit_cast(bf16x8, w_); } while (0)

template <bool MLA>
__device__ __forceinline__ void attn_unit(const Unit u, ALAS char* lds) {
    int tid_o = threadIdx.x; asm volatile("" : "+v"(tid_o));
    const int tid = tid_o, wid = __builtin_amdgcn_readfirstlane(tid >> 6), lane = tid & 63, r32 = lane & 31, hi = lane >> 5;
    const bool actw = wid < u.nact;
    const int sr = tid >> 4, sc = (tid & 15) * 8;
    const int vst0 = v_st(sr, sc), vst1 = v_st(32 + sr, sc), kws = KSWZ(sr, sc * 2);
    const int rk = tid >> 3, rc = (tid & 7) * 8, rws = RSWZ(rk, rc * 2);
    ALAS char* V_l = lds + OFF_V; ALAS char* K_l = lds + OFF_K; ALAS char* R_l = lds + OFF_R;
    ALAS float* al_l = (ALAS float*)(lds + OFF_WS) + wid * 64; ALAS float* li_l = al_l + 32;
    const unsigned vbase = (unsigned)(uintptr_t)V_l + (unsigned)v_rd_base(lane);
    constexpr int NQ = MLA ? 12 : 8;
    bf16x8 qr[NQ];
#pragma unroll
    for (int d0 = 0; d0 < NQ; ++d0) qr[d0] = (bf16x8){0, 0, 0, 0, 0, 0, 0, 0};
    if (actw) {
#pragma unroll
        for (int d0 = 0; d0 < NQ; ++d0) qr[d0] = *(const bf16x8*)(u.Q + (size_t)(wid * 32 + r32) * u.ldq + d0 * 16 + hi * 8);
    }
    const int cw = (u.P0 + wid * 32) >> 6;
    const int qpos = u.P0 + wid * 32 + r32;
    float m_reg = -1e30f, l_reg = 0.f, carry = 0.f;
    f32x16 o[4];
#pragma unroll
    for (int d = 0; d < 4; ++d)
#pragma unroll
        for (int r = 0; r < 16; ++r) o[d][r] = 0.f;
    bf16x8 st_k0, st_k1, st_v0, st_v1, st_r = (bf16x8){0, 0, 0, 0, 0, 0, 0, 0};
#define LOADT(tt) do { const size_t r0_ = (size_t)(tt) * 64; \
        st_k0 = *(const bf16x8*)(u.K + (r0_ + sr) * 2048 + sc); st_k1 = *(const bf16x8*)(u.K + (r0_ + 32 + sr) * 2048 + sc); \
        st_v0 = *(const bf16x8*)(u.V + (r0_ + sr) * 2048 + sc); st_v1 = *(const bf16x8*)(u.V + (r0_ + 32 + sr) * 2048 + sc); \
        if (MLA) st_r = *(const bf16x8*)(u.Kr + (r0_ + rk) * 64 + rc); } while (0)
    LOADT(MLA ? 0 : (u.NT - 1));
    for (int i = 0; i < u.NT; ++i) {
        const int t = MLA ? i : (u.NT - 1 - i); const int buf = i & 1;
        *(ALAS bf16x8*)(K_l + buf * 16384 + kws) = st_k0; *(ALAS bf16x8*)(K_l + buf * 16384 + kws + 32 * 256) = st_k1;
        *(ALAS bf16x8*)(V_l + buf * 16384 + vst0) = st_v0; *(ALAS bf16x8*)(V_l + buf * 16384 + vst1) = st_v1;
        if (MLA) *(ALAS bf16x8*)(R_l + buf * 8192 + rws) = st_r;
        __syncthreads();
        if (i + 1 < u.NT) LOADT(MLA ? (i + 1) : (u.NT - 2 - i));
        if (actw && t <= cw) {
            f32x16 p0, p1;
#pragma unroll
            for (int r = 0; r < 16; ++r) { p0[r] = 0.f; p1[r] = 0.f; }
            qk128(p0, p1, K_l + buf * 16384, r32, hi, qr);
            if (MLA) qk64(p0, p1, R_l + buf * 8192, r32, hi, qr + (MLA ? 8 : 0));
            bf16x8 pa0, pa1, pa2, pa3;
            if (MLA) {
                float pmax = p0[0];
#pragma unroll
                for (int r = 1; r < 16; ++r) pmax = fmaxf(pmax, p0[r]);
#pragma unroll
                for (int r = 0; r < 16; ++r) pmax = fmaxf(pmax, p1[r]);
                { auto rr = __builtin_amdgcn_permlane32_swap(__float_as_uint(pmax), __float_as_uint(pmax), false, false);
                  pmax = fmaxf(__uint_as_float(rr[0]), __uint_as_float(rr[1])); }
                const float mn = fmaxf(m_reg, pmax); const float alpha = __builtin_amdgcn_exp2f(m_reg - mn); m_reg = mn;
                float ps = 0.f;
#pragma unroll
                for (int r = 0; r < 16; ++r) { p0[r] = __builtin_amdgcn_exp2f(p0[r] - mn); ps += p0[r]; }
#pragma unroll
                for (int r = 0; r < 16; ++r) { p1[r] = __builtin_amdgcn_exp2f(p1[r] - mn); ps += p1[r]; }
                { auto rr = __builtin_amdgcn_permlane32_swap(__float_as_uint(ps), __float_as_uint(ps), false, false);
                  ps = __uint_as_float(rr[0]) + __uint_as_float(rr[1]); }
                l_reg = l_reg * alpha + ps;
                if (__any(alpha < 1.f)) {
                    if (hi == 0) al_l[r32] = alpha;
                    asm volatile("s_waitcnt lgkmcnt(0)" ::: "memory");
#pragma unroll
                    for (int r = 0; r < 16; ++r) { const float a = al_l[crow(r, hi)];
#pragma unroll
                        for (int d = 0; d < 4; ++d) o[d][r] *= a; }
                    asm volatile("s_waitcnt lgkmcnt(0)" ::: "memory");
                }
            } else {
                const bool diag = (t == cw); const int dq = qpos - 64 * t - 4 * hi; const float NEG = -__builtin_inff();
                float suf = carry;
#define SB_HALF(P, KOFF) do { f32x16 f_; \
                    _Pragma("unroll") for (int r = 0; r < 16; ++r) { const float y = P[r]; const float e = __builtin_amdgcn_exp2f(-fabsf(y)); const float l2 = __builtin_amdgcn_logf(1.f + e); \
                        const float lb = fminf(y, 0.f) - l2; P[r] = lb; f_[r] = lb - y; } \
                    if (diag) { _Pragma("unroll") for (int r = 0; r < 16; ++r) { const int c = (r & 3) + 8 * (r >> 2) + (KOFF); if (!(c < dq)) { P[r] = NEG; f_[r] = 0.f; } } } \
                    float tg_[4], pg_[4]; \
                    _Pragma("unroll") for (int g = 0; g < 4; ++g) { const float a = (f_[4 * g] + f_[4 * g + 1]) + (f_[4 * g + 2] + f_[4 * g + 3]); \
                        auto rr = __builtin_amdgcn_permlane32_swap(__float_as_uint(a), __float_as_uint(a), false, false); \
                        const float lo = __uint_as_float(rr[0]), hh = __uint_as_float(rr[1]); tg_[g] = lo + hh; pg_[g] = hi == 0 ? hh : 0.f; } \
                    _Pragma("unroll") for (int g = 3; g >= 0; --g) { const float base = suf + pg_[g]; \
                        const float s2 = f_[4 * g + 3], s1 = s2 + f_[4 * g + 2], s0 = s1 + f_[4 * g + 1]; \
                        P[4 * g + 3] = __builtin_amdgcn_exp2f(P[4 * g + 3] + base); P[4 * g + 2] = __builtin_amdgcn_exp2f(P[4 * g + 2] + (base + s2)); \
                        P[4 * g + 1] = __builtin_amdgcn_exp2f(P[4 * g + 1] + (base + s1)); P[4 * g] = __builtin_amdgcn_exp2f(P[4 * g] + (base + s0)); \
                        suf += tg_[g]; } } while (0)
                SB_HALF(p1, 32);
                PK4(p1, 0, pa2); PK4(p1, 8, pa3);
                SB_HALF(p0, 0);
                PK4(p0, 0, pa0); PK4(p0, 8, pa1);
#undef SB_HALF
                carry = suf;
            }
            if (MLA) { PK4(p0, 0, pa0); PK4(p0, 8, pa1); PK4(p1, 0, pa2); PK4(p1, 8, pa3); }
            pv_tile(o, vbase + (unsigned)(buf * 16384), pa0, pa1, pa2, pa3);
        }
    }
    if (actw) {
        float rli[16];
        if (MLA) {
            if (hi == 0) li_l[r32] = l_reg;
            asm volatile("s_waitcnt lgkmcnt(0)" ::: "memory");
#pragma unroll
            for (int r = 0; r < 16; ++r) rli[r] = 1.0f / li_l[crow(r, hi)];
        } else {
#pragma unroll
            for (int r = 0; r < 16; ++r) rli[r] = 1.0f;
        }
        bf16* Ow = u.O + (size_t)(wid * 32) * 2048;
#pragma unroll
        for (int r = 0; r < 16; ++r) { const int orow = crow(r, hi);
#pragma unroll
            for (int d0 = 0; d0 < 4; ++d0) { const float v = o[d0][r] * rli[r]; const float vn = __shfl_xor(v, 1);
                if ((r32 & 1) == 0) *(unsigned*)(Ow + (size_t)orow * 2048 + d0 * 32 + r32) = cvtpk(v, vn); } }
    }
    __syncthreads();
#undef LOADT
}
#undef PK4
}
#define GAS __attribute__((address_space(1)))
#define LAS __attribute__((address_space(3)))
typedef unsigned short bf16;
typedef unsigned v4u __attribute__((ext_vector_type(4)));
typedef float f32x4 __attribute__((ext_vector_type(4)));
typedef short bf16x8 __attribute__((ext_vector_type(8)));
typedef GAS unsigned gu32;
typedef GAS unsigned long long gu64;
#define RLX_AGENT __ATOMIC_RELAXED, __HIP_MEMORY_SCOPE_AGENT
#define LDS_WAIT() asm volatile("s_waitcnt lgkmcnt(0)" ::: "memory")
#define VM_WAIT() asm volatile("s_waitcnt vmcnt(0)" ::: "memory")
__device__ __forceinline__ unsigned long long rt() { return __builtin_amdgcn_s_memrealtime(); }
__device__ __forceinline__ unsigned f2bf(float f) { unsigned u = __builtin_bit_cast(unsigned, f); return (u + 0x7fffu + ((u >> 16) & 1u)) >> 16; }
__device__ __forceinline__ unsigned pk2(float lo, float hi) { return f2bf(lo) | (f2bf(hi) << 16); }

#define XB_TMO      128
#define XB_XCNT(j)  (256  + 64 * (j))
#define XB_XSUB(j)  (1280 + 64 * (j))
#define XB_XGEN(j)  (2304 + 64 * (j))
#define XB_TOP      3328
#define XB_TOPGEN   3392
#define XCD_BAR_WORDS 3456
#define XB_SPIN_CAP (1u << 18)

__device__ __forceinline__ unsigned xb_ld(unsigned* p)              { return __hip_atomic_load(p, __ATOMIC_RELAXED, __HIP_MEMORY_SCOPE_AGENT); }
__device__ __forceinline__ unsigned xb_add(unsigned* p, unsigned v) { return __hip_atomic_fetch_add(p, v, __ATOMIC_RELAXED, __HIP_MEMORY_SCOPE_AGENT); }
__device__ __forceinline__ unsigned xb_xcc_id() { return (unsigned)__builtin_amdgcn_s_getreg((3 << 11) | 20) & 0xFu; }
#define XB_SPIN(cond, bar) do { unsigned _sp = 0; while (cond) { __builtin_amdgcn_s_sleep(1); \
    if ((++_sp & 255u) == 0u) { if (xb_ld(&(bar)[XB_TMO])) break; if (_sp > XB_SPIN_CAP) { atomicAdd(&(bar)[XB_TMO], 1u); break; } } } } while (0)

struct XcdBarrier {
    unsigned* bar; unsigned x;
    volatile LAS unsigned* st;
};

__device__ __forceinline__ XcdBarrier xcd_barrier_post(unsigned* bar, volatile LAS unsigned* st) {
    XcdBarrier b; b.bar = bar; b.x = xb_xcc_id(); b.st = st;
    if (threadIdx.x == 0) (void)xb_add(&bar[XB_XCNT(b.x)], 1u);
    return b;
}
__device__ __forceinline__ void xcd_barrier_complete(unsigned* bar, unsigned x, unsigned& nloc, unsigned& nx) {
    const unsigned G = gridDim.x * gridDim.y * gridDim.z;
    unsigned sum, cnt, mine, sp = 0u;
    for (;;) {
        sum = 0u; cnt = 0u; mine = 0u;
#pragma unroll
        for (unsigned j = 0; j < 16; ++j) { const unsigned c = xb_ld(&bar[XB_XCNT(j)]); sum += c; cnt += (c > 0u) ? 1u : 0u; mine = (j == x) ? c : mine; }
        if (sum == G) break;
        __builtin_amdgcn_s_sleep(1);
        if ((++sp & 255u) == 0u) { if (xb_ld(&bar[XB_TMO])) break; if (sp > XB_SPIN_CAP) { atomicAdd(&bar[XB_TMO], 1u); break; } }
    }
    nloc = mine > 0u ? mine : 1u; nx = cnt > 0u ? cnt : 1u;
}

__device__ __forceinline__ void xcd_barrier(const XcdBarrier& b) {
    asm volatile("s_waitcnt vmcnt(0)" ::: "memory");
    __syncthreads();
    if (threadIdx.x == 0) {
        unsigned* bar = b.bar;
        __builtin_amdgcn_s_waitcnt(0);
        unsigned nloc = b.st[0], nx = b.st[1];
        if (nloc == 0u) { xcd_barrier_complete(bar, b.x, nloc, nx); b.st[0] = nloc; b.st[1] = nx; }
        const unsigned old = xb_add(&bar[XB_XSUB(b.x)], 1u);
        const unsigned gen = old / nloc;
        if (old + 1u == (gen + 1u) * nloc) {
            __builtin_amdgcn_fence(__ATOMIC_RELEASE, "agent");
            asm volatile("s_waitcnt vmcnt(0)" ::: "memory");
            const unsigned og = xb_add(&bar[XB_TOP], 1u);
            const unsigned tg = og / nx;
            if (og + 1u == (tg + 1u) * nx) xb_add(&bar[XB_TOPGEN], 1u);
            else XB_SPIN(xb_ld(&bar[XB_TOPGEN]) == tg, bar);
            __builtin_amdgcn_fence(__ATOMIC_ACQUIRE, "agent");
            xb_add(&bar[XB_XGEN(b.x)], 1u);
            asm volatile("s_waitcnt vmcnt(0)" ::: "memory");
        } else {
            XB_SPIN(xb_ld(&bar[XB_XGEN(b.x)]) == gen, bar);
            __builtin_amdgcn_fence(__ATOMIC_ACQUIRE, "agent");
            asm volatile("s_waitcnt vmcnt(0)" ::: "memory");
        }
    }
    __syncthreads();
}
constexpr int NWAVES = 8;
constexpr int DM = 4096, NP = 16384, NS = 512, MTOK = NP + NS;
constexpr int SEQ = 4096, PAST = 1024, DSEQ = 64, SKVS = PAST + DSEQ;
constexpr int KVROWS = NP + 8 * SKVS;
constexpr int NINP = 7936;
constexpr int QLORA = 1024, KVLORA = 512, ROPE = 64, NOPE = 128, NH = 16, DFF = 16384;
constexpr float EPS = 1e-6f;
constexpr float LOG2E = 1.4426950408889634f;
constexpr float QS_MLA = 0.07216878364870322f * LOG2E;
constexpr float QS_SB = 0.08838834764831845f * LOG2E;

constexpr size_t O_Y = 0, O_CKV_P = 69206016, O_KR_P = 85983232, O_SBK_P = 88080384, O_SBV_P = 155189248,
                 O_CKV_S = 222298112, O_KR_S = 222822400, O_SBK_S = 222887936, O_SBV_S = 224985088, O_END = 227082240;

constexpr size_t MiB = 1u << 20;
constexpr size_t WS_CTL = 0, CTL_ZERO_BYTES = 1 * MiB;
constexpr size_t WS_TAB = 1 * MiB;
constexpr size_t WS_WIN = 2 * MiB;
constexpr size_t WS_WQB = 64 * MiB;
constexpr size_t WS_WKVB = 70 * MiB;
constexpr size_t WS_WO = 74 * MiB;
constexpr size_t WS_WUP = 106 * MiB;
constexpr size_t WS_WDN = 234 * MiB;
constexpr size_t WS_XN = 362 * MiB;
constexpr size_t WS_R = 494 * MiB;
constexpr size_t WS_U = WS_R;
constexpr size_t WS_QLAT = WS_R;
constexpr size_t WS_AKV = WS_QLAT + 33 * MiB;
constexpr size_t WS_KROPE = WS_AKV + 25 * MiB;
constexpr size_t WS_VB = WS_KROPE + 4 * MiB;
constexpr size_t WS_QB = WS_VB + 98 * MiB;
constexpr size_t WS_KN = WS_QB + 99 * MiB;
constexpr size_t WS_SBQ = WS_KN + 98 * MiB;
constexpr size_t WS_SBK = WS_SBQ + 66 * MiB;
constexpr size_t WS_SBV = WS_SBK + 98 * MiB;
constexpr size_t WS_R2 = WS_SBV + 98 * MiB;
constexpr size_t WS_LAT = WS_R2;
constexpr size_t WS_QRAW = WS_R2;
constexpr size_t WS_KNRAW = WS_R2 + 198 * MiB;
constexpr size_t WS_MLAO = WS_R2;
constexpr size_t WS_SBO = WS_R2 + 66 * MiB;
constexpr size_t WS_MERGED = WS_R2 + 132 * MiB;
constexpr size_t WS_END = WS_R2 + 394 * MiB;
static_assert(WS_U + (size_t)MTOK * DFF * 2 <= WS_END, "U fits the overlay region");
static_assert(WS_XN + (size_t)MTOK * DM * 2 <= WS_R && WS_WDN + (size_t)DM * DFF * 2 <= WS_XN && WS_WIN + (size_t)NINP * DM * 2 <= WS_WQB, "ws map");
constexpr int CW_TMO = 0, CW_CODE = 1, CW_BAR = 4096;

constexpr int RING_OFF = 0, RING_BYTES = 131072;
constexpr int LDSCTL_OFF = RING_BYTES, MISC_OFF = LDSCTL_OFF + 320;
constexpr int LDS_BYTES = 147456;
static_assert(att::ATT_LDS_BYTES <= RING_BYTES, "attention scratch fits the ring region");

typedef float f32x2 __attribute__((ext_vector_type(2)));
__device__ __forceinline__ float wave_sum(float v) {
#pragma unroll
    for (int o = 1; o < 64; o <<= 1) v += __shfl_xor(v, o);
    return v;
}
__device__ __forceinline__ unsigned pkbf(float lo, float hi) { return pg8::cvt_pk_bf16(lo, hi); }
__device__ __forceinline__ float bf2f(unsigned short b) { return __uint_as_float(((unsigned)b) << 16); }
__device__ __forceinline__ int kvrow_of(int m) { return m < NP ? m : NP + ((m - NP) >> 6) * SKVS + PAST + ((m - NP) & 63); }
__device__ __forceinline__ int pos_of(int m) { return m < NP ? (m & (SEQ - 1)) : PAST + ((m - NP) & 63); }

__device__ __forceinline__ void sincos_acc(float ang, float& s, float& c) {
    const double a = (double)ang; const double q = rint(a * 0.63661977236758134308);
    double r = fma(-q, 1.57079632679489661923, a); r = fma(-q, 6.123233995736766e-17, r);
    const float rf = (float)r; const int qi = (int)q; const float r2 = rf * rf;
    const float sp = rf + rf * r2 * (-1.6666667163e-1f + r2 * (8.3333337680e-3f + r2 * (-1.9841270114e-4f + r2 * 2.7557314297e-6f)));
    const float cp = 1.f + r2 * (-0.5f + r2 * (4.1666667908e-2f + r2 * (-1.3888889225e-3f + r2 * (2.4801587642e-5f + r2 * (-2.7557314297e-7f)))));
    switch (qi & 3) { case 0: s = sp; c = cp; break; case 1: s = cp; c = -sp; break; case 2: s = -sp; c = -cp; break; default: s = -cp; c = sp; break; }
}

struct Frame {
    LAS unsigned char* lds; volatile LAS unsigned* MISC; gu32* ctl;
    int tid, lane, wave, vcu, G;
};
struct Args { const float* in[22]; float* out; unsigned char* ws; };

__device__ __forceinline__ void transpose_item(const float* W, int K, int N, bf16* WT, int k0, int n0, int drow0, LAS float* scr, int lane) {
#pragma unroll 8
    for (int i = 0; i < 32; ++i) { const int kk = 2 * i + (lane >> 5); scr[kk * 33 + (lane & 31)] = W[(size_t)(k0 + kk) * N + n0 + (lane & 31)]; }
    LDS_WAIT(); asm volatile("" ::: "memory");
    const int c = lane & 7;
#pragma unroll
    for (int j = 0; j < 4; ++j) { const int n = (lane >> 3) + 8 * j; const LAS float* s = scr + (8 * c) * 33 + n;
        v4u o; o.x = pkbf(s[0 * 33], s[1 * 33]); o.y = pkbf(s[2 * 33], s[3 * 33]); o.z = pkbf(s[4 * 33], s[5 * 33]); o.w = pkbf(s[6 * 33], s[7 * 33]);
        *(GAS v4u*)(WT + (size_t)(drow0 + n) * K + k0 + 8 * c) = o; }
    LDS_WAIT(); asm volatile("" ::: "memory");
}
__device__ __forceinline__ void rms_row_4096(const float* xrow, const float* g, bf16* orow, int lane) {
    const GAS f32x4* xr = (const GAS f32x4*)xrow + lane; const GAS f32x4* gr = (const GAS f32x4*)g + lane;
    f32x4 v[16]; float s = 0.f;
#pragma unroll
    for (int j = 0; j < 16; ++j) { v[j] = xr[64 * j]; s += (v[j].x * v[j].x + v[j].y * v[j].y) + (v[j].z * v[j].z + v[j].w * v[j].w); }
    const float rstd = 1.0f / sqrtf(wave_sum(s) * (1.f / 4096.f) + EPS);
    GAS unsigned long long* o8 = (GAS unsigned long long*)orow + lane;
#pragma unroll
    for (int j = 0; j < 16; ++j) { const f32x4 gg = gr[64 * j];
        o8[64 * j] = (unsigned long long)pkbf(v[j].x * rstd * gg.x, v[j].y * rstd * gg.y) | ((unsigned long long)pkbf(v[j].z * rstd * gg.z, v[j].w * rstd * gg.w) << 32); }
}
__device__ __forceinline__ void cache_rows_to_bf16(const float* src, bf16* dst, int W, int gthread, int nthreads) {
    const int per_row = W >> 2; const long total = (long)8 * PAST * per_row;
    for (long i = gthread; i < total; i += nthreads) {
        const int row = (int)(i / per_row), c4 = (int)(i % per_row), b = row >> 10, j = row & 1023;
        const f32x4 v = *(const GAS f32x4*)(src + (size_t)row * W + c4 * 4);
        *(GAS unsigned long long*)(dst + (size_t)(NP + b * SKVS + j) * W + c4 * 4) = (unsigned long long)pkbf(v.x, v.y) | ((unsigned long long)pkbf(v.z, v.w) << 32);
    }
}

__global__ void __launch_bounds__(NWAVES * 64, 2) hymba_fwd(Args args) {
    extern __shared__ __attribute__((aligned(16))) unsigned char lds[];
    Frame F;
    F.lds = (LAS unsigned char*)lds;
    F.MISC = (volatile LAS unsigned*)(F.lds + MISC_OFF);
    F.tid = threadIdx.x; F.lane = F.tid & 63; F.wave = __builtin_amdgcn_readfirstlane(F.tid >> 6);
    F.G = gridDim.x; { const int bx = blockIdx.x; F.vcu = (F.G % 8 == 0) ? (bx % 8) * (F.G / 8) + bx / 8 : bx; }
    unsigned char* ws = args.ws;
    F.ctl = (gu32*)(ws + WS_CTL);
    for (int u = F.tid; u < (LDS_BYTES - LDSCTL_OFF) / 4; u += NWAVES * 64) ((LAS unsigned*)(F.lds + LDSCTL_OFF))[u] = 0u;
    __syncthreads();
    XcdBarrier bar = xcd_barrier_post((unsigned*)(F.ctl + CW_BAR), F.MISC + 8);
#ifndef PHMASK
#define PHMASK 0x3fff
#endif
#define GRID_BAR() xcd_barrier(bar)
#define PHASE_PTRS() unsigned char* wsb = args.ws; float* OUT = args.out; asm volatile("" : "+s"(wsb), "+s"(OUT)); int ptid_ = threadIdx.x; asm volatile("" : "+v"(ptid_)); \
    const int LANE = ptid_ & 63, WAVE = __builtin_amdgcn_readfirstlane(ptid_ >> 6); const int gw = F.vcu * NWAVES + WAVE, NGW = F.G * NWAVES; const int gthread = gw * 64 + LANE, nthreads = NGW * 64; (void)gthread; (void)nthreads; (void)gw; (void)NGW; (void)LANE
#define WIN_T ((bf16*)(wsb + WS_WIN))
#define WQB_T ((bf16*)(wsb + WS_WQB))
#define WKVB_T ((bf16*)(wsb + WS_WKVB))
#define WO_T ((bf16*)(wsb + WS_WO))
#define WUP_T ((bf16*)(wsb + WS_WUP))
#define WDN_T ((bf16*)(wsb + WS_WDN))
#define XN ((bf16*)(wsb + WS_XN))
#define UB ((bf16*)(wsb + WS_U))
#define QLAT ((bf16*)(wsb + WS_QLAT))
#define AKV ((bf16*)(wsb + WS_AKV))
#define KROPE ((bf16*)(wsb + WS_KROPE))
#define VB ((bf16*)(wsb + WS_VB))
#define QB ((bf16*)(wsb + WS_QB))
#define KN ((bf16*)(wsb + WS_KN))
#define SBQ ((bf16*)(wsb + WS_SBQ))
#define SBK ((bf16*)(wsb + WS_SBK))
#define SBV ((bf16*)(wsb + WS_SBV))
#define LAT ((float*)(wsb + WS_LAT))
#define QRAW ((float*)(wsb + WS_QRAW))
#define KNRAW ((float*)(wsb + WS_KNRAW))
#define MLAO ((bf16*)(wsb + WS_MLAO))
#define SBO ((bf16*)(wsb + WS_SBO))
#define MERGED ((bf16*)(wsb + WS_MERGED))
#define TAB ((f32x2*)(wsb + WS_TAB))

    { PHASE_PTRS(); (void)OUT;
    for (int i = gthread; i < SEQ * 32; i += nthreads) {
        const int pos = i >> 5, k = i & 31;
        const float inv_freq = exp2f(-(float)k * (13.287712379549449f / 32.f));
        float s, c; sincos_acc((float)pos * inv_freq, s, c); TAB[i] = (f32x2){c, s};
    } }

#pragma unroll 1
    for (int l = 0; l < 2; ++l) {
        if constexpr ((PHMASK >> 0) & 1) {
            PHASE_PTRS(); (void)OUT;
            const float* w_in = args.in[7] + (size_t)l * DM * 7744; const float* w_qb = args.in[9] + (size_t)l * QLORA * 3072;
            const float* w_kvb = args.in[11] + (size_t)l * KVLORA * 4096; const float* w_o = args.in[18] + (size_t)l * DM * DM;
            const float* w_up = args.in[20] + (size_t)l * DM * DFF; const float* w_dn = args.in[21] + (size_t)l * DFF * DM;
            LAS float* scr = (LAS float*)(F.lds + RING_OFF + WAVE * 16384);
            constexpr int I_IN = 64 * 242, I_QB = 16 * 96, I_KVB = 8 * 128, I_O = 64 * 128, I_UP = 64 * 512, I_DN = 256 * 128;
            constexpr int NITEMS = I_IN + I_QB + I_KVB + I_O + I_UP + I_DN;
            for (int it = gw; it < NITEMS; it += NGW) {
                int r = it;
                if (r < I_IN) { const int kb = r / 242, nb = r % 242, n0 = nb * 32; transpose_item(w_in, DM, 7744, WIN_T, kb * 64, n0, n0 + (n0 >= 1600 ? 192 : 0), scr, LANE); continue; } r -= I_IN;
                if (r < I_QB) { const int kb = r / 96, nb = r % 96; transpose_item(w_qb, QLORA, 3072, WQB_T, kb * 64, nb * 32, nb * 32, scr, LANE); continue; } r -= I_QB;
                if (r < I_KVB) { const int kb = r / 128, nb = r % 128, n0 = nb * 32, h = n0 >> 8, dd = n0 & 255;
                    transpose_item(w_kvb, KVLORA, 4096, WKVB_T, kb * 64, n0, dd < 128 ? h * 128 + dd : 2048 + h * 128 + (dd - 128), scr, LANE); continue; } r -= I_KVB;
                if (r < I_O) { const int kb = r / 128, nb = r % 128; transpose_item(w_o, DM, DM, WO_T, kb * 64, nb * 32, nb * 32, scr, LANE); continue; } r -= I_O;
                if (r < I_UP) { const int kb = r / 512, nb = r % 512; transpose_item(w_up, DM, DFF, WUP_T, kb * 64, nb * 32, nb * 32, scr, LANE); continue; } r -= I_UP;
                { const int kb = r / 128, nb = r % 128; transpose_item(w_dn, DFF, DM, WDN_T, kb * 64, nb * 32, nb * 32, scr, LANE); }
            }
            { unsigned zz = 0u; asm volatile("" : "+v"(zz)); const v4u z4 = {zz, zz, zz, zz};
              for (int i = gthread; i < 192 * DM / 8; i += nthreads) *(GAS v4u*)(WIN_T + (size_t)1600 * DM + (size_t)i * 8) = z4; }
            cache_rows_to_bf16(args.in[2] + (size_t)l * 8 * PAST * KVLORA, AKV, KVLORA, gthread, nthreads);
            cache_rows_to_bf16(args.in[3] + (size_t)l * 8 * PAST * ROPE, KROPE, ROPE, gthread, nthreads);
            cache_rows_to_bf16(args.in[4] + (size_t)l * 8 * PAST * 2048, SBK, 2048, gthread, nthreads);
            cache_rows_to_bf16(args.in[5] + (size_t)l * 8 * PAST * 2048, SBV, 2048, gthread, nthreads);
            const float* g = args.in[6] + (size_t)l * DM;
            for (int m = gw; m < MTOK; m += NGW) {
                const float* xr = (l == 0) ? (m < NP ? args.in[0] + (size_t)m * DM : args.in[1] + (size_t)(m - NP) * DM) : OUT + O_Y + (size_t)m * DM;
                rms_row_4096(xr, g, XN + (size_t)m * DM, LANE);
            }
        }
        GRID_BAR();
        if constexpr ((PHMASK >> 1) & 1) {
            PHASE_PTRS(); (void)OUT;
            pg8::Gemm g{XN, WIN_T, MTOK, NINP, DM}; pg8::StaticOrder S; S.init(MTOK, NINP, F.G, (int)blockIdx.x);
            pg8::EpiIn E{LAT, SBQ, SBK, SBV, OUT + O_SBK_P + (size_t)l * NP * 2048, OUT + O_SBV_P + (size_t)l * NP * 2048,
                         OUT + O_SBK_S + (size_t)l * NS * 2048, OUT + O_SBV_S + (size_t)l * NS * 2048, QS_SB};
            pg8::gemm_phase<pg8::EpiIn, pg8::StaticOrder, true, true>(F.lds + RING_OFF, g, S, E);
        }
        GRID_BAR();
        if constexpr ((PHMASK >> 2) & 1) {
            PHASE_PTRS(); (void)OUT;
            const float* g_q_a = args.in[8] + (size_t)l * QLORA; const float* g_kv_a = args.in[10] + (size_t)l * KVLORA; const float* g_k_rope = args.in[15] + (size_t)l * ROPE;
            for (int m = gw; m < MTOK; m += NGW) {
                const float* lr = LAT + (size_t)m * 1792; const int kvr = kvrow_of(m), pos = pos_of(m);
                {
                    f32x4 v[4]; float s = 0.f;
#pragma unroll
                    for (int j = 0; j < 4; ++j) { v[j] = *(const GAS f32x4*)(lr + 4 * (64 * j + LANE)); s += (v[j].x * v[j].x + v[j].y * v[j].y) + (v[j].z * v[j].z + v[j].w * v[j].w); }
                    const float rstd = 1.0f / sqrtf(wave_sum(s) * (1.f / 1024.f) + EPS);
#pragma unroll
                    for (int j = 0; j < 4; ++j) { const f32x4 gg = *(const GAS f32x4*)(g_q_a + 4 * (64 * j + LANE));
                        *(GAS unsigned long long*)(QLAT + (size_t)m * QLORA + 4 * (64 * j + LANE)) =
                            (unsigned long long)pkbf(v[j].x * rstd * gg.x, v[j].y * rstd * gg.y) | ((unsigned long long)pkbf(v[j].z * rstd * gg.z, v[j].w * rstd * gg.w) << 32); }
                }
                {
                    f32x4 v[2]; float s = 0.f;
#pragma unroll
                    for (int j = 0; j < 2; ++j) { v[j] = *(const GAS f32x4*)(lr + 1024 + 4 * (64 * j + LANE)); s += (v[j].x * v[j].x + v[j].y * v[j].y) + (v[j].z * v[j].z + v[j].w * v[j].w); }
                    const float rstd = 1.0f / sqrtf(wave_sum(s) * (1.f / 512.f) + EPS);
                    float* oc = (m < NP) ? OUT + O_CKV_P + ((size_t)l * NP + m) * KVLORA : OUT + O_CKV_S + ((size_t)l * NS + (m - NP)) * KVLORA;
#pragma unroll
                    for (int j = 0; j < 2; ++j) { const f32x4 gg = *(const GAS f32x4*)(g_kv_a + 4 * (64 * j + LANE));
                        const f32x4 c = {v[j].x * rstd * gg.x, v[j].y * rstd * gg.y, v[j].z * rstd * gg.z, v[j].w * rstd * gg.w};
                        *(GAS f32x4*)(oc + 4 * (64 * j + LANE)) = c;
                        *(GAS unsigned long long*)(AKV + (size_t)kvr * KVLORA + 4 * (64 * j + LANE)) = (unsigned long long)pkbf(c.x, c.y) | ((unsigned long long)pkbf(c.z, c.w) << 32); }
                }
                {
                    const float x = lr[1536 + LANE];
                    const float rstd = 1.0f / sqrtf(wave_sum(x * x) * (1.f / 64.f) + EPS);
                    const float xn = x * rstd * g_k_rope[LANE]; const float xp = __shfl_xor(xn, 32);
                    const f32x2 cs = TAB[pos * 32 + (LANE & 31)];
                    const float o = (LANE < 32) ? xn * cs.x - xp * cs.y : xp * cs.y + xn * cs.x;
                    float* okr = (m < NP) ? OUT + O_KR_P + ((size_t)l * NP + m) * ROPE : OUT + O_KR_S + ((size_t)l * NS + (m - NP)) * ROPE;
                    okr[LANE] = o;
                    const float on = __shfl_xor(o, 1);
                    if ((LANE & 1) == 0) *(GAS unsigned*)(KROPE + (size_t)kvr * ROPE + LANE) = pkbf(o, on);
                }
            }
        }
        GRID_BAR();
        if constexpr ((PHMASK >> 3) & 1) {
            PHASE_PTRS(); (void)OUT;
            pg8::Gemm g{QLAT, WQB_T, MTOK, 3072, QLORA}; pg8::StaticOrder S; S.init(MTOK, 3072, F.G, (int)blockIdx.x);
            pg8::EpiF32 E{QRAW, 3072};
            pg8::gemm_phase<pg8::EpiF32, pg8::StaticOrder, true, true>(F.lds + RING_OFF, g, S, E);
        }
        if constexpr ((PHMASK >> 11) & 1) {
            PHASE_PTRS(); (void)OUT;
            pg8::Gemm g{AKV, WKVB_T, KVROWS, 4096, KVLORA}; pg8::StaticOrder S; S.init(KVROWS, 4096, F.G, (int)blockIdx.x);
            pg8::EpiKvb E{KNRAW, VB};
            pg8::gemm_phase<pg8::EpiKvb, pg8::StaticOrder, true, true>(F.lds + RING_OFF, g, S, E);
        }
        GRID_BAR();
        if constexpr ((PHMASK >> 4) & 1) {
            PHASE_PTRS(); (void)OUT;
            const float* g_q_nope = args.in[12] + (size_t)l * NOPE; const float* g_q_rope = args.in[13] + (size_t)l * ROPE; const float* g_k_nope = args.in[14] + (size_t)l * NOPE;
            const float gn0 = g_q_nope[2 * LANE], gn1 = g_q_nope[2 * LANE + 1], gr = g_q_rope[LANE];
            const float gk0 = g_k_nope[2 * LANE], gk1 = g_k_nope[2 * LANE + 1];
            for (int m = gw; m < MTOK; m += NGW) {
                const float* qr = QRAW + (size_t)m * 3072; bf16* qo = QB + (size_t)m * 3072; const int pos = pos_of(m);
                const f32x2 cs = TAB[pos * 32 + (LANE & 31)];
#pragma unroll 4
                for (int h = 0; h < NH; ++h) {
                    const f32x2 v = *(const GAS f32x2*)(qr + h * 192 + 2 * LANE); const float x = qr[h * 192 + 128 + LANE];
                    const float rn = 1.0f / sqrtf(wave_sum(v.x * v.x + v.y * v.y) * (1.f / 128.f) + EPS);
                    const float rr = 1.0f / sqrtf(wave_sum(x * x) * (1.f / 64.f) + EPS);
                    *(GAS unsigned*)(qo + h * 192 + 2 * LANE) = pkbf(v.x * rn * gn0 * QS_MLA, v.y * rn * gn1 * QS_MLA);
                    const float xn = x * rr * gr; const float xp = __shfl_xor(xn, 32);
                    const float o = ((LANE < 32) ? xn * cs.x - xp * cs.y : xp * cs.y + xn * cs.x) * QS_MLA;
                    const float on = __shfl_xor(o, 1);
                    if ((LANE & 1) == 0) *(GAS unsigned*)(qo + h * 192 + 128 + LANE) = pkbf(o, on);
                }
            }
            for (int r = gw; r < KVROWS; r += NGW) {
                const float* kr = KNRAW + (size_t)r * 2048; bf16* ko = KN + (size_t)r * 2048;
#pragma unroll 4
                for (int h = 0; h < NH; ++h) {
                    const f32x2 v = *(const GAS f32x2*)(kr + h * 128 + 2 * LANE);
                    const float rn = 1.0f / sqrtf(wave_sum(v.x * v.x + v.y * v.y) * (1.f / 128.f) + EPS);
                    *(GAS unsigned*)(ko + h * 128 + 2 * LANE) = pkbf(v.x * rn * gk0, v.y * rn * gk1);
                }
            }
        }
        GRID_BAR();
        if constexpr ((PHMASK >> 5) & 1) {
            PHASE_PTRS(); (void)OUT;
            const int v = F.vcu, bh = v >> 2, b = bh >> 4, h = bh & 15, s = v & 3;
            ALAS char* al = (ALAS char*)(F.lds + RING_OFF);
#pragma unroll 1
            for (int k = 0; k < 5; ++k) {
                att::Unit u;
                if (k < 4) { const int qb = (k == 0) ? s : (k == 1) ? 7 - s : (k == 2) ? 8 + s : 15 - s; const size_t m0 = (size_t)b * SEQ + (size_t)qb * 256, kv0 = (size_t)b * SEQ;
                    u.Q = QB + m0 * 3072 + h * 192; u.ldq = 3072; u.K = KN + kv0 * 2048 + h * 128; u.Kr = KROPE + kv0 * ROPE; u.V = VB + kv0 * 2048 + h * 128;
                    u.O = MLAO + m0 * 2048 + h * 128; u.P0 = qb * 256; u.NT = 4 * qb + 4; u.nact = 8; }
                else { if (v >= 128) break; const int sb = v >> 4, sh = v & 15; const size_t m0 = (size_t)NP + (size_t)sb * 64, kv0 = (size_t)NP + (size_t)sb * SKVS;
                    u.Q = QB + m0 * 3072 + sh * 192; u.ldq = 3072; u.K = KN + kv0 * 2048 + sh * 128; u.Kr = KROPE + kv0 * ROPE; u.V = VB + kv0 * 2048 + sh * 128;
                    u.O = MLAO + m0 * 2048 + sh * 128; u.P0 = PAST; u.NT = 17; u.nact = 2; }
                if constexpr ((PHMASK >> 12) & 1) att::attn_unit<true>(u, al);
            }
#pragma unroll 1
            for (int k = 0; k < 5; ++k) {
                att::Unit u;
                if (k < 4) { const int qb = (k == 0) ? s : (k == 1) ? 7 - s : (k == 2) ? 8 + s : 15 - s; const size_t m0 = (size_t)b * SEQ + (size_t)qb * 256, kv0 = (size_t)b * SEQ;
                    u.Q = SBQ + m0 * 2048 + h * 128; u.ldq = 2048; u.K = SBK + kv0 * 2048 + h * 128; u.Kr = nullptr; u.V = SBV + kv0 * 2048 + h * 128;
                    u.O = SBO + m0 * 2048 + h * 128; u.P0 = qb * 256; u.NT = 4 * qb + 4; u.nact = 8; }
                else { if (v < 128) break; const int w = v - 128, sb = w >> 4, sh = w & 15; const size_t m0 = (size_t)NP + (size_t)sb * 64, kv0 = (size_t)NP + (size_t)sb * SKVS;
                    u.Q = SBQ + m0 * 2048 + sh * 128; u.ldq = 2048; u.K = SBK + kv0 * 2048 + sh * 128; u.Kr = nullptr; u.V = SBV + kv0 * 2048 + sh * 128;
                    u.O = SBO + m0 * 2048 + sh * 128; u.P0 = PAST; u.NT = 17; u.nact = 2; }
                if constexpr ((PHMASK >> 13) & 1) att::attn_unit<false>(u, al);
            }
        }
        GRID_BAR();
        if constexpr ((PHMASK >> 6) & 1) {
            PHASE_PTRS(); (void)OUT;
            const float* g_m = args.in[16] + (size_t)l * 2048; const float* g_s = args.in[17] + (size_t)l * 2048;
            for (int m = gw; m < MTOK; m += NGW) {
#pragma unroll
                for (int half = 0; half < 2; ++half) {
                    const bf16* src = (half ? SBO : MLAO) + (size_t)m * 2048; const float* gg = half ? g_s : g_m;
                    v4u raw[4]; float x[32]; float s = 0.f;
#pragma unroll
                    for (int j = 0; j < 4; ++j) raw[j] = *(const GAS v4u*)(src + 8 * (64 * j + LANE));
#pragma unroll
                    for (int j = 0; j < 4; ++j) { const unsigned w[4] = {raw[j].x, raw[j].y, raw[j].z, raw[j].w};
#pragma unroll
                        for (int e = 0; e < 4; ++e) { x[8 * j + 2 * e] = __uint_as_float(w[e] << 16); x[8 * j + 2 * e + 1] = __uint_as_float(w[e] & 0xffff0000u); } }
#pragma unroll
                    for (int i = 0; i < 32; ++i) s += x[i] * x[i];
                    const float rstd = 1.0f / sqrtf(wave_sum(s) * (1.f / 2048.f) + EPS);
#pragma unroll
                    for (int j = 0; j < 4; ++j) { const f32x4 g0 = *(const GAS f32x4*)(gg + 8 * (64 * j + LANE)), g1 = *(const GAS f32x4*)(gg + 8 * (64 * j + LANE) + 4);
                        v4u o; o.x = pkbf(x[8 * j] * rstd * g0.x, x[8 * j + 1] * rstd * g0.y); o.y = pkbf(x[8 * j + 2] * rstd * g0.z, x[8 * j + 3] * rstd * g0.w);
                        o.z = pkbf(x[8 * j + 4] * rstd * g1.x, x[8 * j + 5] * rstd * g1.y); o.w = pkbf(x[8 * j + 6] * rstd * g1.z, x[8 * j + 7] * rstd * g1.w);
                        *(GAS v4u*)(MERGED + (size_t)m * DM + half * 2048 + 8 * (64 * j + LANE)) = o; }
                }
            }
        }
        GRID_BAR();
        if constexpr ((PHMASK >> 7) & 1) {
            PHASE_PTRS(); (void)OUT;
            pg8::Gemm g{MERGED, WO_T, MTOK, DM, DM}; pg8::StaticOrder S; S.init(MTOK, DM, F.G, (int)blockIdx.x);
            pg8::EpiRes E{l == 0 ? args.in[0] : OUT + O_Y, l == 0 ? args.in[1] : OUT + O_Y + (size_t)NP * DM, OUT + O_Y};
            pg8::gemm_phase<pg8::EpiRes, pg8::StaticOrder, true, true>(F.lds + RING_OFF, g, S, E);
        }
        GRID_BAR();
        if constexpr ((PHMASK >> 8) & 1) {
            PHASE_PTRS(); (void)OUT;
            const float* g = args.in[19] + (size_t)l * DM;
            for (int m = gw; m < MTOK; m += NGW) rms_row_4096(OUT + O_Y + (size_t)m * DM, g, XN + (size_t)m * DM, LANE);
        }
        GRID_BAR();
        if constexpr ((PHMASK >> 9) & 1) {
            PHASE_PTRS(); (void)OUT;
            pg8::Gemm g{XN, WUP_T, MTOK, DFF, DM}; pg8::StaticOrder S; S.init(MTOK, DFF, F.G, (int)blockIdx.x);
            pg8::EpiRelu2 E{UB, DFF};
            pg8::gemm_phase<pg8::EpiRelu2, pg8::StaticOrder, true, true>(F.lds + RING_OFF, g, S, E);
        }
        GRID_BAR();
        if constexpr ((PHMASK >> 10) & 1) {
            PHASE_PTRS(); (void)OUT;
            pg8::Gemm g{UB, WDN_T, MTOK, DM, DFF}; pg8::StaticOrder S; S.init(MTOK, DM, F.G, (int)blockIdx.x);
            pg8::EpiRes E{OUT + O_Y, OUT + O_Y + (size_t)NP * DM, OUT + O_Y};
            pg8::gemm_phase<pg8::EpiRes, pg8::StaticOrder, true, true>(F.lds + RING_OFF, g, S, E);
        }
        GRID_BAR();
    }
#undef GRID_BAR
}

extern "C" void kernel_launch(void* const* d_in, const int* in_sizes, int n_in, void* d_out, int out_size, void* d_ws, size_t ws_size, hipStream_t stream) {
    static int grid = 0;
    if (grid == 0) {
        if (n_in != 22 || (size_t)out_size != O_END || ws_size < WS_END) { fprintf(stderr, "kernel_launch: unexpected shapes: n_in %d out %d ws %zu (need %zu)\n", n_in, out_size, ws_size, (size_t)WS_END); grid = -1; return; }
        int dev = 0, cus = 0, per_cu = 0;
        if (hipGetDevice(&dev) != hipSuccess || hipDeviceGetAttribute(&cus, hipDeviceAttributeMultiprocessorCount, dev) != hipSuccess) { grid = -1; return; }
        if (hipFuncSetAttribute((const void*)hymba_fwd, hipFuncAttributeMaxDynamicSharedMemorySize, LDS_BYTES) != hipSuccess) { fprintf(stderr, "kernel_launch: hipFuncSetAttribute failed\n"); grid = -1; return; }
        if (hipOccupancyMaxActiveBlocksPerMultiprocessor(&per_cu, (const void*)hymba_fwd, NWAVES * 64, LDS_BYTES) != hipSuccess || per_cu < 1) { fprintf(stderr, "kernel_launch: occupancy query reports %d\n", per_cu); }
        (void)hipGetLastError();
        grid = cus;
        if (grid != 256) fprintf(stderr, "kernel_launch: %d CUs (the attention deal assumes 256 workgroups)\n", grid);
    }
    if (grid < 0) return;
    if (hipMemsetAsync((char*)d_ws + WS_CTL, 0, CTL_ZERO_BYTES, stream) != hipSuccess) return;
    Args a{};
    for (int i = 0; i < 22; ++i) a.in[i] = (const float*)d_in[i];
    a.out = (float*)d_out; a.ws = (unsigned char*)d_ws;
    hipLaunchKernelGGL(hymba_fwd, dim3(grid), dim3(NWAVES * 64), LDS_BYTES, stream, a);
}
```

```cpp
#include <hip/hip_runtime.h>
#include <cstdio>
#include <cstdint>
#include <type_traits>
namespace pg8 {
#define PG8_LAS __attribute__((address_space(3)))
typedef unsigned short bf16_t;
typedef short bf16x8 __attribute__((ext_vector_type(8)));
typedef float f32x4 __attribute__((ext_vector_type(4)));
typedef unsigned u32x4 __attribute__((ext_vector_type(4)));
constexpr int BM = 256, BK = 64, HALF = 128, HTB = HALF * BK * 2  , STAGE_BYTES = 8 * HTB, NXCD = 8, WGM = 8;

__host__ __device__ __forceinline__ int lds_byte(int r, int c) { const int st = (r >> 4) * 2 + (c >> 5), rr = r & 15, cc = c & 31, ob = rr * 64 + cc * 2; return st * 1024 + (ob ^ (((ob >> 9) & 1) << 5)); }
__host__ __device__ __forceinline__ void stage_rc(int b, int& R, int& C) { const int st = b / 1024, sb = b % 1024, swz = sb ^ (((sb >> 9) & 1) << 5); R = (st >> 1) * 16 + swz / 64; C = (st & 1) * 32 + (swz % 64) / 2; }
__host__ __device__ __forceinline__ int perm32(int rho) { const int n = rho >> 4, i = rho & 15; return 8 * (i >> 2) + 4 * n + (i & 3); }

struct Unit { int pm, pn, kt0, nkt, part; };
struct Gemm { const bf16_t* A; const bf16_t* Bt; int M, N, K; float* slab; };

struct StaticOrder {
    int nM, nN, nwg, G, c;
    __host__ __device__ __forceinline__ void init(int M, int N, int G_, int c_) { nM = M / BM; nN = N / BM; nwg = nM * nN; G = G_; c = c_; }
    __host__ __device__ __forceinline__ bool next(int i, Unit& u) const {
        const long L = (long)i * G + c; if (L >= nwg) return false;
        int wgid = (int)L; { const int q = nwg / NXCD, r = nwg % NXCD, xcd = wgid % NXCD, off = wgid / NXCD; wgid = (xcd < r ? xcd * (q + 1) : r * (q + 1) + (xcd - r) * q) + off; }
        const int nig = WGM * nN, gid = wgid / nig, fm = gid * WGM, gsz = (nM - fm) < WGM ? (nM - fm) : WGM;
        u.pm = fm + ((wgid % nig) % gsz); u.pn = (wgid % nig) / gsz; u.kt0 = 0; u.nkt = 0; u.part = -1; return true;
    }
    __host__ __device__ __forceinline__ void map(int L, Unit& u) const {
        int wgid = L; { const int q = nwg / NXCD, r = nwg % NXCD, xcd = wgid % NXCD, off = wgid / NXCD; wgid = (xcd < r ? xcd * (q + 1) : r * (q + 1) + (xcd - r) * q) + off; }
        const int nig = WGM * nN, gid = wgid / nig, fm = gid * WGM, gsz = (nM - fm) < WGM ? (nM - fm) : WGM;
        u.pm = fm + ((wgid % nig) % gsz); u.pn = (wgid % nig) / gsz; u.kt0 = 0; u.nkt = 0; u.part = -1;
    }
    __device__ __forceinline__ void a_ready(const Unit&) const {}
    __device__ __forceinline__ void done(const Unit&) const {}
};

template <class S_> struct SubRange {
    const S_& s; int lo, hi;
    __device__ __forceinline__ bool next(int i, Unit& u) const { return (lo + i < hi) && s.next(lo + i, u); }
    __device__ __forceinline__ void a_ready(const Unit& u) const { s.a_ready(u); }
    __device__ __forceinline__ void done(const Unit& u) const { s.done(u); }
};

__device__ __forceinline__ unsigned cvt_pk_bf16(float lo, float hi) { unsigned r; asm volatile("v_cvt_pk_bf16_f32 %0, %1, %2" : "=v"(r) : "v"(lo), "v"(hi)); return r; }

struct TailSplitOrder : StaticOrder {
    int nfull, nsplit, nkt_full, halves; float* slab;
    __host__ __device__ __forceinline__ void init2(int M, int N, int K, int G_, int c_, float* slab_, int halves_ = 1) { init(M, N, G_, c_); nkt_full = K / BK; slab = slab_; halves = halves_; nfull = nwg / G; const int rem = nwg - nfull * G;
        nsplit = (rem > 0 && G % rem == 0 && (nkt_full % (2 * (G / rem))) == 0 && nkt_full / (G / rem) >= 4) ? G / rem : 1; }
    __host__ __device__ __forceinline__ bool next(int i, Unit& u) const {
        const int ii = i / halves, hh = i % halves;
        if (ii < nfull || nsplit == 1) { if (!StaticOrder::next(ii, u)) return false; if (halves == 2) { u.nkt = nkt_full / 2; u.kt0 = hh * u.nkt; u.part = hh == 0 ? -2 : -1; } return true; }
        if (ii > nfull || hh != 0) return false;
        const int j = c / nsplit, s = c % nsplit; map(nfull * G + j, u); u.nkt = nkt_full / nsplit; u.kt0 = s * u.nkt; u.part = j * nsplit + s; return true;
    }
};
typedef unsigned u32x2 __attribute__((ext_vector_type(2)));
constexpr int HY_NP = 16384;
__device__ __forceinline__ int hy_kvrow(int m) { return m < HY_NP ? m : HY_NP + ((m - HY_NP) >> 6) * 1088 + 1024 + ((m - HY_NP) & 63); }

struct EpiIn {
    static constexpr bool PERM = true, AFTER_DRAIN = false;
    float* LAT; bf16_t* SBQ; bf16_t* SBK; bf16_t* SBV; float* outK_p; float* outV_p; float* outK_s; float* outV_s; float qscale;
    const float* ssq; float eps;
    __device__ __forceinline__ void operator()(const f32x4 (&acc)[2][2][4][2], const Unit& u, int wr, int wc, int fr, int fq) const {
        const int row0 = u.pm * BM + wr * 64 + fr, colw = wc * 32 + 8 * fq, pn = u.pn;
        float rs[2][4];
#pragma unroll
        for (int ai = 0; ai < 2; ++ai)
#pragma unroll
            for (int m = 0; m < 4; ++m) rs[ai][m] = ssq ? 1.0f / sqrtf(__hip_atomic_load(ssq + row0 + ai * HALF + m * 16, __ATOMIC_RELAXED, __HIP_MEMORY_SCOPE_AGENT) * (1.f / 4096.f) + eps) : 1.0f;
        if (pn < 7) {
#pragma unroll
            for (int ai = 0; ai < 2; ++ai)
#pragma unroll
                for (int m = 0; m < 4; ++m) { float* rp = LAT + (size_t)(row0 + ai * HALF + m * 16) * 1792 + pn * BM + colw;
#pragma unroll
                    for (int bj = 0; bj < 2; ++bj) { *(f32x4*)(rp + bj * HALF) = acc[ai][bj][m][0] * rs[ai][m]; *(f32x4*)(rp + bj * HALF + 4) = acc[ai][bj][m][1] * rs[ai][m]; } }
        } else if (pn < 15) {
#pragma unroll
            for (int ai = 0; ai < 2; ++ai)
#pragma unroll
                for (int m = 0; m < 4; ++m) { bf16_t* rp = SBQ + (size_t)(row0 + ai * HALF + m * 16) * 2048 + (pn - 7) * BM + colw;
#pragma unroll
                    for (int bj = 0; bj < 2; ++bj) { const float sc = qscale * rs[ai][m]; const f32x4 v0 = acc[ai][bj][m][0] * sc, v1 = acc[ai][bj][m][1] * sc;
                        u32x4 w; w.x = cvt_pk_bf16(v0[0], v0[1]); w.y = cvt_pk_bf16(v0[2], v0[3]); w.z = cvt_pk_bf16(v1[0], v1[1]); w.w = cvt_pk_bf16(v1[2], v1[3]);
                        *(u32x4*)(rp + bj * HALF) = w; } }
        } else {
            const bool isv = pn >= 23; const int c0 = (pn - (isv ? 23 : 15)) * BM + colw;
            float* fop = isv ? outV_p : outK_p; float* fos = isv ? outV_s : outK_s;
#pragma unroll
            for (int ai = 0; ai < 2; ++ai)
#pragma unroll
                for (int m = 0; m < 4; ++m) { const int row = row0 + ai * HALF + m * 16;
                    float* fo = (row < HY_NP) ? fop + (size_t)row * 2048 : fos + (size_t)(row - HY_NP) * 2048;
                    fo += c0;
#pragma unroll
                    for (int bj = 0; bj < 2; ++bj) { __builtin_nontemporal_store(acc[ai][bj][m][0] * rs[ai][m], (f32x4*)(fo + bj * HALF)); __builtin_nontemporal_store(acc[ai][bj][m][1] * rs[ai][m], (f32x4*)(fo + bj * HALF + 4)); } }
        }
    }
};
struct EpiF32 {
    static constexpr bool PERM = false, AFTER_DRAIN = false;
    float* C; int ldc;
    __device__ __forceinline__ void operator()(const f32x4 (&acc)[2][2][4][2], const Unit& u, int wr, int wc, int fr, int fq) const {
        const int row0 = u.pm * BM + wr * 64 + fr, col0 = u.pn * BM + wc * 32 + 4 * fq;
#pragma unroll
        for (int ai = 0; ai < 2; ++ai)
#pragma unroll
            for (int m = 0; m < 4; ++m) { float* rowp = C + (size_t)(row0 + ai * HALF + m * 16) * ldc + col0;
#pragma unroll
                for (int bj = 0; bj < 2; ++bj)
#pragma unroll
                    for (int n = 0; n < 2; ++n) *(f32x4*)(rowp + bj * HALF + n * 16) = acc[ai][bj][m][n]; }
    }
};
struct EpiKvb {
    static constexpr bool PERM = true, AFTER_DRAIN = false;
    float* KNRAW; bf16_t* VB;
    __device__ __forceinline__ void operator()(const f32x4 (&acc)[2][2][4][2], const Unit& u, int wr, int wc, int fr, int fq) const {
        const int row0 = u.pm * BM + wr * 64 + fr, colw = wc * 32 + 8 * fq, pn = u.pn;
        if (pn < 8) {
#pragma unroll
            for (int ai = 0; ai < 2; ++ai)
#pragma unroll
                for (int m = 0; m < 4; ++m) { float* rp = KNRAW + (size_t)(row0 + ai * HALF + m * 16) * 2048 + pn * BM + colw;
#pragma unroll
                    for (int bj = 0; bj < 2; ++bj) { *(f32x4*)(rp + bj * HALF) = acc[ai][bj][m][0]; *(f32x4*)(rp + bj * HALF + 4) = acc[ai][bj][m][1]; } }
        } else {
#pragma unroll
            for (int ai = 0; ai < 2; ++ai)
#pragma unroll
                for (int m = 0; m < 4; ++m) { bf16_t* rp = VB + (size_t)(row0 + ai * HALF + m * 16) * 2048 + (pn - 8) * BM + colw;
#pragma unroll
                    for (int bj = 0; bj < 2; ++bj) { const f32x4 v0 = acc[ai][bj][m][0], v1 = acc[ai][bj][m][1];
                        u32x4 w; w.x = cvt_pk_bf16(v0[0], v0[1]); w.y = cvt_pk_bf16(v0[2], v0[3]); w.z = cvt_pk_bf16(v1[0], v1[1]); w.w = cvt_pk_bf16(v1[2], v1[3]);
                        *(u32x4*)(rp + bj * HALF) = w; } }
        }
    }
};
struct EpiRes {
    static constexpr bool PERM = false, AFTER_DRAIN = false;
    const float* resP; const float* resS; float* out;
    __device__ __forceinline__ void operator()(const f32x4 (&acc)[2][2][4][2], const Unit& u, int wr, int wc, int fr, int fq) const {
        const int row0 = u.pm * BM + wr * 64 + fr, col0 = u.pn * BM + wc * 32 + 4 * fq;
        const bool samp = u.pm >= HY_NP / BM;
#pragma unroll
        for (int ai = 0; ai < 2; ++ai)
#pragma unroll
            for (int m = 0; m < 4; ++m) { const int row = row0 + ai * HALF + m * 16;
                const float* rp = samp ? resS + (size_t)(row - HY_NP) * 4096 + col0 : resP + (size_t)row * 4096 + col0;
                float* op = out + (size_t)row * 4096 + col0;
#pragma unroll
                for (int bj = 0; bj < 2; ++bj)
#pragma unroll
                    for (int n = 0; n < 2; ++n) { const f32x4 r = *(const f32x4*)(rp + bj * HALF + n * 16); *(f32x4*)(op + bj * HALF + n * 16) = r + acc[ai][bj][m][n]; } }
    }
};
struct EpiRelu2 {
    static constexpr bool PERM = true, AFTER_DRAIN = false;
    bf16_t* O; int ldc;
    __device__ __forceinline__ void operator()(const f32x4 (&acc)[2][2][4][2], const Unit& u, int wr, int wc, int fr, int fq) const {
        const int row0 = u.pm * BM + wr * 64 + fr, col0 = u.pn * BM + wc * 32 + 8 * fq;
#pragma unroll
        for (int ai = 0; ai < 2; ++ai)
#pragma unroll
            for (int m = 0; m < 4; ++m) { bf16_t* rowp = O + (size_t)(row0 + ai * HALF + m * 16) * ldc + col0;
#pragma unroll
                for (int bj = 0; bj < 2; ++bj) { f32x4 v0 = acc[ai][bj][m][0], v1 = acc[ai][bj][m][1];
#pragma unroll
                    for (int e = 0; e < 4; ++e) { const float a = fmaxf(v0[e], 0.f), b = fmaxf(v1[e], 0.f); v0[e] = a * a; v1[e] = b * b; }
                    u32x4 w; w.x = cvt_pk_bf16(v0[0], v0[1]); w.y = cvt_pk_bf16(v0[2], v0[3]); w.z = cvt_pk_bf16(v1[0], v1[1]); w.w = cvt_pk_bf16(v1[2], v1[3]);
                    *(u32x4*)(rowp + bj * HALF) = w; } }
    }
};

typedef float f32x2e __attribute__((ext_vector_type(2)));
__device__ __forceinline__ void head_ssq_exchange(const f32x4 (&acc)[2][2][4][2], PG8_LAS float* P, int wr, int wc, int fr, int fq, float (&rstd)[2][4][2], float inv_n, float eps) {
#pragma unroll
    for (int ai = 0; ai < 2; ++ai)
#pragma unroll
        for (int m = 0; m < 4; ++m)
#pragma unroll
            for (int bj = 0; bj < 2; ++bj) {
                const f32x4 a = acc[ai][bj][m][0], b = acc[ai][bj][m][1];
                float s = ((a[0] * a[0] + a[1] * a[1]) + (a[2] * a[2] + a[3] * a[3])) + ((b[0] * b[0] + b[1] * b[1]) + (b[2] * b[2] + b[3] * b[3]));
                s += __shfl_xor(s, 16); s += __shfl_xor(s, 32);
                if (fq == 0) P[(ai * HALF + wr * 64 + m * 16 + fr) * 8 + bj * 4 + wc] = s;
            }
    asm volatile("s_waitcnt lgkmcnt(0)" ::: "memory"); __builtin_amdgcn_s_barrier(); asm volatile("" ::: "memory");
#pragma unroll
    for (int ai = 0; ai < 2; ++ai)
#pragma unroll
        for (int m = 0; m < 4; ++m)
#pragma unroll
            for (int bj = 0; bj < 2; ++bj) {
                const f32x4 p = *(const PG8_LAS f32x4*)(P + (ai * HALF + wr * 64 + m * 16 + fr) * 8 + bj * 4);
                rstd[ai][m][bj] = 1.0f / sqrtf(((p[0] + p[1]) + (p[2] + p[3])) * inv_n + eps);
            }
}
struct EpiQb {
    static constexpr bool PERM = true, AFTER_DRAIN = false;
    bf16_t* QB; const float* g_nope; const float* g_rope; const f32x2e* tab; PG8_LAS float* P; float qs, eps;
    __device__ __forceinline__ void operator()(const f32x4 (&acc)[2][2][4][2], const Unit& u, int wr, int wc, int fr, int fq) const {
        const int row0 = u.pm * BM + wr * 64 + fr, pn = u.pn;
        if (pn < 8) {
            float rstd[2][4][2]; head_ssq_exchange(acc, P, wr, wc, fr, fq, rstd, 1.f / 128.f, eps);
            const f32x4 g0 = *(const f32x4*)(g_nope + wc * 32 + 8 * fq) * qs, g1 = *(const f32x4*)(g_nope + wc * 32 + 8 * fq + 4) * qs;
#pragma unroll
            for (int ai = 0; ai < 2; ++ai)
#pragma unroll
                for (int m = 0; m < 4; ++m) { bf16_t* rp = QB + (size_t)(row0 + ai * HALF + m * 16) * 3072 + (2 * pn) * 192 + wc * 32 + 8 * fq;
#pragma unroll
                    for (int bj = 0; bj < 2; ++bj) { const float r = rstd[ai][m][bj]; const f32x4 v0 = acc[ai][bj][m][0] * g0 * r, v1 = acc[ai][bj][m][1] * g1 * r;
                        u32x4 w; w.x = cvt_pk_bf16(v0[0], v0[1]); w.y = cvt_pk_bf16(v0[2], v0[3]); w.z = cvt_pk_bf16(v1[0], v1[1]); w.w = cvt_pk_bf16(v1[2], v1[3]);
                        *(u32x4*)(rp + bj * 192) = w; } }
        } else {
            const int h = 4 * (pn - 8) + wc;
            const f32x4 ga0 = *(const f32x4*)(g_rope + 8 * fq), ga1 = *(const f32x4*)(g_rope + 8 * fq + 4), gb0 = *(const f32x4*)(g_rope + 32 + 8 * fq), gb1 = *(const f32x4*)(g_rope + 32 + 8 * fq + 4);
#pragma unroll
            for (int ai = 0; ai < 2; ++ai)
#pragma unroll
                for (int m = 0; m < 4; ++m) { const int row = row0 + ai * HALF + m * 16;
                    const f32x4 a0 = acc[ai][0][m][0], a1 = acc[ai][0][m][1], b0 = acc[ai][1][m][0], b1 = acc[ai][1][m][1];
                    float s = (((a0[0] * a0[0] + a0[1] * a0[1]) + (a0[2] * a0[2] + a0[3] * a0[3])) + ((a1[0] * a1[0] + a1[1] * a1[1]) + (a1[2] * a1[2] + a1[3] * a1[3])))
                            + (((b0[0] * b0[0] + b0[1] * b0[1]) + (b0[2] * b0[2] + b0[3] * b0[3])) + ((b1[0] * b1[0] + b1[1] * b1[1]) + (b1[2] * b1[2] + b1[3] * b1[3])));
                    s += __shfl_xor(s, 16); s += __shfl_xor(s, 32);
                    const float r = 1.0f / sqrtf(s * (1.f / 64.f) + eps);
                    const int pos = row < HY_NP ? (row & 4095) : 1024 + ((row - HY_NP) & 63);
                    const f32x4* tp = (const f32x4*)(tab + pos * 32 + 8 * fq);
                    const f32x4 t0 = tp[0], t1 = tp[1], t2 = tp[2], t3 = tp[3];
                    const f32x4 x10 = a0 * ga0 * r, x11 = a1 * ga1 * r, x20 = b0 * gb0 * r, x21 = b1 * gb1 * r;
                    const f32x4 c0 = {t0[0], t0[2], t1[0], t1[2]}, s0 = {t0[1], t0[3], t1[1], t1[3]}, c1 = {t2[0], t2[2], t3[0], t3[2]}, s1 = {t2[1], t2[3], t3[1], t3[3]};
                    const f32x4 o10 = (x10 * c0 - x20 * s0) * qs, o11 = (x11 * c1 - x21 * s1) * qs, o20 = (x10 * s0 + x20 * c0) * qs, o21 = (x11 * s1 + x21 * c1) * qs;
                    bf16_t* rp = QB + (size_t)row * 3072 + h * 192 + 128 + 8 * fq;
                    u32x4 w; w.x = cvt_pk_bf16(o10[0], o10[1]); w.y = cvt_pk_bf16(o10[2], o10[3]); w.z = cvt_pk_bf16(o11[0], o11[1]); w.w = cvt_pk_bf16(o11[2], o11[3]);
                    *(u32x4*)rp = w;
                    w.x = cvt_pk_bf16(o20[0], o20[1]); w.y = cvt_pk_bf16(o20[2], o20[3]); w.z = cvt_pk_bf16(o21[0], o21[1]); w.w = cvt_pk_bf16(o21[2], o21[3]);
                    *(u32x4*)(rp + 32) = w; }
        }
    }
};
struct EpiKvbN {
    static constexpr bool PERM = true, AFTER_DRAIN = false;
    bf16_t* KN; bf16_t* VB; const float* g_nope; PG8_LAS float* P; float eps;
    __device__ __forceinline__ void operator()(const f32x4 (&acc)[2][2][4][2], const Unit& u, int wr, int wc, int fr, int fq) const {
        const int row0 = u.pm * BM + wr * 64 + fr, colw = wc * 32 + 8 * fq, pn = u.pn;
        if (pn < 8) {
            float rstd[2][4][2]; head_ssq_exchange(acc, P, wr, wc, fr, fq, rstd, 1.f / 128.f, eps);
            const f32x4 g0 = *(const f32x4*)(g_nope + colw), g1 = *(const f32x4*)(g_nope + colw + 4);
#pragma unroll
            for (int ai = 0; ai < 2; ++ai)
#pragma unroll
                for (int m = 0; m < 4; ++m) { bf16_t* rp = KN + (size_t)(row0 + ai * HALF + m * 16) * 2048 + pn * BM + colw;
#pragma unroll
                    for (int bj = 0; bj < 2; ++bj) { const float r = rstd[ai][m][bj]; const f32x4 v0 = acc[ai][bj][m][0] * g0 * r, v1 = acc[ai][bj][m][1] * g1 * r;
                        u32x4 w; w.x = cvt_pk_bf16(v0[0], v0[1]); w.y = cvt_pk_bf16(v0[2], v0[3]); w.z = cvt_pk_bf16(v1[0], v1[1]); w.w = cvt_pk_bf16(v1[2], v1[3]);
                        *(u32x4*)(rp + bj * HALF) = w; } }
        } else {
#pragma unroll
            for (int ai = 0; ai < 2; ++ai)
#pragma unroll
                for (int m = 0; m < 4; ++m) { bf16_t* rp = VB + (size_t)(row0 + ai * HALF + m * 16) * 2048 + (pn - 8) * BM + colw;
#pragma unroll
                    for (int bj = 0; bj < 2; ++bj) { const f32x4 v0 = acc[ai][bj][m][0], v1 = acc[ai][bj][m][1];
                        u32x4 w; w.x = cvt_pk_bf16(v0[0], v0[1]); w.y = cvt_pk_bf16(v0[2], v0[3]); w.z = cvt_pk_bf16(v1[0], v1[1]); w.w = cvt_pk_bf16(v1[2], v1[3]);
                        *(u32x4*)(rp + bj * HALF) = w; } }
        }
    }
};

template <bool NORM> struct EpiResP {
    static constexpr bool PERM = true, AFTER_DRAIN = false, MIDK = NORM;
    const float* resP; const float* resS; float* out; bf16_t* HB; float* ssq; const float* ssqm; const float* ssqs; float eps;
    bf16_t* YB;
    __device__ __forceinline__ void mid(f32x4 (&acc)[2][2][4][2], const Unit& u, int wr, int wc, int fr, int fq) const {
        const int row0 = u.pm * BM + wr * 64 + fr;
#pragma unroll
        for (int ai = 0; ai < 2; ++ai)
#pragma unroll
            for (int m = 0; m < 4; ++m) { const int row = row0 + ai * HALF + m * 16;
                const float a = __hip_atomic_load(ssqm + row, __ATOMIC_RELAXED, __HIP_MEMORY_SCOPE_AGENT), b = __hip_atomic_load(ssqs + row, __ATOMIC_RELAXED, __HIP_MEMORY_SCOPE_AGENT);
                const float ratio = sqrtf((b * (1.f / 2048.f) + eps) / (a * (1.f / 2048.f) + eps));
#pragma unroll
                for (int bj = 0; bj < 2; ++bj) { acc[ai][bj][m][0] *= ratio; acc[ai][bj][m][1] *= ratio; } }
    }
    __device__ __forceinline__ void operator()(const f32x4 (&acc)[2][2][4][2], const Unit& u, int wr, int wc, int fr, int fq) const {
        const int row0 = u.pm * BM + wr * 64 + fr, col0 = u.pn * BM + wc * 32 + 8 * fq;
        const bool samp = u.pm >= HY_NP / BM;
#pragma unroll
        for (int ai = 0; ai < 2; ++ai)
#pragma unroll
            for (int m = 0; m < 4; ++m) { const int row = row0 + ai * HALF + m * 16;
                if (NORM) {
                    const float* rp = samp ? resS + (size_t)(row - HY_NP) * 4096 + col0 : resP + (size_t)row * 4096 + col0; float s = 0.f;
                    const bf16_t* yp = YB + (size_t)row * 4096 + col0;
                    const float rs = 1.0f / sqrtf(__hip_atomic_load(ssqs + row, __ATOMIC_RELAXED, __HIP_MEMORY_SCOPE_AGENT) * (1.f / 2048.f) + eps);
#pragma unroll
                    for (int bj = 0; bj < 2; ++bj) { f32x4 r0, r1;
                        if (YB) { const u32x4 h = *(const u32x4*)(yp + bj * HALF);
                            r0 = (f32x4){__uint_as_float(h.x << 16), __uint_as_float(h.x & 0xffff0000u), __uint_as_float(h.y << 16), __uint_as_float(h.y & 0xffff0000u)};
                            r1 = (f32x4){__uint_as_float(h.z << 16), __uint_as_float(h.z & 0xffff0000u), __uint_as_float(h.w << 16), __uint_as_float(h.w & 0xffff0000u)}; }
                        else { r0 = *(const f32x4*)(rp + bj * HALF); r1 = *(const f32x4*)(rp + bj * HALF + 4); }
                        const f32x4 v0 = r0 + acc[ai][bj][m][0] * rs, v1 = r1 + acc[ai][bj][m][1] * rs;
                        s += ((v0[0] * v0[0] + v0[1] * v0[1]) + (v0[2] * v0[2] + v0[3] * v0[3])) + ((v1[0] * v1[0] + v1[1] * v1[1]) + (v1[2] * v1[2] + v1[3] * v1[3]));
                        u32x4 w; w.x = cvt_pk_bf16(v0[0], v0[1]); w.y = cvt_pk_bf16(v0[2], v0[3]); w.z = cvt_pk_bf16(v1[0], v1[1]); w.w = cvt_pk_bf16(v1[2], v1[3]);
                        *(u32x4*)(HB + (size_t)row * 4096 + col0 + bj * HALF) = w; }
                    s += __shfl_xor(s, 16); s += __shfl_xor(s, 32);
                    if (fq == 0) __hip_atomic_fetch_add(ssq + row, s, __ATOMIC_RELAXED, __HIP_MEMORY_SCOPE_AGENT);
                } else {
                    const bf16_t* hp = HB + (size_t)row * 4096 + col0; float* op = out + (size_t)row * 4096 + col0; float s = 0.f;
#pragma unroll
                    for (int bj = 0; bj < 2; ++bj) { const u32x4 h = *(const u32x4*)(hp + bj * HALF);
                        const f32x4 r0 = {__uint_as_float(h.x << 16), __uint_as_float(h.x & 0xffff0000u), __uint_as_float(h.y << 16), __uint_as_float(h.y & 0xffff0000u)};
                        const f32x4 r1 = {__uint_as_float(h.z << 16), __uint_as_float(h.z & 0xffff0000u), __uint_as_float(h.w << 16), __uint_as_float(h.w & 0xffff0000u)};
                        const f32x4 y0 = r0 + acc[ai][bj][m][0], y1 = r1 + acc[ai][bj][m][1];
                        if (YB) { u32x4 w; w.x = cvt_pk_bf16(y0[0], y0[1]); w.y = cvt_pk_bf16(y0[2], y0[3]); w.z = cvt_pk_bf16(y1[0], y1[1]); w.w = cvt_pk_bf16(y1[2], y1[3]);
                                  *(u32x4*)(YB + (size_t)row * 4096 + col0 + bj * HALF) = w;
                                  s += ((y0[0] * y0[0] + y0[1] * y0[1]) + (y0[2] * y0[2] + y0[3] * y0[3])) + ((y1[0] * y1[0] + y1[1] * y1[1]) + (y1[2] * y1[2] + y1[3] * y1[3])); }
                        else { __builtin_nontemporal_store(y0, (f32x4*)(op + bj * HALF)); __builtin_nontemporal_store(y1, (f32x4*)(op + bj * HALF + 4)); } }
                    if (YB) { s += __shfl_xor(s, 16); s += __shfl_xor(s, 32);
                        if (fq == 0) __hip_atomic_fetch_add(ssq + row, s, __ATOMIC_RELAXED, __HIP_MEMORY_SCOPE_AGENT); }
                } }
    }
};
struct EpiRelu2N {
    static constexpr bool PERM = true, AFTER_DRAIN = false;
    bf16_t* O; int ldc; const float* ssq; float eps;
    __device__ __forceinline__ void operator()(const f32x4 (&acc)[2][2][4][2], const Unit& u, int wr, int wc, int fr, int fq) const {
        const int row0 = u.pm * BM + wr * 64 + fr, col0 = u.pn * BM + wc * 32 + 8 * fq;
#pragma unroll
        for (int ai = 0; ai < 2; ++ai)
#pragma unroll
            for (int m = 0; m < 4; ++m) { const int row = row0 + ai * HALF + m * 16; bf16_t* rowp = O + (size_t)row * ldc + col0;
                const float r = 1.0f / sqrtf(__hip_atomic_load(ssq + row, __ATOMIC_RELAXED, __HIP_MEMORY_SCOPE_AGENT) * (1.f / 4096.f) + eps);
#pragma unroll
                for (int bj = 0; bj < 2; ++bj) { f32x4 v0 = acc[ai][bj][m][0], v1 = acc[ai][bj][m][1];
#pragma unroll
                    for (int e = 0; e < 4; ++e) { const float a = fmaxf(v0[e], 0.f) * r, b = fmaxf(v1[e], 0.f) * r; v0[e] = a * a; v1[e] = b * b; }
                    u32x4 w; w.x = cvt_pk_bf16(v0[0], v0[1]); w.y = cvt_pk_bf16(v0[2], v0[3]); w.z = cvt_pk_bf16(v1[0], v1[1]); w.w = cvt_pk_bf16(v1[2], v1[3]);
                    *(u32x4*)(rowp + bj * HALF) = w; } }
    }
};
template <class T, class = void> struct has_midk { static constexpr bool value = false; };
template <class T> struct has_midk<T, typename std::enable_if<T::MIDK>::type> { static constexpr bool value = true; };
template <class Epi, class Sched, bool ALIGN_EPI = false, bool SP2 = false>
__device__ __forceinline__ void gemm_phase(PG8_LAS unsigned char* lds, const Gemm g, const Sched& S, const Epi& E) {
    int tid_o = threadIdx.x; asm volatile("" : "+v"(tid_o));
    const int tid = tid_o, wid = __builtin_amdgcn_readfirstlane(tid >> 6), lane = tid & 63, wr = wid >> 2, wc = wid & 3, fr = lane & 15, fq = lane >> 4;
    const int K = g.K, nt = K / BK;
    unsigned voffA[2], voffB[2];
#pragma unroll
    for (int i = 0; i < 2; ++i) { int R, C; stage_rc(tid * 16 + i * 8192, R, C); const int Rb = Epi::PERM ? ((R & ~31) + perm32(R & 31)) : R;
        voffA[i] = (unsigned)(R * K + C) * 2u; voffB[i] = (unsigned)(Rb * K + C) * 2u; }
    const size_t kstep = (size_t)(BK * 2);
    const size_t hstep = (size_t)HALF * K * 2;
    const size_t tstep = 2 * hstep;
    const unsigned ldsw = (unsigned)wid * 1024u;
    const int aoff = lds_byte(wr * 64 + fr, fq * 8), boff = lds_byte(wc * 32 + fr, fq * 8);
#define PG8_SA(b, h) (((b) * 2 + (h)) * HTB)
#define PG8_SB(b, h) ((4 + (b) * 2 + (h)) * HTB)
#define PG8_STAGE(bufoff, gbase, voff) do { _Pragma("unroll") for (int _i = 0; _i < 2; ++_i) \
        __builtin_amdgcn_global_load_lds((const unsigned*)((const char*)(gbase) + (voff)[_i]), (PG8_LAS unsigned*)(lds + (bufoff) + ldsw + _i * 8192), 16, 0, 0); } while (0)
#define PG8_LDA(dst, b, h) do { _Pragma("unroll") for (int m = 0; m < 4; ++m) _Pragma("unroll") for (int k = 0; k < 2; ++k) dst[m][k] = *(const PG8_LAS bf16x8*)(lds + PG8_SA(b, h) + aoff + m * 2048 + k * 1024); } while (0)
#define PG8_LDB(dst, b, h) do { _Pragma("unroll") for (int n = 0; n < 2; ++n) _Pragma("unroll") for (int k = 0; k < 2; ++k) dst[n][k] = *(const PG8_LAS bf16x8*)(lds + PG8_SB(b, h) + boff + n * 2048 + k * 1024); } while (0)
#define PG8_MMA(ai, bj, At, Bt) do { __builtin_amdgcn_s_setprio(1); _Pragma("unroll") for (int m = 0; m < 4; ++m) _Pragma("unroll") for (int n = 0; n < 2; ++n) _Pragma("unroll") for (int k = 0; k < 2; ++k) \
        acc[ai][bj][m][n] = __builtin_amdgcn_mfma_f32_16x16x32_bf16(Bt[n][k], At[m][k], acc[ai][bj][m][n], 0, 0, 0); __builtin_amdgcn_s_setprio(0); } while (0)
#define PG8_WAIT_V(n) asm volatile("s_waitcnt vmcnt(" #n ")" ::: "memory")
#define PG8_WAIT_L(n) asm volatile("s_waitcnt lgkmcnt(" #n ")" ::: "memory")
#define PG8_BAR __builtin_amdgcn_s_barrier()
#define PG8_SCHED __builtin_amdgcn_sched_barrier(0)
    Unit cur, nxt; int ui = 0;
    if (!S.next(0, cur)) return;
    f32x4 acc[2][2][4][2];
#pragma unroll
    for (int a = 0; a < 2; ++a)
#pragma unroll
        for (int b = 0; b < 2; ++b)
#pragma unroll
            for (int m = 0; m < 4; ++m)
#pragma unroll
                for (int n = 0; n < 2; ++n) acc[a][b][m][n] = (f32x4){0.f, 0.f, 0.f, 0.f};
    bf16x8 At[4][2], B0[2][2], B1[2][2];
    const char* cA = (const char*)g.A + (size_t)cur.pm * tstep + (size_t)cur.kt0 * kstep; const char* cB = (const char*)g.Bt + (size_t)cur.pn * tstep + (size_t)cur.kt0 * kstep;
    int cnt = cur.nkt ? cur.nkt : nt;
    S.a_ready(cur);
    if constexpr (SP2) {
        PG8_STAGE(PG8_SB(0, 0), cB, voffB); PG8_STAGE(PG8_SB(0, 1), cB + hstep, voffB); PG8_STAGE(PG8_SA(0, 0), cA, voffA); PG8_STAGE(PG8_SA(0, 1), cA + hstep, voffA);
        if (wr == 1) PG8_BAR;
        PG8_WAIT_V(2); PG8_BAR;
        PG8_STAGE(PG8_SB(1, 0), cB + kstep, voffB); PG8_STAGE(PG8_SA(1, 0), cA + kstep, voffA); PG8_STAGE(PG8_SB(1, 1), cB + hstep + kstep, voffB);
        PG8_WAIT_V(6); PG8_BAR;
    } else {
        PG8_STAGE(PG8_SB(0, 0), cB, voffB); PG8_STAGE(PG8_SA(0, 0), cA, voffA); PG8_STAGE(PG8_SB(0, 1), cB + hstep, voffB); PG8_STAGE(PG8_SA(0, 1), cA + hstep, voffA);
        if (wr == 1) PG8_BAR;
        PG8_WAIT_V(4); PG8_BAR;
        PG8_STAGE(PG8_SB(1, 0), cB + kstep, voffB); PG8_STAGE(PG8_SA(1, 0), cA + kstep, voffA); PG8_STAGE(PG8_SB(1, 1), cB + hstep + kstep, voffB);
        PG8_WAIT_V(6); PG8_BAR;
    }
    for (;;) {
        const bool has_next = S.next(ui + 1, nxt);
        const char* nA = has_next ? (const char*)g.A + (size_t)nxt.pm * tstep + (size_t)nxt.kt0 * kstep : cA; const char* nB = has_next ? (const char*)g.Bt + (size_t)nxt.pn * tstep + (size_t)nxt.kt0 * kstep : cB;
        for (int t = 0; t < cnt; t += 2) {
            const bool last = (t == cnt - 2);
            const char* a1 = cA + (size_t)(t + 1) * kstep;
            const char* a2 = last ? nA : cA + (size_t)(t + 2) * kstep; const char* b2 = last ? nB : cB + (size_t)(t + 2) * kstep;
            const char* a3 = a2 + kstep; const char* b3 = b2 + kstep;
            if (last && has_next) S.a_ready(nxt);
            if constexpr (SP2) {
            PG8_LDB(B0, 0, 0); PG8_LDB(B1, 0, 1); PG8_SCHED; PG8_LDA(At, 0, 0); PG8_STAGE(PG8_SA(1, 1), a1 + hstep, voffA);
            PG8_WAIT_V(8); PG8_WAIT_L(0); PG8_BAR; PG8_MMA(0, 0, At, B0); PG8_MMA(0, 1, At, B1); PG8_BAR; PG8_SCHED;
            PG8_LDA(At, 0, 1); PG8_STAGE(PG8_SB(0, 0), b2, voffB); PG8_STAGE(PG8_SB(0, 1), b2 + hstep, voffB); PG8_STAGE(PG8_SA(0, 0), a2, voffA);
            PG8_WAIT_V(8); PG8_WAIT_L(0); PG8_BAR; PG8_MMA(1, 0, At, B0); PG8_MMA(1, 1, At, B1); PG8_BAR; PG8_SCHED;
            PG8_LDB(B0, 1, 0); PG8_LDB(B1, 1, 1); PG8_SCHED; PG8_LDA(At, 1, 0); PG8_STAGE(PG8_SA(0, 1), a2 + hstep, voffA);
            PG8_WAIT_V(8); PG8_WAIT_L(0); PG8_BAR; PG8_MMA(0, 0, At, B0); PG8_MMA(0, 1, At, B1); PG8_BAR; PG8_SCHED;
            PG8_LDA(At, 1, 1); PG8_STAGE(PG8_SB(1, 0), b3, voffB); PG8_STAGE(PG8_SB(1, 1), b3 + hstep, voffB); PG8_STAGE(PG8_SA(1, 0), a3, voffA);
            PG8_WAIT_V(8); PG8_WAIT_L(0); PG8_BAR; PG8_MMA(1, 0, At, B0); PG8_MMA(1, 1, At, B1); PG8_BAR; PG8_SCHED;
            } else {
            PG8_LDB(B0, 0, 0); PG8_SCHED; PG8_LDA(At, 0, 0); PG8_STAGE(PG8_SA(1, 1), a1 + hstep, voffA);
            PG8_WAIT_L(8); PG8_BAR; PG8_WAIT_L(0); PG8_MMA(0, 0, At, B0); PG8_BAR; PG8_SCHED;
            PG8_LDB(B1, 0, 1); PG8_STAGE(PG8_SB(0, 0), b2, voffB);
            PG8_BAR; PG8_WAIT_L(0); PG8_MMA(0, 1, At, B1); PG8_BAR;
            PG8_LDA(At, 0, 1); PG8_STAGE(PG8_SA(0, 0), a2, voffA);
            PG8_BAR; PG8_WAIT_L(0); PG8_MMA(1, 0, At, B0); PG8_BAR; PG8_SCHED;
            PG8_STAGE(PG8_SB(0, 1), b2 + hstep, voffB);
            PG8_WAIT_V(6); PG8_BAR; PG8_MMA(1, 1, At, B1); PG8_BAR;
            PG8_LDB(B0, 1, 0); PG8_SCHED; PG8_LDA(At, 1, 0); PG8_STAGE(PG8_SA(0, 1), a2 + hstep, voffA);
            PG8_WAIT_L(8); PG8_BAR; PG8_WAIT_L(0); PG8_MMA(0, 0, At, B0); PG8_BAR; PG8_SCHED;
            PG8_LDB(B1, 1, 1); PG8_STAGE(PG8_SB(1, 0), b3, voffB);
            PG8_BAR; PG8_WAIT_L(0); PG8_MMA(0, 1, At, B1); PG8_BAR;
            PG8_LDA(At, 1, 1); PG8_STAGE(PG8_SA(1, 0), a3, voffA);
            PG8_BAR; PG8_WAIT_L(0); PG8_MMA(1, 0, At, B0); PG8_BAR; PG8_SCHED;
            PG8_STAGE(PG8_SB(1, 1), b3 + hstep, voffB);
            PG8_WAIT_V(6); PG8_BAR; PG8_MMA(1, 1, At, B1); PG8_BAR;
            }
        }
        if constexpr (ALIGN_EPI) { if (wr == 0) PG8_BAR; }
        if constexpr (!Epi::AFTER_DRAIN) {
            if (cur.part == -2) { if constexpr (has_midk<Epi>::value) E.mid(acc, cur, wr, wc, fr, fq); }
            else if (cur.part >= 0) {
                f32x4* sp = (f32x4*)(g.slab + (size_t)cur.part * 65536) + (size_t)wid * 2048 + lane;
#pragma unroll
                for (int a = 0; a < 2; ++a)
#pragma unroll
                    for (int b = 0; b < 2; ++b)
#pragma unroll
                        for (int m = 0; m < 4; ++m)
#pragma unroll
                            for (int n = 0; n < 2; ++n) sp[(((a * 2 + b) * 4 + m) * 2 + n) * 64] = acc[a][b][m][n];
            } else E(acc, cur, wr, wc, fr, fq);
            S.done(cur); }
        if (!has_next) break;
        if (cur.part != -2) {
#pragma unroll
        for (int a = 0; a < 2; ++a)
#pragma unroll
            for (int b = 0; b < 2; ++b)
#pragma unroll
                for (int m = 0; m < 4; ++m)
#pragma unroll
                    for (int n = 0; n < 2; ++n) acc[a][b][m][n] = (f32x4){0.f, 0.f, 0.f, 0.f};
        }
        cur = nxt; cA = nA; cB = nB; ++ui; cnt = cur.nkt ? cur.nkt : nt;
        if constexpr (ALIGN_EPI) { if (wr == 1) PG8_BAR; }
    }
    PG8_WAIT_V(0);
    if constexpr (!ALIGN_EPI) { if (wr == 0) PG8_BAR; }
    PG8_BAR;
    if constexpr (Epi::AFTER_DRAIN) { E.fused(acc, cur, wr, wc, fr, fq, lds, wid, lane); S.done(cur); }
#undef PG8_SA
#undef PG8_SB
#undef PG8_STAGE
#undef PG8_LDA
#undef PG8_LDB
#undef PG8_MMA
#undef PG8_WAIT_V
#undef PG8_WAIT_L
#undef PG8_BAR
#undef PG8_SCHED
}
}
namespace att {
typedef short bf16x8 __attribute__((ext_vector_type(8)));
typedef short s16x4 __attribute__((ext_vector_type(4)));
typedef float f32x16 __attribute__((ext_vector_type(16)));
typedef unsigned u32x4 __attribute__((ext_vector_type(4)));
typedef float f32x4 __attribute__((ext_vector_type(4)));
typedef unsigned short bf16;
#define ALAS __attribute__((address_space(3)))
#ifndef ATT_SSQ_ATOMICS
#define ATT_SSQ_ATOMICS 0
#endif
constexpr int OFF_V = 0, OFF_K = 32768, OFF_R = 65536, OFF_WS = 81920, OFF_FLG = 81920 + 8 * 256, ATT_LDS_BYTES = OFF_FLG + 64;
constexpr float SB_DEAD = -150.f;
#define KSWZ(row, colB) ((row) * 256 + ((colB) ^ (((row) & 15) << 4)))
#define RSWZ(row, colB) ((row) * 128 + ((colB) ^ ((((row) >> 1) & 7) << 4)))
__device__ __forceinline__ int v_st(int k, int c) { const int kk = (k & ~0xC) | ((k & 4) << 1) | ((k & 8) >> 1); return ((kk >> 3) * 4 + (c >> 5)) * 512 + ((kk & 7) * 32 + (c & 31)) * 2; }
__device__ __forceinline__ int v_rd_base(int lane) { return ((lane & 3) << 3) | (((lane >> 2) & 3) << 6) | (((lane >> 4) & 1) << 5) | (((lane >> 5) & 1) << 8); }
__device__ __forceinline__ int crow(int r, int hi) { return (r & 3) + 8 * (r >> 2) + 4 * hi; }
__device__ __forceinline__ unsigned cvtpk(float lo, float hi) { unsigned r; asm volatile("v_cvt_pk_bf16_f32 %0, %1, %2" : "=v"(r) : "v"(lo), "v"(hi)); return r; }

struct Unit { const bf16* Q; int ldq; const bf16* K; const bf16* Kr; const bf16* V; bf16* O; int ldo; float* ssq; int P0; int NT; int nact;
              const float* Kf0; const float* Vf0; const float* Kf1; const float* Vf1; int split; };

__device__ __forceinline__ void qk128(f32x16& p0, f32x16& p1, ALAS const char* Kt, int r32, int hi, const bf16x8* qr) {
#pragma unroll
    for (int d0 = 0; d0 < 8; ++d0) { ALAS const char* a = Kt + KSWZ(r32, (d0 * 16 + hi * 8) * 2);
        const bf16x8 b0 = *(ALAS const bf16x8*)a; const bf16x8 b1 = *(ALAS const bf16x8*)(a + 32 * 256);
        p0 = __builtin_amdgcn_mfma_f32_32x32x16_bf16(b0, qr[d0], p0, 0, 0, 0);
        p1 = __builtin_amdgcn_mfma_f32_32x32x16_bf16(b1, qr[d0], p1, 0, 0, 0); }
}
__device__ __forceinline__ void qk64(f32x16& p0, f32x16& p1, ALAS const char* Kt, int r32, int hi, const bf16x8* qr) {
#pragma unroll
    for (int d0 = 0; d0 < 4; ++d0) { ALAS const char* a = Kt + RSWZ(r32, (d0 * 16 + hi * 8) * 2);
        const bf16x8 b0 = *(ALAS const bf16x8*)a; const bf16x8 b1 = *(ALAS const bf16x8*)(a + 32 * 128);
        p0 = __builtin_amdgcn_mfma_f32_32x32x16_bf16(b0, qr[d0], p0, 0, 0, 0);
        p1 = __builtin_amdgcn_mfma_f32_32x32x16_bf16(b1, qr[d0], p1, 0, 0, 0); }
}
__device__ __forceinline__ void pv_tile(f32x16* o, unsigned vb0, bf16x8 pa0, bf16x8 pa1, bf16x8 pa2, bf16x8 pa3) {
#define TRRD(dst, off) asm volatile("ds_read_b64_tr_b16 %0, %1 offset:%2" : "=&v"(dst) : "v"(vb0), "i"(off) : "memory")
#define PV_LD(S, d0) do { constexpr int b_ = (d0) * 512; \
        TRRD(S##l0, b_); TRRD(S##h0, b_ + 2048); TRRD(S##l1, b_ + 4096); TRRD(S##h1, b_ + 6144); TRRD(S##l2, b_ + 8192); TRRD(S##h2, b_ + 10240); TRRD(S##l3, b_ + 12288); TRRD(S##h3, b_ + 14336); } while (0)
#define PV_MM(S, d0) do { \
        o[d0] = __builtin_amdgcn_mfma_f32_32x32x16_bf16(pa0, (bf16x8){S##l0[0], S##l0[1], S##l0[2], S##l0[3], S##h0[0], S##h0[1], S##h0[2], S##h0[3]}, o[d0], 0, 0, 0); \
        o[d0] = __builtin_amdgcn_mfma_f32_32x32x16_bf16(pa1, (bf16x8){S##l1[0], S##l1[1], S##l1[2], S##l1[3], S##h1[0], S##h1[1], S##h1[2], S##h1[3]}, o[d0], 0, 0, 0); \
        o[d0] = __builtin_amdgcn_mfma_f32_32x32x16_bf16(pa2, (bf16x8){S##l2[0], S##l2[1], S##l2[2], S##l2[3], S##h2[0], S##h2[1], S##h2[2], S##h2[3]}, o[d0], 0, 0, 0); \
        o[d0] = __builtin_amdgcn_mfma_f32_32x32x16_bf16(pa3, (bf16x8){S##l3[0], S##l3[1], S##l3[2], S##l3[3], S##h3[0], S##h3[1], S##h3[2], S##h3[3]}, o[d0], 0, 0, 0); } while (0)
#define PV_WAIT(n) do { asm volatile("s_waitcnt lgkmcnt(" #n ")" ::: "memory"); __builtin_amdgcn_sched_barrier(0); } while (0)
    s16x4 Al0, Al1, Al2, Al3, Ah0, Ah1, Ah2, Ah3, Bl0, Bl1, Bl2, Bl3, Bh0, Bh1, Bh2, Bh3;
    PV_LD(A, 0); PV_LD(B, 1); PV_WAIT(8); PV_MM(A, 0);
    __builtin_amdgcn_sched_barrier(0); PV_LD(A, 2); PV_WAIT(8); PV_MM(B, 1);
    __builtin_amdgcn_sched_barrier(0); PV_LD(B, 3); PV_WAIT(8); PV_MM(A, 2);
    PV_WAIT(0); PV_MM(B, 3);
#undef PV_WAIT
#undef PV_MM
#undef PV_LD
#undef TRRD
}
#define PK4(P, B_, OUT) do { const unsigned a0_ = cvtpk(P[B_ + 0], P[B_ + 1]), a1_ = cvtpk(P[B_ + 2], P[B_ + 3]); \
        const unsigned b0_ = cvtpk(P[B_ + 4], P[B_ + 5]), b1_ = cvtpk(P[B_ + 6], P[B_ + 7]); \
        auto r0_ = __builtin_amdgcn_permlane32_swap(a0_, b0_, false, false); auto r1_ = __builtin_amdgcn_permlane32_swap(a1_, b1_, false, false); \
        u32x4 w_ = {r0_[0], r1_[0], r0_[1], r1_[1]}; OUT = __builtin_bit_cast(bf16x8, w_); } while (0)

__device__ __forceinline__ void store_o_staged(const f32x16* o, const float* rli, bf16* Ow, int ldo, ALAS char* stg, int lane, int r32, int hi, float* ssqp) {
    ALAS unsigned short* s16 = (ALAS unsigned short*)stg;
#pragma unroll
    for (int r = 0; r < 16; ++r) { const int orow = crow(r, hi);
#pragma unroll
        for (int d0 = 0; d0 < 4; ++d0) { const float v = o[d0][r] * rli[r]; s16[orow * 128 + d0 * 32 + r32] = (unsigned short)cvtpk(v, v); } }
    asm volatile("s_waitcnt lgkmcnt(0)" ::: "memory");
#pragma unroll
    for (int i = 0; i < 8; ++i) { const int idx = i * 64 + lane, row = idx >> 4, ch = idx & 15;
        const u32x4 w = *(ALAS const u32x4*)(stg + row * 256 + ch * 16);
        *(u32x4*)(Ow + (size_t)row * ldo + ch * 8) = w;
        float s = 0.f; { const unsigned ww[4] = {w.x, w.y, w.z, w.w};
#pragma unroll
            for (int e = 0; e < 4; ++e) { const float x0 = __uint_as_float(ww[e] << 16), x1 = __uint_as_float(ww[e] & 0xffff0000u); s += x0 * x0 + x1 * x1; } }
        s += __shfl_xor(s, 1); s += __shfl_xor(s, 2); s += __shfl_xor(s, 4); s += __shfl_xor(s, 8);
        if (ch == 0) ssqp[(size_t)row * 32] = s; }
}
template <bool MLA>
__device__ __forceinline__ void attn_unit(const Unit u, ALAS char* lds) {
    int tid_o = threadIdx.x; asm volatile("" : "+v"(tid_o));
    const int tid = tid_o, wid = __builtin_amdgcn_readfirstlane(tid >> 6), lane = tid & 63, r32 = lane & 31, hi = lane >> 5;
    const bool actw = wid < u.nact;
    const int sr = tid >> 4, sc = (tid & 15) * 8;
    const int vst0 = v_st(sr, sc), vst1 = v_st(32 + sr, sc), kws = KSWZ(sr, sc * 2);
    const int rk = tid >> 3, rc = (tid & 7) * 8, rws = RSWZ(rk, rc * 2);
    ALAS char* V_l = lds + OFF_V; ALAS char* K_l = lds + OFF_K; ALAS char* R_l = lds + OFF_R;
    ALAS float* al_l = (ALAS float*)(lds + OFF_WS) + wid * 64; ALAS float* li_l = al_l + 32;
    const unsigned vbase = (unsigned)(uintptr_t)V_l + (unsigned)v_rd_base(lane);
    constexpr int NQ = MLA ? 12 : 8;
    bf16x8 qr[NQ];
#pragma unroll
    for (int d0 = 0; d0 < NQ; ++d0) qr[d0] = (bf16x8){0, 0, 0, 0, 0, 0, 0, 0};
    if (actw) {
#pragma unroll
        for (int d0 = 0; d0 < NQ; ++d0) qr[d0] = *(const bf16x8*)(u.Q + (size_t)(wid * 32 + r32) * u.ldq + d0 * 16 + hi * 8);
    }
    const int cw = (u.P0 + wid * 32) >> 6;
    const int qpos = u.P0 + wid * 32 + r32;
    float m_reg = -1e30f, l_reg = 0.f, carry = 0.f; bool fin = false;
    ALAS unsigned* flg = (ALAS unsigned*)(lds + OFF_FLG);
    f32x16 o[4];
#pragma unroll
    for (int d = 0; d < 4; ++d)
#pragma unroll
        for (int r = 0; r < 16; ++r) o[d][r] = 0.f;
    bf16x8 st_k0, st_k1, st_v0, st_v1, st_r = (bf16x8){0, 0, 0, 0, 0, 0, 0, 0};
    f32x4 fk[4], fv[4];
#define LOADT(tt) do { if (!MLA) { const int t_ = (tt); const bool lo_ = t_ < u.split; const size_t ro_ = (size_t)(lo_ ? t_ : t_ - u.split) * 64 * 2048; \
            const float* kb_ = (lo_ ? u.Kf0 : u.Kf1) + ro_ + (size_t)sr * 2048 + sc; const float* vb_ = (lo_ ? u.Vf0 : u.Vf1) + ro_ + (size_t)sr * 2048 + sc; \
            fk[0] = *(const f32x4*)kb_; fk[1] = *(const f32x4*)(kb_ + 4); fk[2] = *(const f32x4*)(kb_ + 32 * 2048); fk[3] = *(const f32x4*)(kb_ + 32 * 2048 + 4); \
            fv[0] = *(const f32x4*)vb_; fv[1] = *(const f32x4*)(vb_ + 4); fv[2] = *(const f32x4*)(vb_ + 32 * 2048); fv[3] = *(const f32x4*)(vb_ + 32 * 2048 + 4); } else { \
        const size_t r0_ = (size_t)(tt) * 64; \
        st_k0 = *(const bf16x8*)(u.K + (r0_ + sr) * 2048 + sc); st_k1 = *(const bf16x8*)(u.K + (r0_ + 32 + sr) * 2048 + sc); \
        st_v0 = *(const bf16x8*)(u.V + (r0_ + sr) * 2048 + sc); st_v1 = *(const bf16x8*)(u.V + (r0_ + 32 + sr) * 2048 + sc); \
        if (MLA) st_r = *(const bf16x8*)(u.Kr + (r0_ + rk) * 64 + rc); } } while (0)
    LOADT(MLA ? 0 : (u.NT - 1));
    for (int i = 0; i < u.NT; ++i) {
        const int t = MLA ? i : (u.NT - 1 - i); const int buf = i & 1;
        if (!MLA) { u32x4 w_;
            w_ = (u32x4){cvtpk(fk[0][0], fk[0][1]), cvtpk(fk[0][2], fk[0][3]), cvtpk(fk[1][0], fk[1][1]), cvtpk(fk[1][2], fk[1][3])}; st_k0 = __builtin_bit_cast(bf16x8, w_);
            w_ = (u32x4){cvtpk(fk[2][0], fk[2][1]), cvtpk(fk[2][2], fk[2][3]), cvtpk(fk[3][0], fk[3][1]), cvtpk(fk[3][2], fk[3][3])}; st_k1 = __builtin_bit_cast(bf16x8, w_);
            w_ = (u32x4){cvtpk(fv[0][0], fv[0][1]), cvtpk(fv[0][2], fv[0][3]), cvtpk(fv[1][0], fv[1][1]), cvtpk(fv[1][2], fv[1][3])}; st_v0 = __builtin_bit_cast(bf16x8, w_);
            w_ = (u32x4){cvtpk(fv[2][0], fv[2][1]), cvtpk(fv[2][2], fv[2][3]), cvtpk(fv[3][0], fv[3][1]), cvtpk(fv[3][2], fv[3][3])}; st_v1 = __builtin_bit_cast(bf16x8, w_); }
        *(ALAS bf16x8*)(K_l + buf * 16384 + kws) = st_k0; *(ALAS bf16x8*)(K_l + buf * 16384 + kws + 32 * 256) = st_k1;
        *(ALAS bf16x8*)(V_l + buf * 16384 + vst0) = st_v0; *(ALAS bf16x8*)(V_l + buf * 16384 + vst1) = st_v1;
        if (MLA) *(ALAS bf16x8*)(R_l + buf * 8192 + rws) = st_r;
        if (!MLA) { if (lane == 0) flg[buf * 8 + wid] = (fin || !actw) ? 1u : 0u; }
        __syncthreads();
        if (!MLA) {
            const u32x4 fa = *(ALAS const u32x4*)(flg + buf * 8), fb = *(ALAS const u32x4*)(flg + buf * 8 + 4);
            if ((fa.x & fa.y & fa.z & fa.w & fb.x & fb.y & fb.z & fb.w) != 0u) break;
        }
        if (i + 1 < u.NT) LOADT(MLA ? (i + 1) : (u.NT - 2 - i));
        if (actw && t <= cw && !fin) {
            f32x16 p0, p1;
#pragma unroll
            for (int r = 0; r < 16; ++r) { p0[r] = 0.f; p1[r] = 0.f; }
            qk128(p0, p1, K_l + buf * 16384, r32, hi, qr);
            if (MLA) qk64(p0, p1, R_l + buf * 8192, r32, hi, qr + (MLA ? 8 : 0));
            bf16x8 pa0, pa1, pa2, pa3;
            if (MLA) {
                float pmax = p0[0];
#pragma unroll
                for (int r = 1; r < 16; ++r) pmax = fmaxf(pmax, p0[r]);
#pragma unroll
                for (int r = 0; r < 16; ++r) pmax = fmaxf(pmax, p1[r]);
                { auto rr = __builtin_amdgcn_permlane32_swap(__float_as_uint(pmax), __float_as_uint(pmax), false, false);
                  pmax = fmaxf(__uint_as_float(rr[0]), __uint_as_float(rr[1])); }
                const float mn = fmaxf(m_reg, pmax); const float alpha = __builtin_amdgcn_exp2f(m_reg - mn); m_reg = mn;
                float ps = 0.f;
#pragma unroll
                for (int r = 0; r < 16; ++r) { p0[r] = __builtin_amdgcn_exp2f(p0[r] - mn); ps += p0[r]; }
#pragma unroll
                for (int r = 0; r < 16; ++r) { p1[r] = __builtin_amdgcn_exp2f(p1[r] - mn); ps += p1[r]; }
                { auto rr = __builtin_amdgcn_permlane32_swap(__float_as_uint(ps), __float_as_uint(ps), false, false);
                  ps = __uint_as_float(rr[0]) + __uint_as_float(rr[1]); }
                l_reg = l_reg * alpha + ps;
                if (__any(alpha < 1.f)) {
                    if (hi == 0) al_l[r32] = alpha;
                    asm volatile("s_waitcnt lgkmcnt(0)" ::: "memory");
#pragma unroll
                    for (int r = 0; r < 16; ++r) { const float a = al_l[crow(r, hi)];
#pragma unroll
                        for (int d = 0; d < 4; ++d) o[d][r] *= a; }
                    asm volatile("s_waitcnt lgkmcnt(0)" ::: "memory");
                }
            } else {
                const bool diag = (t == cw); const int dq = qpos - 64 * t - 4 * hi; const float NEG = -__builtin_inff();
                float suf = carry;
#define SB_HALF(P, KOFF) do { f32x16 f_; \
                    _Pragma("unroll") for (int r = 0; r < 16; ++r) { const float y = P[r]; const float e = __builtin_amdgcn_exp2f(-fabsf(y)); const float l2 = __builtin_amdgcn_logf(1.f + e); \
                        const float lb = fminf(y, 0.f) - l2; P[r] = lb; f_[r] = lb - y; } \
                    if (diag) { _Pragma("unroll") for (int r = 0; r < 16; ++r) { const int c = (r & 3) + 8 * (r >> 2) + (KOFF); if (!(c < dq)) { P[r] = NEG; f_[r] = 0.f; } } } \
                    float tg_[4], pg_[4]; \
                    _Pragma("unroll") for (int g = 0; g < 4; ++g) { const float a = (f_[4 * g] + f_[4 * g + 1]) + (f_[4 * g + 2] + f_[4 * g + 3]); \
                        auto rr = __builtin_amdgcn_permlane32_swap(__float_as_uint(a), __float_as_uint(a), false, false); \
                        const float lo = __uint_as_float(rr[0]), hh = __uint_as_float(rr[1]); tg_[g] = lo + hh; pg_[g] = hi == 0 ? hh : 0.f; } \
                    _Pragma("unroll") for (int g = 3; g >= 0; --g) { const float base = suf + pg_[g]; \
                        const float s2 = f_[4 * g + 3], s1 = s2 + f_[4 * g + 2], s0 = s1 + f_[4 * g + 1]; \
                        P[4 * g + 3] = __builtin_amdgcn_exp2f(P[4 * g + 3] + base); P[4 * g + 2] = __builtin_amdgcn_exp2f(P[4 * g + 2] + (base + s2)); \
                        P[4 * g + 1] = __builtin_amdgcn_exp2f(P[4 * g + 1] + (base + s1)); P[4 * g] = __builtin_amdgcn_exp2f(P[4 * g] + (base + s0)); \
                        suf += tg_[g]; } } while (0)
                SB_HALF(p1, 32);
                PK4(p1, 0, pa2); PK4(p1, 8, pa3);
                SB_HALF(p0, 0);
                PK4(p0, 0, pa0); PK4(p0, 8, pa1);
#undef SB_HALF
                carry = suf;
                fin = __all(carry < SB_DEAD);
            }
            if (MLA) { PK4(p0, 0, pa0); PK4(p0, 8, pa1); PK4(p1, 0, pa2); PK4(p1, 8, pa3); }
            pv_tile(o, vbase + (unsigned)(buf * 16384), pa0, pa1, pa2, pa3);
        }
    }
    __syncthreads();
    if (actw) {
        float rli[16];
        if (MLA) {
            if (hi == 0) li_l[r32] = l_reg;
            asm volatile("s_waitcnt lgkmcnt(0)" ::: "memory");
#pragma unroll
            for (int r = 0; r < 16; ++r) rli[r] = 1.0f / li_l[crow(r, hi)];
        } else {
#pragma unroll
            for (int r = 0; r < 16; ++r) rli[r] = 1.0f;
        }
        store_o_staged(o, rli, u.O + (size_t)(wid * 32) * u.ldo, u.ldo, lds + wid * 8192, lane, r32, hi, u.ssq + (size_t)(wid * 32) * 32);
    }
    __syncthreads();
#undef LOADT
}

__device__ __forceinline__ void qk192_pipe(f32x16& p0, f32x16& p1, ALAS const char* Kt, ALAS const char* Rt, int r32, int hi, const bf16x8* qr, const f32x16* cinit = nullptr) {
    constexpr int PF = 2;
    bf16x8 fa[12], fb[12];
#define QK_ADDR(s) ((s) < 8 ? Kt + KSWZ(r32, ((s) * 16 + hi * 8) * 2) : Rt + RSWZ(r32, (((s) - 8) * 16 + hi * 8) * 2))
#define QK_LD(s) do { ALAS const char* a_ = QK_ADDR(s); fa[s] = *(ALAS const bf16x8*)a_; fb[s] = *(ALAS const bf16x8*)(a_ + ((s) < 8 ? 32 * 256 : 32 * 128)); } while (0)
#pragma unroll
    for (int s = 0; s < PF; ++s) QK_LD(s);
#pragma unroll
    for (int s = 0; s < 12; ++s) {
        if (s + PF < 12) QK_LD(s + PF);
        __builtin_amdgcn_sched_barrier(0);
        p0 = __builtin_amdgcn_mfma_f32_32x32x16_bf16(fa[s], qr[s], (s == 0 && cinit) ? *cinit : p0, 0, 0, 0);
        p1 = __builtin_amdgcn_mfma_f32_32x32x16_bf16(fb[s], qr[s], (s == 0 && cinit) ? *cinit : p1, 0, 0, 0);
        __builtin_amdgcn_sched_barrier(0);
    }
#undef QK_LD
#undef QK_ADDR
}
constexpr float MLA_THR = 8.f;
__device__ __forceinline__ void mla_softmax(f32x16& p0, f32x16& p1, float& m_reg, float& l_reg, f32x16* o, ALAS float* al_l, int r32, int hi, bf16x8& pa0, bf16x8& pa1, bf16x8& pa2, bf16x8& pa3) {
    float pmax = p0[0];
#pragma unroll
    for (int r = 1; r < 16; ++r) pmax = fmaxf(pmax, p0[r]);
#pragma unroll
    for (int r = 0; r < 16; ++r) pmax = fmaxf(pmax, p1[r]);
    { auto rr = __builtin_amdgcn_permlane32_swap(__float_as_uint(pmax), __float_as_uint(pmax), false, false);
      pmax = fmaxf(__uint_as_float(rr[0]), __uint_as_float(rr[1])); }
    float mn = m_reg, alpha = 1.f;
    if (!__all(pmax - m_reg <= MLA_THR)) { mn = fmaxf(m_reg, pmax); alpha = __builtin_amdgcn_exp2f(m_reg - mn); m_reg = mn; }
    float ps = 0.f;
#pragma unroll
    for (int r = 0; r < 16; ++r) { p0[r] = __builtin_amdgcn_exp2f(p0[r] - mn); ps += p0[r]; }
#pragma unroll
    for (int r = 0; r < 16; ++r) { p1[r] = __builtin_amdgcn_exp2f(p1[r] - mn); ps += p1[r]; }
    { auto rr = __builtin_amdgcn_permlane32_swap(__float_as_uint(ps), __float_as_uint(ps), false, false);
      ps = __uint_as_float(rr[0]) + __uint_as_float(rr[1]); }
    l_reg = l_reg * alpha + ps;
    if (__any(alpha < 1.f)) {
        if (hi == 0) al_l[r32] = alpha;
        asm volatile("s_waitcnt lgkmcnt(0)" ::: "memory");
#pragma unroll
        for (int r = 0; r < 16; ++r) { const float a = al_l[crow(r, hi)];
#pragma unroll
            for (int d = 0; d < 4; ++d) o[d][r] *= a; }
        asm volatile("s_waitcnt lgkmcnt(0)" ::: "memory");
    }
    PK4(p0, 0, pa0); PK4(p0, 8, pa1); PK4(p1, 0, pa2); PK4(p1, 8, pa3);
}
__device__ __forceinline__ void mla_softmax_rel(f32x16& p0, f32x16& p1, float& m_reg, f32x16& negm, bool first, float& l_reg, f32x16* o, ALAS float* al_l, int r32, int hi, bf16x8& pa0, bf16x8& pa1, bf16x8& pa2, bf16x8& pa3) {
    float pmax = p0[0];
#pragma unroll
    for (int r = 1; r < 16; ++r) pmax = fmaxf(pmax, p0[r]);
#pragma unroll
    for (int r = 0; r < 16; ++r) pmax = fmaxf(pmax, p1[r]);
    { auto rr = __builtin_amdgcn_permlane32_swap(__float_as_uint(pmax), __float_as_uint(pmax), false, false);
      pmax = fmaxf(__uint_as_float(rr[0]), __uint_as_float(rr[1])); }
    if (first || !__all(pmax <= MLA_THR)) {
        const float delta = first ? pmax : fmaxf(pmax, 0.f); const float alpha = first ? 1.f : __builtin_amdgcn_exp2f(-delta);
        m_reg += delta; l_reg *= alpha;
#pragma unroll
        for (int r = 0; r < 16; ++r) { p0[r] -= delta; p1[r] -= delta; negm[r] = -m_reg; }
        if (!first) {
            if (hi == 0) al_l[r32] = alpha;
            asm volatile("s_waitcnt lgkmcnt(0)" ::: "memory");
#pragma unroll
            for (int r = 0; r < 16; ++r) { const float a = al_l[crow(r, hi)];
#pragma unroll
                for (int d = 0; d < 4; ++d) o[d][r] *= a; }
            asm volatile("s_waitcnt lgkmcnt(0)" ::: "memory");
        }
    }
    float ps = 0.f;
#pragma unroll
    for (int r = 0; r < 16; ++r) { p0[r] = __builtin_amdgcn_exp2f(p0[r]); ps += p0[r]; }
#pragma unroll
    for (int r = 0; r < 16; ++r) { p1[r] = __builtin_amdgcn_exp2f(p1[r]); ps += p1[r]; }
    { auto rr = __builtin_amdgcn_permlane32_swap(__float_as_uint(ps), __float_as_uint(ps), false, false);
      ps = __uint_as_float(rr[0]) + __uint_as_float(rr[1]); }
    l_reg += ps;
    PK4(p0, 0, pa0); PK4(p0, 8, pa1); PK4(p1, 0, pa2); PK4(p1, 8, pa3);
}
constexpr int M_OFF_V = 0, M_OFF_K = 49152, M_OFF_R = 81920, M_OFF_WS = 98304, MLA_LDS_BYTES = 98304 + 8 * 256;
template <bool ROLEB, int VAR = 0> __device__ __forceinline__ void mla_body(const Unit u, ALAS char* lds) {
    int tid_o = threadIdx.x; asm volatile("" : "+v"(tid_o));
    const int tid = tid_o, wid = __builtin_amdgcn_readfirstlane(tid >> 6), lane = tid & 63, r32 = lane & 31, hi = lane >> 5;
    const bool actw = wid < u.nact; constexpr bool roleB = ROLEB;
    const int sr = tid >> 4, sc = (tid & 15) * 8;
    const int vst0 = v_st(sr, sc), vst1 = v_st(32 + sr, sc), kws = KSWZ(sr, sc * 2);
    const int rk = tid >> 3, rc = (tid & 7) * 8, rws = RSWZ(rk, rc * 2);
    ALAS char* V_l = lds + M_OFF_V; ALAS char* K_l = lds + M_OFF_K; ALAS char* R_l = lds + M_OFF_R;
    ALAS float* al_l = (ALAS float*)(lds + M_OFF_WS) + wid * 64; ALAS float* li_l = al_l + 32;
    const unsigned vbase = (unsigned)(uintptr_t)V_l + (unsigned)v_rd_base(lane);
    bf16x8 qr[12];
#pragma unroll
    for (int d0 = 0; d0 < 12; ++d0) qr[d0] = (bf16x8){0, 0, 0, 0, 0, 0, 0, 0};
    if (actw) {
#pragma unroll
        for (int d0 = 0; d0 < 12; ++d0) qr[d0] = *(const bf16x8*)(u.Q + (size_t)(wid * 32 + r32) * u.ldq + d0 * 16 + hi * 8);
    }
    const int cw = (u.P0 + wid * 32) >> 6;
    float m_reg = -1e30f, l_reg = 0.f;
    f32x16 o[4], p0, p1;
#pragma unroll
    for (int r = 0; r < 16; ++r) { p0[r] = 0.f; p1[r] = 0.f; }
#pragma unroll
    for (int d = 0; d < 4; ++d)
#pragma unroll
        for (int r = 0; r < 16; ++r) o[d][r] = 0.f;
    bf16x8 st_k0, st_k1, st_v0, st_v1, st_r;
#define LOADT(tt) do { const size_t r0_ = (size_t)(tt) * 64; \
        st_k0 = *(const bf16x8*)(u.K + (r0_ + sr) * 2048 + sc); st_k1 = *(const bf16x8*)(u.K + (r0_ + 32 + sr) * 2048 + sc); \
        st_v0 = *(const bf16x8*)(u.V + (r0_ + sr) * 2048 + sc); st_v1 = *(const bf16x8*)(u.V + (r0_ + 32 + sr) * 2048 + sc); \
        st_r = *(const bf16x8*)(u.Kr + (r0_ + rk) * 64 + rc); } while (0)
#define MLA_QK(kb) do { _Pragma("unroll") for (int r = 0; r < 16; ++r) { p0[r] = 0.f; p1[r] = 0.f; } \
        if (VAR == 4 || VAR == 0 || VAR == 5) qk192_pipe(p0, p1, K_l + (kb) * 16384, R_l + (kb) * 8192, r32, hi, qr); else if (VAR != 3) { qk128(p0, p1, K_l + (kb) * 16384, r32, hi, qr); qk64(p0, p1, R_l + (kb) * 8192, r32, hi, qr + 8); } } while (0)
#define MLA_SMPV(vs) do { bf16x8 pa0, pa1, pa2, pa3; \
        if (VAR == 1) { PK4(p0, 0, pa0); PK4(p0, 8, pa1); PK4(p1, 0, pa2); PK4(p1, 8, pa3); l_reg += p0[0]; } \
        else mla_softmax(p0, p1, m_reg, l_reg, o, al_l, r32, hi, pa0, pa1, pa2, pa3); \
        if (VAR != 2) pv_tile(o, vbase + (unsigned)((vs) * 16384), pa0, pa1, pa2, pa3); \
        else { _Pragma("unroll") for (int r = 0; r < 4; ++r) o[r][0] += __builtin_bit_cast(float, (unsigned)pa0[r] ^ (unsigned)pa1[r] ^ (unsigned)pa2[r] ^ (unsigned)pa3[r]); } } while (0)
    LOADT(0);
    int vs_cur = 0, vs_prev = 2;
    for (int i = 0; i <= u.NT; ++i) {
        const int kb = i & 1;
        if (i < u.NT && VAR != 5) {
            *(ALAS bf16x8*)(K_l + kb * 16384 + kws) = st_k0; *(ALAS bf16x8*)(K_l + kb * 16384 + kws + 32 * 256) = st_k1;
            *(ALAS bf16x8*)(V_l + vs_cur * 16384 + vst0) = st_v0; *(ALAS bf16x8*)(V_l + vs_cur * 16384 + vst1) = st_v1;
            *(ALAS bf16x8*)(R_l + kb * 8192 + rws) = st_r;
            __syncthreads();
            if (i + 1 < u.NT) LOADT(i + 1);
        }
        if (actw) {
            if constexpr (!roleB) { if (i < u.NT && i <= cw) { MLA_QK(kb); MLA_SMPV(vs_cur); } }
            else { if (i >= 1 && i - 1 <= cw) MLA_SMPV(vs_prev);
                   if (i < u.NT && i <= cw) MLA_QK(kb); }
        }
        vs_prev = vs_cur; vs_cur = (vs_cur == 2) ? 0 : vs_cur + 1;
    }
    if (actw) {
        if (hi == 0) li_l[r32] = l_reg;
        asm volatile("s_waitcnt lgkmcnt(0)" ::: "memory");
        float rli[16];
#pragma unroll
        for (int r = 0; r < 16; ++r) rli[r] = 1.0f / li_l[crow(r, hi)];
        bf16* Ow = u.O + (size_t)(wid * 32) * u.ldo;
#pragma unroll
        for (int r = 0; r < 16; ++r) { const int orow = crow(r, hi); float sq = 0.f;
#pragma unroll
            for (int d0 = 0; d0 < 4; ++d0) { const float v = o[d0][r] * rli[r]; const float vn = __shfl_xor(v, 1); sq += v * v;
                if ((r32 & 1) == 0) *(unsigned*)(Ow + (size_t)orow * u.ldo + d0 * 32 + r32) = cvtpk(v, vn); }
            sq += __shfl_xor(sq, 1); sq += __shfl_xor(sq, 2); sq += __shfl_xor(sq, 4); sq += __shfl_xor(sq, 8); sq += __shfl_xor(sq, 16);
            if (ATT_SSQ_ATOMICS && r32 == 0) __hip_atomic_fetch_add(u.ssq + wid * 32 + orow, sq, __ATOMIC_RELAXED, __HIP_MEMORY_SCOPE_AGENT); }
    }
    __syncthreads();
#undef LOADT
#undef MLA_QK
#undef MLA_SMPV
}
constexpr int D_OFF_K = 0, D_OFF_R = 49152, D_OFF_V = 73728, D_OFF_WS = 122880, DMA_LDS_BYTES = 122880 + 8 * 256;
template <int VAR = 0> __device__ __forceinline__ void mla_unit_dma(const Unit u, ALAS char* lds) {
    int tid_o = threadIdx.x; asm volatile("" : "+v"(tid_o));
    const int tid = tid_o, wid = __builtin_amdgcn_readfirstlane(tid >> 6), lane = tid & 63, r32 = lane & 31, hi = lane >> 5;
    const bool actw = wid < u.nact;
    if (false) __builtin_amdgcn_s_setprio(1);
    ALAS char* K_l = lds + D_OFF_K; ALAS char* R_l = lds + D_OFF_R; ALAS char* V_l = lds + D_OFF_V;
    ALAS float* al_l = (ALAS float*)(lds + D_OFF_WS) + wid * 64; ALAS float* li_l = al_l + 32;
    const unsigned vbase = (unsigned)(uintptr_t)V_l + (unsigned)v_rd_base(lane);
    unsigned offK[2], offV[2], offR;
#pragma unroll
    for (int j = 0; j < 2; ++j) {
        const int p = wid + 8 * j;
        { const int r = 4 * p + (lane >> 4), c = (lane & 15) ^ (r & 15); offK[j] = (unsigned)(r * 4096 + c * 16); }
        { const int sti = 2 * p + (lane >> 5), kk = (sti >> 2) * 8 + ((lane & 31) >> 2), k = (kk & ~0xC) | ((kk & 4) << 1) | ((kk & 8) >> 1), c = (sti & 3) * 32 + (lane & 3) * 8; offV[j] = (unsigned)(k * 4096 + c * 2); }
    }
    { const int r = 8 * wid + (lane >> 3), c = (lane & 7) ^ ((r >> 1) & 7); offR = (unsigned)(r * 128 + c * 16); }
    const char* gK = (const char*)u.K; const char* gV = (const char*)u.V; const char* gR = (const char*)u.Kr;
#define DMA_TILE(tt, slot) do { const size_t tb_ = (size_t)(tt) * 64; \
        __builtin_amdgcn_global_load_lds((const unsigned*)(gK + tb_ * 4096 + offK[0]), (ALAS unsigned*)(K_l + (slot) * 16384 + wid * 1024), 16, 0, 0); \
        __builtin_amdgcn_global_load_lds((const unsigned*)(gK + tb_ * 4096 + offK[1]), (ALAS unsigned*)(K_l + (slot) * 16384 + (wid + 8) * 1024), 16, 0, 0); \
        __builtin_amdgcn_global_load_lds((const unsigned*)(gR + tb_ * 128 + offR), (ALAS unsigned*)(R_l + (slot) * 8192 + wid * 1024), 16, 0, 0); \
        __builtin_amdgcn_global_load_lds((const unsigned*)(gV + tb_ * 4096 + offV[0]), (ALAS unsigned*)(V_l + (slot) * 16384 + wid * 1024), 16, 0, 0); \
        __builtin_amdgcn_global_load_lds((const unsigned*)(gV + tb_ * 4096 + offV[1]), (ALAS unsigned*)(V_l + (slot) * 16384 + (wid + 8) * 1024), 16, 0, 0); } while (0)
    bf16x8 qr[12];
#pragma unroll
    for (int d0 = 0; d0 < 12; ++d0) qr[d0] = (bf16x8){0, 0, 0, 0, 0, 0, 0, 0};
    if (actw) {
#pragma unroll
        for (int d0 = 0; d0 < 12; ++d0) qr[d0] = *(const bf16x8*)(u.Q + (size_t)(wid * 32 + r32) * u.ldq + d0 * 16 + hi * 8);
    }
#pragma unroll
    for (int d0 = 0; d0 < 12; ++d0) asm volatile("" : "+v"(qr[d0]));
    DMA_TILE(0, 0); if (u.NT > 1) DMA_TILE(1, 1);
    const int cw = (u.P0 + wid * 32) >> 6;
    float m_reg = 0.f, l_reg = 0.f;
    f32x16 o[4], p0, p1, negm;
#pragma unroll
    for (int r = 0; r < 16; ++r) negm[r] = 0.f;
#pragma unroll
    for (int d = 0; d < 4; ++d)
#pragma unroll
        for (int r = 0; r < 16; ++r) o[d][r] = 0.f;
    int sl = 0, sl2 = 2;
    for (int i = 0; i < u.NT; ++i) {
        if (i + 1 < u.NT) asm volatile("s_waitcnt vmcnt(5) lgkmcnt(0)" ::: "memory"); else asm volatile("s_waitcnt vmcnt(0) lgkmcnt(0)" ::: "memory");
        __builtin_amdgcn_s_barrier(); asm volatile("" ::: "memory");
        if (i + 2 < u.NT) DMA_TILE(i + 2, sl2);
        if (actw && i <= cw) {
            __builtin_amdgcn_s_setprio(1); qk192_pipe(p0, p1, K_l + sl * 16384, R_l + sl * 8192, r32, hi, qr, &negm); __builtin_amdgcn_s_setprio(0);
            bf16x8 pa0, pa1, pa2, pa3;
            mla_softmax_rel(p0, p1, m_reg, negm, i == 0, l_reg, o, al_l, r32, hi, pa0, pa1, pa2, pa3);
            __builtin_amdgcn_s_setprio(1); pv_tile(o, vbase + (unsigned)(sl * 16384), pa0, pa1, pa2, pa3); __builtin_amdgcn_s_setprio(0);
        }
        sl = (sl == 2) ? 0 : sl + 1; sl2 = (sl2 == 2) ? 0 : sl2 + 1;
    }
    asm volatile("s_waitcnt lgkmcnt(0)" ::: "memory"); __builtin_amdgcn_s_barrier(); asm volatile("" ::: "memory");
    if (actw) {
        if (hi == 0) li_l[r32] = l_reg;
        asm volatile("s_waitcnt lgkmcnt(0)" ::: "memory");
        float rli[16];
#pragma unroll
        for (int r = 0; r < 16; ++r) rli[r] = 1.0f / li_l[crow(r, hi)];
        store_o_staged(o, rli, u.O + (size_t)(wid * 32) * u.ldo, u.ldo, lds + wid * 8192, lane, r32, hi, u.ssq + (size_t)(wid * 32) * 32);
    }
    asm volatile("s_waitcnt lgkmcnt(0)" ::: "memory"); __builtin_amdgcn_s_barrier(); asm volatile("" ::: "memory");
    __builtin_amdgcn_s_setprio(0);
#undef DMA_TILE
}
template <int VAR = 0> __device__ __forceinline__ void mla_unit(const Unit u, ALAS char* lds) {
    int tid_o = threadIdx.x; asm volatile("" : "+v"(tid_o));
    if (__builtin_amdgcn_readfirstlane(tid_o >> 6) >= 4) mla_body<true, VAR>(u, lds); else mla_body<false, VAR>(u, lds);
}
#undef PK4
}
#define GAS __attribute__((address_space(1)))
#define LAS __attribute__((address_space(3)))
typedef unsigned short bf16;
typedef unsigned v4u __attribute__((ext_vector_type(4)));
typedef float f32x4 __attribute__((ext_vector_type(4)));
typedef short bf16x8 __attribute__((ext_vector_type(8)));
typedef GAS unsigned gu32;
typedef GAS unsigned long long gu64;
#define RLX_AGENT __ATOMIC_RELAXED, __HIP_MEMORY_SCOPE_AGENT
#define LDS_WAIT() asm volatile("s_waitcnt lgkmcnt(0)" ::: "memory")
#define VM_WAIT() asm volatile("s_waitcnt vmcnt(0)" ::: "memory")
__device__ __forceinline__ unsigned long long rt() { return __builtin_amdgcn_s_memrealtime(); }
__device__ __forceinline__ unsigned f2bf(float f) { unsigned u = __builtin_bit_cast(unsigned, f); return (u + 0x7fffu + ((u >> 16) & 1u)) >> 16; }
__device__ __forceinline__ unsigned pk2(float lo, float hi) { return f2bf(lo) | (f2bf(hi) << 16); }

#define XB_TMO      128
#define XB_XCNT(j)  (256  + 64 * (j))
#define XB_XSUB(j)  (1280 + 64 * (j))
#define XB_XGEN(j)  (2304 + 64 * (j))
#define XB_TOP      3328
#define XB_TOPGEN   3392
#define XCD_BAR_WORDS 3456
#define XB_SPIN_CAP (1u << 18)

__device__ __forceinline__ unsigned xb_ld(unsigned* p)              { return __hip_atomic_load(p, __ATOMIC_RELAXED, __HIP_MEMORY_SCOPE_AGENT); }
__device__ __forceinline__ unsigned xb_add(unsigned* p, unsigned v) { return __hip_atomic_fetch_add(p, v, __ATOMIC_RELAXED, __HIP_MEMORY_SCOPE_AGENT); }
__device__ __forceinline__ unsigned xb_xcc_id() { return (unsigned)__builtin_amdgcn_s_getreg((3 << 11) | 20) & 0xFu; }
#define XB_SPIN(cond, bar) do { unsigned _sp = 0; while (cond) { __builtin_amdgcn_s_sleep(1); \
    if ((++_sp & 255u) == 0u) { if (xb_ld(&(bar)[XB_TMO])) break; if (_sp > XB_SPIN_CAP) { atomicAdd(&(bar)[XB_TMO], 1u); break; } } } } while (0)

struct XcdBarrier {
    unsigned* bar; unsigned x;
    volatile LAS unsigned* st;
};

__device__ __forceinline__ XcdBarrier xcd_barrier_post(unsigned* bar, volatile LAS unsigned* st) {
    XcdBarrier b; b.bar = bar; b.x = xb_xcc_id(); b.st = st;
    if (threadIdx.x == 0) (void)xb_add(&bar[XB_XCNT(b.x)], 1u);
    return b;
}
__device__ __forceinline__ void xcd_barrier_complete(unsigned* bar, unsigned x, unsigned& nloc, unsigned& nx) {
    const unsigned G = gridDim.x * gridDim.y * gridDim.z;
    unsigned sum, cnt, mine, sp = 0u;
    for (;;) {
        sum = 0u; cnt = 0u; mine = 0u;
#pragma unroll
        for (unsigned j = 0; j < 16; ++j) { const unsigned c = xb_ld(&bar[XB_XCNT(j)]); sum += c; cnt += (c > 0u) ? 1u : 0u; mine = (j == x) ? c : mine; }
        if (sum == G) break;
        __builtin_amdgcn_s_sleep(1);
        if ((++sp & 255u) == 0u) { if (xb_ld(&bar[XB_TMO])) break; if (sp > XB_SPIN_CAP) { atomicAdd(&bar[XB_TMO], 1u); break; } }
    }
    nloc = mine > 0u ? mine : 1u; nx = cnt > 0u ? cnt : 1u;
}

__device__ __forceinline__ void xcd_barrier(const XcdBarrier& b) {
    asm volatile("s_waitcnt vmcnt(0)" ::: "memory");
    __syncthreads();
    if (threadIdx.x == 0) {
        unsigned* bar = b.bar;
        __builtin_amdgcn_s_waitcnt(0);
        unsigned nloc = b.st[0], nx = b.st[1];
        if (nloc == 0u) { xcd_barrier_complete(bar, b.x, nloc, nx); b.st[0] = nloc; b.st[1] = nx; }
        const unsigned old = xb_add(&bar[XB_XSUB(b.x)], 1u);
        const unsigned gen = old / nloc;
        if (old + 1u == (gen + 1u) * nloc) {
            __builtin_amdgcn_fence(__ATOMIC_RELEASE, "agent");
            asm volatile("s_waitcnt vmcnt(0)" ::: "memory");
            const unsigned og = xb_add(&bar[XB_TOP], 1u);
            const unsigned tg = og / nx;
            if (og + 1u == (tg + 1u) * nx) xb_add(&bar[XB_TOPGEN], 1u);
            else XB_SPIN(xb_ld(&bar[XB_TOPGEN]) == tg, bar);
            __builtin_amdgcn_fence(__ATOMIC_ACQUIRE, "agent");
            xb_add(&bar[XB_XGEN(b.x)], 1u);
            asm volatile("s_waitcnt vmcnt(0)" ::: "memory");
        } else {
            XB_SPIN(xb_ld(&bar[XB_XGEN(b.x)]) == gen, bar);
            __builtin_amdgcn_fence(__ATOMIC_ACQUIRE, "agent");
            asm volatile("s_waitcnt vmcnt(0)" ::: "memory");
        }
    }
    __syncthreads();
}
constexpr int NWAVES = 8;
constexpr int DM = 4096, NP = 16384, NS = 512, MTOK = NP + NS;
constexpr int SEQ = 4096, PAST = 1024, DSEQ = 64, SKVS = PAST + DSEQ;
constexpr int KVROWS = NP + 8 * SKVS;
constexpr int NINP = 7936;
constexpr int QLORA = 1024, KVLORA = 512, ROPE = 64, NOPE = 128, NH = 16, DFF = 16384;
constexpr float EPS = 1e-6f;
constexpr float LOG2E = 1.4426950408889634f;
constexpr float QS_MLA = 0.07216878364870322f * LOG2E;
constexpr float QS_SB = 0.08838834764831845f * LOG2E;

constexpr size_t O_Y = 0, O_CKV_P = 69206016, O_KR_P = 85983232, O_SBK_P = 88080384, O_SBV_P = 155189248,
                 O_CKV_S = 222298112, O_KR_S = 222822400, O_SBK_S = 222887936, O_SBV_S = 224985088, O_END = 227082240;

constexpr size_t MiB = 1u << 20;
constexpr size_t WS_CTL = 0, CTL_ZERO_BYTES = 1 * MiB;
constexpr size_t WS_SSQH = 512 * 1024;
constexpr size_t WS_TAB = 1 * MiB;
constexpr size_t WS_WIN = 2 * MiB;
constexpr size_t WS_WQB = 64 * MiB;
constexpr size_t WS_WKVB = 70 * MiB;
constexpr size_t WS_WO = 74 * MiB;
constexpr size_t WS_WUP = 106 * MiB;
constexpr size_t WS_WDN = 234 * MiB;
constexpr size_t WS_XN = 362 * MiB;
constexpr size_t WS_R = 494 * MiB;
constexpr size_t WS_U = WS_R;
constexpr size_t WS_QLAT = WS_R;
constexpr size_t WS_AKV = WS_QLAT + 33 * MiB;
constexpr size_t WS_KROPE = WS_AKV + 25 * MiB;
constexpr size_t WS_VB = WS_KROPE + 4 * MiB;
constexpr size_t WS_QB = WS_VB + 98 * MiB;
constexpr size_t WS_KN = WS_QB + 99 * MiB;
constexpr size_t WS_SBQ = WS_KN + 98 * MiB;
constexpr size_t WS_SBK = WS_SBQ + 66 * MiB;
constexpr size_t WS_SBV = WS_SBK + 98 * MiB;
constexpr size_t WS_R2 = WS_SBV + 98 * MiB;
constexpr size_t WS_LAT = WS_R2;
constexpr size_t WS_QRAW = WS_R2;
constexpr size_t WS_KNRAW = WS_R2 + 198 * MiB;
constexpr size_t WS_MLAO = WS_R2;
constexpr size_t WS_SBO = WS_R2 + 66 * MiB;
constexpr size_t WS_MERGED = WS_R2 + 132 * MiB;
constexpr size_t WS_SLAB = WS_R2;
constexpr size_t WS_Y0B = WS_R2 + 264 * MiB;
constexpr size_t WS_WDN1 = WS_R2 + 398 * MiB;
constexpr size_t WS_SSQP = WS_WDN1 + 128 * MiB;
constexpr size_t WS_END = WS_SSQP + 3 * MiB;
static_assert(WS_U + (size_t)MTOK * DFF * 2 <= WS_END, "U fits the overlay region");
static_assert(WS_XN + (size_t)MTOK * DM * 2 <= WS_R && WS_WDN + (size_t)DM * DFF * 2 <= WS_XN && WS_WIN + (size_t)NINP * DM * 2 <= WS_WQB, "ws map");
constexpr int CW_TMO = 0, CW_CODE = 1, CW_BAR = 4096;

constexpr int RING_OFF = 0, RING_BYTES = 131072;
constexpr int LDSCTL_OFF = RING_BYTES, MISC_OFF = LDSCTL_OFF + 320;
constexpr int XCH_OFF = LDSCTL_OFF + 1024;
constexpr int LDS_BYTES = 147456;
static_assert(XCH_OFF + 8192 <= LDS_BYTES, "LDS map");
static_assert(att::ATT_LDS_BYTES <= RING_BYTES && att::MLA_LDS_BYTES <= RING_BYTES && att::DMA_LDS_BYTES <= RING_BYTES, "attention scratch fits the ring region");

#if defined(__HIP_DEVICE_COMPILE__)
#define ASSUME_GLOBAL(p) do { __builtin_assume(!__builtin_amdgcn_is_shared((const __attribute__((address_space(0))) void*)(p))); __builtin_assume(!__builtin_amdgcn_is_private((const __attribute__((address_space(0))) void*)(p))); } while (0)
#else
#define ASSUME_GLOBAL(p) do { } while (0)
#endif
typedef float f32x2 __attribute__((ext_vector_type(2)));
__device__ __forceinline__ float wave_sum(float v) {
#pragma unroll
    for (int o = 1; o < 64; o <<= 1) v += __shfl_xor(v, o);
    return v;
}
__device__ __forceinline__ unsigned pkbf(float lo, float hi) { return pg8::cvt_pk_bf16(lo, hi); }
__device__ __forceinline__ float bf2f(unsigned short b) { return __uint_as_float(((unsigned)b) << 16); }
__device__ __forceinline__ int kvrow_of(int m) { return m < NP ? m : NP + ((m - NP) >> 6) * SKVS + PAST + ((m - NP) & 63); }
__device__ __forceinline__ int pos_of(int m) { return m < NP ? (m & (SEQ - 1)) : PAST + ((m - NP) & 63); }

__device__ __forceinline__ void sincos_acc(float ang, float& s, float& c) {
    const double a = (double)ang; const double q = rint(a * 0.63661977236758134308);
    double r = fma(-q, 1.57079632679489661923, a); r = fma(-q, 6.123233995736766e-17, r);
    const float rf = (float)r; const int qi = (int)q; const float r2 = rf * rf;
    const float sp = rf + rf * r2 * (-1.6666667163e-1f + r2 * (8.3333337680e-3f + r2 * (-1.9841270114e-4f + r2 * 2.7557314297e-6f)));
    const float cp = 1.f + r2 * (-0.5f + r2 * (4.1666667908e-2f + r2 * (-1.3888889225e-3f + r2 * (2.4801587642e-5f + r2 * (-2.7557314297e-7f)))));
    switch (qi & 3) { case 0: s = sp; c = cp; break; case 1: s = cp; c = -sp; break; case 2: s = -sp; c = -cp; break; default: s = -cp; c = sp; break; }
}

struct Frame {
    LAS unsigned char* lds; volatile LAS unsigned* MISC; gu32* ctl;
    int tid, lane, wave, vcu, G;
};
struct Args { const float* in[22]; float* out; unsigned char* ws; };

struct TItem { const float* src; bf16* dst; const float* gk; int N, K; };
__device__ __forceinline__ void ti_load(const TItem& P, float (&tv)[32], f32x4& g0, f32x4& g1, int lane) {
    if (P.gk) { g0 = *(const GAS f32x4*)(P.gk + 8 * (lane & 7)); g1 = *(const GAS f32x4*)(P.gk + 8 * (lane & 7) + 4); }
    else { g0 = f32x4{1.f, 1.f, 1.f, 1.f}; g1 = g0; }
    const GAS float* s = (const GAS float*)P.src + (size_t)(lane >> 5) * P.N + (lane & 31);
#pragma unroll
    for (int i = 0; i < 32; ++i) tv[i] = s[(size_t)(2 * i) * P.N];
}
__device__ __forceinline__ void ti_finish(const TItem& P, const float (&tv)[32], const f32x4 g0, const f32x4 g1, LAS float* scr, int lane) {
#pragma unroll
    for (int i = 0; i < 32; ++i) scr[(2 * i + (lane >> 5)) * 33 + (lane & 31)] = tv[i];
    LDS_WAIT(); asm volatile("" ::: "memory");
    const int c = lane & 7;
#pragma unroll
    for (int j = 0; j < 4; ++j) { const int n = (lane >> 3) + 8 * j; const LAS float* s = scr + (8 * c) * 33 + n;
        v4u o; o.x = pkbf(s[0 * 33] * g0.x, s[1 * 33] * g0.y); o.y = pkbf(s[2 * 33] * g0.z, s[3 * 33] * g0.w); o.z = pkbf(s[4 * 33] * g1.x, s[5 * 33] * g1.y); o.w = pkbf(s[6 * 33] * g1.z, s[7 * 33] * g1.w);
        *(GAS v4u*)(P.dst + (size_t)n * P.K + 8 * c) = o; }
    LDS_WAIT(); asm volatile("" ::: "memory");
}
__device__ __forceinline__ void rms_row_4096(const float* xrow, const float* g, bf16* orow, int lane) {
    const GAS f32x4* xr = (const GAS f32x4*)xrow + lane; const GAS f32x4* gr = (const GAS f32x4*)g + lane;
    f32x4 v[16]; float s = 0.f;
#pragma unroll
    for (int j = 0; j < 16; ++j) { v[j] = xr[64 * j]; s += (v[j].x * v[j].x + v[j].y * v[j].y) + (v[j].z * v[j].z + v[j].w * v[j].w); }
    const float rstd = 1.0f / sqrtf(wave_sum(s) * (1.f / 4096.f) + EPS);
    GAS unsigned long long* o8 = (GAS unsigned long long*)orow + lane;
#pragma unroll
    for (int j = 0; j < 16; ++j) { const f32x4 gg = gr[64 * j];
        o8[64 * j] = (unsigned long long)pkbf(v[j].x * rstd * gg.x, v[j].y * rstd * gg.y) | ((unsigned long long)pkbf(v[j].z * rstd * gg.z, v[j].w * rstd * gg.w) << 32); }
}
__device__ __forceinline__ void rms_row_4096_bf16(const bf16* xrow, const float* g, bf16* orow, int lane) {
    const GAS v4u* xr = (const GAS v4u*)xrow + lane; float x[64]; float s = 0.f;
#pragma unroll
    for (int j = 0; j < 8; ++j) { const v4u w = xr[64 * j]; const unsigned ww[4] = {w.x, w.y, w.z, w.w};
#pragma unroll
        for (int e = 0; e < 4; ++e) { x[8 * j + 2 * e] = __uint_as_float(ww[e] << 16); x[8 * j + 2 * e + 1] = __uint_as_float(ww[e] & 0xffff0000u); } }
#pragma unroll
    for (int i = 0; i < 64; ++i) s += x[i] * x[i];
    const float rstd = 1.0f / sqrtf(wave_sum(s) * (1.f / 4096.f) + EPS);
#pragma unroll
    for (int j = 0; j < 8; ++j) { const GAS f32x4* gp = (const GAS f32x4*)(g + 8 * (64 * j + lane)); const f32x4 g0 = gp[0], g1 = gp[1];
        v4u o; o.x = pkbf(x[8 * j] * rstd * g0.x, x[8 * j + 1] * rstd * g0.y); o.y = pkbf(x[8 * j + 2] * rstd * g0.z, x[8 * j + 3] * rstd * g0.w);
        o.z = pkbf(x[8 * j + 4] * rstd * g1.x, x[8 * j + 5] * rstd * g1.y); o.w = pkbf(x[8 * j + 6] * rstd * g1.z, x[8 * j + 7] * rstd * g1.w);
        *((GAS v4u*)orow + 64 * j + lane) = o; }
}
__device__ __forceinline__ void cache_rows_to_bf16(const float* src, bf16* dst, int W, int gthread, int nthreads) {
    const int per_row = W >> 2; const long total = (long)8 * PAST * per_row;
    for (long i = gthread; i < total; i += nthreads) {
        const int row = (int)(i / per_row), c4 = (int)(i % per_row), b = row >> 10, j = row & 1023;
        const f32x4 v = *(const GAS f32x4*)(src + (size_t)row * W + c4 * 4);
        *(GAS unsigned long long*)(dst + (size_t)(NP + b * SKVS + j) * W + c4 * 4) = (unsigned long long)pkbf(v.x, v.y) | ((unsigned long long)pkbf(v.z, v.w) << 32);
    }
}

template <bool NORM>
__device__ __forceinline__ void tail_reduce_res(const pg8::TailSplitOrder& S, const float* resP, const float* resS, float* out, bf16* HB, float* ssq, const float* ssqm, const float* ssqs, bf16* YB, int tid) {
    if (S.nsplit == 1) return;
    const int wid = __builtin_amdgcn_readfirstlane(tid >> 6), lane = tid & 63, wr = wid >> 2, wc = wid & 3, fr = lane & 15, fq = lane >> 4;
    const int j = S.c / S.nsplit, p = S.c % S.nsplit, per = 32 / S.nsplit;
    pg8::Unit u; S.map(S.nfull * S.G + j, u);
    for (int ii = 0; ii < per; ++ii) {
        const int idx = p * per + ii, a = idx >> 4, b = (idx >> 3) & 1, mm = (idx >> 1) & 3, n = idx & 1;
        const int row = u.pm * 256 + a * 128 + wr * 64 + mm * 16 + fr, col = u.pn * 256 + b * 128 + wc * 32 + 8 * fq + 4 * n;
        f32x4 s = {0.f, 0.f, 0.f, 0.f}, s2 = {0.f, 0.f, 0.f, 0.f};
        for (int sp = 0; sp < S.nsplit; ++sp) { const f32x4 v = *((const GAS f32x4*)(S.slab + (size_t)(j * S.nsplit + sp) * 65536) + (size_t)wid * 2048 + idx * 64 + lane); if (2 * sp < S.nsplit) s += v; else s2 += v; }
        if (NORM) {
            const float rm = 1.0f / sqrtf(__hip_atomic_load(ssqm + row, __ATOMIC_RELAXED, __HIP_MEMORY_SCOPE_AGENT) * (1.f / 2048.f) + EPS), rs = 1.0f / sqrtf(__hip_atomic_load(ssqs + row, __ATOMIC_RELAXED, __HIP_MEMORY_SCOPE_AGENT) * (1.f / 2048.f) + EPS);
            s = s * rm + s2 * rs; } else s += s2;
        f32x4 v;
        if (NORM) { if (YB) { const unsigned long long h = *(const GAS unsigned long long*)(YB + (size_t)row * DM + col); const unsigned h0 = (unsigned)h, h1 = (unsigned)(h >> 32);
                                v = (f32x4){__uint_as_float(h0 << 16), __uint_as_float(h0 & 0xffff0000u), __uint_as_float(h1 << 16), __uint_as_float(h1 & 0xffff0000u)} + s; }
                    else { const float* rp = (row >= NP) ? resS + (size_t)(row - NP) * DM + col : resP + (size_t)row * DM + col; v = *(const GAS f32x4*)rp + s; } }
        else { const unsigned long long h = *(const GAS unsigned long long*)(HB + (size_t)row * DM + col); const unsigned h0 = (unsigned)h, h1 = (unsigned)(h >> 32);
               v = (f32x4){__uint_as_float(h0 << 16), __uint_as_float(h0 & 0xffff0000u), __uint_as_float(h1 << 16), __uint_as_float(h1 & 0xffff0000u)} + s;
               if (YB) { *(GAS unsigned long long*)(YB + (size_t)row * DM + col) = (unsigned long long)pkbf(v.x, v.y) | ((unsigned long long)pkbf(v.z, v.w) << 32);
                         float q = (v.x * v.x + v.y * v.y) + (v.z * v.z + v.w * v.w); q += __shfl_xor(q, 16); q += __shfl_xor(q, 32);
                         if (fq == 0) __hip_atomic_fetch_add(ssq + row, q, __ATOMIC_RELAXED, __HIP_MEMORY_SCOPE_AGENT); }
               else *(GAS f32x4*)(out + (size_t)row * DM + col) = v; }
        if (NORM) {
            *(GAS unsigned long long*)(HB + (size_t)row * DM + col) = (unsigned long long)pkbf(v.x, v.y) | ((unsigned long long)pkbf(v.z, v.w) << 32);
            float q = (v.x * v.x + v.y * v.y) + (v.z * v.z + v.w * v.w); q += __shfl_xor(q, 16); q += __shfl_xor(q, 32);
            if (fq == 0) __hip_atomic_fetch_add(ssq + row, q, __ATOMIC_RELAXED, __HIP_MEMORY_SCOPE_AGENT);
        }
    }
}

__global__ void __launch_bounds__(NWAVES * 64, 2) hymba_fwd(Args args) {
    extern __shared__ __attribute__((aligned(16))) unsigned char lds[];
    Frame F;
    F.lds = (LAS unsigned char*)lds;
    F.MISC = (volatile LAS unsigned*)(F.lds + MISC_OFF);
    F.tid = threadIdx.x; F.lane = F.tid & 63; F.wave = __builtin_amdgcn_readfirstlane(F.tid >> 6);
    F.G = gridDim.x; { const int bx = blockIdx.x; F.vcu = (F.G % 8 == 0) ? (bx % 8) * (F.G / 8) + bx / 8 : bx; }
    unsigned char* ws = args.ws;
    F.ctl = (gu32*)(ws + WS_CTL);
    for (int u = F.tid; u < (LDS_BYTES - LDSCTL_OFF) / 4; u += NWAVES * 64) ((LAS unsigned*)(F.lds + LDSCTL_OFF))[u] = 0u;
    __syncthreads();
    XcdBarrier bar = xcd_barrier_post((unsigned*)(F.ctl + CW_BAR), F.MISC + 8);
#ifndef PROBE_MASK
#define PROBE_MASK 0
#endif
#ifndef PROBE_BAR
#define PROBE_BAR 1
#endif
#ifndef PHMASK
#define PHMASK 0x3fff
#endif
#define GRID_BAR() do { for (int br_ = 0; br_ < PROBE_BAR; ++br_) xcd_barrier(bar); } while (0)
#define PHASE_PTRS() unsigned long long zoff_ = 0; asm volatile("" : "+s"(zoff_)); unsigned char* const wsb = args.ws + zoff_; float* const OUT = args.out + zoff_;     int ptid_ = threadIdx.x; asm volatile("" : "+v"(ptid_)); int bx_ = blockIdx.x, G_ = gridDim.x; asm volatile("" : "+s"(bx_), "+s"(G_)); const int VCU = (G_ % 8 == 0) ? (bx_ % 8) * (G_ / 8) + bx_ / 8 : bx_; (void)VCU; \
    const int LANE = ptid_ & 63, WAVE = __builtin_amdgcn_readfirstlane(ptid_ >> 6); const int gw = VCU * NWAVES + WAVE, NGW = G_ * NWAVES; const int gthread = gw * 64 + LANE, nthreads = NGW * 64; (void)gthread; (void)nthreads; (void)gw; (void)NGW; (void)LANE
#define WIN_T ((bf16*)(wsb + WS_WIN))
#define WQB_T ((bf16*)(wsb + WS_WQB))
#define WKVB_T ((bf16*)(wsb + WS_WKVB))
#define WO_T ((bf16*)(wsb + WS_WO))
#define WUP_T ((bf16*)(wsb + WS_WUP))
#define WDN_T0 ((bf16*)(wsb + WS_WDN))
#define WDN_T1 ((bf16*)(wsb + WS_WDN1))
#define XN ((bf16*)(wsb + WS_XN))
#define UB ((bf16*)(wsb + WS_U))
#define QLAT ((bf16*)(wsb + WS_QLAT))
#define AKV ((bf16*)(wsb + WS_AKV))
#define KROPE ((bf16*)(wsb + WS_KROPE))
#define VB ((bf16*)(wsb + WS_VB))
#define QB ((bf16*)(wsb + WS_QB))
#define KN ((bf16*)(wsb + WS_KN))
#define SBQ ((bf16*)(wsb + WS_SBQ))
#define SBK ((bf16*)(wsb + WS_SBK))
#define SBV ((bf16*)(wsb + WS_SBV))
#define LAT ((float*)(wsb + WS_LAT))
#define QRAW ((float*)(wsb + WS_QRAW))
#define KNRAW ((float*)(wsb + WS_KNRAW))
#define MLAO ((bf16*)(wsb + WS_MLAO))
#define SBO ((bf16*)(wsb + WS_SBO))
#define MERGED ((bf16*)(wsb + WS_MERGED))
#define TAB ((f32x2*)(wsb + WS_TAB))
#define SLAB ((float*)(wsb + WS_SLAB))
#define Y0B ((bf16*)(wsb + WS_Y0B))
#define SSQH ((float*)(wsb + WS_SSQH))
#define SSQM ((float*)(wsb + WS_SSQH + 128 * 1024))
#define SSQS ((float*)(wsb + WS_SSQH + 256 * 1024))
#define SSQP ((float*)(wsb + WS_SSQP))
#define SSQY ((float*)(wsb + WS_SSQH + 384 * 1024))

    { PHASE_PTRS(); (void)OUT;
    for (int i = gthread; i < SEQ * 32; i += nthreads) {
        const int pos = i >> 5, k = i & 31;
        const float inv_freq = exp2f(-(float)k * (13.287712379549449f / 32.f));
        float s, c; sincos_acc((float)pos * inv_freq, s, c); TAB[i] = (f32x2){c, s};
    } }

#define CONVERT_ITEMS(LW, R_LO, R_HI, GWV, NGWV) do { \
        const float* w_in = args.in[7] + (size_t)(LW) * DM * 7744; const float* w_qb = args.in[9] + (size_t)(LW) * QLORA * 3072; \
        const float* w_kvb = args.in[11] + (size_t)(LW) * KVLORA * 4096; const float* w_o = args.in[18] + (size_t)(LW) * DM * DM; \
        const float* w_up = args.in[20] + (size_t)(LW) * DM * DFF; const float* w_dn = args.in[21] + (size_t)(LW) * DFF * DM; const int lw_ = (LW); \
        auto dec_ = [&](int it) -> TItem { \
                int r = (R_HI) - 1 - it; \
                if (r < I_IN) { const int kb = r / 242, nb = r % 242, n0 = nb * 32; return TItem{w_in + (size_t)(kb * 64) * 7744 + n0, WIN_T + (size_t)(n0 + (n0 >= 1600 ? 192 : 0)) * DM + kb * 64, lw_ ? args.in[6] + (size_t)lw_ * DM + kb * 64 : nullptr, 7744, DM}; } r -= I_IN; \
                if (r < I_QB) { const int kb = r / 96, nb = r % 96, n0 = nb * 32, h = n0 / 192, dd = n0 % 192; \
                    return TItem{w_qb + (size_t)(kb * 64) * 3072 + n0, WQB_T + (size_t)(dd < 128 ? h * 128 + dd : 2048 + (h >> 2) * 256 + ((dd - 128) >> 5) * 128 + (h & 3) * 32) * QLORA + kb * 64, nullptr, 3072, QLORA}; } r -= I_QB; \
                if (r < I_KVB) { const int kb = r / 128, nb = r % 128, n0 = nb * 32, h = n0 >> 8, dd = n0 & 255; \
                    return TItem{w_kvb + (size_t)(kb * 64) * 4096 + n0, WKVB_T + (size_t)(dd < 128 ? h * 128 + dd : 2048 + h * 128 + (dd - 128)) * KVLORA + kb * 64, nullptr, 4096, KVLORA}; } r -= I_KVB; \
                if (r < I_O) { const int kb = r / 128, nb = r % 128; \
                    return TItem{w_o + (size_t)(kb * 64) * DM + nb * 32, WO_T + (size_t)(nb * 32) * DM + kb * 64, (kb < 32 ? args.in[16] + (size_t)lw_ * 2048 : args.in[17] + (size_t)lw_ * 2048 - 2048) + kb * 64, DM, DM}; } r -= I_O; \
                if (r < I_UP) { const int kb = r / 512, nb = r % 512; return TItem{w_up + (size_t)(kb * 64) * DFF + nb * 32, WUP_T + (size_t)(nb * 32) * DM + kb * 64, args.in[19] + (size_t)lw_ * DM + kb * 64, DFF, DM}; } r -= I_UP; \
                { const int kb = r / 128, nb = r % 128; return TItem{w_dn + (size_t)(kb * 64) * DM + nb * 32, (lw_ ? WDN_T1 : WDN_T0) + (size_t)(nb * 32) * DFF + kb * 64, nullptr, DM, DFF}; } }; \
        const int n_ = (R_HI) - (R_LO); int it = (GWV); \
        if (it < n_) { \
            float tA[32], tB[32]; f32x4 gA0, gA1, gB0, gB1; \
            TItem PA = dec_(it), PB; ti_load(PA, tA, gA0, gA1, LANE); \
            for (;;) {                                     \
                const int it1 = it + (NGWV); PB = dec_(it1 < n_ ? it1 : it); ti_load(PB, tB, gB0, gB1, LANE); \
                ti_finish(PA, tA, gA0, gA1, scr, LANE); \
                if (it1 >= n_) break; \
                const int it2 = it1 + (NGWV); PA = dec_(it2 < n_ ? it2 : it1); ti_load(PA, tA, gA0, gA1, LANE); \
                ti_finish(PB, tB, gB0, gB1, scr, LANE); \
                if (it2 >= n_) break; \
                it = it2; \
            } } } while (0)
    constexpr int I_IN = 64 * 242, I_QB = 16 * 96, I_KVB = 8 * 128, I_O = 64 * 128, I_UP = 64 * 512, I_DN = 256 * 128;
    constexpr int NITEMS = I_IN + I_QB + I_KVB + I_O + I_UP + I_DN, EARLY_ITEMS = I_IN + I_QB + I_KVB + I_O, EARLY0_ITEMS = I_IN + I_QB + I_KVB;
#pragma unroll 1
    for (int l = 0; l < 2; ++l) {
        if (l == 0 || gridDim.x != 256) {
        for (int rep_ = 0; rep_ < (((PROBE_MASK >> 0) & 1) ? 2 : 1); ++rep_) if constexpr ((PHMASK >> 0) & 1) {
            PHASE_PTRS(); (void)OUT;
            LAS float* scr = (LAS float*)(F.lds + RING_OFF + WAVE * 16384);
            const bool early_ok = (G_ == 256);
            CONVERT_ITEMS(l, (l > 0 && early_ok) ? NITEMS : 0, (l == 0 && early_ok) ? EARLY0_ITEMS : NITEMS, gw, NGW);
            if (l == 0) {
            { unsigned zz = 0u; asm volatile("" : "+v"(zz)); const v4u z4 = {zz, zz, zz, zz};
              for (int i = gthread; i < 192 * DM / 8; i += nthreads) *(GAS v4u*)(WIN_T + (size_t)1600 * DM + (size_t)i * 8) = z4; }
            cache_rows_to_bf16(args.in[2] + (size_t)l * 8 * PAST * KVLORA, AKV, KVLORA, gthread, nthreads);
            cache_rows_to_bf16(args.in[3] + (size_t)l * 8 * PAST * ROPE, KROPE, ROPE, gthread, nthreads);
            const float* g = args.in[6] + (size_t)l * DM;
            for (int m = gw; m < MTOK; m += NGW) rms_row_4096(m < NP ? args.in[0] + (size_t)m * DM : args.in[1] + (size_t)(m - NP) * DM, g, XN + (size_t)m * DM, LANE);
            }
        }
        GRID_BAR();
        }
        for (int rep_ = 0; rep_ < (((PROBE_MASK >> 1) & 1) ? 2 : 1); ++rep_) if constexpr ((PHMASK >> 1) & 1) {
            PHASE_PTRS(); (void)OUT;
            pg8::Gemm g{l == 0 ? XN : Y0B, WIN_T, MTOK, NINP, DM, nullptr}; pg8::StaticOrder S; S.init(MTOK, NINP, G_, bx_);
            pg8::EpiIn E{LAT, SBQ, SBK, SBV, OUT + O_SBK_P + (size_t)l * NP * 2048, OUT + O_SBV_P + (size_t)l * NP * 2048,
                         OUT + O_SBK_S + (size_t)l * NS * 2048, OUT + O_SBV_S + (size_t)l * NS * 2048, QS_SB, l == 0 ? nullptr : SSQY, EPS};
            const bool bg = (l == 0 && G_ == 256);
            const int rsplit = bg ? ((bx_ & 7) >> 1) : 0;
#pragma unroll 1
            for (int seg = 0; seg < 2; ++seg) {
                pg8::SubRange<pg8::StaticOrder> SS{S, seg ? rsplit : 0, seg ? (1 << 30) : rsplit};
                pg8::gemm_phase<pg8::EpiIn, pg8::SubRange<pg8::StaticOrder>, true, true>(F.lds + RING_OFF, g, SS, E);
                if (seg == 0 && bg) {
                    LAS float* scr = (LAS float*)(F.lds + RING_OFF + WAVE * 16384);
                    CONVERT_ITEMS(0, EARLY0_ITEMS, NITEMS, gw, NGW);
                    __syncthreads();
                }
            }
        }
        GRID_BAR();
        for (int rep_ = 0; rep_ < (((PROBE_MASK >> 2) & 1) ? 2 : 1); ++rep_) if constexpr ((PHMASK >> 2) & 1) {
            PHASE_PTRS(); (void)OUT;
            for (int i = gthread; i < MTOK; i += nthreads) { SSQH[i] = 0.f; SSQM[i] = 0.f; SSQS[i] = 0.f; if (l == 0) SSQY[i] = 0.f; }
            const float* g_q_a = args.in[8] + (size_t)l * QLORA; const float* g_kv_a = args.in[10] + (size_t)l * KVLORA; const float* g_k_rope = args.in[15] + (size_t)l * ROPE;
            for (int m = gw; m < MTOK; m += NGW) {
                const float* lr = LAT + (size_t)m * 1792; const int kvr = kvrow_of(m), pos = pos_of(m);
                {
                    f32x4 v[4]; float s = 0.f;
#pragma unroll
                    for (int j = 0; j < 4; ++j) { v[j] = *(const GAS f32x4*)(lr + 4 * (64 * j + LANE)); s += (v[j].x * v[j].x + v[j].y * v[j].y) + (v[j].z * v[j].z + v[j].w * v[j].w); }
                    const float rstd = 1.0f / sqrtf(wave_sum(s) * (1.f / 1024.f) + EPS);
#pragma unroll
                    for (int j = 0; j < 4; ++j) { const f32x4 gg = *(const GAS f32x4*)(g_q_a + 4 * (64 * j + LANE));
                        *(GAS unsigned long long*)(QLAT + (size_t)m * QLORA + 4 * (64 * j + LANE)) =
                            (unsigned long long)pkbf(v[j].x * rstd * gg.x, v[j].y * rstd * gg.y) | ((unsigned long long)pkbf(v[j].z * rstd * gg.z, v[j].w * rstd * gg.w) << 32); }
                }
                {
                    f32x4 v[2]; float s = 0.f;
#pragma unroll
                    for (int j = 0; j < 2; ++j) { v[j] = *(const GAS f32x4*)(lr + 1024 + 4 * (64 * j + LANE)); s += (v[j].x * v[j].x + v[j].y * v[j].y) + (v[j].z * v[j].z + v[j].w * v[j].w); }
                    const float rstd = 1.0f / sqrtf(wave_sum(s) * (1.f / 512.f) + EPS);
                    float* oc = (m < NP) ? OUT + O_CKV_P + ((size_t)l * NP + m) * KVLORA : OUT + O_CKV_S + ((size_t)l * NS + (m - NP)) * KVLORA;
#pragma unroll
                    for (int j = 0; j < 2; ++j) { const f32x4 gg = *(const GAS f32x4*)(g_kv_a + 4 * (64 * j + LANE));
                        const f32x4 c = {v[j].x * rstd * gg.x, v[j].y * rstd * gg.y, v[j].z * rstd * gg.z, v[j].w * rstd * gg.w};
                        *(GAS f32x4*)(oc + 4 * (64 * j + LANE)) = c;
                        *(GAS unsigned long long*)(AKV + (size_t)kvr * KVLORA + 4 * (64 * j + LANE)) = (unsigned long long)pkbf(c.x, c.y) | ((unsigned long long)pkbf(c.z, c.w) << 32); }
                }
                {
                    const float x = lr[1536 + LANE];
                    const float rstd = 1.0f / sqrtf(wave_sum(x * x) * (1.f / 64.f) + EPS);
                    const float xn = x * rstd * g_k_rope[LANE]; const float xp = __shfl_xor(xn, 32);
                    const f32x2 cs = TAB[pos * 32 + (LANE & 31)];
                    const float o = (LANE < 32) ? xn * cs.x - xp * cs.y : xp * cs.y + xn * cs.x;
                    float* okr = (m < NP) ? OUT + O_KR_P + ((size_t)l * NP + m) * ROPE : OUT + O_KR_S + ((size_t)l * NS + (m - NP)) * ROPE;
                    okr[LANE] = o;
                    const float on = __shfl_xor(o, 1);
                    if ((LANE & 1) == 0) *(GAS unsigned*)(KROPE + (size_t)kvr * ROPE + LANE) = pkbf(o, on);
                }
            }
        }
        GRID_BAR();
        for (int rep_ = 0; rep_ < (((PROBE_MASK >> 3) & 1) ? 2 : 1); ++rep_) if constexpr ((PHMASK >> 3) & 1) {
            PHASE_PTRS(); (void)OUT;
            pg8::Gemm g{QLAT, WQB_T, MTOK, 3072, QLORA, nullptr}; pg8::StaticOrder S; S.init(MTOK, 3072, G_, bx_);
            pg8::EpiQb E{QB, args.in[12] + (size_t)l * NOPE, args.in[13] + (size_t)l * ROPE, TAB, (LAS float*)(F.lds + XCH_OFF), QS_MLA, EPS};
            pg8::gemm_phase<pg8::EpiQb, pg8::StaticOrder, true, true>(F.lds + RING_OFF, g, S, E);
        }
        for (int rep_ = 0; rep_ < (((PROBE_MASK >> 11) & 1) ? 2 : 1); ++rep_) if constexpr ((PHMASK >> 11) & 1) {
            PHASE_PTRS(); (void)OUT;
            pg8::Gemm g{AKV, WKVB_T, KVROWS, 4096, KVLORA, nullptr}; pg8::StaticOrder S; S.init(KVROWS, 4096, G_, (bx_ + G_ - 24) % G_);
            pg8::EpiKvbN E{KN, VB, args.in[14] + (size_t)l * NOPE, (LAS float*)(F.lds + XCH_OFF), EPS};
            pg8::gemm_phase<pg8::EpiKvbN, pg8::StaticOrder, true, true>(F.lds + RING_OFF, g, S, E);
        }
        GRID_BAR();
        for (int rep_ = 0; rep_ < (((PROBE_MASK >> 5) & 1) ? 2 : 1); ++rep_) if constexpr ((PHMASK >> 5) & 1) {
            PHASE_PTRS(); (void)OUT;
            const int v = VCU, bh = v >> 2, b = bh >> 4, h = bh & 15, s = v & 3;
            ALAS char* al = (ALAS char*)(F.lds + RING_OFF);
#pragma unroll 1
            for (int k = 0; k < 5; ++k) {
                att::Unit u;
                if (k < 4) { const int qb = (k == 0) ? s : (k == 1) ? 7 - s : (k == 2) ? 8 + s : 15 - s; const size_t m0 = (size_t)b * SEQ + (size_t)qb * 256, kv0 = (size_t)b * SEQ;
                    u.Q = QB + m0 * 3072 + h * 192; u.ldq = 3072; u.K = KN + kv0 * 2048 + h * 128; u.Kr = KROPE + kv0 * ROPE; u.V = VB + kv0 * 2048 + h * 128;
                    u.O = MERGED + m0 * 4096 + h * 128; u.ldo = 4096; u.ssq = SSQP + m0 * 32 + h; u.Kf0 = u.Vf0 = u.Kf1 = u.Vf1 = nullptr; u.split = 0; u.P0 = qb * 256; u.NT = 4 * qb + 4; u.nact = 8; }
                else { if (v >= 128) break; const int sb = v >> 4, sh = v & 15; const size_t m0 = (size_t)NP + (size_t)sb * 64, kv0 = (size_t)NP + (size_t)sb * SKVS;
                    u.Q = QB + m0 * 3072 + sh * 192; u.ldq = 3072; u.K = KN + kv0 * 2048 + sh * 128; u.Kr = KROPE + kv0 * ROPE; u.V = VB + kv0 * 2048 + sh * 128;
                    u.O = MERGED + m0 * 4096 + sh * 128; u.ldo = 4096; u.ssq = SSQP + m0 * 32 + sh; u.Kf0 = u.Vf0 = u.Kf1 = u.Vf1 = nullptr; u.split = 0; u.P0 = PAST; u.NT = 17; u.nact = 2; }
                if constexpr ((PHMASK >> 12) & 1) att::mla_unit_dma<0>(u, al);
            }
#pragma unroll 1
            for (int k = 0; k < 5; ++k) {
                att::Unit u;
                if (k < 4) { const int qb = (k == 0) ? s : (k == 1) ? 7 - s : (k == 2) ? 8 + s : 15 - s; const size_t m0 = (size_t)b * SEQ + (size_t)qb * 256, kv0 = (size_t)b * SEQ;
                    u.Q = SBQ + m0 * 2048 + h * 128; u.ldq = 2048; u.K = nullptr; u.Kr = nullptr; u.V = nullptr; u.split = 1 << 30;
                    u.Kf0 = OUT + O_SBK_P + ((size_t)l * NP + kv0) * 2048 + h * 128; u.Vf0 = OUT + O_SBV_P + ((size_t)l * NP + kv0) * 2048 + h * 128; u.Kf1 = u.Kf0; u.Vf1 = u.Vf0;
                    u.O = MERGED + m0 * 4096 + 2048 + h * 128; u.ldo = 4096; u.ssq = SSQP + m0 * 32 + 16 + h; u.P0 = qb * 256; u.NT = 4 * qb + 4; u.nact = 8; }
                else { if (v < 128) break; const int w = v - 128, sb = w >> 4, sh = w & 15; const size_t m0 = (size_t)NP + (size_t)sb * 64, kv0 = (size_t)NP + (size_t)sb * SKVS;
                    u.Q = SBQ + m0 * 2048 + sh * 128; u.ldq = 2048; u.K = nullptr; u.Kr = nullptr; u.V = nullptr; u.split = PAST / 64;
                    u.Kf0 = args.in[4] + ((size_t)(l * 8 + sb) * PAST) * 2048 + sh * 128; u.Vf0 = args.in[5] + ((size_t)(l * 8 + sb) * PAST) * 2048 + sh * 128;
                    u.Kf1 = OUT + O_SBK_S + ((size_t)l * NS + (size_t)sb * 64) * 2048 + sh * 128; u.Vf1 = OUT + O_SBV_S + ((size_t)l * NS + (size_t)sb * 64) * 2048 + sh * 128;
                    u.O = MERGED + m0 * 4096 + 2048 + sh * 128; u.ldo = 4096; u.ssq = SSQP + m0 * 32 + 16 + sh; u.P0 = PAST; u.NT = 17; u.nact = 2; }
                if constexpr ((PHMASK >> 13) & 1) att::attn_unit<false>(u, al);
            }
        }
        GRID_BAR();
#if !ATT_SSQ_ATOMICS
        {
            PHASE_PTRS(); (void)OUT;
            for (int i = gthread; i < MTOK * 2; i += nthreads) { const int m = i >> 1, half = i & 1; const GAS f32x4* p = (const GAS f32x4*)(SSQP + (size_t)m * 32 + half * 16);
                const f32x4 a = p[0], b = p[1], c = p[2], d = p[3];
                const float s = (((a.x + a.y) + (a.z + a.w)) + ((b.x + b.y) + (b.z + b.w))) + (((c.x + c.y) + (c.z + c.w)) + ((d.x + d.y) + (d.z + d.w)));
                (half ? SSQS : SSQM)[m] = s; }
        }
        GRID_BAR();
#endif
        for (int rep_ = 0; rep_ < (((PROBE_MASK >> 7) & 1) ? 2 : 1); ++rep_) if constexpr ((PHMASK >> 7) & 1) {
            PHASE_PTRS(); (void)OUT;
            pg8::Gemm g{MERGED, WO_T, MTOK, DM, DM, SLAB}; pg8::TailSplitOrder S; S.init2(MTOK, DM, DM, G_, bx_, SLAB, 2);
            pg8::EpiResP<true> E{args.in[0], args.in[1], nullptr, XN, SSQH, SSQM, SSQS, EPS, l == 0 ? nullptr : Y0B};
            pg8::gemm_phase<pg8::EpiResP<true>, pg8::TailSplitOrder, true, true>(F.lds + RING_OFF, g, S, E);
        }
        GRID_BAR();
        {
            PHASE_PTRS(); pg8::TailSplitOrder S; S.init2(MTOK, DM, DM, G_, bx_, SLAB, 2);
            tail_reduce_res<true>(S, args.in[0], args.in[1], nullptr, XN, SSQH, SSQM, SSQS, l == 0 ? nullptr : Y0B, ptid_);
        }
        GRID_BAR();
        for (int rep_ = 0; rep_ < (((PROBE_MASK >> 9) & 1) ? 2 : 1); ++rep_) if constexpr ((PHMASK >> 9) & 1) {
            PHASE_PTRS(); (void)OUT;
            pg8::Gemm g{XN, WUP_T, MTOK, DFF, DM, nullptr}; pg8::StaticOrder S; S.init(MTOK, DFF, G_, bx_);
            pg8::EpiRelu2N E{UB, DFF, SSQH, EPS};
            pg8::gemm_phase<pg8::EpiRelu2N, pg8::StaticOrder, true, true>(F.lds + RING_OFF, g, S, E);
            if (l + 1 < 2 && G_ == 256 && bx_ >= 128) {
                LAS float* scr = (LAS float*)(F.lds + RING_OFF + WAVE * 16384);
                CONVERT_ITEMS(l + 1, 0, EARLY_ITEMS, (bx_ - 128) * NWAVES + WAVE, 128 * NWAVES);
            }
        }
        GRID_BAR();
        for (int rep_ = 0; rep_ < (((PROBE_MASK >> 10) & 1) ? 2 : 1); ++rep_) if constexpr ((PHMASK >> 10) & 1) {
            PHASE_PTRS(); (void)OUT;
            pg8::Gemm g{UB, l == 0 ? WDN_T0 : WDN_T1, MTOK, DM, DFF, SLAB}; pg8::TailSplitOrder S; S.init2(MTOK, DM, DFF, G_, bx_, SLAB);
            pg8::EpiResP<false> E{nullptr, nullptr, OUT + O_Y, XN, SSQY, nullptr, nullptr, EPS, l == 1 ? nullptr : Y0B};
            const bool bg = (l + 1 < 2 && G_ == 256);
            const int rsplit = bg ? ((bx_ & 7) >> 1) : 0;
#pragma unroll 1
            for (int seg = 0; seg < 2; ++seg) {
                pg8::SubRange<pg8::TailSplitOrder> SS{S, seg ? rsplit : 0, seg ? (1 << 30) : rsplit};
                pg8::gemm_phase<pg8::EpiResP<false>, pg8::SubRange<pg8::TailSplitOrder>, true, true>(F.lds + RING_OFF, g, SS, E);
                if (seg == 0 && bg) {
                    LAS float* scr = (LAS float*)(F.lds + RING_OFF + WAVE * 16384);
                    CONVERT_ITEMS(l + 1, EARLY_ITEMS, NITEMS, gw, NGW);
                    __syncthreads();
                }
            }
        }
        GRID_BAR();
        {
            PHASE_PTRS(); pg8::TailSplitOrder S; S.init2(MTOK, DM, DFF, G_, bx_, SLAB);
            tail_reduce_res<false>(S, nullptr, nullptr, OUT + O_Y, XN, SSQY, nullptr, nullptr, l == 1 ? nullptr : Y0B, ptid_);
            if (l + 1 < 2) {
                cache_rows_to_bf16(args.in[2] + (size_t)(l + 1) * 8 * PAST * KVLORA, AKV, KVLORA, gthread, nthreads);
                cache_rows_to_bf16(args.in[3] + (size_t)(l + 1) * 8 * PAST * ROPE, KROPE, ROPE, gthread, nthreads);
            }
        }
        GRID_BAR();
    }
#undef GRID_BAR
}

extern "C" void kernel_launch(void* const* d_in, const int* in_sizes, int n_in, void* d_out, int out_size, void* d_ws, size_t ws_size, hipStream_t stream) {
    static int grid = 0;
    if (grid == 0) {
        if (n_in != 22 || (size_t)out_size != O_END || ws_size < WS_END) { fprintf(stderr, "kernel_launch: unexpected shapes: n_in %d out %d ws %zu (need %zu)\n", n_in, out_size, ws_size, (size_t)WS_END); grid = -1; return; }
        int dev = 0, cus = 0, per_cu = 0;
        if (hipGetDevice(&dev) != hipSuccess || hipDeviceGetAttribute(&cus, hipDeviceAttributeMultiprocessorCount, dev) != hipSuccess) { grid = -1; return; }
        if (hipFuncSetAttribute((const void*)hymba_fwd, hipFuncAttributeMaxDynamicSharedMemorySize, LDS_BYTES) != hipSuccess) { fprintf(stderr, "kernel_launch: hipFuncSetAttribute failed\n"); grid = -1; return; }
        if (hipOccupancyMaxActiveBlocksPerMultiprocessor(&per_cu, (const void*)hymba_fwd, NWAVES * 64, LDS_BYTES) != hipSuccess || per_cu < 1) { fprintf(stderr, "kernel_launch: occupancy query reports %d\n", per_cu); }
        (void)hipGetLastError();
        grid = cus;
        if (grid != 256) fprintf(stderr, "kernel_launch: %d CUs (the attention deal assumes 256 workgroups)\n", grid);
    }
    if (grid < 0) return;
    if (hipMemsetAsync((char*)d_ws + WS_CTL, 0, CTL_ZERO_BYTES, stream) != hipSuccess) return;
    Args a{};
    for (int i = 0; i < 22; ++i) a.in[i] = (const float*)d_in[i];
    a.out = (float*)d_out; a.ws = (unsigned char*)d_ws;
    hipLaunchKernelGGL(hymba_fwd, dim3(grid), dim3(NWAVES * 64), LDS_BYTES, stream, a);
}
```

```cpp
#include <hip/hip_runtime.h>
#include <cstdio>
#include <cstdint>
#include <type_traits>
namespace pg8 {
#define PG8_LAS __attribute__((address_space(3)))
typedef unsigned short bf16_t;
typedef short bf16x8 __attribute__((ext_vector_type(8)));
typedef float f32x4 __attribute__((ext_vector_type(4)));
typedef unsigned u32x4 __attribute__((ext_vector_type(4)));
constexpr int BM = 256, BK = 64, HALF = 128, HTB = HALF * BK * 2  , STAGE_BYTES = 8 * HTB, NXCD = 8, WGM = 8;

__host__ __device__ __forceinline__ int lds_byte(int r, int c) { const int st = (r >> 4) * 2 + (c >> 5), rr = r & 15, cc = c & 31, ob = rr * 64 + cc * 2; return st * 1024 + (ob ^ (((ob >> 9) & 1) << 5)); }
__host__ __device__ __forceinline__ void stage_rc(int b, int& R, int& C) { const int st = b / 1024, sb = b % 1024, swz = sb ^ (((sb >> 9) & 1) << 5); R = (st >> 1) * 16 + swz / 64; C = (st & 1) * 32 + (swz % 64) / 2; }
__host__ __device__ __forceinline__ int perm32(int rho) { const int n = rho >> 4, i = rho & 15; return 8 * (i >> 2) + 4 * n + (i & 3); }

struct Unit { int pm, pn, kt0, nkt, part; };
struct Gemm { const bf16_t* A; const bf16_t* Bt; int M, N, K; float* slab; int blocked = 0; };

struct StaticOrder {
    int nM, nN, nwg, G, c, wgm = WGM;
    __host__ __device__ __forceinline__ void init(int M, int N, int G_, int c_) { nM = M / BM; nN = N / BM; nwg = nM * nN; G = G_; c = c_; }
    __host__ __device__ __forceinline__ bool next(int i, Unit& u) const {
        const long L = (long)i * G + c; if (L >= nwg) return false;
        int wgid = (int)L; { const int q = nwg / NXCD, r = nwg % NXCD, xcd = wgid % NXCD, off = wgid / NXCD; wgid = (xcd < r ? xcd * (q + 1) : r * (q + 1) + (xcd - r) * q) + off; }
        const int nig = wgm * nN, gid = wgid / nig, fm = gid * wgm, gsz = (nM - fm) < wgm ? (nM - fm) : wgm;
        u.pm = fm + ((wgid % nig) % gsz); u.pn = (wgid % nig) / gsz; u.kt0 = 0; u.nkt = 0; u.part = -1; return true;
    }
    __host__ __device__ __forceinline__ void map(int L, Unit& u) const {
        int wgid = L; { const int q = nwg / NXCD, r = nwg % NXCD, xcd = wgid % NXCD, off = wgid / NXCD; wgid = (xcd < r ? xcd * (q + 1) : r * (q + 1) + (xcd - r) * q) + off; }
        const int nig = wgm * nN, gid = wgid / nig, fm = gid * wgm, gsz = (nM - fm) < wgm ? (nM - fm) : wgm;
        u.pm = fm + ((wgid % nig) % gsz); u.pn = (wgid % nig) / gsz; u.kt0 = 0; u.nkt = 0; u.part = -1;
    }
    __device__ __forceinline__ void a_ready(const Unit&) const {}
    __device__ __forceinline__ void done(const Unit&) const {}
};

template <class S_> struct SubRange {
    const S_& s; int lo, hi;
    __device__ __forceinline__ bool next(int i, Unit& u) const { return (lo + i < hi) && s.next(lo + i, u); }
    __device__ __forceinline__ void a_ready(const Unit& u) const { s.a_ready(u); }
    __device__ __forceinline__ void done(const Unit& u) const { s.done(u); }
};

__device__ __forceinline__ unsigned cvt_pk_bf16(float lo, float hi) { unsigned r; asm volatile("v_cvt_pk_bf16_f32 %0, %1, %2" : "=v"(r) : "v"(lo), "v"(hi)); return r; }

struct TailSplitOrder : StaticOrder {
    int nfull, nsplit, nkt_full, halves; float* slab;
    __host__ __device__ __forceinline__ void init2(int M, int N, int K, int G_, int c_, float* slab_, int halves_ = 1) { init(M, N, G_, c_); nkt_full = K / BK; slab = slab_; halves = halves_; nfull = nwg / G; const int rem = nwg - nfull * G;
        nsplit = (rem > 0 && G % rem == 0 && (nkt_full % (2 * (G / rem))) == 0 && nkt_full / (G / rem) >= 4) ? G / rem : 1; }
    __host__ __device__ __forceinline__ bool next(int i, Unit& u) const {
        const int ii = i / halves, hh = i % halves;
        if (ii < nfull || nsplit == 1) { if (!StaticOrder::next(ii, u)) return false; if (halves == 2) { u.nkt = nkt_full / 2; u.kt0 = hh * u.nkt; u.part = hh == 0 ? -2 : -1; } return true; }
        if (ii > nfull || hh != 0) return false;
        const int j = c / nsplit, s = c % nsplit; map(nfull * G + j, u); u.nkt = nkt_full / nsplit; u.kt0 = s * u.nkt; u.part = j * nsplit + s; return true;
    }
};
typedef unsigned u32x2 __attribute__((ext_vector_type(2)));
constexpr int HY_NP = 16384;
__device__ __forceinline__ int hy_kvrow(int m) { return m < HY_NP ? m : HY_NP + ((m - HY_NP) >> 6) * 1088 + 1024 + ((m - HY_NP) & 63); }

struct EpiIn {
    static constexpr bool PERM = true, AFTER_DRAIN = false;
    float* LAT; bf16_t* SBQ; bf16_t* SBK; bf16_t* SBV; float* outK_p; float* outV_p; float* outK_s; float* outV_s; float qscale;
    const float* ssq; float eps;
    __device__ __forceinline__ void operator()(const f32x4 (&acc)[2][2][4][2], const Unit& u, int wr, int wc, int fr, int fq) const {
        const int row0 = u.pm * BM + wr * 64 + fr, colw = wc * 32 + 8 * fq, pn = u.pn;
        float rs[2][4];
#pragma unroll
        for (int ai = 0; ai < 2; ++ai)
#pragma unroll
            for (int m = 0; m < 4; ++m) rs[ai][m] = ssq ? 1.0f / sqrtf(__hip_atomic_load(ssq + row0 + ai * HALF + m * 16, __ATOMIC_RELAXED, __HIP_MEMORY_SCOPE_AGENT) * (1.f / 4096.f) + eps) : 1.0f;
        if (pn < 7) {
#pragma unroll
            for (int ai = 0; ai < 2; ++ai)
#pragma unroll
                for (int m = 0; m < 4; ++m) { float* rp = LAT + (size_t)(row0 + ai * HALF + m * 16) * 1792 + pn * BM + colw;
#pragma unroll
                    for (int bj = 0; bj < 2; ++bj) { *(f32x4*)(rp + bj * HALF) = acc[ai][bj][m][0] * rs[ai][m]; *(f32x4*)(rp + bj * HALF + 4) = acc[ai][bj][m][1] * rs[ai][m]; } }
        } else if (pn < 15) {
#pragma unroll
            for (int ai = 0; ai < 2; ++ai)
#pragma unroll
                for (int m = 0; m < 4; ++m) { bf16_t* rp = SBQ + (size_t)(row0 + ai * HALF + m * 16) * 2048 + (pn - 7) * BM + colw;
#pragma unroll
                    for (int bj = 0; bj < 2; ++bj) { const float sc = qscale * rs[ai][m]; const f32x4 v0 = acc[ai][bj][m][0] * sc, v1 = acc[ai][bj][m][1] * sc;
                        u32x4 w; w.x = cvt_pk_bf16(v0[0], v0[1]); w.y = cvt_pk_bf16(v0[2], v0[3]); w.z = cvt_pk_bf16(v1[0], v1[1]); w.w = cvt_pk_bf16(v1[2], v1[3]);
                        *(u32x4*)(rp + bj * HALF) = w; } }
        } else {
            const bool isv = pn >= 23; const int c0 = (pn - (isv ? 23 : 15)) * BM + colw;
            float* fop = isv ? outV_p : outK_p; float* fos = isv ? outV_s : outK_s;
#pragma unroll
            for (int ai = 0; ai < 2; ++ai)
#pragma unroll
                for (int m = 0; m < 4; ++m) { const int row = row0 + ai * HALF + m * 16;
                    float* fo = (row < HY_NP) ? fop + (size_t)row * 2048 : fos + (size_t)(row - HY_NP) * 2048;
                    fo += c0;
#pragma unroll
                    for (int bj = 0; bj < 2; ++bj) { __builtin_nontemporal_store(acc[ai][bj][m][0] * rs[ai][m], (f32x4*)(fo + bj * HALF)); __builtin_nontemporal_store(acc[ai][bj][m][1] * rs[ai][m], (f32x4*)(fo + bj * HALF + 4)); } }
        }
    }
};
struct EpiF32 {
    static constexpr bool PERM = false, AFTER_DRAIN = false;
    float* C; int ldc;
    __device__ __forceinline__ void operator()(const f32x4 (&acc)[2][2][4][2], const Unit& u, int wr, int wc, int fr, int fq) const {
        const int row0 = u.pm * BM + wr * 64 + fr, col0 = u.pn * BM + wc * 32 + 4 * fq;
#pragma unroll
        for (int ai = 0; ai < 2; ++ai)
#pragma unroll
            for (int m = 0; m < 4; ++m) { float* rowp = C + (size_t)(row0 + ai * HALF + m * 16) * ldc + col0;
#pragma unroll
                for (int bj = 0; bj < 2; ++bj)
#pragma unroll
                    for (int n = 0; n < 2; ++n) *(f32x4*)(rowp + bj * HALF + n * 16) = acc[ai][bj][m][n]; }
    }
};
struct EpiKvb {
    static constexpr bool PERM = true, AFTER_DRAIN = false;
    float* KNRAW; bf16_t* VB;
    __device__ __forceinline__ void operator()(const f32x4 (&acc)[2][2][4][2], const Unit& u, int wr, int wc, int fr, int fq) const {
        const int row0 = u.pm * BM + wr * 64 + fr, colw = wc * 32 + 8 * fq, pn = u.pn;
        if (pn < 8) {
#pragma unroll
            for (int ai = 0; ai < 2; ++ai)
#pragma unroll
                for (int m = 0; m < 4; ++m) { float* rp = KNRAW + (size_t)(row0 + ai * HALF + m * 16) * 2048 + pn * BM + colw;
#pragma unroll
                    for (int bj = 0; bj < 2; ++bj) { *(f32x4*)(rp + bj * HALF) = acc[ai][bj][m][0]; *(f32x4*)(rp + bj * HALF + 4) = acc[ai][bj][m][1]; } }
        } else {
#pragma unroll
            for (int ai = 0; ai < 2; ++ai)
#pragma unroll
                for (int m = 0; m < 4; ++m) { bf16_t* rp = VB + (size_t)(row0 + ai * HALF + m * 16) * 2048 + (pn - 8) * BM + colw;
#pragma unroll
                    for (int bj = 0; bj < 2; ++bj) { const f32x4 v0 = acc[ai][bj][m][0], v1 = acc[ai][bj][m][1];
                        u32x4 w; w.x = cvt_pk_bf16(v0[0], v0[1]); w.y = cvt_pk_bf16(v0[2], v0[3]); w.z = cvt_pk_bf16(v1[0], v1[1]); w.w = cvt_pk_bf16(v1[2], v1[3]);
                        *(u32x4*)(rp + bj * HALF) = w; } }
        }
    }
};
struct EpiRes {
    static constexpr bool PERM = false, AFTER_DRAIN = false;
    const float* resP; const float* resS; float* out;
    __device__ __forceinline__ void operator()(const f32x4 (&acc)[2][2][4][2], const Unit& u, int wr, int wc, int fr, int fq) const {
        const int row0 = u.pm * BM + wr * 64 + fr, col0 = u.pn * BM + wc * 32 + 4 * fq;
        const bool samp = u.pm >= HY_NP / BM;
#pragma unroll
        for (int ai = 0; ai < 2; ++ai)
#pragma unroll
            for (int m = 0; m < 4; ++m) { const int row = row0 + ai * HALF + m * 16;
                const float* rp = samp ? resS + (size_t)(row - HY_NP) * 4096 + col0 : resP + (size_t)row * 4096 + col0;
                float* op = out + (size_t)row * 4096 + col0;
#pragma unroll
                for (int bj = 0; bj < 2; ++bj)
#pragma unroll
                    for (int n = 0; n < 2; ++n) { const f32x4 r = *(const f32x4*)(rp + bj * HALF + n * 16); *(f32x4*)(op + bj * HALF + n * 16) = r + acc[ai][bj][m][n]; } }
    }
};
struct EpiRelu2 {
    static constexpr bool PERM = true, AFTER_DRAIN = false;
    bf16_t* O; int ldc;
    __device__ __forceinline__ void operator()(const f32x4 (&acc)[2][2][4][2], const Unit& u, int wr, int wc, int fr, int fq) const {
        const int row0 = u.pm * BM + wr * 64 + fr, col0 = u.pn * BM + wc * 32 + 8 * fq;
#pragma unroll
        for (int ai = 0; ai < 2; ++ai)
#pragma unroll
            for (int m = 0; m < 4; ++m) { bf16_t* rowp = O + (size_t)(row0 + ai * HALF + m * 16) * ldc + col0;
#pragma unroll
                for (int bj = 0; bj < 2; ++bj) { f32x4 v0 = acc[ai][bj][m][0], v1 = acc[ai][bj][m][1];
#pragma unroll
                    for (int e = 0; e < 4; ++e) { const float a = fmaxf(v0[e], 0.f), b = fmaxf(v1[e], 0.f); v0[e] = a * a; v1[e] = b * b; }
                    u32x4 w; w.x = cvt_pk_bf16(v0[0], v0[1]); w.y = cvt_pk_bf16(v0[2], v0[3]); w.z = cvt_pk_bf16(v1[0], v1[1]); w.w = cvt_pk_bf16(v1[2], v1[3]);
                    *(u32x4*)(rowp + bj * HALF) = w; } }
    }
};

typedef float f32x2e __attribute__((ext_vector_type(2)));
__device__ __forceinline__ void head_ssq_exchange(const f32x4 (&acc)[2][2][4][2], PG8_LAS float* P, int wr, int wc, int fr, int fq, float (&rstd)[2][4][2], float inv_n, float eps) {
#pragma unroll
    for (int ai = 0; ai < 2; ++ai)
#pragma unroll
        for (int m = 0; m < 4; ++m)
#pragma unroll
            for (int bj = 0; bj < 2; ++bj) {
                const f32x4 a = acc[ai][bj][m][0], b = acc[ai][bj][m][1];
                float s = ((a[0] * a[0] + a[1] * a[1]) + (a[2] * a[2] + a[3] * a[3])) + ((b[0] * b[0] + b[1] * b[1]) + (b[2] * b[2] + b[3] * b[3]));
                s += __shfl_xor(s, 16); s += __shfl_xor(s, 32);
                if (fq == 0) P[(ai * HALF + wr * 64 + m * 16 + fr) * 8 + bj * 4 + wc] = s;
            }
    asm volatile("s_waitcnt lgkmcnt(0)" ::: "memory"); __builtin_amdgcn_s_barrier(); asm volatile("" ::: "memory");
#pragma unroll
    for (int ai = 0; ai < 2; ++ai)
#pragma unroll
        for (int m = 0; m < 4; ++m)
#pragma unroll
            for (int bj = 0; bj < 2; ++bj) {
                const f32x4 p = *(const PG8_LAS f32x4*)(P + (ai * HALF + wr * 64 + m * 16 + fr) * 8 + bj * 4);
                rstd[ai][m][bj] = 1.0f / sqrtf(((p[0] + p[1]) + (p[2] + p[3])) * inv_n + eps);
            }
}
struct EpiQb {
    static constexpr bool PERM = true, AFTER_DRAIN = false;
    bf16_t* QB; const float* g_nope; const float* g_rope; const f32x2e* tab; PG8_LAS float* P; float qs, eps;
    __device__ __forceinline__ void operator()(const f32x4 (&acc)[2][2][4][2], const Unit& u, int wr, int wc, int fr, int fq) const {
        const int row0 = u.pm * BM + wr * 64 + fr, pn = u.pn;
        if (pn < 8) {
            float rstd[2][4][2]; head_ssq_exchange(acc, P, wr, wc, fr, fq, rstd, 1.f / 128.f, eps);
            const f32x4 g0 = *(const f32x4*)(g_nope + wc * 32 + 8 * fq) * qs, g1 = *(const f32x4*)(g_nope + wc * 32 + 8 * fq + 4) * qs;
#pragma unroll
            for (int ai = 0; ai < 2; ++ai)
#pragma unroll
                for (int m = 0; m < 4; ++m) { bf16_t* rp = QB + (size_t)(row0 + ai * HALF + m * 16) * 3072 + (2 * pn) * 192 + wc * 32 + 8 * fq;
#pragma unroll
                    for (int bj = 0; bj < 2; ++bj) { const float r = rstd[ai][m][bj]; const f32x4 v0 = acc[ai][bj][m][0] * g0 * r, v1 = acc[ai][bj][m][1] * g1 * r;
                        u32x4 w; w.x = cvt_pk_bf16(v0[0], v0[1]); w.y = cvt_pk_bf16(v0[2], v0[3]); w.z = cvt_pk_bf16(v1[0], v1[1]); w.w = cvt_pk_bf16(v1[2], v1[3]);
                        *(u32x4*)(rp + bj * 192) = w; } }
        } else {
            const int h = 4 * (pn - 8) + wc;
            const f32x4 ga0 = *(const f32x4*)(g_rope + 8 * fq), ga1 = *(const f32x4*)(g_rope + 8 * fq + 4), gb0 = *(const f32x4*)(g_rope + 32 + 8 * fq), gb1 = *(const f32x4*)(g_rope + 32 + 8 * fq + 4);
#pragma unroll
            for (int ai = 0; ai < 2; ++ai)
#pragma unroll
                for (int m = 0; m < 4; ++m) { const int row = row0 + ai * HALF + m * 16;
                    const f32x4 a0 = acc[ai][0][m][0], a1 = acc[ai][0][m][1], b0 = acc[ai][1][m][0], b1 = acc[ai][1][m][1];
                    float s = (((a0[0] * a0[0] + a0[1] * a0[1]) + (a0[2] * a0[2] + a0[3] * a0[3])) + ((a1[0] * a1[0] + a1[1] * a1[1]) + (a1[2] * a1[2] + a1[3] * a1[3])))
                            + (((b0[0] * b0[0] + b0[1] * b0[1]) + (b0[2] * b0[2] + b0[3] * b0[3])) + ((b1[0] * b1[0] + b1[1] * b1[1]) + (b1[2] * b1[2] + b1[3] * b1[3])));
                    s += __shfl_xor(s, 16); s += __shfl_xor(s, 32);
                    const float r = 1.0f / sqrtf(s * (1.f / 64.f) + eps);
                    const int pos = row < HY_NP ? (row & 4095) : 1024 + ((row - HY_NP) & 63);
                    const f32x4* tp = (const f32x4*)(tab + pos * 32 + 8 * fq);
                    const f32x4 t0 = tp[0], t1 = tp[1], t2 = tp[2], t3 = tp[3];
                    const f32x4 x10 = a0 * ga0 * r, x11 = a1 * ga1 * r, x20 = b0 * gb0 * r, x21 = b1 * gb1 * r;
                    const f32x4 c0 = {t0[0], t0[2], t1[0], t1[2]}, s0 = {t0[1], t0[3], t1[1], t1[3]}, c1 = {t2[0], t2[2], t3[0], t3[2]}, s1 = {t2[1], t2[3], t3[1], t3[3]};
                    const f32x4 o10 = (x10 * c0 - x20 * s0) * qs, o11 = (x11 * c1 - x21 * s1) * qs, o20 = (x10 * s0 + x20 * c0) * qs, o21 = (x11 * s1 + x21 * c1) * qs;
                    bf16_t* rp = QB + (size_t)row * 3072 + h * 192 + 128 + 8 * fq;
                    u32x4 w; w.x = cvt_pk_bf16(o10[0], o10[1]); w.y = cvt_pk_bf16(o10[2], o10[3]); w.z = cvt_pk_bf16(o11[0], o11[1]); w.w = cvt_pk_bf16(o11[2], o11[3]);
                    *(u32x4*)rp = w;
                    w.x = cvt_pk_bf16(o20[0], o20[1]); w.y = cvt_pk_bf16(o20[2], o20[3]); w.z = cvt_pk_bf16(o21[0], o21[1]); w.w = cvt_pk_bf16(o21[2], o21[3]);
                    *(u32x4*)(rp + 32) = w; }
        }
    }
};
struct EpiKvbN {
    static constexpr bool PERM = true, AFTER_DRAIN = false;
    bf16_t* KN; bf16_t* VB; const float* g_nope; PG8_LAS float* P; float eps;
    __device__ __forceinline__ void operator()(const f32x4 (&acc)[2][2][4][2], const Unit& u, int wr, int wc, int fr, int fq) const {
        const int row0 = u.pm * BM + wr * 64 + fr, colw = wc * 32 + 8 * fq, pn = u.pn;
        if (pn < 8) {
            float rstd[2][4][2]; head_ssq_exchange(acc, P, wr, wc, fr, fq, rstd, 1.f / 128.f, eps);
            const f32x4 g0 = *(const f32x4*)(g_nope + colw), g1 = *(const f32x4*)(g_nope + colw + 4);
#pragma unroll
            for (int ai = 0; ai < 2; ++ai)
#pragma unroll
                for (int m = 0; m < 4; ++m) { bf16_t* rp = KN + (size_t)(row0 + ai * HALF + m * 16) * 2048 + pn * BM + colw;
#pragma unroll
                    for (int bj = 0; bj < 2; ++bj) { const float r = rstd[ai][m][bj]; const f32x4 v0 = acc[ai][bj][m][0] * g0 * r, v1 = acc[ai][bj][m][1] * g1 * r;
                        u32x4 w; w.x = cvt_pk_bf16(v0[0], v0[1]); w.y = cvt_pk_bf16(v0[2], v0[3]); w.z = cvt_pk_bf16(v1[0], v1[1]); w.w = cvt_pk_bf16(v1[2], v1[3]);
                        *(u32x4*)(rp + bj * HALF) = w; } }
        } else {
#pragma unroll
            for (int ai = 0; ai < 2; ++ai)
#pragma unroll
                for (int m = 0; m < 4; ++m) { bf16_t* rp = VB + (size_t)(row0 + ai * HALF + m * 16) * 2048 + (pn - 8) * BM + colw;
#pragma unroll
                    for (int bj = 0; bj < 2; ++bj) { const f32x4 v0 = acc[ai][bj][m][0], v1 = acc[ai][bj][m][1];
                        u32x4 w; w.x = cvt_pk_bf16(v0[0], v0[1]); w.y = cvt_pk_bf16(v0[2], v0[3]); w.z = cvt_pk_bf16(v1[0], v1[1]); w.w = cvt_pk_bf16(v1[2], v1[3]);
                        *(u32x4*)(rp + bj * HALF) = w; } }
        }
    }
};

template <bool NORM> struct EpiResP {
    static constexpr bool PERM = true, AFTER_DRAIN = false, MIDK = NORM;
    const float* resP; const float* resS; float* out; bf16_t* HB; float* ssq; const float* ssqm; const float* ssqs; float eps;
    bf16_t* YB;
    __device__ __forceinline__ void mid(f32x4 (&acc)[2][2][4][2], const Unit& u, int wr, int wc, int fr, int fq) const {
        const int row0 = u.pm * BM + wr * 64 + fr;
#pragma unroll
        for (int ai = 0; ai < 2; ++ai)
#pragma unroll
            for (int m = 0; m < 4; ++m) { const int row = row0 + ai * HALF + m * 16;
                const float a = __hip_atomic_load(ssqm + row, __ATOMIC_RELAXED, __HIP_MEMORY_SCOPE_AGENT), b = __hip_atomic_load(ssqs + row, __ATOMIC_RELAXED, __HIP_MEMORY_SCOPE_AGENT);
                const float ratio = sqrtf((b * (1.f / 2048.f) + eps) / (a * (1.f / 2048.f) + eps));
#pragma unroll
                for (int bj = 0; bj < 2; ++bj) { acc[ai][bj][m][0] *= ratio; acc[ai][bj][m][1] *= ratio; } }
    }
    __device__ __forceinline__ void operator()(const f32x4 (&acc)[2][2][4][2], const Unit& u, int wr, int wc, int fr, int fq) const {
        const int row0 = u.pm * BM + wr * 64 + fr, col0 = u.pn * BM + wc * 32 + 8 * fq;
        const bool samp = u.pm >= HY_NP / BM;
#pragma unroll
        for (int ai = 0; ai < 2; ++ai)
#pragma unroll
            for (int m = 0; m < 4; ++m) { const int row = row0 + ai * HALF + m * 16;
                if (NORM) {
                    const float* rp = samp ? resS + (size_t)(row - HY_NP) * 4096 + col0 : resP + (size_t)row * 4096 + col0; float s = 0.f;
                    const bf16_t* yp = YB + (size_t)row * 4096 + col0;
                    const float rs = 1.0f / sqrtf(__hip_atomic_load(ssqs + row, __ATOMIC_RELAXED, __HIP_MEMORY_SCOPE_AGENT) * (1.f / 2048.f) + eps);
#pragma unroll
                    for (int bj = 0; bj < 2; ++bj) { f32x4 r0, r1;
                        if (YB) { const u32x4 h = *(const u32x4*)(yp + bj * HALF);
                            r0 = (f32x4){__uint_as_float(h.x << 16), __uint_as_float(h.x & 0xffff0000u), __uint_as_float(h.y << 16), __uint_as_float(h.y & 0xffff0000u)};
                            r1 = (f32x4){__uint_as_float(h.z << 16), __uint_as_float(h.z & 0xffff0000u), __uint_as_float(h.w << 16), __uint_as_float(h.w & 0xffff0000u)}; }
                        else { r0 = *(const f32x4*)(rp + bj * HALF); r1 = *(const f32x4*)(rp + bj * HALF + 4); }
                        const f32x4 v0 = r0 + acc[ai][bj][m][0] * rs, v1 = r1 + acc[ai][bj][m][1] * rs;
                        s += ((v0[0] * v0[0] + v0[1] * v0[1]) + (v0[2] * v0[2] + v0[3] * v0[3])) + ((v1[0] * v1[0] + v1[1] * v1[1]) + (v1[2] * v1[2] + v1[3] * v1[3]));
                        u32x4 w; w.x = cvt_pk_bf16(v0[0], v0[1]); w.y = cvt_pk_bf16(v0[2], v0[3]); w.z = cvt_pk_bf16(v1[0], v1[1]); w.w = cvt_pk_bf16(v1[2], v1[3]);
                        *(u32x4*)(HB + (size_t)row * 4096 + col0 + bj * HALF) = w; }
                    s += __shfl_xor(s, 16); s += __shfl_xor(s, 32);
                    if (fq == 0) __hip_atomic_fetch_add(ssq + row, s, __ATOMIC_RELAXED, __HIP_MEMORY_SCOPE_AGENT);
                } else {
                    const bf16_t* hp = HB + (size_t)row * 4096 + col0; float* op = out + (size_t)row * 4096 + col0; float s = 0.f;
#pragma unroll
                    for (int bj = 0; bj < 2; ++bj) { const u32x4 h = *(const u32x4*)(hp + bj * HALF);
                        const f32x4 r0 = {__uint_as_float(h.x << 16), __uint_as_float(h.x & 0xffff0000u), __uint_as_float(h.y << 16), __uint_as_float(h.y & 0xffff0000u)};
                        const f32x4 r1 = {__uint_as_float(h.z << 16), __uint_as_float(h.z & 0xffff0000u), __uint_as_float(h.w << 16), __uint_as_float(h.w & 0xffff0000u)};
                        const f32x4 y0 = r0 + acc[ai][bj][m][0], y1 = r1 + acc[ai][bj][m][1];
                        if (YB) { u32x4 w; w.x = cvt_pk_bf16(y0[0], y0[1]); w.y = cvt_pk_bf16(y0[2], y0[3]); w.z = cvt_pk_bf16(y1[0], y1[1]); w.w = cvt_pk_bf16(y1[2], y1[3]);
                                  *(u32x4*)(YB + (size_t)row * 4096 + col0 + bj * HALF) = w;
                                  s += ((y0[0] * y0[0] + y0[1] * y0[1]) + (y0[2] * y0[2] + y0[3] * y0[3])) + ((y1[0] * y1[0] + y1[1] * y1[1]) + (y1[2] * y1[2] + y1[3] * y1[3])); }
                        else { __builtin_nontemporal_store(y0, (f32x4*)(op + bj * HALF)); __builtin_nontemporal_store(y1, (f32x4*)(op + bj * HALF + 4)); } }
                    if (YB) { s += __shfl_xor(s, 16); s += __shfl_xor(s, 32);
                        if (fq == 0) __hip_atomic_fetch_add(ssq + row, s, __ATOMIC_RELAXED, __HIP_MEMORY_SCOPE_AGENT); }
                } }
    }
};
struct EpiRelu2N {
    static constexpr bool PERM = true, AFTER_DRAIN = false;
    bf16_t* O; int ldc; const float* ssq; float eps;
    __device__ __forceinline__ void operator()(const f32x4 (&acc)[2][2][4][2], const Unit& u, int wr, int wc, int fr, int fq) const {
        const int row0 = u.pm * BM + wr * 64 + fr;
        bf16_t* const tile0 = O + ((size_t)u.pm * (ldc >> 6) + u.pn * 4 + (wc >> 1)) * 16384 + (wc & 1) * 32 + 8 * fq;
#pragma unroll
        for (int ai = 0; ai < 2; ++ai)
#pragma unroll
            for (int m = 0; m < 4; ++m) { const int row = row0 + ai * HALF + m * 16; bf16_t* rowp = tile0 + (wr * 64 + fr + ai * HALF + m * 16) * 64;
                const float r = 1.0f / sqrtf(__hip_atomic_load(ssq + row, __ATOMIC_RELAXED, __HIP_MEMORY_SCOPE_AGENT) * (1.f / 4096.f) + eps);
#pragma unroll
                for (int bj = 0; bj < 2; ++bj) { f32x4 v0 = acc[ai][bj][m][0], v1 = acc[ai][bj][m][1];
#pragma unroll
                    for (int e = 0; e < 4; ++e) { const float a = fmaxf(v0[e], 0.f) * r, b = fmaxf(v1[e], 0.f) * r; v0[e] = a * a; v1[e] = b * b; }
                    u32x4 w; w.x = cvt_pk_bf16(v0[0], v0[1]); w.y = cvt_pk_bf16(v0[2], v0[3]); w.z = cvt_pk_bf16(v1[0], v1[1]); w.w = cvt_pk_bf16(v1[2], v1[3]);
                    *(u32x4*)(rowp + bj * 2 * 16384) = w; } }
    }
};
template <class T, class = void> struct has_midk { static constexpr bool value = false; };
template <class T> struct has_midk<T, typename std::enable_if<T::MIDK>::type> { static constexpr bool value = true; };
template <class Epi, class Sched, bool ALIGN_EPI = false, bool SP2 = false>
__device__ __forceinline__ void gemm_phase(PG8_LAS unsigned char* lds, const Gemm g, const Sched& S, const Epi& E) {
    int tid_o = threadIdx.x; asm volatile("" : "+v"(tid_o));
    const int tid = tid_o, wid = __builtin_amdgcn_readfirstlane(tid >> 6), lane = tid & 63, wr = wid >> 2, wc = wid & 3, fr = lane & 15, fq = lane >> 4;
    const int nt = g.K / BK, K = g.blocked ? BK : g.K;
    unsigned voffA[2], voffB[2];
#pragma unroll
    for (int i = 0; i < 2; ++i) { int R, C; stage_rc(tid * 16 + i * 8192, R, C); const int Rb = Epi::PERM ? ((R & ~31) + perm32(R & 31)) : R;
        voffA[i] = (unsigned)(R * K + C) * 2u; voffB[i] = (unsigned)(Rb * K + C) * 2u; }
    const size_t kstep = g.blocked ? (size_t)(BM * BK * 2) : (size_t)(BK * 2);
    const size_t hstep = (size_t)HALF * K * 2;
    const size_t tstep = (size_t)BM * g.K * 2;
    const unsigned ldsw = (unsigned)wid * 1024u;
    const int aoff = lds_byte(wr * 64 + fr, fq * 8), boff = lds_byte(wc * 32 + fr, fq * 8);
#define PG8_SA(b, h) (((b) * 2 + (h)) * HTB)
#define PG8_SB(b, h) ((4 + (b) * 2 + (h)) * HTB)
#define PG8_STAGE(bufoff, gbase, voff) do { _Pragma("unroll") for (int _i = 0; _i < 2; ++_i) \
        __builtin_amdgcn_global_load_lds((const unsigned*)((const char*)(gbase) + (voff)[_i]), (PG8_LAS unsigned*)(lds + (bufoff) + ldsw + _i * 8192), 16, 0, 0); } while (0)
#define PG8_LDA(dst, b, h) do { _Pragma("unroll") for (int m = 0; m < 4; ++m) _Pragma("unroll") for (int k = 0; k < 2; ++k) dst[m][k] = *(const PG8_LAS bf16x8*)(lds + PG8_SA(b, h) + aoff + m * 2048 + k * 1024); } while (0)
#define PG8_LDB(dst, b, h) do { _Pragma("unroll") for (int n = 0; n < 2; ++n) _Pragma("unroll") for (int k = 0; k < 2; ++k) dst[n][k] = *(const PG8_LAS bf16x8*)(lds + PG8_SB(b, h) + boff + n * 2048 + k * 1024); } while (0)
#define PG8_MMA(ai, bj, At, Bt) do { __builtin_amdgcn_s_setprio(1); _Pragma("unroll") for (int m = 0; m < 4; ++m) _Pragma("unroll") for (int n = 0; n < 2; ++n) _Pragma("unroll") for (int k = 0; k < 2; ++k) \
        acc[ai][bj][m][n] = __builtin_amdgcn_mfma_f32_16x16x32_bf16(Bt[n][k], At[m][k], acc[ai][bj][m][n], 0, 0, 0); __builtin_amdgcn_s_setprio(0); } while (0)
#define PG8_WAIT_V(n) asm volatile("s_waitcnt vmcnt(" #n ")" ::: "memory")
#define PG8_WAIT_L(n) asm volatile("s_waitcnt lgkmcnt(" #n ")" ::: "memory")
#define PG8_BAR __builtin_amdgcn_s_barrier()
#define PG8_SCHED __builtin_amdgcn_sched_barrier(0)
    Unit cur, nxt; int ui = 0;
    if (!S.next(0, cur)) return;
    f32x4 acc[2][2][4][2];
#pragma unroll
    for (int a = 0; a < 2; ++a)
#pragma unroll
        for (int b = 0; b < 2; ++b)
#pragma unroll
            for (int m = 0; m < 4; ++m)
#pragma unroll
                for (int n = 0; n < 2; ++n) acc[a][b][m][n] = (f32x4){0.f, 0.f, 0.f, 0.f};
    bf16x8 At[4][2], B0[2][2], B1[2][2];
    const char* cA = (const char*)g.A + (size_t)cur.pm * tstep + (size_t)cur.kt0 * kstep; const char* cB = (const char*)g.Bt + (size_t)cur.pn * tstep + (size_t)cur.kt0 * kstep;
    int cnt = cur.nkt ? cur.nkt : nt;
    S.a_ready(cur);
    if constexpr (SP2) {
        PG8_STAGE(PG8_SB(0, 0), cB, voffB); PG8_STAGE(PG8_SB(0, 1), cB + hstep, voffB); PG8_STAGE(PG8_SA(0, 0), cA, voffA); PG8_STAGE(PG8_SA(0, 1), cA + hstep, voffA);
        if (wr == 1) PG8_BAR;
        PG8_WAIT_V(2); PG8_BAR;
        PG8_STAGE(PG8_SB(1, 0), cB + kstep, voffB); PG8_STAGE(PG8_SA(1, 0), cA + kstep, voffA); PG8_STAGE(PG8_SB(1, 1), cB + hstep + kstep, voffB);
        PG8_WAIT_V(6); PG8_BAR;
    } else {
        PG8_STAGE(PG8_SB(0, 0), cB, voffB); PG8_STAGE(PG8_SA(0, 0), cA, voffA); PG8_STAGE(PG8_SB(0, 1), cB + hstep, voffB); PG8_STAGE(PG8_SA(0, 1), cA + hstep, voffA);
        if (wr == 1) PG8_BAR;
        PG8_WAIT_V(4); PG8_BAR;
        PG8_STAGE(PG8_SB(1, 0), cB + kstep, voffB); PG8_STAGE(PG8_SA(1, 0), cA + kstep, voffA); PG8_STAGE(PG8_SB(1, 1), cB + hstep + kstep, voffB);
        PG8_WAIT_V(6); PG8_BAR;
    }
    for (;;) {
        const bool has_next = S.next(ui + 1, nxt);
        const char* nA = has_next ? (const char*)g.A + (size_t)nxt.pm * tstep + (size_t)nxt.kt0 * kstep : cA; const char* nB = has_next ? (const char*)g.Bt + (size_t)nxt.pn * tstep + (size_t)nxt.kt0 * kstep : cB;
        for (int t = 0; t < cnt; t += 2) {
            const bool last = (t == cnt - 2);
            const char* a1 = cA + (size_t)(t + 1) * kstep;
            const char* a2 = last ? nA : cA + (size_t)(t + 2) * kstep; const char* b2 = last ? nB : cB + (size_t)(t + 2) * kstep;
            const char* a3 = a2 + kstep; const char* b3 = b2 + kstep;
            if (last && has_next) S.a_ready(nxt);
            if constexpr (SP2) {
            PG8_LDB(B0, 0, 0); PG8_LDB(B1, 0, 1); PG8_SCHED; PG8_LDA(At, 0, 0); PG8_STAGE(PG8_SA(1, 1), a1 + hstep, voffA);
            PG8_WAIT_V(8); PG8_WAIT_L(0); PG8_BAR; PG8_MMA(0, 0, At, B0); PG8_MMA(0, 1, At, B1); PG8_BAR; PG8_SCHED;
            PG8_LDA(At, 0, 1); PG8_STAGE(PG8_SB(0, 0), b2, voffB); PG8_STAGE(PG8_SB(0, 1), b2 + hstep, voffB); PG8_STAGE(PG8_SA(0, 0), a2, voffA);
            PG8_WAIT_V(8); PG8_WAIT_L(0); PG8_BAR; PG8_MMA(1, 0, At, B0); PG8_MMA(1, 1, At, B1); PG8_BAR; PG8_SCHED;
            PG8_LDB(B0, 1, 0); PG8_LDB(B1, 1, 1); PG8_SCHED; PG8_LDA(At, 1, 0); PG8_STAGE(PG8_SA(0, 1), a2 + hstep, voffA);
            PG8_WAIT_V(8); PG8_WAIT_L(0); PG8_BAR; PG8_MMA(0, 0, At, B0); PG8_MMA(0, 1, At, B1); PG8_BAR; PG8_SCHED;
            PG8_LDA(At, 1, 1); PG8_STAGE(PG8_SB(1, 0), b3, voffB); PG8_STAGE(PG8_SB(1, 1), b3 + hstep, voffB); PG8_STAGE(PG8_SA(1, 0), a3, voffA);
            PG8_WAIT_V(8); PG8_WAIT_L(0); PG8_BAR; PG8_MMA(1, 0, At, B0); PG8_MMA(1, 1, At, B1); PG8_BAR; PG8_SCHED;
            } else {
            PG8_LDB(B0, 0, 0); PG8_SCHED; PG8_LDA(At, 0, 0); PG8_STAGE(PG8_SA(1, 1), a1 + hstep, voffA);
            PG8_WAIT_L(8); PG8_BAR; PG8_WAIT_L(0); PG8_MMA(0, 0, At, B0); PG8_BAR; PG8_SCHED;
            PG8_LDB(B1, 0, 1); PG8_STAGE(PG8_SB(0, 0), b2, voffB);
            PG8_BAR; PG8_WAIT_L(0); PG8_MMA(0, 1, At, B1); PG8_BAR;
            PG8_LDA(At, 0, 1); PG8_STAGE(PG8_SA(0, 0), a2, voffA);
            PG8_BAR; PG8_WAIT_L(0); PG8_MMA(1, 0, At, B0); PG8_BAR; PG8_SCHED;
            PG8_STAGE(PG8_SB(0, 1), b2 + hstep, voffB);
            PG8_WAIT_V(6); PG8_BAR; PG8_MMA(1, 1, At, B1); PG8_BAR;
            PG8_LDB(B0, 1, 0); PG8_SCHED; PG8_LDA(At, 1, 0); PG8_STAGE(PG8_SA(0, 1), a2 + hstep, voffA);
            PG8_WAIT_L(8); PG8_BAR; PG8_WAIT_L(0); PG8_MMA(0, 0, At, B0); PG8_BAR; PG8_SCHED;
            PG8_LDB(B1, 1, 1); PG8_STAGE(PG8_SB(1, 0), b3, voffB);
            PG8_BAR; PG8_WAIT_L(0); PG8_MMA(0, 1, At, B1); PG8_BAR;
            PG8_LDA(At, 1, 1); PG8_STAGE(PG8_SA(1, 0), a3, voffA);
            PG8_BAR; PG8_WAIT_L(0); PG8_MMA(1, 0, At, B0); PG8_BAR; PG8_SCHED;
            PG8_STAGE(PG8_SB(1, 1), b3 + hstep, voffB);
            PG8_WAIT_V(6); PG8_BAR; PG8_MMA(1, 1, At, B1); PG8_BAR;
            }
        }
        if constexpr (ALIGN_EPI) { if (wr == 0) PG8_BAR; }
        if constexpr (!Epi::AFTER_DRAIN) {
            if (cur.part == -2) { if constexpr (has_midk<Epi>::value) E.mid(acc, cur, wr, wc, fr, fq); }
            else if (cur.part >= 0) {
                f32x4* sp = (f32x4*)(g.slab + (size_t)cur.part * 65536) + (size_t)wid * 2048 + lane;
#pragma unroll
                for (int a = 0; a < 2; ++a)
#pragma unroll
                    for (int b = 0; b < 2; ++b)
#pragma unroll
                        for (int m = 0; m < 4; ++m)
#pragma unroll
                            for (int n = 0; n < 2; ++n) sp[(((a * 2 + b) * 4 + m) * 2 + n) * 64] = acc[a][b][m][n];
            } else E(acc, cur, wr, wc, fr, fq);
            S.done(cur); }
        if (!has_next) break;
        if (cur.part != -2) {
#pragma unroll
        for (int a = 0; a < 2; ++a)
#pragma unroll
            for (int b = 0; b < 2; ++b)
#pragma unroll
                for (int m = 0; m < 4; ++m)
#pragma unroll
                    for (int n = 0; n < 2; ++n) acc[a][b][m][n] = (f32x4){0.f, 0.f, 0.f, 0.f};
        }
        cur = nxt; cA = nA; cB = nB; ++ui; cnt = cur.nkt ? cur.nkt : nt;
        if constexpr (ALIGN_EPI) { if (wr == 1) PG8_BAR; }
    }
    PG8_WAIT_V(0);
    if constexpr (!ALIGN_EPI) { if (wr == 0) PG8_BAR; }
    PG8_BAR;
    if constexpr (Epi::AFTER_DRAIN) { E.fused(acc, cur, wr, wc, fr, fq, lds, wid, lane); S.done(cur); }
#undef PG8_SA
#undef PG8_SB
#undef PG8_STAGE
#undef PG8_LDA
#undef PG8_LDB
#undef PG8_MMA
#undef PG8_WAIT_V
#undef PG8_WAIT_L
#undef PG8_BAR
#undef PG8_SCHED
}
}
namespace att {
typedef short bf16x8 __attribute__((ext_vector_type(8)));
typedef short s16x4 __attribute__((ext_vector_type(4)));
typedef float f32x16 __attribute__((ext_vector_type(16)));
typedef unsigned u32x4 __attribute__((ext_vector_type(4)));
typedef float f32x4 __attribute__((ext_vector_type(4)));
typedef unsigned short bf16;
#define ALAS __attribute__((address_space(3)))
#ifndef ATT_SSQ_ATOMICS
#define ATT_SSQ_ATOMICS 0
#endif
constexpr int OFF_V = 0, OFF_K = 32768, OFF_R = 65536, OFF_WS = 81920, OFF_FLG = 81920 + 8 * 256, ATT_LDS_BYTES = OFF_FLG + 64;
constexpr float SB_DEAD = -150.f;
#define KSWZ(row, colB) ((row) * 256 + ((colB) ^ (((row) & 15) << 4)))
#define RSWZ(row, colB) ((row) * 128 + ((colB) ^ ((((row) >> 1) & 7) << 4)))
__device__ __forceinline__ int v_st(int k, int c) { const int kk = (k & ~0xC) | ((k & 4) << 1) | ((k & 8) >> 1); return ((kk >> 3) * 4 + (c >> 5)) * 512 + ((kk & 7) * 32 + (c & 31)) * 2; }
__device__ __forceinline__ int v_rd_base(int lane) { return ((lane & 3) << 3) | (((lane >> 2) & 3) << 6) | (((lane >> 4) & 1) << 5) | (((lane >> 5) & 1) << 8); }
__device__ __forceinline__ int crow(int r, int hi) { return (r & 3) + 8 * (r >> 2) + 4 * hi; }
__device__ __forceinline__ unsigned cvtpk(float lo, float hi) { unsigned r; asm volatile("v_cvt_pk_bf16_f32 %0, %1, %2" : "=v"(r) : "v"(lo), "v"(hi)); return r; }

struct Unit { const bf16* Q; int ldq; const bf16* K; const bf16* Kr; const bf16* V; bf16* O; int ldo; float* ssq; int P0; int NT; int nact;
              const float* Kf0; const float* Vf0; const float* Kf1; const float* Vf1; int split; };

__device__ __forceinline__ void qk128(f32x16& p0, f32x16& p1, ALAS const char* Kt, int r32, int hi, const bf16x8* qr) {
#pragma unroll
    for (int d0 = 0; d0 < 8; ++d0) { ALAS const char* a = Kt + KSWZ(r32, (d0 * 16 + hi * 8) * 2);
        const bf16x8 b0 = *(ALAS const bf16x8*)a; const bf16x8 b1 = *(ALAS const bf16x8*)(a + 32 * 256);
        p0 = __builtin_amdgcn_mfma_f32_32x32x16_bf16(b0, qr[d0], p0, 0, 0, 0);
        p1 = __builtin_amdgcn_mfma_f32_32x32x16_bf16(b1, qr[d0], p1, 0, 0, 0); }
}
__device__ __forceinline__ void qk64(f32x16& p0, f32x16& p1, ALAS const char* Kt, int r32, int hi, const bf16x8* qr) {
#pragma unroll
    for (int d0 = 0; d0 < 4; ++d0) { ALAS const char* a = Kt + RSWZ(r32, (d0 * 16 + hi * 8) * 2);
        const bf16x8 b0 = *(ALAS const bf16x8*)a; const bf16x8 b1 = *(ALAS const bf16x8*)(a + 32 * 128);
        p0 = __builtin_amdgcn_mfma_f32_32x32x16_bf16(b0, qr[d0], p0, 0, 0, 0);
        p1 = __builtin_amdgcn_mfma_f32_32x32x16_bf16(b1, qr[d0], p1, 0, 0, 0); }
}
__device__ __forceinline__ void pv_tile(f32x16* o, unsigned vb0, bf16x8 pa0, bf16x8 pa1, bf16x8 pa2, bf16x8 pa3) {
#define TRRD(dst, off) asm volatile("ds_read_b64_tr_b16 %0, %1 offset:%2" : "=&v"(dst) : "v"(vb0), "i"(off) : "memory")
#define PV_LD(S, d0) do { constexpr int b_ = (d0) * 512; \
        TRRD(S##l0, b_); TRRD(S##h0, b_ + 2048); TRRD(S##l1, b_ + 4096); TRRD(S##h1, b_ + 6144); TRRD(S##l2, b_ + 8192); TRRD(S##h2, b_ + 10240); TRRD(S##l3, b_ + 12288); TRRD(S##h3, b_ + 14336); } while (0)
#define PV_MM(S, d0) do { \
        o[d0] = __builtin_amdgcn_mfma_f32_32x32x16_bf16(pa0, (bf16x8){S##l0[0], S##l0[1], S##l0[2], S##l0[3], S##h0[0], S##h0[1], S##h0[2], S##h0[3]}, o[d0], 0, 0, 0); \
        o[d0] = __builtin_amdgcn_mfma_f32_32x32x16_bf16(pa1, (bf16x8){S##l1[0], S##l1[1], S##l1[2], S##l1[3], S##h1[0], S##h1[1], S##h1[2], S##h1[3]}, o[d0], 0, 0, 0); \
        o[d0] = __builtin_amdgcn_mfma_f32_32x32x16_bf16(pa2, (bf16x8){S##l2[0], S##l2[1], S##l2[2], S##l2[3], S##h2[0], S##h2[1], S##h2[2], S##h2[3]}, o[d0], 0, 0, 0); \
        o[d0] = __builtin_amdgcn_mfma_f32_32x32x16_bf16(pa3, (bf16x8){S##l3[0], S##l3[1], S##l3[2], S##l3[3], S##h3[0], S##h3[1], S##h3[2], S##h3[3]}, o[d0], 0, 0, 0); } while (0)
#define PV_WAIT(n) do { asm volatile("s_waitcnt lgkmcnt(" #n ")" ::: "memory"); __builtin_amdgcn_sched_barrier(0); } while (0)
    s16x4 Al0, Al1, Al2, Al3, Ah0, Ah1, Ah2, Ah3, Bl0, Bl1, Bl2, Bl3, Bh0, Bh1, Bh2, Bh3;
    PV_LD(A, 0); PV_LD(B, 1); PV_WAIT(8); PV_MM(A, 0);
    __builtin_amdgcn_sched_barrier(0); PV_LD(A, 2); PV_WAIT(8); PV_MM(B, 1);
    __builtin_amdgcn_sched_barrier(0); PV_LD(B, 3); PV_WAIT(8); PV_MM(A, 2);
    PV_WAIT(0); PV_MM(B, 3);
#undef PV_WAIT
#undef PV_MM
#undef PV_LD
#undef TRRD
}
#define PK4(P, B_, OUT) do { const unsigned a0_ = cvtpk(P[B_ + 0], P[B_ + 1]), a1_ = cvtpk(P[B_ + 2], P[B_ + 3]); \
        const unsigned b0_ = cvtpk(P[B_ + 4], P[B_ + 5]), b1_ = cvtpk(P[B_ + 6], P[B_ + 7]); \
        auto r0_ = __builtin_amdgcn_permlane32_swap(a0_, b0_, false, false); auto r1_ = __builtin_amdgcn_permlane32_swap(a1_, b1_, false, false); \
        u32x4 w_ = {r0_[0], r1_[0], r0_[1], r1_[1]}; OUT = __builtin_bit_cast(bf16x8, w_); } while (0)

__device__ __forceinline__ void store_o_staged(const f32x16* o, const float* rli, bf16* Ow, int ldo, ALAS char* stg, int lane, int r32, int hi, float* ssqp) {
    ALAS unsigned short* s16 = (ALAS unsigned short*)stg;
#pragma unroll
    for (int r = 0; r < 16; ++r) { const int orow = crow(r, hi);
#pragma unroll
        for (int d0 = 0; d0 < 4; ++d0) { const float v = o[d0][r] * rli[r]; s16[orow * 128 + d0 * 32 + r32] = (unsigned short)cvtpk(v, v); } }
    asm volatile("s_waitcnt lgkmcnt(0)" ::: "memory");
#pragma unroll
    for (int i = 0; i < 8; ++i) { const int idx = i * 64 + lane, row = idx >> 4, ch = idx & 15;
        const u32x4 w = *(ALAS const u32x4*)(stg + row * 256 + ch * 16);
        *(u32x4*)(Ow + (size_t)row * ldo + ch * 8) = w;
        float s = 0.f; { const unsigned ww[4] = {w.x, w.y, w.z, w.w};
#pragma unroll
            for (int e = 0; e < 4; ++e) { const float x0 = __uint_as_float(ww[e] << 16), x1 = __uint_as_float(ww[e] & 0xffff0000u); s += x0 * x0 + x1 * x1; } }
        s += __shfl_xor(s, 1); s += __shfl_xor(s, 2); s += __shfl_xor(s, 4); s += __shfl_xor(s, 8);
        if (ch == 0) ssqp[(size_t)row * 32] = s; }
}
template <bool MLA>
__device__ __forceinline__ void attn_unit(const Unit u, ALAS char* lds) {
    int tid_o = threadIdx.x; asm volatile("" : "+v"(tid_o));
    const int tid = tid_o, wid = __builtin_amdgcn_readfirstlane(tid >> 6), lane = tid & 63, r32 = lane & 31, hi = lane >> 5;
    const bool actw = wid < u.nact;
    const int sr = tid >> 4, sc = (tid & 15) * 8;
    const int vst0 = v_st(sr, sc), vst1 = v_st(32 + sr, sc), kws = KSWZ(sr, sc * 2);
    const int rk = tid >> 3, rc = (tid & 7) * 8, rws = RSWZ(rk, rc * 2);
    ALAS char* V_l = lds + OFF_V; ALAS char* K_l = lds + OFF_K; ALAS char* R_l = lds + OFF_R;
    ALAS float* al_l = (ALAS float*)(lds + OFF_WS) + wid * 64; ALAS float* li_l = al_l + 32;
    const unsigned vbase = (unsigned)(uintptr_t)V_l + (unsigned)v_rd_base(lane);
    constexpr int NQ = MLA ? 12 : 8;
    bf16x8 qr[NQ];
#pragma unroll
    for (int d0 = 0; d0 < NQ; ++d0) qr[d0] = (bf16x8){0, 0, 0, 0, 0, 0, 0, 0};
    if (actw) {
#pragma unroll
        for (int d0 = 0; d0 < NQ; ++d0) qr[d0] = *(const bf16x8*)(u.Q + (size_t)(wid * 32 + r32) * u.ldq + d0 * 16 + hi * 8);
    }
    const int cw = (u.P0 + wid * 32) >> 6;
    const int qpos = u.P0 + wid * 32 + r32;
    float m_reg = -1e30f, l_reg = 0.f, carry = 0.f; bool fin = false;
    ALAS unsigned* flg = (ALAS unsigned*)(lds + OFF_FLG);
    f32x16 o[4];
#pragma unroll
    for (int d = 0; d < 4; ++d)
#pragma unroll
        for (int r = 0; r < 16; ++r) o[d][r] = 0.f;
    bf16x8 st_k0, st_k1, st_v0, st_v1, st_r = (bf16x8){0, 0, 0, 0, 0, 0, 0, 0};
    f32x4 fk[4], fv[4];
#define LOADT(tt) do { if (!MLA) { const int t_ = (tt); const bool lo_ = t_ < u.split; const size_t ro_ = (size_t)(lo_ ? t_ : t_ - u.split) * 64 * 2048; \
            const float* kb_ = (lo_ ? u.Kf0 : u.Kf1) + ro_ + (size_t)sr * 2048 + sc; const float* vb_ = (lo_ ? u.Vf0 : u.Vf1) + ro_ + (size_t)sr * 2048 + sc; \
            fk[0] = *(const f32x4*)kb_; fk[1] = *(const f32x4*)(kb_ + 4); fk[2] = *(const f32x4*)(kb_ + 32 * 2048); fk[3] = *(const f32x4*)(kb_ + 32 * 2048 + 4); \
            fv[0] = *(const f32x4*)vb_; fv[1] = *(const f32x4*)(vb_ + 4); fv[2] = *(const f32x4*)(vb_ + 32 * 2048); fv[3] = *(const f32x4*)(vb_ + 32 * 2048 + 4); } else { \
        const size_t r0_ = (size_t)(tt) * 64; \
        st_k0 = *(const bf16x8*)(u.K + (r0_ + sr) * 2048 + sc); st_k1 = *(const bf16x8*)(u.K + (r0_ + 32 + sr) * 2048 + sc); \
        st_v0 = *(const bf16x8*)(u.V + (r0_ + sr) * 2048 + sc); st_v1 = *(const bf16x8*)(u.V + (r0_ + 32 + sr) * 2048 + sc); \
        if (MLA) st_r = *(const bf16x8*)(u.Kr + (r0_ + rk) * 64 + rc); } } while (0)
    LOADT(MLA ? 0 : (u.NT - 1));
    for (int i = 0; i < u.NT; ++i) {
        const int t = MLA ? i : (u.NT - 1 - i); const int buf = i & 1;
        if (!MLA) { u32x4 w_;
            w_ = (u32x4){cvtpk(fk[0][0], fk[0][1]), cvtpk(fk[0][2], fk[0][3]), cvtpk(fk[1][0], fk[1][1]), cvtpk(fk[1][2], fk[1][3])}; st_k0 = __builtin_bit_cast(bf16x8, w_);
            w_ = (u32x4){cvtpk(fk[2][0], fk[2][1]), cvtpk(fk[2][2], fk[2][3]), cvtpk(fk[3][0], fk[3][1]), cvtpk(fk[3][2], fk[3][3])}; st_k1 = __builtin_bit_cast(bf16x8, w_);
            w_ = (u32x4){cvtpk(fv[0][0], fv[0][1]), cvtpk(fv[0][2], fv[0][3]), cvtpk(fv[1][0], fv[1][1]), cvtpk(fv[1][2], fv[1][3])}; st_v0 = __builtin_bit_cast(bf16x8, w_);
            w_ = (u32x4){cvtpk(fv[2][0], fv[2][1]), cvtpk(fv[2][2], fv[2][3]), cvtpk(fv[3][0], fv[3][1]), cvtpk(fv[3][2], fv[3][3])}; st_v1 = __builtin_bit_cast(bf16x8, w_); }
        *(ALAS bf16x8*)(K_l + buf * 16384 + kws) = st_k0; *(ALAS bf16x8*)(K_l + buf * 16384 + kws + 32 * 256) = st_k1;
        *(ALAS bf16x8*)(V_l + buf * 16384 + vst0) = st_v0; *(ALAS bf16x8*)(V_l + buf * 16384 + vst1) = st_v1;
        if (MLA) *(ALAS bf16x8*)(R_l + buf * 8192 + rws) = st_r;
        if (!MLA) { if (lane == 0) flg[buf * 8 + wid] = (fin || !actw) ? 1u : 0u; }
        __syncthreads();
        if (!MLA) {
            const u32x4 fa = *(ALAS const u32x4*)(flg + buf * 8), fb = *(ALAS const u32x4*)(flg + buf * 8 + 4);
            if ((fa.x & fa.y & fa.z & fa.w & fb.x & fb.y & fb.z & fb.w) != 0u) break;
        }
        if (i + 1 < u.NT) LOADT(MLA ? (i + 1) : (u.NT - 2 - i));
        if (actw && t <= cw && !fin) {
            f32x16 p0, p1;
#pragma unroll
            for (int r = 0; r < 16; ++r) { p0[r] = 0.f; p1[r] = 0.f; }
            qk128(p0, p1, K_l + buf * 16384, r32, hi, qr);
            if (MLA) qk64(p0, p1, R_l + buf * 8192, r32, hi, qr + (MLA ? 8 : 0));
            bf16x8 pa0, pa1, pa2, pa3;
            if (MLA) {
                float pmax = p0[0];
#pragma unroll
                for (int r = 1; r < 16; ++r) pmax = fmaxf(pmax, p0[r]);
#pragma unroll
                for (int r = 0; r < 16; ++r) pmax = fmaxf(pmax, p1[r]);
                { auto rr = __builtin_amdgcn_permlane32_swap(__float_as_uint(pmax), __float_as_uint(pmax), false, false);
                  pmax = fmaxf(__uint_as_float(rr[0]), __uint_as_float(rr[1])); }
                const float mn = fmaxf(m_reg, pmax); const float alpha = __builtin_amdgcn_exp2f(m_reg - mn); m_reg = mn;
                float ps = 0.f;
#pragma unroll
                for (int r = 0; r < 16; ++r) { p0[r] = __builtin_amdgcn_exp2f(p0[r] - mn); ps += p0[r]; }
#pragma unroll
                for (int r = 0; r < 16; ++r) { p1[r] = __builtin_amdgcn_exp2f(p1[r] - mn); ps += p1[r]; }
                { auto rr = __builtin_amdgcn_permlane32_swap(__float_as_uint(ps), __float_as_uint(ps), false, false);
                  ps = __uint_as_float(rr[0]) + __uint_as_float(rr[1]); }
                l_reg = l_reg * alpha + ps;
                if (__any(alpha < 1.f)) {
                    if (hi == 0) al_l[r32] = alpha;
                    asm volatile("s_waitcnt lgkmcnt(0)" ::: "memory");
#pragma unroll
                    for (int r = 0; r < 16; ++r) { const float a = al_l[crow(r, hi)];
#pragma unroll
                        for (int d = 0; d < 4; ++d) o[d][r] *= a; }
                    asm volatile("s_waitcnt lgkmcnt(0)" ::: "memory");
                }
            } else {
                const bool diag = (t == cw); const int dq = qpos - 64 * t - 4 * hi; const float NEG = -__builtin_inff();
                float suf = carry;
#define SB_HALF(P, KOFF) do { f32x16 f_; \
                    _Pragma("unroll") for (int r = 0; r < 16; ++r) { const float y = P[r]; const float e = __builtin_amdgcn_exp2f(-fabsf(y)); const float l2 = __builtin_amdgcn_logf(1.f + e); \
                        const float lb = fminf(y, 0.f) - l2; P[r] = lb; f_[r] = lb - y; } \
                    if (diag) { _Pragma("unroll") for (int r = 0; r < 16; ++r) { const int c = (r & 3) + 8 * (r >> 2) + (KOFF); if (!(c < dq)) { P[r] = NEG; f_[r] = 0.f; } } } \
                    float tg_[4], pg_[4]; \
                    _Pragma("unroll") for (int g = 0; g < 4; ++g) { const float a = (f_[4 * g] + f_[4 * g + 1]) + (f_[4 * g + 2] + f_[4 * g + 3]); \
                        auto rr = __builtin_amdgcn_permlane32_swap(__float_as_uint(a), __float_as_uint(a), false, false); \
                        const float lo = __uint_as_float(rr[0]), hh = __uint_as_float(rr[1]); tg_[g] = lo + hh; pg_[g] = hi == 0 ? hh : 0.f; } \
                    _Pragma("unroll") for (int g = 3; g >= 0; --g) { const float base = suf + pg_[g]; \
                        const float s2 = f_[4 * g + 3], s1 = s2 + f_[4 * g + 2], s0 = s1 + f_[4 * g + 1]; \
                        P[4 * g + 3] = __builtin_amdgcn_exp2f(P[4 * g + 3] + base); P[4 * g + 2] = __builtin_amdgcn_exp2f(P[4 * g + 2] + (base + s2)); \
                        P[4 * g + 1] = __builtin_amdgcn_exp2f(P[4 * g + 1] + (base + s1)); P[4 * g] = __builtin_amdgcn_exp2f(P[4 * g] + (base + s0)); \
                        suf += tg_[g]; } } while (0)
                SB_HALF(p1, 32);
                PK4(p1, 0, pa2); PK4(p1, 8, pa3);
                SB_HALF(p0, 0);
                PK4(p0, 0, pa0); PK4(p0, 8, pa1);
#undef SB_HALF
                carry = suf;
                fin = __all(carry < SB_DEAD);
            }
            if (MLA) { PK4(p0, 0, pa0); PK4(p0, 8, pa1); PK4(p1, 0, pa2); PK4(p1, 8, pa3); }
            pv_tile(o, vbase + (unsigned)(buf * 16384), pa0, pa1, pa2, pa3);
        }
    }
    __syncthreads();
    if (actw) {
        float rli[16];
        if (MLA) {
            if (hi == 0) li_l[r32] = l_reg;
            asm volatile("s_waitcnt lgkmcnt(0)" ::: "memory");
#pragma unroll
            for (int r = 0; r < 16; ++r) rli[r] = 1.0f / li_l[crow(r, hi)];
        } else {
#pragma unroll
            for (int r = 0; r < 16; ++r) rli[r] = 1.0f;
        }
        store_o_staged(o, rli, u.O + (size_t)(wid * 32) * u.ldo, u.ldo, lds + wid * 8192, lane, r32, hi, u.ssq + (size_t)(wid * 32) * 32);
    }
    __syncthreads();
#undef LOADT
}

__device__ __forceinline__ void qk192_pipe(f32x16& p0, f32x16& p1, ALAS const char* Kt, ALAS const char* Rt, int r32, int hi, const bf16x8* qr, const f32x16* cinit = nullptr) {
    constexpr int PF = 2;
    bf16x8 fa[12], fb[12];
#define QK_ADDR(s) ((s) < 8 ? Kt + KSWZ(r32, ((s) * 16 + hi * 8) * 2) : Rt + RSWZ(r32, (((s) - 8) * 16 + hi * 8) * 2))
#define QK_LD(s) do { ALAS const char* a_ = QK_ADDR(s); fa[s] = *(ALAS const bf16x8*)a_; fb[s] = *(ALAS const bf16x8*)(a_ + ((s) < 8 ? 32 * 256 : 32 * 128)); } while (0)
#pragma unroll
    for (int s = 0; s < PF; ++s) QK_LD(s);
#pragma unroll
    for (int s = 0; s < 12; ++s) {
        if (s + PF < 12) QK_LD(s + PF);
        __builtin_amdgcn_sched_barrier(0);
        p0 = __builtin_amdgcn_mfma_f32_32x32x16_bf16(fa[s], qr[s], (s == 0 && cinit) ? *cinit : p0, 0, 0, 0);
        p1 = __builtin_amdgcn_mfma_f32_32x32x16_bf16(fb[s], qr[s], (s == 0 && cinit) ? *cinit : p1, 0, 0, 0);
        __builtin_amdgcn_sched_barrier(0);
    }
#undef QK_LD
#undef QK_ADDR
}
constexpr float MLA_THR = 8.f;
__device__ __forceinline__ void mla_softmax(f32x16& p0, f32x16& p1, float& m_reg, float& l_reg, f32x16* o, ALAS float* al_l, int r32, int hi, bf16x8& pa0, bf16x8& pa1, bf16x8& pa2, bf16x8& pa3) {
    float pmax = p0[0];
#pragma unroll
    for (int r = 1; r < 16; ++r) pmax = fmaxf(pmax, p0[r]);
#pragma unroll
    for (int r = 0; r < 16; ++r) pmax = fmaxf(pmax, p1[r]);
    { auto rr = __builtin_amdgcn_permlane32_swap(__float_as_uint(pmax), __float_as_uint(pmax), false, false);
      pmax = fmaxf(__uint_as_float(rr[0]), __uint_as_float(rr[1])); }
    float mn = m_reg, alpha = 1.f;
    if (!__all(pmax - m_reg <= MLA_THR)) { mn = fmaxf(m_reg, pmax); alpha = __builtin_amdgcn_exp2f(m_reg - mn); m_reg = mn; }
    float ps = 0.f;
#pragma unroll
    for (int r = 0; r < 16; ++r) { p0[r] = __builtin_amdgcn_exp2f(p0[r] - mn); ps += p0[r]; }
#pragma unroll
    for (int r = 0; r < 16; ++r) { p1[r] = __builtin_amdgcn_exp2f(p1[r] - mn); ps += p1[r]; }
    { auto rr = __builtin_amdgcn_permlane32_swap(__float_as_uint(ps), __float_as_uint(ps), false, false);
      ps = __uint_as_float(rr[0]) + __uint_as_float(rr[1]); }
    l_reg = l_reg * alpha + ps;
    if (__any(alpha < 1.f)) {
        if (hi == 0) al_l[r32] = alpha;
        asm volatile("s_waitcnt lgkmcnt(0)" ::: "memory");
#pragma unroll
        for (int r = 0; r < 16; ++r) { const float a = al_l[crow(r, hi)];
#pragma unroll
            for (int d = 0; d < 4; ++d) o[d][r] *= a; }
        asm volatile("s_waitcnt lgkmcnt(0)" ::: "memory");
    }
    PK4(p0, 0, pa0); PK4(p0, 8, pa1); PK4(p1, 0, pa2); PK4(p1, 8, pa3);
}
__device__ __forceinline__ void mla_softmax_rel(f32x16& p0, f32x16& p1, float& m_reg, f32x16& negm, bool first, float& l_reg, f32x16* o, ALAS float* al_l, int r32, int hi, bf16x8& pa0, bf16x8& pa1, bf16x8& pa2, bf16x8& pa3) {
    float pmax = p0[0];
#pragma unroll
    for (int r = 1; r < 16; ++r) pmax = fmaxf(pmax, p0[r]);
#pragma unroll
    for (int r = 0; r < 16; ++r) pmax = fmaxf(pmax, p1[r]);
    { auto rr = __builtin_amdgcn_permlane32_swap(__float_as_uint(pmax), __float_as_uint(pmax), false, false);
      pmax = fmaxf(__uint_as_float(rr[0]), __uint_as_float(rr[1])); }
    if (first || !__all(pmax <= MLA_THR)) {
        const float delta = first ? pmax : fmaxf(pmax, 0.f); const float alpha = first ? 1.f : __builtin_amdgcn_exp2f(-delta);
        m_reg += delta; l_reg *= alpha;
#pragma unroll
        for (int r = 0; r < 16; ++r) { p0[r] -= delta; p1[r] -= delta; negm[r] = -m_reg; }
        if (!first) {
            if (hi == 0) al_l[r32] = alpha;
            asm volatile("s_waitcnt lgkmcnt(0)" ::: "memory");
#pragma unroll
            for (int r = 0; r < 16; ++r) { const float a = al_l[crow(r, hi)];
#pragma unroll
                for (int d = 0; d < 4; ++d) o[d][r] *= a; }
            asm volatile("s_waitcnt lgkmcnt(0)" ::: "memory");
        }
    }
    float ps = 0.f;
#pragma unroll
    for (int r = 0; r < 16; ++r) { p0[r] = __builtin_amdgcn_exp2f(p0[r]); ps += p0[r]; }
#pragma unroll
    for (int r = 0; r < 16; ++r) { p1[r] = __builtin_amdgcn_exp2f(p1[r]); ps += p1[r]; }
    { auto rr = __builtin_amdgcn_permlane32_swap(__float_as_uint(ps), __float_as_uint(ps), false, false);
      ps = __uint_as_float(rr[0]) + __uint_as_float(rr[1]); }
    l_reg += ps;
    PK4(p0, 0, pa0); PK4(p0, 8, pa1); PK4(p1, 0, pa2); PK4(p1, 8, pa3);
}
constexpr int M_OFF_V = 0, M_OFF_K = 49152, M_OFF_R = 81920, M_OFF_WS = 98304, MLA_LDS_BYTES = 98304 + 8 * 256;
template <bool ROLEB, int VAR = 0> __device__ __forceinline__ void mla_body(const Unit u, ALAS char* lds) {
    int tid_o = threadIdx.x; asm volatile("" : "+v"(tid_o));
    const int tid = tid_o, wid = __builtin_amdgcn_readfirstlane(tid >> 6), lane = tid & 63, r32 = lane & 31, hi = lane >> 5;
    const bool actw = wid < u.nact; constexpr bool roleB = ROLEB;
    const int sr = tid >> 4, sc = (tid & 15) * 8;
    const int vst0 = v_st(sr, sc), vst1 = v_st(32 + sr, sc), kws = KSWZ(sr, sc * 2);
    const int rk = tid >> 3, rc = (tid & 7) * 8, rws = RSWZ(rk, rc * 2);
    ALAS char* V_l = lds + M_OFF_V; ALAS char* K_l = lds + M_OFF_K; ALAS char* R_l = lds + M_OFF_R;
    ALAS float* al_l = (ALAS float*)(lds + M_OFF_WS) + wid * 64; ALAS float* li_l = al_l + 32;
    const unsigned vbase = (unsigned)(uintptr_t)V_l + (unsigned)v_rd_base(lane);
    bf16x8 qr[12];
#pragma unroll
    for (int d0 = 0; d0 < 12; ++d0) qr[d0] = (bf16x8){0, 0, 0, 0, 0, 0, 0, 0};
    if (actw) {
#pragma unroll
        for (int d0 = 0; d0 < 12; ++d0) qr[d0] = *(const bf16x8*)(u.Q + (size_t)(wid * 32 + r32) * u.ldq + d0 * 16 + hi * 8);
    }
    const int cw = (u.P0 + wid * 32) >> 6;
    float m_reg = -1e30f, l_reg = 0.f;
    f32x16 o[4], p0, p1;
#pragma unroll
    for (int r = 0; r < 16; ++r) { p0[r] = 0.f; p1[r] = 0.f; }
#pragma unroll
    for (int d = 0; d < 4; ++d)
#pragma unroll
        for (int r = 0; r < 16; ++r) o[d][r] = 0.f;
    bf16x8 st_k0, st_k1, st_v0, st_v1, st_r;
#define LOADT(tt) do { const size_t r0_ = (size_t)(tt) * 64; \
        st_k0 = *(const bf16x8*)(u.K + (r0_ + sr) * 2048 + sc); st_k1 = *(const bf16x8*)(u.K + (r0_ + 32 + sr) * 2048 + sc); \
        st_v0 = *(const bf16x8*)(u.V + (r0_ + sr) * 2048 + sc); st_v1 = *(const bf16x8*)(u.V + (r0_ + 32 + sr) * 2048 + sc); \
        st_r = *(const bf16x8*)(u.Kr + (r0_ + rk) * 64 + rc); } while (0)
#define MLA_QK(kb) do { _Pragma("unroll") for (int r = 0; r < 16; ++r) { p0[r] = 0.f; p1[r] = 0.f; } \
        if (VAR == 4 || VAR == 0 || VAR == 5) qk192_pipe(p0, p1, K_l + (kb) * 16384, R_l + (kb) * 8192, r32, hi, qr); else if (VAR != 3) { qk128(p0, p1, K_l + (kb) * 16384, r32, hi, qr); qk64(p0, p1, R_l + (kb) * 8192, r32, hi, qr + 8); } } while (0)
#define MLA_SMPV(vs) do { bf16x8 pa0, pa1, pa2, pa3; \
        if (VAR == 1) { PK4(p0, 0, pa0); PK4(p0, 8, pa1); PK4(p1, 0, pa2); PK4(p1, 8, pa3); l_reg += p0[0]; } \
        else mla_softmax(p0, p1, m_reg, l_reg, o, al_l, r32, hi, pa0, pa1, pa2, pa3); \
        if (VAR != 2) pv_tile(o, vbase + (unsigned)((vs) * 16384), pa0, pa1, pa2, pa3); \
        else { _Pragma("unroll") for (int r = 0; r < 4; ++r) o[r][0] += __builtin_bit_cast(float, (unsigned)pa0[r] ^ (unsigned)pa1[r] ^ (unsigned)pa2[r] ^ (unsigned)pa3[r]); } } while (0)
    LOADT(0);
    int vs_cur = 0, vs_prev = 2;
    for (int i = 0; i <= u.NT; ++i) {
        const int kb = i & 1;
        if (i < u.NT && VAR != 5) {
            *(ALAS bf16x8*)(K_l + kb * 16384 + kws) = st_k0; *(ALAS bf16x8*)(K_l + kb * 16384 + kws + 32 * 256) = st_k1;
            *(ALAS bf16x8*)(V_l + vs_cur * 16384 + vst0) = st_v0; *(ALAS bf16x8*)(V_l + vs_cur * 16384 + vst1) = st_v1;
            *(ALAS bf16x8*)(R_l + kb * 8192 + rws) = st_r;
            __syncthreads();
            if (i + 1 < u.NT) LOADT(i + 1);
        }
        if (actw) {
            if constexpr (!roleB) { if (i < u.NT && i <= cw) { MLA_QK(kb); MLA_SMPV(vs_cur); } }
            else { if (i >= 1 && i - 1 <= cw) MLA_SMPV(vs_prev);
                   if (i < u.NT && i <= cw) MLA_QK(kb); }
        }
        vs_prev = vs_cur; vs_cur = (vs_cur == 2) ? 0 : vs_cur + 1;
    }
    if (actw) {
        if (hi == 0) li_l[r32] = l_reg;
        asm volatile("s_waitcnt lgkmcnt(0)" ::: "memory");
        float rli[16];
#pragma unroll
        for (int r = 0; r < 16; ++r) rli[r] = 1.0f / li_l[crow(r, hi)];
        bf16* Ow = u.O + (size_t)(wid * 32) * u.ldo;
#pragma unroll
        for (int r = 0; r < 16; ++r) { const int orow = crow(r, hi); float sq = 0.f;
#pragma unroll
            for (int d0 = 0; d0 < 4; ++d0) { const float v = o[d0][r] * rli[r]; const float vn = __shfl_xor(v, 1); sq += v * v;
                if ((r32 & 1) == 0) *(unsigned*)(Ow + (size_t)orow * u.ldo + d0 * 32 + r32) = cvtpk(v, vn); }
            sq += __shfl_xor(sq, 1); sq += __shfl_xor(sq, 2); sq += __shfl_xor(sq, 4); sq += __shfl_xor(sq, 8); sq += __shfl_xor(sq, 16);
            if (ATT_SSQ_ATOMICS && r32 == 0) __hip_atomic_fetch_add(u.ssq + wid * 32 + orow, sq, __ATOMIC_RELAXED, __HIP_MEMORY_SCOPE_AGENT); }
    }
    __syncthreads();
#undef LOADT
#undef MLA_QK
#undef MLA_SMPV
}
constexpr int D_OFF_K = 0, D_OFF_R = 49152, D_OFF_V = 73728, D_OFF_WS = 122880, DMA_LDS_BYTES = 122880 + 8 * 256;
template <int VAR = 0> __device__ __forceinline__ void mla_unit_dma(const Unit u, ALAS char* lds) {
    int tid_o = threadIdx.x; asm volatile("" : "+v"(tid_o));
    const int tid = tid_o, wid = __builtin_amdgcn_readfirstlane(tid >> 6), lane = tid & 63, r32 = lane & 31, hi = lane >> 5;
    const bool actw = wid < u.nact;
    if (false) __builtin_amdgcn_s_setprio(1);
    ALAS char* K_l = lds + D_OFF_K; ALAS char* R_l = lds + D_OFF_R; ALAS char* V_l = lds + D_OFF_V;
    ALAS float* al_l = (ALAS float*)(lds + D_OFF_WS) + wid * 64; ALAS float* li_l = al_l + 32;
    const unsigned vbase = (unsigned)(uintptr_t)V_l + (unsigned)v_rd_base(lane);
    unsigned offK[2], offV[2], offR;
#pragma unroll
    for (int j = 0; j < 2; ++j) {
        const int p = wid + 8 * j;
        { const int r = 4 * p + (lane >> 4), c = (lane & 15) ^ (r & 15); offK[j] = (unsigned)(r * 4096 + c * 16); }
        { const int sti = 2 * p + (lane >> 5), kk = (sti >> 2) * 8 + ((lane & 31) >> 2), k = (kk & ~0xC) | ((kk & 4) << 1) | ((kk & 8) >> 1), c = (sti & 3) * 32 + (lane & 3) * 8; offV[j] = (unsigned)(k * 4096 + c * 2); }
    }
    { const int r = 8 * wid + (lane >> 3), c = (lane & 7) ^ ((r >> 1) & 7); offR = (unsigned)(r * 128 + c * 16); }
    const char* gK = (const char*)u.K; const char* gV = (const char*)u.V; const char* gR = (const char*)u.Kr;
#define DMA_TILE(tt, slot) do { const size_t tb_ = (size_t)(tt) * 64; \
        __builtin_amdgcn_global_load_lds((const unsigned*)(gK + tb_ * 4096 + offK[0]), (ALAS unsigned*)(K_l + (slot) * 16384 + wid * 1024), 16, 0, 0); \
        __builtin_amdgcn_global_load_lds((const unsigned*)(gK + tb_ * 4096 + offK[1]), (ALAS unsigned*)(K_l + (slot) * 16384 + (wid + 8) * 1024), 16, 0, 0); \
        __builtin_amdgcn_global_load_lds((const unsigned*)(gR + tb_ * 128 + offR), (ALAS unsigned*)(R_l + (slot) * 8192 + wid * 1024), 16, 0, 0); \
        __builtin_amdgcn_global_load_lds((const unsigned*)(gV + tb_ * 4096 + offV[0]), (ALAS unsigned*)(V_l + (slot) * 16384 + wid * 1024), 16, 0, 0); \
        __builtin_amdgcn_global_load_lds((const unsigned*)(gV + tb_ * 4096 + offV[1]), (ALAS unsigned*)(V_l + (slot) * 16384 + (wid + 8) * 1024), 16, 0, 0); } while (0)
    bf16x8 qr[12];
#pragma unroll
    for (int d0 = 0; d0 < 12; ++d0) qr[d0] = (bf16x8){0, 0, 0, 0, 0, 0, 0, 0};
    if (actw) {
#pragma unroll
        for (int d0 = 0; d0 < 12; ++d0) qr[d0] = *(const bf16x8*)(u.Q + (size_t)(wid * 32 + r32) * u.ldq + d0 * 16 + hi * 8);
    }
#pragma unroll
    for (int d0 = 0; d0 < 12; ++d0) asm volatile("" : "+v"(qr[d0]));
    DMA_TILE(0, 0); if (u.NT > 1) DMA_TILE(1, 1);
    const int cw = (u.P0 + wid * 32) >> 6;
    float m_reg = 0.f, l_reg = 0.f;
    f32x16 o[4], p0, p1, negm;
#pragma unroll
    for (int r = 0; r < 16; ++r) negm[r] = 0.f;
#pragma unroll
    for (int d = 0; d < 4; ++d)
#pragma unroll
        for (int r = 0; r < 16; ++r) o[d][r] = 0.f;
    int sl = 0, sl2 = 2;
    for (int i = 0; i < u.NT; ++i) {
        if (i + 1 < u.NT) asm volatile("s_waitcnt vmcnt(5) lgkmcnt(0)" ::: "memory"); else asm volatile("s_waitcnt vmcnt(0) lgkmcnt(0)" ::: "memory");
        __builtin_amdgcn_s_barrier(); asm volatile("" ::: "memory");
        if (i + 2 < u.NT) DMA_TILE(i + 2, sl2);
        if (actw && i <= cw) {
            __builtin_amdgcn_s_setprio(1); qk192_pipe(p0, p1, K_l + sl * 16384, R_l + sl * 8192, r32, hi, qr, &negm); __builtin_amdgcn_s_setprio(0);
            bf16x8 pa0, pa1, pa2, pa3;
            mla_softmax_rel(p0, p1, m_reg, negm, i == 0, l_reg, o, al_l, r32, hi, pa0, pa1, pa2, pa3);
            __builtin_amdgcn_s_setprio(1); pv_tile(o, vbase + (unsigned)(sl * 16384), pa0, pa1, pa2, pa3); __builtin_amdgcn_s_setprio(0);
        }
        sl = (sl == 2) ? 0 : sl + 1; sl2 = (sl2 == 2) ? 0 : sl2 + 1;
    }
    asm volatile("s_waitcnt lgkmcnt(0)" ::: "memory"); __builtin_amdgcn_s_barrier(); asm volatile("" ::: "memory");
    if (actw) {
        if (hi == 0) li_l[r32] = l_reg;
        asm volatile("s_waitcnt lgkmcnt(0)" ::: "memory");
        float rli[16];
#pragma unroll
        for (int r = 0; r < 16; ++r) rli[r] = 1.0f / li_l[crow(r, hi)];
        store_o_staged(o, rli, u.O + (size_t)(wid * 32) * u.ldo, u.ldo, lds + wid * 8192, lane, r32, hi, u.ssq + (size_t)(wid * 32) * 32);
    }
    asm volatile("s_waitcnt lgkmcnt(0)" ::: "memory"); __builtin_amdgcn_s_barrier(); asm volatile("" ::: "memory");
    __builtin_amdgcn_s_setprio(0);
#undef DMA_TILE
}
template <int VAR = 0> __device__ __forceinline__ void mla_unit(const Unit u, ALAS char* lds) {
    int tid_o = threadIdx.x; asm volatile("" : "+v"(tid_o));
    if (__builtin_amdgcn_readfirstlane(tid_o >> 6) >= 4) mla_body<true, VAR>(u, lds); else mla_body<false, VAR>(u, lds);
}
#undef PK4
}
#define GAS __attribute__((address_space(1)))
#define LAS __attribute__((address_space(3)))
typedef unsigned short bf16;
typedef unsigned v4u __attribute__((ext_vector_type(4)));
typedef float f32x4 __attribute__((ext_vector_type(4)));
typedef short bf16x8 __attribute__((ext_vector_type(8)));
typedef GAS unsigned gu32;
typedef GAS unsigned long long gu64;
#define RLX_AGENT __ATOMIC_RELAXED, __HIP_MEMORY_SCOPE_AGENT
#define LDS_WAIT() asm volatile("s_waitcnt lgkmcnt(0)" ::: "memory")
#define VM_WAIT() asm volatile("s_waitcnt vmcnt(0)" ::: "memory")
__device__ __forceinline__ unsigned long long rt() { return __builtin_amdgcn_s_memrealtime(); }
__device__ __forceinline__ unsigned f2bf(float f) { unsigned u = __builtin_bit_cast(unsigned, f); return (u + 0x7fffu + ((u >> 16) & 1u)) >> 16; }
__device__ __forceinline__ unsigned pk2(float lo, float hi) { return f2bf(lo) | (f2bf(hi) << 16); }

#define XB_TMO      128
#define XB_XCNT(j)  (256  + 64 * (j))
#define XB_XSUB(j)  (1280 + 64 * (j))
#define XB_XGEN(j)  (2304 + 64 * (j))
#define XB_TOP      3328
#define XB_TOPGEN   3392
#define XCD_BAR_WORDS 3456
#define XB_SPIN_CAP (1u << 18)

__device__ __forceinline__ unsigned xb_ld(unsigned* p)              { return __hip_atomic_load(p, __ATOMIC_RELAXED, __HIP_MEMORY_SCOPE_AGENT); }
__device__ __forceinline__ unsigned xb_add(unsigned* p, unsigned v) { return __hip_atomic_fetch_add(p, v, __ATOMIC_RELAXED, __HIP_MEMORY_SCOPE_AGENT); }
__device__ __forceinline__ unsigned xb_xcc_id() { return (unsigned)__builtin_amdgcn_s_getreg((3 << 11) | 20) & 0xFu; }
#define XB_SPIN(cond, bar) do { unsigned _sp = 0; while (cond) { __builtin_amdgcn_s_sleep(1); \
    if ((++_sp & 255u) == 0u) { if (xb_ld(&(bar)[XB_TMO])) break; if (_sp > XB_SPIN_CAP) { atomicAdd(&(bar)[XB_TMO], 1u); break; } } } } while (0)

struct XcdBarrier {
    unsigned* bar; unsigned x;
    volatile LAS unsigned* st;
};

__device__ __forceinline__ XcdBarrier xcd_barrier_post(unsigned* bar, volatile LAS unsigned* st) {
    XcdBarrier b; b.bar = bar; b.x = xb_xcc_id(); b.st = st;
    if (threadIdx.x == 0) (void)xb_add(&bar[XB_XCNT(b.x)], 1u);
    return b;
}
__device__ __forceinline__ void xcd_barrier_complete(unsigned* bar, unsigned x, unsigned& nloc, unsigned& nx) {
    const unsigned G = gridDim.x * gridDim.y * gridDim.z;
    unsigned sum, cnt, mine, sp = 0u;
    for (;;) {
        sum = 0u; cnt = 0u; mine = 0u;
#pragma unroll
        for (unsigned j = 0; j < 16; ++j) { const unsigned c = xb_ld(&bar[XB_XCNT(j)]); sum += c; cnt += (c > 0u) ? 1u : 0u; mine = (j == x) ? c : mine; }
        if (sum == G) break;
        __builtin_amdgcn_s_sleep(1);
        if ((++sp & 255u) == 0u) { if (xb_ld(&bar[XB_TMO])) break; if (sp > XB_SPIN_CAP) { atomicAdd(&bar[XB_TMO], 1u); break; } }
    }
    nloc = mine > 0u ? mine : 1u; nx = cnt > 0u ? cnt : 1u;
}

__device__ __forceinline__ void xcd_barrier(const XcdBarrier& b) {
    asm volatile("s_waitcnt vmcnt(0)" ::: "memory");
    __syncthreads();
    if (threadIdx.x == 0) {
        unsigned* bar = b.bar;
        __builtin_amdgcn_s_waitcnt(0);
        unsigned nloc = b.st[0], nx = b.st[1];
        if (nloc == 0u) { xcd_barrier_complete(bar, b.x, nloc, nx); b.st[0] = nloc; b.st[1] = nx; }
        const unsigned old = xb_add(&bar[XB_XSUB(b.x)], 1u);
        const unsigned gen = old / nloc;
        if (old + 1u == (gen + 1u) * nloc) {
            __builtin_amdgcn_fence(__ATOMIC_RELEASE, "agent");
            asm volatile("s_waitcnt vmcnt(0)" ::: "memory");
            const unsigned og = xb_add(&bar[XB_TOP], 1u);
            const unsigned tg = og / nx;
            if (og + 1u == (tg + 1u) * nx) xb_add(&bar[XB_TOPGEN], 1u);
            else XB_SPIN(xb_ld(&bar[XB_TOPGEN]) == tg, bar);
            __builtin_amdgcn_fence(__ATOMIC_ACQUIRE, "agent");
            xb_add(&bar[XB_XGEN(b.x)], 1u);
            asm volatile("s_waitcnt vmcnt(0)" ::: "memory");
        } else {
            XB_SPIN(xb_ld(&bar[XB_XGEN(b.x)]) == gen, bar);
            __builtin_amdgcn_fence(__ATOMIC_ACQUIRE, "agent");
            asm volatile("s_waitcnt vmcnt(0)" ::: "memory");
        }
    }
    __syncthreads();
}
constexpr int NWAVES = 8;
constexpr int DM = 4096, NP = 16384, NS = 512, MTOK = NP + NS;
constexpr int SEQ = 4096, PAST = 1024, DSEQ = 64, SKVS = PAST + DSEQ;
constexpr int KVROWS = NP + 8 * SKVS;
constexpr int NINP = 7936;
constexpr int QLORA = 1024, KVLORA = 512, ROPE = 64, NOPE = 128, NH = 16, DFF = 16384;
constexpr float EPS = 1e-6f;
constexpr float LOG2E = 1.4426950408889634f;
constexpr float QS_MLA = 0.07216878364870322f * LOG2E;
constexpr float QS_SB = 0.08838834764831845f * LOG2E;

constexpr size_t O_Y = 0, O_CKV_P = 69206016, O_KR_P = 85983232, O_SBK_P = 88080384, O_SBV_P = 155189248,
                 O_CKV_S = 222298112, O_KR_S = 222822400, O_SBK_S = 222887936, O_SBV_S = 224985088, O_END = 227082240;

constexpr size_t MiB = 1u << 20;
constexpr size_t WS_CTL = 0, CTL_ZERO_BYTES = 1 * MiB;
constexpr size_t WS_SSQH = 512 * 1024;
constexpr size_t WS_TAB = 1 * MiB;
constexpr size_t WS_WIN = 2 * MiB;
constexpr size_t WS_WQB = 64 * MiB;
constexpr size_t WS_WKVB = 70 * MiB;
constexpr size_t WS_WO = 74 * MiB;
constexpr size_t WS_WUP = 106 * MiB;
constexpr size_t WS_WDN = 234 * MiB;
constexpr size_t WS_XN = 362 * MiB;
constexpr size_t WS_R = 494 * MiB;
constexpr size_t WS_U = WS_R;
constexpr size_t WS_QLAT = WS_R;
constexpr size_t WS_AKV = WS_QLAT + 33 * MiB;
constexpr size_t WS_KROPE = WS_AKV + 25 * MiB;
constexpr size_t WS_VB = WS_KROPE + 4 * MiB;
constexpr size_t WS_QB = WS_VB + 98 * MiB;
constexpr size_t WS_KN = WS_QB + 99 * MiB;
constexpr size_t WS_SBQ = WS_KN + 98 * MiB;
constexpr size_t WS_SBK = WS_SBQ + 66 * MiB;
constexpr size_t WS_SBV = WS_SBK + 98 * MiB;
constexpr size_t WS_R2 = WS_SBV + 98 * MiB;
constexpr size_t WS_LAT = WS_R2;
constexpr size_t WS_QRAW = WS_R2;
constexpr size_t WS_KNRAW = WS_R2 + 198 * MiB;
constexpr size_t WS_MLAO = WS_R2;
constexpr size_t WS_SBO = WS_R2 + 66 * MiB;
constexpr size_t WS_MERGED = WS_R2 + 132 * MiB;
constexpr size_t WS_SLAB = WS_R2;
constexpr size_t WS_Y0B = WS_R2 + 264 * MiB;
constexpr size_t WS_WDN1 = WS_R2 + 398 * MiB;
constexpr size_t WS_SSQP = WS_WDN1 + 128 * MiB;
constexpr size_t WS_END = WS_SSQP + 3 * MiB;
static_assert(WS_U + (size_t)MTOK * DFF * 2 <= WS_END, "U fits the overlay region");
static_assert(WS_XN + (size_t)MTOK * DM * 2 <= WS_R && WS_WDN + (size_t)DM * DFF * 2 <= WS_XN && WS_WIN + (size_t)NINP * DM * 2 <= WS_WQB, "ws map");
constexpr int CW_TMO = 0, CW_CODE = 1, CW_BAR = 4096;

constexpr int RING_OFF = 0, RING_BYTES = 131072;
constexpr int LDSCTL_OFF = RING_BYTES, MISC_OFF = LDSCTL_OFF + 320;
constexpr int XCH_OFF = LDSCTL_OFF + 1024;
constexpr int LDS_BYTES = 147456;
static_assert(XCH_OFF + 8192 <= LDS_BYTES, "LDS map");
static_assert(att::ATT_LDS_BYTES <= RING_BYTES && att::MLA_LDS_BYTES <= RING_BYTES && att::DMA_LDS_BYTES <= RING_BYTES, "attention scratch fits the ring region");

#if defined(__HIP_DEVICE_COMPILE__)
#define ASSUME_GLOBAL(p) do { __builtin_assume(!__builtin_amdgcn_is_shared((const __attribute__((address_space(0))) void*)(p))); __builtin_assume(!__builtin_amdgcn_is_private((const __attribute__((address_space(0))) void*)(p))); } while (0)
#else
#define ASSUME_GLOBAL(p) do { } while (0)
#endif
typedef float f32x2 __attribute__((ext_vector_type(2)));
__device__ __forceinline__ float wave_sum(float v) {
#pragma unroll
    for (int o = 1; o < 64; o <<= 1) v += __shfl_xor(v, o);
    return v;
}
__device__ __forceinline__ unsigned pkbf(float lo, float hi) { return pg8::cvt_pk_bf16(lo, hi); }
__device__ __forceinline__ float bf2f(unsigned short b) { return __uint_as_float(((unsigned)b) << 16); }
__device__ __forceinline__ int kvrow_of(int m) { return m < NP ? m : NP + ((m - NP) >> 6) * SKVS + PAST + ((m - NP) & 63); }
__device__ __forceinline__ int pos_of(int m) { return m < NP ? (m & (SEQ - 1)) : PAST + ((m - NP) & 63); }

__device__ __forceinline__ void sincos_acc(float ang, float& s, float& c) {
    const double a = (double)ang; const double q = rint(a * 0.63661977236758134308);
    double r = fma(-q, 1.57079632679489661923, a); r = fma(-q, 6.123233995736766e-17, r);
    const float rf = (float)r; const int qi = (int)q; const float r2 = rf * rf;
    const float sp = rf + rf * r2 * (-1.6666667163e-1f + r2 * (8.3333337680e-3f + r2 * (-1.9841270114e-4f + r2 * 2.7557314297e-6f)));
    const float cp = 1.f + r2 * (-0.5f + r2 * (4.1666667908e-2f + r2 * (-1.3888889225e-3f + r2 * (2.4801587642e-5f + r2 * (-2.7557314297e-7f)))));
    switch (qi & 3) { case 0: s = sp; c = cp; break; case 1: s = cp; c = -sp; break; case 2: s = -sp; c = -cp; break; default: s = -cp; c = sp; break; }
}

struct Frame {
    LAS unsigned char* lds; volatile LAS unsigned* MISC; gu32* ctl;
    int tid, lane, wave, vcu, G;
};
struct Args { const float* in[22]; float* out; unsigned char* ws; };

struct TItem { const float* src; bf16* dst; const float* gk; int N, K; };
__device__ __forceinline__ void ti_load(const TItem& P, float (&tv)[32], f32x4& g0, f32x4& g1, int lane) {
    if (P.gk) { g0 = *(const GAS f32x4*)(P.gk + 8 * (lane & 7)); g1 = *(const GAS f32x4*)(P.gk + 8 * (lane & 7) + 4); }
    else { g0 = f32x4{1.f, 1.f, 1.f, 1.f}; g1 = g0; }
    const GAS float* s = (const GAS float*)P.src + (size_t)(lane >> 5) * P.N + (lane & 31);
#pragma unroll
    for (int i = 0; i < 32; ++i) tv[i] = s[(size_t)(2 * i) * P.N];
}
__device__ __forceinline__ void ti_finish(const TItem& P, const float (&tv)[32], const f32x4 g0, const f32x4 g1, LAS float* scr, int lane) {
#pragma unroll
    for (int i = 0; i < 32; ++i) scr[(2 * i + (lane >> 5)) * 33 + (lane & 31)] = tv[i];
    LDS_WAIT(); asm volatile("" ::: "memory");
    const int c = lane & 7;
#pragma unroll
    for (int j = 0; j < 4; ++j) { const int n = (lane >> 3) + 8 * j; const LAS float* s = scr + (8 * c) * 33 + n;
        v4u o; o.x = pkbf(s[0 * 33] * g0.x, s[1 * 33] * g0.y); o.y = pkbf(s[2 * 33] * g0.z, s[3 * 33] * g0.w); o.z = pkbf(s[4 * 33] * g1.x, s[5 * 33] * g1.y); o.w = pkbf(s[6 * 33] * g1.z, s[7 * 33] * g1.w);
        *(GAS v4u*)(P.dst + (size_t)n * P.K + 8 * c) = o; }
    LDS_WAIT(); asm volatile("" ::: "memory");
}
__device__ __forceinline__ void rms_row_4096(const float* xrow, const float* g, bf16* orow, int lane) {
    const GAS f32x4* xr = (const GAS f32x4*)xrow + lane; const GAS f32x4* gr = (const GAS f32x4*)g + lane;
    f32x4 v[16]; float s = 0.f;
#pragma unroll
    for (int j = 0; j < 16; ++j) { v[j] = xr[64 * j]; s += (v[j].x * v[j].x + v[j].y * v[j].y) + (v[j].z * v[j].z + v[j].w * v[j].w); }
    const float rstd = 1.0f / sqrtf(wave_sum(s) * (1.f / 4096.f) + EPS);
    GAS unsigned long long* o8 = (GAS unsigned long long*)orow + lane;
#pragma unroll
    for (int j = 0; j < 16; ++j) { const f32x4 gg = gr[64 * j];
        o8[64 * j] = (unsigned long long)pkbf(v[j].x * rstd * gg.x, v[j].y * rstd * gg.y) | ((unsigned long long)pkbf(v[j].z * rstd * gg.z, v[j].w * rstd * gg.w) << 32); }
}
__device__ __forceinline__ void rms_row_4096_bf16(const bf16* xrow, const float* g, bf16* orow, int lane) {
    const GAS v4u* xr = (const GAS v4u*)xrow + lane; float x[64]; float s = 0.f;
#pragma unroll
    for (int j = 0; j < 8; ++j) { const v4u w = xr[64 * j]; const unsigned ww[4] = {w.x, w.y, w.z, w.w};
#pragma unroll
        for (int e = 0; e < 4; ++e) { x[8 * j + 2 * e] = __uint_as_float(ww[e] << 16); x[8 * j + 2 * e + 1] = __uint_as_float(ww[e] & 0xffff0000u); } }
#pragma unroll
    for (int i = 0; i < 64; ++i) s += x[i] * x[i];
    const float rstd = 1.0f / sqrtf(wave_sum(s) * (1.f / 4096.f) + EPS);
#pragma unroll
    for (int j = 0; j < 8; ++j) { const GAS f32x4* gp = (const GAS f32x4*)(g + 8 * (64 * j + lane)); const f32x4 g0 = gp[0], g1 = gp[1];
        v4u o; o.x = pkbf(x[8 * j] * rstd * g0.x, x[8 * j + 1] * rstd * g0.y); o.y = pkbf(x[8 * j + 2] * rstd * g0.z, x[8 * j + 3] * rstd * g0.w);
        o.z = pkbf(x[8 * j + 4] * rstd * g1.x, x[8 * j + 5] * rstd * g1.y); o.w = pkbf(x[8 * j + 6] * rstd * g1.z, x[8 * j + 7] * rstd * g1.w);
        *((GAS v4u*)orow + 64 * j + lane) = o; }
}
__device__ __forceinline__ void cache_rows_to_bf16(const float* src, bf16* dst, int W, int gthread, int nthreads) {
    const int per_row = W >> 2; const long total = (long)8 * PAST * per_row;
    for (long i = gthread; i < total; i += nthreads) {
        const int row = (int)(i / per_row), c4 = (int)(i % per_row), b = row >> 10, j = row & 1023;
        const f32x4 v = *(const GAS f32x4*)(src + (size_t)row * W + c4 * 4);
        *(GAS unsigned long long*)(dst + (size_t)(NP + b * SKVS + j) * W + c4 * 4) = (unsigned long long)pkbf(v.x, v.y) | ((unsigned long long)pkbf(v.z, v.w) << 32);
    }
}

template <bool NORM>
__device__ __forceinline__ void tail_reduce_res(const pg8::TailSplitOrder& S, const float* resP, const float* resS, float* out, bf16* HB, float* ssq, const float* ssqm, const float* ssqs, bf16* YB, int tid) {
    if (S.nsplit == 1) return;
    const int wid = __builtin_amdgcn_readfirstlane(tid >> 6), lane = tid & 63, wr = wid >> 2, wc = wid & 3, fr = lane & 15, fq = lane >> 4;
    const int j = S.c / S.nsplit, p = S.c % S.nsplit, per = 32 / S.nsplit;
    pg8::Unit u; S.map(S.nfull * S.G + j, u);
    for (int ii = 0; ii < per; ++ii) {
        const int idx = p * per + ii, a = idx >> 4, b = (idx >> 3) & 1, mm = (idx >> 1) & 3, n = idx & 1;
        const int row = u.pm * 256 + a * 128 + wr * 64 + mm * 16 + fr, col = u.pn * 256 + b * 128 + wc * 32 + 8 * fq + 4 * n;
        f32x4 s = {0.f, 0.f, 0.f, 0.f}, s2 = {0.f, 0.f, 0.f, 0.f};
        for (int sp = 0; sp < S.nsplit; ++sp) { const f32x4 v = *((const GAS f32x4*)(S.slab + (size_t)(j * S.nsplit + sp) * 65536) + (size_t)wid * 2048 + idx * 64 + lane); if (2 * sp < S.nsplit) s += v; else s2 += v; }
        if (NORM) {
            const float rm = 1.0f / sqrtf(__hip_atomic_load(ssqm + row, __ATOMIC_RELAXED, __HIP_MEMORY_SCOPE_AGENT) * (1.f / 2048.f) + EPS), rs = 1.0f / sqrtf(__hip_atomic_load(ssqs + row, __ATOMIC_RELAXED, __HIP_MEMORY_SCOPE_AGENT) * (1.f / 2048.f) + EPS);
            s = s * rm + s2 * rs; } else s += s2;
        f32x4 v;
        if (NORM) { if (YB) { const unsigned long long h = *(const GAS unsigned long long*)(YB + (size_t)row * DM + col); const unsigned h0 = (unsigned)h, h1 = (unsigned)(h >> 32);
                                v = (f32x4){__uint_as_float(h0 << 16), __uint_as_float(h0 & 0xffff0000u), __uint_as_float(h1 << 16), __uint_as_float(h1 & 0xffff0000u)} + s; }
                    else { const float* rp = (row >= NP) ? resS + (size_t)(row - NP) * DM + col : resP + (size_t)row * DM + col; v = *(const GAS f32x4*)rp + s; } }
        else { const unsigned long long h = *(const GAS unsigned long long*)(HB + (size_t)row * DM + col); const unsigned h0 = (unsigned)h, h1 = (unsigned)(h >> 32);
               v = (f32x4){__uint_as_float(h0 << 16), __uint_as_float(h0 & 0xffff0000u), __uint_as_float(h1 << 16), __uint_as_float(h1 & 0xffff0000u)} + s;
               if (YB) { *(GAS unsigned long long*)(YB + (size_t)row * DM + col) = (unsigned long long)pkbf(v.x, v.y) | ((unsigned long long)pkbf(v.z, v.w) << 32);
                         float q = (v.x * v.x + v.y * v.y) + (v.z * v.z + v.w * v.w); q += __shfl_xor(q, 16); q += __shfl_xor(q, 32);
                         if (fq == 0) __hip_atomic_fetch_add(ssq + row, q, __ATOMIC_RELAXED, __HIP_MEMORY_SCOPE_AGENT); }
               else *(GAS f32x4*)(out + (size_t)row * DM + col) = v; }
        if (NORM) {
            *(GAS unsigned long long*)(HB + (size_t)row * DM + col) = (unsigned long long)pkbf(v.x, v.y) | ((unsigned long long)pkbf(v.z, v.w) << 32);
            float q = (v.x * v.x + v.y * v.y) + (v.z * v.z + v.w * v.w); q += __shfl_xor(q, 16); q += __shfl_xor(q, 32);
            if (fq == 0) __hip_atomic_fetch_add(ssq + row, q, __ATOMIC_RELAXED, __HIP_MEMORY_SCOPE_AGENT);
        }
    }
}

__global__ void __launch_bounds__(NWAVES * 64, 2) hymba_fwd(Args args) {
    extern __shared__ __attribute__((aligned(16))) unsigned char lds[];
    Frame F;
    F.lds = (LAS unsigned char*)lds;
    F.MISC = (volatile LAS unsigned*)(F.lds + MISC_OFF);
    F.tid = threadIdx.x; F.lane = F.tid & 63; F.wave = __builtin_amdgcn_readfirstlane(F.tid >> 6);
    F.G = gridDim.x; { const int bx = blockIdx.x; F.vcu = (F.G % 8 == 0) ? (bx % 8) * (F.G / 8) + bx / 8 : bx; }
    unsigned char* ws = args.ws;
    F.ctl = (gu32*)(ws + WS_CTL);
    for (int u = F.tid; u < (LDS_BYTES - LDSCTL_OFF) / 4; u += NWAVES * 64) ((LAS unsigned*)(F.lds + LDSCTL_OFF))[u] = 0u;
    __syncthreads();
    XcdBarrier bar = xcd_barrier_post((unsigned*)(F.ctl + CW_BAR), F.MISC + 8);
#ifndef G5_WGM
#define G5_WGM 8
#endif
#ifndef PROBE_MASK
#define PROBE_MASK 0
#endif
#ifndef PROBE_BAR
#define PROBE_BAR 1
#endif
#ifndef PHMASK
#define PHMASK 0x3fff
#endif
#define GRID_BAR() do { for (int br_ = 0; br_ < PROBE_BAR; ++br_) xcd_barrier(bar); } while (0)
#define PHASE_PTRS() unsigned long long zoff_ = 0; asm volatile("" : "+s"(zoff_)); unsigned char* const wsb = args.ws + zoff_; float* const OUT = args.out + zoff_;     int ptid_ = threadIdx.x; asm volatile("" : "+v"(ptid_)); int bx_ = blockIdx.x, G_ = gridDim.x; asm volatile("" : "+s"(bx_), "+s"(G_)); const int VCU = (G_ % 8 == 0) ? (bx_ % 8) * (G_ / 8) + bx_ / 8 : bx_; (void)VCU; \
    const int LANE = ptid_ & 63, WAVE = __builtin_amdgcn_readfirstlane(ptid_ >> 6); const int gw = VCU * NWAVES + WAVE, NGW = G_ * NWAVES; const int gthread = gw * 64 + LANE, nthreads = NGW * 64; (void)gthread; (void)nthreads; (void)gw; (void)NGW; (void)LANE
#define WIN_T ((bf16*)(wsb + WS_WIN))
#define WQB_T ((bf16*)(wsb + WS_WQB))
#define WKVB_T ((bf16*)(wsb + WS_WKVB))
#define WO_T ((bf16*)(wsb + WS_WO))
#define WUP_T ((bf16*)(wsb + WS_WUP))
#define WDN_T0 ((bf16*)(wsb + WS_WDN))
#define WDN_T1 ((bf16*)(wsb + WS_WDN1))
#define XN ((bf16*)(wsb + WS_XN))
#define UB ((bf16*)(wsb + WS_U))
#define QLAT ((bf16*)(wsb + WS_QLAT))
#define AKV ((bf16*)(wsb + WS_AKV))
#define KROPE ((bf16*)(wsb + WS_KROPE))
#define VB ((bf16*)(wsb + WS_VB))
#define QB ((bf16*)(wsb + WS_QB))
#define KN ((bf16*)(wsb + WS_KN))
#define SBQ ((bf16*)(wsb + WS_SBQ))
#define SBK ((bf16*)(wsb + WS_SBK))
#define SBV ((bf16*)(wsb + WS_SBV))
#define LAT ((float*)(wsb + WS_LAT))
#define QRAW ((float*)(wsb + WS_QRAW))
#define KNRAW ((float*)(wsb + WS_KNRAW))
#define MLAO ((bf16*)(wsb + WS_MLAO))
#define SBO ((bf16*)(wsb + WS_SBO))
#define MERGED ((bf16*)(wsb + WS_MERGED))
#define TAB ((f32x2*)(wsb + WS_TAB))
#define SLAB ((float*)(wsb + WS_SLAB))
#define Y0B ((bf16*)(wsb + WS_Y0B))
#define SSQH ((float*)(wsb + WS_SSQH))
#define SSQM ((float*)(wsb + WS_SSQH + 128 * 1024))
#define SSQS ((float*)(wsb + WS_SSQH + 256 * 1024))
#define SSQP ((float*)(wsb + WS_SSQP))
#define SSQY ((float*)(wsb + WS_SSQH + 384 * 1024))

    { PHASE_PTRS(); (void)OUT;
    for (int i = gthread; i < SEQ * 32; i += nthreads) {
        const int pos = i >> 5, k = i & 31;
        const float inv_freq = exp2f(-(float)k * (13.287712379549449f / 32.f));
        float s, c; sincos_acc((float)pos * inv_freq, s, c); TAB[i] = (f32x2){c, s};
    } }

#define CONVERT_ITEMS(LW, R_LO, R_HI, GWV, NGWV) do { \
        const float* w_in = args.in[7] + (size_t)(LW) * DM * 7744; const float* w_qb = args.in[9] + (size_t)(LW) * QLORA * 3072; \
        const float* w_kvb = args.in[11] + (size_t)(LW) * KVLORA * 4096; const float* w_o = args.in[18] + (size_t)(LW) * DM * DM; \
        const float* w_up = args.in[20] + (size_t)(LW) * DM * DFF; const float* w_dn = args.in[21] + (size_t)(LW) * DFF * DM; const int lw_ = (LW); \
        auto dec_ = [&](int it) -> TItem { \
                int r = (R_HI) - 1 - it; \
                if (r < I_IN) { const int kb = r / 242, nb = r % 242, n0 = nb * 32; return TItem{w_in + (size_t)(kb * 64) * 7744 + n0, WIN_T + (size_t)(n0 + (n0 >= 1600 ? 192 : 0)) * DM + kb * 64, lw_ ? args.in[6] + (size_t)lw_ * DM + kb * 64 : nullptr, 7744, DM}; } r -= I_IN; \
                if (r < I_QB) { const int kb = r / 96, nb = r % 96, n0 = nb * 32, h = n0 / 192, dd = n0 % 192; \
                    return TItem{w_qb + (size_t)(kb * 64) * 3072 + n0, WQB_T + (size_t)(dd < 128 ? h * 128 + dd : 2048 + (h >> 2) * 256 + ((dd - 128) >> 5) * 128 + (h & 3) * 32) * QLORA + kb * 64, nullptr, 3072, QLORA}; } r -= I_QB; \
                if (r < I_KVB) { const int kb = r / 128, nb = r % 128, n0 = nb * 32, h = n0 >> 8, dd = n0 & 255; \
                    return TItem{w_kvb + (size_t)(kb * 64) * 4096 + n0, WKVB_T + (size_t)(dd < 128 ? h * 128 + dd : 2048 + h * 128 + (dd - 128)) * KVLORA + kb * 64, nullptr, 4096, KVLORA}; } r -= I_KVB; \
                if (r < I_O) { const int kb = r / 128, nb = r % 128; \
                    return TItem{w_o + (size_t)(kb * 64) * DM + nb * 32, WO_T + (size_t)(nb * 32) * DM + kb * 64, (kb < 32 ? args.in[16] + (size_t)lw_ * 2048 : args.in[17] + (size_t)lw_ * 2048 - 2048) + kb * 64, DM, DM}; } r -= I_O; \
                if (r < I_UP) { const int kb = r / 512, nb = r % 512; return TItem{w_up + (size_t)(kb * 64) * DFF + nb * 32, WUP_T + (size_t)(nb * 32) * DM + kb * 64, args.in[19] + (size_t)lw_ * DM + kb * 64, DFF, DM}; } r -= I_UP; \
                { const int kb = r / 128, nb = r % 128; return TItem{w_dn + (size_t)(kb * 64) * DM + nb * 32, (lw_ ? WDN_T1 : WDN_T0) + ((size_t)((nb >> 3) * 256 + kb) * 256 + (nb & 7) * 32) * 64, nullptr, DM, 64}; } }; \
        const int n_ = (R_HI) - (R_LO); int it = (GWV); \
        if (it < n_) { \
            float tA[32], tB[32]; f32x4 gA0, gA1, gB0, gB1; \
            TItem PA = dec_(it), PB; ti_load(PA, tA, gA0, gA1, LANE); \
            for (;;) {                                     \
                const int it1 = it + (NGWV); PB = dec_(it1 < n_ ? it1 : it); ti_load(PB, tB, gB0, gB1, LANE); \
                ti_finish(PA, tA, gA0, gA1, scr, LANE); \
                if (it1 >= n_) break; \
                const int it2 = it1 + (NGWV); PA = dec_(it2 < n_ ? it2 : it1); ti_load(PA, tA, gA0, gA1, LANE); \
                ti_finish(PB, tB, gB0, gB1, scr, LANE); \
                if (it2 >= n_) break; \
                it = it2; \
            } } } while (0)
    constexpr int I_IN = 64 * 242, I_QB = 16 * 96, I_KVB = 8 * 128, I_O = 64 * 128, I_UP = 64 * 512, I_DN = 256 * 128;
    constexpr int NITEMS = I_IN + I_QB + I_KVB + I_O + I_UP + I_DN, EARLY_ITEMS = I_IN + I_QB + I_KVB + I_O, EARLY0_ITEMS = I_IN + I_QB + I_KVB;
#pragma unroll 1
    for (int l = 0; l < 2; ++l) {
        if (l == 0 || gridDim.x != 256) {
        for (int rep_ = 0; rep_ < (((PROBE_MASK >> 0) & 1) ? 2 : 1); ++rep_) if constexpr ((PHMASK >> 0) & 1) {
            PHASE_PTRS(); (void)OUT;
            LAS float* scr = (LAS float*)(F.lds + RING_OFF + WAVE * 16384);
            const bool early_ok = (G_ == 256);
            CONVERT_ITEMS(l, (l > 0 && early_ok) ? NITEMS : 0, (l == 0 && early_ok) ? EARLY0_ITEMS : NITEMS, gw, NGW);
            if (l == 0) {
            { unsigned zz = 0u; asm volatile("" : "+v"(zz)); const v4u z4 = {zz, zz, zz, zz};
              for (int i = gthread; i < 192 * DM / 8; i += nthreads) *(GAS v4u*)(WIN_T + (size_t)1600 * DM + (size_t)i * 8) = z4; }
            cache_rows_to_bf16(args.in[2] + (size_t)l * 8 * PAST * KVLORA, AKV, KVLORA, gthread, nthreads);
            cache_rows_to_bf16(args.in[3] + (size_t)l * 8 * PAST * ROPE, KROPE, ROPE, gthread, nthreads);
            const float* g = args.in[6] + (size_t)l * DM;
            for (int m = gw; m < MTOK; m += NGW) rms_row_4096(m < NP ? args.in[0] + (size_t)m * DM : args.in[1] + (size_t)(m - NP) * DM, g, XN + (size_t)m * DM, LANE);
            }
        }
        GRID_BAR();
        }
        for (int rep_ = 0; rep_ < (((PROBE_MASK >> 1) & 1) ? 2 : 1); ++rep_) if constexpr ((PHMASK >> 1) & 1) {
            PHASE_PTRS(); (void)OUT;
            pg8::Gemm g{l == 0 ? XN : Y0B, WIN_T, MTOK, NINP, DM, nullptr}; pg8::StaticOrder S; S.init(MTOK, NINP, G_, bx_);
            pg8::EpiIn E{LAT, SBQ, SBK, SBV, OUT + O_SBK_P + (size_t)l * NP * 2048, OUT + O_SBV_P + (size_t)l * NP * 2048,
                         OUT + O_SBK_S + (size_t)l * NS * 2048, OUT + O_SBV_S + (size_t)l * NS * 2048, QS_SB, l == 0 ? nullptr : SSQY, EPS};
            const bool bg = (l == 0 && G_ == 256);
            const int rsplit = bg ? ((bx_ & 7) >> 1) : 0;
#pragma unroll 1
            for (int seg = 0; seg < 2; ++seg) {
                pg8::SubRange<pg8::StaticOrder> SS{S, seg ? rsplit : 0, seg ? (1 << 30) : rsplit};
                pg8::gemm_phase<pg8::EpiIn, pg8::SubRange<pg8::StaticOrder>, true, true>(F.lds + RING_OFF, g, SS, E);
                if (seg == 0 && bg) {
                    LAS float* scr = (LAS float*)(F.lds + RING_OFF + WAVE * 16384);
                    CONVERT_ITEMS(0, EARLY0_ITEMS, NITEMS, gw, NGW);
                    __syncthreads();
                }
            }
        }
        GRID_BAR();
        for (int rep_ = 0; rep_ < (((PROBE_MASK >> 2) & 1) ? 2 : 1); ++rep_) if constexpr ((PHMASK >> 2) & 1) {
            PHASE_PTRS(); (void)OUT;
            for (int i = gthread; i < MTOK; i += nthreads) { SSQH[i] = 0.f; SSQM[i] = 0.f; SSQS[i] = 0.f; if (l == 0) SSQY[i] = 0.f; }
            const float* g_q_a = args.in[8] + (size_t)l * QLORA; const float* g_kv_a = args.in[10] + (size_t)l * KVLORA; const float* g_k_rope = args.in[15] + (size_t)l * ROPE;
            for (int m = gw; m < MTOK; m += NGW) {
                const float* lr = LAT + (size_t)m * 1792; const int kvr = kvrow_of(m), pos = pos_of(m);
                {
                    f32x4 v[4]; float s = 0.f;
#pragma unroll
                    for (int j = 0; j < 4; ++j) { v[j] = *(const GAS f32x4*)(lr + 4 * (64 * j + LANE)); s += (v[j].x * v[j].x + v[j].y * v[j].y) + (v[j].z * v[j].z + v[j].w * v[j].w); }
                    const float rstd = 1.0f / sqrtf(wave_sum(s) * (1.f / 1024.f) + EPS);
#pragma unroll
                    for (int j = 0; j < 4; ++j) { const f32x4 gg = *(const GAS f32x4*)(g_q_a + 4 * (64 * j + LANE));
                        *(GAS unsigned long long*)(QLAT + (size_t)m * QLORA + 4 * (64 * j + LANE)) =
                            (unsigned long long)pkbf(v[j].x * rstd * gg.x, v[j].y * rstd * gg.y) | ((unsigned long long)pkbf(v[j].z * rstd * gg.z, v[j].w * rstd * gg.w) << 32); }
                }
                {
                    f32x4 v[2]; float s = 0.f;
#pragma unroll
                    for (int j = 0; j < 2; ++j) { v[j] = *(const GAS f32x4*)(lr + 1024 + 4 * (64 * j + LANE)); s += (v[j].x * v[j].x + v[j].y * v[j].y) + (v[j].z * v[j].z + v[j].w * v[j].w); }
                    const float rstd = 1.0f / sqrtf(wave_sum(s) * (1.f / 512.f) + EPS);
                    float* oc = (m < NP) ? OUT + O_CKV_P + ((size_t)l * NP + m) * KVLORA : OUT + O_CKV_S + ((size_t)l * NS + (m - NP)) * KVLORA;
#pragma unroll
                    for (int j = 0; j < 2; ++j) { const f32x4 gg = *(const GAS f32x4*)(g_kv_a + 4 * (64 * j + LANE));
                        const f32x4 c = {v[j].x * rstd * gg.x, v[j].y * rstd * gg.y, v[j].z * rstd * gg.z, v[j].w * rstd * gg.w};
                        *(GAS f32x4*)(oc + 4 * (64 * j + LANE)) = c;
                        *(GAS unsigned long long*)(AKV + (size_t)kvr * KVLORA + 4 * (64 * j + LANE)) = (unsigned long long)pkbf(c.x, c.y) | ((unsigned long long)pkbf(c.z, c.w) << 32); }
                }
                {
                    const float x = lr[1536 + LANE];
                    const float rstd = 1.0f / sqrtf(wave_sum(x * x) * (1.f / 64.f) + EPS);
                    const float xn = x * rstd * g_k_rope[LANE]; const float xp = __shfl_xor(xn, 32);
                    const f32x2 cs = TAB[pos * 32 + (LANE & 31)];
                    const float o = (LANE < 32) ? xn * cs.x - xp * cs.y : xp * cs.y + xn * cs.x;
                    float* okr = (m < NP) ? OUT + O_KR_P + ((size_t)l * NP + m) * ROPE : OUT + O_KR_S + ((size_t)l * NS + (m - NP)) * ROPE;
                    okr[LANE] = o;
                    const float on = __shfl_xor(o, 1);
                    if ((LANE & 1) == 0) *(GAS unsigned*)(KROPE + (size_t)kvr * ROPE + LANE) = pkbf(o, on);
                }
            }
        }
        GRID_BAR();
        for (int rep_ = 0; rep_ < (((PROBE_MASK >> 3) & 1) ? 2 : 1); ++rep_) if constexpr ((PHMASK >> 3) & 1) {
            PHASE_PTRS(); (void)OUT;
            pg8::Gemm g{QLAT, WQB_T, MTOK, 3072, QLORA, nullptr}; pg8::StaticOrder S; S.init(MTOK, 3072, G_, bx_);
            pg8::EpiQb E{QB, args.in[12] + (size_t)l * NOPE, args.in[13] + (size_t)l * ROPE, TAB, (LAS float*)(F.lds + XCH_OFF), QS_MLA, EPS};
            pg8::gemm_phase<pg8::EpiQb, pg8::StaticOrder, true, true>(F.lds + RING_OFF, g, S, E);
        }
        for (int rep_ = 0; rep_ < (((PROBE_MASK >> 11) & 1) ? 2 : 1); ++rep_) if constexpr ((PHMASK >> 11) & 1) {
            PHASE_PTRS(); (void)OUT;
            pg8::Gemm g{AKV, WKVB_T, KVROWS, 4096, KVLORA, nullptr}; pg8::StaticOrder S; S.init(KVROWS, 4096, G_, (bx_ + G_ - 24) % G_);
            pg8::EpiKvbN E{KN, VB, args.in[14] + (size_t)l * NOPE, (LAS float*)(F.lds + XCH_OFF), EPS};
            pg8::gemm_phase<pg8::EpiKvbN, pg8::StaticOrder, true, true>(F.lds + RING_OFF, g, S, E);
        }
        GRID_BAR();
        for (int rep_ = 0; rep_ < (((PROBE_MASK >> 5) & 1) ? 2 : 1); ++rep_) if constexpr ((PHMASK >> 5) & 1) {
            PHASE_PTRS(); (void)OUT;
            const int v = VCU, bh = v >> 2, b = bh >> 4, h = bh & 15, s = v & 3;
            ALAS char* al = (ALAS char*)(F.lds + RING_OFF);
#pragma unroll 1
            for (int k = 0; k < 5; ++k) {
                att::Unit u;
                if (k < 4) { const int qb = (k == 0) ? s : (k == 1) ? 7 - s : (k == 2) ? 8 + s : 15 - s; const size_t m0 = (size_t)b * SEQ + (size_t)qb * 256, kv0 = (size_t)b * SEQ;
                    u.Q = QB + m0 * 3072 + h * 192; u.ldq = 3072; u.K = KN + kv0 * 2048 + h * 128; u.Kr = KROPE + kv0 * ROPE; u.V = VB + kv0 * 2048 + h * 128;
                    u.O = MERGED + m0 * 4096 + h * 128; u.ldo = 4096; u.ssq = SSQP + m0 * 32 + h; u.Kf0 = u.Vf0 = u.Kf1 = u.Vf1 = nullptr; u.split = 0; u.P0 = qb * 256; u.NT = 4 * qb + 4; u.nact = 8; }
                else { if (v >= 128) break; const int sb = v >> 4, sh = v & 15; const size_t m0 = (size_t)NP + (size_t)sb * 64, kv0 = (size_t)NP + (size_t)sb * SKVS;
                    u.Q = QB + m0 * 3072 + sh * 192; u.ldq = 3072; u.K = KN + kv0 * 2048 + sh * 128; u.Kr = KROPE + kv0 * ROPE; u.V = VB + kv0 * 2048 + sh * 128;
                    u.O = MERGED + m0 * 4096 + sh * 128; u.ldo = 4096; u.ssq = SSQP + m0 * 32 + sh; u.Kf0 = u.Vf0 = u.Kf1 = u.Vf1 = nullptr; u.split = 0; u.P0 = PAST; u.NT = 17; u.nact = 2; }
                if constexpr ((PHMASK >> 12) & 1) att::mla_unit_dma<0>(u, al);
            }
#pragma unroll 1
            for (int k = 0; k < 5; ++k) {
                att::Unit u;
                if (k < 4) { const int qb = (k == 0) ? s : (k == 1) ? 7 - s : (k == 2) ? 8 + s : 15 - s; const size_t m0 = (size_t)b * SEQ + (size_t)qb * 256, kv0 = (size_t)b * SEQ;
                    u.Q = SBQ + m0 * 2048 + h * 128; u.ldq = 2048; u.K = nullptr; u.Kr = nullptr; u.V = nullptr; u.split = 1 << 30;
                    u.Kf0 = OUT + O_SBK_P + ((size_t)l * NP + kv0) * 2048 + h * 128; u.Vf0 = OUT + O_SBV_P + ((size_t)l * NP + kv0) * 2048 + h * 128; u.Kf1 = u.Kf0; u.Vf1 = u.Vf0;
                    u.O = MERGED + m0 * 4096 + 2048 + h * 128; u.ldo = 4096; u.ssq = SSQP + m0 * 32 + 16 + h; u.P0 = qb * 256; u.NT = 4 * qb + 4; u.nact = 8; }
                else { if (v < 128) break; const int w = v - 128, sb = w >> 4, sh = w & 15; const size_t m0 = (size_t)NP + (size_t)sb * 64, kv0 = (size_t)NP + (size_t)sb * SKVS;
                    u.Q = SBQ + m0 * 2048 + sh * 128; u.ldq = 2048; u.K = nullptr; u.Kr = nullptr; u.V = nullptr; u.split = PAST / 64;
                    u.Kf0 = args.in[4] + ((size_t)(l * 8 + sb) * PAST) * 2048 + sh * 128; u.Vf0 = args.in[5] + ((size_t)(l * 8 + sb) * PAST) * 2048 + sh * 128;
                    u.Kf1 = OUT + O_SBK_S + ((size_t)l * NS + (size_t)sb * 64) * 2048 + sh * 128; u.Vf1 = OUT + O_SBV_S + ((size_t)l * NS + (size_t)sb * 64) * 2048 + sh * 128;
                    u.O = MERGED + m0 * 4096 + 2048 + sh * 128; u.ldo = 4096; u.ssq = SSQP + m0 * 32 + 16 + sh; u.P0 = PAST; u.NT = 17; u.nact = 2; }
                if constexpr ((PHMASK >> 13) & 1) att::attn_unit<false>(u, al);
            }
        }
        GRID_BAR();
#if !ATT_SSQ_ATOMICS
        {
            PHASE_PTRS(); (void)OUT;
            for (int i = gthread; i < MTOK * 2; i += nthreads) { const int m = i >> 1, half = i & 1; const GAS f32x4* p = (const GAS f32x4*)(SSQP + (size_t)m * 32 + half * 16);
                const f32x4 a = p[0], b = p[1], c = p[2], d = p[3];
                const float s = (((a.x + a.y) + (a.z + a.w)) + ((b.x + b.y) + (b.z + b.w))) + (((c.x + c.y) + (c.z + c.w)) + ((d.x + d.y) + (d.z + d.w)));
                (half ? SSQS : SSQM)[m] = s; }
        }
        GRID_BAR();
#endif
        for (int rep_ = 0; rep_ < (((PROBE_MASK >> 7) & 1) ? 2 : 1); ++rep_) if constexpr ((PHMASK >> 7) & 1) {
            PHASE_PTRS(); (void)OUT;
            pg8::Gemm g{MERGED, WO_T, MTOK, DM, DM, SLAB}; pg8::TailSplitOrder S; S.init2(MTOK, DM, DM, G_, bx_, SLAB, 2);
            pg8::EpiResP<true> E{args.in[0], args.in[1], nullptr, XN, SSQH, SSQM, SSQS, EPS, l == 0 ? nullptr : Y0B};
            pg8::gemm_phase<pg8::EpiResP<true>, pg8::TailSplitOrder, true, true>(F.lds + RING_OFF, g, S, E);
        }
        GRID_BAR();
        {
            PHASE_PTRS(); pg8::TailSplitOrder S; S.init2(MTOK, DM, DM, G_, bx_, SLAB, 2);
            tail_reduce_res<true>(S, args.in[0], args.in[1], nullptr, XN, SSQH, SSQM, SSQS, l == 0 ? nullptr : Y0B, ptid_);
        }
        GRID_BAR();
        for (int rep_ = 0; rep_ < (((PROBE_MASK >> 9) & 1) ? 2 : 1); ++rep_) if constexpr ((PHMASK >> 9) & 1) {
            PHASE_PTRS(); (void)OUT;
            pg8::Gemm g{XN, WUP_T, MTOK, DFF, DM, nullptr}; pg8::StaticOrder S; S.init(MTOK, DFF, G_, bx_);
            pg8::EpiRelu2N E{UB, DFF, SSQH, EPS};
            pg8::gemm_phase<pg8::EpiRelu2N, pg8::StaticOrder, true, true>(F.lds + RING_OFF, g, S, E);
            if (l + 1 < 2 && G_ == 256 && bx_ >= 128) {
                LAS float* scr = (LAS float*)(F.lds + RING_OFF + WAVE * 16384);
                CONVERT_ITEMS(l + 1, 0, EARLY_ITEMS, (bx_ - 128) * NWAVES + WAVE, 128 * NWAVES);
            }
        }
        GRID_BAR();
        for (int rep_ = 0; rep_ < (((PROBE_MASK >> 10) & 1) ? 2 : 1); ++rep_) if constexpr ((PHMASK >> 10) & 1) {
            PHASE_PTRS(); (void)OUT;
            pg8::Gemm g{UB, l == 0 ? WDN_T0 : WDN_T1, MTOK, DM, DFF, SLAB, 1};     pg8::TailSplitOrder S; S.wgm = G5_WGM; S.init2(MTOK, DM, DFF, G_, bx_, SLAB);
            pg8::EpiResP<false> E{nullptr, nullptr, OUT + O_Y, XN, SSQY, nullptr, nullptr, EPS, l == 1 ? nullptr : Y0B};
            const bool bg = (l + 1 < 2 && G_ == 256);
            const int rsplit = bg ? ((bx_ & 7) >> 1) : 0;
#pragma unroll 1
            for (int seg = 0; seg < 2; ++seg) {
                pg8::SubRange<pg8::TailSplitOrder> SS{S, seg ? rsplit : 0, seg ? (1 << 30) : rsplit};
                pg8::gemm_phase<pg8::EpiResP<false>, pg8::SubRange<pg8::TailSplitOrder>, true, true>(F.lds + RING_OFF, g, SS, E);
                if (seg == 0 && bg) {
                    LAS float* scr = (LAS float*)(F.lds + RING_OFF + WAVE * 16384);
                    CONVERT_ITEMS(l + 1, EARLY_ITEMS, NITEMS, gw, NGW);
                    __syncthreads();
                }
            }
        }
        GRID_BAR();
        {
            PHASE_PTRS(); pg8::TailSplitOrder S; S.wgm = G5_WGM; S.init2(MTOK, DM, DFF, G_, bx_, SLAB);
            tail_reduce_res<false>(S, nullptr, nullptr, OUT + O_Y, XN, SSQY, nullptr, nullptr, l == 1 ? nullptr : Y0B, ptid_);
            if (l + 1 < 2) {
                cache_rows_to_bf16(args.in[2] + (size_t)(l + 1) * 8 * PAST * KVLORA, AKV, KVLORA, gthread, nthreads);
                cache_rows_to_bf16(args.in[3] + (size_t)(l + 1) * 8 * PAST * ROPE, KROPE, ROPE, gthread, nthreads);
            }
        }
        GRID_BAR();
    }
#undef GRID_BAR
}

extern "C" void kernel_launch(void* const* d_in, const int* in_sizes, int n_in, void* d_out, int out_size, void* d_ws, size_t ws_size, hipStream_t stream) {
    static int grid = 0;
    if (grid == 0) {
        if (n_in != 22 || (size_t)out_size != O_END || ws_size < WS_END) { fprintf(stderr, "kernel_launch: unexpected shapes: n_in %d out %d ws %zu (need %zu)\n", n_in, out_size, ws_size, (size_t)WS_END); grid = -1; return; }
        int dev = 0, cus = 0, per_cu = 0;
        if (hipGetDevice(&dev) != hipSuccess || hipDeviceGetAttribute(&cus, hipDeviceAttributeMultiprocessorCount, dev) != hipSuccess) { grid = -1; return; }
        if (hipFuncSetAttribute((const void*)hymba_fwd, hipFuncAttributeMaxDynamicSharedMemorySize, LDS_BYTES) != hipSuccess) { fprintf(stderr, "kernel_launch: hipFuncSetAttribute failed\n"); grid = -1; return; }
        if (hipOccupancyMaxActiveBlocksPerMultiprocessor(&per_cu, (const void*)hymba_fwd, NWAVES * 64, LDS_BYTES) != hipSuccess || per_cu < 1) { fprintf(stderr, "kernel_launch: occupancy query reports %d\n", per_cu); }
        (void)hipGetLastError();
        grid = cus;
        if (grid != 256) fprintf(stderr, "kernel_launch: %d CUs (the attention deal assumes 256 workgroups)\n", grid);
    }
    if (grid < 0) return;
    if (hipMemsetAsync((char*)d_ws + WS_CTL, 0, CTL_ZERO_BYTES, stream) != hipSuccess) return;
    Args a{};
    for (int i = 0; i < 22; ++i) a.in[i] = (const float*)d_in[i];
    a.out = (float*)d_out; a.ws = (unsigned char*)d_ws;
    hipLaunchKernelGGL(hymba_fwd, dim3(grid), dim3(NWAVES * 64), LDS_BYTES, stream, a);
}
```

```cpp
#include <hip/hip_runtime.h>
#include <cstdio>
#include <cstdint>
#include <type_traits>
namespace pg8 {
#define PG8_LAS __attribute__((address_space(3)))
typedef unsigned short bf16_t;
typedef short bf16x8 __attribute__((ext_vector_type(8)));
typedef float f32x4 __attribute__((ext_vector_type(4)));
typedef unsigned u32x4 __attribute__((ext_vector_type(4)));
constexpr int BM = 256, BK = 64, HALF = 128, HTB = HALF * BK * 2  , STAGE_BYTES = 8 * HTB, NXCD = 8, WGM = 8;

__host__ __device__ __forceinline__ int lds_byte(int r, int c) { const int st = (r >> 4) * 2 + (c >> 5), rr = r & 15, cc = c & 31, ob = rr * 64 + cc * 2; return st * 1024 + (ob ^ (((ob >> 9) & 1) << 5)); }
__host__ __device__ __forceinline__ void stage_rc(int b, int& R, int& C) { const int st = b / 1024, sb = b % 1024, swz = sb ^ (((sb >> 9) & 1) << 5); R = (st >> 1) * 16 + swz / 64; C = (st & 1) * 32 + (swz % 64) / 2; }
__host__ __device__ __forceinline__ int perm32(int rho) { const int n = rho >> 4, i = rho & 15; return 8 * (i >> 2) + 4 * n + (i & 3); }

struct Unit { int pm, pn, kt0, nkt, part; };
struct Gemm { const bf16_t* A; const bf16_t* Bt; int M, N, K; float* slab; int blocked = 0; };

struct StaticOrder {
    int nM, nN, nwg, G, c, wgm = WGM;
    __host__ __device__ __forceinline__ void init(int M, int N, int G_, int c_) { nM = M / BM; nN = N / BM; nwg = nM * nN; G = G_; c = c_; }
    __host__ __device__ __forceinline__ bool next(int i, Unit& u) const {
        const long L = (long)i * G + c; if (L >= nwg) return false;
        int wgid = (int)L; { const int q = nwg / NXCD, r = nwg % NXCD, xcd = wgid % NXCD, off = wgid / NXCD; wgid = (xcd < r ? xcd * (q + 1) : r * (q + 1) + (xcd - r) * q) + off; }
        const int nig = wgm * nN, gid = wgid / nig, fm = gid * wgm, gsz = (nM - fm) < wgm ? (nM - fm) : wgm;
        u.pm = fm + ((wgid % nig) % gsz); u.pn = (wgid % nig) / gsz; u.kt0 = 0; u.nkt = 0; u.part = -1; return true;
    }
    __host__ __device__ __forceinline__ void map(int L, Unit& u) const {
        int wgid = L; { const int q = nwg / NXCD, r = nwg % NXCD, xcd = wgid % NXCD, off = wgid / NXCD; wgid = (xcd < r ? xcd * (q + 1) : r * (q + 1) + (xcd - r) * q) + off; }
        const int nig = wgm * nN, gid = wgid / nig, fm = gid * wgm, gsz = (nM - fm) < wgm ? (nM - fm) : wgm;
        u.pm = fm + ((wgid % nig) % gsz); u.pn = (wgid % nig) / gsz; u.kt0 = 0; u.nkt = 0; u.part = -1;
    }
    __device__ __forceinline__ void a_ready(const Unit&) const {}
    __device__ __forceinline__ void done(const Unit&) const {}
};

template <class S_> struct SubRange {
    const S_& s; int lo, hi;
    __device__ __forceinline__ bool next(int i, Unit& u) const { return (lo + i < hi) && s.next(lo + i, u); }
    __device__ __forceinline__ void a_ready(const Unit& u) const { s.a_ready(u); }
    __device__ __forceinline__ void done(const Unit& u) const { s.done(u); }
};

__device__ __forceinline__ unsigned cvt_pk_bf16(float lo, float hi) { unsigned r; asm volatile("v_cvt_pk_bf16_f32 %0, %1, %2" : "=v"(r) : "v"(lo), "v"(hi)); return r; }

struct TailSplitOrder : StaticOrder {
    int nfull, nsplit, nkt_full, halves; float* slab;
    __host__ __device__ __forceinline__ void init2(int M, int N, int K, int G_, int c_, float* slab_, int halves_ = 1) { init(M, N, G_, c_); nkt_full = K / BK; slab = slab_; halves = halves_; nfull = nwg / G; const int rem = nwg - nfull * G;
        nsplit = (rem > 0 && G % rem == 0 && (nkt_full % (2 * (G / rem))) == 0 && nkt_full / (G / rem) >= 4) ? G / rem : 1; }
    __host__ __device__ __forceinline__ bool next(int i, Unit& u) const {
        const int ii = i / halves, hh = i % halves;
        if (ii < nfull || nsplit == 1) { if (!StaticOrder::next(ii, u)) return false; if (halves == 2) { u.nkt = nkt_full / 2; u.kt0 = hh * u.nkt; u.part = hh == 0 ? -2 : -1; } return true; }
        if (ii > nfull || hh != 0) return false;
        const int j = c / nsplit, s = c % nsplit; map(nfull * G + j, u); u.nkt = nkt_full / nsplit; u.kt0 = s * u.nkt; u.part = j * nsplit + s; return true;
    }
};

struct PanelOrder : TailSplitOrder {
    bool panel;
    __host__ __device__ __forceinline__ void init3(int M, int N, int K, int G_, int c_, float* slab_) { init2(M, N, K, G_, c_, slab_); panel = (G_ == 256 && nM == 66 && nN == 16 && nsplit == 8); }
    __host__ __device__ __forceinline__ void mapu(int L, Unit& u) const {
        if (L < 1024) { const int r = L >> 8, x = L & 7, idx = (L & 255) >> 3; u.pm = 16 * r + 4 * (x >> 1) + (idx & 3); u.pn = 8 * (x & 1) + (idx >> 2); }
        else { const int j = L - 1024; u.pm = 64 + (j & 1); u.pn = j >> 1; }
        u.kt0 = 0; u.nkt = 0; u.part = -1; }
    __host__ __device__ __forceinline__ bool next(int i, Unit& u) const {
        if (!panel) return TailSplitOrder::next(i, u);
        if (i < nfull) { mapu(i * G + c, u); return true; }
        if (i > nfull) return false;
        const int j = c / nsplit, s = c % nsplit; mapu(nfull * G + j, u); u.nkt = nkt_full / nsplit; u.kt0 = s * u.nkt; u.part = j * nsplit + s; return true; }
    __host__ __device__ __forceinline__ void map(int L, Unit& u) const { if (panel) mapu(L, u); else TailSplitOrder::map(L, u); }
};

typedef unsigned u32x2 __attribute__((ext_vector_type(2)));
constexpr int HY_NP = 16384;
__device__ __forceinline__ int hy_kvrow(int m) { return m < HY_NP ? m : HY_NP + ((m - HY_NP) >> 6) * 1088 + 1024 + ((m - HY_NP) & 63); }

struct EpiIn {
    static constexpr bool PERM = true, AFTER_DRAIN = false;
    float* LAT; bf16_t* SBQ; bf16_t* SBK; bf16_t* SBV; float* outK_p; float* outV_p; float* outK_s; float* outV_s; float qscale;
    const float* ssq; float eps;
    __device__ __forceinline__ void operator()(const f32x4 (&acc)[2][2][4][2], const Unit& u, int wr, int wc, int fr, int fq) const {
        const int row0 = u.pm * BM + wr * 64 + fr, colw = wc * 32 + 8 * fq, pn = u.pn;
        float rs[2][4];
#pragma unroll
        for (int ai = 0; ai < 2; ++ai)
#pragma unroll
            for (int m = 0; m < 4; ++m) rs[ai][m] = ssq ? 1.0f / sqrtf(__hip_atomic_load(ssq + row0 + ai * HALF + m * 16, __ATOMIC_RELAXED, __HIP_MEMORY_SCOPE_AGENT) * (1.f / 4096.f) + eps) : 1.0f;
        if (pn < 7) {
#pragma unroll
            for (int ai = 0; ai < 2; ++ai)
#pragma unroll
                for (int m = 0; m < 4; ++m) { float* rp = LAT + (size_t)(row0 + ai * HALF + m * 16) * 1792 + pn * BM + colw;
#pragma unroll
                    for (int bj = 0; bj < 2; ++bj) { *(f32x4*)(rp + bj * HALF) = acc[ai][bj][m][0] * rs[ai][m]; *(f32x4*)(rp + bj * HALF + 4) = acc[ai][bj][m][1] * rs[ai][m]; } }
        } else if (pn < 15) {
#pragma unroll
            for (int ai = 0; ai < 2; ++ai)
#pragma unroll
                for (int m = 0; m < 4; ++m) { bf16_t* rp = SBQ + (size_t)(row0 + ai * HALF + m * 16) * 2048 + (pn - 7) * BM + colw;
#pragma unroll
                    for (int bj = 0; bj < 2; ++bj) { const float sc = qscale * rs[ai][m]; const f32x4 v0 = acc[ai][bj][m][0] * sc, v1 = acc[ai][bj][m][1] * sc;
                        u32x4 w; w.x = cvt_pk_bf16(v0[0], v0[1]); w.y = cvt_pk_bf16(v0[2], v0[3]); w.z = cvt_pk_bf16(v1[0], v1[1]); w.w = cvt_pk_bf16(v1[2], v1[3]);
                        *(u32x4*)(rp + bj * HALF) = w; } }
        } else {
            const bool isv = pn >= 23; const int c0 = (pn - (isv ? 23 : 15)) * BM + colw;
            float* fop = isv ? outV_p : outK_p; float* fos = isv ? outV_s : outK_s;
#pragma unroll
            for (int ai = 0; ai < 2; ++ai)
#pragma unroll
                for (int m = 0; m < 4; ++m) { const int row = row0 + ai * HALF + m * 16;
                    float* fo = (row < HY_NP) ? fop + (size_t)row * 2048 : fos + (size_t)(row - HY_NP) * 2048;
                    fo += c0;
#pragma unroll
                    for (int bj = 0; bj < 2; ++bj) { __builtin_nontemporal_store(acc[ai][bj][m][0] * rs[ai][m], (f32x4*)(fo + bj * HALF)); __builtin_nontemporal_store(acc[ai][bj][m][1] * rs[ai][m], (f32x4*)(fo + bj * HALF + 4)); } }
        }
    }
};
struct EpiF32 {
    static constexpr bool PERM = false, AFTER_DRAIN = false;
    float* C; int ldc;
    __device__ __forceinline__ void operator()(const f32x4 (&acc)[2][2][4][2], const Unit& u, int wr, int wc, int fr, int fq) const {
        const int row0 = u.pm * BM + wr * 64 + fr, col0 = u.pn * BM + wc * 32 + 4 * fq;
#pragma unroll
        for (int ai = 0; ai < 2; ++ai)
#pragma unroll
            for (int m = 0; m < 4; ++m) { float* rowp = C + (size_t)(row0 + ai * HALF + m * 16) * ldc + col0;
#pragma unroll
                for (int bj = 0; bj < 2; ++bj)
#pragma unroll
                    for (int n = 0; n < 2; ++n) *(f32x4*)(rowp + bj * HALF + n * 16) = acc[ai][bj][m][n]; }
    }
};
struct EpiKvb {
    static constexpr bool PERM = true, AFTER_DRAIN = false;
    float* KNRAW; bf16_t* VB;
    __device__ __forceinline__ void operator()(const f32x4 (&acc)[2][2][4][2], const Unit& u, int wr, int wc, int fr, int fq) const {
        const int row0 = u.pm * BM + wr * 64 + fr, colw = wc * 32 + 8 * fq, pn = u.pn;
        if (pn < 8) {
#pragma unroll
            for (int ai = 0; ai < 2; ++ai)
#pragma unroll
                for (int m = 0; m < 4; ++m) { float* rp = KNRAW + (size_t)(row0 + ai * HALF + m * 16) * 2048 + pn * BM + colw;
#pragma unroll
                    for (int bj = 0; bj < 2; ++bj) { *(f32x4*)(rp + bj * HALF) = acc[ai][bj][m][0]; *(f32x4*)(rp + bj * HALF + 4) = acc[ai][bj][m][1]; } }
        } else {
#pragma unroll
            for (int ai = 0; ai < 2; ++ai)
#pragma unroll
                for (int m = 0; m < 4; ++m) { bf16_t* rp = VB + (size_t)(row0 + ai * HALF + m * 16) * 2048 + (pn - 8) * BM + colw;
#pragma unroll
                    for (int bj = 0; bj < 2; ++bj) { const f32x4 v0 = acc[ai][bj][m][0], v1 = acc[ai][bj][m][1];
                        u32x4 w; w.x = cvt_pk_bf16(v0[0], v0[1]); w.y = cvt_pk_bf16(v0[2], v0[3]); w.z = cvt_pk_bf16(v1[0], v1[1]); w.w = cvt_pk_bf16(v1[2], v1[3]);
                        *(u32x4*)(rp + bj * HALF) = w; } }
        }
    }
};
struct EpiRes {
    static constexpr bool PERM = false, AFTER_DRAIN = false;
    const float* resP; const float* resS; float* out;
    __device__ __forceinline__ void operator()(const f32x4 (&acc)[2][2][4][2], const Unit& u, int wr, int wc, int fr, int fq) const {
        const int row0 = u.pm * BM + wr * 64 + fr, col0 = u.pn * BM + wc * 32 + 4 * fq;
        const bool samp = u.pm >= HY_NP / BM;
#pragma unroll
        for (int ai = 0; ai < 2; ++ai)
#pragma unroll
            for (int m = 0; m < 4; ++m) { const int row = row0 + ai * HALF + m * 16;
                const float* rp = samp ? resS + (size_t)(row - HY_NP) * 4096 + col0 : resP + (size_t)row * 4096 + col0;
                float* op = out + (size_t)row * 4096 + col0;
#pragma unroll
                for (int bj = 0; bj < 2; ++bj)
#pragma unroll
                    for (int n = 0; n < 2; ++n) { const f32x4 r = *(const f32x4*)(rp + bj * HALF + n * 16); *(f32x4*)(op + bj * HALF + n * 16) = r + acc[ai][bj][m][n]; } }
    }
};
struct EpiRelu2 {
    static constexpr bool PERM = true, AFTER_DRAIN = false;
    bf16_t* O; int ldc;
    __device__ __forceinline__ void operator()(const f32x4 (&acc)[2][2][4][2], const Unit& u, int wr, int wc, int fr, int fq) const {
        const int row0 = u.pm * BM + wr * 64 + fr, col0 = u.pn * BM + wc * 32 + 8 * fq;
#pragma unroll
        for (int ai = 0; ai < 2; ++ai)
#pragma unroll
            for (int m = 0; m < 4; ++m) { bf16_t* rowp = O + (size_t)(row0 + ai * HALF + m * 16) * ldc + col0;
#pragma unroll
                for (int bj = 0; bj < 2; ++bj) { f32x4 v0 = acc[ai][bj][m][0], v1 = acc[ai][bj][m][1];
#pragma unroll
                    for (int e = 0; e < 4; ++e) { const float a = fmaxf(v0[e], 0.f), b = fmaxf(v1[e], 0.f); v0[e] = a * a; v1[e] = b * b; }
                    u32x4 w; w.x = cvt_pk_bf16(v0[0], v0[1]); w.y = cvt_pk_bf16(v0[2], v0[3]); w.z = cvt_pk_bf16(v1[0], v1[1]); w.w = cvt_pk_bf16(v1[2], v1[3]);
                    *(u32x4*)(rowp + bj * HALF) = w; } }
    }
};

typedef float f32x2e __attribute__((ext_vector_type(2)));
__device__ __forceinline__ void head_ssq_exchange(const f32x4 (&acc)[2][2][4][2], PG8_LAS float* P, int wr, int wc, int fr, int fq, float (&rstd)[2][4][2], float inv_n, float eps) {
#pragma unroll
    for (int ai = 0; ai < 2; ++ai)
#pragma unroll
        for (int m = 0; m < 4; ++m)
#pragma unroll
            for (int bj = 0; bj < 2; ++bj) {
                const f32x4 a = acc[ai][bj][m][0], b = acc[ai][bj][m][1];
                float s = ((a[0] * a[0] + a[1] * a[1]) + (a[2] * a[2] + a[3] * a[3])) + ((b[0] * b[0] + b[1] * b[1]) + (b[2] * b[2] + b[3] * b[3]));
                s += __shfl_xor(s, 16); s += __shfl_xor(s, 32);
                if (fq == 0) P[(ai * HALF + wr * 64 + m * 16 + fr) * 8 + bj * 4 + wc] = s;
            }
    asm volatile("s_waitcnt lgkmcnt(0)" ::: "memory"); __builtin_amdgcn_s_barrier(); asm volatile("" ::: "memory");
#pragma unroll
    for (int ai = 0; ai < 2; ++ai)
#pragma unroll
        for (int m = 0; m < 4; ++m)
#pragma unroll
            for (int bj = 0; bj < 2; ++bj) {
                const f32x4 p = *(const PG8_LAS f32x4*)(P + (ai * HALF + wr * 64 + m * 16 + fr) * 8 + bj * 4);
                rstd[ai][m][bj] = 1.0f / sqrtf(((p[0] + p[1]) + (p[2] + p[3])) * inv_n + eps);
            }
}
struct EpiQb {
    static constexpr bool PERM = true, AFTER_DRAIN = false;
    bf16_t* QB; const float* g_nope; const float* g_rope; const f32x2e* tab; PG8_LAS float* P; float qs, eps;
    __device__ __forceinline__ void operator()(const f32x4 (&acc)[2][2][4][2], const Unit& u, int wr, int wc, int fr, int fq) const {
        const int row0 = u.pm * BM + wr * 64 + fr, pn = u.pn;
        if (pn < 8) {
            float rstd[2][4][2]; head_ssq_exchange(acc, P, wr, wc, fr, fq, rstd, 1.f / 128.f, eps);
            const f32x4 g0 = *(const f32x4*)(g_nope + wc * 32 + 8 * fq) * qs, g1 = *(const f32x4*)(g_nope + wc * 32 + 8 * fq + 4) * qs;
#pragma unroll
            for (int ai = 0; ai < 2; ++ai)
#pragma unroll
                for (int m = 0; m < 4; ++m) { bf16_t* rp = QB + (size_t)(row0 + ai * HALF + m * 16) * 3072 + (2 * pn) * 192 + wc * 32 + 8 * fq;
#pragma unroll
                    for (int bj = 0; bj < 2; ++bj) { const float r = rstd[ai][m][bj]; const f32x4 v0 = acc[ai][bj][m][0] * g0 * r, v1 = acc[ai][bj][m][1] * g1 * r;
                        u32x4 w; w.x = cvt_pk_bf16(v0[0], v0[1]); w.y = cvt_pk_bf16(v0[2], v0[3]); w.z = cvt_pk_bf16(v1[0], v1[1]); w.w = cvt_pk_bf16(v1[2], v1[3]);
                        *(u32x4*)(rp + bj * 192) = w; } }
        } else {
            const int h = 4 * (pn - 8) + wc;
            const f32x4 ga0 = *(const f32x4*)(g_rope + 8 * fq), ga1 = *(const f32x4*)(g_rope + 8 * fq + 4), gb0 = *(const f32x4*)(g_rope + 32 + 8 * fq), gb1 = *(const f32x4*)(g_rope + 32 + 8 * fq + 4);
#pragma unroll
            for (int ai = 0; ai < 2; ++ai)
#pragma unroll
                for (int m = 0; m < 4; ++m) { const int row = row0 + ai * HALF + m * 16;
                    const f32x4 a0 = acc[ai][0][m][0], a1 = acc[ai][0][m][1], b0 = acc[ai][1][m][0], b1 = acc[ai][1][m][1];
                    float s = (((a0[0] * a0[0] + a0[1] * a0[1]) + (a0[2] * a0[2] + a0[3] * a0[3])) + ((a1[0] * a1[0] + a1[1] * a1[1]) + (a1[2] * a1[2] + a1[3] * a1[3])))
                            + (((b0[0] * b0[0] + b0[1] * b0[1]) + (b0[2] * b0[2] + b0[3] * b0[3])) + ((b1[0] * b1[0] + b1[1] * b1[1]) + (b1[2] * b1[2] + b1[3] * b1[3])));
                    s += __shfl_xor(s, 16); s += __shfl_xor(s, 32);
                    const float r = 1.0f / sqrtf(s * (1.f / 64.f) + eps);
                    const int pos = row < HY_NP ? (row & 4095) : 1024 + ((row - HY_NP) & 63);
                    const f32x4* tp = (const f32x4*)(tab + pos * 32 + 8 * fq);
                    const f32x4 t0 = tp[0], t1 = tp[1], t2 = tp[2], t3 = tp[3];
                    const f32x4 x10 = a0 * ga0 * r, x11 = a1 * ga1 * r, x20 = b0 * gb0 * r, x21 = b1 * gb1 * r;
                    const f32x4 c0 = {t0[0], t0[2], t1[0], t1[2]}, s0 = {t0[1], t0[3], t1[1], t1[3]}, c1 = {t2[0], t2[2], t3[0], t3[2]}, s1 = {t2[1], t2[3], t3[1], t3[3]};
                    const f32x4 o10 = (x10 * c0 - x20 * s0) * qs, o11 = (x11 * c1 - x21 * s1) * qs, o20 = (x10 * s0 + x20 * c0) * qs, o21 = (x11 * s1 + x21 * c1) * qs;
                    bf16_t* rp = QB + (size_t)row * 3072 + h * 192 + 128 + 8 * fq;
                    u32x4 w; w.x = cvt_pk_bf16(o10[0], o10[1]); w.y = cvt_pk_bf16(o10[2], o10[3]); w.z = cvt_pk_bf16(o11[0], o11[1]); w.w = cvt_pk_bf16(o11[2], o11[3]);
                    *(u32x4*)rp = w;
                    w.x = cvt_pk_bf16(o20[0], o20[1]); w.y = cvt_pk_bf16(o20[2], o20[3]); w.z = cvt_pk_bf16(o21[0], o21[1]); w.w = cvt_pk_bf16(o21[2], o21[3]);
                    *(u32x4*)(rp + 32) = w; }
        }
    }
};
struct EpiKvbN {
    static constexpr bool PERM = true, AFTER_DRAIN = false;
    bf16_t* KN; bf16_t* VB; const float* g_nope; PG8_LAS float* P; float eps;
    __device__ __forceinline__ void operator()(const f32x4 (&acc)[2][2][4][2], const Unit& u, int wr, int wc, int fr, int fq) const {
        const int row0 = u.pm * BM + wr * 64 + fr, colw = wc * 32 + 8 * fq, pn = u.pn;
        if (pn < 8) {
            float rstd[2][4][2]; head_ssq_exchange(acc, P, wr, wc, fr, fq, rstd, 1.f / 128.f, eps);
            const f32x4 g0 = *(const f32x4*)(g_nope + colw), g1 = *(const f32x4*)(g_nope + colw + 4);
#pragma unroll
            for (int ai = 0; ai < 2; ++ai)
#pragma unroll
                for (int m = 0; m < 4; ++m) { bf16_t* rp = KN + (size_t)(row0 + ai * HALF + m * 16) * 2048 + pn * BM + colw;
#pragma unroll
                    for (int bj = 0; bj < 2; ++bj) { const float r = rstd[ai][m][bj]; const f32x4 v0 = acc[ai][bj][m][0] * g0 * r, v1 = acc[ai][bj][m][1] * g1 * r;
                        u32x4 w; w.x = cvt_pk_bf16(v0[0], v0[1]); w.y = cvt_pk_bf16(v0[2], v0[3]); w.z = cvt_pk_bf16(v1[0], v1[1]); w.w = cvt_pk_bf16(v1[2], v1[3]);
                        *(u32x4*)(rp + bj * HALF) = w; } }
        } else {
#pragma unroll
            for (int ai = 0; ai < 2; ++ai)
#pragma unroll
                for (int m = 0; m < 4; ++m) { bf16_t* rp = VB + (size_t)(row0 + ai * HALF + m * 16) * 2048 + (pn - 8) * BM + colw;
#pragma unroll
                    for (int bj = 0; bj < 2; ++bj) { const f32x4 v0 = acc[ai][bj][m][0], v1 = acc[ai][bj][m][1];
                        u32x4 w; w.x = cvt_pk_bf16(v0[0], v0[1]); w.y = cvt_pk_bf16(v0[2], v0[3]); w.z = cvt_pk_bf16(v1[0], v1[1]); w.w = cvt_pk_bf16(v1[2], v1[3]);
                        *(u32x4*)(rp + bj * HALF) = w; } }
        }
    }
};

template <bool NORM> struct EpiResP {
    static constexpr bool PERM = true, AFTER_DRAIN = false, MIDK = NORM;
    const float* resP; const float* resS; float* out; bf16_t* HB; float* ssq; const float* ssqm; const float* ssqs; float eps;
    bf16_t* YB;
    __device__ __forceinline__ void mid(f32x4 (&acc)[2][2][4][2], const Unit& u, int wr, int wc, int fr, int fq) const {
        const int row0 = u.pm * BM + wr * 64 + fr;
#pragma unroll
        for (int ai = 0; ai < 2; ++ai)
#pragma unroll
            for (int m = 0; m < 4; ++m) { const int row = row0 + ai * HALF + m * 16;
                const float a = __hip_atomic_load(ssqm + row, __ATOMIC_RELAXED, __HIP_MEMORY_SCOPE_AGENT), b = __hip_atomic_load(ssqs + row, __ATOMIC_RELAXED, __HIP_MEMORY_SCOPE_AGENT);
                const float ratio = sqrtf((b * (1.f / 2048.f) + eps) / (a * (1.f / 2048.f) + eps));
#pragma unroll
                for (int bj = 0; bj < 2; ++bj) { acc[ai][bj][m][0] *= ratio; acc[ai][bj][m][1] *= ratio; } }
    }
    __device__ __forceinline__ void operator()(const f32x4 (&acc)[2][2][4][2], const Unit& u, int wr, int wc, int fr, int fq) const {
        const int row0 = u.pm * BM + wr * 64 + fr, col0 = u.pn * BM + wc * 32 + 8 * fq;
        const bool samp = u.pm >= HY_NP / BM;
#pragma unroll
        for (int ai = 0; ai < 2; ++ai)
#pragma unroll
            for (int m = 0; m < 4; ++m) { const int row = row0 + ai * HALF + m * 16;
                if (NORM) {
                    const float* rp = samp ? resS + (size_t)(row - HY_NP) * 4096 + col0 : resP + (size_t)row * 4096 + col0; float s = 0.f;
                    const bf16_t* yp = YB + (size_t)row * 4096 + col0;
                    const float rs = 1.0f / sqrtf(__hip_atomic_load(ssqs + row, __ATOMIC_RELAXED, __HIP_MEMORY_SCOPE_AGENT) * (1.f / 2048.f) + eps);
#pragma unroll
                    for (int bj = 0; bj < 2; ++bj) { f32x4 r0, r1;
                        if (YB) { const u32x4 h = *(const u32x4*)(yp + bj * HALF);
                            r0 = (f32x4){__uint_as_float(h.x << 16), __uint_as_float(h.x & 0xffff0000u), __uint_as_float(h.y << 16), __uint_as_float(h.y & 0xffff0000u)};
                            r1 = (f32x4){__uint_as_float(h.z << 16), __uint_as_float(h.z & 0xffff0000u), __uint_as_float(h.w << 16), __uint_as_float(h.w & 0xffff0000u)}; }
                        else { r0 = *(const f32x4*)(rp + bj * HALF); r1 = *(const f32x4*)(rp + bj * HALF + 4); }
                        const f32x4 v0 = r0 + acc[ai][bj][m][0] * rs, v1 = r1 + acc[ai][bj][m][1] * rs;
                        s += ((v0[0] * v0[0] + v0[1] * v0[1]) + (v0[2] * v0[2] + v0[3] * v0[3])) + ((v1[0] * v1[0] + v1[1] * v1[1]) + (v1[2] * v1[2] + v1[3] * v1[3]));
                        u32x4 w; w.x = cvt_pk_bf16(v0[0], v0[1]); w.y = cvt_pk_bf16(v0[2], v0[3]); w.z = cvt_pk_bf16(v1[0], v1[1]); w.w = cvt_pk_bf16(v1[2], v1[3]);
                        *(u32x4*)(HB + (size_t)row * 4096 + col0 + bj * HALF) = w; }
                    s += __shfl_xor(s, 16); s += __shfl_xor(s, 32);
                    if (fq == 0) __hip_atomic_fetch_add(ssq + row, s, __ATOMIC_RELAXED, __HIP_MEMORY_SCOPE_AGENT);
                } else {
                    const bf16_t* hp = HB + (size_t)row * 4096 + col0; float* op = out + (size_t)row * 4096 + col0; float s = 0.f;
#pragma unroll
                    for (int bj = 0; bj < 2; ++bj) { const u32x4 h = *(const u32x4*)(hp + bj * HALF);
                        const f32x4 r0 = {__uint_as_float(h.x << 16), __uint_as_float(h.x & 0xffff0000u), __uint_as_float(h.y << 16), __uint_as_float(h.y & 0xffff0000u)};
                        const f32x4 r1 = {__uint_as_float(h.z << 16), __uint_as_float(h.z & 0xffff0000u), __uint_as_float(h.w << 16), __uint_as_float(h.w & 0xffff0000u)};
                        const f32x4 y0 = r0 + acc[ai][bj][m][0], y1 = r1 + acc[ai][bj][m][1];
                        if (YB) { u32x4 w; w.x = cvt_pk_bf16(y0[0], y0[1]); w.y = cvt_pk_bf16(y0[2], y0[3]); w.z = cvt_pk_bf16(y1[0], y1[1]); w.w = cvt_pk_bf16(y1[2], y1[3]);
                                  *(u32x4*)(YB + (size_t)row * 4096 + col0 + bj * HALF) = w;
                                  s += ((y0[0] * y0[0] + y0[1] * y0[1]) + (y0[2] * y0[2] + y0[3] * y0[3])) + ((y1[0] * y1[0] + y1[1] * y1[1]) + (y1[2] * y1[2] + y1[3] * y1[3])); }
                        else { __builtin_nontemporal_store(y0, (f32x4*)(op + bj * HALF)); __builtin_nontemporal_store(y1, (f32x4*)(op + bj * HALF + 4)); } }
                    if (YB) { s += __shfl_xor(s, 16); s += __shfl_xor(s, 32);
                        if (fq == 0) __hip_atomic_fetch_add(ssq + row, s, __ATOMIC_RELAXED, __HIP_MEMORY_SCOPE_AGENT); }
                } }
    }
};
struct EpiRelu2N {
    static constexpr bool PERM = true, AFTER_DRAIN = false;
    bf16_t* O; int ldc; const float* ssq; float eps;
    __device__ __forceinline__ void operator()(const f32x4 (&acc)[2][2][4][2], const Unit& u, int wr, int wc, int fr, int fq) const {
        const int row0 = u.pm * BM + wr * 64 + fr;
        bf16_t* const tile0 = O + ((size_t)u.pm * (ldc >> 6) + u.pn * 4 + (wc >> 1)) * 16384 + (wc & 1) * 32 + 8 * fq;
#pragma unroll
        for (int ai = 0; ai < 2; ++ai)
#pragma unroll
            for (int m = 0; m < 4; ++m) { const int row = row0 + ai * HALF + m * 16; bf16_t* rowp = tile0 + (wr * 64 + fr + ai * HALF + m * 16) * 64;
                const float r = 1.0f / sqrtf(__hip_atomic_load(ssq + row, __ATOMIC_RELAXED, __HIP_MEMORY_SCOPE_AGENT) * (1.f / 4096.f) + eps);
#pragma unroll
                for (int bj = 0; bj < 2; ++bj) { f32x4 v0 = acc[ai][bj][m][0], v1 = acc[ai][bj][m][1];
#pragma unroll
                    for (int e = 0; e < 4; ++e) { const float a = fmaxf(v0[e], 0.f) * r, b = fmaxf(v1[e], 0.f) * r; v0[e] = a * a; v1[e] = b * b; }
                    u32x4 w; w.x = cvt_pk_bf16(v0[0], v0[1]); w.y = cvt_pk_bf16(v0[2], v0[3]); w.z = cvt_pk_bf16(v1[0], v1[1]); w.w = cvt_pk_bf16(v1[2], v1[3]);
                    *(u32x4*)(rowp + bj * 2 * 16384) = w; } }
    }
};
template <class T, class = void> struct has_midk { static constexpr bool value = false; };
template <class T> struct has_midk<T, typename std::enable_if<T::MIDK>::type> { static constexpr bool value = true; };
template <class Epi, class Sched, bool ALIGN_EPI = false, bool SP2 = false>
__device__ __forceinline__ void gemm_phase(PG8_LAS unsigned char* lds, const Gemm g, const Sched& S, const Epi& E) {
    int tid_o = threadIdx.x; asm volatile("" : "+v"(tid_o));
    const int tid = tid_o, wid = __builtin_amdgcn_readfirstlane(tid >> 6), lane = tid & 63, wr = wid >> 2, wc = wid & 3, fr = lane & 15, fq = lane >> 4;
    const int nt = g.K / BK, K = g.blocked ? BK : g.K;
    unsigned voffA[2], voffB[2];
#pragma unroll
    for (int i = 0; i < 2; ++i) { int R, C; stage_rc(tid * 16 + i * 8192, R, C); const int Rb = Epi::PERM ? ((R & ~31) + perm32(R & 31)) : R;
        voffA[i] = (unsigned)(R * K + C) * 2u; voffB[i] = (unsigned)(Rb * K + C) * 2u; }
    const size_t kstep = g.blocked ? (size_t)(BM * BK * 2) : (size_t)(BK * 2);
    const size_t hstep = (size_t)HALF * K * 2;
    const size_t tstep = (size_t)BM * g.K * 2;
    const unsigned ldsw = (unsigned)wid * 1024u;
    const int aoff = lds_byte(wr * 64 + fr, fq * 8), boff = lds_byte(wc * 32 + fr, fq * 8);
#define PG8_SA(b, h) (((b) * 2 + (h)) * HTB)
#define PG8_SB(b, h) ((4 + (b) * 2 + (h)) * HTB)
#define PG8_STAGE(bufoff, gbase, voff) do { _Pragma("unroll") for (int _i = 0; _i < 2; ++_i) \
        __builtin_amdgcn_global_load_lds((const unsigned*)((const char*)(gbase) + (voff)[_i]), (PG8_LAS unsigned*)(lds + (bufoff) + ldsw + _i * 8192), 16, 0, 0); } while (0)
#define PG8_LDA(dst, b, h) do { _Pragma("unroll") for (int m = 0; m < 4; ++m) _Pragma("unroll") for (int k = 0; k < 2; ++k) dst[m][k] = *(const PG8_LAS bf16x8*)(lds + PG8_SA(b, h) + aoff + m * 2048 + k * 1024); } while (0)
#define PG8_LDB(dst, b, h) do { _Pragma("unroll") for (int n = 0; n < 2; ++n) _Pragma("unroll") for (int k = 0; k < 2; ++k) dst[n][k] = *(const PG8_LAS bf16x8*)(lds + PG8_SB(b, h) + boff + n * 2048 + k * 1024); } while (0)
#define PG8_MMA(ai, bj, At, Bt) do { __builtin_amdgcn_s_setprio(1); _Pragma("unroll") for (int m = 0; m < 4; ++m) _Pragma("unroll") for (int n = 0; n < 2; ++n) _Pragma("unroll") for (int k = 0; k < 2; ++k) \
        acc[ai][bj][m][n] = __builtin_amdgcn_mfma_f32_16x16x32_bf16(Bt[n][k], At[m][k], acc[ai][bj][m][n], 0, 0, 0); __builtin_amdgcn_s_setprio(0); } while (0)
#define PG8_WAIT_V(n) asm volatile("s_waitcnt vmcnt(" #n ")" ::: "memory")
#define PG8_WAIT_L(n) asm volatile("s_waitcnt lgkmcnt(" #n ")" ::: "memory")
#define PG8_BAR __builtin_amdgcn_s_barrier()
#define PG8_SCHED __builtin_amdgcn_sched_barrier(0)
    Unit cur, nxt; int ui = 0;
    if (!S.next(0, cur)) return;
    f32x4 acc[2][2][4][2];
#pragma unroll
    for (int a = 0; a < 2; ++a)
#pragma unroll
        for (int b = 0; b < 2; ++b)
#pragma unroll
            for (int m = 0; m < 4; ++m)
#pragma unroll
                for (int n = 0; n < 2; ++n) acc[a][b][m][n] = (f32x4){0.f, 0.f, 0.f, 0.f};
    bf16x8 At[4][2], B0[2][2], B1[2][2];
    const char* cA = (const char*)g.A + (size_t)cur.pm * tstep + (size_t)cur.kt0 * kstep; const char* cB = (const char*)g.Bt + (size_t)cur.pn * tstep + (size_t)cur.kt0 * kstep;
    int cnt = cur.nkt ? cur.nkt : nt;
    S.a_ready(cur);
    if constexpr (SP2) {
        PG8_STAGE(PG8_SB(0, 0), cB, voffB); PG8_STAGE(PG8_SB(0, 1), cB + hstep, voffB); PG8_STAGE(PG8_SA(0, 0), cA, voffA); PG8_STAGE(PG8_SA(0, 1), cA + hstep, voffA);
        if (wr == 1) PG8_BAR;
        PG8_WAIT_V(2); PG8_BAR;
        PG8_STAGE(PG8_SB(1, 0), cB + kstep, voffB); PG8_STAGE(PG8_SA(1, 0), cA + kstep, voffA); PG8_STAGE(PG8_SB(1, 1), cB + hstep + kstep, voffB);
        PG8_WAIT_V(6); PG8_BAR;
    } else {
        PG8_STAGE(PG8_SB(0, 0), cB, voffB); PG8_STAGE(PG8_SA(0, 0), cA, voffA); PG8_STAGE(PG8_SB(0, 1), cB + hstep, voffB); PG8_STAGE(PG8_SA(0, 1), cA + hstep, voffA);
        if (wr == 1) PG8_BAR;
        PG8_WAIT_V(4); PG8_BAR;
        PG8_STAGE(PG8_SB(1, 0), cB + kstep, voffB); PG8_STAGE(PG8_SA(1, 0), cA + kstep, voffA); PG8_STAGE(PG8_SB(1, 1), cB + hstep + kstep, voffB);
        PG8_WAIT_V(6); PG8_BAR;
    }
    for (;;) {
        const bool has_next = S.next(ui + 1, nxt);
        const char* nA = has_next ? (const char*)g.A + (size_t)nxt.pm * tstep + (size_t)nxt.kt0 * kstep : cA; const char* nB = has_next ? (const char*)g.Bt + (size_t)nxt.pn * tstep + (size_t)nxt.kt0 * kstep : cB;
        for (int t = 0; t < cnt; t += 2) {
            const bool last = (t == cnt - 2);
            const char* a1 = cA + (size_t)(t + 1) * kstep;
            const char* a2 = last ? nA : cA + (size_t)(t + 2) * kstep; const char* b2 = last ? nB : cB + (size_t)(t + 2) * kstep;
            const char* a3 = a2 + kstep; const char* b3 = b2 + kstep;
            if (last && has_next) S.a_ready(nxt);
            if constexpr (SP2) {
            PG8_LDB(B0, 0, 0); PG8_LDB(B1, 0, 1); PG8_SCHED; PG8_LDA(At, 0, 0); PG8_STAGE(PG8_SA(1, 1), a1 + hstep, voffA);
            PG8_WAIT_V(8); PG8_WAIT_L(0); PG8_BAR; PG8_MMA(0, 0, At, B0); PG8_MMA(0, 1, At, B1); PG8_BAR; PG8_SCHED;
            PG8_LDA(At, 0, 1); PG8_STAGE(PG8_SB(0, 0), b2, voffB); PG8_STAGE(PG8_SB(0, 1), b2 + hstep, voffB); PG8_STAGE(PG8_SA(0, 0), a2, voffA);
            PG8_WAIT_V(8); PG8_WAIT_L(0); PG8_BAR; PG8_MMA(1, 0, At, B0); PG8_MMA(1, 1, At, B1); PG8_BAR; PG8_SCHED;
            PG8_LDB(B0, 1, 0); PG8_LDB(B1, 1, 1); PG8_SCHED; PG8_LDA(At, 1, 0); PG8_STAGE(PG8_SA(0, 1), a2 + hstep, voffA);
            PG8_WAIT_V(8); PG8_WAIT_L(0); PG8_BAR; PG8_MMA(0, 0, At, B0); PG8_MMA(0, 1, At, B1); PG8_BAR; PG8_SCHED;
            PG8_LDA(At, 1, 1); PG8_STAGE(PG8_SB(1, 0), b3, voffB); PG8_STAGE(PG8_SB(1, 1), b3 + hstep, voffB); PG8_STAGE(PG8_SA(1, 0), a3, voffA);
            PG8_WAIT_V(8); PG8_WAIT_L(0); PG8_BAR; PG8_MMA(1, 0, At, B0); PG8_MMA(1, 1, At, B1); PG8_BAR; PG8_SCHED;
            } else {
            PG8_LDB(B0, 0, 0); PG8_SCHED; PG8_LDA(At, 0, 0); PG8_STAGE(PG8_SA(1, 1), a1 + hstep, voffA);
            PG8_WAIT_L(8); PG8_BAR; PG8_WAIT_L(0); PG8_MMA(0, 0, At, B0); PG8_BAR; PG8_SCHED;
            PG8_LDB(B1, 0, 1); PG8_STAGE(PG8_SB(0, 0), b2, voffB);
            PG8_BAR; PG8_WAIT_L(0); PG8_MMA(0, 1, At, B1); PG8_BAR;
            PG8_LDA(At, 0, 1); PG8_STAGE(PG8_SA(0, 0), a2, voffA);
            PG8_BAR; PG8_WAIT_L(0); PG8_MMA(1, 0, At, B0); PG8_BAR; PG8_SCHED;
            PG8_STAGE(PG8_SB(0, 1), b2 + hstep, voffB);
            PG8_WAIT_V(6); PG8_BAR; PG8_MMA(1, 1, At, B1); PG8_BAR;
            PG8_LDB(B0, 1, 0); PG8_SCHED; PG8_LDA(At, 1, 0); PG8_STAGE(PG8_SA(0, 1), a2 + hstep, voffA);
            PG8_WAIT_L(8); PG8_BAR; PG8_WAIT_L(0); PG8_MMA(0, 0, At, B0); PG8_BAR; PG8_SCHED;
            PG8_LDB(B1, 1, 1); PG8_STAGE(PG8_SB(1, 0), b3, voffB);
            PG8_BAR; PG8_WAIT_L(0); PG8_MMA(0, 1, At, B1); PG8_BAR;
            PG8_LDA(At, 1, 1); PG8_STAGE(PG8_SA(1, 0), a3, voffA);
            PG8_BAR; PG8_WAIT_L(0); PG8_MMA(1, 0, At, B0); PG8_BAR; PG8_SCHED;
            PG8_STAGE(PG8_SB(1, 1), b3 + hstep, voffB);
            PG8_WAIT_V(6); PG8_BAR; PG8_MMA(1, 1, At, B1); PG8_BAR;
            }
        }
        if constexpr (ALIGN_EPI) { if (wr == 0) PG8_BAR; }
        if constexpr (!Epi::AFTER_DRAIN) {
            if (cur.part == -2) { if constexpr (has_midk<Epi>::value) E.mid(acc, cur, wr, wc, fr, fq); }
            else if (cur.part >= 0) {
                f32x4* sp = (f32x4*)(g.slab + (size_t)cur.part * 65536) + (size_t)wid * 2048 + lane;
#pragma unroll
                for (int a = 0; a < 2; ++a)
#pragma unroll
                    for (int b = 0; b < 2; ++b)
#pragma unroll
                        for (int m = 0; m < 4; ++m)
#pragma unroll
                            for (int n = 0; n < 2; ++n) sp[(((a * 2 + b) * 4 + m) * 2 + n) * 64] = acc[a][b][m][n];
            } else E(acc, cur, wr, wc, fr, fq);
            S.done(cur); }
        if (!has_next) break;
        if (cur.part != -2) {
#pragma unroll
        for (int a = 0; a < 2; ++a)
#pragma unroll
            for (int b = 0; b < 2; ++b)
#pragma unroll
                for (int m = 0; m < 4; ++m)
#pragma unroll
                    for (int n = 0; n < 2; ++n) acc[a][b][m][n] = (f32x4){0.f, 0.f, 0.f, 0.f};
        }
        cur = nxt; cA = nA; cB = nB; ++ui; cnt = cur.nkt ? cur.nkt : nt;
        if constexpr (ALIGN_EPI) { if (wr == 1) PG8_BAR; }
    }
    PG8_WAIT_V(0);
    if constexpr (!ALIGN_EPI) { if (wr == 0) PG8_BAR; }
    PG8_BAR;
    if constexpr (Epi::AFTER_DRAIN) { E.fused(acc, cur, wr, wc, fr, fq, lds, wid, lane); S.done(cur); }
#undef PG8_SA
#undef PG8_SB
#undef PG8_STAGE
#undef PG8_LDA
#undef PG8_LDB
#undef PG8_MMA
#undef PG8_WAIT_V
#undef PG8_WAIT_L
#undef PG8_BAR
#undef PG8_SCHED
}
}
namespace att {
typedef short bf16x8 __attribute__((ext_vector_type(8)));
typedef short s16x4 __attribute__((ext_vector_type(4)));
typedef float f32x16 __attribute__((ext_vector_type(16)));
typedef unsigned u32x4 __attribute__((ext_vector_type(4)));
typedef float f32x4 __attribute__((ext_vector_type(4)));
typedef unsigned short bf16;
#define ALAS __attribute__((address_space(3)))
#ifndef ATT_SSQ_ATOMICS
#define ATT_SSQ_ATOMICS 0
#endif
constexpr int OFF_V = 0, OFF_K = 32768, OFF_R = 65536, OFF_WS = 81920, OFF_FLG = 81920 + 8 * 256, ATT_LDS_BYTES = OFF_FLG + 64;
constexpr float SB_DEAD = -150.f;
#define KSWZ(row, colB) ((row) * 256 + ((colB) ^ (((row) & 15) << 4)))
#define RSWZ(row, colB) ((row) * 128 + ((colB) ^ ((((row) >> 1) & 7) << 4)))
__device__ __forceinline__ int v_st(int k, int c) { const int kk = (k & ~0xC) | ((k & 4) << 1) | ((k & 8) >> 1); return ((kk >> 3) * 4 + (c >> 5)) * 512 + ((kk & 7) * 32 + (c & 31)) * 2; }
__device__ __forceinline__ int v_rd_base(int lane) { return ((lane & 3) << 3) | (((lane >> 2) & 3) << 6) | (((lane >> 4) & 1) << 5) | (((lane >> 5) & 1) << 8); }
__device__ __forceinline__ int crow(int r, int hi) { return (r & 3) + 8 * (r >> 2) + 4 * hi; }
__device__ __forceinline__ unsigned cvtpk(float lo, float hi) { unsigned r; asm volatile("v_cvt_pk_bf16_f32 %0, %1, %2" : "=v"(r) : "v"(lo), "v"(hi)); return r; }

struct Unit { const bf16* Q; int ldq; const bf16* K; const bf16* Kr; const bf16* V; bf16* O; int ldo; float* ssq; int P0; int NT; int nact;
              const float* Kf0; const float* Vf0; const float* Kf1; const float* Vf1; int split; };

__device__ __forceinline__ void qk128(f32x16& p0, f32x16& p1, ALAS const char* Kt, int r32, int hi, const bf16x8* qr) {
#pragma unroll
    for (int d0 = 0; d0 < 8; ++d0) { ALAS const char* a = Kt + KSWZ(r32, (d0 * 16 + hi * 8) * 2);
        const bf16x8 b0 = *(ALAS const bf16x8*)a; const bf16x8 b1 = *(ALAS const bf16x8*)(a + 32 * 256);
        p0 = __builtin_amdgcn_mfma_f32_32x32x16_bf16(b0, qr[d0], p0, 0, 0, 0);
        p1 = __builtin_amdgcn_mfma_f32_32x32x16_bf16(b1, qr[d0], p1, 0, 0, 0); }
}
__device__ __forceinline__ void qk64(f32x16& p0, f32x16& p1, ALAS const char* Kt, int r32, int hi, const bf16x8* qr) {
#pragma unroll
    for (int d0 = 0; d0 < 4; ++d0) { ALAS const char* a = Kt + RSWZ(r32, (d0 * 16 + hi * 8) * 2);
        const bf16x8 b0 = *(ALAS const bf16x8*)a; const bf16x8 b1 = *(ALAS const bf16x8*)(a + 32 * 128);
        p0 = __builtin_amdgcn_mfma_f32_32x32x16_bf16(b0, qr[d0], p0, 0, 0, 0);
        p1 = __builtin_amdgcn_mfma_f32_32x32x16_bf16(b1, qr[d0], p1, 0, 0, 0); }
}
__device__ __forceinline__ void pv_tile(f32x16* o, unsigned vb0, bf16x8 pa0, bf16x8 pa1, bf16x8 pa2, bf16x8 pa3) {
#define TRRD(dst, off) asm volatile("ds_read_b64_tr_b16 %0, %1 offset:%2" : "=&v"(dst) : "v"(vb0), "i"(off) : "memory")
#define PV_LD(S, d0) do { constexpr int b_ = (d0) * 512; \
        TRRD(S##l0, b_); TRRD(S##h0, b_ + 2048); TRRD(S##l1, b_ + 4096); TRRD(S##h1, b_ + 6144); TRRD(S##l2, b_ + 8192); TRRD(S##h2, b_ + 10240); TRRD(S##l3, b_ + 12288); TRRD(S##h3, b_ + 14336); } while (0)
#define PV_MM(S, d0) do { \
        o[d0] = __builtin_amdgcn_mfma_f32_32x32x16_bf16(pa0, (bf16x8){S##l0[0], S##l0[1], S##l0[2], S##l0[3], S##h0[0], S##h0[1], S##h0[2], S##h0[3]}, o[d0], 0, 0, 0); \
        o[d0] = __builtin_amdgcn_mfma_f32_32x32x16_bf16(pa1, (bf16x8){S##l1[0], S##l1[1], S##l1[2], S##l1[3], S##h1[0], S##h1[1], S##h1[2], S##h1[3]}, o[d0], 0, 0, 0); \
        o[d0] = __builtin_amdgcn_mfma_f32_32x32x16_bf16(pa2, (bf16x8){S##l2[0], S##l2[1], S##l2[2], S##l2[3], S##h2[0], S##h2[1], S##h2[2], S##h2[3]}, o[d0], 0, 0, 0); \
        o[d0] = __builtin_amdgcn_mfma_f32_32x32x16_bf16(pa3, (bf16x8){S##l3[0], S##l3[1], S##l3[2], S##l3[3], S##h3[0], S##h3[1], S##h3[2], S##h3[3]}, o[d0], 0, 0, 0); } while (0)
#define PV_WAIT(n) do { asm volatile("s_waitcnt lgkmcnt(" #n ")" ::: "memory"); __builtin_amdgcn_sched_barrier(0); } while (0)
    s16x4 Al0, Al1, Al2, Al3, Ah0, Ah1, Ah2, Ah3, Bl0, Bl1, Bl2, Bl3, Bh0, Bh1, Bh2, Bh3;
    PV_LD(A, 0); PV_LD(B, 1); PV_WAIT(8); PV_MM(A, 0);
    __builtin_amdgcn_sched_barrier(0); PV_LD(A, 2); PV_WAIT(8); PV_MM(B, 1);
    __builtin_amdgcn_sched_barrier(0); PV_LD(B, 3); PV_WAIT(8); PV_MM(A, 2);
    PV_WAIT(0); PV_MM(B, 3);
#undef PV_WAIT
#undef PV_MM
#undef PV_LD
#undef TRRD
}
#define PK4(P, B_, OUT) do { const unsigned a0_ = cvtpk(P[B_ + 0], P[B_ + 1]), a1_ = cvtpk(P[B_ + 2], P[B_ + 3]); \
        const unsigned b0_ = cvtpk(P[B_ + 4], P[B_ + 5]), b1_ = cvtpk(P[B_ + 6], P[B_ + 7]); \
        auto r0_ = __builtin_amdgcn_permlane32_swap(a0_, b0_, false, false); auto r1_ = __builtin_amdgcn_permlane32_swap(a1_, b1_, false, false); \
        u32x4 w_ = {r0_[0], r1_[0], r0_[1], r1_[1]}; OUT = __builtin_bit_cast(bf16x8, w_); } while (0)

__device__ __forceinline__ void store_o_staged(const f32x16* o, const float* rli, bf16* Ow, int ldo, ALAS char* stg, int lane, int r32, int hi, float* ssqp) {
    ALAS unsigned short* s16 = (ALAS unsigned short*)stg;
#pragma unroll
    for (int r = 0; r < 16; ++r) { const int orow = crow(r, hi);
#pragma unroll
        for (int d0 = 0; d0 < 4; ++d0) { const float v = o[d0][r] * rli[r]; s16[orow * 128 + d0 * 32 + r32] = (unsigned short)cvtpk(v, v); } }
    asm volatile("s_waitcnt lgkmcnt(0)" ::: "memory");
#pragma unroll
    for (int i = 0; i < 8; ++i) { const int idx = i * 64 + lane, row = idx >> 4, ch = idx & 15;
        const u32x4 w = *(ALAS const u32x4*)(stg + row * 256 + ch * 16);
        *(u32x4*)(Ow + (size_t)row * ldo + ch * 8) = w;
        float s = 0.f; { const unsigned ww[4] = {w.x, w.y, w.z, w.w};
#pragma unroll
            for (int e = 0; e < 4; ++e) { const float x0 = __uint_as_float(ww[e] << 16), x1 = __uint_as_float(ww[e] & 0xffff0000u); s += x0 * x0 + x1 * x1; } }
        s += __shfl_xor(s, 1); s += __shfl_xor(s, 2); s += __shfl_xor(s, 4); s += __shfl_xor(s, 8);
        if (ch == 0) ssqp[(size_t)row * 32] = s; }
}
template <bool MLA>
__device__ __forceinline__ void attn_unit(const Unit u, ALAS char* lds) {
    int tid_o = threadIdx.x; asm volatile("" : "+v"(tid_o));
    const int tid = tid_o, wid = __builtin_amdgcn_readfirstlane(tid >> 6), lane = tid & 63, r32 = lane & 31, hi = lane >> 5;
    const bool actw = wid < u.nact;
    const int sr = tid >> 4, sc = (tid & 15) * 8;
    const int vst0 = v_st(sr, sc), vst1 = v_st(32 + sr, sc), kws = KSWZ(sr, sc * 2);
    const int rk = tid >> 3, rc = (tid & 7) * 8, rws = RSWZ(rk, rc * 2);
    ALAS char* V_l = lds + OFF_V; ALAS char* K_l = lds + OFF_K; ALAS char* R_l = lds + OFF_R;
    ALAS float* al_l = (ALAS float*)(lds + OFF_WS) + wid * 64; ALAS float* li_l = al_l + 32;
    const unsigned vbase = (unsigned)(uintptr_t)V_l + (unsigned)v_rd_base(lane);
    constexpr int NQ = MLA ? 12 : 8;
    bf16x8 qr[NQ];
#pragma unroll
    for (int d0 = 0; d0 < NQ; ++d0) qr[d0] = (bf16x8){0, 0, 0, 0, 0, 0, 0, 0};
    if (actw) {
#pragma unroll
        for (int d0 = 0; d0 < NQ; ++d0) qr[d0] = *(const bf16x8*)(u.Q + (size_t)(wid * 32 + r32) * u.ldq + d0 * 16 + hi * 8);
    }
    const int cw = (u.P0 + wid * 32) >> 6;
    const int qpos = u.P0 + wid * 32 + r32;
    float m_reg = -1e30f, l_reg = 0.f, carry = 0.f; bool fin = false;
    ALAS unsigned* flg = (ALAS unsigned*)(lds + OFF_FLG);
    f32x16 o[4];
#pragma unroll
    for (int d = 0; d < 4; ++d)
#pragma unroll
        for (int r = 0; r < 16; ++r) o[d][r] = 0.f;
    bf16x8 st_k0, st_k1, st_v0, st_v1, st_r = (bf16x8){0, 0, 0, 0, 0, 0, 0, 0};
    f32x4 fk[4], fv[4];
#define LOADT(tt) do { if (!MLA) { const int t_ = (tt); const bool lo_ = t_ < u.split; const size_t ro_ = (size_t)(lo_ ? t_ : t_ - u.split) * 64 * 2048; \
            const float* kb_ = (lo_ ? u.Kf0 : u.Kf1) + ro_ + (size_t)sr * 2048 + sc; const float* vb_ = (lo_ ? u.Vf0 : u.Vf1) + ro_ + (size_t)sr * 2048 + sc; \
            fk[0] = *(const f32x4*)kb_; fk[1] = *(const f32x4*)(kb_ + 4); fk[2] = *(const f32x4*)(kb_ + 32 * 2048); fk[3] = *(const f32x4*)(kb_ + 32 * 2048 + 4); \
            fv[0] = *(const f32x4*)vb_; fv[1] = *(const f32x4*)(vb_ + 4); fv[2] = *(const f32x4*)(vb_ + 32 * 2048); fv[3] = *(const f32x4*)(vb_ + 32 * 2048 + 4); } else { \
        const size_t r0_ = (size_t)(tt) * 64; \
        st_k0 = *(const bf16x8*)(u.K + (r0_ + sr) * 2048 + sc); st_k1 = *(const bf16x8*)(u.K + (r0_ + 32 + sr) * 2048 + sc); \
        st_v0 = *(const bf16x8*)(u.V + (r0_ + sr) * 2048 + sc); st_v1 = *(const bf16x8*)(u.V + (r0_ + 32 + sr) * 2048 + sc); \
        if (MLA) st_r = *(const bf16x8*)(u.Kr + (r0_ + rk) * 64 + rc); } } while (0)
    LOADT(MLA ? 0 : (u.NT - 1));
    for (int i = 0; i < u.NT; ++i) {
        const int t = MLA ? i : (u.NT - 1 - i); const int buf = i & 1;
        if (!MLA) { u32x4 w_;
            w_ = (u32x4){cvtpk(fk[0][0], fk[0][1]), cvtpk(fk[0][2], fk[0][3]), cvtpk(fk[1][0], fk[1][1]), cvtpk(fk[1][2], fk[1][3])}; st_k0 = __builtin_bit_cast(bf16x8, w_);
            w_ = (u32x4){cvtpk(fk[2][0], fk[2][1]), cvtpk(fk[2][2], fk[2][3]), cvtpk(fk[3][0], fk[3][1]), cvtpk(fk[3][2], fk[3][3])}; st_k1 = __builtin_bit_cast(bf16x8, w_);
            w_ = (u32x4){cvtpk(fv[0][0], fv[0][1]), cvtpk(fv[0][2], fv[0][3]), cvtpk(fv[1][0], fv[1][1]), cvtpk(fv[1][2], fv[1][3])}; st_v0 = __builtin_bit_cast(bf16x8, w_);
            w_ = (u32x4){cvtpk(fv[2][0], fv[2][1]), cvtpk(fv[2][2], fv[2][3]), cvtpk(fv[3][0], fv[3][1]), cvtpk(fv[3][2], fv[3][3])}; st_v1 = __builtin_bit_cast(bf16x8, w_); }
        *(ALAS bf16x8*)(K_l + buf * 16384 + kws) = st_k0; *(ALAS bf16x8*)(K_l + buf * 16384 + kws + 32 * 256) = st_k1;
        *(ALAS bf16x8*)(V_l + buf * 16384 + vst0) = st_v0; *(ALAS bf16x8*)(V_l + buf * 16384 + vst1) = st_v1;
        if (MLA) *(ALAS bf16x8*)(R_l + buf * 8192 + rws) = st_r;
        if (!MLA) { if (lane == 0) flg[buf * 8 + wid] = (fin || !actw) ? 1u : 0u; }
        __syncthreads();
        if (!MLA) {
            const u32x4 fa = *(ALAS const u32x4*)(flg + buf * 8), fb = *(ALAS const u32x4*)(flg + buf * 8 + 4);
            if ((fa.x & fa.y & fa.z & fa.w & fb.x & fb.y & fb.z & fb.w) != 0u) break;
        }
        if (i + 1 < u.NT) LOADT(MLA ? (i + 1) : (u.NT - 2 - i));
        if (actw && t <= cw && !fin) {
            f32x16 p0, p1;
#pragma unroll
            for (int r = 0; r < 16; ++r) { p0[r] = 0.f; p1[r] = 0.f; }
            qk128(p0, p1, K_l + buf * 16384, r32, hi, qr);
            if (MLA) qk64(p0, p1, R_l + buf * 8192, r32, hi, qr + (MLA ? 8 : 0));
            bf16x8 pa0, pa1, pa2, pa3;
            if (MLA) {
                float pmax = p0[0];
#pragma unroll
                for (int r = 1; r < 16; ++r) pmax = fmaxf(pmax, p0[r]);
#pragma unroll
                for (int r = 0; r < 16; ++r) pmax = fmaxf(pmax, p1[r]);
                { auto rr = __builtin_amdgcn_permlane32_swap(__float_as_uint(pmax), __float_as_uint(pmax), false, false);
                  pmax = fmaxf(__uint_as_float(rr[0]), __uint_as_float(rr[1])); }
                const float mn = fmaxf(m_reg, pmax); const float alpha = __builtin_amdgcn_exp2f(m_reg - mn); m_reg = mn;
                float ps = 0.f;
#pragma unroll
                for (int r = 0; r < 16; ++r) { p0[r] = __builtin_amdgcn_exp2f(p0[r] - mn); ps += p0[r]; }
#pragma unroll
                for (int r = 0; r < 16; ++r) { p1[r] = __builtin_amdgcn_exp2f(p1[r] - mn); ps += p1[r]; }
                { auto rr = __builtin_amdgcn_permlane32_swap(__float_as_uint(ps), __float_as_uint(ps), false, false);
                  ps = __uint_as_float(rr[0]) + __uint_as_float(rr[1]); }
                l_reg = l_reg * alpha + ps;
                if (__any(alpha < 1.f)) {
                    if (hi == 0) al_l[r32] = alpha;
                    asm volatile("s_waitcnt lgkmcnt(0)" ::: "memory");
#pragma unroll
                    for (int r = 0; r < 16; ++r) { const float a = al_l[crow(r, hi)];
#pragma unroll
                        for (int d = 0; d < 4; ++d) o[d][r] *= a; }
                    asm volatile("s_waitcnt lgkmcnt(0)" ::: "memory");
                }
            } else {
                const bool diag = (t == cw); const int dq = qpos - 64 * t - 4 * hi; const float NEG = -__builtin_inff();
                float suf = carry;
#define SB_HALF(P, KOFF) do { f32x16 f_; \
                    _Pragma("unroll") for (int r = 0; r < 16; ++r) { const float y = P[r]; const float e = __builtin_amdgcn_exp2f(-fabsf(y)); const float l2 = __builtin_amdgcn_logf(1.f + e); \
                        const float lb = fminf(y, 0.f) - l2; P[r] = lb; f_[r] = lb - y; } \
                    if (diag) { _Pragma("unroll") for (int r = 0; r < 16; ++r) { const int c = (r & 3) + 8 * (r >> 2) + (KOFF); if (!(c < dq)) { P[r] = NEG; f_[r] = 0.f; } } } \
                    float tg_[4], pg_[4]; \
                    _Pragma("unroll") for (int g = 0; g < 4; ++g) { const float a = (f_[4 * g] + f_[4 * g + 1]) + (f_[4 * g + 2] + f_[4 * g + 3]); \
                        auto rr = __builtin_amdgcn_permlane32_swap(__float_as_uint(a), __float_as_uint(a), false, false); \
                        const float lo = __uint_as_float(rr[0]), hh = __uint_as_float(rr[1]); tg_[g] = lo + hh; pg_[g] = hi == 0 ? hh : 0.f; } \
                    _Pragma("unroll") for (int g = 3; g >= 0; --g) { const float base = suf + pg_[g]; \
                        const float s2 = f_[4 * g + 3], s1 = s2 + f_[4 * g + 2], s0 = s1 + f_[4 * g + 1]; \
                        P[4 * g + 3] = __builtin_amdgcn_exp2f(P[4 * g + 3] + base); P[4 * g + 2] = __builtin_amdgcn_exp2f(P[4 * g + 2] + (base + s2)); \
                        P[4 * g + 1] = __builtin_amdgcn_exp2f(P[4 * g + 1] + (base + s1)); P[4 * g] = __builtin_amdgcn_exp2f(P[4 * g] + (base + s0)); \
                        suf += tg_[g]; } } while (0)
                SB_HALF(p1, 32);
                PK4(p1, 0, pa2); PK4(p1, 8, pa3);
                SB_HALF(p0, 0);
                PK4(p0, 0, pa0); PK4(p0, 8, pa1);
#undef SB_HALF
                carry = suf;
                fin = __all(carry < SB_DEAD);
            }
            if (MLA) { PK4(p0, 0, pa0); PK4(p0, 8, pa1); PK4(p1, 0, pa2); PK4(p1, 8, pa3); }
            pv_tile(o, vbase + (unsigned)(buf * 16384), pa0, pa1, pa2, pa3);
        }
    }
    __syncthreads();
    if (actw) {
        float rli[16];
        if (MLA) {
            if (hi == 0) li_l[r32] = l_reg;
            asm volatile("s_waitcnt lgkmcnt(0)" ::: "memory");
#pragma unroll
            for (int r = 0; r < 16; ++r) rli[r] = 1.0f / li_l[crow(r, hi)];
        } else {
#pragma unroll
            for (int r = 0; r < 16; ++r) rli[r] = 1.0f;
        }
        store_o_staged(o, rli, u.O + (size_t)(wid * 32) * u.ldo, u.ldo, lds + wid * 8192, lane, r32, hi, u.ssq + (size_t)(wid * 32) * 32);
    }
    __syncthreads();
#undef LOADT
}

__device__ __forceinline__ void qk192_pipe(f32x16& p0, f32x16& p1, ALAS const char* Kt, ALAS const char* Rt, int r32, int hi, const bf16x8* qr, const f32x16* cinit = nullptr) {
    constexpr int PF = 2;
    bf16x8 fa[12], fb[12];
#define QK_ADDR(s) ((s) < 8 ? Kt + KSWZ(r32, ((s) * 16 + hi * 8) * 2) : Rt + RSWZ(r32, (((s) - 8) * 16 + hi * 8) * 2))
#define QK_LD(s) do { ALAS const char* a_ = QK_ADDR(s); fa[s] = *(ALAS const bf16x8*)a_; fb[s] = *(ALAS const bf16x8*)(a_ + ((s) < 8 ? 32 * 256 : 32 * 128)); } while (0)
#pragma unroll
    for (int s = 0; s < PF; ++s) QK_LD(s);
#pragma unroll
    for (int s = 0; s < 12; ++s) {
        if (s + PF < 12) QK_LD(s + PF);
        __builtin_amdgcn_sched_barrier(0);
        p0 = __builtin_amdgcn_mfma_f32_32x32x16_bf16(fa[s], qr[s], (s == 0 && cinit) ? *cinit : p0, 0, 0, 0);
        p1 = __builtin_amdgcn_mfma_f32_32x32x16_bf16(fb[s], qr[s], (s == 0 && cinit) ? *cinit : p1, 0, 0, 0);
        __builtin_amdgcn_sched_barrier(0);
    }
#undef QK_LD
#undef QK_ADDR
}
constexpr float MLA_THR = 8.f;
__device__ __forceinline__ void mla_softmax(f32x16& p0, f32x16& p1, float& m_reg, float& l_reg, f32x16* o, ALAS float* al_l, int r32, int hi, bf16x8& pa0, bf16x8& pa1, bf16x8& pa2, bf16x8& pa3) {
    float pmax = p0[0];
#pragma unroll
    for (int r = 1; r < 16; ++r) pmax = fmaxf(pmax, p0[r]);
#pragma unroll
    for (int r = 0; r < 16; ++r) pmax = fmaxf(pmax, p1[r]);
    { auto rr = __builtin_amdgcn_permlane32_swap(__float_as_uint(pmax), __float_as_uint(pmax), false, false);
      pmax = fmaxf(__uint_as_float(rr[0]), __uint_as_float(rr[1])); }
    float mn = m_reg, alpha = 1.f;
    if (!__all(pmax - m_reg <= MLA_THR)) { mn = fmaxf(m_reg, pmax); alpha = __builtin_amdgcn_exp2f(m_reg - mn); m_reg = mn; }
    float ps = 0.f;
#pragma unroll
    for (int r = 0; r < 16; ++r) { p0[r] = __builtin_amdgcn_exp2f(p0[r] - mn); ps += p0[r]; }
#pragma unroll
    for (int r = 0; r < 16; ++r) { p1[r] = __builtin_amdgcn_exp2f(p1[r] - mn); ps += p1[r]; }
    { auto rr = __builtin_amdgcn_permlane32_swap(__float_as_uint(ps), __float_as_uint(ps), false, false);
      ps = __uint_as_float(rr[0]) + __uint_as_float(rr[1]); }
    l_reg = l_reg * alpha + ps;
    if (__any(alpha < 1.f)) {
        if (hi == 0) al_l[r32] = alpha;
        asm volatile("s_waitcnt lgkmcnt(0)" ::: "memory");
#pragma unroll
        for (int r = 0; r < 16; ++r) { const float a = al_l[crow(r, hi)];
#pragma unroll
            for (int d = 0; d < 4; ++d) o[d][r] *= a; }
        asm volatile("s_waitcnt lgkmcnt(0)" ::: "memory");
    }
    PK4(p0, 0, pa0); PK4(p0, 8, pa1); PK4(p1, 0, pa2); PK4(p1, 8, pa3);
}
__device__ __forceinline__ void mla_softmax_rel(f32x16& p0, f32x16& p1, float& m_reg, f32x16& negm, bool first, float& l_reg, f32x16* o, ALAS float* al_l, int r32, int hi, bf16x8& pa0, bf16x8& pa1, bf16x8& pa2, bf16x8& pa3) {
    float pmax = p0[0];
#pragma unroll
    for (int r = 1; r < 16; ++r) pmax = fmaxf(pmax, p0[r]);
#pragma unroll
    for (int r = 0; r < 16; ++r) pmax = fmaxf(pmax, p1[r]);
    { auto rr = __builtin_amdgcn_permlane32_swap(__float_as_uint(pmax), __float_as_uint(pmax), false, false);
      pmax = fmaxf(__uint_as_float(rr[0]), __uint_as_float(rr[1])); }
    if (first || !__all(pmax <= MLA_THR)) {
        const float delta = first ? pmax : fmaxf(pmax, 0.f); const float alpha = first ? 1.f : __builtin_amdgcn_exp2f(-delta);
        m_reg += delta; l_reg *= alpha;
#pragma unroll
        for (int r = 0; r < 16; ++r) { p0[r] -= delta; p1[r] -= delta; negm[r] = -m_reg; }
        if (!first) {
            if (hi == 0) al_l[r32] = alpha;
            asm volatile("s_waitcnt lgkmcnt(0)" ::: "memory");
#pragma unroll
            for (int r = 0; r < 16; ++r) { const float a = al_l[crow(r, hi)];
#pragma unroll
                for (int d = 0; d < 4; ++d) o[d][r] *= a; }
            asm volatile("s_waitcnt lgkmcnt(0)" ::: "memory");
        }
    }
    float ps = 0.f;
#pragma unroll
    for (int r = 0; r < 16; ++r) { p0[r] = __builtin_amdgcn_exp2f(p0[r]); ps += p0[r]; }
#pragma unroll
    for (int r = 0; r < 16; ++r) { p1[r] = __builtin_amdgcn_exp2f(p1[r]); ps += p1[r]; }
    { auto rr = __builtin_amdgcn_permlane32_swap(__float_as_uint(ps), __float_as_uint(ps), false, false);
      ps = __uint_as_float(rr[0]) + __uint_as_float(rr[1]); }
    l_reg += ps;
    PK4(p0, 0, pa0); PK4(p0, 8, pa1); PK4(p1, 0, pa2); PK4(p1, 8, pa3);
}
constexpr int M_OFF_V = 0, M_OFF_K = 49152, M_OFF_R = 81920, M_OFF_WS = 98304, MLA_LDS_BYTES = 98304 + 8 * 256;
template <bool ROLEB, int VAR = 0> __device__ __forceinline__ void mla_body(const Unit u, ALAS char* lds) {
    int tid_o = threadIdx.x; asm volatile("" : "+v"(tid_o));
    const int tid = tid_o, wid = __builtin_amdgcn_readfirstlane(tid >> 6), lane = tid & 63, r32 = lane & 31, hi = lane >> 5;
    const bool actw = wid < u.nact; constexpr bool roleB = ROLEB;
    const int sr = tid >> 4, sc = (tid & 15) * 8;
    const int vst0 = v_st(sr, sc), vst1 = v_st(32 + sr, sc), kws = KSWZ(sr, sc * 2);
    const int rk = tid >> 3, rc = (tid & 7) * 8, rws = RSWZ(rk, rc * 2);
    ALAS char* V_l = lds + M_OFF_V; ALAS char* K_l = lds + M_OFF_K; ALAS char* R_l = lds + M_OFF_R;
    ALAS float* al_l = (ALAS float*)(lds + M_OFF_WS) + wid * 64; ALAS float* li_l = al_l + 32;
    const unsigned vbase = (unsigned)(uintptr_t)V_l + (unsigned)v_rd_base(lane);
    bf16x8 qr[12];
#pragma unroll
    for (int d0 = 0; d0 < 12; ++d0) qr[d0] = (bf16x8){0, 0, 0, 0, 0, 0, 0, 0};
    if (actw) {
#pragma unroll
        for (int d0 = 0; d0 < 12; ++d0) qr[d0] = *(const bf16x8*)(u.Q + (size_t)(wid * 32 + r32) * u.ldq + d0 * 16 + hi * 8);
    }
    const int cw = (u.P0 + wid * 32) >> 6;
    float m_reg = -1e30f, l_reg = 0.f;
    f32x16 o[4], p0, p1;
#pragma unroll
    for (int r = 0; r < 16; ++r) { p0[r] = 0.f; p1[r] = 0.f; }
#pragma unroll
    for (int d = 0; d < 4; ++d)
#pragma unroll
        for (int r = 0; r < 16; ++r) o[d][r] = 0.f;
    bf16x8 st_k0, st_k1, st_v0, st_v1, st_r;
#define LOADT(tt) do { const size_t r0_ = (size_t)(tt) * 64; \
        st_k0 = *(const bf16x8*)(u.K + (r0_ + sr) * 2048 + sc); st_k1 = *(const bf16x8*)(u.K + (r0_ + 32 + sr) * 2048 + sc); \
        st_v0 = *(const bf16x8*)(u.V + (r0_ + sr) * 2048 + sc); st_v1 = *(const bf16x8*)(u.V + (r0_ + 32 + sr) * 2048 + sc); \
        st_r = *(const bf16x8*)(u.Kr + (r0_ + rk) * 64 + rc); } while (0)
#define MLA_QK(kb) do { _Pragma("unroll") for (int r = 0; r < 16; ++r) { p0[r] = 0.f; p1[r] = 0.f; } \
        if (VAR == 4 || VAR == 0 || VAR == 5) qk192_pipe(p0, p1, K_l + (kb) * 16384, R_l + (kb) * 8192, r32, hi, qr); else if (VAR != 3) { qk128(p0, p1, K_l + (kb) * 16384, r32, hi, qr); qk64(p0, p1, R_l + (kb) * 8192, r32, hi, qr + 8); } } while (0)
#define MLA_SMPV(vs) do { bf16x8 pa0, pa1, pa2, pa3; \
        if (VAR == 1) { PK4(p0, 0, pa0); PK4(p0, 8, pa1); PK4(p1, 0, pa2); PK4(p1, 8, pa3); l_reg += p0[0]; } \
        else mla_softmax(p0, p1, m_reg, l_reg, o, al_l, r32, hi, pa0, pa1, pa2, pa3); \
        if (VAR != 2) pv_tile(o, vbase + (unsigned)((vs) * 16384), pa0, pa1, pa2, pa3); \
        else { _Pragma("unroll") for (int r = 0; r < 4; ++r) o[r][0] += __builtin_bit_cast(float, (unsigned)pa0[r] ^ (unsigned)pa1[r] ^ (unsigned)pa2[r] ^ (unsigned)pa3[r]); } } while (0)
    LOADT(0);
    int vs_cur = 0, vs_prev = 2;
    for (int i = 0; i <= u.NT; ++i) {
        const int kb = i & 1;
        if (i < u.NT && VAR != 5) {
            *(ALAS bf16x8*)(K_l + kb * 16384 + kws) = st_k0; *(ALAS bf16x8*)(K_l + kb * 16384 + kws + 32 * 256) = st_k1;
            *(ALAS bf16x8*)(V_l + vs_cur * 16384 + vst0) = st_v0; *(ALAS bf16x8*)(V_l + vs_cur * 16384 + vst1) = st_v1;
            *(ALAS bf16x8*)(R_l + kb * 8192 + rws) = st_r;
            __syncthreads();
            if (i + 1 < u.NT) LOADT(i + 1);
        }
        if (actw) {
            if constexpr (!roleB) { if (i < u.NT && i <= cw) { MLA_QK(kb); MLA_SMPV(vs_cur); } }
            else { if (i >= 1 && i - 1 <= cw) MLA_SMPV(vs_prev);
                   if (i < u.NT && i <= cw) MLA_QK(kb); }
        }
        vs_prev = vs_cur; vs_cur = (vs_cur == 2) ? 0 : vs_cur + 1;
    }
    if (actw) {
        if (hi == 0) li_l[r32] = l_reg;
        asm volatile("s_waitcnt lgkmcnt(0)" ::: "memory");
        float rli[16];
#pragma unroll
        for (int r = 0; r < 16; ++r) rli[r] = 1.0f / li_l[crow(r, hi)];
        bf16* Ow = u.O + (size_t)(wid * 32) * u.ldo;
#pragma unroll
        for (int r = 0; r < 16; ++r) { const int orow = crow(r, hi); float sq = 0.f;
#pragma unroll
            for (int d0 = 0; d0 < 4; ++d0) { const float v = o[d0][r] * rli[r]; const float vn = __shfl_xor(v, 1); sq += v * v;
                if ((r32 & 1) == 0) *(unsigned*)(Ow + (size_t)orow * u.ldo + d0 * 32 + r32) = cvtpk(v, vn); }
            sq += __shfl_xor(sq, 1); sq += __shfl_xor(sq, 2); sq += __shfl_xor(sq, 4); sq += __shfl_xor(sq, 8); sq += __shfl_xor(sq, 16);
            if (ATT_SSQ_ATOMICS && r32 == 0) __hip_atomic_fetch_add(u.ssq + wid * 32 + orow, sq, __ATOMIC_RELAXED, __HIP_MEMORY_SCOPE_AGENT); }
    }
    __syncthreads();
#undef LOADT
#undef MLA_QK
#undef MLA_SMPV
}
constexpr int D_OFF_K = 0, D_OFF_R = 49152, D_OFF_V = 73728, D_OFF_WS = 122880, DMA_LDS_BYTES = 122880 + 8 * 256;
template <int VAR = 0> __device__ __forceinline__ void mla_unit_dma(const Unit u, ALAS char* lds) {
    int tid_o = threadIdx.x; asm volatile("" : "+v"(tid_o));
    const int tid = tid_o, wid = __builtin_amdgcn_readfirstlane(tid >> 6), lane = tid & 63, r32 = lane & 31, hi = lane >> 5;
    const bool actw = wid < u.nact;
    if (false) __builtin_amdgcn_s_setprio(1);
    ALAS char* K_l = lds + D_OFF_K; ALAS char* R_l = lds + D_OFF_R; ALAS char* V_l = lds + D_OFF_V;
    ALAS float* al_l = (ALAS float*)(lds + D_OFF_WS) + wid * 64; ALAS float* li_l = al_l + 32;
    const unsigned vbase = (unsigned)(uintptr_t)V_l + (unsigned)v_rd_base(lane);
    unsigned offK[2], offV[2], offR;
#pragma unroll
    for (int j = 0; j < 2; ++j) {
        const int p = wid + 8 * j;
        { const int r = 4 * p + (lane >> 4), c = (lane & 15) ^ (r & 15); offK[j] = (unsigned)(r * 4096 + c * 16); }
        { const int sti = 2 * p + (lane >> 5), kk = (sti >> 2) * 8 + ((lane & 31) >> 2), k = (kk & ~0xC) | ((kk & 4) << 1) | ((kk & 8) >> 1), c = (sti & 3) * 32 + (lane & 3) * 8; offV[j] = (unsigned)(k * 4096 + c * 2); }
    }
    { const int r = 8 * wid + (lane >> 3), c = (lane & 7) ^ ((r >> 1) & 7); offR = (unsigned)(r * 128 + c * 16); }
    const char* gK = (const char*)u.K; const char* gV = (const char*)u.V; const char* gR = (const char*)u.Kr;
#define DMA_TILE(tt, slot) do { const size_t tb_ = (size_t)(tt) * 64; \
        __builtin_amdgcn_global_load_lds((const unsigned*)(gK + tb_ * 4096 + offK[0]), (ALAS unsigned*)(K_l + (slot) * 16384 + wid * 1024), 16, 0, 0); \
        __builtin_amdgcn_global_load_lds((const unsigned*)(gK + tb_ * 4096 + offK[1]), (ALAS unsigned*)(K_l + (slot) * 16384 + (wid + 8) * 1024), 16, 0, 0); \
        __builtin_amdgcn_global_load_lds((const unsigned*)(gR + tb_ * 128 + offR), (ALAS unsigned*)(R_l + (slot) * 8192 + wid * 1024), 16, 0, 0); \
        __builtin_amdgcn_global_load_lds((const unsigned*)(gV + tb_ * 4096 + offV[0]), (ALAS unsigned*)(V_l + (slot) * 16384 + wid * 1024), 16, 0, 0); \
        __builtin_amdgcn_global_load_lds((const unsigned*)(gV + tb_ * 4096 + offV[1]), (ALAS unsigned*)(V_l + (slot) * 16384 + (wid + 8) * 1024), 16, 0, 0); } while (0)
    bf16x8 qr[12];
#pragma unroll
    for (int d0 = 0; d0 < 12; ++d0) qr[d0] = (bf16x8){0, 0, 0, 0, 0, 0, 0, 0};
    if (actw) {
#pragma unroll
        for (int d0 = 0; d0 < 12; ++d0) qr[d0] = *(const bf16x8*)(u.Q + (size_t)(wid * 32 + r32) * u.ldq + d0 * 16 + hi * 8);
    }
#pragma unroll
    for (int d0 = 0; d0 < 12; ++d0) asm volatile("" : "+v"(qr[d0]));
    DMA_TILE(0, 0); if (u.NT > 1) DMA_TILE(1, 1);
    const int cw = (u.P0 + wid * 32) >> 6;
    float m_reg = 0.f, l_reg = 0.f;
    f32x16 o[4], p0, p1, negm;
#pragma unroll
    for (int r = 0; r < 16; ++r) negm[r] = 0.f;
#pragma unroll
    for (int d = 0; d < 4; ++d)
#pragma unroll
        for (int r = 0; r < 16; ++r) o[d][r] = 0.f;
    int sl = 0, sl2 = 2;
    for (int i = 0; i < u.NT; ++i) {
        if (i + 1 < u.NT) asm volatile("s_waitcnt vmcnt(5) lgkmcnt(0)" ::: "memory"); else asm volatile("s_waitcnt vmcnt(0) lgkmcnt(0)" ::: "memory");
        __builtin_amdgcn_s_barrier(); asm volatile("" ::: "memory");
        if (i + 2 < u.NT) DMA_TILE(i + 2, sl2);
        if (actw && i <= cw) {
            __builtin_amdgcn_s_setprio(1); qk192_pipe(p0, p1, K_l + sl * 16384, R_l + sl * 8192, r32, hi, qr, &negm); __builtin_amdgcn_s_setprio(0);
            bf16x8 pa0, pa1, pa2, pa3;
            mla_softmax_rel(p0, p1, m_reg, negm, i == 0, l_reg, o, al_l, r32, hi, pa0, pa1, pa2, pa3);
            __builtin_amdgcn_s_setprio(1); pv_tile(o, vbase + (unsigned)(sl * 16384), pa0, pa1, pa2, pa3); __builtin_amdgcn_s_setprio(0);
        }
        sl = (sl == 2) ? 0 : sl + 1; sl2 = (sl2 == 2) ? 0 : sl2 + 1;
    }
    asm volatile("s_waitcnt lgkmcnt(0)" ::: "memory"); __builtin_amdgcn_s_barrier(); asm volatile("" ::: "memory");
    if (actw) {
        if (hi == 0) li_l[r32] = l_reg;
        asm volatile("s_waitcnt lgkmcnt(0)" ::: "memory");
        float rli[16];
#pragma unroll
        for (int r = 0; r < 16; ++r) rli[r] = 1.0f / li_l[crow(r, hi)];
        store_o_staged(o, rli, u.O + (size_t)(wid * 32) * u.ldo, u.ldo, lds + wid * 8192, lane, r32, hi, u.ssq + (size_t)(wid * 32) * 32);
    }
    asm volatile("s_waitcnt lgkmcnt(0)" ::: "memory"); __builtin_amdgcn_s_barrier(); asm volatile("" ::: "memory");
    __builtin_amdgcn_s_setprio(0);
#undef DMA_TILE
}
template <int VAR = 0> __device__ __forceinline__ void mla_unit(const Unit u, ALAS char* lds) {
    int tid_o = threadIdx.x; asm volatile("" : "+v"(tid_o));
    if (__builtin_amdgcn_readfirstlane(tid_o >> 6) >= 4) mla_body<true, VAR>(u, lds); else mla_body<false, VAR>(u, lds);
}
#undef PK4
}
#define GAS __attribute__((address_space(1)))
#define LAS __attribute__((address_space(3)))
typedef unsigned short bf16;
typedef unsigned v4u __attribute__((ext_vector_type(4)));
typedef float f32x4 __attribute__((ext_vector_type(4)));
typedef short bf16x8 __attribute__((ext_vector_type(8)));
typedef GAS unsigned gu32;
typedef GAS unsigned long long gu64;
#define RLX_AGENT __ATOMIC_RELAXED, __HIP_MEMORY_SCOPE_AGENT
#define LDS_WAIT() asm volatile("s_waitcnt lgkmcnt(0)" ::: "memory")
#define VM_WAIT() asm volatile("s_waitcnt vmcnt(0)" ::: "memory")
__device__ __forceinline__ unsigned long long rt() { return __builtin_amdgcn_s_memrealtime(); }
__device__ __forceinline__ unsigned f2bf(float f) { unsigned u = __builtin_bit_cast(unsigned, f); return (u + 0x7fffu + ((u >> 16) & 1u)) >> 16; }
__device__ __forceinline__ unsigned pk2(float lo, float hi) { return f2bf(lo) | (f2bf(hi) << 16); }

#define XB_TMO      128
#define XB_XCNT(j)  (256  + 64 * (j))
#define XB_XSUB(j)  (1280 + 64 * (j))
#define XB_XGEN(j)  (2304 + 64 * (j))
#define XB_TOP      3328
#define XB_TOPGEN   3392
#define XCD_BAR_WORDS 3456
#define XB_SPIN_CAP (1u << 18)

__device__ __forceinline__ unsigned xb_ld(unsigned* p)              { return __hip_atomic_load(p, __ATOMIC_RELAXED, __HIP_MEMORY_SCOPE_AGENT); }
__device__ __forceinline__ unsigned xb_add(unsigned* p, unsigned v) { return __hip_atomic_fetch_add(p, v, __ATOMIC_RELAXED, __HIP_MEMORY_SCOPE_AGENT); }
__device__ __forceinline__ unsigned xb_xcc_id() { return (unsigned)__builtin_amdgcn_s_getreg((3 << 11) | 20) & 0xFu; }
#define XB_SPIN(cond, bar) do { unsigned _sp = 0; while (cond) { __builtin_amdgcn_s_sleep(1); \
    if ((++_sp & 255u) == 0u) { if (xb_ld(&(bar)[XB_TMO])) break; if (_sp > XB_SPIN_CAP) { atomicAdd(&(bar)[XB_TMO], 1u); break; } } } } while (0)

struct XcdBarrier {
    unsigned* bar; unsigned x;
    volatile LAS unsigned* st;
};

__device__ __forceinline__ XcdBarrier xcd_barrier_post(unsigned* bar, volatile LAS unsigned* st) {
    XcdBarrier b; b.bar = bar; b.x = xb_xcc_id(); b.st = st;
    if (threadIdx.x == 0) (void)xb_add(&bar[XB_XCNT(b.x)], 1u);
    return b;
}
__device__ __forceinline__ void xcd_barrier_complete(unsigned* bar, unsigned x, unsigned& nloc, unsigned& nx) {
    const unsigned G = gridDim.x * gridDim.y * gridDim.z;
    unsigned sum, cnt, mine, sp = 0u;
    for (;;) {
        sum = 0u; cnt = 0u; mine = 0u;
#pragma unroll
        for (unsigned j = 0; j < 16; ++j) { const unsigned c = xb_ld(&bar[XB_XCNT(j)]); sum += c; cnt += (c > 0u) ? 1u : 0u; mine = (j == x) ? c : mine; }
        if (sum == G) break;
        __builtin_amdgcn_s_sleep(1);
        if ((++sp & 255u) == 0u) { if (xb_ld(&bar[XB_TMO])) break; if (sp > XB_SPIN_CAP) { atomicAdd(&bar[XB_TMO], 1u); break; } }
    }
    nloc = mine > 0u ? mine : 1u; nx = cnt > 0u ? cnt : 1u;
}

__device__ __forceinline__ void xcd_barrier(const XcdBarrier& b) {
    asm volatile("s_waitcnt vmcnt(0)" ::: "memory");
    __syncthreads();
    if (threadIdx.x == 0) {
        unsigned* bar = b.bar;
        __builtin_amdgcn_s_waitcnt(0);
        unsigned nloc = b.st[0], nx = b.st[1];
        if (nloc == 0u) { xcd_barrier_complete(bar, b.x, nloc, nx); b.st[0] = nloc; b.st[1] = nx; }
        const unsigned old = xb_add(&bar[XB_XSUB(b.x)], 1u);
        const unsigned gen = old / nloc;
        if (old + 1u == (gen + 1u) * nloc) {
            __builtin_amdgcn_fence(__ATOMIC_RELEASE, "agent");
            asm volatile("s_waitcnt vmcnt(0)" ::: "memory");
            const unsigned og = xb_add(&bar[XB_TOP], 1u);
            const unsigned tg = og / nx;
            if (og + 1u == (tg + 1u) * nx) xb_add(&bar[XB_TOPGEN], 1u);
            else XB_SPIN(xb_ld(&bar[XB_TOPGEN]) == tg, bar);
            __builtin_amdgcn_fence(__ATOMIC_ACQUIRE, "agent");
            xb_add(&bar[XB_XGEN(b.x)], 1u);
            asm volatile("s_waitcnt vmcnt(0)" ::: "memory");
        } else {
            XB_SPIN(xb_ld(&bar[XB_XGEN(b.x)]) == gen, bar);
            __builtin_amdgcn_fence(__ATOMIC_ACQUIRE, "agent");
            asm volatile("s_waitcnt vmcnt(0)" ::: "memory");
        }
    }
    __syncthreads();
}
constexpr int NWAVES = 8;
constexpr int DM = 4096, NP = 16384, NS = 512, MTOK = NP + NS;
constexpr int SEQ = 4096, PAST = 1024, DSEQ = 64, SKVS = PAST + DSEQ;
constexpr int KVROWS = NP + 8 * SKVS;
constexpr int NINP = 7936;
constexpr int QLORA = 1024, KVLORA = 512, ROPE = 64, NOPE = 128, NH = 16, DFF = 16384;
constexpr float EPS = 1e-6f;
constexpr float LOG2E = 1.4426950408889634f;
constexpr float QS_MLA = 0.07216878364870322f * LOG2E;
constexpr float QS_SB = 0.08838834764831845f * LOG2E;

constexpr size_t O_Y = 0, O_CKV_P = 69206016, O_KR_P = 85983232, O_SBK_P = 88080384, O_SBV_P = 155189248,
                 O_CKV_S = 222298112, O_KR_S = 222822400, O_SBK_S = 222887936, O_SBV_S = 224985088, O_END = 227082240;

constexpr size_t MiB = 1u << 20;
constexpr size_t WS_CTL = 0, CTL_ZERO_BYTES = 1 * MiB;
constexpr size_t WS_SSQH = 512 * 1024;
constexpr size_t WS_TAB = 1 * MiB;
constexpr size_t WS_WIN = 2 * MiB;
constexpr size_t WS_WQB = 64 * MiB;
constexpr size_t WS_WKVB = 70 * MiB;
constexpr size_t WS_WO = 74 * MiB;
constexpr size_t WS_WUP = 106 * MiB;
constexpr size_t WS_WDN = 234 * MiB;
constexpr size_t WS_XN = 362 * MiB;
constexpr size_t WS_R = 494 * MiB;
constexpr size_t WS_U = WS_R;
constexpr size_t WS_QLAT = WS_R;
constexpr size_t WS_AKV = WS_QLAT + 33 * MiB;
constexpr size_t WS_KROPE = WS_AKV + 25 * MiB;
constexpr size_t WS_VB = WS_KROPE + 4 * MiB;
constexpr size_t WS_QB = WS_VB + 98 * MiB;
constexpr size_t WS_KN = WS_QB + 99 * MiB;
constexpr size_t WS_SBQ = WS_KN + 98 * MiB;
constexpr size_t WS_SBK = WS_SBQ + 66 * MiB;
constexpr size_t WS_SBV = WS_SBK + 98 * MiB;
constexpr size_t WS_R2 = WS_SBV + 98 * MiB;
constexpr size_t WS_LAT = WS_R2;
constexpr size_t WS_QRAW = WS_R2;
constexpr size_t WS_KNRAW = WS_R2 + 198 * MiB;
constexpr size_t WS_MLAO = WS_R2;
constexpr size_t WS_SBO = WS_R2 + 66 * MiB;
constexpr size_t WS_MERGED = WS_R2 + 132 * MiB;
constexpr size_t WS_SLAB = WS_R2;
constexpr size_t WS_Y0B = WS_R2 + 264 * MiB;
constexpr size_t WS_WDN1 = WS_R2 + 398 * MiB;
constexpr size_t WS_SSQP = WS_WDN1 + 128 * MiB;
constexpr size_t WS_END = WS_SSQP + 3 * MiB;
static_assert(WS_U + (size_t)MTOK * DFF * 2 <= WS_END, "U fits the overlay region");
static_assert(WS_XN + (size_t)MTOK * DM * 2 <= WS_R && WS_WDN + (size_t)DM * DFF * 2 <= WS_XN && WS_WIN + (size_t)NINP * DM * 2 <= WS_WQB, "ws map");
constexpr int CW_TMO = 0, CW_CODE = 1, CW_BAR = 4096;

constexpr int RING_OFF = 0, RING_BYTES = 131072;
constexpr int LDSCTL_OFF = RING_BYTES, MISC_OFF = LDSCTL_OFF + 320;
constexpr int XCH_OFF = LDSCTL_OFF + 1024;
constexpr int LDS_BYTES = 147456;
static_assert(XCH_OFF + 8192 <= LDS_BYTES, "LDS map");
static_assert(att::ATT_LDS_BYTES <= RING_BYTES && att::MLA_LDS_BYTES <= RING_BYTES && att::DMA_LDS_BYTES <= RING_BYTES, "attention scratch fits the ring region");

#if defined(__HIP_DEVICE_COMPILE__)
#define ASSUME_GLOBAL(p) do { __builtin_assume(!__builtin_amdgcn_is_shared((const __attribute__((address_space(0))) void*)(p))); __builtin_assume(!__builtin_amdgcn_is_private((const __attribute__((address_space(0))) void*)(p))); } while (0)
#else
#define ASSUME_GLOBAL(p) do { } while (0)
#endif
typedef float f32x2 __attribute__((ext_vector_type(2)));
__device__ __forceinline__ float wave_sum(float v) {
#pragma unroll
    for (int o = 1; o < 64; o <<= 1) v += __shfl_xor(v, o);
    return v;
}
__device__ __forceinline__ unsigned pkbf(float lo, float hi) { return pg8::cvt_pk_bf16(lo, hi); }
__device__ __forceinline__ float bf2f(unsigned short b) { return __uint_as_float(((unsigned)b) << 16); }
__device__ __forceinline__ int kvrow_of(int m) { return m < NP ? m : NP + ((m - NP) >> 6) * SKVS + PAST + ((m - NP) & 63); }
__device__ __forceinline__ int pos_of(int m) { return m < NP ? (m & (SEQ - 1)) : PAST + ((m - NP) & 63); }

__device__ __forceinline__ void sincos_acc(float ang, float& s, float& c) {
    const double a = (double)ang; const double q = rint(a * 0.63661977236758134308);
    double r = fma(-q, 1.57079632679489661923, a); r = fma(-q, 6.123233995736766e-17, r);
    const float rf = (float)r; const int qi = (int)q; const float r2 = rf * rf;
    const float sp = rf + rf * r2 * (-1.6666667163e-1f + r2 * (8.3333337680e-3f + r2 * (-1.9841270114e-4f + r2 * 2.7557314297e-6f)));
    const float cp = 1.f + r2 * (-0.5f + r2 * (4.1666667908e-2f + r2 * (-1.3888889225e-3f + r2 * (2.4801587642e-5f + r2 * (-2.7557314297e-7f)))));
    switch (qi & 3) { case 0: s = sp; c = cp; break; case 1: s = cp; c = -sp; break; case 2: s = -sp; c = -cp; break; default: s = -cp; c = sp; break; }
}

struct Frame {
    LAS unsigned char* lds; volatile LAS unsigned* MISC; gu32* ctl;
    int tid, lane, wave, vcu, G;
};
struct Args { const float* in[22]; float* out; unsigned char* ws; };

struct TItem { const float* src; bf16* dst; const float* gk; int N, K; };
__device__ __forceinline__ void ti_load(const TItem& P, float (&tv)[32], f32x4& g0, f32x4& g1, int lane) {
    if (P.gk) { g0 = *(const GAS f32x4*)(P.gk + 8 * (lane & 7)); g1 = *(const GAS f32x4*)(P.gk + 8 * (lane & 7) + 4); }
    else { g0 = f32x4{1.f, 1.f, 1.f, 1.f}; g1 = g0; }
    const GAS float* s = (const GAS float*)P.src + (size_t)(lane >> 5) * P.N + (lane & 31);
#pragma unroll
    for (int i = 0; i < 32; ++i) tv[i] = s[(size_t)(2 * i) * P.N];
}
__device__ __forceinline__ void ti_finish(const TItem& P, const float (&tv)[32], const f32x4 g0, const f32x4 g1, LAS float* scr, int lane) {
#pragma unroll
    for (int i = 0; i < 32; ++i) scr[(2 * i + (lane >> 5)) * 33 + (lane & 31)] = tv[i];
    LDS_WAIT(); asm volatile("" ::: "memory");
    const int c = lane & 7;
#pragma unroll
    for (int j = 0; j < 4; ++j) { const int n = (lane >> 3) + 8 * j; const LAS float* s = scr + (8 * c) * 33 + n;
        v4u o; o.x = pkbf(s[0 * 33] * g0.x, s[1 * 33] * g0.y); o.y = pkbf(s[2 * 33] * g0.z, s[3 * 33] * g0.w); o.z = pkbf(s[4 * 33] * g1.x, s[5 * 33] * g1.y); o.w = pkbf(s[6 * 33] * g1.z, s[7 * 33] * g1.w);
        *(GAS v4u*)(P.dst + (size_t)n * P.K + 8 * c) = o; }
    LDS_WAIT(); asm volatile("" ::: "memory");
}
__device__ __forceinline__ void rms_row_4096(const float* xrow, const float* g, bf16* orow, int lane) {
    const GAS f32x4* xr = (const GAS f32x4*)xrow + lane; const GAS f32x4* gr = (const GAS f32x4*)g + lane;
    f32x4 v[16]; float s = 0.f;
#pragma unroll
    for (int j = 0; j < 16; ++j) { v[j] = xr[64 * j]; s += (v[j].x * v[j].x + v[j].y * v[j].y) + (v[j].z * v[j].z + v[j].w * v[j].w); }
    const float rstd = 1.0f / sqrtf(wave_sum(s) * (1.f / 4096.f) + EPS);
    GAS unsigned long long* o8 = (GAS unsigned long long*)orow + lane;
#pragma unroll
    for (int j = 0; j < 16; ++j) { const f32x4 gg = gr[64 * j];
        o8[64 * j] = (unsigned long long)pkbf(v[j].x * rstd * gg.x, v[j].y * rstd * gg.y) | ((unsigned long long)pkbf(v[j].z * rstd * gg.z, v[j].w * rstd * gg.w) << 32); }
}
__device__ __forceinline__ void rms_row_4096_bf16(const bf16* xrow, const float* g, bf16* orow, int lane) {
    const GAS v4u* xr = (const GAS v4u*)xrow + lane; float x[64]; float s = 0.f;
#pragma unroll
    for (int j = 0; j < 8; ++j) { const v4u w = xr[64 * j]; const unsigned ww[4] = {w.x, w.y, w.z, w.w};
#pragma unroll
        for (int e = 0; e < 4; ++e) { x[8 * j + 2 * e] = __uint_as_float(ww[e] << 16); x[8 * j + 2 * e + 1] = __uint_as_float(ww[e] & 0xffff0000u); } }
#pragma unroll
    for (int i = 0; i < 64; ++i) s += x[i] * x[i];
    const float rstd = 1.0f / sqrtf(wave_sum(s) * (1.f / 4096.f) + EPS);
#pragma unroll
    for (int j = 0; j < 8; ++j) { const GAS f32x4* gp = (const GAS f32x4*)(g + 8 * (64 * j + lane)); const f32x4 g0 = gp[0], g1 = gp[1];
        v4u o; o.x = pkbf(x[8 * j] * rstd * g0.x, x[8 * j + 1] * rstd * g0.y); o.y = pkbf(x[8 * j + 2] * rstd * g0.z, x[8 * j + 3] * rstd * g0.w);
        o.z = pkbf(x[8 * j + 4] * rstd * g1.x, x[8 * j + 5] * rstd * g1.y); o.w = pkbf(x[8 * j + 6] * rstd * g1.z, x[8 * j + 7] * rstd * g1.w);
        *((GAS v4u*)orow + 64 * j + lane) = o; }
}
__device__ __forceinline__ void cache_rows_to_bf16(const float* src, bf16* dst, int W, int gthread, int nthreads) {
    const int per_row = W >> 2; const long total = (long)8 * PAST * per_row;
    for (long i = gthread; i < total; i += nthreads) {
        const int row = (int)(i / per_row), c4 = (int)(i % per_row), b = row >> 10, j = row & 1023;
        const f32x4 v = *(const GAS f32x4*)(src + (size_t)row * W + c4 * 4);
        *(GAS unsigned long long*)(dst + (size_t)(NP + b * SKVS + j) * W + c4 * 4) = (unsigned long long)pkbf(v.x, v.y) | ((unsigned long long)pkbf(v.z, v.w) << 32);
    }
}

template <bool NORM, class Order>
__device__ __forceinline__ void tail_reduce_res(const Order& S, const float* resP, const float* resS, float* out, bf16* HB, float* ssq, const float* ssqm, const float* ssqs, bf16* YB, int tid) {
    if (S.nsplit == 1) return;
    const int wid = __builtin_amdgcn_readfirstlane(tid >> 6), lane = tid & 63, wr = wid >> 2, wc = wid & 3, fr = lane & 15, fq = lane >> 4;
    const int j = S.c / S.nsplit, p = S.c % S.nsplit, per = 32 / S.nsplit;
    pg8::Unit u; S.map(S.nfull * S.G + j, u);
    for (int ii = 0; ii < per; ++ii) {
        const int idx = p * per + ii, a = idx >> 4, b = (idx >> 3) & 1, mm = (idx >> 1) & 3, n = idx & 1;
        const int row = u.pm * 256 + a * 128 + wr * 64 + mm * 16 + fr, col = u.pn * 256 + b * 128 + wc * 32 + 8 * fq + 4 * n;
        f32x4 s = {0.f, 0.f, 0.f, 0.f}, s2 = {0.f, 0.f, 0.f, 0.f};
        for (int sp = 0; sp < S.nsplit; ++sp) { const f32x4 v = *((const GAS f32x4*)(S.slab + (size_t)(j * S.nsplit + sp) * 65536) + (size_t)wid * 2048 + idx * 64 + lane); if (2 * sp < S.nsplit) s += v; else s2 += v; }
        if (NORM) {
            const float rm = 1.0f / sqrtf(__hip_atomic_load(ssqm + row, __ATOMIC_RELAXED, __HIP_MEMORY_SCOPE_AGENT) * (1.f / 2048.f) + EPS), rs = 1.0f / sqrtf(__hip_atomic_load(ssqs + row, __ATOMIC_RELAXED, __HIP_MEMORY_SCOPE_AGENT) * (1.f / 2048.f) + EPS);
            s = s * rm + s2 * rs; } else s += s2;
        f32x4 v;
        if (NORM) { if (YB) { const unsigned long long h = *(const GAS unsigned long long*)(YB + (size_t)row * DM + col); const unsigned h0 = (unsigned)h, h1 = (unsigned)(h >> 32);
                                v = (f32x4){__uint_as_float(h0 << 16), __uint_as_float(h0 & 0xffff0000u), __uint_as_float(h1 << 16), __uint_as_float(h1 & 0xffff0000u)} + s; }
                    else { const float* rp = (row >= NP) ? resS + (size_t)(row - NP) * DM + col : resP + (size_t)row * DM + col; v = *(const GAS f32x4*)rp + s; } }
        else { const unsigned long long h = *(const GAS unsigned long long*)(HB + (size_t)row * DM + col); const unsigned h0 = (unsigned)h, h1 = (unsigned)(h >> 32);
               v = (f32x4){__uint_as_float(h0 << 16), __uint_as_float(h0 & 0xffff0000u), __uint_as_float(h1 << 16), __uint_as_float(h1 & 0xffff0000u)} + s;
               if (YB) { *(GAS unsigned long long*)(YB + (size_t)row * DM + col) = (unsigned long long)pkbf(v.x, v.y) | ((unsigned long long)pkbf(v.z, v.w) << 32);
                         float q = (v.x * v.x + v.y * v.y) + (v.z * v.z + v.w * v.w); q += __shfl_xor(q, 16); q += __shfl_xor(q, 32);
                         if (fq == 0) __hip_atomic_fetch_add(ssq + row, q, __ATOMIC_RELAXED, __HIP_MEMORY_SCOPE_AGENT); }
               else *(GAS f32x4*)(out + (size_t)row * DM + col) = v; }
        if (NORM) {
            *(GAS unsigned long long*)(HB + (size_t)row * DM + col) = (unsigned long long)pkbf(v.x, v.y) | ((unsigned long long)pkbf(v.z, v.w) << 32);
            float q = (v.x * v.x + v.y * v.y) + (v.z * v.z + v.w * v.w); q += __shfl_xor(q, 16); q += __shfl_xor(q, 32);
            if (fq == 0) __hip_atomic_fetch_add(ssq + row, q, __ATOMIC_RELAXED, __HIP_MEMORY_SCOPE_AGENT);
        }
    }
}

__global__ void __launch_bounds__(NWAVES * 64, 2) hymba_fwd(Args args) {
    extern __shared__ __attribute__((aligned(16))) unsigned char lds[];
    Frame F;
    F.lds = (LAS unsigned char*)lds;
    F.MISC = (volatile LAS unsigned*)(F.lds + MISC_OFF);
    F.tid = threadIdx.x; F.lane = F.tid & 63; F.wave = __builtin_amdgcn_readfirstlane(F.tid >> 6);
    F.G = gridDim.x; { const int bx = blockIdx.x; F.vcu = (F.G % 8 == 0) ? (bx % 8) * (F.G / 8) + bx / 8 : bx; }
    unsigned char* ws = args.ws;
    F.ctl = (gu32*)(ws + WS_CTL);
    for (int u = F.tid; u < (LDS_BYTES - LDSCTL_OFF) / 4; u += NWAVES * 64) ((LAS unsigned*)(F.lds + LDSCTL_OFF))[u] = 0u;
    __syncthreads();
    XcdBarrier bar = xcd_barrier_post((unsigned*)(F.ctl + CW_BAR), F.MISC + 8);
#ifndef G5_WGM
#define G5_WGM 8
#endif
#ifndef PROBE_MASK
#define PROBE_MASK 0
#endif
#ifndef PROBE_BAR
#define PROBE_BAR 1
#endif
#ifndef PHMASK
#define PHMASK 0x3fff
#endif
#define GRID_BAR() do { for (int br_ = 0; br_ < PROBE_BAR; ++br_) xcd_barrier(bar); } while (0)
#define PHASE_PTRS() unsigned long long zoff_ = 0; asm volatile("" : "+s"(zoff_)); unsigned char* const wsb = args.ws + zoff_; float* const OUT = args.out + zoff_;     int ptid_ = threadIdx.x; asm volatile("" : "+v"(ptid_)); int bx_ = blockIdx.x, G_ = gridDim.x; asm volatile("" : "+s"(bx_), "+s"(G_)); const int VCU = (G_ % 8 == 0) ? (bx_ % 8) * (G_ / 8) + bx_ / 8 : bx_; (void)VCU; \
    const int LANE = ptid_ & 63, WAVE = __builtin_amdgcn_readfirstlane(ptid_ >> 6); const int gw = VCU * NWAVES + WAVE, NGW = G_ * NWAVES; const int gthread = gw * 64 + LANE, nthreads = NGW * 64; (void)gthread; (void)nthreads; (void)gw; (void)NGW; (void)LANE
#define WIN_T ((bf16*)(wsb + WS_WIN))
#define WQB_T ((bf16*)(wsb + WS_WQB))
#define WKVB_T ((bf16*)(wsb + WS_WKVB))
#define WO_T ((bf16*)(wsb + WS_WO))
#define WUP_T ((bf16*)(wsb + WS_WUP))
#define WDN_T0 ((bf16*)(wsb + WS_WDN))
#define WDN_T1 ((bf16*)(wsb + WS_WDN1))
#define XN ((bf16*)(wsb + WS_XN))
#define UB ((bf16*)(wsb + WS_U))
#define QLAT ((bf16*)(wsb + WS_QLAT))
#define AKV ((bf16*)(wsb + WS_AKV))
#define KROPE ((bf16*)(wsb + WS_KROPE))
#define VB ((bf16*)(wsb + WS_VB))
#define QB ((bf16*)(wsb + WS_QB))
#define KN ((bf16*)(wsb + WS_KN))
#define SBQ ((bf16*)(wsb + WS_SBQ))
#define SBK ((bf16*)(wsb + WS_SBK))
#define SBV ((bf16*)(wsb + WS_SBV))
#define LAT ((float*)(wsb + WS_LAT))
#define QRAW ((float*)(wsb + WS_QRAW))
#define KNRAW ((float*)(wsb + WS_KNRAW))
#define MLAO ((bf16*)(wsb + WS_MLAO))
#define SBO ((bf16*)(wsb + WS_SBO))
#define MERGED ((bf16*)(wsb + WS_MERGED))
#define TAB ((f32x2*)(wsb + WS_TAB))
#define SLAB ((float*)(wsb + WS_SLAB))
#define Y0B ((bf16*)(wsb + WS_Y0B))
#define SSQH ((float*)(wsb + WS_SSQH))
#define SSQM ((float*)(wsb + WS_SSQH + 128 * 1024))
#define SSQS ((float*)(wsb + WS_SSQH + 256 * 1024))
#define SSQP ((float*)(wsb + WS_SSQP))
#define SSQY ((float*)(wsb + WS_SSQH + 384 * 1024))

    { PHASE_PTRS(); (void)OUT;
    for (int i = gthread; i < SEQ * 32; i += nthreads) {
        const int pos = i >> 5, k = i & 31;
        const float inv_freq = exp2f(-(float)k * (13.287712379549449f / 32.f));
        float s, c; sincos_acc((float)pos * inv_freq, s, c); TAB[i] = (f32x2){c, s};
    } }

#define CONVERT_ITEMS(LW, R_LO, R_HI, GWV, NGWV) do { \
        const float* w_in = args.in[7] + (size_t)(LW) * DM * 7744; const float* w_qb = args.in[9] + (size_t)(LW) * QLORA * 3072; \
        const float* w_kvb = args.in[11] + (size_t)(LW) * KVLORA * 4096; const float* w_o = args.in[18] + (size_t)(LW) * DM * DM; \
        const float* w_up = args.in[20] + (size_t)(LW) * DM * DFF; const float* w_dn = args.in[21] + (size_t)(LW) * DFF * DM; const int lw_ = (LW); \
        auto dec_ = [&](int it) -> TItem { \
                int r = (R_HI) - 1 - it; \
                if (r < I_IN) { const int kb = r / 242, nb = r % 242, n0 = nb * 32; return TItem{w_in + (size_t)(kb * 64) * 7744 + n0, WIN_T + (size_t)(n0 + (n0 >= 1600 ? 192 : 0)) * DM + kb * 64, lw_ ? args.in[6] + (size_t)lw_ * DM + kb * 64 : nullptr, 7744, DM}; } r -= I_IN; \
                if (r < I_QB) { const int kb = r / 96, nb = r % 96, n0 = nb * 32, h = n0 / 192, dd = n0 % 192; \
                    return TItem{w_qb + (size_t)(kb * 64) * 3072 + n0, WQB_T + (size_t)(dd < 128 ? h * 128 + dd : 2048 + (h >> 2) * 256 + ((dd - 128) >> 5) * 128 + (h & 3) * 32) * QLORA + kb * 64, nullptr, 3072, QLORA}; } r -= I_QB; \
                if (r < I_KVB) { const int kb = r / 128, nb = r % 128, n0 = nb * 32, h = n0 >> 8, dd = n0 & 255; \
                    return TItem{w_kvb + (size_t)(kb * 64) * 4096 + n0, WKVB_T + (size_t)(dd < 128 ? h * 128 + dd : 2048 + h * 128 + (dd - 128)) * KVLORA + kb * 64, nullptr, 4096, KVLORA}; } r -= I_KVB; \
                if (r < I_O) { const int kb = r / 128, nb = r % 128; \
                    return TItem{w_o + (size_t)(kb * 64) * DM + nb * 32, WO_T + (size_t)(nb * 32) * DM + kb * 64, (kb < 32 ? args.in[16] + (size_t)lw_ * 2048 : args.in[17] + (size_t)lw_ * 2048 - 2048) + kb * 64, DM, DM}; } r -= I_O; \
                if (r < I_UP) { const int kb = r / 512, nb = r % 512; return TItem{w_up + (size_t)(kb * 64) * DFF + nb * 32, WUP_T + (size_t)(nb * 32) * DM + kb * 64, args.in[19] + (size_t)lw_ * DM + kb * 64, DFF, DM}; } r -= I_UP; \
                { const int kb = r / 128, nb = r % 128; return TItem{w_dn + (size_t)(kb * 64) * DM + nb * 32, (lw_ ? WDN_T1 : WDN_T0) + ((size_t)((nb >> 3) * 256 + kb) * 256 + (nb & 7) * 32) * 64, nullptr, DM, 64}; } }; \
        const int n_ = (R_HI) - (R_LO); int it = (GWV); \
        if (it < n_) { \
            float tA[32], tB[32]; f32x4 gA0, gA1, gB0, gB1; \
            TItem PA = dec_(it), PB; ti_load(PA, tA, gA0, gA1, LANE); \
            for (;;) {                                     \
                const int it1 = it + (NGWV); PB = dec_(it1 < n_ ? it1 : it); ti_load(PB, tB, gB0, gB1, LANE); \
                ti_finish(PA, tA, gA0, gA1, scr, LANE); \
                if (it1 >= n_) break; \
                const int it2 = it1 + (NGWV); PA = dec_(it2 < n_ ? it2 : it1); ti_load(PA, tA, gA0, gA1, LANE); \
                ti_finish(PB, tB, gB0, gB1, scr, LANE); \
                if (it2 >= n_) break; \
                it = it2; \
            } } } while (0)
    constexpr int I_IN = 64 * 242, I_QB = 16 * 96, I_KVB = 8 * 128, I_O = 64 * 128, I_UP = 64 * 512, I_DN = 256 * 128;
    constexpr int NITEMS = I_IN + I_QB + I_KVB + I_O + I_UP + I_DN, EARLY_ITEMS = I_IN + I_QB + I_KVB + I_O, EARLY0_ITEMS = I_IN + I_QB + I_KVB;
#pragma unroll 1
    for (int l = 0; l < 2; ++l) {
        if (l == 0 || gridDim.x != 256) {
        for (int rep_ = 0; rep_ < (((PROBE_MASK >> 0) & 1) ? 2 : 1); ++rep_) if constexpr ((PHMASK >> 0) & 1) {
            PHASE_PTRS(); (void)OUT;
            LAS float* scr = (LAS float*)(F.lds + RING_OFF + WAVE * 16384);
            const bool early_ok = (G_ == 256);
            CONVERT_ITEMS(l, (l > 0 && early_ok) ? NITEMS : 0, (l == 0 && early_ok) ? EARLY0_ITEMS : NITEMS, gw, NGW);
            if (l == 0) {
            { unsigned zz = 0u; asm volatile("" : "+v"(zz)); const v4u z4 = {zz, zz, zz, zz};
              for (int i = gthread; i < 192 * DM / 8; i += nthreads) *(GAS v4u*)(WIN_T + (size_t)1600 * DM + (size_t)i * 8) = z4; }
            cache_rows_to_bf16(args.in[2] + (size_t)l * 8 * PAST * KVLORA, AKV, KVLORA, gthread, nthreads);
            cache_rows_to_bf16(args.in[3] + (size_t)l * 8 * PAST * ROPE, KROPE, ROPE, gthread, nthreads);
            const float* g = args.in[6] + (size_t)l * DM;
            for (int m = gw; m < MTOK; m += NGW) rms_row_4096(m < NP ? args.in[0] + (size_t)m * DM : args.in[1] + (size_t)(m - NP) * DM, g, XN + (size_t)m * DM, LANE);
            }
        }
        GRID_BAR();
        }
        for (int rep_ = 0; rep_ < (((PROBE_MASK >> 1) & 1) ? 2 : 1); ++rep_) if constexpr ((PHMASK >> 1) & 1) {
            PHASE_PTRS(); (void)OUT;
            pg8::Gemm g{l == 0 ? XN : Y0B, WIN_T, MTOK, NINP, DM, nullptr}; pg8::StaticOrder S; S.init(MTOK, NINP, G_, bx_);
            pg8::EpiIn E{LAT, SBQ, SBK, SBV, OUT + O_SBK_P + (size_t)l * NP * 2048, OUT + O_SBV_P + (size_t)l * NP * 2048,
                         OUT + O_SBK_S + (size_t)l * NS * 2048, OUT + O_SBV_S + (size_t)l * NS * 2048, QS_SB, l == 0 ? nullptr : SSQY, EPS};
            const bool bg = (l == 0 && G_ == 256);
            const int rsplit = bg ? ((bx_ & 7) >> 1) : 0;
#pragma unroll 1
            for (int seg = 0; seg < 2; ++seg) {
                pg8::SubRange<pg8::StaticOrder> SS{S, seg ? rsplit : 0, seg ? (1 << 30) : rsplit};
                pg8::gemm_phase<pg8::EpiIn, pg8::SubRange<pg8::StaticOrder>, true, true>(F.lds + RING_OFF, g, SS, E);
                if (seg == 0 && bg) {
                    LAS float* scr = (LAS float*)(F.lds + RING_OFF + WAVE * 16384);
                    CONVERT_ITEMS(0, EARLY0_ITEMS, NITEMS, gw, NGW);
                    __syncthreads();
                }
            }
        }
        GRID_BAR();
        for (int rep_ = 0; rep_ < (((PROBE_MASK >> 2) & 1) ? 2 : 1); ++rep_) if constexpr ((PHMASK >> 2) & 1) {
            PHASE_PTRS(); (void)OUT;
            for (int i = gthread; i < MTOK; i += nthreads) { SSQH[i] = 0.f; SSQM[i] = 0.f; SSQS[i] = 0.f; if (l == 0) SSQY[i] = 0.f; }
            const float* g_q_a = args.in[8] + (size_t)l * QLORA; const float* g_kv_a = args.in[10] + (size_t)l * KVLORA; const float* g_k_rope = args.in[15] + (size_t)l * ROPE;
            for (int m = gw; m < MTOK; m += NGW) {
                const float* lr = LAT + (size_t)m * 1792; const int kvr = kvrow_of(m), pos = pos_of(m);
                {
                    f32x4 v[4]; float s = 0.f;
#pragma unroll
                    for (int j = 0; j < 4; ++j) { v[j] = *(const GAS f32x4*)(lr + 4 * (64 * j + LANE)); s += (v[j].x * v[j].x + v[j].y * v[j].y) + (v[j].z * v[j].z + v[j].w * v[j].w); }
                    const float rstd = 1.0f / sqrtf(wave_sum(s) * (1.f / 1024.f) + EPS);
#pragma unroll
                    for (int j = 0; j < 4; ++j) { const f32x4 gg = *(const GAS f32x4*)(g_q_a + 4 * (64 * j + LANE));
                        *(GAS unsigned long long*)(QLAT + (size_t)m * QLORA + 4 * (64 * j + LANE)) =
                            (unsigned long long)pkbf(v[j].x * rstd * gg.x, v[j].y * rstd * gg.y) | ((unsigned long long)pkbf(v[j].z * rstd * gg.z, v[j].w * rstd * gg.w) << 32); }
                }
                {
                    f32x4 v[2]; float s = 0.f;
#pragma unroll
                    for (int j = 0; j < 2; ++j) { v[j] = *(const GAS f32x4*)(lr + 1024 + 4 * (64 * j + LANE)); s += (v[j].x * v[j].x + v[j].y * v[j].y) + (v[j].z * v[j].z + v[j].w * v[j].w); }
                    const float rstd = 1.0f / sqrtf(wave_sum(s) * (1.f / 512.f) + EPS);
                    float* oc = (m < NP) ? OUT + O_CKV_P + ((size_t)l * NP + m) * KVLORA : OUT + O_CKV_S + ((size_t)l * NS + (m - NP)) * KVLORA;
#pragma unroll
                    for (int j = 0; j < 2; ++j) { const f32x4 gg = *(const GAS f32x4*)(g_kv_a + 4 * (64 * j + LANE));
                        const f32x4 c = {v[j].x * rstd * gg.x, v[j].y * rstd * gg.y, v[j].z * rstd * gg.z, v[j].w * rstd * gg.w};
                        *(GAS f32x4*)(oc + 4 * (64 * j + LANE)) = c;
                        *(GAS unsigned long long*)(AKV + (size_t)kvr * KVLORA + 4 * (64 * j + LANE)) = (unsigned long long)pkbf(c.x, c.y) | ((unsigned long long)pkbf(c.z, c.w) << 32); }
                }
                {
                    const float x = lr[1536 + LANE];
                    const float rstd = 1.0f / sqrtf(wave_sum(x * x) * (1.f / 64.f) + EPS);
                    const float xn = x * rstd * g_k_rope[LANE]; const float xp = __shfl_xor(xn, 32);
                    const f32x2 cs = TAB[pos * 32 + (LANE & 31)];
                    const float o = (LANE < 32) ? xn * cs.x - xp * cs.y : xp * cs.y + xn * cs.x;
                    float* okr = (m < NP) ? OUT + O_KR_P + ((size_t)l * NP + m) * ROPE : OUT + O_KR_S + ((size_t)l * NS + (m - NP)) * ROPE;
                    okr[LANE] = o;
                    const float on = __shfl_xor(o, 1);
                    if ((LANE & 1) == 0) *(GAS unsigned*)(KROPE + (size_t)kvr * ROPE + LANE) = pkbf(o, on);
                }
            }
        }
        GRID_BAR();
        for (int rep_ = 0; rep_ < (((PROBE_MASK >> 3) & 1) ? 2 : 1); ++rep_) if constexpr ((PHMASK >> 3) & 1) {
            PHASE_PTRS(); (void)OUT;
            pg8::Gemm g{QLAT, WQB_T, MTOK, 3072, QLORA, nullptr}; pg8::StaticOrder S; S.init(MTOK, 3072, G_, bx_);
            pg8::EpiQb E{QB, args.in[12] + (size_t)l * NOPE, args.in[13] + (size_t)l * ROPE, TAB, (LAS float*)(F.lds + XCH_OFF), QS_MLA, EPS};
            pg8::gemm_phase<pg8::EpiQb, pg8::StaticOrder, true, true>(F.lds + RING_OFF, g, S, E);
        }
        for (int rep_ = 0; rep_ < (((PROBE_MASK >> 11) & 1) ? 2 : 1); ++rep_) if constexpr ((PHMASK >> 11) & 1) {
            PHASE_PTRS(); (void)OUT;
            pg8::Gemm g{AKV, WKVB_T, KVROWS, 4096, KVLORA, nullptr}; pg8::StaticOrder S; S.init(KVROWS, 4096, G_, (bx_ + G_ - 24) % G_);
            pg8::EpiKvbN E{KN, VB, args.in[14] + (size_t)l * NOPE, (LAS float*)(F.lds + XCH_OFF), EPS};
            pg8::gemm_phase<pg8::EpiKvbN, pg8::StaticOrder, true, true>(F.lds + RING_OFF, g, S, E);
        }
        GRID_BAR();
        for (int rep_ = 0; rep_ < (((PROBE_MASK >> 5) & 1) ? 2 : 1); ++rep_) if constexpr ((PHMASK >> 5) & 1) {
            PHASE_PTRS(); (void)OUT;
            const int v = VCU, bh = v >> 2, b = bh >> 4, h = bh & 15, s = v & 3;
            ALAS char* al = (ALAS char*)(F.lds + RING_OFF);
#pragma unroll 1
            for (int k = 0; k < 5; ++k) {
                att::Unit u;
                if (k < 4) { const int qb = (k == 0) ? s : (k == 1) ? 7 - s : (k == 2) ? 8 + s : 15 - s; const size_t m0 = (size_t)b * SEQ + (size_t)qb * 256, kv0 = (size_t)b * SEQ;
                    u.Q = QB + m0 * 3072 + h * 192; u.ldq = 3072; u.K = KN + kv0 * 2048 + h * 128; u.Kr = KROPE + kv0 * ROPE; u.V = VB + kv0 * 2048 + h * 128;
                    u.O = MERGED + m0 * 4096 + h * 128; u.ldo = 4096; u.ssq = SSQP + m0 * 32 + h; u.Kf0 = u.Vf0 = u.Kf1 = u.Vf1 = nullptr; u.split = 0; u.P0 = qb * 256; u.NT = 4 * qb + 4; u.nact = 8; }
                else { if (v >= 128) break; const int sb = v >> 4, sh = v & 15; const size_t m0 = (size_t)NP + (size_t)sb * 64, kv0 = (size_t)NP + (size_t)sb * SKVS;
                    u.Q = QB + m0 * 3072 + sh * 192; u.ldq = 3072; u.K = KN + kv0 * 2048 + sh * 128; u.Kr = KROPE + kv0 * ROPE; u.V = VB + kv0 * 2048 + sh * 128;
                    u.O = MERGED + m0 * 4096 + sh * 128; u.ldo = 4096; u.ssq = SSQP + m0 * 32 + sh; u.Kf0 = u.Vf0 = u.Kf1 = u.Vf1 = nullptr; u.split = 0; u.P0 = PAST; u.NT = 17; u.nact = 2; }
                if constexpr ((PHMASK >> 12) & 1) att::mla_unit_dma<0>(u, al);
            }
#pragma unroll 1
            for (int k = 0; k < 5; ++k) {
                att::Unit u;
                if (k < 4) { const int qb = (k == 0) ? s : (k == 1) ? 7 - s : (k == 2) ? 8 + s : 15 - s; const size_t m0 = (size_t)b * SEQ + (size_t)qb * 256, kv0 = (size_t)b * SEQ;
                    u.Q = SBQ + m0 * 2048 + h * 128; u.ldq = 2048; u.K = nullptr; u.Kr = nullptr; u.V = nullptr; u.split = 1 << 30;
                    u.Kf0 = OUT + O_SBK_P + ((size_t)l * NP + kv0) * 2048 + h * 128; u.Vf0 = OUT + O_SBV_P + ((size_t)l * NP + kv0) * 2048 + h * 128; u.Kf1 = u.Kf0; u.Vf1 = u.Vf0;
                    u.O = MERGED + m0 * 4096 + 2048 + h * 128; u.ldo = 4096; u.ssq = SSQP + m0 * 32 + 16 + h; u.P0 = qb * 256; u.NT = 4 * qb + 4; u.nact = 8; }
                else { if (v < 128) break; const int w = v - 128, sb = w >> 4, sh = w & 15; const size_t m0 = (size_t)NP + (size_t)sb * 64, kv0 = (size_t)NP + (size_t)sb * SKVS;
                    u.Q = SBQ + m0 * 2048 + sh * 128; u.ldq = 2048; u.K = nullptr; u.Kr = nullptr; u.V = nullptr; u.split = PAST / 64;
                    u.Kf0 = args.in[4] + ((size_t)(l * 8 + sb) * PAST) * 2048 + sh * 128; u.Vf0 = args.in[5] + ((size_t)(l * 8 + sb) * PAST) * 2048 + sh * 128;
                    u.Kf1 = OUT + O_SBK_S + ((size_t)l * NS + (size_t)sb * 64) * 2048 + sh * 128; u.Vf1 = OUT + O_SBV_S + ((size_t)l * NS + (size_t)sb * 64) * 2048 + sh * 128;
                    u.O = MERGED + m0 * 4096 + 2048 + sh * 128; u.ldo = 4096; u.ssq = SSQP + m0 * 32 + 16 + sh; u.P0 = PAST; u.NT = 17; u.nact = 2; }
                if constexpr ((PHMASK >> 13) & 1) att::attn_unit<false>(u, al);
            }
        }
        GRID_BAR();
#if !ATT_SSQ_ATOMICS
        {
            PHASE_PTRS(); (void)OUT;
            for (int i = gthread; i < MTOK * 2; i += nthreads) { const int m = i >> 1, half = i & 1; const GAS f32x4* p = (const GAS f32x4*)(SSQP + (size_t)m * 32 + half * 16);
                const f32x4 a = p[0], b = p[1], c = p[2], d = p[3];
                const float s = (((a.x + a.y) + (a.z + a.w)) + ((b.x + b.y) + (b.z + b.w))) + (((c.x + c.y) + (c.z + c.w)) + ((d.x + d.y) + (d.z + d.w)));
                (half ? SSQS : SSQM)[m] = s; }
        }
        GRID_BAR();
#endif
        for (int rep_ = 0; rep_ < (((PROBE_MASK >> 7) & 1) ? 2 : 1); ++rep_) if constexpr ((PHMASK >> 7) & 1) {
            PHASE_PTRS(); (void)OUT;
            pg8::Gemm g{MERGED, WO_T, MTOK, DM, DM, SLAB}; pg8::TailSplitOrder S; S.init2(MTOK, DM, DM, G_, bx_, SLAB, 2);
            pg8::EpiResP<true> E{args.in[0], args.in[1], nullptr, XN, SSQH, SSQM, SSQS, EPS, l == 0 ? nullptr : Y0B};
            pg8::gemm_phase<pg8::EpiResP<true>, pg8::TailSplitOrder, true, true>(F.lds + RING_OFF, g, S, E);
        }
        GRID_BAR();
        {
            PHASE_PTRS(); pg8::TailSplitOrder S; S.init2(MTOK, DM, DM, G_, bx_, SLAB, 2);
            tail_reduce_res<true>(S, args.in[0], args.in[1], nullptr, XN, SSQH, SSQM, SSQS, l == 0 ? nullptr : Y0B, ptid_);
        }
        GRID_BAR();
        for (int rep_ = 0; rep_ < (((PROBE_MASK >> 9) & 1) ? 2 : 1); ++rep_) if constexpr ((PHMASK >> 9) & 1) {
            PHASE_PTRS(); (void)OUT;
            pg8::Gemm g{XN, WUP_T, MTOK, DFF, DM, nullptr}; pg8::StaticOrder S; S.init(MTOK, DFF, G_, bx_);
            pg8::EpiRelu2N E{UB, DFF, SSQH, EPS};
            pg8::gemm_phase<pg8::EpiRelu2N, pg8::StaticOrder, true, true>(F.lds + RING_OFF, g, S, E);
            if (l + 1 < 2 && G_ == 256 && bx_ >= 128) {
                LAS float* scr = (LAS float*)(F.lds + RING_OFF + WAVE * 16384);
                CONVERT_ITEMS(l + 1, 0, EARLY_ITEMS, (bx_ - 128) * NWAVES + WAVE, 128 * NWAVES);
            }
        }
        GRID_BAR();
        for (int rep_ = 0; rep_ < (((PROBE_MASK >> 10) & 1) ? 2 : 1); ++rep_) if constexpr ((PHMASK >> 10) & 1) {
            PHASE_PTRS(); (void)OUT;
            pg8::Gemm g{UB, l == 0 ? WDN_T0 : WDN_T1, MTOK, DM, DFF, SLAB, 1};     pg8::PanelOrder S; S.init3(MTOK, DM, DFF, G_, bx_, SLAB);
            pg8::EpiResP<false> E{nullptr, nullptr, OUT + O_Y, XN, SSQY, nullptr, nullptr, EPS, l == 1 ? nullptr : Y0B};
            const bool bg = (l + 1 < 2 && G_ == 256);
            const int rsplit = bg ? ((bx_ & 7) >> 1) : 0;
#pragma unroll 1
            for (int seg = 0; seg < 2; ++seg) {
                pg8::SubRange<pg8::PanelOrder> SS{S, seg ? rsplit : 0, seg ? (1 << 30) : rsplit};
                pg8::gemm_phase<pg8::EpiResP<false>, pg8::SubRange<pg8::PanelOrder>, true, true>(F.lds + RING_OFF, g, SS, E);
                if (seg == 0 && bg) {
                    LAS float* scr = (LAS float*)(F.lds + RING_OFF + WAVE * 16384);
                    CONVERT_ITEMS(l + 1, EARLY_ITEMS, NITEMS, gw, NGW);
                    __syncthreads();
                }
            }
        }
        GRID_BAR();
        {
            PHASE_PTRS(); pg8::PanelOrder S; S.init3(MTOK, DM, DFF, G_, bx_, SLAB);
            tail_reduce_res<false>(S, nullptr, nullptr, OUT + O_Y, XN, SSQY, nullptr, nullptr, l == 1 ? nullptr : Y0B, ptid_);
            if (l + 1 < 2) {
                cache_rows_to_bf16(args.in[2] + (size_t)(l + 1) * 8 * PAST * KVLORA, AKV, KVLORA, gthread, nthreads);
                cache_rows_to_bf16(args.in[3] + (size_t)(l + 1) * 8 * PAST * ROPE, KROPE, ROPE, gthread, nthreads);
            }
        }
        GRID_BAR();
    }
#undef GRID_BAR
}

extern "C" void kernel_launch(void* const* d_in, const int* in_sizes, int n_in, void* d_out, int out_size, void* d_ws, size_t ws_size, hipStream_t stream) {
    static int grid = 0;
    if (grid == 0) {
        if (n_in != 22 || (size_t)out_size != O_END || ws_size < WS_END) { fprintf(stderr, "kernel_launch: unexpected shapes: n_in %d out %d ws %zu (need %zu)\n", n_in, out_size, ws_size, (size_t)WS_END); grid = -1; return; }
        int dev = 0, cus = 0, per_cu = 0;
        if (hipGetDevice(&dev) != hipSuccess || hipDeviceGetAttribute(&cus, hipDeviceAttributeMultiprocessorCount, dev) != hipSuccess) { grid = -1; return; }
        if (hipFuncSetAttribute((const void*)hymba_fwd, hipFuncAttributeMaxDynamicSharedMemorySize, LDS_BYTES) != hipSuccess) { fprintf(stderr, "kernel_launch: hipFuncSetAttribute failed\n"); grid = -1; return; }
        if (hipOccupancyMaxActiveBlocksPerMultiprocessor(&per_cu, (const void*)hymba_fwd, NWAVES * 64, LDS_BYTES) != hipSuccess || per_cu < 1) { fprintf(stderr, "kernel_launch: occupancy query reports %d\n", per_cu); }
        (void)hipGetLastError();
        grid = cus;
        if (grid != 256) fprintf(stderr, "kernel_launch: %d CUs (the attention deal assumes 256 workgroups)\n", grid);
    }
    if (grid < 0) return;
    if (hipMemsetAsync((char*)d_ws + WS_CTL, 0, CTL_ZERO_BYTES, stream) != hipSuccess) return;
    Args a{};
    for (int i = 0; i < 22; ++i) a.in[i] = (const float*)d_in[i];
    a.out = (float*)d_out; a.ws = (unsigned char*)d_ws;
    hipLaunchKernelGGL(hymba_fwd, dim3(grid), dim3(NWAVES * 64), LDS_BYTES, stream, a);
}
```

```cpp
#include <hip/hip_runtime.h>
#include <cstdio>
#include <cstdint>
#include <type_traits>
namespace pg8 {
#define PG8_LAS __attribute__((address_space(3)))
typedef unsigned short bf16_t;
typedef short bf16x8 __attribute__((ext_vector_type(8)));
typedef float f32x4 __attribute__((ext_vector_type(4)));
typedef unsigned u32x4 __attribute__((ext_vector_type(4)));
constexpr int BM = 256, BK = 64, HALF = 128, HTB = HALF * BK * 2  , STAGE_BYTES = 8 * HTB, NXCD = 8, WGM = 8;

__host__ __device__ __forceinline__ int lds_byte(int r, int c) { const int st = (r >> 4) * 2 + (c >> 5), rr = r & 15, cc = c & 31, ob = rr * 64 + cc * 2; return st * 1024 + (ob ^ (((ob >> 9) & 1) << 5)); }
__host__ __device__ __forceinline__ void stage_rc(int b, int& R, int& C) { const int st = b / 1024, sb = b % 1024, swz = sb ^ (((sb >> 9) & 1) << 5); R = (st >> 1) * 16 + swz / 64; C = (st & 1) * 32 + (swz % 64) / 2; }
__host__ __device__ __forceinline__ int perm32(int rho) { const int n = rho >> 4, i = rho & 15; return 8 * (i >> 2) + 4 * n + (i & 3); }

struct Unit { int pm, pn, kt0, nkt, part; };
struct Gemm { const bf16_t* A; const bf16_t* Bt; int M, N, K; float* slab; int blocked = 0; };

struct StaticOrder {
    int nM, nN, nwg, G, c, wgm = WGM;
    __host__ __device__ __forceinline__ void init(int M, int N, int G_, int c_) { nM = M / BM; nN = N / BM; nwg = nM * nN; G = G_; c = c_; }
    __host__ __device__ __forceinline__ bool next(int i, Unit& u) const {
        const long L = (long)i * G + c; if (L >= nwg) return false;
        int wgid = (int)L; { const int q = nwg / NXCD, r = nwg % NXCD, xcd = wgid % NXCD, off = wgid / NXCD; wgid = (xcd < r ? xcd * (q + 1) : r * (q + 1) + (xcd - r) * q) + off; }
        const int nig = wgm * nN, gid = wgid / nig, fm = gid * wgm, gsz = (nM - fm) < wgm ? (nM - fm) : wgm;
        u.pm = fm + ((wgid % nig) % gsz); u.pn = (wgid % nig) / gsz; u.kt0 = 0; u.nkt = 0; u.part = -1; return true;
    }
    __host__ __device__ __forceinline__ void map(int L, Unit& u) const {
        int wgid = L; { const int q = nwg / NXCD, r = nwg % NXCD, xcd = wgid % NXCD, off = wgid / NXCD; wgid = (xcd < r ? xcd * (q + 1) : r * (q + 1) + (xcd - r) * q) + off; }
        const int nig = wgm * nN, gid = wgid / nig, fm = gid * wgm, gsz = (nM - fm) < wgm ? (nM - fm) : wgm;
        u.pm = fm + ((wgid % nig) % gsz); u.pn = (wgid % nig) / gsz; u.kt0 = 0; u.nkt = 0; u.part = -1;
    }
    __device__ __forceinline__ void a_ready(const Unit&) const {}
    __device__ __forceinline__ void done(const Unit&) const {}
};

template <class S_> struct SubRange {
    const S_& s; int lo, hi;
    __device__ __forceinline__ bool next(int i, Unit& u) const { return (lo + i < hi) && s.next(lo + i, u); }
    __device__ __forceinline__ void a_ready(const Unit& u) const { s.a_ready(u); }
    __device__ __forceinline__ void done(const Unit& u) const { s.done(u); }
};

__device__ __forceinline__ unsigned cvt_pk_bf16(float lo, float hi) { unsigned r; asm volatile("v_cvt_pk_bf16_f32 %0, %1, %2" : "=v"(r) : "v"(lo), "v"(hi)); return r; }

struct TailSplitOrder : StaticOrder {
    int nfull, nsplit, nkt_full, halves; float* slab;
    __host__ __device__ __forceinline__ void init2(int M, int N, int K, int G_, int c_, float* slab_, int halves_ = 1) { init(M, N, G_, c_); nkt_full = K / BK; slab = slab_; halves = halves_; nfull = nwg / G; const int rem = nwg - nfull * G;
        nsplit = (rem > 0 && G % rem == 0 && (nkt_full % (2 * (G / rem))) == 0 && nkt_full / (G / rem) >= 4) ? G / rem : 1; }
    __host__ __device__ __forceinline__ bool next(int i, Unit& u) const {
        const int ii = i / halves, hh = i % halves;
        if (ii < nfull || nsplit == 1) { if (!StaticOrder::next(ii, u)) return false; if (halves == 2) { u.nkt = nkt_full / 2; u.kt0 = hh * u.nkt; u.part = hh == 0 ? -2 : -1; } return true; }
        if (ii > nfull || hh != 0) return false;
        const int j = c / nsplit, s = c % nsplit; map(nfull * G + j, u); u.nkt = nkt_full / nsplit; u.kt0 = s * u.nkt; u.part = j * nsplit + s; return true;
    }
};

struct PanelOrder : TailSplitOrder {
    bool panel;
    __host__ __device__ __forceinline__ void init3(int M, int N, int K, int G_, int c_, float* slab_, int halves_ = 1) { init2(M, N, K, G_, c_, slab_, halves_); panel = (G_ == 256 && nM == 66 && nN == 16 && nsplit == 8); }
    __host__ __device__ __forceinline__ void mapu(int L, Unit& u) const {
        if (L < 1024) { const int r = L >> 8, x = L & 7, idx = (L & 255) >> 3; u.pm = 16 * r + 4 * (x >> 1) + (idx & 3); u.pn = 8 * (x & 1) + (idx >> 2); }
        else { const int j = L - 1024; u.pm = 64 + (j & 1); u.pn = j >> 1; }
        u.kt0 = 0; u.nkt = 0; u.part = -1; }
    __host__ __device__ __forceinline__ bool next(int i, Unit& u) const {
        if (!panel) return TailSplitOrder::next(i, u);
        const int ii = i / halves, hh = i % halves;
        if (ii < nfull) { mapu(ii * G + c, u); if (halves == 2) { u.nkt = nkt_full / 2; u.kt0 = hh * u.nkt; u.part = hh == 0 ? -2 : -1; } return true; }
        if (ii > nfull || hh != 0) return false;
        const int j = c / nsplit, s = c % nsplit; mapu(nfull * G + j, u); u.nkt = nkt_full / nsplit; u.kt0 = s * u.nkt; u.part = j * nsplit + s; return true; }
    __host__ __device__ __forceinline__ void map(int L, Unit& u) const { if (panel) mapu(L, u); else TailSplitOrder::map(L, u); }
};

typedef unsigned u32x2 __attribute__((ext_vector_type(2)));
constexpr int HY_NP = 16384;
__device__ __forceinline__ int hy_kvrow(int m) { return m < HY_NP ? m : HY_NP + ((m - HY_NP) >> 6) * 1088 + 1024 + ((m - HY_NP) & 63); }

struct EpiIn {
    static constexpr bool PERM = true, AFTER_DRAIN = false;
    float* LAT; bf16_t* SBQ; bf16_t* SBK; bf16_t* SBV; float* outK_p; float* outV_p; float* outK_s; float* outV_s; float qscale;
    const float* ssq; float eps;
    __device__ __forceinline__ void operator()(const f32x4 (&acc)[2][2][4][2], const Unit& u, int wr, int wc, int fr, int fq) const {
        const int row0 = u.pm * BM + wr * 64 + fr, colw = wc * 32 + 8 * fq, pn = u.pn;
        float rs[2][4];
#pragma unroll
        for (int ai = 0; ai < 2; ++ai)
#pragma unroll
            for (int m = 0; m < 4; ++m) rs[ai][m] = ssq ? 1.0f / sqrtf(__hip_atomic_load(ssq + row0 + ai * HALF + m * 16, __ATOMIC_RELAXED, __HIP_MEMORY_SCOPE_AGENT) * (1.f / 4096.f) + eps) : 1.0f;
        if (pn < 7) {
#pragma unroll
            for (int ai = 0; ai < 2; ++ai)
#pragma unroll
                for (int m = 0; m < 4; ++m) { float* rp = LAT + (size_t)(row0 + ai * HALF + m * 16) * 1792 + pn * BM + colw;
#pragma unroll
                    for (int bj = 0; bj < 2; ++bj) { *(f32x4*)(rp + bj * HALF) = acc[ai][bj][m][0] * rs[ai][m]; *(f32x4*)(rp + bj * HALF + 4) = acc[ai][bj][m][1] * rs[ai][m]; } }
        } else if (pn < 15) {
#pragma unroll
            for (int ai = 0; ai < 2; ++ai)
#pragma unroll
                for (int m = 0; m < 4; ++m) { bf16_t* rp = SBQ + (size_t)(row0 + ai * HALF + m * 16) * 2048 + (pn - 7) * BM + colw;
#pragma unroll
                    for (int bj = 0; bj < 2; ++bj) { const float sc = qscale * rs[ai][m]; const f32x4 v0 = acc[ai][bj][m][0] * sc, v1 = acc[ai][bj][m][1] * sc;
                        u32x4 w; w.x = cvt_pk_bf16(v0[0], v0[1]); w.y = cvt_pk_bf16(v0[2], v0[3]); w.z = cvt_pk_bf16(v1[0], v1[1]); w.w = cvt_pk_bf16(v1[2], v1[3]);
                        *(u32x4*)(rp + bj * HALF) = w; } }
        } else {
            const bool isv = pn >= 23; const int c0 = (pn - (isv ? 23 : 15)) * BM + colw;
            float* fop = isv ? outV_p : outK_p; float* fos = isv ? outV_s : outK_s;
#pragma unroll
            for (int ai = 0; ai < 2; ++ai)
#pragma unroll
                for (int m = 0; m < 4; ++m) { const int row = row0 + ai * HALF + m * 16;
                    float* fo = (row < HY_NP) ? fop + (size_t)row * 2048 : fos + (size_t)(row - HY_NP) * 2048;
                    fo += c0;
#pragma unroll
                    for (int bj = 0; bj < 2; ++bj) { __builtin_nontemporal_store(acc[ai][bj][m][0] * rs[ai][m], (f32x4*)(fo + bj * HALF)); __builtin_nontemporal_store(acc[ai][bj][m][1] * rs[ai][m], (f32x4*)(fo + bj * HALF + 4)); } }
        }
    }
};
struct EpiF32 {
    static constexpr bool PERM = false, AFTER_DRAIN = false;
    float* C; int ldc;
    __device__ __forceinline__ void operator()(const f32x4 (&acc)[2][2][4][2], const Unit& u, int wr, int wc, int fr, int fq) const {
        const int row0 = u.pm * BM + wr * 64 + fr, col0 = u.pn * BM + wc * 32 + 4 * fq;
#pragma unroll
        for (int ai = 0; ai < 2; ++ai)
#pragma unroll
            for (int m = 0; m < 4; ++m) { float* rowp = C + (size_t)(row0 + ai * HALF + m * 16) * ldc + col0;
#pragma unroll
                for (int bj = 0; bj < 2; ++bj)
#pragma unroll
                    for (int n = 0; n < 2; ++n) *(f32x4*)(rowp + bj * HALF + n * 16) = acc[ai][bj][m][n]; }
    }
};
struct EpiKvb {
    static constexpr bool PERM = true, AFTER_DRAIN = false;
    float* KNRAW; bf16_t* VB;
    __device__ __forceinline__ void operator()(const f32x4 (&acc)[2][2][4][2], const Unit& u, int wr, int wc, int fr, int fq) const {
        const int row0 = u.pm * BM + wr * 64 + fr, colw = wc * 32 + 8 * fq, pn = u.pn;
        if (pn < 8) {
#pragma unroll
            for (int ai = 0; ai < 2; ++ai)
#pragma unroll
                for (int m = 0; m < 4; ++m) { float* rp = KNRAW + (size_t)(row0 + ai * HALF + m * 16) * 2048 + pn * BM + colw;
#pragma unroll
                    for (int bj = 0; bj < 2; ++bj) { *(f32x4*)(rp + bj * HALF) = acc[ai][bj][m][0]; *(f32x4*)(rp + bj * HALF + 4) = acc[ai][bj][m][1]; } }
        } else {
#pragma unroll
            for (int ai = 0; ai < 2; ++ai)
#pragma unroll
                for (int m = 0; m < 4; ++m) { bf16_t* rp = VB + (size_t)(row0 + ai * HALF + m * 16) * 2048 + (pn - 8) * BM + colw;
#pragma unroll
                    for (int bj = 0; bj < 2; ++bj) { const f32x4 v0 = acc[ai][bj][m][0], v1 = acc[ai][bj][m][1];
                        u32x4 w; w.x = cvt_pk_bf16(v0[0], v0[1]); w.y = cvt_pk_bf16(v0[2], v0[3]); w.z = cvt_pk_bf16(v1[0], v1[1]); w.w = cvt_pk_bf16(v1[2], v1[3]);
                        *(u32x4*)(rp + bj * HALF) = w; } }
        }
    }
};
struct EpiRes {
    static constexpr bool PERM = false, AFTER_DRAIN = false;
    const float* resP; const float* resS; float* out;
    __device__ __forceinline__ void operator()(const f32x4 (&acc)[2][2][4][2], const Unit& u, int wr, int wc, int fr, int fq) const {
        const int row0 = u.pm * BM + wr * 64 + fr, col0 = u.pn * BM + wc * 32 + 4 * fq;
        const bool samp = u.pm >= HY_NP / BM;
#pragma unroll
        for (int ai = 0; ai < 2; ++ai)
#pragma unroll
            for (int m = 0; m < 4; ++m) { const int row = row0 + ai * HALF + m * 16;
                const float* rp = samp ? resS + (size_t)(row - HY_NP) * 4096 + col0 : resP + (size_t)row * 4096 + col0;
                float* op = out + (size_t)row * 4096 + col0;
#pragma unroll
                for (int bj = 0; bj < 2; ++bj)
#pragma unroll
                    for (int n = 0; n < 2; ++n) { const f32x4 r = *(const f32x4*)(rp + bj * HALF + n * 16); *(f32x4*)(op + bj * HALF + n * 16) = r + acc[ai][bj][m][n]; } }
    }
};
struct EpiRelu2 {
    static constexpr bool PERM = true, AFTER_DRAIN = false;
    bf16_t* O; int ldc;
    __device__ __forceinline__ void operator()(const f32x4 (&acc)[2][2][4][2], const Unit& u, int wr, int wc, int fr, int fq) const {
        const int row0 = u.pm * BM + wr * 64 + fr, col0 = u.pn * BM + wc * 32 + 8 * fq;
#pragma unroll
        for (int ai = 0; ai < 2; ++ai)
#pragma unroll
            for (int m = 0; m < 4; ++m) { bf16_t* rowp = O + (size_t)(row0 + ai * HALF + m * 16) * ldc + col0;
#pragma unroll
                for (int bj = 0; bj < 2; ++bj) { f32x4 v0 = acc[ai][bj][m][0], v1 = acc[ai][bj][m][1];
#pragma unroll
                    for (int e = 0; e < 4; ++e) { const float a = fmaxf(v0[e], 0.f), b = fmaxf(v1[e], 0.f); v0[e] = a * a; v1[e] = b * b; }
                    u32x4 w; w.x = cvt_pk_bf16(v0[0], v0[1]); w.y = cvt_pk_bf16(v0[2], v0[3]); w.z = cvt_pk_bf16(v1[0], v1[1]); w.w = cvt_pk_bf16(v1[2], v1[3]);
                    *(u32x4*)(rowp + bj * HALF) = w; } }
    }
};

typedef float f32x2e __attribute__((ext_vector_type(2)));
__device__ __forceinline__ void head_ssq_exchange(const f32x4 (&acc)[2][2][4][2], PG8_LAS float* P, int wr, int wc, int fr, int fq, float (&rstd)[2][4][2], float inv_n, float eps) {
#pragma unroll
    for (int ai = 0; ai < 2; ++ai)
#pragma unroll
        for (int m = 0; m < 4; ++m)
#pragma unroll
            for (int bj = 0; bj < 2; ++bj) {
                const f32x4 a = acc[ai][bj][m][0], b = acc[ai][bj][m][1];
                float s = ((a[0] * a[0] + a[1] * a[1]) + (a[2] * a[2] + a[3] * a[3])) + ((b[0] * b[0] + b[1] * b[1]) + (b[2] * b[2] + b[3] * b[3]));
                s += __shfl_xor(s, 16); s += __shfl_xor(s, 32);
                if (fq == 0) P[(ai * HALF + wr * 64 + m * 16 + fr) * 8 + bj * 4 + wc] = s;
            }
    asm volatile("s_waitcnt lgkmcnt(0)" ::: "memory"); __builtin_amdgcn_s_barrier(); asm volatile("" ::: "memory");
#pragma unroll
    for (int ai = 0; ai < 2; ++ai)
#pragma unroll
        for (int m = 0; m < 4; ++m)
#pragma unroll
            for (int bj = 0; bj < 2; ++bj) {
                const f32x4 p = *(const PG8_LAS f32x4*)(P + (ai * HALF + wr * 64 + m * 16 + fr) * 8 + bj * 4);
                rstd[ai][m][bj] = 1.0f / sqrtf(((p[0] + p[1]) + (p[2] + p[3])) * inv_n + eps);
            }
}
struct EpiQb {
    static constexpr bool PERM = true, AFTER_DRAIN = false;
    bf16_t* QB; const float* g_nope; const float* g_rope; const f32x2e* tab; PG8_LAS float* P; float qs, eps;
    __device__ __forceinline__ void operator()(const f32x4 (&acc)[2][2][4][2], const Unit& u, int wr, int wc, int fr, int fq) const {
        const int row0 = u.pm * BM + wr * 64 + fr, pn = u.pn;
        if (pn < 8) {
            float rstd[2][4][2]; head_ssq_exchange(acc, P, wr, wc, fr, fq, rstd, 1.f / 128.f, eps);
            const f32x4 g0 = *(const f32x4*)(g_nope + wc * 32 + 8 * fq) * qs, g1 = *(const f32x4*)(g_nope + wc * 32 + 8 * fq + 4) * qs;
#pragma unroll
            for (int ai = 0; ai < 2; ++ai)
#pragma unroll
                for (int m = 0; m < 4; ++m) { bf16_t* rp = QB + (size_t)(row0 + ai * HALF + m * 16) * 3072 + (2 * pn) * 192 + wc * 32 + 8 * fq;
#pragma unroll
                    for (int bj = 0; bj < 2; ++bj) { const float r = rstd[ai][m][bj]; const f32x4 v0 = acc[ai][bj][m][0] * g0 * r, v1 = acc[ai][bj][m][1] * g1 * r;
                        u32x4 w; w.x = cvt_pk_bf16(v0[0], v0[1]); w.y = cvt_pk_bf16(v0[2], v0[3]); w.z = cvt_pk_bf16(v1[0], v1[1]); w.w = cvt_pk_bf16(v1[2], v1[3]);
                        *(u32x4*)(rp + bj * 192) = w; } }
        } else {
            const int h = 4 * (pn - 8) + wc;
            const f32x4 ga0 = *(const f32x4*)(g_rope + 8 * fq), ga1 = *(const f32x4*)(g_rope + 8 * fq + 4), gb0 = *(const f32x4*)(g_rope + 32 + 8 * fq), gb1 = *(const f32x4*)(g_rope + 32 + 8 * fq + 4);
#pragma unroll
            for (int ai = 0; ai < 2; ++ai)
#pragma unroll
                for (int m = 0; m < 4; ++m) { const int row = row0 + ai * HALF + m * 16;
                    const f32x4 a0 = acc[ai][0][m][0], a1 = acc[ai][0][m][1], b0 = acc[ai][1][m][0], b1 = acc[ai][1][m][1];
                    float s = (((a0[0] * a0[0] + a0[1] * a0[1]) + (a0[2] * a0[2] + a0[3] * a0[3])) + ((a1[0] * a1[0] + a1[1] * a1[1]) + (a1[2] * a1[2] + a1[3] * a1[3])))
                            + (((b0[0] * b0[0] + b0[1] * b0[1]) + (b0[2] * b0[2] + b0[3] * b0[3])) + ((b1[0] * b1[0] + b1[1] * b1[1]) + (b1[2] * b1[2] + b1[3] * b1[3])));
                    s += __shfl_xor(s, 16); s += __shfl_xor(s, 32);
                    const float r = 1.0f / sqrtf(s * (1.f / 64.f) + eps);
                    const int pos = row < HY_NP ? (row & 4095) : 1024 + ((row - HY_NP) & 63);
                    const f32x4* tp = (const f32x4*)(tab + pos * 32 + 8 * fq);
                    const f32x4 t0 = tp[0], t1 = tp[1], t2 = tp[2], t3 = tp[3];
                    const f32x4 x10 = a0 * ga0 * r, x11 = a1 * ga1 * r, x20 = b0 * gb0 * r, x21 = b1 * gb1 * r;
                    const f32x4 c0 = {t0[0], t0[2], t1[0], t1[2]}, s0 = {t0[1], t0[3], t1[1], t1[3]}, c1 = {t2[0], t2[2], t3[0], t3[2]}, s1 = {t2[1], t2[3], t3[1], t3[3]};
                    const f32x4 o10 = (x10 * c0 - x20 * s0) * qs, o11 = (x11 * c1 - x21 * s1) * qs, o20 = (x10 * s0 + x20 * c0) * qs, o21 = (x11 * s1 + x21 * c1) * qs;
                    bf16_t* rp = QB + (size_t)row * 3072 + h * 192 + 128 + 8 * fq;
                    u32x4 w; w.x = cvt_pk_bf16(o10[0], o10[1]); w.y = cvt_pk_bf16(o10[2], o10[3]); w.z = cvt_pk_bf16(o11[0], o11[1]); w.w = cvt_pk_bf16(o11[2], o11[3]);
                    *(u32x4*)rp = w;
                    w.x = cvt_pk_bf16(o20[0], o20[1]); w.y = cvt_pk_bf16(o20[2], o20[3]); w.z = cvt_pk_bf16(o21[0], o21[1]); w.w = cvt_pk_bf16(o21[2], o21[3]);
                    *(u32x4*)(rp + 32) = w; }
        }
    }
};
struct EpiKvbN {
    static constexpr bool PERM = true, AFTER_DRAIN = false;
    bf16_t* KN; bf16_t* VB; const float* g_nope; PG8_LAS float* P; float eps;
    __device__ __forceinline__ void operator()(const f32x4 (&acc)[2][2][4][2], const Unit& u, int wr, int wc, int fr, int fq) const {
        const int row0 = u.pm * BM + wr * 64 + fr, colw = wc * 32 + 8 * fq, pn = u.pn;
        if (pn < 8) {
            float rstd[2][4][2]; head_ssq_exchange(acc, P, wr, wc, fr, fq, rstd, 1.f / 128.f, eps);
            const f32x4 g0 = *(const f32x4*)(g_nope + colw), g1 = *(const f32x4*)(g_nope + colw + 4);
#pragma unroll
            for (int ai = 0; ai < 2; ++ai)
#pragma unroll
                for (int m = 0; m < 4; ++m) { bf16_t* rp = KN + (size_t)(row0 + ai * HALF + m * 16) * 2048 + pn * BM + colw;
#pragma unroll
                    for (int bj = 0; bj < 2; ++bj) { const float r = rstd[ai][m][bj]; const f32x4 v0 = acc[ai][bj][m][0] * g0 * r, v1 = acc[ai][bj][m][1] * g1 * r;
                        u32x4 w; w.x = cvt_pk_bf16(v0[0], v0[1]); w.y = cvt_pk_bf16(v0[2], v0[3]); w.z = cvt_pk_bf16(v1[0], v1[1]); w.w = cvt_pk_bf16(v1[2], v1[3]);
                        *(u32x4*)(rp + bj * HALF) = w; } }
        } else {
#pragma unroll
            for (int ai = 0; ai < 2; ++ai)
#pragma unroll
                for (int m = 0; m < 4; ++m) { bf16_t* rp = VB + (size_t)(row0 + ai * HALF + m * 16) * 2048 + (pn - 8) * BM + colw;
#pragma unroll
                    for (int bj = 0; bj < 2; ++bj) { const f32x4 v0 = acc[ai][bj][m][0], v1 = acc[ai][bj][m][1];
                        u32x4 w; w.x = cvt_pk_bf16(v0[0], v0[1]); w.y = cvt_pk_bf16(v0[2], v0[3]); w.z = cvt_pk_bf16(v1[0], v1[1]); w.w = cvt_pk_bf16(v1[2], v1[3]);
                        *(u32x4*)(rp + bj * HALF) = w; } }
        }
    }
};

template <bool NORM> struct EpiResP {
    static constexpr bool PERM = true, AFTER_DRAIN = false, MIDK = NORM;
    const float* resP; const float* resS; float* out; bf16_t* HB; float* ssq; const float* ssqm; const float* ssqs; float eps;
    bf16_t* YB;
    __device__ __forceinline__ void mid(f32x4 (&acc)[2][2][4][2], const Unit& u, int wr, int wc, int fr, int fq) const {
        const int row0 = u.pm * BM + wr * 64 + fr;
#pragma unroll
        for (int ai = 0; ai < 2; ++ai)
#pragma unroll
            for (int m = 0; m < 4; ++m) { const int row = row0 + ai * HALF + m * 16;
                const float a = __hip_atomic_load(ssqm + row, __ATOMIC_RELAXED, __HIP_MEMORY_SCOPE_AGENT), b = __hip_atomic_load(ssqs + row, __ATOMIC_RELAXED, __HIP_MEMORY_SCOPE_AGENT);
                const float ratio = sqrtf((b * (1.f / 2048.f) + eps) / (a * (1.f / 2048.f) + eps));
#pragma unroll
                for (int bj = 0; bj < 2; ++bj) { acc[ai][bj][m][0] *= ratio; acc[ai][bj][m][1] *= ratio; } }
    }
    __device__ __forceinline__ void operator()(const f32x4 (&acc)[2][2][4][2], const Unit& u, int wr, int wc, int fr, int fq) const {
        const int row0 = u.pm * BM + wr * 64 + fr, col0 = u.pn * BM + wc * 32 + 8 * fq;
        const bool samp = u.pm >= HY_NP / BM;
#pragma unroll
        for (int ai = 0; ai < 2; ++ai)
#pragma unroll
            for (int m = 0; m < 4; ++m) { const int row = row0 + ai * HALF + m * 16;
                if (NORM) {
                    const float* rp = samp ? resS + (size_t)(row - HY_NP) * 4096 + col0 : resP + (size_t)row * 4096 + col0; float s = 0.f;
                    const bf16_t* yp = YB + (size_t)row * 4096 + col0;
                    const float rs = 1.0f / sqrtf(__hip_atomic_load(ssqs + row, __ATOMIC_RELAXED, __HIP_MEMORY_SCOPE_AGENT) * (1.f / 2048.f) + eps);
#pragma unroll
                    for (int bj = 0; bj < 2; ++bj) { f32x4 r0, r1;
                        if (YB) { const u32x4 h = *(const u32x4*)(yp + bj * HALF);
                            r0 = (f32x4){__uint_as_float(h.x << 16), __uint_as_float(h.x & 0xffff0000u), __uint_as_float(h.y << 16), __uint_as_float(h.y & 0xffff0000u)};
                            r1 = (f32x4){__uint_as_float(h.z << 16), __uint_as_float(h.z & 0xffff0000u), __uint_as_float(h.w << 16), __uint_as_float(h.w & 0xffff0000u)}; }
                        else { r0 = *(const f32x4*)(rp + bj * HALF); r1 = *(const f32x4*)(rp + bj * HALF + 4); }
                        const f32x4 v0 = r0 + acc[ai][bj][m][0] * rs, v1 = r1 + acc[ai][bj][m][1] * rs;
                        s += ((v0[0] * v0[0] + v0[1] * v0[1]) + (v0[2] * v0[2] + v0[3] * v0[3])) + ((v1[0] * v1[0] + v1[1] * v1[1]) + (v1[2] * v1[2] + v1[3] * v1[3]));
                        u32x4 w; w.x = cvt_pk_bf16(v0[0], v0[1]); w.y = cvt_pk_bf16(v0[2], v0[3]); w.z = cvt_pk_bf16(v1[0], v1[1]); w.w = cvt_pk_bf16(v1[2], v1[3]);
                        *(u32x4*)(HB + (size_t)row * 4096 + col0 + bj * HALF) = w; }
                    s += __shfl_xor(s, 16); s += __shfl_xor(s, 32);
                    if (fq == 0) __hip_atomic_fetch_add(ssq + row, s, __ATOMIC_RELAXED, __HIP_MEMORY_SCOPE_AGENT);
                } else {
                    const bf16_t* hp = HB + (size_t)row * 4096 + col0; float* op = out + (size_t)row * 4096 + col0; float s = 0.f;
#pragma unroll
                    for (int bj = 0; bj < 2; ++bj) { const u32x4 h = *(const u32x4*)(hp + bj * HALF);
                        const f32x4 r0 = {__uint_as_float(h.x << 16), __uint_as_float(h.x & 0xffff0000u), __uint_as_float(h.y << 16), __uint_as_float(h.y & 0xffff0000u)};
                        const f32x4 r1 = {__uint_as_float(h.z << 16), __uint_as_float(h.z & 0xffff0000u), __uint_as_float(h.w << 16), __uint_as_float(h.w & 0xffff0000u)};
                        const f32x4 y0 = r0 + acc[ai][bj][m][0], y1 = r1 + acc[ai][bj][m][1];
                        if (YB) { u32x4 w; w.x = cvt_pk_bf16(y0[0], y0[1]); w.y = cvt_pk_bf16(y0[2], y0[3]); w.z = cvt_pk_bf16(y1[0], y1[1]); w.w = cvt_pk_bf16(y1[2], y1[3]);
                                  *(u32x4*)(YB + (size_t)row * 4096 + col0 + bj * HALF) = w;
                                  s += ((y0[0] * y0[0] + y0[1] * y0[1]) + (y0[2] * y0[2] + y0[3] * y0[3])) + ((y1[0] * y1[0] + y1[1] * y1[1]) + (y1[2] * y1[2] + y1[3] * y1[3])); }
                        else { __builtin_nontemporal_store(y0, (f32x4*)(op + bj * HALF)); __builtin_nontemporal_store(y1, (f32x4*)(op + bj * HALF + 4)); } }
                    if (YB) { s += __shfl_xor(s, 16); s += __shfl_xor(s, 32);
                        if (fq == 0) __hip_atomic_fetch_add(ssq + row, s, __ATOMIC_RELAXED, __HIP_MEMORY_SCOPE_AGENT); }
                } }
    }
};
struct EpiRelu2N {
    static constexpr bool PERM = true, AFTER_DRAIN = false;
    bf16_t* O; int ldc; const float* ssq; float eps;
    __device__ __forceinline__ void operator()(const f32x4 (&acc)[2][2][4][2], const Unit& u, int wr, int wc, int fr, int fq) const {
        const int row0 = u.pm * BM + wr * 64 + fr;
        bf16_t* const tile0 = O + ((size_t)u.pm * (ldc >> 6) + u.pn * 4 + (wc >> 1)) * 16384 + (wc & 1) * 32 + 8 * fq;
#pragma unroll
        for (int ai = 0; ai < 2; ++ai)
#pragma unroll
            for (int m = 0; m < 4; ++m) { const int row = row0 + ai * HALF + m * 16; bf16_t* rowp = tile0 + (wr * 64 + fr + ai * HALF + m * 16) * 64;
                const float r = 1.0f / sqrtf(__hip_atomic_load(ssq + row, __ATOMIC_RELAXED, __HIP_MEMORY_SCOPE_AGENT) * (1.f / 4096.f) + eps);
#pragma unroll
                for (int bj = 0; bj < 2; ++bj) { f32x4 v0 = acc[ai][bj][m][0], v1 = acc[ai][bj][m][1];
#pragma unroll
                    for (int e = 0; e < 4; ++e) { const float a = fmaxf(v0[e], 0.f) * r, b = fmaxf(v1[e], 0.f) * r; v0[e] = a * a; v1[e] = b * b; }
                    u32x4 w; w.x = cvt_pk_bf16(v0[0], v0[1]); w.y = cvt_pk_bf16(v0[2], v0[3]); w.z = cvt_pk_bf16(v1[0], v1[1]); w.w = cvt_pk_bf16(v1[2], v1[3]);
                    *(u32x4*)(rowp + bj * 2 * 16384) = w; } }
    }
};
template <class T, class = void> struct has_midk { static constexpr bool value = false; };
template <class T> struct has_midk<T, typename std::enable_if<T::MIDK>::type> { static constexpr bool value = true; };
template <class Epi, class Sched, bool ALIGN_EPI = false, bool SP2 = false>
__device__ __forceinline__ void gemm_phase(PG8_LAS unsigned char* lds, const Gemm g, const Sched& S, const Epi& E) {
    int tid_o = threadIdx.x; asm volatile("" : "+v"(tid_o));
    const int tid = tid_o, wid = __builtin_amdgcn_readfirstlane(tid >> 6), lane = tid & 63, wr = wid >> 2, wc = wid & 3, fr = lane & 15, fq = lane >> 4;
    const int nt = g.K / BK, K = g.blocked ? BK : g.K;
    unsigned voffA[2], voffB[2];
#pragma unroll
    for (int i = 0; i < 2; ++i) { int R, C; stage_rc(tid * 16 + i * 8192, R, C); const int Rb = Epi::PERM ? ((R & ~31) + perm32(R & 31)) : R;
        voffA[i] = (unsigned)(R * K + C) * 2u; voffB[i] = (unsigned)(Rb * K + C) * 2u; }
    const size_t kstep = g.blocked ? (size_t)(BM * BK * 2) : (size_t)(BK * 2);
    const size_t hstep = (size_t)HALF * K * 2;
    const size_t tstep = (size_t)BM * g.K * 2;
    const unsigned ldsw = (unsigned)wid * 1024u;
    const int aoff = lds_byte(wr * 64 + fr, fq * 8), boff = lds_byte(wc * 32 + fr, fq * 8);
#define PG8_SA(b, h) (((b) * 2 + (h)) * HTB)
#define PG8_SB(b, h) ((4 + (b) * 2 + (h)) * HTB)
#define PG8_STAGE(bufoff, gbase, voff) do { _Pragma("unroll") for (int _i = 0; _i < 2; ++_i) \
        __builtin_amdgcn_global_load_lds((const unsigned*)((const char*)(gbase) + (voff)[_i]), (PG8_LAS unsigned*)(lds + (bufoff) + ldsw + _i * 8192), 16, 0, 0); } while (0)
#define PG8_LDA(dst, b, h) do { _Pragma("unroll") for (int m = 0; m < 4; ++m) _Pragma("unroll") for (int k = 0; k < 2; ++k) dst[m][k] = *(const PG8_LAS bf16x8*)(lds + PG8_SA(b, h) + aoff + m * 2048 + k * 1024); } while (0)
#define PG8_LDB(dst, b, h) do { _Pragma("unroll") for (int n = 0; n < 2; ++n) _Pragma("unroll") for (int k = 0; k < 2; ++k) dst[n][k] = *(const PG8_LAS bf16x8*)(lds + PG8_SB(b, h) + boff + n * 2048 + k * 1024); } while (0)
#define PG8_MMA(ai, bj, At, Bt) do { __builtin_amdgcn_s_setprio(1); _Pragma("unroll") for (int m = 0; m < 4; ++m) _Pragma("unroll") for (int n = 0; n < 2; ++n) _Pragma("unroll") for (int k = 0; k < 2; ++k) \
        acc[ai][bj][m][n] = __builtin_amdgcn_mfma_f32_16x16x32_bf16(Bt[n][k], At[m][k], acc[ai][bj][m][n], 0, 0, 0); __builtin_amdgcn_s_setprio(0); } while (0)
#define PG8_WAIT_V(n) asm volatile("s_waitcnt vmcnt(" #n ")" ::: "memory")
#define PG8_WAIT_L(n) asm volatile("s_waitcnt lgkmcnt(" #n ")" ::: "memory")
#define PG8_BAR __builtin_amdgcn_s_barrier()
#define PG8_SCHED __builtin_amdgcn_sched_barrier(0)
    Unit cur, nxt; int ui = 0;
    if (!S.next(0, cur)) return;
    f32x4 acc[2][2][4][2];
#pragma unroll
    for (int a = 0; a < 2; ++a)
#pragma unroll
        for (int b = 0; b < 2; ++b)
#pragma unroll
            for (int m = 0; m < 4; ++m)
#pragma unroll
                for (int n = 0; n < 2; ++n) acc[a][b][m][n] = (f32x4){0.f, 0.f, 0.f, 0.f};
    bf16x8 At[4][2], B0[2][2], B1[2][2];
    const char* cA = (const char*)g.A + (size_t)cur.pm * tstep + (size_t)cur.kt0 * kstep; const char* cB = (const char*)g.Bt + (size_t)cur.pn * tstep + (size_t)cur.kt0 * kstep;
    int cnt = cur.nkt ? cur.nkt : nt;
    S.a_ready(cur);
    if constexpr (SP2) {
        PG8_STAGE(PG8_SB(0, 0), cB, voffB); PG8_STAGE(PG8_SB(0, 1), cB + hstep, voffB); PG8_STAGE(PG8_SA(0, 0), cA, voffA); PG8_STAGE(PG8_SA(0, 1), cA + hstep, voffA);
        if (wr == 1) PG8_BAR;
        PG8_WAIT_V(2); PG8_BAR;
        PG8_STAGE(PG8_SB(1, 0), cB + kstep, voffB); PG8_STAGE(PG8_SA(1, 0), cA + kstep, voffA); PG8_STAGE(PG8_SB(1, 1), cB + hstep + kstep, voffB);
        PG8_WAIT_V(6); PG8_BAR;
    } else {
        PG8_STAGE(PG8_SB(0, 0), cB, voffB); PG8_STAGE(PG8_SA(0, 0), cA, voffA); PG8_STAGE(PG8_SB(0, 1), cB + hstep, voffB); PG8_STAGE(PG8_SA(0, 1), cA + hstep, voffA);
        if (wr == 1) PG8_BAR;
        PG8_WAIT_V(4); PG8_BAR;
        PG8_STAGE(PG8_SB(1, 0), cB + kstep, voffB); PG8_STAGE(PG8_SA(1, 0), cA + kstep, voffA); PG8_STAGE(PG8_SB(1, 1), cB + hstep + kstep, voffB);
        PG8_WAIT_V(6); PG8_BAR;
    }
    for (;;) {
        const bool has_next = S.next(ui + 1, nxt);
        const char* nA = has_next ? (const char*)g.A + (size_t)nxt.pm * tstep + (size_t)nxt.kt0 * kstep : cA; const char* nB = has_next ? (const char*)g.Bt + (size_t)nxt.pn * tstep + (size_t)nxt.kt0 * kstep : cB;
        for (int t = 0; t < cnt; t += 2) {
            const bool last = (t == cnt - 2);
            const char* a1 = cA + (size_t)(t + 1) * kstep;
            const char* a2 = last ? nA : cA + (size_t)(t + 2) * kstep; const char* b2 = last ? nB : cB + (size_t)(t + 2) * kstep;
            const char* a3 = a2 + kstep; const char* b3 = b2 + kstep;
            if (last && has_next) S.a_ready(nxt);
            if constexpr (SP2) {
            PG8_LDB(B0, 0, 0); PG8_LDB(B1, 0, 1); PG8_SCHED; PG8_LDA(At, 0, 0); PG8_STAGE(PG8_SA(1, 1), a1 + hstep, voffA);
            PG8_WAIT_V(8); PG8_WAIT_L(0); PG8_BAR; PG8_MMA(0, 0, At, B0); PG8_MMA(0, 1, At, B1); PG8_BAR; PG8_SCHED;
            PG8_LDA(At, 0, 1); PG8_STAGE(PG8_SB(0, 0), b2, voffB); PG8_STAGE(PG8_SB(0, 1), b2 + hstep, voffB); PG8_STAGE(PG8_SA(0, 0), a2, voffA);
            PG8_WAIT_V(8); PG8_WAIT_L(0); PG8_BAR; PG8_MMA(1, 0, At, B0); PG8_MMA(1, 1, At, B1); PG8_BAR; PG8_SCHED;
            PG8_LDB(B0, 1, 0); PG8_LDB(B1, 1, 1); PG8_SCHED; PG8_LDA(At, 1, 0); PG8_STAGE(PG8_SA(0, 1), a2 + hstep, voffA);
            PG8_WAIT_V(8); PG8_WAIT_L(0); PG8_BAR; PG8_MMA(0, 0, At, B0); PG8_MMA(0, 1, At, B1); PG8_BAR; PG8_SCHED;
            PG8_LDA(At, 1, 1); PG8_STAGE(PG8_SB(1, 0), b3, voffB); PG8_STAGE(PG8_SB(1, 1), b3 + hstep, voffB); PG8_STAGE(PG8_SA(1, 0), a3, voffA);
            PG8_WAIT_V(8); PG8_WAIT_L(0); PG8_BAR; PG8_MMA(1, 0, At, B0); PG8_MMA(1, 1, At, B1); PG8_BAR; PG8_SCHED;
            } else {
            PG8_LDB(B0, 0, 0); PG8_SCHED; PG8_LDA(At, 0, 0); PG8_STAGE(PG8_SA(1, 1), a1 + hstep, voffA);
            PG8_WAIT_L(8); PG8_BAR; PG8_WAIT_L(0); PG8_MMA(0, 0, At, B0); PG8_BAR; PG8_SCHED;
            PG8_LDB(B1, 0, 1); PG8_STAGE(PG8_SB(0, 0), b2, voffB);
            PG8_BAR; PG8_WAIT_L(0); PG8_MMA(0, 1, At, B1); PG8_BAR;
            PG8_LDA(At, 0, 1); PG8_STAGE(PG8_SA(0, 0), a2, voffA);
            PG8_BAR; PG8_WAIT_L(0); PG8_MMA(1, 0, At, B0); PG8_BAR; PG8_SCHED;
            PG8_STAGE(PG8_SB(0, 1), b2 + hstep, voffB);
            PG8_WAIT_V(6); PG8_BAR; PG8_MMA(1, 1, At, B1); PG8_BAR;
            PG8_LDB(B0, 1, 0); PG8_SCHED; PG8_LDA(At, 1, 0); PG8_STAGE(PG8_SA(0, 1), a2 + hstep, voffA);
            PG8_WAIT_L(8); PG8_BAR; PG8_WAIT_L(0); PG8_MMA(0, 0, At, B0); PG8_BAR; PG8_SCHED;
            PG8_LDB(B1, 1, 1); PG8_STAGE(PG8_SB(1, 0), b3, voffB);
            PG8_BAR; PG8_WAIT_L(0); PG8_MMA(0, 1, At, B1); PG8_BAR;
            PG8_LDA(At, 1, 1); PG8_STAGE(PG8_SA(1, 0), a3, voffA);
            PG8_BAR; PG8_WAIT_L(0); PG8_MMA(1, 0, At, B0); PG8_BAR; PG8_SCHED;
            PG8_STAGE(PG8_SB(1, 1), b3 + hstep, voffB);
            PG8_WAIT_V(6); PG8_BAR; PG8_MMA(1, 1, At, B1); PG8_BAR;
            }
        }
        if constexpr (ALIGN_EPI) { if (wr == 0) PG8_BAR; }
        if constexpr (!Epi::AFTER_DRAIN) {
            if (cur.part == -2) { if constexpr (has_midk<Epi>::value) E.mid(acc, cur, wr, wc, fr, fq); }
            else if (cur.part >= 0) {
                f32x4* sp = (f32x4*)(g.slab + (size_t)cur.part * 65536) + (size_t)wid * 2048 + lane;
#pragma unroll
                for (int a = 0; a < 2; ++a)
#pragma unroll
                    for (int b = 0; b < 2; ++b)
#pragma unroll
                        for (int m = 0; m < 4; ++m)
#pragma unroll
                            for (int n = 0; n < 2; ++n) sp[(((a * 2 + b) * 4 + m) * 2 + n) * 64] = acc[a][b][m][n];
            } else E(acc, cur, wr, wc, fr, fq);
            S.done(cur); }
        if (!has_next) break;
        if (cur.part != -2) {
#pragma unroll
        for (int a = 0; a < 2; ++a)
#pragma unroll
            for (int b = 0; b < 2; ++b)
#pragma unroll
                for (int m = 0; m < 4; ++m)
#pragma unroll
                    for (int n = 0; n < 2; ++n) acc[a][b][m][n] = (f32x4){0.f, 0.f, 0.f, 0.f};
        }
        cur = nxt; cA = nA; cB = nB; ++ui; cnt = cur.nkt ? cur.nkt : nt;
        if constexpr (ALIGN_EPI) { if (wr == 1) PG8_BAR; }
    }
    PG8_WAIT_V(0);
    if constexpr (!ALIGN_EPI) { if (wr == 0) PG8_BAR; }
    PG8_BAR;
    if constexpr (Epi::AFTER_DRAIN) { E.fused(acc, cur, wr, wc, fr, fq, lds, wid, lane); S.done(cur); }
#undef PG8_SA
#undef PG8_SB
#undef PG8_STAGE
#undef PG8_LDA
#undef PG8_LDB
#undef PG8_MMA
#undef PG8_WAIT_V
#undef PG8_WAIT_L
#undef PG8_BAR
#undef PG8_SCHED
}
}
namespace att {
typedef short bf16x8 __attribute__((ext_vector_type(8)));
typedef short s16x4 __attribute__((ext_vector_type(4)));
typedef float f32x16 __attribute__((ext_vector_type(16)));
typedef unsigned u32x4 __attribute__((ext_vector_type(4)));
typedef float f32x4 __attribute__((ext_vector_type(4)));
typedef unsigned short bf16;
#define ALAS __attribute__((address_space(3)))
#ifndef ATT_SSQ_ATOMICS
#define ATT_SSQ_ATOMICS 0
#endif
constexpr int OFF_V = 0, OFF_K = 32768, OFF_R = 65536, OFF_WS = 81920, OFF_FLG = 81920 + 8 * 256, ATT_LDS_BYTES = OFF_FLG + 64;
constexpr float SB_DEAD = -150.f;
#define KSWZ(row, colB) ((row) * 256 + ((colB) ^ (((row) & 15) << 4)))
#define RSWZ(row, colB) ((row) * 128 + ((colB) ^ ((((row) >> 1) & 7) << 4)))
__device__ __forceinline__ int v_st(int k, int c) { const int kk = (k & ~0xC) | ((k & 4) << 1) | ((k & 8) >> 1); return ((kk >> 3) * 4 + (c >> 5)) * 512 + ((kk & 7) * 32 + (c & 31)) * 2; }
__device__ __forceinline__ int v_rd_base(int lane) { return ((lane & 3) << 3) | (((lane >> 2) & 3) << 6) | (((lane >> 4) & 1) << 5) | (((lane >> 5) & 1) << 8); }
__device__ __forceinline__ int crow(int r, int hi) { return (r & 3) + 8 * (r >> 2) + 4 * hi; }
__device__ __forceinline__ unsigned cvtpk(float lo, float hi) { unsigned r; asm volatile("v_cvt_pk_bf16_f32 %0, %1, %2" : "=v"(r) : "v"(lo), "v"(hi)); return r; }

struct Unit { const bf16* Q; int ldq; const bf16* K; const bf16* Kr; const bf16* V; bf16* O; int ldo; float* ssq; int P0; int NT; int nact;
              const float* Kf0; const float* Vf0; const float* Kf1; const float* Vf1; int split; };

__device__ __forceinline__ void qk128(f32x16& p0, f32x16& p1, ALAS const char* Kt, int r32, int hi, const bf16x8* qr) {
#pragma unroll
    for (int d0 = 0; d0 < 8; ++d0) { ALAS const char* a = Kt + KSWZ(r32, (d0 * 16 + hi * 8) * 2);
        const bf16x8 b0 = *(ALAS const bf16x8*)a; const bf16x8 b1 = *(ALAS const bf16x8*)(a + 32 * 256);
        p0 = __builtin_amdgcn_mfma_f32_32x32x16_bf16(b0, qr[d0], p0, 0, 0, 0);
        p1 = __builtin_amdgcn_mfma_f32_32x32x16_bf16(b1, qr[d0], p1, 0, 0, 0); }
}
__device__ __forceinline__ void qk64(f32x16& p0, f32x16& p1, ALAS const char* Kt, int r32, int hi, const bf16x8* qr) {
#pragma unroll
    for (int d0 = 0; d0 < 4; ++d0) { ALAS const char* a = Kt + RSWZ(r32, (d0 * 16 + hi * 8) * 2);
        const bf16x8 b0 = *(ALAS const bf16x8*)a; const bf16x8 b1 = *(ALAS const bf16x8*)(a + 32 * 128);
        p0 = __builtin_amdgcn_mfma_f32_32x32x16_bf16(b0, qr[d0], p0, 0, 0, 0);
        p1 = __builtin_amdgcn_mfma_f32_32x32x16_bf16(b1, qr[d0], p1, 0, 0, 0); }
}
__device__ __forceinline__ void pv_tile(f32x16* o, unsigned vb0, bf16x8 pa0, bf16x8 pa1, bf16x8 pa2, bf16x8 pa3) {
#define TRRD(dst, off) asm volatile("ds_read_b64_tr_b16 %0, %1 offset:%2" : "=&v"(dst) : "v"(vb0), "i"(off) : "memory")
#define PV_LD(S, d0) do { constexpr int b_ = (d0) * 512; \
        TRRD(S##l0, b_); TRRD(S##h0, b_ + 2048); TRRD(S##l1, b_ + 4096); TRRD(S##h1, b_ + 6144); TRRD(S##l2, b_ + 8192); TRRD(S##h2, b_ + 10240); TRRD(S##l3, b_ + 12288); TRRD(S##h3, b_ + 14336); } while (0)
#define PV_MM(S, d0) do { \
        o[d0] = __builtin_amdgcn_mfma_f32_32x32x16_bf16(pa0, (bf16x8){S##l0[0], S##l0[1], S##l0[2], S##l0[3], S##h0[0], S##h0[1], S##h0[2], S##h0[3]}, o[d0], 0, 0, 0); \
        o[d0] = __builtin_amdgcn_mfma_f32_32x32x16_bf16(pa1, (bf16x8){S##l1[0], S##l1[1], S##l1[2], S##l1[3], S##h1[0], S##h1[1], S##h1[2], S##h1[3]}, o[d0], 0, 0, 0); \
        o[d0] = __builtin_amdgcn_mfma_f32_32x32x16_bf16(pa2, (bf16x8){S##l2[0], S##l2[1], S##l2[2], S##l2[3], S##h2[0], S##h2[1], S##h2[2], S##h2[3]}, o[d0], 0, 0, 0); \
        o[d0] = __builtin_amdgcn_mfma_f32_32x32x16_bf16(pa3, (bf16x8){S##l3[0], S##l3[1], S##l3[2], S##l3[3], S##h3[0], S##h3[1], S##h3[2], S##h3[3]}, o[d0], 0, 0, 0); } while (0)
#define PV_WAIT(n) do { asm volatile("s_waitcnt lgkmcnt(" #n ")" ::: "memory"); __builtin_amdgcn_sched_barrier(0); } while (0)
    s16x4 Al0, Al1, Al2, Al3, Ah0, Ah1, Ah2, Ah3, Bl0, Bl1, Bl2, Bl3, Bh0, Bh1, Bh2, Bh3;
    PV_LD(A, 0); PV_LD(B, 1); PV_WAIT(8); PV_MM(A, 0);
    __builtin_amdgcn_sched_barrier(0); PV_LD(A, 2); PV_WAIT(8); PV_MM(B, 1);
    __builtin_amdgcn_sched_barrier(0); PV_LD(B, 3); PV_WAIT(8); PV_MM(A, 2);
    PV_WAIT(0); PV_MM(B, 3);
#undef PV_WAIT
#undef PV_MM
#undef PV_LD
#undef TRRD
}
#define PK4(P, B_, OUT) do { const unsigned a0_ = cvtpk(P[B_ + 0], P[B_ + 1]), a1_ = cvtpk(P[B_ + 2], P[B_ + 3]); \
        const unsigned b0_ = cvtpk(P[B_ + 4], P[B_ + 5]), b1_ = cvtpk(P[B_ + 6], P[B_ + 7]); \
        auto r0_ = __builtin_amdgcn_permlane32_swap(a0_, b0_, false, false); auto r1_ = __builtin_amdgcn_permlane32_swap(a1_, b1_, false, false); \
        u32x4 w_ = {r0_[0], r1_[0], r0_[1], r1_[1]}; OUT = __builtin_bit_cast(bf16x8, w_); } while (0)

__device__ __forceinline__ void store_o_staged(const f32x16* o, const float* rli, bf16* Ow, int ldo, ALAS char* stg, int lane, int r32, int hi, float* ssqp) {
    ALAS unsigned short* s16 = (ALAS unsigned short*)stg;
#pragma unroll
    for (int r = 0; r < 16; ++r) { const int orow = crow(r, hi);
#pragma unroll
        for (int d0 = 0; d0 < 4; ++d0) { const float v = o[d0][r] * rli[r]; s16[orow * 128 + d0 * 32 + r32] = (unsigned short)cvtpk(v, v); } }
    asm volatile("s_waitcnt lgkmcnt(0)" ::: "memory");
#pragma unroll
    for (int i = 0; i < 8; ++i) { const int idx = i * 64 + lane, row = idx >> 4, ch = idx & 15;
        const u32x4 w = *(ALAS const u32x4*)(stg + row * 256 + ch * 16);
        *(u32x4*)(Ow + (size_t)row * ldo + ch * 8) = w;
        float s = 0.f; { const unsigned ww[4] = {w.x, w.y, w.z, w.w};
#pragma unroll
            for (int e = 0; e < 4; ++e) { const float x0 = __uint_as_float(ww[e] << 16), x1 = __uint_as_float(ww[e] & 0xffff0000u); s += x0 * x0 + x1 * x1; } }
        s += __shfl_xor(s, 1); s += __shfl_xor(s, 2); s += __shfl_xor(s, 4); s += __shfl_xor(s, 8);
        if (ch == 0) ssqp[(size_t)row * 32] = s; }
}
template <bool MLA>
__device__ __forceinline__ void attn_unit(const Unit u, ALAS char* lds) {
    int tid_o = threadIdx.x; asm volatile("" : "+v"(tid_o));
    const int tid = tid_o, wid = __builtin_amdgcn_readfirstlane(tid >> 6), lane = tid & 63, r32 = lane & 31, hi = lane >> 5;
    const bool actw = wid < u.nact;
    const int sr = tid >> 4, sc = (tid & 15) * 8;
    const int vst0 = v_st(sr, sc), vst1 = v_st(32 + sr, sc), kws = KSWZ(sr, sc * 2);
    const int rk = tid >> 3, rc = (tid & 7) * 8, rws = RSWZ(rk, rc * 2);
    ALAS char* V_l = lds + OFF_V; ALAS char* K_l = lds + OFF_K; ALAS char* R_l = lds + OFF_R;
    ALAS float* al_l = (ALAS float*)(lds + OFF_WS) + wid * 64; ALAS float* li_l = al_l + 32;
    const unsigned vbase = (unsigned)(uintptr_t)V_l + (unsigned)v_rd_base(lane);
    constexpr int NQ = MLA ? 12 : 8;
    bf16x8 qr[NQ];
#pragma unroll
    for (int d0 = 0; d0 < NQ; ++d0) qr[d0] = (bf16x8){0, 0, 0, 0, 0, 0, 0, 0};
    if (actw) {
#pragma unroll
        for (int d0 = 0; d0 < NQ; ++d0) qr[d0] = *(const bf16x8*)(u.Q + (size_t)(wid * 32 + r32) * u.ldq + d0 * 16 + hi * 8);
    }
    const int cw = (u.P0 + wid * 32) >> 6;
    const int qpos = u.P0 + wid * 32 + r32;
    float m_reg = -1e30f, l_reg = 0.f, carry = 0.f; bool fin = false;
    ALAS unsigned* flg = (ALAS unsigned*)(lds + OFF_FLG);
    f32x16 o[4];
#pragma unroll
    for (int d = 0; d < 4; ++d)
#pragma unroll
        for (int r = 0; r < 16; ++r) o[d][r] = 0.f;
    bf16x8 st_k0, st_k1, st_v0, st_v1, st_r = (bf16x8){0, 0, 0, 0, 0, 0, 0, 0};
    f32x4 fk[4], fv[4];
#define LOADT(tt) do { if (!MLA) { const int t_ = (tt); const bool lo_ = t_ < u.split; const size_t ro_ = (size_t)(lo_ ? t_ : t_ - u.split) * 64 * 2048; \
            const float* kb_ = (lo_ ? u.Kf0 : u.Kf1) + ro_ + (size_t)sr * 2048 + sc; const float* vb_ = (lo_ ? u.Vf0 : u.Vf1) + ro_ + (size_t)sr * 2048 + sc; \
            fk[0] = *(const f32x4*)kb_; fk[1] = *(const f32x4*)(kb_ + 4); fk[2] = *(const f32x4*)(kb_ + 32 * 2048); fk[3] = *(const f32x4*)(kb_ + 32 * 2048 + 4); \
            fv[0] = *(const f32x4*)vb_; fv[1] = *(const f32x4*)(vb_ + 4); fv[2] = *(const f32x4*)(vb_ + 32 * 2048); fv[3] = *(const f32x4*)(vb_ + 32 * 2048 + 4); } else { \
        const size_t r0_ = (size_t)(tt) * 64; \
        st_k0 = *(const bf16x8*)(u.K + (r0_ + sr) * 2048 + sc); st_k1 = *(const bf16x8*)(u.K + (r0_ + 32 + sr) * 2048 + sc); \
        st_v0 = *(const bf16x8*)(u.V + (r0_ + sr) * 2048 + sc); st_v1 = *(const bf16x8*)(u.V + (r0_ + 32 + sr) * 2048 + sc); \
        if (MLA) st_r = *(const bf16x8*)(u.Kr + (r0_ + rk) * 64 + rc); } } while (0)
    LOADT(MLA ? 0 : (u.NT - 1));
    for (int i = 0; i < u.NT; ++i) {
        const int t = MLA ? i : (u.NT - 1 - i); const int buf = i & 1;
        if (!MLA) { u32x4 w_;
            w_ = (u32x4){cvtpk(fk[0][0], fk[0][1]), cvtpk(fk[0][2], fk[0][3]), cvtpk(fk[1][0], fk[1][1]), cvtpk(fk[1][2], fk[1][3])}; st_k0 = __builtin_bit_cast(bf16x8, w_);
            w_ = (u32x4){cvtpk(fk[2][0], fk[2][1]), cvtpk(fk[2][2], fk[2][3]), cvtpk(fk[3][0], fk[3][1]), cvtpk(fk[3][2], fk[3][3])}; st_k1 = __builtin_bit_cast(bf16x8, w_);
            w_ = (u32x4){cvtpk(fv[0][0], fv[0][1]), cvtpk(fv[0][2], fv[0][3]), cvtpk(fv[1][0], fv[1][1]), cvtpk(fv[1][2], fv[1][3])}; st_v0 = __builtin_bit_cast(bf16x8, w_);
            w_ = (u32x4){cvtpk(fv[2][0], fv[2][1]), cvtpk(fv[2][2], fv[2][3]), cvtpk(fv[3][0], fv[3][1]), cvtpk(fv[3][2], fv[3][3])}; st_v1 = __builtin_bit_cast(bf16x8, w_); }
        *(ALAS bf16x8*)(K_l + buf * 16384 + kws) = st_k0; *(ALAS bf16x8*)(K_l + buf * 16384 + kws + 32 * 256) = st_k1;
        *(ALAS bf16x8*)(V_l + buf * 16384 + vst0) = st_v0; *(ALAS bf16x8*)(V_l + buf * 16384 + vst1) = st_v1;
        if (MLA) *(ALAS bf16x8*)(R_l + buf * 8192 + rws) = st_r;
        if (!MLA) { if (lane == 0) flg[buf * 8 + wid] = (fin || !actw) ? 1u : 0u; }
        __syncthreads();
        if (!MLA) {
            const u32x4 fa = *(ALAS const u32x4*)(flg + buf * 8), fb = *(ALAS const u32x4*)(flg + buf * 8 + 4);
            if ((fa.x & fa.y & fa.z & fa.w & fb.x & fb.y & fb.z & fb.w) != 0u) break;
        }
        if (i + 1 < u.NT) LOADT(MLA ? (i + 1) : (u.NT - 2 - i));
        if (actw && t <= cw && !fin) {
            f32x16 p0, p1;
#pragma unroll
            for (int r = 0; r < 16; ++r) { p0[r] = 0.f; p1[r] = 0.f; }
            qk128(p0, p1, K_l + buf * 16384, r32, hi, qr);
            if (MLA) qk64(p0, p1, R_l + buf * 8192, r32, hi, qr + (MLA ? 8 : 0));
            bf16x8 pa0, pa1, pa2, pa3;
            if (MLA) {
                float pmax = p0[0];
#pragma unroll
                for (int r = 1; r < 16; ++r) pmax = fmaxf(pmax, p0[r]);
#pragma unroll
                for (int r = 0; r < 16; ++r) pmax = fmaxf(pmax, p1[r]);
                { auto rr = __builtin_amdgcn_permlane32_swap(__float_as_uint(pmax), __float_as_uint(pmax), false, false);
                  pmax = fmaxf(__uint_as_float(rr[0]), __uint_as_float(rr[1])); }
                const float mn = fmaxf(m_reg, pmax); const float alpha = __builtin_amdgcn_exp2f(m_reg - mn); m_reg = mn;
                float ps = 0.f;
#pragma unroll
                for (int r = 0; r < 16; ++r) { p0[r] = __builtin_amdgcn_exp2f(p0[r] - mn); ps += p0[r]; }
#pragma unroll
                for (int r = 0; r < 16; ++r) { p1[r] = __builtin_amdgcn_exp2f(p1[r] - mn); ps += p1[r]; }
                { auto rr = __builtin_amdgcn_permlane32_swap(__float_as_uint(ps), __float_as_uint(ps), false, false);
                  ps = __uint_as_float(rr[0]) + __uint_as_float(rr[1]); }
                l_reg = l_reg * alpha + ps;
                if (__any(alpha < 1.f)) {
                    if (hi == 0) al_l[r32] = alpha;
                    asm volatile("s_waitcnt lgkmcnt(0)" ::: "memory");
#pragma unroll
                    for (int r = 0; r < 16; ++r) { const float a = al_l[crow(r, hi)];
#pragma unroll
                        for (int d = 0; d < 4; ++d) o[d][r] *= a; }
                    asm volatile("s_waitcnt lgkmcnt(0)" ::: "memory");
                }
            } else {
                const bool diag = (t == cw); const int dq = qpos - 64 * t - 4 * hi; const float NEG = -__builtin_inff();
                float suf = carry;
#define SB_HALF(P, KOFF) do { f32x16 f_; \
                    _Pragma("unroll") for (int r = 0; r < 16; ++r) { const float y = P[r]; const float e = __builtin_amdgcn_exp2f(-fabsf(y)); const float l2 = __builtin_amdgcn_logf(1.f + e); \
                        const float lb = fminf(y, 0.f) - l2; P[r] = lb; f_[r] = lb - y; } \
                    if (diag) { _Pragma("unroll") for (int r = 0; r < 16; ++r) { const int c = (r & 3) + 8 * (r >> 2) + (KOFF); if (!(c < dq)) { P[r] = NEG; f_[r] = 0.f; } } } \
                    float tg_[4], pg_[4]; \
                    _Pragma("unroll") for (int g = 0; g < 4; ++g) { const float a = (f_[4 * g] + f_[4 * g + 1]) + (f_[4 * g + 2] + f_[4 * g + 3]); \
                        auto rr = __builtin_amdgcn_permlane32_swap(__float_as_uint(a), __float_as_uint(a), false, false); \
                        const float lo = __uint_as_float(rr[0]), hh = __uint_as_float(rr[1]); tg_[g] = lo + hh; pg_[g] = hi == 0 ? hh : 0.f; } \
                    _Pragma("unroll") for (int g = 3; g >= 0; --g) { const float base = suf + pg_[g]; \
                        const float s2 = f_[4 * g + 3], s1 = s2 + f_[4 * g + 2], s0 = s1 + f_[4 * g + 1]; \
                        P[4 * g + 3] = __builtin_amdgcn_exp2f(P[4 * g + 3] + base); P[4 * g + 2] = __builtin_amdgcn_exp2f(P[4 * g + 2] + (base + s2)); \
                        P[4 * g + 1] = __builtin_amdgcn_exp2f(P[4 * g + 1] + (base + s1)); P[4 * g] = __builtin_amdgcn_exp2f(P[4 * g] + (base + s0)); \
                        suf += tg_[g]; } } while (0)
                SB_HALF(p1, 32);
                PK4(p1, 0, pa2); PK4(p1, 8, pa3);
                SB_HALF(p0, 0);
                PK4(p0, 0, pa0); PK4(p0, 8, pa1);
#undef SB_HALF
                carry = suf;
                fin = __all(carry < SB_DEAD);
            }
            if (MLA) { PK4(p0, 0, pa0); PK4(p0, 8, pa1); PK4(p1, 0, pa2); PK4(p1, 8, pa3); }
            pv_tile(o, vbase + (unsigned)(buf * 16384), pa0, pa1, pa2, pa3);
        }
    }
    __syncthreads();
    if (actw) {
        float rli[16];
        if (MLA) {
            if (hi == 0) li_l[r32] = l_reg;
            asm volatile("s_waitcnt lgkmcnt(0)" ::: "memory");
#pragma unroll
            for (int r = 0; r < 16; ++r) rli[r] = 1.0f / li_l[crow(r, hi)];
        } else {
#pragma unroll
            for (int r = 0; r < 16; ++r) rli[r] = 1.0f;
        }
        store_o_staged(o, rli, u.O + (size_t)(wid * 32) * u.ldo, u.ldo, lds + wid * 8192, lane, r32, hi, u.ssq + (size_t)(wid * 32) * 32);
    }
    __syncthreads();
#undef LOADT
}

__device__ __forceinline__ void qk192_pipe(f32x16& p0, f32x16& p1, ALAS const char* Kt, ALAS const char* Rt, int r32, int hi, const bf16x8* qr, const f32x16* cinit = nullptr) {
    constexpr int PF = 2;
    bf16x8 fa[12], fb[12];
#define QK_ADDR(s) ((s) < 8 ? Kt + KSWZ(r32, ((s) * 16 + hi * 8) * 2) : Rt + RSWZ(r32, (((s) - 8) * 16 + hi * 8) * 2))
#define QK_LD(s) do { ALAS const char* a_ = QK_ADDR(s); fa[s] = *(ALAS const bf16x8*)a_; fb[s] = *(ALAS const bf16x8*)(a_ + ((s) < 8 ? 32 * 256 : 32 * 128)); } while (0)
#pragma unroll
    for (int s = 0; s < PF; ++s) QK_LD(s);
#pragma unroll
    for (int s = 0; s < 12; ++s) {
        if (s + PF < 12) QK_LD(s + PF);
        __builtin_amdgcn_sched_barrier(0);
        p0 = __builtin_amdgcn_mfma_f32_32x32x16_bf16(fa[s], qr[s], (s == 0 && cinit) ? *cinit : p0, 0, 0, 0);
        p1 = __builtin_amdgcn_mfma_f32_32x32x16_bf16(fb[s], qr[s], (s == 0 && cinit) ? *cinit : p1, 0, 0, 0);
        __builtin_amdgcn_sched_barrier(0);
    }
#undef QK_LD
#undef QK_ADDR
}
constexpr float MLA_THR = 8.f;
__device__ __forceinline__ void mla_softmax(f32x16& p0, f32x16& p1, float& m_reg, float& l_reg, f32x16* o, ALAS float* al_l, int r32, int hi, bf16x8& pa0, bf16x8& pa1, bf16x8& pa2, bf16x8& pa3) {
    float pmax = p0[0];
#pragma unroll
    for (int r = 1; r < 16; ++r) pmax = fmaxf(pmax, p0[r]);
#pragma unroll
    for (int r = 0; r < 16; ++r) pmax = fmaxf(pmax, p1[r]);
    { auto rr = __builtin_amdgcn_permlane32_swap(__float_as_uint(pmax), __float_as_uint(pmax), false, false);
      pmax = fmaxf(__uint_as_float(rr[0]), __uint_as_float(rr[1])); }
    float mn = m_reg, alpha = 1.f;
    if (!__all(pmax - m_reg <= MLA_THR)) { mn = fmaxf(m_reg, pmax); alpha = __builtin_amdgcn_exp2f(m_reg - mn); m_reg = mn; }
    float ps = 0.f;
#pragma unroll
    for (int r = 0; r < 16; ++r) { p0[r] = __builtin_amdgcn_exp2f(p0[r] - mn); ps += p0[r]; }
#pragma unroll
    for (int r = 0; r < 16; ++r) { p1[r] = __builtin_amdgcn_exp2f(p1[r] - mn); ps += p1[r]; }
    { auto rr = __builtin_amdgcn_permlane32_swap(__float_as_uint(ps), __float_as_uint(ps), false, false);
      ps = __uint_as_float(rr[0]) + __uint_as_float(rr[1]); }
    l_reg = l_reg * alpha + ps;
    if (__any(alpha < 1.f)) {
        if (hi == 0) al_l[r32] = alpha;
        asm volatile("s_waitcnt lgkmcnt(0)" ::: "memory");
#pragma unroll
        for (int r = 0; r < 16; ++r) { const float a = al_l[crow(r, hi)];
#pragma unroll
            for (int d = 0; d < 4; ++d) o[d][r] *= a; }
        asm volatile("s_waitcnt lgkmcnt(0)" ::: "memory");
    }
    PK4(p0, 0, pa0); PK4(p0, 8, pa1); PK4(p1, 0, pa2); PK4(p1, 8, pa3);
}
__device__ __forceinline__ void mla_softmax_rel(f32x16& p0, f32x16& p1, float& m_reg, f32x16& negm, bool first, float& l_reg, f32x16* o, ALAS float* al_l, int r32, int hi, bf16x8& pa0, bf16x8& pa1, bf16x8& pa2, bf16x8& pa3) {
    float pmax = p0[0];
#pragma unroll
    for (int r = 1; r < 16; ++r) pmax = fmaxf(pmax, p0[r]);
#pragma unroll
    for (int r = 0; r < 16; ++r) pmax = fmaxf(pmax, p1[r]);
    { auto rr = __builtin_amdgcn_permlane32_swap(__float_as_uint(pmax), __float_as_uint(pmax), false, false);
      pmax = fmaxf(__uint_as_float(rr[0]), __uint_as_float(rr[1])); }
    if (first || !__all(pmax <= MLA_THR)) {
        const float delta = first ? pmax : fmaxf(pmax, 0.f); const float alpha = first ? 1.f : __builtin_amdgcn_exp2f(-delta);
        m_reg += delta; l_reg *= alpha;
#pragma unroll
        for (int r = 0; r < 16; ++r) { p0[r] -= delta; p1[r] -= delta; negm[r] = -m_reg; }
        if (!first) {
            if (hi == 0) al_l[r32] = alpha;
            asm volatile("s_waitcnt lgkmcnt(0)" ::: "memory");
#pragma unroll
            for (int r = 0; r < 16; ++r) { const float a = al_l[crow(r, hi)];
#pragma unroll
                for (int d = 0; d < 4; ++d) o[d][r] *= a; }
            asm volatile("s_waitcnt lgkmcnt(0)" ::: "memory");
        }
    }
    float ps = 0.f;
#pragma unroll
    for (int r = 0; r < 16; ++r) { p0[r] = __builtin_amdgcn_exp2f(p0[r]); ps += p0[r]; }
#pragma unroll
    for (int r = 0; r < 16; ++r) { p1[r] = __builtin_amdgcn_exp2f(p1[r]); ps += p1[r]; }
    { auto rr = __builtin_amdgcn_permlane32_swap(__float_as_uint(ps), __float_as_uint(ps), false, false);
      ps = __uint_as_float(rr[0]) + __uint_as_float(rr[1]); }
    l_reg += ps;
    PK4(p0, 0, pa0); PK4(p0, 8, pa1); PK4(p1, 0, pa2); PK4(p1, 8, pa3);
}
constexpr int M_OFF_V = 0, M_OFF_K = 49152, M_OFF_R = 81920, M_OFF_WS = 98304, MLA_LDS_BYTES = 98304 + 8 * 256;
template <bool ROLEB, int VAR = 0> __device__ __forceinline__ void mla_body(const Unit u, ALAS char* lds) {
    int tid_o = threadIdx.x; asm volatile("" : "+v"(tid_o));
    const int tid = tid_o, wid = __builtin_amdgcn_readfirstlane(tid >> 6), lane = tid & 63, r32 = lane & 31, hi = lane >> 5;
    const bool actw = wid < u.nact; constexpr bool roleB = ROLEB;
    const int sr = tid >> 4, sc = (tid & 15) * 8;
    const int vst0 = v_st(sr, sc), vst1 = v_st(32 + sr, sc), kws = KSWZ(sr, sc * 2);
    const int rk = tid >> 3, rc = (tid & 7) * 8, rws = RSWZ(rk, rc * 2);
    ALAS char* V_l = lds + M_OFF_V; ALAS char* K_l = lds + M_OFF_K; ALAS char* R_l = lds + M_OFF_R;
    ALAS float* al_l = (ALAS float*)(lds + M_OFF_WS) + wid * 64; ALAS float* li_l = al_l + 32;
    const unsigned vbase = (unsigned)(uintptr_t)V_l + (unsigned)v_rd_base(lane);
    bf16x8 qr[12];
#pragma unroll
    for (int d0 = 0; d0 < 12; ++d0) qr[d0] = (bf16x8){0, 0, 0, 0, 0, 0, 0, 0};
    if (actw) {
#pragma unroll
        for (int d0 = 0; d0 < 12; ++d0) qr[d0] = *(const bf16x8*)(u.Q + (size_t)(wid * 32 + r32) * u.ldq + d0 * 16 + hi * 8);
    }
    const int cw = (u.P0 + wid * 32) >> 6;
    float m_reg = -1e30f, l_reg = 0.f;
    f32x16 o[4], p0, p1;
#pragma unroll
    for (int r = 0; r < 16; ++r) { p0[r] = 0.f; p1[r] = 0.f; }
#pragma unroll
    for (int d = 0; d < 4; ++d)
#pragma unroll
        for (int r = 0; r < 16; ++r) o[d][r] = 0.f;
    bf16x8 st_k0, st_k1, st_v0, st_v1, st_r;
#define LOADT(tt) do { const size_t r0_ = (size_t)(tt) * 64; \
        st_k0 = *(const bf16x8*)(u.K + (r0_ + sr) * 2048 + sc); st_k1 = *(const bf16x8*)(u.K + (r0_ + 32 + sr) * 2048 + sc); \
        st_v0 = *(const bf16x8*)(u.V + (r0_ + sr) * 2048 + sc); st_v1 = *(const bf16x8*)(u.V + (r0_ + 32 + sr) * 2048 + sc); \
        st_r = *(const bf16x8*)(u.Kr + (r0_ + rk) * 64 + rc); } while (0)
#define MLA_QK(kb) do { _Pragma("unroll") for (int r = 0; r < 16; ++r) { p0[r] = 0.f; p1[r] = 0.f; } \
        if (VAR == 4 || VAR == 0 || VAR == 5) qk192_pipe(p0, p1, K_l + (kb) * 16384, R_l + (kb) * 8192, r32, hi, qr); else if (VAR != 3) { qk128(p0, p1, K_l + (kb) * 16384, r32, hi, qr); qk64(p0, p1, R_l + (kb) * 8192, r32, hi, qr + 8); } } while (0)
#define MLA_SMPV(vs) do { bf16x8 pa0, pa1, pa2, pa3; \
        if (VAR == 1) { PK4(p0, 0, pa0); PK4(p0, 8, pa1); PK4(p1, 0, pa2); PK4(p1, 8, pa3); l_reg += p0[0]; } \
        else mla_softmax(p0, p1, m_reg, l_reg, o, al_l, r32, hi, pa0, pa1, pa2, pa3); \
        if (VAR != 2) pv_tile(o, vbase + (unsigned)((vs) * 16384), pa0, pa1, pa2, pa3); \
        else { _Pragma("unroll") for (int r = 0; r < 4; ++r) o[r][0] += __builtin_bit_cast(float, (unsigned)pa0[r] ^ (unsigned)pa1[r] ^ (unsigned)pa2[r] ^ (unsigned)pa3[r]); } } while (0)
    LOADT(0);
    int vs_cur = 0, vs_prev = 2;
    for (int i = 0; i <= u.NT; ++i) {
        const int kb = i & 1;
        if (i < u.NT && VAR != 5) {
            *(ALAS bf16x8*)(K_l + kb * 16384 + kws) = st_k0; *(ALAS bf16x8*)(K_l + kb * 16384 + kws + 32 * 256) = st_k1;
            *(ALAS bf16x8*)(V_l + vs_cur * 16384 + vst0) = st_v0; *(ALAS bf16x8*)(V_l + vs_cur * 16384 + vst1) = st_v1;
            *(ALAS bf16x8*)(R_l + kb * 8192 + rws) = st_r;
            __syncthreads();
            if (i + 1 < u.NT) LOADT(i + 1);
        }
        if (actw) {
            if constexpr (!roleB) { if (i < u.NT && i <= cw) { MLA_QK(kb); MLA_SMPV(vs_cur); } }
            else { if (i >= 1 && i - 1 <= cw) MLA_SMPV(vs_prev);
                   if (i < u.NT && i <= cw) MLA_QK(kb); }
        }
        vs_prev = vs_cur; vs_cur = (vs_cur == 2) ? 0 : vs_cur + 1;
    }
    if (actw) {
        if (hi == 0) li_l[r32] = l_reg;
        asm volatile("s_waitcnt lgkmcnt(0)" ::: "memory");
        float rli[16];
#pragma unroll
        for (int r = 0; r < 16; ++r) rli[r] = 1.0f / li_l[crow(r, hi)];
        bf16* Ow = u.O + (size_t)(wid * 32) * u.ldo;
#pragma unroll
        for (int r = 0; r < 16; ++r) { const int orow = crow(r, hi); float sq = 0.f;
#pragma unroll
            for (int d0 = 0; d0 < 4; ++d0) { const float v = o[d0][r] * rli[r]; const float vn = __shfl_xor(v, 1); sq += v * v;
                if ((r32 & 1) == 0) *(unsigned*)(Ow + (size_t)orow * u.ldo + d0 * 32 + r32) = cvtpk(v, vn); }
            sq += __shfl_xor(sq, 1); sq += __shfl_xor(sq, 2); sq += __shfl_xor(sq, 4); sq += __shfl_xor(sq, 8); sq += __shfl_xor(sq, 16);
            if (ATT_SSQ_ATOMICS && r32 == 0) __hip_atomic_fetch_add(u.ssq + wid * 32 + orow, sq, __ATOMIC_RELAXED, __HIP_MEMORY_SCOPE_AGENT); }
    }
    __syncthreads();
#undef LOADT
#undef MLA_QK
#undef MLA_SMPV
}
constexpr int D_OFF_K = 0, D_OFF_R = 49152, D_OFF_V = 73728, D_OFF_WS = 122880, DMA_LDS_BYTES = 122880 + 8 * 256;
template <int VAR = 0> __device__ __forceinline__ void mla_unit_dma(const Unit u, ALAS char* lds) {
    int tid_o = threadIdx.x; asm volatile("" : "+v"(tid_o));
    const int tid = tid_o, wid = __builtin_amdgcn_readfirstlane(tid >> 6), lane = tid & 63, r32 = lane & 31, hi = lane >> 5;
    const bool actw = wid < u.nact;
    if (false) __builtin_amdgcn_s_setprio(1);
    ALAS char* K_l = lds + D_OFF_K; ALAS char* R_l = lds + D_OFF_R; ALAS char* V_l = lds + D_OFF_V;
    ALAS float* al_l = (ALAS float*)(lds + D_OFF_WS) + wid * 64; ALAS float* li_l = al_l + 32;
    const unsigned vbase = (unsigned)(uintptr_t)V_l + (unsigned)v_rd_base(lane);
    unsigned offK[2], offV[2], offR;
#pragma unroll
    for (int j = 0; j < 2; ++j) {
        const int p = wid + 8 * j;
        { const int r = 4 * p + (lane >> 4), c = (lane & 15) ^ (r & 15); offK[j] = (unsigned)(r * 4096 + c * 16); }
        { const int sti = 2 * p + (lane >> 5), kk = (sti >> 2) * 8 + ((lane & 31) >> 2), k = (kk & ~0xC) | ((kk & 4) << 1) | ((kk & 8) >> 1), c = (sti & 3) * 32 + (lane & 3) * 8; offV[j] = (unsigned)(k * 4096 + c * 2); }
    }
    { const int r = 8 * wid + (lane >> 3), c = (lane & 7) ^ ((r >> 1) & 7); offR = (unsigned)(r * 128 + c * 16); }
    const char* gK = (const char*)u.K; const char* gV = (const char*)u.V; const char* gR = (const char*)u.Kr;
#define DMA_TILE(tt, slot) do { const size_t tb_ = (size_t)(tt) * 64; \
        __builtin_amdgcn_global_load_lds((const unsigned*)(gK + tb_ * 4096 + offK[0]), (ALAS unsigned*)(K_l + (slot) * 16384 + wid * 1024), 16, 0, 0); \
        __builtin_amdgcn_global_load_lds((const unsigned*)(gK + tb_ * 4096 + offK[1]), (ALAS unsigned*)(K_l + (slot) * 16384 + (wid + 8) * 1024), 16, 0, 0); \
        __builtin_amdgcn_global_load_lds((const unsigned*)(gR + tb_ * 128 + offR), (ALAS unsigned*)(R_l + (slot) * 8192 + wid * 1024), 16, 0, 0); \
        __builtin_amdgcn_global_load_lds((const unsigned*)(gV + tb_ * 4096 + offV[0]), (ALAS unsigned*)(V_l + (slot) * 16384 + wid * 1024), 16, 0, 0); \
        __builtin_amdgcn_global_load_lds((const unsigned*)(gV + tb_ * 4096 + offV[1]), (ALAS unsigned*)(V_l + (slot) * 16384 + (wid + 8) * 1024), 16, 0, 0); } while (0)
    bf16x8 qr[12];
#pragma unroll
    for (int d0 = 0; d0 < 12; ++d0) qr[d0] = (bf16x8){0, 0, 0, 0, 0, 0, 0, 0};
    if (actw) {
#pragma unroll
        for (int d0 = 0; d0 < 12; ++d0) qr[d0] = *(const bf16x8*)(u.Q + (size_t)(wid * 32 + r32) * u.ldq + d0 * 16 + hi * 8);
    }
#pragma unroll
    for (int d0 = 0; d0 < 12; ++d0) asm volatile("" : "+v"(qr[d0]));
    DMA_TILE(0, 0); if (u.NT > 1) DMA_TILE(1, 1);
    const int cw = (u.P0 + wid * 32) >> 6;
    float m_reg = 0.f, l_reg = 0.f;
    f32x16 o[4], p0, p1, negm;
#pragma unroll
    for (int r = 0; r < 16; ++r) negm[r] = 0.f;
#pragma unroll
    for (int d = 0; d < 4; ++d)
#pragma unroll
        for (int r = 0; r < 16; ++r) o[d][r] = 0.f;
    int sl = 0, sl2 = 2;
    for (int i = 0; i < u.NT; ++i) {
        if (i + 1 < u.NT) asm volatile("s_waitcnt vmcnt(5) lgkmcnt(0)" ::: "memory"); else asm volatile("s_waitcnt vmcnt(0) lgkmcnt(0)" ::: "memory");
        __builtin_amdgcn_s_barrier(); asm volatile("" ::: "memory");
        if (i + 2 < u.NT) DMA_TILE(i + 2, sl2);
        if (actw && i <= cw) {
            __builtin_amdgcn_s_setprio(1); qk192_pipe(p0, p1, K_l + sl * 16384, R_l + sl * 8192, r32, hi, qr, &negm); __builtin_amdgcn_s_setprio(0);
            bf16x8 pa0, pa1, pa2, pa3;
            mla_softmax_rel(p0, p1, m_reg, negm, i == 0, l_reg, o, al_l, r32, hi, pa0, pa1, pa2, pa3);
            __builtin_amdgcn_s_setprio(1); pv_tile(o, vbase + (unsigned)(sl * 16384), pa0, pa1, pa2, pa3); __builtin_amdgcn_s_setprio(0);
        }
        sl = (sl == 2) ? 0 : sl + 1; sl2 = (sl2 == 2) ? 0 : sl2 + 1;
    }
    asm volatile("s_waitcnt lgkmcnt(0)" ::: "memory"); __builtin_amdgcn_s_barrier(); asm volatile("" ::: "memory");
    if (actw) {
        if (hi == 0) li_l[r32] = l_reg;
        asm volatile("s_waitcnt lgkmcnt(0)" ::: "memory");
        float rli[16];
#pragma unroll
        for (int r = 0; r < 16; ++r) rli[r] = 1.0f / li_l[crow(r, hi)];
        store_o_staged(o, rli, u.O + (size_t)(wid * 32) * u.ldo, u.ldo, lds + wid * 8192, lane, r32, hi, u.ssq + (size_t)(wid * 32) * 32);
    }
    asm volatile("s_waitcnt lgkmcnt(0)" ::: "memory"); __builtin_amdgcn_s_barrier(); asm volatile("" ::: "memory");
    __builtin_amdgcn_s_setprio(0);
#undef DMA_TILE
}
template <int VAR = 0> __device__ __forceinline__ void mla_unit(const Unit u, ALAS char* lds) {
    int tid_o = threadIdx.x; asm volatile("" : "+v"(tid_o));
    if (__builtin_amdgcn_readfirstlane(tid_o >> 6) >= 4) mla_body<true, VAR>(u, lds); else mla_body<false, VAR>(u, lds);
}
#undef PK4
}
#define GAS __attribute__((address_space(1)))
#define LAS __attribute__((address_space(3)))
typedef unsigned short bf16;
typedef unsigned v4u __attribute__((ext_vector_type(4)));
typedef float f32x4 __attribute__((ext_vector_type(4)));
typedef short bf16x8 __attribute__((ext_vector_type(8)));
typedef GAS unsigned gu32;
typedef GAS unsigned long long gu64;
#define RLX_AGENT __ATOMIC_RELAXED, __HIP_MEMORY_SCOPE_AGENT
#define LDS_WAIT() asm volatile("s_waitcnt lgkmcnt(0)" ::: "memory")
#define VM_WAIT() asm volatile("s_waitcnt vmcnt(0)" ::: "memory")
__device__ __forceinline__ unsigned long long rt() { return __builtin_amdgcn_s_memrealtime(); }
__device__ __forceinline__ unsigned f2bf(float f) { unsigned u = __builtin_bit_cast(unsigned, f); return (u + 0x7fffu + ((u >> 16) & 1u)) >> 16; }
__device__ __forceinline__ unsigned pk2(float lo, float hi) { return f2bf(lo) | (f2bf(hi) << 16); }

#define XB_TMO      128
#define XB_XCNT(j)  (256  + 64 * (j))
#define XB_XSUB(j)  (1280 + 64 * (j))
#define XB_XGEN(j)  (2304 + 64 * (j))
#define XB_TOP      3328
#define XB_TOPGEN   3392
#define XCD_BAR_WORDS 3456
#define XB_SPIN_CAP (1u << 18)

__device__ __forceinline__ unsigned xb_ld(unsigned* p)              { return __hip_atomic_load(p, __ATOMIC_RELAXED, __HIP_MEMORY_SCOPE_AGENT); }
__device__ __forceinline__ unsigned xb_add(unsigned* p, unsigned v) { return __hip_atomic_fetch_add(p, v, __ATOMIC_RELAXED, __HIP_MEMORY_SCOPE_AGENT); }
__device__ __forceinline__ unsigned xb_xcc_id() { return (unsigned)__builtin_amdgcn_s_getreg((3 << 11) | 20) & 0xFu; }
#define XB_SPIN(cond, bar) do { unsigned _sp = 0; while (cond) { __builtin_amdgcn_s_sleep(1); \
    if ((++_sp & 255u) == 0u) { if (xb_ld(&(bar)[XB_TMO])) break; if (_sp > XB_SPIN_CAP) { atomicAdd(&(bar)[XB_TMO], 1u); break; } } } } while (0)

struct XcdBarrier {
    unsigned* bar; unsigned x;
    volatile LAS unsigned* st;
};

__device__ __forceinline__ XcdBarrier xcd_barrier_post(unsigned* bar, volatile LAS unsigned* st) {
    XcdBarrier b; b.bar = bar; b.x = xb_xcc_id(); b.st = st;
    if (threadIdx.x == 0) (void)xb_add(&bar[XB_XCNT(b.x)], 1u);
    return b;
}
__device__ __forceinline__ void xcd_barrier_complete(unsigned* bar, unsigned x, unsigned& nloc, unsigned& nx) {
    const unsigned G = gridDim.x * gridDim.y * gridDim.z;
    unsigned sum, cnt, mine, sp = 0u;
    for (;;) {
        sum = 0u; cnt = 0u; mine = 0u;
#pragma unroll
        for (unsigned j = 0; j < 16; ++j) { const unsigned c = xb_ld(&bar[XB_XCNT(j)]); sum += c; cnt += (c > 0u) ? 1u : 0u; mine = (j == x) ? c : mine; }
        if (sum == G) break;
        __builtin_amdgcn_s_sleep(1);
        if ((++sp & 255u) == 0u) { if (xb_ld(&bar[XB_TMO])) break; if (sp > XB_SPIN_CAP) { atomicAdd(&bar[XB_TMO], 1u); break; } }
    }
    nloc = mine > 0u ? mine : 1u; nx = cnt > 0u ? cnt : 1u;
}

__device__ __forceinline__ void xcd_barrier(const XcdBarrier& b) {
    asm volatile("s_waitcnt vmcnt(0)" ::: "memory");
    __syncthreads();
    if (threadIdx.x == 0) {
        unsigned* bar = b.bar;
        __builtin_amdgcn_s_waitcnt(0);
        unsigned nloc = b.st[0], nx = b.st[1];
        if (nloc == 0u) { xcd_barrier_complete(bar, b.x, nloc, nx); b.st[0] = nloc; b.st[1] = nx; }
        const unsigned old = xb_add(&bar[XB_XSUB(b.x)], 1u);
        const unsigned gen = old / nloc;
        if (old + 1u == (gen + 1u) * nloc) {
            __builtin_amdgcn_fence(__ATOMIC_RELEASE, "agent");
            asm volatile("s_waitcnt vmcnt(0)" ::: "memory");
            const unsigned og = xb_add(&bar[XB_TOP], 1u);
            const unsigned tg = og / nx;
            if (og + 1u == (tg + 1u) * nx) xb_add(&bar[XB_TOPGEN], 1u);
            else XB_SPIN(xb_ld(&bar[XB_TOPGEN]) == tg, bar);
            __builtin_amdgcn_fence(__ATOMIC_ACQUIRE, "agent");
            xb_add(&bar[XB_XGEN(b.x)], 1u);
            asm volatile("s_waitcnt vmcnt(0)" ::: "memory");
        } else {
            XB_SPIN(xb_ld(&bar[XB_XGEN(b.x)]) == gen, bar);
            __builtin_amdgcn_fence(__ATOMIC_ACQUIRE, "agent");
            asm volatile("s_waitcnt vmcnt(0)" ::: "memory");
        }
    }
    __syncthreads();
}
constexpr int NWAVES = 8;
constexpr int DM = 4096, NP = 16384, NS = 512, MTOK = NP + NS;
constexpr int SEQ = 4096, PAST = 1024, DSEQ = 64, SKVS = PAST + DSEQ;
constexpr int KVROWS = NP + 8 * SKVS;
constexpr int NINP = 7936;
constexpr int QLORA = 1024, KVLORA = 512, ROPE = 64, NOPE = 128, NH = 16, DFF = 16384;
constexpr float EPS = 1e-6f;
constexpr float LOG2E = 1.4426950408889634f;
constexpr float QS_MLA = 0.07216878364870322f * LOG2E;
constexpr float QS_SB = 0.08838834764831845f * LOG2E;

constexpr size_t O_Y = 0, O_CKV_P = 69206016, O_KR_P = 85983232, O_SBK_P = 88080384, O_SBV_P = 155189248,
                 O_CKV_S = 222298112, O_KR_S = 222822400, O_SBK_S = 222887936, O_SBV_S = 224985088, O_END = 227082240;

constexpr size_t MiB = 1u << 20;
constexpr size_t WS_CTL = 0, CTL_ZERO_BYTES = 1 * MiB;
constexpr size_t WS_SSQH = 512 * 1024;
constexpr size_t WS_TAB = 1 * MiB;
constexpr size_t WS_WIN = 2 * MiB;
constexpr size_t WS_WQB = 64 * MiB;
constexpr size_t WS_WKVB = 70 * MiB;
constexpr size_t WS_WO = 74 * MiB;
constexpr size_t WS_WUP = 106 * MiB;
constexpr size_t WS_WDN = 234 * MiB;
constexpr size_t WS_XN = 362 * MiB;
constexpr size_t WS_R = 494 * MiB;
constexpr size_t WS_U = WS_R;
constexpr size_t WS_QLAT = WS_R;
constexpr size_t WS_AKV = WS_QLAT + 33 * MiB;
constexpr size_t WS_KROPE = WS_AKV + 25 * MiB;
constexpr size_t WS_VB = WS_KROPE + 4 * MiB;
constexpr size_t WS_QB = WS_VB + 98 * MiB;
constexpr size_t WS_KN = WS_QB + 99 * MiB;
constexpr size_t WS_SBQ = WS_KN + 98 * MiB;
constexpr size_t WS_SBK = WS_SBQ + 66 * MiB;
constexpr size_t WS_SBV = WS_SBK + 98 * MiB;
constexpr size_t WS_R2 = WS_SBV + 98 * MiB;
constexpr size_t WS_LAT = WS_R2;
constexpr size_t WS_QRAW = WS_R2;
constexpr size_t WS_KNRAW = WS_R2 + 198 * MiB;
constexpr size_t WS_MLAO = WS_R2;
constexpr size_t WS_SBO = WS_R2 + 66 * MiB;
constexpr size_t WS_MERGED = WS_R2 + 132 * MiB;
constexpr size_t WS_SLAB = WS_R2;
constexpr size_t WS_Y0B = WS_R2 + 264 * MiB;
constexpr size_t WS_WDN1 = WS_R2 + 398 * MiB;
constexpr size_t WS_SSQP = WS_WDN1 + 128 * MiB;
constexpr size_t WS_END = WS_SSQP + 3 * MiB;
static_assert(WS_U + (size_t)MTOK * DFF * 2 <= WS_END, "U fits the overlay region");
static_assert(WS_XN + (size_t)MTOK * DM * 2 <= WS_R && WS_WDN + (size_t)DM * DFF * 2 <= WS_XN && WS_WIN + (size_t)NINP * DM * 2 <= WS_WQB, "ws map");
constexpr int CW_TMO = 0, CW_CODE = 1, CW_BAR = 4096;

constexpr int RING_OFF = 0, RING_BYTES = 131072;
constexpr int LDSCTL_OFF = RING_BYTES, MISC_OFF = LDSCTL_OFF + 320;
constexpr int XCH_OFF = LDSCTL_OFF + 1024;
constexpr int LDS_BYTES = 147456;
static_assert(XCH_OFF + 8192 <= LDS_BYTES, "LDS map");
static_assert(att::ATT_LDS_BYTES <= RING_BYTES && att::MLA_LDS_BYTES <= RING_BYTES && att::DMA_LDS_BYTES <= RING_BYTES, "attention scratch fits the ring region");

#if defined(__HIP_DEVICE_COMPILE__)
#define ASSUME_GLOBAL(p) do { __builtin_assume(!__builtin_amdgcn_is_shared((const __attribute__((address_space(0))) void*)(p))); __builtin_assume(!__builtin_amdgcn_is_private((const __attribute__((address_space(0))) void*)(p))); } while (0)
#else
#define ASSUME_GLOBAL(p) do { } while (0)
#endif
typedef float f32x2 __attribute__((ext_vector_type(2)));
__device__ __forceinline__ float wave_sum(float v) {
#pragma unroll
    for (int o = 1; o < 64; o <<= 1) v += __shfl_xor(v, o);
    return v;
}
__device__ __forceinline__ unsigned pkbf(float lo, float hi) { return pg8::cvt_pk_bf16(lo, hi); }
__device__ __forceinline__ float bf2f(unsigned short b) { return __uint_as_float(((unsigned)b) << 16); }
__device__ __forceinline__ int kvrow_of(int m) { return m < NP ? m : NP + ((m - NP) >> 6) * SKVS + PAST + ((m - NP) & 63); }
__device__ __forceinline__ int pos_of(int m) { return m < NP ? (m & (SEQ - 1)) : PAST + ((m - NP) & 63); }

__device__ __forceinline__ void sincos_acc(float ang, float& s, float& c) {
    const double a = (double)ang; const double q = rint(a * 0.63661977236758134308);
    double r = fma(-q, 1.57079632679489661923, a); r = fma(-q, 6.123233995736766e-17, r);
    const float rf = (float)r; const int qi = (int)q; const float r2 = rf * rf;
    const float sp = rf + rf * r2 * (-1.6666667163e-1f + r2 * (8.3333337680e-3f + r2 * (-1.9841270114e-4f + r2 * 2.7557314297e-6f)));
    const float cp = 1.f + r2 * (-0.5f + r2 * (4.1666667908e-2f + r2 * (-1.3888889225e-3f + r2 * (2.4801587642e-5f + r2 * (-2.7557314297e-7f)))));
    switch (qi & 3) { case 0: s = sp; c = cp; break; case 1: s = cp; c = -sp; break; case 2: s = -sp; c = -cp; break; default: s = -cp; c = sp; break; }
}

struct Frame {
    LAS unsigned char* lds; volatile LAS unsigned* MISC; gu32* ctl;
    int tid, lane, wave, vcu, G;
};
struct Args { const float* in[22]; float* out; unsigned char* ws; };

struct TItem { const float* src; bf16* dst; const float* gk; int N, K; };
__device__ __forceinline__ void ti_load(const TItem& P, float (&tv)[32], f32x4& g0, f32x4& g1, int lane) {
    if (P.gk) { g0 = *(const GAS f32x4*)(P.gk + 8 * (lane & 7)); g1 = *(const GAS f32x4*)(P.gk + 8 * (lane & 7) + 4); }
    else { g0 = f32x4{1.f, 1.f, 1.f, 1.f}; g1 = g0; }
    const GAS float* s = (const GAS float*)P.src + (size_t)(lane >> 5) * P.N + (lane & 31);
#pragma unroll
    for (int i = 0; i < 32; ++i) tv[i] = s[(size_t)(2 * i) * P.N];
}
__device__ __forceinline__ void ti_finish(const TItem& P, const float (&tv)[32], const f32x4 g0, const f32x4 g1, LAS float* scr, int lane) {
#pragma unroll
    for (int i = 0; i < 32; ++i) scr[(2 * i + (lane >> 5)) * 33 + (lane & 31)] = tv[i];
    LDS_WAIT(); asm volatile("" ::: "memory");
    const int c = lane & 7;
#pragma unroll
    for (int j = 0; j < 4; ++j) { const int n = (lane >> 3) + 8 * j; const LAS float* s = scr + (8 * c) * 33 + n;
        v4u o; o.x = pkbf(s[0 * 33] * g0.x, s[1 * 33] * g0.y); o.y = pkbf(s[2 * 33] * g0.z, s[3 * 33] * g0.w); o.z = pkbf(s[4 * 33] * g1.x, s[5 * 33] * g1.y); o.w = pkbf(s[6 * 33] * g1.z, s[7 * 33] * g1.w);
        *(GAS v4u*)(P.dst + (size_t)n * P.K + 8 * c) = o; }
    LDS_WAIT(); asm volatile("" ::: "memory");
}
__device__ __forceinline__ void rms_row_4096(const float* xrow, const float* g, bf16* orow, int lane) {
    const GAS f32x4* xr = (const GAS f32x4*)xrow + lane; const GAS f32x4* gr = (const GAS f32x4*)g + lane;
    f32x4 v[16]; float s = 0.f;
#pragma unroll
    for (int j = 0; j < 16; ++j) { v[j] = xr[64 * j]; s += (v[j].x * v[j].x + v[j].y * v[j].y) + (v[j].z * v[j].z + v[j].w * v[j].w); }
    const float rstd = 1.0f / sqrtf(wave_sum(s) * (1.f / 4096.f) + EPS);
    GAS unsigned long long* o8 = (GAS unsigned long long*)orow + lane;
#pragma unroll
    for (int j = 0; j < 16; ++j) { const f32x4 gg = gr[64 * j];
        o8[64 * j] = (unsigned long long)pkbf(v[j].x * rstd * gg.x, v[j].y * rstd * gg.y) | ((unsigned long long)pkbf(v[j].z * rstd * gg.z, v[j].w * rstd * gg.w) << 32); }
}
__device__ __forceinline__ void rms_row_4096_bf16(const bf16* xrow, const float* g, bf16* orow, int lane) {
    const GAS v4u* xr = (const GAS v4u*)xrow + lane; float x[64]; float s = 0.f;
#pragma unroll
    for (int j = 0; j < 8; ++j) { const v4u w = xr[64 * j]; const unsigned ww[4] = {w.x, w.y, w.z, w.w};
#pragma unroll
        for (int e = 0; e < 4; ++e) { x[8 * j + 2 * e] = __uint_as_float(ww[e] << 16); x[8 * j + 2 * e + 1] = __uint_as_float(ww[e] & 0xffff0000u); } }
#pragma unroll
    for (int i = 0; i < 64; ++i) s += x[i] * x[i];
    const float rstd = 1.0f / sqrtf(wave_sum(s) * (1.f / 4096.f) + EPS);
#pragma unroll
    for (int j = 0; j < 8; ++j) { const GAS f32x4* gp = (const GAS f32x4*)(g + 8 * (64 * j + lane)); const f32x4 g0 = gp[0], g1 = gp[1];
        v4u o; o.x = pkbf(x[8 * j] * rstd * g0.x, x[8 * j + 1] * rstd * g0.y); o.y = pkbf(x[8 * j + 2] * rstd * g0.z, x[8 * j + 3] * rstd * g0.w);
        o.z = pkbf(x[8 * j + 4] * rstd * g1.x, x[8 * j + 5] * rstd * g1.y); o.w = pkbf(x[8 * j + 6] * rstd * g1.z, x[8 * j + 7] * rstd * g1.w);
        *((GAS v4u*)orow + 64 * j + lane) = o; }
}
__device__ __forceinline__ void cache_rows_to_bf16(const float* src, bf16* dst, int W, int gthread, int nthreads) {
    const int per_row = W >> 2; const long total = (long)8 * PAST * per_row;
    for (long i = gthread; i < total; i += nthreads) {
        const int row = (int)(i / per_row), c4 = (int)(i % per_row), b = row >> 10, j = row & 1023;
        const f32x4 v = *(const GAS f32x4*)(src + (size_t)row * W + c4 * 4);
        *(GAS unsigned long long*)(dst + (size_t)(NP + b * SKVS + j) * W + c4 * 4) = (unsigned long long)pkbf(v.x, v.y) | ((unsigned long long)pkbf(v.z, v.w) << 32);
    }
}

template <bool NORM, class Order>
__device__ __forceinline__ void tail_reduce_res(const Order& S, const float* resP, const float* resS, float* out, bf16* HB, float* ssq, const float* ssqm, const float* ssqs, bf16* YB, int tid) {
    if (S.nsplit == 1) return;
    const int wid = __builtin_amdgcn_readfirstlane(tid >> 6), lane = tid & 63, wr = wid >> 2, wc = wid & 3, fr = lane & 15, fq = lane >> 4;
    const int j = S.c / S.nsplit, p = S.c % S.nsplit, per = 32 / S.nsplit;
    pg8::Unit u; S.map(S.nfull * S.G + j, u);
    for (int ii = 0; ii < per; ++ii) {
        const int idx = p * per + ii, a = idx >> 4, b = (idx >> 3) & 1, mm = (idx >> 1) & 3, n = idx & 1;
        const int row = u.pm * 256 + a * 128 + wr * 64 + mm * 16 + fr, col = u.pn * 256 + b * 128 + wc * 32 + 8 * fq + 4 * n;
        f32x4 s = {0.f, 0.f, 0.f, 0.f}, s2 = {0.f, 0.f, 0.f, 0.f};
        for (int sp = 0; sp < S.nsplit; ++sp) { const f32x4 v = *((const GAS f32x4*)(S.slab + (size_t)(j * S.nsplit + sp) * 65536) + (size_t)wid * 2048 + idx * 64 + lane); if (2 * sp < S.nsplit) s += v; else s2 += v; }
        if (NORM) {
            const float rm = 1.0f / sqrtf(__hip_atomic_load(ssqm + row, __ATOMIC_RELAXED, __HIP_MEMORY_SCOPE_AGENT) * (1.f / 2048.f) + EPS), rs = 1.0f / sqrtf(__hip_atomic_load(ssqs + row, __ATOMIC_RELAXED, __HIP_MEMORY_SCOPE_AGENT) * (1.f / 2048.f) + EPS);
            s = s * rm + s2 * rs; } else s += s2;
        f32x4 v;
        if (NORM) { if (YB) { const unsigned long long h = *(const GAS unsigned long long*)(YB + (size_t)row * DM + col); const unsigned h0 = (unsigned)h, h1 = (unsigned)(h >> 32);
                                v = (f32x4){__uint_as_float(h0 << 16), __uint_as_float(h0 & 0xffff0000u), __uint_as_float(h1 << 16), __uint_as_float(h1 & 0xffff0000u)} + s; }
                    else { const float* rp = (row >= NP) ? resS + (size_t)(row - NP) * DM + col : resP + (size_t)row * DM + col; v = *(const GAS f32x4*)rp + s; } }
        else { const unsigned long long h = *(const GAS unsigned long long*)(HB + (size_t)row * DM + col); const unsigned h0 = (unsigned)h, h1 = (unsigned)(h >> 32);
               v = (f32x4){__uint_as_float(h0 << 16), __uint_as_float(h0 & 0xffff0000u), __uint_as_float(h1 << 16), __uint_as_float(h1 & 0xffff0000u)} + s;
               if (YB) { *(GAS unsigned long long*)(YB + (size_t)row * DM + col) = (unsigned long long)pkbf(v.x, v.y) | ((unsigned long long)pkbf(v.z, v.w) << 32);
                         float q = (v.x * v.x + v.y * v.y) + (v.z * v.z + v.w * v.w); q += __shfl_xor(q, 16); q += __shfl_xor(q, 32);
                         if (fq == 0) __hip_atomic_fetch_add(ssq + row, q, __ATOMIC_RELAXED, __HIP_MEMORY_SCOPE_AGENT); }
               else *(GAS f32x4*)(out + (size_t)row * DM + col) = v; }
        if (NORM) {
            *(GAS unsigned long long*)(HB + (size_t)row * DM + col) = (unsigned long long)pkbf(v.x, v.y) | ((unsigned long long)pkbf(v.z, v.w) << 32);
            float q = (v.x * v.x + v.y * v.y) + (v.z * v.z + v.w * v.w); q += __shfl_xor(q, 16); q += __shfl_xor(q, 32);
            if (fq == 0) __hip_atomic_fetch_add(ssq + row, q, __ATOMIC_RELAXED, __HIP_MEMORY_SCOPE_AGENT);
        }
    }
}

__global__ void __launch_bounds__(NWAVES * 64, 2) hymba_fwd(Args args) {
    extern __shared__ __attribute__((aligned(16))) unsigned char lds[];
    Frame F;
    F.lds = (LAS unsigned char*)lds;
    F.MISC = (volatile LAS unsigned*)(F.lds + MISC_OFF);
    F.tid = threadIdx.x; F.lane = F.tid & 63; F.wave = __builtin_amdgcn_readfirstlane(F.tid >> 6);
    F.G = gridDim.x; { const int bx = blockIdx.x; F.vcu = (F.G % 8 == 0) ? (bx % 8) * (F.G / 8) + bx / 8 : bx; }
    unsigned char* ws = args.ws;
    F.ctl = (gu32*)(ws + WS_CTL);
    for (int u = F.tid; u < (LDS_BYTES - LDSCTL_OFF) / 4; u += NWAVES * 64) ((LAS unsigned*)(F.lds + LDSCTL_OFF))[u] = 0u;
    __syncthreads();
    XcdBarrier bar = xcd_barrier_post((unsigned*)(F.ctl + CW_BAR), F.MISC + 8);
#ifndef G5_WGM
#define G5_WGM 8
#endif
#ifndef PROBE_MASK
#define PROBE_MASK 0
#endif
#ifndef PROBE_BAR
#define PROBE_BAR 1
#endif
#ifndef PHMASK
#define PHMASK 0x3fff
#endif
#define GRID_BAR() do { for (int br_ = 0; br_ < PROBE_BAR; ++br_) xcd_barrier(bar); } while (0)
#define PHASE_PTRS() unsigned long long zoff_ = 0; asm volatile("" : "+s"(zoff_)); unsigned char* const wsb = args.ws + zoff_; float* const OUT = args.out + zoff_;     int ptid_ = threadIdx.x; asm volatile("" : "+v"(ptid_)); int bx_ = blockIdx.x, G_ = gridDim.x; asm volatile("" : "+s"(bx_), "+s"(G_)); const int VCU = (G_ % 8 == 0) ? (bx_ % 8) * (G_ / 8) + bx_ / 8 : bx_; (void)VCU; \
    const int LANE = ptid_ & 63, WAVE = __builtin_amdgcn_readfirstlane(ptid_ >> 6); const int gw = VCU * NWAVES + WAVE, NGW = G_ * NWAVES; const int gthread = gw * 64 + LANE, nthreads = NGW * 64; (void)gthread; (void)nthreads; (void)gw; (void)NGW; (void)LANE
#define WIN_T ((bf16*)(wsb + WS_WIN))
#define WQB_T ((bf16*)(wsb + WS_WQB))
#define WKVB_T ((bf16*)(wsb + WS_WKVB))
#define WO_T ((bf16*)(wsb + WS_WO))
#define WUP_T ((bf16*)(wsb + WS_WUP))
#define WDN_T0 ((bf16*)(wsb + WS_WDN))
#define WDN_T1 ((bf16*)(wsb + WS_WDN1))
#define XN ((bf16*)(wsb + WS_XN))
#define UB ((bf16*)(wsb + WS_U))
#define QLAT ((bf16*)(wsb + WS_QLAT))
#define AKV ((bf16*)(wsb + WS_AKV))
#define KROPE ((bf16*)(wsb + WS_KROPE))
#define VB ((bf16*)(wsb + WS_VB))
#define QB ((bf16*)(wsb + WS_QB))
#define KN ((bf16*)(wsb + WS_KN))
#define SBQ ((bf16*)(wsb + WS_SBQ))
#define SBK ((bf16*)(wsb + WS_SBK))
#define SBV ((bf16*)(wsb + WS_SBV))
#define LAT ((float*)(wsb + WS_LAT))
#define QRAW ((float*)(wsb + WS_QRAW))
#define KNRAW ((float*)(wsb + WS_KNRAW))
#define MLAO ((bf16*)(wsb + WS_MLAO))
#define SBO ((bf16*)(wsb + WS_SBO))
#define MERGED ((bf16*)(wsb + WS_MERGED))
#define TAB ((f32x2*)(wsb + WS_TAB))
#define SLAB ((float*)(wsb + WS_SLAB))
#define Y0B ((bf16*)(wsb + WS_Y0B))
#define SSQH ((float*)(wsb + WS_SSQH))
#define SSQM ((float*)(wsb + WS_SSQH + 128 * 1024))
#define SSQS ((float*)(wsb + WS_SSQH + 256 * 1024))
#define SSQP ((float*)(wsb + WS_SSQP))
#define SSQY ((float*)(wsb + WS_SSQH + 384 * 1024))

    { PHASE_PTRS(); (void)OUT;
    for (int i = gthread; i < SEQ * 32; i += nthreads) {
        const int pos = i >> 5, k = i & 31;
        const float inv_freq = exp2f(-(float)k * (13.287712379549449f / 32.f));
        float s, c; sincos_acc((float)pos * inv_freq, s, c); TAB[i] = (f32x2){c, s};
    } }

#define CONVERT_ITEMS(LW, R_LO, R_HI, GWV, NGWV) do { \
        const float* w_in = args.in[7] + (size_t)(LW) * DM * 7744; const float* w_qb = args.in[9] + (size_t)(LW) * QLORA * 3072; \
        const float* w_kvb = args.in[11] + (size_t)(LW) * KVLORA * 4096; const float* w_o = args.in[18] + (size_t)(LW) * DM * DM; \
        const float* w_up = args.in[20] + (size_t)(LW) * DM * DFF; const float* w_dn = args.in[21] + (size_t)(LW) * DFF * DM; const int lw_ = (LW); \
        auto dec_ = [&](int it) -> TItem { \
                int r = (R_HI) - 1 - it; \
                if (r < I_IN) { const int kb = r / 242, nb = r % 242, n0 = nb * 32; return TItem{w_in + (size_t)(kb * 64) * 7744 + n0, WIN_T + (size_t)(n0 + (n0 >= 1600 ? 192 : 0)) * DM + kb * 64, lw_ ? args.in[6] + (size_t)lw_ * DM + kb * 64 : nullptr, 7744, DM}; } r -= I_IN; \
                if (r < I_QB) { const int kb = r / 96, nb = r % 96, n0 = nb * 32, h = n0 / 192, dd = n0 % 192; \
                    return TItem{w_qb + (size_t)(kb * 64) * 3072 + n0, WQB_T + (size_t)(dd < 128 ? h * 128 + dd : 2048 + (h >> 2) * 256 + ((dd - 128) >> 5) * 128 + (h & 3) * 32) * QLORA + kb * 64, nullptr, 3072, QLORA}; } r -= I_QB; \
                if (r < I_KVB) { const int kb = r / 128, nb = r % 128, n0 = nb * 32, h = n0 >> 8, dd = n0 & 255; \
                    return TItem{w_kvb + (size_t)(kb * 64) * 4096 + n0, WKVB_T + (size_t)(dd < 128 ? h * 128 + dd : 2048 + h * 128 + (dd - 128)) * KVLORA + kb * 64, nullptr, 4096, KVLORA}; } r -= I_KVB; \
                if (r < I_O) { const int kb = r / 128, nb = r % 128; \
                    return TItem{w_o + (size_t)(kb * 64) * DM + nb * 32, WO_T + (size_t)(nb * 32) * DM + kb * 64, (kb < 32 ? args.in[16] + (size_t)lw_ * 2048 : args.in[17] + (size_t)lw_ * 2048 - 2048) + kb * 64, DM, DM}; } r -= I_O; \
                if (r < I_UP) { const int kb = r / 512, nb = r % 512; return TItem{w_up + (size_t)(kb * 64) * DFF + nb * 32, WUP_T + (size_t)(nb * 32) * DM + kb * 64, args.in[19] + (size_t)lw_ * DM + kb * 64, DFF, DM}; } r -= I_UP; \
                { const int kb = r / 128, nb = r % 128; return TItem{w_dn + (size_t)(kb * 64) * DM + nb * 32, (lw_ ? WDN_T1 : WDN_T0) + ((size_t)((nb >> 3) * 256 + kb) * 256 + (nb & 7) * 32) * 64, nullptr, DM, 64}; } }; \
        const int n_ = (R_HI) - (R_LO); int it = (GWV); \
        if (it < n_) { \
            float tA[32], tB[32]; f32x4 gA0, gA1, gB0, gB1; \
            TItem PA = dec_(it), PB; ti_load(PA, tA, gA0, gA1, LANE); \
            for (;;) {                                     \
                const int it1 = it + (NGWV); PB = dec_(it1 < n_ ? it1 : it); ti_load(PB, tB, gB0, gB1, LANE); \
                ti_finish(PA, tA, gA0, gA1, scr, LANE); \
                if (it1 >= n_) break; \
                const int it2 = it1 + (NGWV); PA = dec_(it2 < n_ ? it2 : it1); ti_load(PA, tA, gA0, gA1, LANE); \
                ti_finish(PB, tB, gB0, gB1, scr, LANE); \
                if (it2 >= n_) break; \
                it = it2; \
            } } } while (0)
    constexpr int I_IN = 64 * 242, I_QB = 16 * 96, I_KVB = 8 * 128, I_O = 64 * 128, I_UP = 64 * 512, I_DN = 256 * 128;
    constexpr int NITEMS = I_IN + I_QB + I_KVB + I_O + I_UP + I_DN, EARLY_ITEMS = I_IN + I_QB + I_KVB + I_O, EARLY0_ITEMS = I_IN + I_QB + I_KVB;
#pragma unroll 1
    for (int l = 0; l < 2; ++l) {
        if (l == 0 || gridDim.x != 256) {
        for (int rep_ = 0; rep_ < (((PROBE_MASK >> 0) & 1) ? 2 : 1); ++rep_) if constexpr ((PHMASK >> 0) & 1) {
            PHASE_PTRS(); (void)OUT;
            LAS float* scr = (LAS float*)(F.lds + RING_OFF + WAVE * 16384);
            const bool early_ok = (G_ == 256);
            CONVERT_ITEMS(l, (l > 0 && early_ok) ? NITEMS : 0, (l == 0 && early_ok) ? EARLY0_ITEMS : NITEMS, gw, NGW);
            if (l == 0) {
            { unsigned zz = 0u; asm volatile("" : "+v"(zz)); const v4u z4 = {zz, zz, zz, zz};
              for (int i = gthread; i < 192 * DM / 8; i += nthreads) *(GAS v4u*)(WIN_T + (size_t)1600 * DM + (size_t)i * 8) = z4; }
            cache_rows_to_bf16(args.in[2] + (size_t)l * 8 * PAST * KVLORA, AKV, KVLORA, gthread, nthreads);
            cache_rows_to_bf16(args.in[3] + (size_t)l * 8 * PAST * ROPE, KROPE, ROPE, gthread, nthreads);
            const float* g = args.in[6] + (size_t)l * DM;
            for (int m = gw; m < MTOK; m += NGW) rms_row_4096(m < NP ? args.in[0] + (size_t)m * DM : args.in[1] + (size_t)(m - NP) * DM, g, XN + (size_t)m * DM, LANE);
            }
        }
        GRID_BAR();
        }
        for (int rep_ = 0; rep_ < (((PROBE_MASK >> 1) & 1) ? 2 : 1); ++rep_) if constexpr ((PHMASK >> 1) & 1) {
            PHASE_PTRS(); (void)OUT;
            pg8::Gemm g{l == 0 ? XN : Y0B, WIN_T, MTOK, NINP, DM, nullptr}; pg8::StaticOrder S; S.init(MTOK, NINP, G_, bx_);
            pg8::EpiIn E{LAT, SBQ, SBK, SBV, OUT + O_SBK_P + (size_t)l * NP * 2048, OUT + O_SBV_P + (size_t)l * NP * 2048,
                         OUT + O_SBK_S + (size_t)l * NS * 2048, OUT + O_SBV_S + (size_t)l * NS * 2048, QS_SB, l == 0 ? nullptr : SSQY, EPS};
            const bool bg = (l == 0 && G_ == 256);
            const int rsplit = bg ? ((bx_ & 7) >> 1) : 0;
#pragma unroll 1
            for (int seg = 0; seg < 2; ++seg) {
                pg8::SubRange<pg8::StaticOrder> SS{S, seg ? rsplit : 0, seg ? (1 << 30) : rsplit};
                pg8::gemm_phase<pg8::EpiIn, pg8::SubRange<pg8::StaticOrder>, true, true>(F.lds + RING_OFF, g, SS, E);
                if (seg == 0 && bg) {
                    LAS float* scr = (LAS float*)(F.lds + RING_OFF + WAVE * 16384);
                    CONVERT_ITEMS(0, EARLY0_ITEMS, NITEMS, gw, NGW);
                    __syncthreads();
                }
            }
        }
        GRID_BAR();
        for (int rep_ = 0; rep_ < (((PROBE_MASK >> 2) & 1) ? 2 : 1); ++rep_) if constexpr ((PHMASK >> 2) & 1) {
            PHASE_PTRS(); (void)OUT;
            for (int i = gthread; i < MTOK; i += nthreads) { SSQH[i] = 0.f; SSQM[i] = 0.f; SSQS[i] = 0.f; if (l == 0) SSQY[i] = 0.f; }
            const float* g_q_a = args.in[8] + (size_t)l * QLORA; const float* g_kv_a = args.in[10] + (size_t)l * KVLORA; const float* g_k_rope = args.in[15] + (size_t)l * ROPE;
            for (int m = gw; m < MTOK; m += NGW) {
                const float* lr = LAT + (size_t)m * 1792; const int kvr = kvrow_of(m), pos = pos_of(m);
                {
                    f32x4 v[4]; float s = 0.f;
#pragma unroll
                    for (int j = 0; j < 4; ++j) { v[j] = *(const GAS f32x4*)(lr + 4 * (64 * j + LANE)); s += (v[j].x * v[j].x + v[j].y * v[j].y) + (v[j].z * v[j].z + v[j].w * v[j].w); }
                    const float rstd = 1.0f / sqrtf(wave_sum(s) * (1.f / 1024.f) + EPS);
#pragma unroll
                    for (int j = 0; j < 4; ++j) { const f32x4 gg = *(const GAS f32x4*)(g_q_a + 4 * (64 * j + LANE));
                        *(GAS unsigned long long*)(QLAT + (size_t)m * QLORA + 4 * (64 * j + LANE)) =
                            (unsigned long long)pkbf(v[j].x * rstd * gg.x, v[j].y * rstd * gg.y) | ((unsigned long long)pkbf(v[j].z * rstd * gg.z, v[j].w * rstd * gg.w) << 32); }
                }
                {
                    f32x4 v[2]; float s = 0.f;
#pragma unroll
                    for (int j = 0; j < 2; ++j) { v[j] = *(const GAS f32x4*)(lr + 1024 + 4 * (64 * j + LANE)); s += (v[j].x * v[j].x + v[j].y * v[j].y) + (v[j].z * v[j].z + v[j].w * v[j].w); }
                    const float rstd = 1.0f / sqrtf(wave_sum(s) * (1.f / 512.f) + EPS);
                    float* oc = (m < NP) ? OUT + O_CKV_P + ((size_t)l * NP + m) * KVLORA : OUT + O_CKV_S + ((size_t)l * NS + (m - NP)) * KVLORA;
#pragma unroll
                    for (int j = 0; j < 2; ++j) { const f32x4 gg = *(const GAS f32x4*)(g_kv_a + 4 * (64 * j + LANE));
                        const f32x4 c = {v[j].x * rstd * gg.x, v[j].y * rstd * gg.y, v[j].z * rstd * gg.z, v[j].w * rstd * gg.w};
                        *(GAS f32x4*)(oc + 4 * (64 * j + LANE)) = c;
                        *(GAS unsigned long long*)(AKV + (size_t)kvr * KVLORA + 4 * (64 * j + LANE)) = (unsigned long long)pkbf(c.x, c.y) | ((unsigned long long)pkbf(c.z, c.w) << 32); }
                }
                {
                    const float x = lr[1536 + LANE];
                    const float rstd = 1.0f / sqrtf(wave_sum(x * x) * (1.f / 64.f) + EPS);
                    const float xn = x * rstd * g_k_rope[LANE]; const float xp = __shfl_xor(xn, 32);
                    const f32x2 cs = TAB[pos * 32 + (LANE & 31)];
                    const float o = (LANE < 32) ? xn * cs.x - xp * cs.y : xp * cs.y + xn * cs.x;
                    float* okr = (m < NP) ? OUT + O_KR_P + ((size_t)l * NP + m) * ROPE : OUT + O_KR_S + ((size_t)l * NS + (m - NP)) * ROPE;
                    okr[LANE] = o;
                    const float on = __shfl_xor(o, 1);
                    if ((LANE & 1) == 0) *(GAS unsigned*)(KROPE + (size_t)kvr * ROPE + LANE) = pkbf(o, on);
                }
            }
        }
        GRID_BAR();
        for (int rep_ = 0; rep_ < (((PROBE_MASK >> 3) & 1) ? 2 : 1); ++rep_) if constexpr ((PHMASK >> 3) & 1) {
            PHASE_PTRS(); (void)OUT;
            pg8::Gemm g{QLAT, WQB_T, MTOK, 3072, QLORA, nullptr}; pg8::StaticOrder S; S.init(MTOK, 3072, G_, bx_);
            pg8::EpiQb E{QB, args.in[12] + (size_t)l * NOPE, args.in[13] + (size_t)l * ROPE, TAB, (LAS float*)(F.lds + XCH_OFF), QS_MLA, EPS};
            pg8::gemm_phase<pg8::EpiQb, pg8::StaticOrder, true, true>(F.lds + RING_OFF, g, S, E);
        }
        for (int rep_ = 0; rep_ < (((PROBE_MASK >> 11) & 1) ? 2 : 1); ++rep_) if constexpr ((PHMASK >> 11) & 1) {
            PHASE_PTRS(); (void)OUT;
            pg8::Gemm g{AKV, WKVB_T, KVROWS, 4096, KVLORA, nullptr}; pg8::StaticOrder S; S.init(KVROWS, 4096, G_, (bx_ + G_ - 24) % G_);
            pg8::EpiKvbN E{KN, VB, args.in[14] + (size_t)l * NOPE, (LAS float*)(F.lds + XCH_OFF), EPS};
            pg8::gemm_phase<pg8::EpiKvbN, pg8::StaticOrder, true, true>(F.lds + RING_OFF, g, S, E);
        }
        GRID_BAR();
        for (int rep_ = 0; rep_ < (((PROBE_MASK >> 5) & 1) ? 2 : 1); ++rep_) if constexpr ((PHMASK >> 5) & 1) {
            PHASE_PTRS(); (void)OUT;
            const int v = VCU, bh = v >> 2, b = bh >> 4, h = bh & 15, s = v & 3;
            ALAS char* al = (ALAS char*)(F.lds + RING_OFF);
#pragma unroll 1
            for (int k = 0; k < 5; ++k) {
                att::Unit u;
                if (k < 4) { const int qb = (k == 0) ? s : (k == 1) ? 7 - s : (k == 2) ? 8 + s : 15 - s; const size_t m0 = (size_t)b * SEQ + (size_t)qb * 256, kv0 = (size_t)b * SEQ;
                    u.Q = QB + m0 * 3072 + h * 192; u.ldq = 3072; u.K = KN + kv0 * 2048 + h * 128; u.Kr = KROPE + kv0 * ROPE; u.V = VB + kv0 * 2048 + h * 128;
                    u.O = MERGED + m0 * 4096 + h * 128; u.ldo = 4096; u.ssq = SSQP + m0 * 32 + h; u.Kf0 = u.Vf0 = u.Kf1 = u.Vf1 = nullptr; u.split = 0; u.P0 = qb * 256; u.NT = 4 * qb + 4; u.nact = 8; }
                else { if (v >= 128) break; const int sb = v >> 4, sh = v & 15; const size_t m0 = (size_t)NP + (size_t)sb * 64, kv0 = (size_t)NP + (size_t)sb * SKVS;
                    u.Q = QB + m0 * 3072 + sh * 192; u.ldq = 3072; u.K = KN + kv0 * 2048 + sh * 128; u.Kr = KROPE + kv0 * ROPE; u.V = VB + kv0 * 2048 + sh * 128;
                    u.O = MERGED + m0 * 4096 + sh * 128; u.ldo = 4096; u.ssq = SSQP + m0 * 32 + sh; u.Kf0 = u.Vf0 = u.Kf1 = u.Vf1 = nullptr; u.split = 0; u.P0 = PAST; u.NT = 17; u.nact = 2; }
                if constexpr ((PHMASK >> 12) & 1) att::mla_unit_dma<0>(u, al);
            }
#pragma unroll 1
            for (int k = 0; k < 5; ++k) {
                att::Unit u;
                if (k < 4) { const int qb = (k == 0) ? s : (k == 1) ? 7 - s : (k == 2) ? 8 + s : 15 - s; const size_t m0 = (size_t)b * SEQ + (size_t)qb * 256, kv0 = (size_t)b * SEQ;
                    u.Q = SBQ + m0 * 2048 + h * 128; u.ldq = 2048; u.K = nullptr; u.Kr = nullptr; u.V = nullptr; u.split = 1 << 30;
                    u.Kf0 = OUT + O_SBK_P + ((size_t)l * NP + kv0) * 2048 + h * 128; u.Vf0 = OUT + O_SBV_P + ((size_t)l * NP + kv0) * 2048 + h * 128; u.Kf1 = u.Kf0; u.Vf1 = u.Vf0;
                    u.O = MERGED + m0 * 4096 + 2048 + h * 128; u.ldo = 4096; u.ssq = SSQP + m0 * 32 + 16 + h; u.P0 = qb * 256; u.NT = 4 * qb + 4; u.nact = 8; }
                else { if (v < 128) break; const int w = v - 128, sb = w >> 4, sh = w & 15; const size_t m0 = (size_t)NP + (size_t)sb * 64, kv0 = (size_t)NP + (size_t)sb * SKVS;
                    u.Q = SBQ + m0 * 2048 + sh * 128; u.ldq = 2048; u.K = nullptr; u.Kr = nullptr; u.V = nullptr; u.split = PAST / 64;
                    u.Kf0 = args.in[4] + ((size_t)(l * 8 + sb) * PAST) * 2048 + sh * 128; u.Vf0 = args.in[5] + ((size_t)(l * 8 + sb) * PAST) * 2048 + sh * 128;
                    u.Kf1 = OUT + O_SBK_S + ((size_t)l * NS + (size_t)sb * 64) * 2048 + sh * 128; u.Vf1 = OUT + O_SBV_S + ((size_t)l * NS + (size_t)sb * 64) * 2048 + sh * 128;
                    u.O = MERGED + m0 * 4096 + 2048 + sh * 128; u.ldo = 4096; u.ssq = SSQP + m0 * 32 + 16 + sh; u.P0 = PAST; u.NT = 17; u.nact = 2; }
                if constexpr ((PHMASK >> 13) & 1) att::attn_unit<false>(u, al);
            }
        }
        GRID_BAR();
#if !ATT_SSQ_ATOMICS
        {
            PHASE_PTRS(); (void)OUT;
            for (int i = gthread; i < MTOK * 2; i += nthreads) { const int m = i >> 1, half = i & 1; const GAS f32x4* p = (const GAS f32x4*)(SSQP + (size_t)m * 32 + half * 16);
                const f32x4 a = p[0], b = p[1], c = p[2], d = p[3];
                const float s = (((a.x + a.y) + (a.z + a.w)) + ((b.x + b.y) + (b.z + b.w))) + (((c.x + c.y) + (c.z + c.w)) + ((d.x + d.y) + (d.z + d.w)));
                (half ? SSQS : SSQM)[m] = s; }
        }
        GRID_BAR();
#endif
        for (int rep_ = 0; rep_ < (((PROBE_MASK >> 7) & 1) ? 2 : 1); ++rep_) if constexpr ((PHMASK >> 7) & 1) {
            PHASE_PTRS(); (void)OUT;
            pg8::Gemm g{MERGED, WO_T, MTOK, DM, DM, SLAB}; pg8::PanelOrder S; S.init3(MTOK, DM, DM, G_, bx_, SLAB, 2);
            pg8::EpiResP<true> E{args.in[0], args.in[1], nullptr, XN, SSQH, SSQM, SSQS, EPS, l == 0 ? nullptr : Y0B};
            pg8::gemm_phase<pg8::EpiResP<true>, pg8::PanelOrder, true, true>(F.lds + RING_OFF, g, S, E);
        }
        GRID_BAR();
        {
            PHASE_PTRS(); pg8::PanelOrder S; S.init3(MTOK, DM, DM, G_, bx_, SLAB, 2);
            tail_reduce_res<true>(S, args.in[0], args.in[1], nullptr, XN, SSQH, SSQM, SSQS, l == 0 ? nullptr : Y0B, ptid_);
        }
        GRID_BAR();
        for (int rep_ = 0; rep_ < (((PROBE_MASK >> 9) & 1) ? 2 : 1); ++rep_) if constexpr ((PHMASK >> 9) & 1) {
            PHASE_PTRS(); (void)OUT;
            pg8::Gemm g{XN, WUP_T, MTOK, DFF, DM, nullptr}; pg8::StaticOrder S; S.init(MTOK, DFF, G_, bx_);
            pg8::EpiRelu2N E{UB, DFF, SSQH, EPS};
            pg8::gemm_phase<pg8::EpiRelu2N, pg8::StaticOrder, true, true>(F.lds + RING_OFF, g, S, E);
            if (l + 1 < 2 && G_ == 256 && bx_ >= 128) {
                LAS float* scr = (LAS float*)(F.lds + RING_OFF + WAVE * 16384);
                CONVERT_ITEMS(l + 1, 0, EARLY_ITEMS, (bx_ - 128) * NWAVES + WAVE, 128 * NWAVES);
            }
        }
        GRID_BAR();
        for (int rep_ = 0; rep_ < (((PROBE_MASK >> 10) & 1) ? 2 : 1); ++rep_) if constexpr ((PHMASK >> 10) & 1) {
            PHASE_PTRS(); (void)OUT;
            pg8::Gemm g{UB, l == 0 ? WDN_T0 : WDN_T1, MTOK, DM, DFF, SLAB, 1};     pg8::PanelOrder S; S.init3(MTOK, DM, DFF, G_, bx_, SLAB);
            pg8::EpiResP<false> E{nullptr, nullptr, OUT + O_Y, XN, SSQY, nullptr, nullptr, EPS, l == 1 ? nullptr : Y0B};
            const bool bg = (l + 1 < 2 && G_ == 256);
            const int rsplit = bg ? ((bx_ & 7) >> 1) : 0;
#pragma unroll 1
            for (int seg = 0; seg < 2; ++seg) {
                pg8::SubRange<pg8::PanelOrder> SS{S, seg ? rsplit : 0, seg ? (1 << 30) : rsplit};
                pg8::gemm_phase<pg8::EpiResP<false>, pg8::SubRange<pg8::PanelOrder>, true, true>(F.lds + RING_OFF, g, SS, E);
                if (seg == 0 && bg) {
                    LAS float* scr = (LAS float*)(F.lds + RING_OFF + WAVE * 16384);
                    CONVERT_ITEMS(l + 1, EARLY_ITEMS, NITEMS, gw, NGW);
                    __syncthreads();
                }
            }
        }
        GRID_BAR();
        {
            PHASE_PTRS(); pg8::PanelOrder S; S.init3(MTOK, DM, DFF, G_, bx_, SLAB);
            tail_reduce_res<false>(S, nullptr, nullptr, OUT + O_Y, XN, SSQY, nullptr, nullptr, l == 1 ? nullptr : Y0B, ptid_);
            if (l + 1 < 2) {
                cache_rows_to_bf16(args.in[2] + (size_t)(l + 1) * 8 * PAST * KVLORA, AKV, KVLORA, gthread, nthreads);
                cache_rows_to_bf16(args.in[3] + (size_t)(l + 1) * 8 * PAST * ROPE, KROPE, ROPE, gthread, nthreads);
            }
        }
        GRID_BAR();
    }
#undef GRID_BAR
}

extern "C" void kernel_launch(void* const* d_in, const int* in_sizes, int n_in, void* d_out, int out_size, void* d_ws, size_t ws_size, hipStream_t stream) {
    static int grid = 0;
    if (grid == 0) {
        if (n_in != 22 || (size_t)out_size != O_END || ws_size < WS_END) { fprintf(stderr, "kernel_launch: unexpected shapes: n_in %d out %d ws %zu (need %zu)\n", n_in, out_size, ws_size, (size_t)WS_END); grid = -1; return; }
        int dev = 0, cus = 0, per_cu = 0;
        if (hipGetDevice(&dev) != hipSuccess || hipDeviceGetAttribute(&cus, hipDeviceAttributeMultiprocessorCount, dev) != hipSuccess) { grid = -1; return; }
        if (hipFuncSetAttribute((const void*)hymba_fwd, hipFuncAttributeMaxDynamicSharedMemorySize, LDS_BYTES) != hipSuccess) { fprintf(stderr, "kernel_launch: hipFuncSetAttribute failed\n"); grid = -1; return; }
        if (hipOccupancyMaxActiveBlocksPerMultiprocessor(&per_cu, (const void*)hymba_fwd, NWAVES * 64, LDS_BYTES) != hipSuccess || per_cu < 1) { fprintf(stderr, "kernel_launch: occupancy query reports %d\n", per_cu); }
        (void)hipGetLastError();
        grid = cus;
        if (grid != 256) fprintf(stderr, "kernel_launch: %d CUs (the attention deal assumes 256 workgroups)\n", grid);
    }
    if (grid < 0) return;
    if (hipMemsetAsync((char*)d_ws + WS_CTL, 0, CTL_ZERO_BYTES, stream) != hipSuccess) return;
    Args a{};
    for (int i = 0; i < 22; ++i) a.in[i] = (const float*)d_in[i];
    a.out = (float*)d_out; a.ws = (unsigned char*)d_ws;
    hipLaunchKernelGGL(hymba_fwd, dim3(grid), dim3(NWAVES * 64), LDS_BYTES, stream, a);
}
```

```cpp
#include <hip/hip_runtime.h>
#include <cstdio>
#include <cstdint>
#include <type_traits>
namespace pg8 {
#define PG8_LAS __attribute__((address_space(3)))
typedef unsigned short bf16_t;
typedef short bf16x8 __attribute__((ext_vector_type(8)));
typedef float f32x4 __attribute__((ext_vector_type(4)));
typedef unsigned u32x4 __attribute__((ext_vector_type(4)));
constexpr int BM = 256, BK = 64, HALF = 128, HTB = HALF * BK * 2  , STAGE_BYTES = 8 * HTB, NXCD = 8, WGM = 8;

__host__ __device__ __forceinline__ int lds_byte(int r, int c) { const int st = (r >> 4) * 2 + (c >> 5), rr = r & 15, cc = c & 31, ob = rr * 64 + cc * 2; return st * 1024 + (ob ^ (((ob >> 9) & 1) << 5)); }
__host__ __device__ __forceinline__ void stage_rc(int b, int& R, int& C) { const int st = b / 1024, sb = b % 1024, swz = sb ^ (((sb >> 9) & 1) << 5); R = (st >> 1) * 16 + swz / 64; C = (st & 1) * 32 + (swz % 64) / 2; }
__host__ __device__ __forceinline__ int perm32(int rho) { const int n = rho >> 4, i = rho & 15; return 8 * (i >> 2) + 4 * n + (i & 3); }

struct Unit { int pm, pn, kt0, nkt, part; };
struct Gemm { const bf16_t* A; const bf16_t* Bt; int M, N, K; float* slab; int blocked = 0; };

struct StaticOrder {
    int nM, nN, nwg, G, c, wgm = WGM;
    __host__ __device__ __forceinline__ void init(int M, int N, int G_, int c_) { nM = M / BM; nN = N / BM; nwg = nM * nN; G = G_; c = c_; }
    __host__ __device__ __forceinline__ bool next(int i, Unit& u) const {
        const long L = (long)i * G + c; if (L >= nwg) return false;
        int wgid = (int)L; { const int q = nwg / NXCD, r = nwg % NXCD, xcd = wgid % NXCD, off = wgid / NXCD; wgid = (xcd < r ? xcd * (q + 1) : r * (q + 1) + (xcd - r) * q) + off; }
        const int nig = wgm * nN, gid = wgid / nig, fm = gid * wgm, gsz = (nM - fm) < wgm ? (nM - fm) : wgm;
        u.pm = fm + ((wgid % nig) % gsz); u.pn = (wgid % nig) / gsz; u.kt0 = 0; u.nkt = 0; u.part = -1; return true;
    }
    __host__ __device__ __forceinline__ void map(int L, Unit& u) const {
        int wgid = L; { const int q = nwg / NXCD, r = nwg % NXCD, xcd = wgid % NXCD, off = wgid / NXCD; wgid = (xcd < r ? xcd * (q + 1) : r * (q + 1) + (xcd - r) * q) + off; }
        const int nig = wgm * nN, gid = wgid / nig, fm = gid * wgm, gsz = (nM - fm) < wgm ? (nM - fm) : wgm;
        u.pm = fm + ((wgid % nig) % gsz); u.pn = (wgid % nig) / gsz; u.kt0 = 0; u.nkt = 0; u.part = -1;
    }
    __device__ __forceinline__ void a_ready(const Unit&) const {}
    __device__ __forceinline__ void done(const Unit&) const {}
};

struct InOrder : StaticOrder {
    bool panel;
    __host__ __device__ __forceinline__ void init3(int M, int N, int G_, int c_) { init(M, N, G_, c_); panel = (G_ == 256 && nM == 66 && nN == 31); }
    __host__ __device__ __forceinline__ bool next(int i, Unit& u) const {
        if (!panel) return StaticOrder::next(i, u);
        if (i >= 8) return false;
        const int x = c & 7, idx = c >> 3, g = x >> 2, q = x & 3, pmo = idx & 3, pn = 8 * q + (idx >> 2);
        if (pn < 31) { u.pm = 8 * i + 4 * g + pmo; u.pn = pn; }
        else { const int su = i * 8 + g * 4 + pmo; if (su >= 62) return false; const int hi31 = su >= 31 ? 1 : 0; u.pm = 64 + hi31; u.pn = su - 31 * hi31; }
        u.kt0 = 0; u.nkt = 0; u.part = -1; return true; }
};

template <class S_> struct SubRange {
    const S_& s; int lo, hi;
    __device__ __forceinline__ bool next(int i, Unit& u) const { return (lo + i < hi) && s.next(lo + i, u); }
    __device__ __forceinline__ void a_ready(const Unit& u) const { s.a_ready(u); }
    __device__ __forceinline__ void done(const Unit& u) const { s.done(u); }
};

__device__ __forceinline__ unsigned cvt_pk_bf16(float lo, float hi) { unsigned r; asm volatile("v_cvt_pk_bf16_f32 %0, %1, %2" : "=v"(r) : "v"(lo), "v"(hi)); return r; }

struct TailSplitOrder : StaticOrder {
    int nfull, nsplit, nkt_full, halves; float* slab;
    __host__ __device__ __forceinline__ void init2(int M, int N, int K, int G_, int c_, float* slab_, int halves_ = 1) { init(M, N, G_, c_); nkt_full = K / BK; slab = slab_; halves = halves_; nfull = nwg / G; const int rem = nwg - nfull * G;
        nsplit = (rem > 0 && G % rem == 0 && (nkt_full % (2 * (G / rem))) == 0 && nkt_full / (G / rem) >= 4) ? G / rem : 1; }
    __host__ __device__ __forceinline__ bool next(int i, Unit& u) const {
        const int ii = i / halves, hh = i % halves;
        if (ii < nfull || nsplit == 1) { if (!StaticOrder::next(ii, u)) return false; if (halves == 2) { u.nkt = nkt_full / 2; u.kt0 = hh * u.nkt; u.part = hh == 0 ? -2 : -1; } return true; }
        if (ii > nfull || hh != 0) return false;
        const int j = c / nsplit, s = c % nsplit; map(nfull * G + j, u); u.nkt = nkt_full / nsplit; u.kt0 = s * u.nkt; u.part = j * nsplit + s; return true;
    }
};

struct PanelOrder : TailSplitOrder {
    bool panel;
    __host__ __device__ __forceinline__ void init3(int M, int N, int K, int G_, int c_, float* slab_, int halves_ = 1) { init2(M, N, K, G_, c_, slab_, halves_); panel = (G_ == 256 && nM == 66 && nN == 16 && nsplit == 8); }
    __host__ __device__ __forceinline__ void mapu(int L, Unit& u) const {
        if (L < 1024) { const int r = L >> 8, x = L & 7, idx = (L & 255) >> 3; u.pm = 16 * r + 4 * (x >> 1) + (idx & 3); u.pn = 8 * (x & 1) + (idx >> 2); }
        else { const int j = L - 1024; u.pm = 64 + (j & 1); u.pn = j >> 1; }
        u.kt0 = 0; u.nkt = 0; u.part = -1; }
    __host__ __device__ __forceinline__ bool next(int i, Unit& u) const {
        if (!panel) return TailSplitOrder::next(i, u);
        const int ii = i / halves, hh = i % halves;
        if (ii < nfull) { mapu(ii * G + c, u); if (halves == 2) { u.nkt = nkt_full / 2; u.kt0 = hh * u.nkt; u.part = hh == 0 ? -2 : -1; } return true; }
        if (ii > nfull || hh != 0) return false;
        const int j = c / nsplit, s = c % nsplit; mapu(nfull * G + j, u); u.nkt = nkt_full / nsplit; u.kt0 = s * u.nkt; u.part = j * nsplit + s; return true; }
    __host__ __device__ __forceinline__ void map(int L, Unit& u) const { if (panel) mapu(L, u); else TailSplitOrder::map(L, u); }
};

typedef unsigned u32x2 __attribute__((ext_vector_type(2)));
constexpr int HY_NP = 16384;
__device__ __forceinline__ int hy_kvrow(int m) { return m < HY_NP ? m : HY_NP + ((m - HY_NP) >> 6) * 1088 + 1024 + ((m - HY_NP) & 63); }

struct EpiIn {
    static constexpr bool PERM = true, AFTER_DRAIN = false;
    float* LAT; bf16_t* SBQ; bf16_t* SBK; bf16_t* SBV; float* outK_p; float* outV_p; float* outK_s; float* outV_s; float qscale;
    const float* ssq; float eps;
    __device__ __forceinline__ void operator()(const f32x4 (&acc)[2][2][4][2], const Unit& u, int wr, int wc, int fr, int fq) const {
        const int row0 = u.pm * BM + wr * 64 + fr, colw = wc * 32 + 8 * fq, pn = u.pn;
        float rs[2][4];
#pragma unroll
        for (int ai = 0; ai < 2; ++ai)
#pragma unroll
            for (int m = 0; m < 4; ++m) rs[ai][m] = ssq ? 1.0f / sqrtf(__hip_atomic_load(ssq + row0 + ai * HALF + m * 16, __ATOMIC_RELAXED, __HIP_MEMORY_SCOPE_AGENT) * (1.f / 4096.f) + eps) : 1.0f;
        if (pn < 7) {
#pragma unroll
            for (int ai = 0; ai < 2; ++ai)
#pragma unroll
                for (int m = 0; m < 4; ++m) { float* rp = LAT + (size_t)(row0 + ai * HALF + m * 16) * 1792 + pn * BM + colw;
#pragma unroll
                    for (int bj = 0; bj < 2; ++bj) { *(f32x4*)(rp + bj * HALF) = acc[ai][bj][m][0] * rs[ai][m]; *(f32x4*)(rp + bj * HALF + 4) = acc[ai][bj][m][1] * rs[ai][m]; } }
        } else if (pn < 15) {
#pragma unroll
            for (int ai = 0; ai < 2; ++ai)
#pragma unroll
                for (int m = 0; m < 4; ++m) { bf16_t* rp = SBQ + (size_t)(row0 + ai * HALF + m * 16) * 2048 + (pn - 7) * BM + colw;
#pragma unroll
                    for (int bj = 0; bj < 2; ++bj) { const float sc = qscale * rs[ai][m]; const f32x4 v0 = acc[ai][bj][m][0] * sc, v1 = acc[ai][bj][m][1] * sc;
                        u32x4 w; w.x = cvt_pk_bf16(v0[0], v0[1]); w.y = cvt_pk_bf16(v0[2], v0[3]); w.z = cvt_pk_bf16(v1[0], v1[1]); w.w = cvt_pk_bf16(v1[2], v1[3]);
                        *(u32x4*)(rp + bj * HALF) = w; } }
        } else {
            const bool isv = pn >= 23; const int c0 = (pn - (isv ? 23 : 15)) * BM + colw;
            float* fop = isv ? outV_p : outK_p; float* fos = isv ? outV_s : outK_s;
#pragma unroll
            for (int ai = 0; ai < 2; ++ai)
#pragma unroll
                for (int m = 0; m < 4; ++m) { const int row = row0 + ai * HALF + m * 16;
                    float* fo = (row < HY_NP) ? fop + (size_t)row * 2048 : fos + (size_t)(row - HY_NP) * 2048;
                    fo += c0;
#pragma unroll
                    for (int bj = 0; bj < 2; ++bj) { __builtin_nontemporal_store(acc[ai][bj][m][0] * rs[ai][m], (f32x4*)(fo + bj * HALF)); __builtin_nontemporal_store(acc[ai][bj][m][1] * rs[ai][m], (f32x4*)(fo + bj * HALF + 4)); } }
        }
    }
};
struct EpiF32 {
    static constexpr bool PERM = false, AFTER_DRAIN = false;
    float* C; int ldc;
    __device__ __forceinline__ void operator()(const f32x4 (&acc)[2][2][4][2], const Unit& u, int wr, int wc, int fr, int fq) const {
        const int row0 = u.pm * BM + wr * 64 + fr, col0 = u.pn * BM + wc * 32 + 4 * fq;
#pragma unroll
        for (int ai = 0; ai < 2; ++ai)
#pragma unroll
            for (int m = 0; m < 4; ++m) { float* rowp = C + (size_t)(row0 + ai * HALF + m * 16) * ldc + col0;
#pragma unroll
                for (int bj = 0; bj < 2; ++bj)
#pragma unroll
                    for (int n = 0; n < 2; ++n) *(f32x4*)(rowp + bj * HALF + n * 16) = acc[ai][bj][m][n]; }
    }
};
struct EpiKvb {
    static constexpr bool PERM = true, AFTER_DRAIN = false;
    float* KNRAW; bf16_t* VB;
    __device__ __forceinline__ void operator()(const f32x4 (&acc)[2][2][4][2], const Unit& u, int wr, int wc, int fr, int fq) const {
        const int row0 = u.pm * BM + wr * 64 + fr, colw = wc * 32 + 8 * fq, pn = u.pn;
        if (pn < 8) {
#pragma unroll
            for (int ai = 0; ai < 2; ++ai)
#pragma unroll
                for (int m = 0; m < 4; ++m) { float* rp = KNRAW + (size_t)(row0 + ai * HALF + m * 16) * 2048 + pn * BM + colw;
#pragma unroll
                    for (int bj = 0; bj < 2; ++bj) { *(f32x4*)(rp + bj * HALF) = acc[ai][bj][m][0]; *(f32x4*)(rp + bj * HALF + 4) = acc[ai][bj][m][1]; } }
        } else {
#pragma unroll
            for (int ai = 0; ai < 2; ++ai)
#pragma unroll
                for (int m = 0; m < 4; ++m) { bf16_t* rp = VB + (size_t)(row0 + ai * HALF + m * 16) * 2048 + (pn - 8) * BM + colw;
#pragma unroll
                    for (int bj = 0; bj < 2; ++bj) { const f32x4 v0 = acc[ai][bj][m][0], v1 = acc[ai][bj][m][1];
                        u32x4 w; w.x = cvt_pk_bf16(v0[0], v0[1]); w.y = cvt_pk_bf16(v0[2], v0[3]); w.z = cvt_pk_bf16(v1[0], v1[1]); w.w = cvt_pk_bf16(v1[2], v1[3]);
                        *(u32x4*)(rp + bj * HALF) = w; } }
        }
    }
};
struct EpiRes {
    static constexpr bool PERM = false, AFTER_DRAIN = false;
    const float* resP; const float* resS; float* out;
    __device__ __forceinline__ void operator()(const f32x4 (&acc)[2][2][4][2], const Unit& u, int wr, int wc, int fr, int fq) const {
        const int row0 = u.pm * BM + wr * 64 + fr, col0 = u.pn * BM + wc * 32 + 4 * fq;
        const bool samp = u.pm >= HY_NP / BM;
#pragma unroll
        for (int ai = 0; ai < 2; ++ai)
#pragma unroll
            for (int m = 0; m < 4; ++m) { const int row = row0 + ai * HALF + m * 16;
                const float* rp = samp ? resS + (size_t)(row - HY_NP) * 4096 + col0 : resP + (size_t)row * 4096 + col0;
                float* op = out + (size_t)row * 4096 + col0;
#pragma unroll
                for (int bj = 0; bj < 2; ++bj)
#pragma unroll
                    for (int n = 0; n < 2; ++n) { const f32x4 r = *(const f32x4*)(rp + bj * HALF + n * 16); *(f32x4*)(op + bj * HALF + n * 16) = r + acc[ai][bj][m][n]; } }
    }
};
struct EpiRelu2 {
    static constexpr bool PERM = true, AFTER_DRAIN = false;
    bf16_t* O; int ldc;
    __device__ __forceinline__ void operator()(const f32x4 (&acc)[2][2][4][2], const Unit& u, int wr, int wc, int fr, int fq) const {
        const int row0 = u.pm * BM + wr * 64 + fr, col0 = u.pn * BM + wc * 32 + 8 * fq;
#pragma unroll
        for (int ai = 0; ai < 2; ++ai)
#pragma unroll
            for (int m = 0; m < 4; ++m) { bf16_t* rowp = O + (size_t)(row0 + ai * HALF + m * 16) * ldc + col0;
#pragma unroll
                for (int bj = 0; bj < 2; ++bj) { f32x4 v0 = acc[ai][bj][m][0], v1 = acc[ai][bj][m][1];
#pragma unroll
                    for (int e = 0; e < 4; ++e) { const float a = fmaxf(v0[e], 0.f), b = fmaxf(v1[e], 0.f); v0[e] = a * a; v1[e] = b * b; }
                    u32x4 w; w.x = cvt_pk_bf16(v0[0], v0[1]); w.y = cvt_pk_bf16(v0[2], v0[3]); w.z = cvt_pk_bf16(v1[0], v1[1]); w.w = cvt_pk_bf16(v1[2], v1[3]);
                    *(u32x4*)(rowp + bj * HALF) = w; } }
    }
};

typedef float f32x2e __attribute__((ext_vector_type(2)));
__device__ __forceinline__ void head_ssq_exchange(const f32x4 (&acc)[2][2][4][2], PG8_LAS float* P, int wr, int wc, int fr, int fq, float (&rstd)[2][4][2], float inv_n, float eps) {
#pragma unroll
    for (int ai = 0; ai < 2; ++ai)
#pragma unroll
        for (int m = 0; m < 4; ++m)
#pragma unroll
            for (int bj = 0; bj < 2; ++bj) {
                const f32x4 a = acc[ai][bj][m][0], b = acc[ai][bj][m][1];
                float s = ((a[0] * a[0] + a[1] * a[1]) + (a[2] * a[2] + a[3] * a[3])) + ((b[0] * b[0] + b[1] * b[1]) + (b[2] * b[2] + b[3] * b[3]));
                s += __shfl_xor(s, 16); s += __shfl_xor(s, 32);
                if (fq == 0) P[(ai * HALF + wr * 64 + m * 16 + fr) * 8 + bj * 4 + wc] = s;
            }
    asm volatile("s_waitcnt lgkmcnt(0)" ::: "memory"); __builtin_amdgcn_s_barrier(); asm volatile("" ::: "memory");
#pragma unroll
    for (int ai = 0; ai < 2; ++ai)
#pragma unroll
        for (int m = 0; m < 4; ++m)
#pragma unroll
            for (int bj = 0; bj < 2; ++bj) {
                const f32x4 p = *(const PG8_LAS f32x4*)(P + (ai * HALF + wr * 64 + m * 16 + fr) * 8 + bj * 4);
                rstd[ai][m][bj] = 1.0f / sqrtf(((p[0] + p[1]) + (p[2] + p[3])) * inv_n + eps);
            }
}
struct EpiQb {
    static constexpr bool PERM = true, AFTER_DRAIN = false;
    bf16_t* QB; const float* g_nope; const float* g_rope; const f32x2e* tab; PG8_LAS float* P; float qs, eps;
    __device__ __forceinline__ void operator()(const f32x4 (&acc)[2][2][4][2], const Unit& u, int wr, int wc, int fr, int fq) const {
        const int row0 = u.pm * BM + wr * 64 + fr, pn = u.pn;
        if (pn < 8) {
            float rstd[2][4][2]; head_ssq_exchange(acc, P, wr, wc, fr, fq, rstd, 1.f / 128.f, eps);
            const f32x4 g0 = *(const f32x4*)(g_nope + wc * 32 + 8 * fq) * qs, g1 = *(const f32x4*)(g_nope + wc * 32 + 8 * fq + 4) * qs;
#pragma unroll
            for (int ai = 0; ai < 2; ++ai)
#pragma unroll
                for (int m = 0; m < 4; ++m) { bf16_t* rp = QB + (size_t)(row0 + ai * HALF + m * 16) * 3072 + (2 * pn) * 192 + wc * 32 + 8 * fq;
#pragma unroll
                    for (int bj = 0; bj < 2; ++bj) { const float r = rstd[ai][m][bj]; const f32x4 v0 = acc[ai][bj][m][0] * g0 * r, v1 = acc[ai][bj][m][1] * g1 * r;
                        u32x4 w; w.x = cvt_pk_bf16(v0[0], v0[1]); w.y = cvt_pk_bf16(v0[2], v0[3]); w.z = cvt_pk_bf16(v1[0], v1[1]); w.w = cvt_pk_bf16(v1[2], v1[3]);
                        *(u32x4*)(rp + bj * 192) = w; } }
        } else {
            const int h = 4 * (pn - 8) + wc;
            const f32x4 ga0 = *(const f32x4*)(g_rope + 8 * fq), ga1 = *(const f32x4*)(g_rope + 8 * fq + 4), gb0 = *(const f32x4*)(g_rope + 32 + 8 * fq), gb1 = *(const f32x4*)(g_rope + 32 + 8 * fq + 4);
#pragma unroll
            for (int ai = 0; ai < 2; ++ai)
#pragma unroll
                for (int m = 0; m < 4; ++m) { const int row = row0 + ai * HALF + m * 16;
                    const f32x4 a0 = acc[ai][0][m][0], a1 = acc[ai][0][m][1], b0 = acc[ai][1][m][0], b1 = acc[ai][1][m][1];
                    float s = (((a0[0] * a0[0] + a0[1] * a0[1]) + (a0[2] * a0[2] + a0[3] * a0[3])) + ((a1[0] * a1[0] + a1[1] * a1[1]) + (a1[2] * a1[2] + a1[3] * a1[3])))
                            + (((b0[0] * b0[0] + b0[1] * b0[1]) + (b0[2] * b0[2] + b0[3] * b0[3])) + ((b1[0] * b1[0] + b1[1] * b1[1]) + (b1[2] * b1[2] + b1[3] * b1[3])));
                    s += __shfl_xor(s, 16); s += __shfl_xor(s, 32);
                    const float r = 1.0f / sqrtf(s * (1.f / 64.f) + eps);
                    const int pos = row < HY_NP ? (row & 4095) : 1024 + ((row - HY_NP) & 63);
                    const f32x4* tp = (const f32x4*)(tab + pos * 32 + 8 * fq);
                    const f32x4 t0 = tp[0], t1 = tp[1], t2 = tp[2], t3 = tp[3];
                    const f32x4 x10 = a0 * ga0 * r, x11 = a1 * ga1 * r, x20 = b0 * gb0 * r, x21 = b1 * gb1 * r;
                    const f32x4 c0 = {t0[0], t0[2], t1[0], t1[2]}, s0 = {t0[1], t0[3], t1[1], t1[3]}, c1 = {t2[0], t2[2], t3[0], t3[2]}, s1 = {t2[1], t2[3], t3[1], t3[3]};
                    const f32x4 o10 = (x10 * c0 - x20 * s0) * qs, o11 = (x11 * c1 - x21 * s1) * qs, o20 = (x10 * s0 + x20 * c0) * qs, o21 = (x11 * s1 + x21 * c1) * qs;
                    bf16_t* rp = QB + (size_t)row * 3072 + h * 192 + 128 + 8 * fq;
                    u32x4 w; w.x = cvt_pk_bf16(o10[0], o10[1]); w.y = cvt_pk_bf16(o10[2], o10[3]); w.z = cvt_pk_bf16(o11[0], o11[1]); w.w = cvt_pk_bf16(o11[2], o11[3]);
                    *(u32x4*)rp = w;
                    w.x = cvt_pk_bf16(o20[0], o20[1]); w.y = cvt_pk_bf16(o20[2], o20[3]); w.z = cvt_pk_bf16(o21[0], o21[1]); w.w = cvt_pk_bf16(o21[2], o21[3]);
                    *(u32x4*)(rp + 32) = w; }
        }
    }
};
struct EpiKvbN {
    static constexpr bool PERM = true, AFTER_DRAIN = false;
    bf16_t* KN; bf16_t* VB; const float* g_nope; PG8_LAS float* P; float eps;
    __device__ __forceinline__ void operator()(const f32x4 (&acc)[2][2][4][2], const Unit& u, int wr, int wc, int fr, int fq) const {
        const int row0 = u.pm * BM + wr * 64 + fr, colw = wc * 32 + 8 * fq, pn = u.pn;
        if (pn < 8) {
            float rstd[2][4][2]; head_ssq_exchange(acc, P, wr, wc, fr, fq, rstd, 1.f / 128.f, eps);
            const f32x4 g0 = *(const f32x4*)(g_nope + colw), g1 = *(const f32x4*)(g_nope + colw + 4);
#pragma unroll
            for (int ai = 0; ai < 2; ++ai)
#pragma unroll
                for (int m = 0; m < 4; ++m) { bf16_t* rp = KN + (size_t)(row0 + ai * HALF + m * 16) * 2048 + pn * BM + colw;
#pragma unroll
                    for (int bj = 0; bj < 2; ++bj) { const float r = rstd[ai][m][bj]; const f32x4 v0 = acc[ai][bj][m][0] * g0 * r, v1 = acc[ai][bj][m][1] * g1 * r;
                        u32x4 w; w.x = cvt_pk_bf16(v0[0], v0[1]); w.y = cvt_pk_bf16(v0[2], v0[3]); w.z = cvt_pk_bf16(v1[0], v1[1]); w.w = cvt_pk_bf16(v1[2], v1[3]);
                        *(u32x4*)(rp + bj * HALF) = w; } }
        } else {
#pragma unroll
            for (int ai = 0; ai < 2; ++ai)
#pragma unroll
                for (int m = 0; m < 4; ++m) { bf16_t* rp = VB + (size_t)(row0 + ai * HALF + m * 16) * 2048 + (pn - 8) * BM + colw;
#pragma unroll
                    for (int bj = 0; bj < 2; ++bj) { const f32x4 v0 = acc[ai][bj][m][0], v1 = acc[ai][bj][m][1];
                        u32x4 w; w.x = cvt_pk_bf16(v0[0], v0[1]); w.y = cvt_pk_bf16(v0[2], v0[3]); w.z = cvt_pk_bf16(v1[0], v1[1]); w.w = cvt_pk_bf16(v1[2], v1[3]);
                        *(u32x4*)(rp + bj * HALF) = w; } }
        }
    }
};

template <bool NORM> struct EpiResP {
    static constexpr bool PERM = true, AFTER_DRAIN = false, MIDK = NORM;
    const float* resP; const float* resS; float* out; bf16_t* HB; float* ssq; const float* ssqm; const float* ssqs; float eps;
    bf16_t* YB;
    __device__ __forceinline__ void mid(f32x4 (&acc)[2][2][4][2], const Unit& u, int wr, int wc, int fr, int fq) const {
        const int row0 = u.pm * BM + wr * 64 + fr;
#pragma unroll
        for (int ai = 0; ai < 2; ++ai)
#pragma unroll
            for (int m = 0; m < 4; ++m) { const int row = row0 + ai * HALF + m * 16;
                const float a = __hip_atomic_load(ssqm + row, __ATOMIC_RELAXED, __HIP_MEMORY_SCOPE_AGENT), b = __hip_atomic_load(ssqs + row, __ATOMIC_RELAXED, __HIP_MEMORY_SCOPE_AGENT);
                const float ratio = sqrtf((b * (1.f / 2048.f) + eps) / (a * (1.f / 2048.f) + eps));
#pragma unroll
                for (int bj = 0; bj < 2; ++bj) { acc[ai][bj][m][0] *= ratio; acc[ai][bj][m][1] *= ratio; } }
    }
    __device__ __forceinline__ void operator()(const f32x4 (&acc)[2][2][4][2], const Unit& u, int wr, int wc, int fr, int fq) const {
        const int row0 = u.pm * BM + wr * 64 + fr, col0 = u.pn * BM + wc * 32 + 8 * fq;
        const bool samp = u.pm >= HY_NP / BM;
#pragma unroll
        for (int ai = 0; ai < 2; ++ai)
#pragma unroll
            for (int m = 0; m < 4; ++m) { const int row = row0 + ai * HALF + m * 16;
                if (NORM) {
                    const float* rp = samp ? resS + (size_t)(row - HY_NP) * 4096 + col0 : resP + (size_t)row * 4096 + col0; float s = 0.f;
                    const bf16_t* yp = YB + (size_t)row * 4096 + col0;
                    const float rs = 1.0f / sqrtf(__hip_atomic_load(ssqs + row, __ATOMIC_RELAXED, __HIP_MEMORY_SCOPE_AGENT) * (1.f / 2048.f) + eps);
#pragma unroll
                    for (int bj = 0; bj < 2; ++bj) { f32x4 r0, r1;
                        if (YB) { const u32x4 h = *(const u32x4*)(yp + bj * HALF);
                            r0 = (f32x4){__uint_as_float(h.x << 16), __uint_as_float(h.x & 0xffff0000u), __uint_as_float(h.y << 16), __uint_as_float(h.y & 0xffff0000u)};
                            r1 = (f32x4){__uint_as_float(h.z << 16), __uint_as_float(h.z & 0xffff0000u), __uint_as_float(h.w << 16), __uint_as_float(h.w & 0xffff0000u)}; }
                        else { r0 = *(const f32x4*)(rp + bj * HALF); r1 = *(const f32x4*)(rp + bj * HALF + 4); }
                        const f32x4 v0 = r0 + acc[ai][bj][m][0] * rs, v1 = r1 + acc[ai][bj][m][1] * rs;
                        s += ((v0[0] * v0[0] + v0[1] * v0[1]) + (v0[2] * v0[2] + v0[3] * v0[3])) + ((v1[0] * v1[0] + v1[1] * v1[1]) + (v1[2] * v1[2] + v1[3] * v1[3]));
                        u32x4 w; w.x = cvt_pk_bf16(v0[0], v0[1]); w.y = cvt_pk_bf16(v0[2], v0[3]); w.z = cvt_pk_bf16(v1[0], v1[1]); w.w = cvt_pk_bf16(v1[2], v1[3]);
                        *(u32x4*)(HB + (size_t)row * 4096 + col0 + bj * HALF) = w; }
                    s += __shfl_xor(s, 16); s += __shfl_xor(s, 32);
                    if (fq == 0) __hip_atomic_fetch_add(ssq + row, s, __ATOMIC_RELAXED, __HIP_MEMORY_SCOPE_AGENT);
                } else {
                    const bf16_t* hp = HB + (size_t)row * 4096 + col0; float* op = out + (size_t)row * 4096 + col0; float s = 0.f;
#pragma unroll
                    for (int bj = 0; bj < 2; ++bj) { const u32x4 h = *(const u32x4*)(hp + bj * HALF);
                        const f32x4 r0 = {__uint_as_float(h.x << 16), __uint_as_float(h.x & 0xffff0000u), __uint_as_float(h.y << 16), __uint_as_float(h.y & 0xffff0000u)};
                        const f32x4 r1 = {__uint_as_float(h.z << 16), __uint_as_float(h.z & 0xffff0000u), __uint_as_float(h.w << 16), __uint_as_float(h.w & 0xffff0000u)};
                        const f32x4 y0 = r0 + acc[ai][bj][m][0], y1 = r1 + acc[ai][bj][m][1];
                        if (YB) { u32x4 w; w.x = cvt_pk_bf16(y0[0], y0[1]); w.y = cvt_pk_bf16(y0[2], y0[3]); w.z = cvt_pk_bf16(y1[0], y1[1]); w.w = cvt_pk_bf16(y1[2], y1[3]);
                                  *(u32x4*)(YB + (size_t)row * 4096 + col0 + bj * HALF) = w;
                                  s += ((y0[0] * y0[0] + y0[1] * y0[1]) + (y0[2] * y0[2] + y0[3] * y0[3])) + ((y1[0] * y1[0] + y1[1] * y1[1]) + (y1[2] * y1[2] + y1[3] * y1[3])); }
                        else { __builtin_nontemporal_store(y0, (f32x4*)(op + bj * HALF)); __builtin_nontemporal_store(y1, (f32x4*)(op + bj * HALF + 4)); } }
                    if (YB) { s += __shfl_xor(s, 16); s += __shfl_xor(s, 32);
                        if (fq == 0) __hip_atomic_fetch_add(ssq + row, s, __ATOMIC_RELAXED, __HIP_MEMORY_SCOPE_AGENT); }
                } }
    }
};
struct EpiRelu2N {
    static constexpr bool PERM = true, AFTER_DRAIN = false;
    bf16_t* O; int ldc; const float* ssq; float eps;
    __device__ __forceinline__ void operator()(const f32x4 (&acc)[2][2][4][2], const Unit& u, int wr, int wc, int fr, int fq) const {
        const int row0 = u.pm * BM + wr * 64 + fr;
        bf16_t* const tile0 = O + ((size_t)u.pm * (ldc >> 6) + u.pn * 4 + (wc >> 1)) * 16384 + (wc & 1) * 32 + 8 * fq;
#pragma unroll
        for (int ai = 0; ai < 2; ++ai)
#pragma unroll
            for (int m = 0; m < 4; ++m) { const int row = row0 + ai * HALF + m * 16; bf16_t* rowp = tile0 + (wr * 64 + fr + ai * HALF + m * 16) * 64;
                const float r = 1.0f / sqrtf(__hip_atomic_load(ssq + row, __ATOMIC_RELAXED, __HIP_MEMORY_SCOPE_AGENT) * (1.f / 4096.f) + eps);
#pragma unroll
                for (int bj = 0; bj < 2; ++bj) { f32x4 v0 = acc[ai][bj][m][0], v1 = acc[ai][bj][m][1];
#pragma unroll
                    for (int e = 0; e < 4; ++e) { const float a = fmaxf(v0[e], 0.f) * r, b = fmaxf(v1[e], 0.f) * r; v0[e] = a * a; v1[e] = b * b; }
                    u32x4 w; w.x = cvt_pk_bf16(v0[0], v0[1]); w.y = cvt_pk_bf16(v0[2], v0[3]); w.z = cvt_pk_bf16(v1[0], v1[1]); w.w = cvt_pk_bf16(v1[2], v1[3]);
                    *(u32x4*)(rowp + bj * 2 * 16384) = w; } }
    }
};
template <class T, class = void> struct has_midk { static constexpr bool value = false; };
template <class T> struct has_midk<T, typename std::enable_if<T::MIDK>::type> { static constexpr bool value = true; };
template <class Epi, class Sched, bool ALIGN_EPI = false, bool SP2 = false>
__device__ __forceinline__ void gemm_phase(PG8_LAS unsigned char* lds, const Gemm g, const Sched& S, const Epi& E) {
    int tid_o = threadIdx.x; asm volatile("" : "+v"(tid_o));
    const int tid = tid_o, wid = __builtin_amdgcn_readfirstlane(tid >> 6), lane = tid & 63, wr = wid >> 2, wc = wid & 3, fr = lane & 15, fq = lane >> 4;
    const int nt = g.K / BK, K = g.blocked ? BK : g.K;
    unsigned voffA[2], voffB[2];
#pragma unroll
    for (int i = 0; i < 2; ++i) { int R, C; stage_rc(tid * 16 + i * 8192, R, C); const int Rb = Epi::PERM ? ((R & ~31) + perm32(R & 31)) : R;
        voffA[i] = (unsigned)(R * K + C) * 2u; voffB[i] = (unsigned)(Rb * K + C) * 2u; }
    const size_t kstep = g.blocked ? (size_t)(BM * BK * 2) : (size_t)(BK * 2);
    const size_t hstep = (size_t)HALF * K * 2;
    const size_t tstep = (size_t)BM * g.K * 2;
    const unsigned ldsw = (unsigned)wid * 1024u;
    const int aoff = lds_byte(wr * 64 + fr, fq * 8), boff = lds_byte(wc * 32 + fr, fq * 8);
#define PG8_SA(b, h) (((b) * 2 + (h)) * HTB)
#define PG8_SB(b, h) ((4 + (b) * 2 + (h)) * HTB)
#define PG8_STAGE(bufoff, gbase, voff) do { _Pragma("unroll") for (int _i = 0; _i < 2; ++_i) \
        __builtin_amdgcn_global_load_lds((const unsigned*)((const char*)(gbase) + (voff)[_i]), (PG8_LAS unsigned*)(lds + (bufoff) + ldsw + _i * 8192), 16, 0, 0); } while (0)
#define PG8_LDA(dst, b, h) do { _Pragma("unroll") for (int m = 0; m < 4; ++m) _Pragma("unroll") for (int k = 0; k < 2; ++k) dst[m][k] = *(const PG8_LAS bf16x8*)(lds + PG8_SA(b, h) + aoff + m * 2048 + k * 1024); } while (0)
#define PG8_LDB(dst, b, h) do { _Pragma("unroll") for (int n = 0; n < 2; ++n) _Pragma("unroll") for (int k = 0; k < 2; ++k) dst[n][k] = *(const PG8_LAS bf16x8*)(lds + PG8_SB(b, h) + boff + n * 2048 + k * 1024); } while (0)
#define PG8_MMA(ai, bj, At, Bt) do { __builtin_amdgcn_s_setprio(1); _Pragma("unroll") for (int m = 0; m < 4; ++m) _Pragma("unroll") for (int n = 0; n < 2; ++n) _Pragma("unroll") for (int k = 0; k < 2; ++k) \
        acc[ai][bj][m][n] = __builtin_amdgcn_mfma_f32_16x16x32_bf16(Bt[n][k], At[m][k], acc[ai][bj][m][n], 0, 0, 0); __builtin_amdgcn_s_setprio(0); } while (0)
#define PG8_WAIT_V(n) asm volatile("s_waitcnt vmcnt(" #n ")" ::: "memory")
#define PG8_WAIT_L(n) asm volatile("s_waitcnt lgkmcnt(" #n ")" ::: "memory")
#define PG8_BAR __builtin_amdgcn_s_barrier()
#define PG8_SCHED __builtin_amdgcn_sched_barrier(0)
    Unit cur, nxt; int ui = 0;
    if (!S.next(0, cur)) return;
    f32x4 acc[2][2][4][2];
#pragma unroll
    for (int a = 0; a < 2; ++a)
#pragma unroll
        for (int b = 0; b < 2; ++b)
#pragma unroll
            for (int m = 0; m < 4; ++m)
#pragma unroll
                for (int n = 0; n < 2; ++n) acc[a][b][m][n] = (f32x4){0.f, 0.f, 0.f, 0.f};
    bf16x8 At[4][2], B0[2][2], B1[2][2];
    const char* cA = (const char*)g.A + (size_t)cur.pm * tstep + (size_t)cur.kt0 * kstep; const char* cB = (const char*)g.Bt + (size_t)cur.pn * tstep + (size_t)cur.kt0 * kstep;
    int cnt = cur.nkt ? cur.nkt : nt;
    S.a_ready(cur);
    if constexpr (SP2) {
        PG8_STAGE(PG8_SB(0, 0), cB, voffB); PG8_STAGE(PG8_SB(0, 1), cB + hstep, voffB); PG8_STAGE(PG8_SA(0, 0), cA, voffA); PG8_STAGE(PG8_SA(0, 1), cA + hstep, voffA);
        if (wr == 1) PG8_BAR;
        PG8_WAIT_V(2); PG8_BAR;
        PG8_STAGE(PG8_SB(1, 0), cB + kstep, voffB); PG8_STAGE(PG8_SA(1, 0), cA + kstep, voffA); PG8_STAGE(PG8_SB(1, 1), cB + hstep + kstep, voffB);
        PG8_WAIT_V(6); PG8_BAR;
    } else {
        PG8_STAGE(PG8_SB(0, 0), cB, voffB); PG8_STAGE(PG8_SA(0, 0), cA, voffA); PG8_STAGE(PG8_SB(0, 1), cB + hstep, voffB); PG8_STAGE(PG8_SA(0, 1), cA + hstep, voffA);
        if (wr == 1) PG8_BAR;
        PG8_WAIT_V(4); PG8_BAR;
        PG8_STAGE(PG8_SB(1, 0), cB + kstep, voffB); PG8_STAGE(PG8_SA(1, 0), cA + kstep, voffA); PG8_STAGE(PG8_SB(1, 1), cB + hstep + kstep, voffB);
        PG8_WAIT_V(6); PG8_BAR;
    }
    for (;;) {
        const bool has_next = S.next(ui + 1, nxt);
        const char* nA = has_next ? (const char*)g.A + (size_t)nxt.pm * tstep + (size_t)nxt.kt0 * kstep : cA; const char* nB = has_next ? (const char*)g.Bt + (size_t)nxt.pn * tstep + (size_t)nxt.kt0 * kstep : cB;
        for (int t = 0; t < cnt; t += 2) {
            const bool last = (t == cnt - 2);
            const char* a1 = cA + (size_t)(t + 1) * kstep;
            const char* a2 = last ? nA : cA + (size_t)(t + 2) * kstep; const char* b2 = last ? nB : cB + (size_t)(t + 2) * kstep;
            const char* a3 = a2 + kstep; const char* b3 = b2 + kstep;
            if (last && has_next) S.a_ready(nxt);
            if constexpr (SP2) {
            PG8_LDB(B0, 0, 0); PG8_LDB(B1, 0, 1); PG8_SCHED; PG8_LDA(At, 0, 0); PG8_STAGE(PG8_SA(1, 1), a1 + hstep, voffA);
            PG8_WAIT_V(8); PG8_WAIT_L(0); PG8_BAR; PG8_MMA(0, 0, At, B0); PG8_MMA(0, 1, At, B1); PG8_BAR; PG8_SCHED;
            PG8_LDA(At, 0, 1); PG8_STAGE(PG8_SB(0, 0), b2, voffB); PG8_STAGE(PG8_SB(0, 1), b2 + hstep, voffB); PG8_STAGE(PG8_SA(0, 0), a2, voffA);
            PG8_WAIT_V(8); PG8_WAIT_L(0); PG8_BAR; PG8_MMA(1, 0, At, B0); PG8_MMA(1, 1, At, B1); PG8_BAR; PG8_SCHED;
            PG8_LDB(B0, 1, 0); PG8_LDB(B1, 1, 1); PG8_SCHED; PG8_LDA(At, 1, 0); PG8_STAGE(PG8_SA(0, 1), a2 + hstep, voffA);
            PG8_WAIT_V(8); PG8_WAIT_L(0); PG8_BAR; PG8_MMA(0, 0, At, B0); PG8_MMA(0, 1, At, B1); PG8_BAR; PG8_SCHED;
            PG8_LDA(At, 1, 1); PG8_STAGE(PG8_SB(1, 0), b3, voffB); PG8_STAGE(PG8_SB(1, 1), b3 + hstep, voffB); PG8_STAGE(PG8_SA(1, 0), a3, voffA);
            PG8_WAIT_V(8); PG8_WAIT_L(0); PG8_BAR; PG8_MMA(1, 0, At, B0); PG8_MMA(1, 1, At, B1); PG8_BAR; PG8_SCHED;
            } else {
            PG8_LDB(B0, 0, 0); PG8_SCHED; PG8_LDA(At, 0, 0); PG8_STAGE(PG8_SA(1, 1), a1 + hstep, voffA);
            PG8_WAIT_L(8); PG8_BAR; PG8_WAIT_L(0); PG8_MMA(0, 0, At, B0); PG8_BAR; PG8_SCHED;
            PG8_LDB(B1, 0, 1); PG8_STAGE(PG8_SB(0, 0), b2, voffB);
            PG8_BAR; PG8_WAIT_L(0); PG8_MMA(0, 1, At, B1); PG8_BAR;
            PG8_LDA(At, 0, 1); PG8_STAGE(PG8_SA(0, 0), a2, voffA);
            PG8_BAR; PG8_WAIT_L(0); PG8_MMA(1, 0, At, B0); PG8_BAR; PG8_SCHED;
            PG8_STAGE(PG8_SB(0, 1), b2 + hstep, voffB);
            PG8_WAIT_V(6); PG8_BAR; PG8_MMA(1, 1, At, B1); PG8_BAR;
            PG8_LDB(B0, 1, 0); PG8_SCHED; PG8_LDA(At, 1, 0); PG8_STAGE(PG8_SA(0, 1), a2 + hstep, voffA);
            PG8_WAIT_L(8); PG8_BAR; PG8_WAIT_L(0); PG8_MMA(0, 0, At, B0); PG8_BAR; PG8_SCHED;
            PG8_LDB(B1, 1, 1); PG8_STAGE(PG8_SB(1, 0), b3, voffB);
            PG8_BAR; PG8_WAIT_L(0); PG8_MMA(0, 1, At, B1); PG8_BAR;
            PG8_LDA(At, 1, 1); PG8_STAGE(PG8_SA(1, 0), a3, voffA);
            PG8_BAR; PG8_WAIT_L(0); PG8_MMA(1, 0, At, B0); PG8_BAR; PG8_SCHED;
            PG8_STAGE(PG8_SB(1, 1), b3 + hstep, voffB);
            PG8_WAIT_V(6); PG8_BAR; PG8_MMA(1, 1, At, B1); PG8_BAR;
            }
        }
        if constexpr (ALIGN_EPI) { if (wr == 0) PG8_BAR; }
        if constexpr (!Epi::AFTER_DRAIN) {
            if (cur.part == -2) { if constexpr (has_midk<Epi>::value) E.mid(acc, cur, wr, wc, fr, fq); }
            else if (cur.part >= 0) {
                f32x4* sp = (f32x4*)(g.slab + (size_t)cur.part * 65536) + (size_t)wid * 2048 + lane;
#pragma unroll
                for (int a = 0; a < 2; ++a)
#pragma unroll
                    for (int b = 0; b < 2; ++b)
#pragma unroll
                        for (int m = 0; m < 4; ++m)
#pragma unroll
                            for (int n = 0; n < 2; ++n) sp[(((a * 2 + b) * 4 + m) * 2 + n) * 64] = acc[a][b][m][n];
            } else E(acc, cur, wr, wc, fr, fq);
            S.done(cur); }
        if (!has_next) break;
        if (cur.part != -2) {
#pragma unroll
        for (int a = 0; a < 2; ++a)
#pragma unroll
            for (int b = 0; b < 2; ++b)
#pragma unroll
                for (int m = 0; m < 4; ++m)
#pragma unroll
                    for (int n = 0; n < 2; ++n) acc[a][b][m][n] = (f32x4){0.f, 0.f, 0.f, 0.f};
        }
        cur = nxt; cA = nA; cB = nB; ++ui; cnt = cur.nkt ? cur.nkt : nt;
        if constexpr (ALIGN_EPI) { if (wr == 1) PG8_BAR; }
    }
    PG8_WAIT_V(0);
    if constexpr (!ALIGN_EPI) { if (wr == 0) PG8_BAR; }
    PG8_BAR;
    if constexpr (Epi::AFTER_DRAIN) { E.fused(acc, cur, wr, wc, fr, fq, lds, wid, lane); S.done(cur); }
#undef PG8_SA
#undef PG8_SB
#undef PG8_STAGE
#undef PG8_LDA
#undef PG8_LDB
#undef PG8_MMA
#undef PG8_WAIT_V
#undef PG8_WAIT_L
#undef PG8_BAR
#undef PG8_SCHED
}
}
namespace att {
typedef short bf16x8 __attribute__((ext_vector_type(8)));
typedef short s16x4 __attribute__((ext_vector_type(4)));
typedef float f32x16 __attribute__((ext_vector_type(16)));
typedef unsigned u32x4 __attribute__((ext_vector_type(4)));
typedef float f32x4 __attribute__((ext_vector_type(4)));
typedef unsigned short bf16;
#define ALAS __attribute__((address_space(3)))
#ifndef ATT_SSQ_ATOMICS
#define ATT_SSQ_ATOMICS 0
#endif
constexpr int OFF_V = 0, OFF_K = 32768, OFF_R = 65536, OFF_WS = 81920, OFF_FLG = 81920 + 8 * 256, ATT_LDS_BYTES = OFF_FLG + 64;
constexpr float SB_DEAD = -150.f;
#define KSWZ(row, colB) ((row) * 256 + ((colB) ^ (((row) & 15) << 4)))
#define RSWZ(row, colB) ((row) * 128 + ((colB) ^ ((((row) >> 1) & 7) << 4)))
__device__ __forceinline__ int v_st(int k, int c) { const int kk = (k & ~0xC) | ((k & 4) << 1) | ((k & 8) >> 1); return ((kk >> 3) * 4 + (c >> 5)) * 512 + ((kk & 7) * 32 + (c & 31)) * 2; }
__device__ __forceinline__ int v_rd_base(int lane) { return ((lane & 3) << 3) | (((lane >> 2) & 3) << 6) | (((lane >> 4) & 1) << 5) | (((lane >> 5) & 1) << 8); }
__device__ __forceinline__ int crow(int r, int hi) { return (r & 3) + 8 * (r >> 2) + 4 * hi; }
__device__ __forceinline__ unsigned cvtpk(float lo, float hi) { unsigned r; asm volatile("v_cvt_pk_bf16_f32 %0, %1, %2" : "=v"(r) : "v"(lo), "v"(hi)); return r; }

struct Unit { const bf16* Q; int ldq; const bf16* K; const bf16* Kr; const bf16* V; bf16* O; int ldo; float* ssq; int P0; int NT; int nact;
              const float* Kf0; const float* Vf0; const float* Kf1; const float* Vf1; int split; };

__device__ __forceinline__ void qk128(f32x16& p0, f32x16& p1, ALAS const char* Kt, int r32, int hi, const bf16x8* qr) {
#pragma unroll
    for (int d0 = 0; d0 < 8; ++d0) { ALAS const char* a = Kt + KSWZ(r32, (d0 * 16 + hi * 8) * 2);
        const bf16x8 b0 = *(ALAS const bf16x8*)a; const bf16x8 b1 = *(ALAS const bf16x8*)(a + 32 * 256);
        p0 = __builtin_amdgcn_mfma_f32_32x32x16_bf16(b0, qr[d0], p0, 0, 0, 0);
        p1 = __builtin_amdgcn_mfma_f32_32x32x16_bf16(b1, qr[d0], p1, 0, 0, 0); }
}
__device__ __forceinline__ void qk64(f32x16& p0, f32x16& p1, ALAS const char* Kt, int r32, int hi, const bf16x8* qr) {
#pragma unroll
    for (int d0 = 0; d0 < 4; ++d0) { ALAS const char* a = Kt + RSWZ(r32, (d0 * 16 + hi * 8) * 2);
        const bf16x8 b0 = *(ALAS const bf16x8*)a; const bf16x8 b1 = *(ALAS const bf16x8*)(a + 32 * 128);
        p0 = __builtin_amdgcn_mfma_f32_32x32x16_bf16(b0, qr[d0], p0, 0, 0, 0);
        p1 = __builtin_amdgcn_mfma_f32_32x32x16_bf16(b1, qr[d0], p1, 0, 0, 0); }
}
__device__ __forceinline__ void pv_tile(f32x16* o, unsigned vb0, bf16x8 pa0, bf16x8 pa1, bf16x8 pa2, bf16x8 pa3) {
#define TRRD(dst, off) asm volatile("ds_read_b64_tr_b16 %0, %1 offset:%2" : "=&v"(dst) : "v"(vb0), "i"(off) : "memory")
#define PV_LD(S, d0) do { constexpr int b_ = (d0) * 512; \
        TRRD(S##l0, b_); TRRD(S##h0, b_ + 2048); TRRD(S##l1, b_ + 4096); TRRD(S##h1, b_ + 6144); TRRD(S##l2, b_ + 8192); TRRD(S##h2, b_ + 10240); TRRD(S##l3, b_ + 12288); TRRD(S##h3, b_ + 14336); } while (0)
#define PV_MM(S, d0) do { \
        o[d0] = __builtin_amdgcn_mfma_f32_32x32x16_bf16(pa0, (bf16x8){S##l0[0], S##l0[1], S##l0[2], S##l0[3], S##h0[0], S##h0[1], S##h0[2], S##h0[3]}, o[d0], 0, 0, 0); \
        o[d0] = __builtin_amdgcn_mfma_f32_32x32x16_bf16(pa1, (bf16x8){S##l1[0], S##l1[1], S##l1[2], S##l1[3], S##h1[0], S##h1[1], S##h1[2], S##h1[3]}, o[d0], 0, 0, 0); \
        o[d0] = __builtin_amdgcn_mfma_f32_32x32x16_bf16(pa2, (bf16x8){S##l2[0], S##l2[1], S##l2[2], S##l2[3], S##h2[0], S##h2[1], S##h2[2], S##h2[3]}, o[d0], 0, 0, 0); \
        o[d0] = __builtin_amdgcn_mfma_f32_32x32x16_bf16(pa3, (bf16x8){S##l3[0], S##l3[1], S##l3[2], S##l3[3], S##h3[0], S##h3[1], S##h3[2], S##h3[3]}, o[d0], 0, 0, 0); } while (0)
#define PV_WAIT(n) do { asm volatile("s_waitcnt lgkmcnt(" #n ")" ::: "memory"); __builtin_amdgcn_sched_barrier(0); } while (0)
    s16x4 Al0, Al1, Al2, Al3, Ah0, Ah1, Ah2, Ah3, Bl0, Bl1, Bl2, Bl3, Bh0, Bh1, Bh2, Bh3;
    PV_LD(A, 0); PV_LD(B, 1); PV_WAIT(8); PV_MM(A, 0);
    __builtin_amdgcn_sched_barrier(0); PV_LD(A, 2); PV_WAIT(8); PV_MM(B, 1);
    __builtin_amdgcn_sched_barrier(0); PV_LD(B, 3); PV_WAIT(8); PV_MM(A, 2);
    PV_WAIT(0); PV_MM(B, 3);
#undef PV_WAIT
#undef PV_MM
#undef PV_LD
#undef TRRD
}
#define PK4(P, B_, OUT) do { const unsigned a0_ = cvtpk(P[B_ + 0], P[B_ + 1]), a1_ = cvtpk(P[B_ + 2], P[B_ + 3]); \
        const unsigned b0_ = cvtpk(P[B_ + 4], P[B_ + 5]), b1_ = cvtpk(P[B_ + 6], P[B_ + 7]); \
        auto r0_ = __builtin_amdgcn_permlane32_swap(a0_, b0_, false, false); auto r1_ = __builtin_amdgcn_permlane32_swap(a1_, b1_, false, false); \
        u32x4 w_ = {r0_[0], r1_[0], r0_[1], r1_[1]}; OUT = __builtin_bit_cast(bf16x8, w_); } while (0)

__device__ __forceinline__ void store_o_staged(const f32x16* o, const float* rli, bf16* Ow, int ldo, ALAS char* stg, int lane, int r32, int hi, float* ssqp) {
    ALAS unsigned short* s16 = (ALAS unsigned short*)stg;
#pragma unroll
    for (int r = 0; r < 16; ++r) { const int orow = crow(r, hi);
#pragma unroll
        for (int d0 = 0; d0 < 4; ++d0) { const float v = o[d0][r] * rli[r]; s16[orow * 128 + d0 * 32 + r32] = (unsigned short)cvtpk(v, v); } }
    asm volatile("s_waitcnt lgkmcnt(0)" ::: "memory");
#pragma unroll
    for (int i = 0; i < 8; ++i) { const int idx = i * 64 + lane, row = idx >> 4, ch = idx & 15;
        const u32x4 w = *(ALAS const u32x4*)(stg + row * 256 + ch * 16);
        *(u32x4*)(Ow + (size_t)row * ldo + ch * 8) = w;
        float s = 0.f; { const unsigned ww[4] = {w.x, w.y, w.z, w.w};
#pragma unroll
            for (int e = 0; e < 4; ++e) { const float x0 = __uint_as_float(ww[e] << 16), x1 = __uint_as_float(ww[e] & 0xffff0000u); s += x0 * x0 + x1 * x1; } }
        s += __shfl_xor(s, 1); s += __shfl_xor(s, 2); s += __shfl_xor(s, 4); s += __shfl_xor(s, 8);
        if (ch == 0) ssqp[(size_t)row * 32] = s; }
}
template <bool MLA>
__device__ __forceinline__ void attn_unit(const Unit u, ALAS char* lds) {
    int tid_o = threadIdx.x; asm volatile("" : "+v"(tid_o));
    const int tid = tid_o, wid = __builtin_amdgcn_readfirstlane(tid >> 6), lane = tid & 63, r32 = lane & 31, hi = lane >> 5;
    const bool actw = wid < u.nact;
    const int sr = tid >> 4, sc = (tid & 15) * 8;
    const int vst0 = v_st(sr, sc), vst1 = v_st(32 + sr, sc), kws = KSWZ(sr, sc * 2);
    const int rk = tid >> 3, rc = (tid & 7) * 8, rws = RSWZ(rk, rc * 2);
    ALAS char* V_l = lds + OFF_V; ALAS char* K_l = lds + OFF_K; ALAS char* R_l = lds + OFF_R;
    ALAS float* al_l = (ALAS float*)(lds + OFF_WS) + wid * 64; ALAS float* li_l = al_l + 32;
    const unsigned vbase = (unsigned)(uintptr_t)V_l + (unsigned)v_rd_base(lane);
    constexpr int NQ = MLA ? 12 : 8;
    bf16x8 qr[NQ];
#pragma unroll
    for (int d0 = 0; d0 < NQ; ++d0) qr[d0] = (bf16x8){0, 0, 0, 0, 0, 0, 0, 0};
    if (actw) {
#pragma unroll
        for (int d0 = 0; d0 < NQ; ++d0) qr[d0] = *(const bf16x8*)(u.Q + (size_t)(wid * 32 + r32) * u.ldq + d0 * 16 + hi * 8);
    }
    const int cw = (u.P0 + wid * 32) >> 6;
    const int qpos = u.P0 + wid * 32 + r32;
    float m_reg = -1e30f, l_reg = 0.f, carry = 0.f; bool fin = false;
    ALAS unsigned* flg = (ALAS unsigned*)(lds + OFF_FLG);
    f32x16 o[4];
#pragma unroll
    for (int d = 0; d < 4; ++d)
#pragma unroll
        for (int r = 0; r < 16; ++r) o[d][r] = 0.f;
    bf16x8 st_k0, st_k1, st_v0, st_v1, st_r = (bf16x8){0, 0, 0, 0, 0, 0, 0, 0};
    f32x4 fk[4], fv[4];
#define LOADT(tt) do { if (!MLA) { const int t_ = (tt); const bool lo_ = t_ < u.split; const size_t ro_ = (size_t)(lo_ ? t_ : t_ - u.split) * 64 * 2048; \
            const float* kb_ = (lo_ ? u.Kf0 : u.Kf1) + ro_ + (size_t)sr * 2048 + sc; const float* vb_ = (lo_ ? u.Vf0 : u.Vf1) + ro_ + (size_t)sr * 2048 + sc; \
            fk[0] = *(const f32x4*)kb_; fk[1] = *(const f32x4*)(kb_ + 4); fk[2] = *(const f32x4*)(kb_ + 32 * 2048); fk[3] = *(const f32x4*)(kb_ + 32 * 2048 + 4); \
            fv[0] = *(const f32x4*)vb_; fv[1] = *(const f32x4*)(vb_ + 4); fv[2] = *(const f32x4*)(vb_ + 32 * 2048); fv[3] = *(const f32x4*)(vb_ + 32 * 2048 + 4); } else { \
        const size_t r0_ = (size_t)(tt) * 64; \
        st_k0 = *(const bf16x8*)(u.K + (r0_ + sr) * 2048 + sc); st_k1 = *(const bf16x8*)(u.K + (r0_ + 32 + sr) * 2048 + sc); \
        st_v0 = *(const bf16x8*)(u.V + (r0_ + sr) * 2048 + sc); st_v1 = *(const bf16x8*)(u.V + (r0_ + 32 + sr) * 2048 + sc); \
        if (MLA) st_r = *(const bf16x8*)(u.Kr + (r0_ + rk) * 64 + rc); } } while (0)
    LOADT(MLA ? 0 : (u.NT - 1));
    for (int i = 0; i < u.NT; ++i) {
        const int t = MLA ? i : (u.NT - 1 - i); const int buf = i & 1;
        if (!MLA) { u32x4 w_;
            w_ = (u32x4){cvtpk(fk[0][0], fk[0][1]), cvtpk(fk[0][2], fk[0][3]), cvtpk(fk[1][0], fk[1][1]), cvtpk(fk[1][2], fk[1][3])}; st_k0 = __builtin_bit_cast(bf16x8, w_);
            w_ = (u32x4){cvtpk(fk[2][0], fk[2][1]), cvtpk(fk[2][2], fk[2][3]), cvtpk(fk[3][0], fk[3][1]), cvtpk(fk[3][2], fk[3][3])}; st_k1 = __builtin_bit_cast(bf16x8, w_);
            w_ = (u32x4){cvtpk(fv[0][0], fv[0][1]), cvtpk(fv[0][2], fv[0][3]), cvtpk(fv[1][0], fv[1][1]), cvtpk(fv[1][2], fv[1][3])}; st_v0 = __builtin_bit_cast(bf16x8, w_);
            w_ = (u32x4){cvtpk(fv[2][0], fv[2][1]), cvtpk(fv[2][2], fv[2][3]), cvtpk(fv[3][0], fv[3][1]), cvtpk(fv[3][2], fv[3][3])}; st_v1 = __builtin_bit_cast(bf16x8, w_); }
        *(ALAS bf16x8*)(K_l + buf * 16384 + kws) = st_k0; *(ALAS bf16x8*)(K_l + buf * 16384 + kws + 32 * 256) = st_k1;
        *(ALAS bf16x8*)(V_l + buf * 16384 + vst0) = st_v0; *(ALAS bf16x8*)(V_l + buf * 16384 + vst1) = st_v1;
        if (MLA) *(ALAS bf16x8*)(R_l + buf * 8192 + rws) = st_r;
        if (!MLA) { if (lane == 0) flg[buf * 8 + wid] = (fin || !actw) ? 1u : 0u; }
        __syncthreads();
        if (!MLA) {
            const u32x4 fa = *(ALAS const u32x4*)(flg + buf * 8), fb = *(ALAS const u32x4*)(flg + buf * 8 + 4);
            if ((fa.x & fa.y & fa.z & fa.w & fb.x & fb.y & fb.z & fb.w) != 0u) break;
        }
        if (i + 1 < u.NT) LOADT(MLA ? (i + 1) : (u.NT - 2 - i));
        if (actw && t <= cw && !fin) {
            f32x16 p0, p1;
#pragma unroll
            for (int r = 0; r < 16; ++r) { p0[r] = 0.f; p1[r] = 0.f; }
            qk128(p0, p1, K_l + buf * 16384, r32, hi, qr);
            if (MLA) qk64(p0, p1, R_l + buf * 8192, r32, hi, qr + (MLA ? 8 : 0));
            bf16x8 pa0, pa1, pa2, pa3;
            if (MLA) {
                float pmax = p0[0];
#pragma unroll
                for (int r = 1; r < 16; ++r) pmax = fmaxf(pmax, p0[r]);
#pragma unroll
                for (int r = 0; r < 16; ++r) pmax = fmaxf(pmax, p1[r]);
                { auto rr = __builtin_amdgcn_permlane32_swap(__float_as_uint(pmax), __float_as_uint(pmax), false, false);
                  pmax = fmaxf(__uint_as_float(rr[0]), __uint_as_float(rr[1])); }
                const float mn = fmaxf(m_reg, pmax); const float alpha = __builtin_amdgcn_exp2f(m_reg - mn); m_reg = mn;
                float ps = 0.f;
#pragma unroll
                for (int r = 0; r < 16; ++r) { p0[r] = __builtin_amdgcn_exp2f(p0[r] - mn); ps += p0[r]; }
#pragma unroll
                for (int r = 0; r < 16; ++r) { p1[r] = __builtin_amdgcn_exp2f(p1[r] - mn); ps += p1[r]; }
                { auto rr = __builtin_amdgcn_permlane32_swap(__float_as_uint(ps), __float_as_uint(ps), false, false);
                  ps = __uint_as_float(rr[0]) + __uint_as_float(rr[1]); }
                l_reg = l_reg * alpha + ps;
                if (__any(alpha < 1.f)) {
                    if (hi == 0) al_l[r32] = alpha;
                    asm volatile("s_waitcnt lgkmcnt(0)" ::: "memory");
#pragma unroll
                    for (int r = 0; r < 16; ++r) { const float a = al_l[crow(r, hi)];
#pragma unroll
                        for (int d = 0; d < 4; ++d) o[d][r] *= a; }
                    asm volatile("s_waitcnt lgkmcnt(0)" ::: "memory");
                }
            } else {
                const bool diag = (t == cw); const int dq = qpos - 64 * t - 4 * hi; const float NEG = -__builtin_inff();
                float suf = carry;
#define SB_HALF(P, KOFF) do { f32x16 f_; \
                    _Pragma("unroll") for (int r = 0; r < 16; ++r) { const float y = P[r]; const float e = __builtin_amdgcn_exp2f(-fabsf(y)); const float l2 = __builtin_amdgcn_logf(1.f + e); \
                        const float lb = fminf(y, 0.f) - l2; P[r] = lb; f_[r] = lb - y; } \
                    if (diag) { _Pragma("unroll") for (int r = 0; r < 16; ++r) { const int c = (r & 3) + 8 * (r >> 2) + (KOFF); if (!(c < dq)) { P[r] = NEG; f_[r] = 0.f; } } } \
                    float tg_[4], pg_[4]; \
                    _Pragma("unroll") for (int g = 0; g < 4; ++g) { const float a = (f_[4 * g] + f_[4 * g + 1]) + (f_[4 * g + 2] + f_[4 * g + 3]); \
                        auto rr = __builtin_amdgcn_permlane32_swap(__float_as_uint(a), __float_as_uint(a), false, false); \
                        const float lo = __uint_as_float(rr[0]), hh = __uint_as_float(rr[1]); tg_[g] = lo + hh; pg_[g] = hi == 0 ? hh : 0.f; } \
                    _Pragma("unroll") for (int g = 3; g >= 0; --g) { const float base = suf + pg_[g]; \
                        const float s2 = f_[4 * g + 3], s1 = s2 + f_[4 * g + 2], s0 = s1 + f_[4 * g + 1]; \
                        P[4 * g + 3] = __builtin_amdgcn_exp2f(P[4 * g + 3] + base); P[4 * g + 2] = __builtin_amdgcn_exp2f(P[4 * g + 2] + (base + s2)); \
                        P[4 * g + 1] = __builtin_amdgcn_exp2f(P[4 * g + 1] + (base + s1)); P[4 * g] = __builtin_amdgcn_exp2f(P[4 * g] + (base + s0)); \
                        suf += tg_[g]; } } while (0)
                SB_HALF(p1, 32);
                PK4(p1, 0, pa2); PK4(p1, 8, pa3);
                SB_HALF(p0, 0);
                PK4(p0, 0, pa0); PK4(p0, 8, pa1);
#undef SB_HALF
                carry = suf;
                fin = __all(carry < SB_DEAD);
            }
            if (MLA) { PK4(p0, 0, pa0); PK4(p0, 8, pa1); PK4(p1, 0, pa2); PK4(p1, 8, pa3); }
            pv_tile(o, vbase + (unsigned)(buf * 16384), pa0, pa1, pa2, pa3);
        }
    }
    __syncthreads();
    if (actw) {
        float rli[16];
        if (MLA) {
            if (hi == 0) li_l[r32] = l_reg;
            asm volatile("s_waitcnt lgkmcnt(0)" ::: "memory");
#pragma unroll
            for (int r = 0; r < 16; ++r) rli[r] = 1.0f / li_l[crow(r, hi)];
        } else {
#pragma unroll
            for (int r = 0; r < 16; ++r) rli[r] = 1.0f;
        }
        store_o_staged(o, rli, u.O + (size_t)(wid * 32) * u.ldo, u.ldo, lds + wid * 8192, lane, r32, hi, u.ssq + (size_t)(wid * 32) * 32);
    }
    __syncthreads();
#undef LOADT
}

__device__ __forceinline__ void qk192_pipe(f32x16& p0, f32x16& p1, ALAS const char* Kt, ALAS const char* Rt, int r32, int hi, const bf16x8* qr, const f32x16* cinit = nullptr) {
    constexpr int PF = 2;
    bf16x8 fa[12], fb[12];
#define QK_ADDR(s) ((s) < 8 ? Kt + KSWZ(r32, ((s) * 16 + hi * 8) * 2) : Rt + RSWZ(r32, (((s) - 8) * 16 + hi * 8) * 2))
#define QK_LD(s) do { ALAS const char* a_ = QK_ADDR(s); fa[s] = *(ALAS const bf16x8*)a_; fb[s] = *(ALAS const bf16x8*)(a_ + ((s) < 8 ? 32 * 256 : 32 * 128)); } while (0)
#pragma unroll
    for (int s = 0; s < PF; ++s) QK_LD(s);
#pragma unroll
    for (int s = 0; s < 12; ++s) {
        if (s + PF < 12) QK_LD(s + PF);
        __builtin_amdgcn_sched_barrier(0);
        p0 = __builtin_amdgcn_mfma_f32_32x32x16_bf16(fa[s], qr[s], (s == 0 && cinit) ? *cinit : p0, 0, 0, 0);
        p1 = __builtin_amdgcn_mfma_f32_32x32x16_bf16(fb[s], qr[s], (s == 0 && cinit) ? *cinit : p1, 0, 0, 0);
        __builtin_amdgcn_sched_barrier(0);
    }
#undef QK_LD
#undef QK_ADDR
}
constexpr float MLA_THR = 8.f;
__device__ __forceinline__ void mla_softmax(f32x16& p0, f32x16& p1, float& m_reg, float& l_reg, f32x16* o, ALAS float* al_l, int r32, int hi, bf16x8& pa0, bf16x8& pa1, bf16x8& pa2, bf16x8& pa3) {
    float pmax = p0[0];
#pragma unroll
    for (int r = 1; r < 16; ++r) pmax = fmaxf(pmax, p0[r]);
#pragma unroll
    for (int r = 0; r < 16; ++r) pmax = fmaxf(pmax, p1[r]);
    { auto rr = __builtin_amdgcn_permlane32_swap(__float_as_uint(pmax), __float_as_uint(pmax), false, false);
      pmax = fmaxf(__uint_as_float(rr[0]), __uint_as_float(rr[1])); }
    float mn = m_reg, alpha = 1.f;
    if (!__all(pmax - m_reg <= MLA_THR)) { mn = fmaxf(m_reg, pmax); alpha = __builtin_amdgcn_exp2f(m_reg - mn); m_reg = mn; }
    float ps = 0.f;
#pragma unroll
    for (int r = 0; r < 16; ++r) { p0[r] = __builtin_amdgcn_exp2f(p0[r] - mn); ps += p0[r]; }
#pragma unroll
    for (int r = 0; r < 16; ++r) { p1[r] = __builtin_amdgcn_exp2f(p1[r] - mn); ps += p1[r]; }
    { auto rr = __builtin_amdgcn_permlane32_swap(__float_as_uint(ps), __float_as_uint(ps), false, false);
      ps = __uint_as_float(rr[0]) + __uint_as_float(rr[1]); }
    l_reg = l_reg * alpha + ps;
    if (__any(alpha < 1.f)) {
        if (hi == 0) al_l[r32] = alpha;
        asm volatile("s_waitcnt lgkmcnt(0)" ::: "memory");
#pragma unroll
        for (int r = 0; r < 16; ++r) { const float a = al_l[crow(r, hi)];
#pragma unroll
            for (int d = 0; d < 4; ++d) o[d][r] *= a; }
        asm volatile("s_waitcnt lgkmcnt(0)" ::: "memory");
    }
    PK4(p0, 0, pa0); PK4(p0, 8, pa1); PK4(p1, 0, pa2); PK4(p1, 8, pa3);
}
__device__ __forceinline__ void mla_softmax_rel(f32x16& p0, f32x16& p1, float& m_reg, f32x16& negm, bool first, float& l_reg, f32x16* o, ALAS float* al_l, int r32, int hi, bf16x8& pa0, bf16x8& pa1, bf16x8& pa2, bf16x8& pa3) {
    float pmax = p0[0];
#pragma unroll
    for (int r = 1; r < 16; ++r) pmax = fmaxf(pmax, p0[r]);
#pragma unroll
    for (int r = 0; r < 16; ++r) pmax = fmaxf(pmax, p1[r]);
    { auto rr = __builtin_amdgcn_permlane32_swap(__float_as_uint(pmax), __float_as_uint(pmax), false, false);
      pmax = fmaxf(__uint_as_float(rr[0]), __uint_as_float(rr[1])); }
    if (first || !__all(pmax <= MLA_THR)) {
        const float delta = first ? pmax : fmaxf(pmax, 0.f); const float alpha = first ? 1.f : __builtin_amdgcn_exp2f(-delta);
        m_reg += delta; l_reg *= alpha;
#pragma unroll
        for (int r = 0; r < 16; ++r) { p0[r] -= delta; p1[r] -= delta; negm[r] = -m_reg; }
        if (!first) {
            if (hi == 0) al_l[r32] = alpha;
            asm volatile("s_waitcnt lgkmcnt(0)" ::: "memory");
#pragma unroll
            for (int r = 0; r < 16; ++r) { const float a = al_l[crow(r, hi)];
#pragma unroll
                for (int d = 0; d < 4; ++d) o[d][r] *= a; }
            asm volatile("s_waitcnt lgkmcnt(0)" ::: "memory");
        }
    }
    float ps = 0.f;
#pragma unroll
    for (int r = 0; r < 16; ++r) { p0[r] = __builtin_amdgcn_exp2f(p0[r]); ps += p0[r]; }
#pragma unroll
    for (int r = 0; r < 16; ++r) { p1[r] = __builtin_amdgcn_exp2f(p1[r]); ps += p1[r]; }
    { auto rr = __builtin_amdgcn_permlane32_swap(__float_as_uint(ps), __float_as_uint(ps), false, false);
      ps = __uint_as_float(rr[0]) + __uint_as_float(rr[1]); }
    l_reg += ps;
    PK4(p0, 0, pa0); PK4(p0, 8, pa1); PK4(p1, 0, pa2); PK4(p1, 8, pa3);
}
constexpr int M_OFF_V = 0, M_OFF_K = 49152, M_OFF_R = 81920, M_OFF_WS = 98304, MLA_LDS_BYTES = 98304 + 8 * 256;
template <bool ROLEB, int VAR = 0> __device__ __forceinline__ void mla_body(const Unit u, ALAS char* lds) {
    int tid_o = threadIdx.x; asm volatile("" : "+v"(tid_o));
    const int tid = tid_o, wid = __builtin_amdgcn_readfirstlane(tid >> 6), lane = tid & 63, r32 = lane & 31, hi = lane >> 5;
    const bool actw = wid < u.nact; constexpr bool roleB = ROLEB;
    const int sr = tid >> 4, sc = (tid & 15) * 8;
    const int vst0 = v_st(sr, sc), vst1 = v_st(32 + sr, sc), kws = KSWZ(sr, sc * 2);
    const int rk = tid >> 3, rc = (tid & 7) * 8, rws = RSWZ(rk, rc * 2);
    ALAS char* V_l = lds + M_OFF_V; ALAS char* K_l = lds + M_OFF_K; ALAS char* R_l = lds + M_OFF_R;
    ALAS float* al_l = (ALAS float*)(lds + M_OFF_WS) + wid * 64; ALAS float* li_l = al_l + 32;
    const unsigned vbase = (unsigned)(uintptr_t)V_l + (unsigned)v_rd_base(lane);
    bf16x8 qr[12];
#pragma unroll
    for (int d0 = 0; d0 < 12; ++d0) qr[d0] = (bf16x8){0, 0, 0, 0, 0, 0, 0, 0};
    if (actw) {
#pragma unroll
        for (int d0 = 0; d0 < 12; ++d0) qr[d0] = *(const bf16x8*)(u.Q + (size_t)(wid * 32 + r32) * u.ldq + d0 * 16 + hi * 8);
    }
    const int cw = (u.P0 + wid * 32) >> 6;
    float m_reg = -1e30f, l_reg = 0.f;
    f32x16 o[4], p0, p1;
#pragma unroll
    for (int r = 0; r < 16; ++r) { p0[r] = 0.f; p1[r] = 0.f; }
#pragma unroll
    for (int d = 0; d < 4; ++d)
#pragma unroll
        for (int r = 0; r < 16; ++r) o[d][r] = 0.f;
    bf16x8 st_k0, st_k1, st_v0, st_v1, st_r;
#define LOADT(tt) do { const size_t r0_ = (size_t)(tt) * 64; \
        st_k0 = *(const bf16x8*)(u.K + (r0_ + sr) * 2048 + sc); st_k1 = *(const bf16x8*)(u.K + (r0_ + 32 + sr) * 2048 + sc); \
        st_v0 = *(const bf16x8*)(u.V + (r0_ + sr) * 2048 + sc); st_v1 = *(const bf16x8*)(u.V + (r0_ + 32 + sr) * 2048 + sc); \
        st_r = *(const bf16x8*)(u.Kr + (r0_ + rk) * 64 + rc); } while (0)
#define MLA_QK(kb) do { _Pragma("unroll") for (int r = 0; r < 16; ++r) { p0[r] = 0.f; p1[r] = 0.f; } \
        if (VAR == 4 || VAR == 0 || VAR == 5) qk192_pipe(p0, p1, K_l + (kb) * 16384, R_l + (kb) * 8192, r32, hi, qr); else if (VAR != 3) { qk128(p0, p1, K_l + (kb) * 16384, r32, hi, qr); qk64(p0, p1, R_l + (kb) * 8192, r32, hi, qr + 8); } } while (0)
#define MLA_SMPV(vs) do { bf16x8 pa0, pa1, pa2, pa3; \
        if (VAR == 1) { PK4(p0, 0, pa0); PK4(p0, 8, pa1); PK4(p1, 0, pa2); PK4(p1, 8, pa3); l_reg += p0[0]; } \
        else mla_softmax(p0, p1, m_reg, l_reg, o, al_l, r32, hi, pa0, pa1, pa2, pa3); \
        if (VAR != 2) pv_tile(o, vbase + (unsigned)((vs) * 16384), pa0, pa1, pa2, pa3); \
        else { _Pragma("unroll") for (int r = 0; r < 4; ++r) o[r][0] += __builtin_bit_cast(float, (unsigned)pa0[r] ^ (unsigned)pa1[r] ^ (unsigned)pa2[r] ^ (unsigned)pa3[r]); } } while (0)
    LOADT(0);
    int vs_cur = 0, vs_prev = 2;
    for (int i = 0; i <= u.NT; ++i) {
        const int kb = i & 1;
        if (i < u.NT && VAR != 5) {
            *(ALAS bf16x8*)(K_l + kb * 16384 + kws) = st_k0; *(ALAS bf16x8*)(K_l + kb * 16384 + kws + 32 * 256) = st_k1;
            *(ALAS bf16x8*)(V_l + vs_cur * 16384 + vst0) = st_v0; *(ALAS bf16x8*)(V_l + vs_cur * 16384 + vst1) = st_v1;
            *(ALAS bf16x8*)(R_l + kb * 8192 + rws) = st_r;
            __syncthreads();
            if (i + 1 < u.NT) LOADT(i + 1);
        }
        if (actw) {
            if constexpr (!roleB) { if (i < u.NT && i <= cw) { MLA_QK(kb); MLA_SMPV(vs_cur); } }
            else { if (i >= 1 && i - 1 <= cw) MLA_SMPV(vs_prev);
                   if (i < u.NT && i <= cw) MLA_QK(kb); }
        }
        vs_prev = vs_cur; vs_cur = (vs_cur == 2) ? 0 : vs_cur + 1;
    }
    if (actw) {
        if (hi == 0) li_l[r32] = l_reg;
        asm volatile("s_waitcnt lgkmcnt(0)" ::: "memory");
        float rli[16];
#pragma unroll
        for (int r = 0; r < 16; ++r) rli[r] = 1.0f / li_l[crow(r, hi)];
        bf16* Ow = u.O + (size_t)(wid * 32) * u.ldo;
#pragma unroll
        for (int r = 0; r < 16; ++r) { const int orow = crow(r, hi); float sq = 0.f;
#pragma unroll
            for (int d0 = 0; d0 < 4; ++d0) { const float v = o[d0][r] * rli[r]; const float vn = __shfl_xor(v, 1); sq += v * v;
                if ((r32 & 1) == 0) *(unsigned*)(Ow + (size_t)orow * u.ldo + d0 * 32 + r32) = cvtpk(v, vn); }
            sq += __shfl_xor(sq, 1); sq += __shfl_xor(sq, 2); sq += __shfl_xor(sq, 4); sq += __shfl_xor(sq, 8); sq += __shfl_xor(sq, 16);
            if (ATT_SSQ_ATOMICS && r32 == 0) __hip_atomic_fetch_add(u.ssq + wid * 32 + orow, sq, __ATOMIC_RELAXED, __HIP_MEMORY_SCOPE_AGENT); }
    }
    __syncthreads();
#undef LOADT
#undef MLA_QK
#undef MLA_SMPV
}
constexpr int D_OFF_K = 0, D_OFF_R = 49152, D_OFF_V = 73728, D_OFF_WS = 122880, DMA_LDS_BYTES = 122880 + 8 * 256;
template <int VAR = 0> __device__ __forceinline__ void mla_unit_dma(const Unit u, ALAS char* lds) {
    int tid_o = threadIdx.x; asm volatile("" : "+v"(tid_o));
    const int tid = tid_o, wid = __builtin_amdgcn_readfirstlane(tid >> 6), lane = tid & 63, r32 = lane & 31, hi = lane >> 5;
    const bool actw = wid < u.nact;
    if (false) __builtin_amdgcn_s_setprio(1);
    ALAS char* K_l = lds + D_OFF_K; ALAS char* R_l = lds + D_OFF_R; ALAS char* V_l = lds + D_OFF_V;
    ALAS float* al_l = (ALAS float*)(lds + D_OFF_WS) + wid * 64; ALAS float* li_l = al_l + 32;
    const unsigned vbase = (unsigned)(uintptr_t)V_l + (unsigned)v_rd_base(lane);
    unsigned offK[2], offV[2], offR;
#pragma unroll
    for (int j = 0; j < 2; ++j) {
        const int p = wid + 8 * j;
        { const int r = 4 * p + (lane >> 4), c = (lane & 15) ^ (r & 15); offK[j] = (unsigned)(r * 4096 + c * 16); }
        { const int sti = 2 * p + (lane >> 5), kk = (sti >> 2) * 8 + ((lane & 31) >> 2), k = (kk & ~0xC) | ((kk & 4) << 1) | ((kk & 8) >> 1), c = (sti & 3) * 32 + (lane & 3) * 8; offV[j] = (unsigned)(k * 4096 + c * 2); }
    }
    { const int r = 8 * wid + (lane >> 3), c = (lane & 7) ^ ((r >> 1) & 7); offR = (unsigned)(r * 128 + c * 16); }
    const char* gK = (const char*)u.K; const char* gV = (const char*)u.V; const char* gR = (const char*)u.Kr;
#define DMA_TILE(tt, slot) do { const size_t tb_ = (size_t)(tt) * 64; \
        __builtin_amdgcn_global_load_lds((const unsigned*)(gK + tb_ * 4096 + offK[0]), (ALAS unsigned*)(K_l + (slot) * 16384 + wid * 1024), 16, 0, 0); \
        __builtin_amdgcn_global_load_lds((const unsigned*)(gK + tb_ * 4096 + offK[1]), (ALAS unsigned*)(K_l + (slot) * 16384 + (wid + 8) * 1024), 16, 0, 0); \
        __builtin_amdgcn_global_load_lds((const unsigned*)(gR + tb_ * 128 + offR), (ALAS unsigned*)(R_l + (slot) * 8192 + wid * 1024), 16, 0, 0); \
        __builtin_amdgcn_global_load_lds((const unsigned*)(gV + tb_ * 4096 + offV[0]), (ALAS unsigned*)(V_l + (slot) * 16384 + wid * 1024), 16, 0, 0); \
        __builtin_amdgcn_global_load_lds((const unsigned*)(gV + tb_ * 4096 + offV[1]), (ALAS unsigned*)(V_l + (slot) * 16384 + (wid + 8) * 1024), 16, 0, 0); } while (0)
    bf16x8 qr[12];
#pragma unroll
    for (int d0 = 0; d0 < 12; ++d0) qr[d0] = (bf16x8){0, 0, 0, 0, 0, 0, 0, 0};
    if (actw) {
#pragma unroll
        for (int d0 = 0; d0 < 12; ++d0) qr[d0] = *(const bf16x8*)(u.Q + (size_t)(wid * 32 + r32) * u.ldq + d0 * 16 + hi * 8);
    }
#pragma unroll
    for (int d0 = 0; d0 < 12; ++d0) asm volatile("" : "+v"(qr[d0]));
    DMA_TILE(0, 0); if (u.NT > 1) DMA_TILE(1, 1);
    const int cw = (u.P0 + wid * 32) >> 6;
    float m_reg = 0.f, l_reg = 0.f;
    f32x16 o[4], p0, p1, negm;
#pragma unroll
    for (int r = 0; r < 16; ++r) negm[r] = 0.f;
#pragma unroll
    for (int d = 0; d < 4; ++d)
#pragma unroll
        for (int r = 0; r < 16; ++r) o[d][r] = 0.f;
    int sl = 0, sl2 = 2;
    for (int i = 0; i < u.NT; ++i) {
        if (i + 1 < u.NT) asm volatile("s_waitcnt vmcnt(5) lgkmcnt(0)" ::: "memory"); else asm volatile("s_waitcnt vmcnt(0) lgkmcnt(0)" ::: "memory");
        __builtin_amdgcn_s_barrier(); asm volatile("" ::: "memory");
        if (i + 2 < u.NT) DMA_TILE(i + 2, sl2);
        if (actw && i <= cw) {
            __builtin_amdgcn_s_setprio(1); qk192_pipe(p0, p1, K_l + sl * 16384, R_l + sl * 8192, r32, hi, qr, &negm); __builtin_amdgcn_s_setprio(0);
            bf16x8 pa0, pa1, pa2, pa3;
            mla_softmax_rel(p0, p1, m_reg, negm, i == 0, l_reg, o, al_l, r32, hi, pa0, pa1, pa2, pa3);
            __builtin_amdgcn_s_setprio(1); pv_tile(o, vbase + (unsigned)(sl * 16384), pa0, pa1, pa2, pa3); __builtin_amdgcn_s_setprio(0);
        }
        sl = (sl == 2) ? 0 : sl + 1; sl2 = (sl2 == 2) ? 0 : sl2 + 1;
    }
    asm volatile("s_waitcnt lgkmcnt(0)" ::: "memory"); __builtin_amdgcn_s_barrier(); asm volatile("" ::: "memory");
    if (actw) {
        if (hi == 0) li_l[r32] = l_reg;
        asm volatile("s_waitcnt lgkmcnt(0)" ::: "memory");
        float rli[16];
#pragma unroll
        for (int r = 0; r < 16; ++r) rli[r] = 1.0f / li_l[crow(r, hi)];
        store_o_staged(o, rli, u.O + (size_t)(wid * 32) * u.ldo, u.ldo, lds + wid * 8192, lane, r32, hi, u.ssq + (size_t)(wid * 32) * 32);
    }
    asm volatile("s_waitcnt lgkmcnt(0)" ::: "memory"); __builtin_amdgcn_s_barrier(); asm volatile("" ::: "memory");
    __builtin_amdgcn_s_setprio(0);
#undef DMA_TILE
}
template <int VAR = 0> __device__ __forceinline__ void mla_unit(const Unit u, ALAS char* lds) {
    int tid_o = threadIdx.x; asm volatile("" : "+v"(tid_o));
    if (__builtin_amdgcn_readfirstlane(tid_o >> 6) >= 4) mla_body<true, VAR>(u, lds); else mla_body<false, VAR>(u, lds);
}
#undef PK4
}
#define GAS __attribute__((address_space(1)))
#define LAS __attribute__((address_space(3)))
typedef unsigned short bf16;
typedef unsigned v4u __attribute__((ext_vector_type(4)));
typedef float f32x4 __attribute__((ext_vector_type(4)));
typedef short bf16x8 __attribute__((ext_vector_type(8)));
typedef GAS unsigned gu32;
typedef GAS unsigned long long gu64;
#define RLX_AGENT __ATOMIC_RELAXED, __HIP_MEMORY_SCOPE_AGENT
#define LDS_WAIT() asm volatile("s_waitcnt lgkmcnt(0)" ::: "memory")
#define VM_WAIT() asm volatile("s_waitcnt vmcnt(0)" ::: "memory")
__device__ __forceinline__ unsigned long long rt() { return __builtin_amdgcn_s_memrealtime(); }
__device__ __forceinline__ unsigned f2bf(float f) { unsigned u = __builtin_bit_cast(unsigned, f); return (u + 0x7fffu + ((u >> 16) & 1u)) >> 16; }
__device__ __forceinline__ unsigned pk2(float lo, float hi) { return f2bf(lo) | (f2bf(hi) << 16); }

#define XB_TMO      128
#define XB_XCNT(j)  (256  + 64 * (j))
#define XB_XSUB(j)  (1280 + 64 * (j))
#define XB_XGEN(j)  (2304 + 64 * (j))
#define XB_TOP      3328
#define XB_TOPGEN   3392
#define XCD_BAR_WORDS 3456
#define XB_SPIN_CAP (1u << 18)

__device__ __forceinline__ unsigned xb_ld(unsigned* p)              { return __hip_atomic_load(p, __ATOMIC_RELAXED, __HIP_MEMORY_SCOPE_AGENT); }
__device__ __forceinline__ unsigned xb_add(unsigned* p, unsigned v) { return __hip_atomic_fetch_add(p, v, __ATOMIC_RELAXED, __HIP_MEMORY_SCOPE_AGENT); }
__device__ __forceinline__ unsigned xb_xcc_id() { return (unsigned)__builtin_amdgcn_s_getreg((3 << 11) | 20) & 0xFu; }
#define XB_SPIN(cond, bar) do { unsigned _sp = 0; while (cond) { __builtin_amdgcn_s_sleep(1); \
    if ((++_sp & 255u) == 0u) { if (xb_ld(&(bar)[XB_TMO])) break; if (_sp > XB_SPIN_CAP) { atomicAdd(&(bar)[XB_TMO], 1u); break; } } } } while (0)

struct XcdBarrier {
    unsigned* bar; unsigned x;
    volatile LAS unsigned* st;
};

__device__ __forceinline__ XcdBarrier xcd_barrier_post(unsigned* bar, volatile LAS unsigned* st) {
    XcdBarrier b; b.bar = bar; b.x = xb_xcc_id(); b.st = st;
    if (threadIdx.x == 0) (void)xb_add(&bar[XB_XCNT(b.x)], 1u);
    return b;
}
__device__ __forceinline__ void xcd_barrier_complete(unsigned* bar, unsigned x, unsigned& nloc, unsigned& nx) {
    const unsigned G = gridDim.x * gridDim.y * gridDim.z;
    unsigned sum, cnt, mine, sp = 0u;
    for (;;) {
        sum = 0u; cnt = 0u; mine = 0u;
#pragma unroll
        for (unsigned j = 0; j < 16; ++j) { const unsigned c = xb_ld(&bar[XB_XCNT(j)]); sum += c; cnt += (c > 0u) ? 1u : 0u; mine = (j == x) ? c : mine; }
        if (sum == G) break;
        __builtin_amdgcn_s_sleep(1);
        if ((++sp & 255u) == 0u) { if (xb_ld(&bar[XB_TMO])) break; if (sp > XB_SPIN_CAP) { atomicAdd(&bar[XB_TMO], 1u); break; } }
    }
    nloc = mine > 0u ? mine : 1u; nx = cnt > 0u ? cnt : 1u;
}

__device__ __forceinline__ void xcd_barrier(const XcdBarrier& b) {
    asm volatile("s_waitcnt vmcnt(0)" ::: "memory");
    __syncthreads();
    if (threadIdx.x == 0) {
        unsigned* bar = b.bar;
        __builtin_amdgcn_s_waitcnt(0);
        unsigned nloc = b.st[0], nx = b.st[1];
        if (nloc == 0u) { xcd_barrier_complete(bar, b.x, nloc, nx); b.st[0] = nloc; b.st[1] = nx; }
        const unsigned old = xb_add(&bar[XB_XSUB(b.x)], 1u);
        const unsigned gen = old / nloc;
        if (old + 1u == (gen + 1u) * nloc) {
            __builtin_amdgcn_fence(__ATOMIC_RELEASE, "agent");
            asm volatile("s_waitcnt vmcnt(0)" ::: "memory");
            const unsigned og = xb_add(&bar[XB_TOP], 1u);
            const unsigned tg = og / nx;
            if (og + 1u == (tg + 1u) * nx) xb_add(&bar[XB_TOPGEN], 1u);
            else XB_SPIN(xb_ld(&bar[XB_TOPGEN]) == tg, bar);
            __builtin_amdgcn_fence(__ATOMIC_ACQUIRE, "agent");
            xb_add(&bar[XB_XGEN(b.x)], 1u);
            asm volatile("s_waitcnt vmcnt(0)" ::: "memory");
        } else {
            XB_SPIN(xb_ld(&bar[XB_XGEN(b.x)]) == gen, bar);
            __builtin_amdgcn_fence(__ATOMIC_ACQUIRE, "agent");
            asm volatile("s_waitcnt vmcnt(0)" ::: "memory");
        }
    }
    __syncthreads();
}
constexpr int NWAVES = 8;
constexpr int DM = 4096, NP = 16384, NS = 512, MTOK = NP + NS;
constexpr int SEQ = 4096, PAST = 1024, DSEQ = 64, SKVS = PAST + DSEQ;
constexpr int KVROWS = NP + 8 * SKVS;
constexpr int NINP = 7936;
constexpr int QLORA = 1024, KVLORA = 512, ROPE = 64, NOPE = 128, NH = 16, DFF = 16384;
constexpr float EPS = 1e-6f;
constexpr float LOG2E = 1.4426950408889634f;
constexpr float QS_MLA = 0.07216878364870322f * LOG2E;
constexpr float QS_SB = 0.08838834764831845f * LOG2E;

constexpr size_t O_Y = 0, O_CKV_P = 69206016, O_KR_P = 85983232, O_SBK_P = 88080384, O_SBV_P = 155189248,
                 O_CKV_S = 222298112, O_KR_S = 222822400, O_SBK_S = 222887936, O_SBV_S = 224985088, O_END = 227082240;

constexpr size_t MiB = 1u << 20;
constexpr size_t WS_CTL = 0, CTL_ZERO_BYTES = 1 * MiB;
constexpr size_t WS_SSQH = 512 * 1024;
constexpr size_t WS_TAB = 1 * MiB;
constexpr size_t WS_WIN = 2 * MiB;
constexpr size_t WS_WQB = 64 * MiB;
constexpr size_t WS_WKVB = 70 * MiB;
constexpr size_t WS_WO = 74 * MiB;
constexpr size_t WS_WUP = 106 * MiB;
constexpr size_t WS_WDN = 234 * MiB;
constexpr size_t WS_XN = 362 * MiB;
constexpr size_t WS_R = 494 * MiB;
constexpr size_t WS_U = WS_R;
constexpr size_t WS_QLAT = WS_R;
constexpr size_t WS_AKV = WS_QLAT + 33 * MiB;
constexpr size_t WS_KROPE = WS_AKV + 25 * MiB;
constexpr size_t WS_VB = WS_KROPE + 4 * MiB;
constexpr size_t WS_QB = WS_VB + 98 * MiB;
constexpr size_t WS_KN = WS_QB + 99 * MiB;
constexpr size_t WS_SBQ = WS_KN + 98 * MiB;
constexpr size_t WS_SBK = WS_SBQ + 66 * MiB;
constexpr size_t WS_SBV = WS_SBK + 98 * MiB;
constexpr size_t WS_R2 = WS_SBV + 98 * MiB;
constexpr size_t WS_LAT = WS_R2;
constexpr size_t WS_QRAW = WS_R2;
constexpr size_t WS_KNRAW = WS_R2 + 198 * MiB;
constexpr size_t WS_MLAO = WS_R2;
constexpr size_t WS_SBO = WS_R2 + 66 * MiB;
constexpr size_t WS_MERGED = WS_R2 + 132 * MiB;
constexpr size_t WS_SLAB = WS_R2;
constexpr size_t WS_Y0B = WS_R2 + 264 * MiB;
constexpr size_t WS_WDN1 = WS_R2 + 398 * MiB;
constexpr size_t WS_SSQP = WS_WDN1 + 128 * MiB;
constexpr size_t WS_END = WS_SSQP + 3 * MiB;
static_assert(WS_U + (size_t)MTOK * DFF * 2 <= WS_END, "U fits the overlay region");
static_assert(WS_XN + (size_t)MTOK * DM * 2 <= WS_R && WS_WDN + (size_t)DM * DFF * 2 <= WS_XN && WS_WIN + (size_t)NINP * DM * 2 <= WS_WQB, "ws map");
constexpr int CW_TMO = 0, CW_CODE = 1, CW_BAR = 4096;

constexpr int RING_OFF = 0, RING_BYTES = 131072;
constexpr int LDSCTL_OFF = RING_BYTES, MISC_OFF = LDSCTL_OFF + 320;
constexpr int XCH_OFF = LDSCTL_OFF + 1024;
constexpr int LDS_BYTES = 147456;
static_assert(XCH_OFF + 8192 <= LDS_BYTES, "LDS map");
static_assert(att::ATT_LDS_BYTES <= RING_BYTES && att::MLA_LDS_BYTES <= RING_BYTES && att::DMA_LDS_BYTES <= RING_BYTES, "attention scratch fits the ring region");

#if defined(__HIP_DEVICE_COMPILE__)
#define ASSUME_GLOBAL(p) do { __builtin_assume(!__builtin_amdgcn_is_shared((const __attribute__((address_space(0))) void*)(p))); __builtin_assume(!__builtin_amdgcn_is_private((const __attribute__((address_space(0))) void*)(p))); } while (0)
#else
#define ASSUME_GLOBAL(p) do { } while (0)
#endif
typedef float f32x2 __attribute__((ext_vector_type(2)));
__device__ __forceinline__ float wave_sum(float v) {
#pragma unroll
    for (int o = 1; o < 64; o <<= 1) v += __shfl_xor(v, o);
    return v;
}
__device__ __forceinline__ unsigned pkbf(float lo, float hi) { return pg8::cvt_pk_bf16(lo, hi); }
__device__ __forceinline__ float bf2f(unsigned short b) { return __uint_as_float(((unsigned)b) << 16); }
__device__ __forceinline__ int kvrow_of(int m) { return m < NP ? m : NP + ((m - NP) >> 6) * SKVS + PAST + ((m - NP) & 63); }
__device__ __forceinline__ int pos_of(int m) { return m < NP ? (m & (SEQ - 1)) : PAST + ((m - NP) & 63); }

__device__ __forceinline__ void sincos_acc(float ang, float& s, float& c) {
    const double a = (double)ang; const double q = rint(a * 0.63661977236758134308);
    double r = fma(-q, 1.57079632679489661923, a); r = fma(-q, 6.123233995736766e-17, r);
    const float rf = (float)r; const int qi = (int)q; const float r2 = rf * rf;
    const float sp = rf + rf * r2 * (-1.6666667163e-1f + r2 * (8.3333337680e-3f + r2 * (-1.9841270114e-4f + r2 * 2.7557314297e-6f)));
    const float cp = 1.f + r2 * (-0.5f + r2 * (4.1666667908e-2f + r2 * (-1.3888889225e-3f + r2 * (2.4801587642e-5f + r2 * (-2.7557314297e-7f)))));
    switch (qi & 3) { case 0: s = sp; c = cp; break; case 1: s = cp; c = -sp; break; case 2: s = -sp; c = -cp; break; default: s = -cp; c = sp; break; }
}

struct Frame {
    LAS unsigned char* lds; volatile LAS unsigned* MISC; gu32* ctl;
    int tid, lane, wave, vcu, G;
};
struct Args { const float* in[22]; float* out; unsigned char* ws; };

struct TItem { const float* src; bf16* dst; const float* gk; int N, K; };
__device__ __forceinline__ void ti_load(const TItem& P, float (&tv)[32], f32x4& g0, f32x4& g1, int lane) {
    if (P.gk) { g0 = *(const GAS f32x4*)(P.gk + 8 * (lane & 7)); g1 = *(const GAS f32x4*)(P.gk + 8 * (lane & 7) + 4); }
    else { g0 = f32x4{1.f, 1.f, 1.f, 1.f}; g1 = g0; }
    const GAS float* s = (const GAS float*)P.src + (size_t)(lane >> 5) * P.N + (lane & 31);
#pragma unroll
    for (int i = 0; i < 32; ++i) tv[i] = s[(size_t)(2 * i) * P.N];
}
__device__ __forceinline__ void ti_finish(const TItem& P, const float (&tv)[32], const f32x4 g0, const f32x4 g1, LAS float* scr, int lane) {
#pragma unroll
    for (int i = 0; i < 32; ++i) scr[(2 * i + (lane >> 5)) * 33 + (lane & 31)] = tv[i];
    LDS_WAIT(); asm volatile("" ::: "memory");
    const int c = lane & 7;
#pragma unroll
    for (int j = 0; j < 4; ++j) { const int n = (lane >> 3) + 8 * j; const LAS float* s = scr + (8 * c) * 33 + n;
        v4u o; o.x = pkbf(s[0 * 33] * g0.x, s[1 * 33] * g0.y); o.y = pkbf(s[2 * 33] * g0.z, s[3 * 33] * g0.w); o.z = pkbf(s[4 * 33] * g1.x, s[5 * 33] * g1.y); o.w = pkbf(s[6 * 33] * g1.z, s[7 * 33] * g1.w);
        *(GAS v4u*)(P.dst + (size_t)n * P.K + 8 * c) = o; }
    LDS_WAIT(); asm volatile("" ::: "memory");
}
__device__ __forceinline__ void rms_row_4096(const float* xrow, const float* g, bf16* orow, int lane) {
    const GAS f32x4* xr = (const GAS f32x4*)xrow + lane; const GAS f32x4* gr = (const GAS f32x4*)g + lane;
    f32x4 v[16]; float s = 0.f;
#pragma unroll
    for (int j = 0; j < 16; ++j) { v[j] = xr[64 * j]; s += (v[j].x * v[j].x + v[j].y * v[j].y) + (v[j].z * v[j].z + v[j].w * v[j].w); }
    const float rstd = 1.0f / sqrtf(wave_sum(s) * (1.f / 4096.f) + EPS);
    GAS unsigned long long* o8 = (GAS unsigned long long*)orow + lane;
#pragma unroll
    for (int j = 0; j < 16; ++j) { const f32x4 gg = gr[64 * j];
        o8[64 * j] = (unsigned long long)pkbf(v[j].x * rstd * gg.x, v[j].y * rstd * gg.y) | ((unsigned long long)pkbf(v[j].z * rstd * gg.z, v[j].w * rstd * gg.w) << 32); }
}
__device__ __forceinline__ void rms_row_4096_bf16(const bf16* xrow, const float* g, bf16* orow, int lane) {
    const GAS v4u* xr = (const GAS v4u*)xrow + lane; float x[64]; float s = 0.f;
#pragma unroll
    for (int j = 0; j < 8; ++j) { const v4u w = xr[64 * j]; const unsigned ww[4] = {w.x, w.y, w.z, w.w};
#pragma unroll
        for (int e = 0; e < 4; ++e) { x[8 * j + 2 * e] = __uint_as_float(ww[e] << 16); x[8 * j + 2 * e + 1] = __uint_as_float(ww[e] & 0xffff0000u); } }
#pragma unroll
    for (int i = 0; i < 64; ++i) s += x[i] * x[i];
    const float rstd = 1.0f / sqrtf(wave_sum(s) * (1.f / 4096.f) + EPS);
#pragma unroll
    for (int j = 0; j < 8; ++j) { const GAS f32x4* gp = (const GAS f32x4*)(g + 8 * (64 * j + lane)); const f32x4 g0 = gp[0], g1 = gp[1];
        v4u o; o.x = pkbf(x[8 * j] * rstd * g0.x, x[8 * j + 1] * rstd * g0.y); o.y = pkbf(x[8 * j + 2] * rstd * g0.z, x[8 * j + 3] * rstd * g0.w);
        o.z = pkbf(x[8 * j + 4] * rstd * g1.x, x[8 * j + 5] * rstd * g1.y); o.w = pkbf(x[8 * j + 6] * rstd * g1.z, x[8 * j + 7] * rstd * g1.w);
        *((GAS v4u*)orow + 64 * j + lane) = o; }
}
__device__ __forceinline__ void cache_rows_to_bf16(const float* src, bf16* dst, int W, int gthread, int nthreads) {
    const int per_row = W >> 2; const long total = (long)8 * PAST * per_row;
    for (long i = gthread; i < total; i += nthreads) {
        const int row = (int)(i / per_row), c4 = (int)(i % per_row), b = row >> 10, j = row & 1023;
        const f32x4 v = *(const GAS f32x4*)(src + (size_t)row * W + c4 * 4);
        *(GAS unsigned long long*)(dst + (size_t)(NP + b * SKVS + j) * W + c4 * 4) = (unsigned long long)pkbf(v.x, v.y) | ((unsigned long long)pkbf(v.z, v.w) << 32);
    }
}

template <bool NORM, class Order>
__device__ __forceinline__ void tail_reduce_res(const Order& S, const float* resP, const float* resS, float* out, bf16* HB, float* ssq, const float* ssqm, const float* ssqs, bf16* YB, int tid) {
    if (S.nsplit == 1) return;
    const int wid = __builtin_amdgcn_readfirstlane(tid >> 6), lane = tid & 63, wr = wid >> 2, wc = wid & 3, fr = lane & 15, fq = lane >> 4;
    const int j = S.c / S.nsplit, p = S.c % S.nsplit, per = 32 / S.nsplit;
    pg8::Unit u; S.map(S.nfull * S.G + j, u);
    for (int ii = 0; ii < per; ++ii) {
        const int idx = p * per + ii, a = idx >> 4, b = (idx >> 3) & 1, mm = (idx >> 1) & 3, n = idx & 1;
        const int row = u.pm * 256 + a * 128 + wr * 64 + mm * 16 + fr, col = u.pn * 256 + b * 128 + wc * 32 + 8 * fq + 4 * n;
        f32x4 s = {0.f, 0.f, 0.f, 0.f}, s2 = {0.f, 0.f, 0.f, 0.f};
        for (int sp = 0; sp < S.nsplit; ++sp) { const f32x4 v = *((const GAS f32x4*)(S.slab + (size_t)(j * S.nsplit + sp) * 65536) + (size_t)wid * 2048 + idx * 64 + lane); if (2 * sp < S.nsplit) s += v; else s2 += v; }
        if (NORM) {
            const float rm = 1.0f / sqrtf(__hip_atomic_load(ssqm + row, __ATOMIC_RELAXED, __HIP_MEMORY_SCOPE_AGENT) * (1.f / 2048.f) + EPS), rs = 1.0f / sqrtf(__hip_atomic_load(ssqs + row, __ATOMIC_RELAXED, __HIP_MEMORY_SCOPE_AGENT) * (1.f / 2048.f) + EPS);
            s = s * rm + s2 * rs; } else s += s2;
        f32x4 v;
        if (NORM) { if (YB) { const unsigned long long h = *(const GAS unsigned long long*)(YB + (size_t)row * DM + col); const unsigned h0 = (unsigned)h, h1 = (unsigned)(h >> 32);
                                v = (f32x4){__uint_as_float(h0 << 16), __uint_as_float(h0 & 0xffff0000u), __uint_as_float(h1 << 16), __uint_as_float(h1 & 0xffff0000u)} + s; }
                    else { const float* rp = (row >= NP) ? resS + (size_t)(row - NP) * DM + col : resP + (size_t)row * DM + col; v = *(const GAS f32x4*)rp + s; } }
        else { const unsigned long long h = *(const GAS unsigned long long*)(HB + (size_t)row * DM + col); const unsigned h0 = (unsigned)h, h1 = (unsigned)(h >> 32);
               v = (f32x4){__uint_as_float(h0 << 16), __uint_as_float(h0 & 0xffff0000u), __uint_as_float(h1 << 16), __uint_as_float(h1 & 0xffff0000u)} + s;
               if (YB) { *(GAS unsigned long long*)(YB + (size_t)row * DM + col) = (unsigned long long)pkbf(v.x, v.y) | ((unsigned long long)pkbf(v.z, v.w) << 32);
                         float q = (v.x * v.x + v.y * v.y) + (v.z * v.z + v.w * v.w); q += __shfl_xor(q, 16); q += __shfl_xor(q, 32);
                         if (fq == 0) __hip_atomic_fetch_add(ssq + row, q, __ATOMIC_RELAXED, __HIP_MEMORY_SCOPE_AGENT); }
               else *(GAS f32x4*)(out + (size_t)row * DM + col) = v; }
        if (NORM) {
            *(GAS unsigned long long*)(HB + (size_t)row * DM + col) = (unsigned long long)pkbf(v.x, v.y) | ((unsigned long long)pkbf(v.z, v.w) << 32);
            float q = (v.x * v.x + v.y * v.y) + (v.z * v.z + v.w * v.w); q += __shfl_xor(q, 16); q += __shfl_xor(q, 32);
            if (fq == 0) __hip_atomic_fetch_add(ssq + row, q, __ATOMIC_RELAXED, __HIP_MEMORY_SCOPE_AGENT);
        }
    }
}

__global__ void __launch_bounds__(NWAVES * 64, 2) hymba_fwd(Args args) {
    extern __shared__ __attribute__((aligned(16))) unsigned char lds[];
    Frame F;
    F.lds = (LAS unsigned char*)lds;
    F.MISC = (volatile LAS unsigned*)(F.lds + MISC_OFF);
    F.tid = threadIdx.x; F.lane = F.tid & 63; F.wave = __builtin_amdgcn_readfirstlane(F.tid >> 6);
    F.G = gridDim.x; { const int bx = blockIdx.x; F.vcu = (F.G % 8 == 0) ? (bx % 8) * (F.G / 8) + bx / 8 : bx; }
    unsigned char* ws = args.ws;
    F.ctl = (gu32*)(ws + WS_CTL);
    for (int u = F.tid; u < (LDS_BYTES - LDSCTL_OFF) / 4; u += NWAVES * 64) ((LAS unsigned*)(F.lds + LDSCTL_OFF))[u] = 0u;
    __syncthreads();
    XcdBarrier bar = xcd_barrier_post((unsigned*)(F.ctl + CW_BAR), F.MISC + 8);
#ifndef G5_WGM
#define G5_WGM 8
#endif
#ifndef PROBE_MASK
#define PROBE_MASK 0
#endif
#ifndef PROBE_BAR
#define PROBE_BAR 1
#endif
#ifndef PHMASK
#define PHMASK 0x3fff
#endif
#define GRID_BAR() do { for (int br_ = 0; br_ < PROBE_BAR; ++br_) xcd_barrier(bar); } while (0)
#define PHASE_PTRS() unsigned long long zoff_ = 0; asm volatile("" : "+s"(zoff_)); unsigned char* const wsb = args.ws + zoff_; float* const OUT = args.out + zoff_;     int ptid_ = threadIdx.x; asm volatile("" : "+v"(ptid_)); int bx_ = blockIdx.x, G_ = gridDim.x; asm volatile("" : "+s"(bx_), "+s"(G_)); const int VCU = (G_ % 8 == 0) ? (bx_ % 8) * (G_ / 8) + bx_ / 8 : bx_; (void)VCU; \
    const int LANE = ptid_ & 63, WAVE = __builtin_amdgcn_readfirstlane(ptid_ >> 6); const int gw = VCU * NWAVES + WAVE, NGW = G_ * NWAVES; const int gthread = gw * 64 + LANE, nthreads = NGW * 64; (void)gthread; (void)nthreads; (void)gw; (void)NGW; (void)LANE
#define WIN_T ((bf16*)(wsb + WS_WIN))
#define WQB_T ((bf16*)(wsb + WS_WQB))
#define WKVB_T ((bf16*)(wsb + WS_WKVB))
#define WO_T ((bf16*)(wsb + WS_WO))
#define WUP_T ((bf16*)(wsb + WS_WUP))
#define WDN_T0 ((bf16*)(wsb + WS_WDN))
#define WDN_T1 ((bf16*)(wsb + WS_WDN1))
#define XN ((bf16*)(wsb + WS_XN))
#define UB ((bf16*)(wsb + WS_U))
#define QLAT ((bf16*)(wsb + WS_QLAT))
#define AKV ((bf16*)(wsb + WS_AKV))
#define KROPE ((bf16*)(wsb + WS_KROPE))
#define VB ((bf16*)(wsb + WS_VB))
#define QB ((bf16*)(wsb + WS_QB))
#define KN ((bf16*)(wsb + WS_KN))
#define SBQ ((bf16*)(wsb + WS_SBQ))
#define SBK ((bf16*)(wsb + WS_SBK))
#define SBV ((bf16*)(wsb + WS_SBV))
#define LAT ((float*)(wsb + WS_LAT))
#define QRAW ((float*)(wsb + WS_QRAW))
#define KNRAW ((float*)(wsb + WS_KNRAW))
#define MLAO ((bf16*)(wsb + WS_MLAO))
#define SBO ((bf16*)(wsb + WS_SBO))
#define MERGED ((bf16*)(wsb + WS_MERGED))
#define TAB ((f32x2*)(wsb + WS_TAB))
#define SLAB ((float*)(wsb + WS_SLAB))
#define Y0B ((bf16*)(wsb + WS_Y0B))
#define SSQH ((float*)(wsb + WS_SSQH))
#define SSQM ((float*)(wsb + WS_SSQH + 128 * 1024))
#define SSQS ((float*)(wsb + WS_SSQH + 256 * 1024))
#define SSQP ((float*)(wsb + WS_SSQP))
#define SSQY ((float*)(wsb + WS_SSQH + 384 * 1024))

    { PHASE_PTRS(); (void)OUT;
    for (int i = gthread; i < SEQ * 32; i += nthreads) {
        const int pos = i >> 5, k = i & 31;
        const float inv_freq = exp2f(-(float)k * (13.287712379549449f / 32.f));
        float s, c; sincos_acc((float)pos * inv_freq, s, c); TAB[i] = (f32x2){c, s};
    } }

#define CONVERT_ITEMS(LW, R_LO, R_HI, GWV, NGWV) do { \
        const float* w_in = args.in[7] + (size_t)(LW) * DM * 7744; const float* w_qb = args.in[9] + (size_t)(LW) * QLORA * 3072; \
        const float* w_kvb = args.in[11] + (size_t)(LW) * KVLORA * 4096; const float* w_o = args.in[18] + (size_t)(LW) * DM * DM; \
        const float* w_up = args.in[20] + (size_t)(LW) * DM * DFF; const float* w_dn = args.in[21] + (size_t)(LW) * DFF * DM; const int lw_ = (LW); \
        auto dec_ = [&](int it) -> TItem { \
                int r = (R_HI) - 1 - it; \
                if (r < I_IN) { const int kb = r / 242, nb = r % 242, n0 = nb * 32; return TItem{w_in + (size_t)(kb * 64) * 7744 + n0, WIN_T + (size_t)(n0 + (n0 >= 1600 ? 192 : 0)) * DM + kb * 64, lw_ ? args.in[6] + (size_t)lw_ * DM + kb * 64 : nullptr, 7744, DM}; } r -= I_IN; \
                if (r < I_QB) { const int kb = r / 96, nb = r % 96, n0 = nb * 32, h = n0 / 192, dd = n0 % 192; \
                    return TItem{w_qb + (size_t)(kb * 64) * 3072 + n0, WQB_T + (size_t)(dd < 128 ? h * 128 + dd : 2048 + (h >> 2) * 256 + ((dd - 128) >> 5) * 128 + (h & 3) * 32) * QLORA + kb * 64, nullptr, 3072, QLORA}; } r -= I_QB; \
                if (r < I_KVB) { const int kb = r / 128, nb = r % 128, n0 = nb * 32, h = n0 >> 8, dd = n0 & 255; \
                    return TItem{w_kvb + (size_t)(kb * 64) * 4096 + n0, WKVB_T + (size_t)(dd < 128 ? h * 128 + dd : 2048 + h * 128 + (dd - 128)) * KVLORA + kb * 64, nullptr, 4096, KVLORA}; } r -= I_KVB; \
                if (r < I_O) { const int kb = r / 128, nb = r % 128; \
                    return TItem{w_o + (size_t)(kb * 64) * DM + nb * 32, WO_T + (size_t)(nb * 32) * DM + kb * 64, (kb < 32 ? args.in[16] + (size_t)lw_ * 2048 : args.in[17] + (size_t)lw_ * 2048 - 2048) + kb * 64, DM, DM}; } r -= I_O; \
                if (r < I_UP) { const int kb = r / 512, nb = r % 512; return TItem{w_up + (size_t)(kb * 64) * DFF + nb * 32, WUP_T + (size_t)(nb * 32) * DM + kb * 64, args.in[19] + (size_t)lw_ * DM + kb * 64, DFF, DM}; } r -= I_UP; \
                { const int kb = r / 128, nb = r % 128; return TItem{w_dn + (size_t)(kb * 64) * DM + nb * 32, (lw_ ? WDN_T1 : WDN_T0) + ((size_t)((nb >> 3) * 256 + kb) * 256 + (nb & 7) * 32) * 64, nullptr, DM, 64}; } }; \
        const int n_ = (R_HI) - (R_LO); int it = (GWV); \
        if (it < n_) { \
            float tA[32], tB[32]; f32x4 gA0, gA1, gB0, gB1; \
            TItem PA = dec_(it), PB; ti_load(PA, tA, gA0, gA1, LANE); \
            for (;;) {                                     \
                const int it1 = it + (NGWV); PB = dec_(it1 < n_ ? it1 : it); ti_load(PB, tB, gB0, gB1, LANE); \
                ti_finish(PA, tA, gA0, gA1, scr, LANE); \
                if (it1 >= n_) break; \
                const int it2 = it1 + (NGWV); PA = dec_(it2 < n_ ? it2 : it1); ti_load(PA, tA, gA0, gA1, LANE); \
                ti_finish(PB, tB, gB0, gB1, scr, LANE); \
                if (it2 >= n_) break; \
                it = it2; \
            } } } while (0)
    constexpr int I_IN = 64 * 242, I_QB = 16 * 96, I_KVB = 8 * 128, I_O = 64 * 128, I_UP = 64 * 512, I_DN = 256 * 128;
    constexpr int NITEMS = I_IN + I_QB + I_KVB + I_O + I_UP + I_DN, EARLY_ITEMS = I_IN + I_QB + I_KVB + I_O, EARLY0_ITEMS = I_IN + I_QB + I_KVB;
#pragma unroll 1
    for (int l = 0; l < 2; ++l) {
        if (l == 0 || gridDim.x != 256) {
        for (int rep_ = 0; rep_ < (((PROBE_MASK >> 0) & 1) ? 2 : 1); ++rep_) if constexpr ((PHMASK >> 0) & 1) {
            PHASE_PTRS(); (void)OUT;
            LAS float* scr = (LAS float*)(F.lds + RING_OFF + WAVE * 16384);
            const bool early_ok = (G_ == 256);
            CONVERT_ITEMS(l, (l > 0 && early_ok) ? NITEMS : 0, (l == 0 && early_ok) ? EARLY0_ITEMS : NITEMS, gw, NGW);
            if (l == 0) {
            { unsigned zz = 0u; asm volatile("" : "+v"(zz)); const v4u z4 = {zz, zz, zz, zz};
              for (int i = gthread; i < 192 * DM / 8; i += nthreads) *(GAS v4u*)(WIN_T + (size_t)1600 * DM + (size_t)i * 8) = z4; }
            cache_rows_to_bf16(args.in[2] + (size_t)l * 8 * PAST * KVLORA, AKV, KVLORA, gthread, nthreads);
            cache_rows_to_bf16(args.in[3] + (size_t)l * 8 * PAST * ROPE, KROPE, ROPE, gthread, nthreads);
            const float* g = args.in[6] + (size_t)l * DM;
            for (int m = gw; m < MTOK; m += NGW) rms_row_4096(m < NP ? args.in[0] + (size_t)m * DM : args.in[1] + (size_t)(m - NP) * DM, g, XN + (size_t)m * DM, LANE);
            }
        }
        GRID_BAR();
        }
        for (int rep_ = 0; rep_ < (((PROBE_MASK >> 1) & 1) ? 2 : 1); ++rep_) if constexpr ((PHMASK >> 1) & 1) {
            PHASE_PTRS(); (void)OUT;
            pg8::Gemm g{l == 0 ? XN : Y0B, WIN_T, MTOK, NINP, DM, nullptr}; pg8::InOrder S; S.init3(MTOK, NINP, G_, bx_);
            pg8::EpiIn E{LAT, SBQ, SBK, SBV, OUT + O_SBK_P + (size_t)l * NP * 2048, OUT + O_SBV_P + (size_t)l * NP * 2048,
                         OUT + O_SBK_S + (size_t)l * NS * 2048, OUT + O_SBV_S + (size_t)l * NS * 2048, QS_SB, l == 0 ? nullptr : SSQY, EPS};
            const bool bg = (l == 0 && G_ == 256);
            const int rsplit = bg ? ((bx_ & 7) >> 1) : 0;
#pragma unroll 1
            for (int seg = 0; seg < 2; ++seg) {
                pg8::SubRange<pg8::InOrder> SS{S, seg ? rsplit : 0, seg ? (1 << 30) : rsplit};
                pg8::gemm_phase<pg8::EpiIn, pg8::SubRange<pg8::InOrder>, true, true>(F.lds + RING_OFF, g, SS, E);
                if (seg == 0 && bg) {
                    LAS float* scr = (LAS float*)(F.lds + RING_OFF + WAVE * 16384);
                    CONVERT_ITEMS(0, EARLY0_ITEMS, NITEMS, gw, NGW);
                    __syncthreads();
                }
            }
        }
        GRID_BAR();
        for (int rep_ = 0; rep_ < (((PROBE_MASK >> 2) & 1) ? 2 : 1); ++rep_) if constexpr ((PHMASK >> 2) & 1) {
            PHASE_PTRS(); (void)OUT;
            for (int i = gthread; i < MTOK; i += nthreads) { SSQH[i] = 0.f; SSQM[i] = 0.f; SSQS[i] = 0.f; if (l == 0) SSQY[i] = 0.f; }
            const float* g_q_a = args.in[8] + (size_t)l * QLORA; const float* g_kv_a = args.in[10] + (size_t)l * KVLORA; const float* g_k_rope = args.in[15] + (size_t)l * ROPE;
            for (int m = gw; m < MTOK; m += NGW) {
                const float* lr = LAT + (size_t)m * 1792; const int kvr = kvrow_of(m), pos = pos_of(m);
                {
                    f32x4 v[4]; float s = 0.f;
#pragma unroll
                    for (int j = 0; j < 4; ++j) { v[j] = *(const GAS f32x4*)(lr + 4 * (64 * j + LANE)); s += (v[j].x * v[j].x + v[j].y * v[j].y) + (v[j].z * v[j].z + v[j].w * v[j].w); }
                    const float rstd = 1.0f / sqrtf(wave_sum(s) * (1.f / 1024.f) + EPS);
#pragma unroll
                    for (int j = 0; j < 4; ++j) { const f32x4 gg = *(const GAS f32x4*)(g_q_a + 4 * (64 * j + LANE));
                        *(GAS unsigned long long*)(QLAT + (size_t)m * QLORA + 4 * (64 * j + LANE)) =
                            (unsigned long long)pkbf(v[j].x * rstd * gg.x, v[j].y * rstd * gg.y) | ((unsigned long long)pkbf(v[j].z * rstd * gg.z, v[j].w * rstd * gg.w) << 32); }
                }
                {
                    f32x4 v[2]; float s = 0.f;
#pragma unroll
                    for (int j = 0; j < 2; ++j) { v[j] = *(const GAS f32x4*)(lr + 1024 + 4 * (64 * j + LANE)); s += (v[j].x * v[j].x + v[j].y * v[j].y) + (v[j].z * v[j].z + v[j].w * v[j].w); }
                    const float rstd = 1.0f / sqrtf(wave_sum(s) * (1.f / 512.f) + EPS);
                    float* oc = (m < NP) ? OUT + O_CKV_P + ((size_t)l * NP + m) * KVLORA : OUT + O_CKV_S + ((size_t)l * NS + (m - NP)) * KVLORA;
#pragma unroll
                    for (int j = 0; j < 2; ++j) { const f32x4 gg = *(const GAS f32x4*)(g_kv_a + 4 * (64 * j + LANE));
                        const f32x4 c = {v[j].x * rstd * gg.x, v[j].y * rstd * gg.y, v[j].z * rstd * gg.z, v[j].w * rstd * gg.w};
                        *(GAS f32x4*)(oc + 4 * (64 * j + LANE)) = c;
                        *(GAS unsigned long long*)(AKV + (size_t)kvr * KVLORA + 4 * (64 * j + LANE)) = (unsigned long long)pkbf(c.x, c.y) | ((unsigned long long)pkbf(c.z, c.w) << 32); }
                }
                {
                    const float x = lr[1536 + LANE];
                    const float rstd = 1.0f / sqrtf(wave_sum(x * x) * (1.f / 64.f) + EPS);
                    const float xn = x * rstd * g_k_rope[LANE]; const float xp = __shfl_xor(xn, 32);
                    const f32x2 cs = TAB[pos * 32 + (LANE & 31)];
                    const float o = (LANE < 32) ? xn * cs.x - xp * cs.y : xp * cs.y + xn * cs.x;
                    float* okr = (m < NP) ? OUT + O_KR_P + ((size_t)l * NP + m) * ROPE : OUT + O_KR_S + ((size_t)l * NS + (m - NP)) * ROPE;
                    okr[LANE] = o;
                    const float on = __shfl_xor(o, 1);
                    if ((LANE & 1) == 0) *(GAS unsigned*)(KROPE + (size_t)kvr * ROPE + LANE) = pkbf(o, on);
                }
            }
        }
        GRID_BAR();
        for (int rep_ = 0; rep_ < (((PROBE_MASK >> 3) & 1) ? 2 : 1); ++rep_) if constexpr ((PHMASK >> 3) & 1) {
            PHASE_PTRS(); (void)OUT;
            pg8::Gemm g{QLAT, WQB_T, MTOK, 3072, QLORA, nullptr}; pg8::StaticOrder S; S.init(MTOK, 3072, G_, bx_);
            pg8::EpiQb E{QB, args.in[12] + (size_t)l * NOPE, args.in[13] + (size_t)l * ROPE, TAB, (LAS float*)(F.lds + XCH_OFF), QS_MLA, EPS};
            pg8::gemm_phase<pg8::EpiQb, pg8::StaticOrder, true, true>(F.lds + RING_OFF, g, S, E);
        }
        for (int rep_ = 0; rep_ < (((PROBE_MASK >> 11) & 1) ? 2 : 1); ++rep_) if constexpr ((PHMASK >> 11) & 1) {
            PHASE_PTRS(); (void)OUT;
            pg8::Gemm g{AKV, WKVB_T, KVROWS, 4096, KVLORA, nullptr}; pg8::StaticOrder S; S.init(KVROWS, 4096, G_, (bx_ + G_ - 24) % G_);
            pg8::EpiKvbN E{KN, VB, args.in[14] + (size_t)l * NOPE, (LAS float*)(F.lds + XCH_OFF), EPS};
            pg8::gemm_phase<pg8::EpiKvbN, pg8::StaticOrder, true, true>(F.lds + RING_OFF, g, S, E);
        }
        GRID_BAR();
        for (int rep_ = 0; rep_ < (((PROBE_MASK >> 5) & 1) ? 2 : 1); ++rep_) if constexpr ((PHMASK >> 5) & 1) {
            PHASE_PTRS(); (void)OUT;
            const int v = VCU, bh = v >> 2, b = bh >> 4, h = bh & 15, s = v & 3;
            ALAS char* al = (ALAS char*)(F.lds + RING_OFF);
#pragma unroll 1
            for (int k = 0; k < 5; ++k) {
                att::Unit u;
                if (k < 4) { const int qb = (k == 0) ? s : (k == 1) ? 7 - s : (k == 2) ? 8 + s : 15 - s; const size_t m0 = (size_t)b * SEQ + (size_t)qb * 256, kv0 = (size_t)b * SEQ;
                    u.Q = QB + m0 * 3072 + h * 192; u.ldq = 3072; u.K = KN + kv0 * 2048 + h * 128; u.Kr = KROPE + kv0 * ROPE; u.V = VB + kv0 * 2048 + h * 128;
                    u.O = MERGED + m0 * 4096 + h * 128; u.ldo = 4096; u.ssq = SSQP + m0 * 32 + h; u.Kf0 = u.Vf0 = u.Kf1 = u.Vf1 = nullptr; u.split = 0; u.P0 = qb * 256; u.NT = 4 * qb + 4; u.nact = 8; }
                else { if (v >= 128) break; const int sb = v >> 4, sh = v & 15; const size_t m0 = (size_t)NP + (size_t)sb * 64, kv0 = (size_t)NP + (size_t)sb * SKVS;
                    u.Q = QB + m0 * 3072 + sh * 192; u.ldq = 3072; u.K = KN + kv0 * 2048 + sh * 128; u.Kr = KROPE + kv0 * ROPE; u.V = VB + kv0 * 2048 + sh * 128;
                    u.O = MERGED + m0 * 4096 + sh * 128; u.ldo = 4096; u.ssq = SSQP + m0 * 32 + sh; u.Kf0 = u.Vf0 = u.Kf1 = u.Vf1 = nullptr; u.split = 0; u.P0 = PAST; u.NT = 17; u.nact = 2; }
                if constexpr ((PHMASK >> 12) & 1) att::mla_unit_dma<0>(u, al);
            }
#pragma unroll 1
            for (int k = 0; k < 5; ++k) {
                att::Unit u;
                if (k < 4) { const int qb = (k == 0) ? s : (k == 1) ? 7 - s : (k == 2) ? 8 + s : 15 - s; const size_t m0 = (size_t)b * SEQ + (size_t)qb * 256, kv0 = (size_t)b * SEQ;
                    u.Q = SBQ + m0 * 2048 + h * 128; u.ldq = 2048; u.K = nullptr; u.Kr = nullptr; u.V = nullptr; u.split = 1 << 30;
                    u.Kf0 = OUT + O_SBK_P + ((size_t)l * NP + kv0) * 2048 + h * 128; u.Vf0 = OUT + O_SBV_P + ((size_t)l * NP + kv0) * 2048 + h * 128; u.Kf1 = u.Kf0; u.Vf1 = u.Vf0;
                    u.O = MERGED + m0 * 4096 + 2048 + h * 128; u.ldo = 4096; u.ssq = SSQP + m0 * 32 + 16 + h; u.P0 = qb * 256; u.NT = 4 * qb + 4; u.nact = 8; }
                else { if (v < 128) break; const int w = v - 128, sb = w >> 4, sh = w & 15; const size_t m0 = (size_t)NP + (size_t)sb * 64, kv0 = (size_t)NP + (size_t)sb * SKVS;
                    u.Q = SBQ + m0 * 2048 + sh * 128; u.ldq = 2048; u.K = nullptr; u.Kr = nullptr; u.V = nullptr; u.split = PAST / 64;
                    u.Kf0 = args.in[4] + ((size_t)(l * 8 + sb) * PAST) * 2048 + sh * 128; u.Vf0 = args.in[5] + ((size_t)(l * 8 + sb) * PAST) * 2048 + sh * 128;
                    u.Kf1 = OUT + O_SBK_S + ((size_t)l * NS + (size_t)sb * 64) * 2048 + sh * 128; u.Vf1 = OUT + O_SBV_S + ((size_t)l * NS + (size_t)sb * 64) * 2048 + sh * 128;
                    u.O = MERGED + m0 * 4096 + 2048 + sh * 128; u.ldo = 4096; u.ssq = SSQP + m0 * 32 + 16 + sh; u.P0 = PAST; u.NT = 17; u.nact = 2; }
                if constexpr ((PHMASK >> 13) & 1) att::attn_unit<false>(u, al);
            }
        }
        GRID_BAR();
#if !ATT_SSQ_ATOMICS
        {
            PHASE_PTRS(); (void)OUT;
            for (int i = gthread; i < MTOK * 2; i += nthreads) { const int m = i >> 1, half = i & 1; const GAS f32x4* p = (const GAS f32x4*)(SSQP + (size_t)m * 32 + half * 16);
                const f32x4 a = p[0], b = p[1], c = p[2], d = p[3];
                const float s = (((a.x + a.y) + (a.z + a.w)) + ((b.x + b.y) + (b.z + b.w))) + (((c.x + c.y) + (c.z + c.w)) + ((d.x + d.y) + (d.z + d.w)));
                (half ? SSQS : SSQM)[m] = s; }
        }
        GRID_BAR();
#endif
        for (int rep_ = 0; rep_ < (((PROBE_MASK >> 7) & 1) ? 2 : 1); ++rep_) if constexpr ((PHMASK >> 7) & 1) {
            PHASE_PTRS(); (void)OUT;
            pg8::Gemm g{MERGED, WO_T, MTOK, DM, DM, SLAB}; pg8::PanelOrder S; S.init3(MTOK, DM, DM, G_, bx_, SLAB, 2);
            pg8::EpiResP<true> E{args.in[0], args.in[1], nullptr, XN, SSQH, SSQM, SSQS, EPS, l == 0 ? nullptr : Y0B};
            pg8::gemm_phase<pg8::EpiResP<true>, pg8::PanelOrder, true, true>(F.lds + RING_OFF, g, S, E);
        }
        GRID_BAR();
        {
            PHASE_PTRS(); pg8::PanelOrder S; S.init3(MTOK, DM, DM, G_, bx_, SLAB, 2);
            tail_reduce_res<true>(S, args.in[0], args.in[1], nullptr, XN, SSQH, SSQM, SSQS, l == 0 ? nullptr : Y0B, ptid_);
        }
        GRID_BAR();
        for (int rep_ = 0; rep_ < (((PROBE_MASK >> 9) & 1) ? 2 : 1); ++rep_) if constexpr ((PHMASK >> 9) & 1) {
            PHASE_PTRS(); (void)OUT;
            pg8::Gemm g{XN, WUP_T, MTOK, DFF, DM, nullptr}; pg8::StaticOrder S; S.init(MTOK, DFF, G_, bx_);
            pg8::EpiRelu2N E{UB, DFF, SSQH, EPS};
            pg8::gemm_phase<pg8::EpiRelu2N, pg8::StaticOrder, true, true>(F.lds + RING_OFF, g, S, E);
            if (l + 1 < 2 && G_ == 256 && bx_ >= 128) {
                LAS float* scr = (LAS float*)(F.lds + RING_OFF + WAVE * 16384);
                CONVERT_ITEMS(l + 1, 0, EARLY_ITEMS, (bx_ - 128) * NWAVES + WAVE, 128 * NWAVES);
            }
        }
        GRID_BAR();
        for (int rep_ = 0; rep_ < (((PROBE_MASK >> 10) & 1) ? 2 : 1); ++rep_) if constexpr ((PHMASK >> 10) & 1) {
            PHASE_PTRS(); (void)OUT;
            pg8::Gemm g{UB, l == 0 ? WDN_T0 : WDN_T1, MTOK, DM, DFF, SLAB, 1};     pg8::PanelOrder S; S.init3(MTOK, DM, DFF, G_, bx_, SLAB);
            pg8::EpiResP<false> E{nullptr, nullptr, OUT + O_Y, XN, SSQY, nullptr, nullptr, EPS, l == 1 ? nullptr : Y0B};
            const bool bg = (l + 1 < 2 && G_ == 256);
            const int rsplit = bg ? ((bx_ & 7) >> 1) : 0;
#pragma unroll 1
            for (int seg = 0; seg < 2; ++seg) {
                pg8::SubRange<pg8::PanelOrder> SS{S, seg ? rsplit : 0, seg ? (1 << 30) : rsplit};
                pg8::gemm_phase<pg8::EpiResP<false>, pg8::SubRange<pg8::PanelOrder>, true, true>(F.lds + RING_OFF, g, SS, E);
                if (seg == 0 && bg) {
                    LAS float* scr = (LAS float*)(F.lds + RING_OFF + WAVE * 16384);
                    CONVERT_ITEMS(l + 1, EARLY_ITEMS, NITEMS, gw, NGW);
                    __syncthreads();
                }
            }
        }
        GRID_BAR();
        {
            PHASE_PTRS(); pg8::PanelOrder S; S.init3(MTOK, DM, DFF, G_, bx_, SLAB);
            tail_reduce_res<false>(S, nullptr, nullptr, OUT + O_Y, XN, SSQY, nullptr, nullptr, l == 1 ? nullptr : Y0B, ptid_);
            if (l + 1 < 2) {
                cache_rows_to_bf16(args.in[2] + (size_t)(l + 1) * 8 * PAST * KVLORA, AKV, KVLORA, gthread, nthreads);
                cache_rows_to_bf16(args.in[3] + (size_t)(l + 1) * 8 * PAST * ROPE, KROPE, ROPE, gthread, nthreads);
            }
        }
        GRID_BAR();
    }
#undef GRID_BAR
}

extern "C" void kernel_launch(void* const* d_in, const int* in_sizes, int n_in, void* d_out, int out_size, void* d_ws, size_t ws_size, hipStream_t stream) {
    static int grid = 0;
    if (grid == 0) {
        if (n_in != 22 || (size_t)out_size != O_END || ws_size < WS_END) { fprintf(stderr, "kernel_launch: unexpected shapes: n_in %d out %d ws %zu (need %zu)\n", n_in, out_size, ws_size, (size_t)WS_END); grid = -1; return; }
        int dev = 0, cus = 0, per_cu = 0;
        if (hipGetDevice(&dev) != hipSuccess || hipDeviceGetAttribute(&cus, hipDeviceAttributeMultiprocessorCount, dev) != hipSuccess) { grid = -1; return; }
        if (hipFuncSetAttribute((const void*)hymba_fwd, hipFuncAttributeMaxDynamicSharedMemorySize, LDS_BYTES) != hipSuccess) { fprintf(stderr, "kernel_launch: hipFuncSetAttribute failed\n"); grid = -1; return; }
        if (hipOccupancyMaxActiveBlocksPerMultiprocessor(&per_cu, (const void*)hymba_fwd, NWAVES * 64, LDS_BYTES) != hipSuccess || per_cu < 1) { fprintf(stderr, "kernel_launch: occupancy query reports %d\n", per_cu); }
        (void)hipGetLastError();
        grid = cus;
        if (grid != 256) fprintf(stderr, "kernel_launch: %d CUs (the attention deal assumes 256 workgroups)\n", grid);
    }
    if (grid < 0) return;
    if (hipMemsetAsync((char*)d_ws + WS_CTL, 0, CTL_ZERO_BYTES, stream) != hipSuccess) return;
    Args a{};
    for (int i = 0; i < 22; ++i) a.in[i] = (const float*)d_in[i];
    a.out = (float*)d_out; a.ws = (unsigned char*)d_ws;
    hipLaunchKernelGGL(hymba_fwd, dim3(grid), dim3(NWAVES * 64), LDS_BYTES, stream, a);
}
```

```cpp
#include <hip/hip_runtime.h>
#include <cstdio>
#include <cstdint>
#include <type_traits>
namespace pg8 {
#define PG8_LAS __attribute__((address_space(3)))
typedef unsigned short bf16_t;
typedef short bf16x8 __attribute__((ext_vector_type(8)));
typedef float f32x4 __attribute__((ext_vector_type(4)));
typedef unsigned u32x4 __attribute__((ext_vector_type(4)));
constexpr int BM = 256, BK = 64, HALF = 128, HTB = HALF * BK * 2  , STAGE_BYTES = 8 * HTB, NXCD = 8, WGM = 8;

__host__ __device__ __forceinline__ int lds_byte(int r, int c) { const int st = (r >> 4) * 2 + (c >> 5), rr = r & 15, cc = c & 31, ob = rr * 64 + cc * 2; return st * 1024 + (ob ^ (((ob >> 9) & 1) << 5)); }
__host__ __device__ __forceinline__ void stage_rc(int b, int& R, int& C) { const int st = b / 1024, sb = b % 1024, swz = sb ^ (((sb >> 9) & 1) << 5); R = (st >> 1) * 16 + swz / 64; C = (st & 1) * 32 + (swz % 64) / 2; }
__host__ __device__ __forceinline__ int perm32(int rho) { const int n = rho >> 4, i = rho & 15; return 8 * (i >> 2) + 4 * n + (i & 3); }

struct Unit { int pm, pn, kt0, nkt, part; };
struct Gemm { const bf16_t* A; const bf16_t* Bt; int M, N, K; float* slab; int blocked = 0; };

struct StaticOrder {
    int nM, nN, nwg, G, c, wgm = WGM;
    __host__ __device__ __forceinline__ void init(int M, int N, int G_, int c_) { nM = M / BM; nN = N / BM; nwg = nM * nN; G = G_; c = c_; }
    __host__ __device__ __forceinline__ bool next(int i, Unit& u) const {
        const long L = (long)i * G + c; if (L >= nwg) return false;
        int wgid = (int)L; { const int q = nwg / NXCD, r = nwg % NXCD, xcd = wgid % NXCD, off = wgid / NXCD; wgid = (xcd < r ? xcd * (q + 1) : r * (q + 1) + (xcd - r) * q) + off; }
        const int nig = wgm * nN, gid = wgid / nig, fm = gid * wgm, gsz = (nM - fm) < wgm ? (nM - fm) : wgm;
        u.pm = fm + ((wgid % nig) % gsz); u.pn = (wgid % nig) / gsz; u.kt0 = 0; u.nkt = 0; u.part = -1; return true;
    }
    __host__ __device__ __forceinline__ void map(int L, Unit& u) const {
        int wgid = L; { const int q = nwg / NXCD, r = nwg % NXCD, xcd = wgid % NXCD, off = wgid / NXCD; wgid = (xcd < r ? xcd * (q + 1) : r * (q + 1) + (xcd - r) * q) + off; }
        const int nig = wgm * nN, gid = wgid / nig, fm = gid * wgm, gsz = (nM - fm) < wgm ? (nM - fm) : wgm;
        u.pm = fm + ((wgid % nig) % gsz); u.pn = (wgid % nig) / gsz; u.kt0 = 0; u.nkt = 0; u.part = -1;
    }
    __device__ __forceinline__ void a_ready(const Unit&) const {}
    __device__ __forceinline__ void done(const Unit&) const {}
};

struct InOrder : StaticOrder {
    bool panel;
    __host__ __device__ __forceinline__ void init3(int M, int N, int G_, int c_) { init(M, N, G_, c_); panel = (G_ == 256 && nM == 66 && nN == 31); }
    __host__ __device__ __forceinline__ bool next(int i, Unit& u) const {
        if (!panel) return StaticOrder::next(i, u);
        if (i >= 8) return false;
        const int x = c & 7, idx = c >> 3, g = x >> 2, q = x & 3, pmo = idx & 3, pn = 8 * q + (idx >> 2);
        if (pn < 31) { u.pm = 8 * i + 4 * g + pmo; u.pn = pn; }
        else { const int su = i * 8 + g * 4 + pmo; if (su >= 62) return false; const int hi31 = su >= 31 ? 1 : 0; u.pm = 64 + hi31; u.pn = su - 31 * hi31; }
        u.kt0 = 0; u.nkt = 0; u.part = -1; return true; }
};

struct UpOrder : StaticOrder {
    bool panel;
    __host__ __device__ __forceinline__ void init3(int M, int N, int G_, int c_) { init(M, N, G_, c_); panel = (G_ == 256 && nM == 66 && nN == 64); }
    __host__ __device__ __forceinline__ bool next(int i, Unit& u) const {
        if (!panel) return StaticOrder::next(i, u);
        const int x = c & 7, idx = c >> 3;
        if (i < 16) { u.pm = 4 * i + (idx & 3); u.pn = 8 * x + (idx >> 2); }
        else if (i == 16 && c < 128) { u.pm = 64 + (idx & 1); u.pn = 8 * x + (idx >> 1); }
        else return false;
        u.kt0 = 0; u.nkt = 0; u.part = -1; return true; }
};

template <class S_> struct SubRange {
    const S_& s; int lo, hi;
    __device__ __forceinline__ bool next(int i, Unit& u) const { return (lo + i < hi) && s.next(lo + i, u); }
    __device__ __forceinline__ void a_ready(const Unit& u) const { s.a_ready(u); }
    __device__ __forceinline__ void done(const Unit& u) const { s.done(u); }
};

__device__ __forceinline__ unsigned cvt_pk_bf16(float lo, float hi) { unsigned r; asm volatile("v_cvt_pk_bf16_f32 %0, %1, %2" : "=v"(r) : "v"(lo), "v"(hi)); return r; }

struct TailSplitOrder : StaticOrder {
    int nfull, nsplit, nkt_full, halves; float* slab;
    __host__ __device__ __forceinline__ void init2(int M, int N, int K, int G_, int c_, float* slab_, int halves_ = 1) { init(M, N, G_, c_); nkt_full = K / BK; slab = slab_; halves = halves_; nfull = nwg / G; const int rem = nwg - nfull * G;
        nsplit = (rem > 0 && G % rem == 0 && (nkt_full % (2 * (G / rem))) == 0 && nkt_full / (G / rem) >= 4) ? G / rem : 1; }
    __host__ __device__ __forceinline__ bool next(int i, Unit& u) const {
        const int ii = i / halves, hh = i % halves;
        if (ii < nfull || nsplit == 1) { if (!StaticOrder::next(ii, u)) return false; if (halves == 2) { u.nkt = nkt_full / 2; u.kt0 = hh * u.nkt; u.part = hh == 0 ? -2 : -1; } return true; }
        if (ii > nfull || hh != 0) return false;
        const int j = c / nsplit, s = c % nsplit; map(nfull * G + j, u); u.nkt = nkt_full / nsplit; u.kt0 = s * u.nkt; u.part = j * nsplit + s; return true;
    }
};

struct PanelOrder : TailSplitOrder {
    bool panel;
    __host__ __device__ __forceinline__ void init3(int M, int N, int K, int G_, int c_, float* slab_, int halves_ = 1) { init2(M, N, K, G_, c_, slab_, halves_); panel = (G_ == 256 && nM == 66 && nN == 16 && nsplit == 8); }
    __host__ __device__ __forceinline__ void mapu(int L, Unit& u) const {
        if (L < 1024) { const int r = L >> 8, x = L & 7, idx = (L & 255) >> 3; u.pm = 16 * r + 4 * (x >> 1) + (idx & 3); u.pn = 8 * (x & 1) + (idx >> 2); }
        else { const int j = L - 1024; u.pm = 64 + (j & 1); u.pn = j >> 1; }
        u.kt0 = 0; u.nkt = 0; u.part = -1; }
    __host__ __device__ __forceinline__ bool next(int i, Unit& u) const {
        if (!panel) return TailSplitOrder::next(i, u);
        const int ii = i / halves, hh = i % halves;
        if (ii < nfull) { mapu(ii * G + c, u); if (halves == 2) { u.nkt = nkt_full / 2; u.kt0 = hh * u.nkt; u.part = hh == 0 ? -2 : -1; } return true; }
        if (ii > nfull || hh != 0) return false;
        const int j = c / nsplit, s = c % nsplit; mapu(nfull * G + j, u); u.nkt = nkt_full / nsplit; u.kt0 = s * u.nkt; u.part = j * nsplit + s; return true; }
    __host__ __device__ __forceinline__ void map(int L, Unit& u) const { if (panel) mapu(L, u); else TailSplitOrder::map(L, u); }
};

typedef unsigned u32x2 __attribute__((ext_vector_type(2)));
constexpr int HY_NP = 16384;
__device__ __forceinline__ int hy_kvrow(int m) { return m < HY_NP ? m : HY_NP + ((m - HY_NP) >> 6) * 1088 + 1024 + ((m - HY_NP) & 63); }

struct EpiIn {
    static constexpr bool PERM = true, AFTER_DRAIN = false;
    float* LAT; bf16_t* SBQ; bf16_t* SBK; bf16_t* SBV; float* outK_p; float* outV_p; float* outK_s; float* outV_s; float qscale;
    const float* ssq; float eps;
    __device__ __forceinline__ void operator()(const f32x4 (&acc)[2][2][4][2], const Unit& u, int wr, int wc, int fr, int fq) const {
        const int row0 = u.pm * BM + wr * 64 + fr, colw = wc * 32 + 8 * fq, pn = u.pn;
        float rs[2][4];
#pragma unroll
        for (int ai = 0; ai < 2; ++ai)
#pragma unroll
            for (int m = 0; m < 4; ++m) rs[ai][m] = ssq ? 1.0f / sqrtf(__hip_atomic_load(ssq + row0 + ai * HALF + m * 16, __ATOMIC_RELAXED, __HIP_MEMORY_SCOPE_AGENT) * (1.f / 4096.f) + eps) : 1.0f;
        if (pn < 7) {
#pragma unroll
            for (int ai = 0; ai < 2; ++ai)
#pragma unroll
                for (int m = 0; m < 4; ++m) { float* rp = LAT + (size_t)(row0 + ai * HALF + m * 16) * 1792 + pn * BM + colw;
#pragma unroll
                    for (int bj = 0; bj < 2; ++bj) { *(f32x4*)(rp + bj * HALF) = acc[ai][bj][m][0] * rs[ai][m]; *(f32x4*)(rp + bj * HALF + 4) = acc[ai][bj][m][1] * rs[ai][m]; } }
        } else if (pn < 15) {
#pragma unroll
            for (int ai = 0; ai < 2; ++ai)
#pragma unroll
                for (int m = 0; m < 4; ++m) { bf16_t* rp = SBQ + (size_t)(row0 + ai * HALF + m * 16) * 2048 + (pn - 7) * BM + colw;
#pragma unroll
                    for (int bj = 0; bj < 2; ++bj) { const float sc = qscale * rs[ai][m]; const f32x4 v0 = acc[ai][bj][m][0] * sc, v1 = acc[ai][bj][m][1] * sc;
                        u32x4 w; w.x = cvt_pk_bf16(v0[0], v0[1]); w.y = cvt_pk_bf16(v0[2], v0[3]); w.z = cvt_pk_bf16(v1[0], v1[1]); w.w = cvt_pk_bf16(v1[2], v1[3]);
                        *(u32x4*)(rp + bj * HALF) = w; } }
        } else {
            const bool isv = pn >= 23; const int c0 = (pn - (isv ? 23 : 15)) * BM + colw;
            float* fop = isv ? outV_p : outK_p; float* fos = isv ? outV_s : outK_s;
#pragma unroll
            for (int ai = 0; ai < 2; ++ai)
#pragma unroll
                for (int m = 0; m < 4; ++m) { const int row = row0 + ai * HALF + m * 16;
                    float* fo = (row < HY_NP) ? fop + (size_t)row * 2048 : fos + (size_t)(row - HY_NP) * 2048;
                    fo += c0;
#pragma unroll
                    for (int bj = 0; bj < 2; ++bj) { __builtin_nontemporal_store(acc[ai][bj][m][0] * rs[ai][m], (f32x4*)(fo + bj * HALF)); __builtin_nontemporal_store(acc[ai][bj][m][1] * rs[ai][m], (f32x4*)(fo + bj * HALF + 4)); } }
        }
    }
};
struct EpiF32 {
    static constexpr bool PERM = false, AFTER_DRAIN = false;
    float* C; int ldc;
    __device__ __forceinline__ void operator()(const f32x4 (&acc)[2][2][4][2], const Unit& u, int wr, int wc, int fr, int fq) const {
        const int row0 = u.pm * BM + wr * 64 + fr, col0 = u.pn * BM + wc * 32 + 4 * fq;
#pragma unroll
        for (int ai = 0; ai < 2; ++ai)
#pragma unroll
            for (int m = 0; m < 4; ++m) { float* rowp = C + (size_t)(row0 + ai * HALF + m * 16) * ldc + col0;
#pragma unroll
                for (int bj = 0; bj < 2; ++bj)
#pragma unroll
                    for (int n = 0; n < 2; ++n) *(f32x4*)(rowp + bj * HALF + n * 16) = acc[ai][bj][m][n]; }
    }
};
struct EpiKvb {
    static constexpr bool PERM = true, AFTER_DRAIN = false;
    float* KNRAW; bf16_t* VB;
    __device__ __forceinline__ void operator()(const f32x4 (&acc)[2][2][4][2], const Unit& u, int wr, int wc, int fr, int fq) const {
        const int row0 = u.pm * BM + wr * 64 + fr, colw = wc * 32 + 8 * fq, pn = u.pn;
        if (pn < 8) {
#pragma unroll
            for (int ai = 0; ai < 2; ++ai)
#pragma unroll
                for (int m = 0; m < 4; ++m) { float* rp = KNRAW + (size_t)(row0 + ai * HALF + m * 16) * 2048 + pn * BM + colw;
#pragma unroll
                    for (int bj = 0; bj < 2; ++bj) { *(f32x4*)(rp + bj * HALF) = acc[ai][bj][m][0]; *(f32x4*)(rp + bj * HALF + 4) = acc[ai][bj][m][1]; } }
        } else {
#pragma unroll
            for (int ai = 0; ai < 2; ++ai)
#pragma unroll
                for (int m = 0; m < 4; ++m) { bf16_t* rp = VB + (size_t)(row0 + ai * HALF + m * 16) * 2048 + (pn - 8) * BM + colw;
#pragma unroll
                    for (int bj = 0; bj < 2; ++bj) { const f32x4 v0 = acc[ai][bj][m][0], v1 = acc[ai][bj][m][1];
                        u32x4 w; w.x = cvt_pk_bf16(v0[0], v0[1]); w.y = cvt_pk_bf16(v0[2], v0[3]); w.z = cvt_pk_bf16(v1[0], v1[1]); w.w = cvt_pk_bf16(v1[2], v1[3]);
                        *(u32x4*)(rp + bj * HALF) = w; } }
        }
    }
};
struct EpiRes {
    static constexpr bool PERM = false, AFTER_DRAIN = false;
    const float* resP; const float* resS; float* out;
    __device__ __forceinline__ void operator()(const f32x4 (&acc)[2][2][4][2], const Unit& u, int wr, int wc, int fr, int fq) const {
        const int row0 = u.pm * BM + wr * 64 + fr, col0 = u.pn * BM + wc * 32 + 4 * fq;
        const bool samp = u.pm >= HY_NP / BM;
#pragma unroll
        for (int ai = 0; ai < 2; ++ai)
#pragma unroll
            for (int m = 0; m < 4; ++m) { const int row = row0 + ai * HALF + m * 16;
                const float* rp = samp ? resS + (size_t)(row - HY_NP) * 4096 + col0 : resP + (size_t)row * 4096 + col0;
                float* op = out + (size_t)row * 4096 + col0;
#pragma unroll
                for (int bj = 0; bj < 2; ++bj)
#pragma unroll
                    for (int n = 0; n < 2; ++n) { const f32x4 r = *(const f32x4*)(rp + bj * HALF + n * 16); *(f32x4*)(op + bj * HALF + n * 16) = r + acc[ai][bj][m][n]; } }
    }
};
struct EpiRelu2 {
    static constexpr bool PERM = true, AFTER_DRAIN = false;
    bf16_t* O; int ldc;
    __device__ __forceinline__ void operator()(const f32x4 (&acc)[2][2][4][2], const Unit& u, int wr, int wc, int fr, int fq) const {
        const int row0 = u.pm * BM + wr * 64 + fr, col0 = u.pn * BM + wc * 32 + 8 * fq;
#pragma unroll
        for (int ai = 0; ai < 2; ++ai)
#pragma unroll
            for (int m = 0; m < 4; ++m) { bf16_t* rowp = O + (size_t)(row0 + ai * HALF + m * 16) * ldc + col0;
#pragma unroll
                for (int bj = 0; bj < 2; ++bj) { f32x4 v0 = acc[ai][bj][m][0], v1 = acc[ai][bj][m][1];
#pragma unroll
                    for (int e = 0; e < 4; ++e) { const float a = fmaxf(v0[e], 0.f), b = fmaxf(v1[e], 0.f); v0[e] = a * a; v1[e] = b * b; }
                    u32x4 w; w.x = cvt_pk_bf16(v0[0], v0[1]); w.y = cvt_pk_bf16(v0[2], v0[3]); w.z = cvt_pk_bf16(v1[0], v1[1]); w.w = cvt_pk_bf16(v1[2], v1[3]);
                    *(u32x4*)(rowp + bj * HALF) = w; } }
    }
};

typedef float f32x2e __attribute__((ext_vector_type(2)));
__device__ __forceinline__ void head_ssq_exchange(const f32x4 (&acc)[2][2][4][2], PG8_LAS float* P, int wr, int wc, int fr, int fq, float (&rstd)[2][4][2], float inv_n, float eps) {
#pragma unroll
    for (int ai = 0; ai < 2; ++ai)
#pragma unroll
        for (int m = 0; m < 4; ++m)
#pragma unroll
            for (int bj = 0; bj < 2; ++bj) {
                const f32x4 a = acc[ai][bj][m][0], b = acc[ai][bj][m][1];
                float s = ((a[0] * a[0] + a[1] * a[1]) + (a[2] * a[2] + a[3] * a[3])) + ((b[0] * b[0] + b[1] * b[1]) + (b[2] * b[2] + b[3] * b[3]));
                s += __shfl_xor(s, 16); s += __shfl_xor(s, 32);
                if (fq == 0) P[(ai * HALF + wr * 64 + m * 16 + fr) * 8 + bj * 4 + wc] = s;
            }
    asm volatile("s_waitcnt lgkmcnt(0)" ::: "memory"); __builtin_amdgcn_s_barrier(); asm volatile("" ::: "memory");
#pragma unroll
    for (int ai = 0; ai < 2; ++ai)
#pragma unroll
        for (int m = 0; m < 4; ++m)
#pragma unroll
            for (int bj = 0; bj < 2; ++bj) {
                const f32x4 p = *(const PG8_LAS f32x4*)(P + (ai * HALF + wr * 64 + m * 16 + fr) * 8 + bj * 4);
                rstd[ai][m][bj] = 1.0f / sqrtf(((p[0] + p[1]) + (p[2] + p[3])) * inv_n + eps);
            }
}
struct EpiQb {
    static constexpr bool PERM = true, AFTER_DRAIN = false;
    bf16_t* QB; const float* g_nope; const float* g_rope; const f32x2e* tab; PG8_LAS float* P; float qs, eps;
    __device__ __forceinline__ void operator()(const f32x4 (&acc)[2][2][4][2], const Unit& u, int wr, int wc, int fr, int fq) const {
        const int row0 = u.pm * BM + wr * 64 + fr, pn = u.pn;
        if (pn < 8) {
            float rstd[2][4][2]; head_ssq_exchange(acc, P, wr, wc, fr, fq, rstd, 1.f / 128.f, eps);
            const f32x4 g0 = *(const f32x4*)(g_nope + wc * 32 + 8 * fq) * qs, g1 = *(const f32x4*)(g_nope + wc * 32 + 8 * fq + 4) * qs;
#pragma unroll
            for (int ai = 0; ai < 2; ++ai)
#pragma unroll
                for (int m = 0; m < 4; ++m) { bf16_t* rp = QB + (size_t)(row0 + ai * HALF + m * 16) * 3072 + (2 * pn) * 192 + wc * 32 + 8 * fq;
#pragma unroll
                    for (int bj = 0; bj < 2; ++bj) { const float r = rstd[ai][m][bj]; const f32x4 v0 = acc[ai][bj][m][0] * g0 * r, v1 = acc[ai][bj][m][1] * g1 * r;
                        u32x4 w; w.x = cvt_pk_bf16(v0[0], v0[1]); w.y = cvt_pk_bf16(v0[2], v0[3]); w.z = cvt_pk_bf16(v1[0], v1[1]); w.w = cvt_pk_bf16(v1[2], v1[3]);
                        *(u32x4*)(rp + bj * 192) = w; } }
        } else {
            const int h = 4 * (pn - 8) + wc;
            const f32x4 ga0 = *(const f32x4*)(g_rope + 8 * fq), ga1 = *(const f32x4*)(g_rope + 8 * fq + 4), gb0 = *(const f32x4*)(g_rope + 32 + 8 * fq), gb1 = *(const f32x4*)(g_rope + 32 + 8 * fq + 4);
#pragma unroll
            for (int ai = 0; ai < 2; ++ai)
#pragma unroll
                for (int m = 0; m < 4; ++m) { const int row = row0 + ai * HALF + m * 16;
                    const f32x4 a0 = acc[ai][0][m][0], a1 = acc[ai][0][m][1], b0 = acc[ai][1][m][0], b1 = acc[ai][1][m][1];
                    float s = (((a0[0] * a0[0] + a0[1] * a0[1]) + (a0[2] * a0[2] + a0[3] * a0[3])) + ((a1[0] * a1[0] + a1[1] * a1[1]) + (a1[2] * a1[2] + a1[3] * a1[3])))
                            + (((b0[0] * b0[0] + b0[1] * b0[1]) + (b0[2] * b0[2] + b0[3] * b0[3])) + ((b1[0] * b1[0] + b1[1] * b1[1]) + (b1[2] * b1[2] + b1[3] * b1[3])));
                    s += __shfl_xor(s, 16); s += __shfl_xor(s, 32);
                    const float r = 1.0f / sqrtf(s * (1.f / 64.f) + eps);
                    const int pos = row < HY_NP ? (row & 4095) : 1024 + ((row - HY_NP) & 63);
                    const f32x4* tp = (const f32x4*)(tab + pos * 32 + 8 * fq);
                    const f32x4 t0 = tp[0], t1 = tp[1], t2 = tp[2], t3 = tp[3];
                    const f32x4 x10 = a0 * ga0 * r, x11 = a1 * ga1 * r, x20 = b0 * gb0 * r, x21 = b1 * gb1 * r;
                    const f32x4 c0 = {t0[0], t0[2], t1[0], t1[2]}, s0 = {t0[1], t0[3], t1[1], t1[3]}, c1 = {t2[0], t2[2], t3[0], t3[2]}, s1 = {t2[1], t2[3], t3[1], t3[3]};
                    const f32x4 o10 = (x10 * c0 - x20 * s0) * qs, o11 = (x11 * c1 - x21 * s1) * qs, o20 = (x10 * s0 + x20 * c0) * qs, o21 = (x11 * s1 + x21 * c1) * qs;
                    bf16_t* rp = QB + (size_t)row * 3072 + h * 192 + 128 + 8 * fq;
                    u32x4 w; w.x = cvt_pk_bf16(o10[0], o10[1]); w.y = cvt_pk_bf16(o10[2], o10[3]); w.z = cvt_pk_bf16(o11[0], o11[1]); w.w = cvt_pk_bf16(o11[2], o11[3]);
                    *(u32x4*)rp = w;
                    w.x = cvt_pk_bf16(o20[0], o20[1]); w.y = cvt_pk_bf16(o20[2], o20[3]); w.z = cvt_pk_bf16(o21[0], o21[1]); w.w = cvt_pk_bf16(o21[2], o21[3]);
                    *(u32x4*)(rp + 32) = w; }
        }
    }
};
struct EpiKvbN {
    static constexpr bool PERM = true, AFTER_DRAIN = false;
    bf16_t* KN; bf16_t* VB; const float* g_nope; PG8_LAS float* P; float eps;
    __device__ __forceinline__ void operator()(const f32x4 (&acc)[2][2][4][2], const Unit& u, int wr, int wc, int fr, int fq) const {
        const int row0 = u.pm * BM + wr * 64 + fr, colw = wc * 32 + 8 * fq, pn = u.pn;
        if (pn < 8) {
            float rstd[2][4][2]; head_ssq_exchange(acc, P, wr, wc, fr, fq, rstd, 1.f / 128.f, eps);
            const f32x4 g0 = *(const f32x4*)(g_nope + colw), g1 = *(const f32x4*)(g_nope + colw + 4);
#pragma unroll
            for (int ai = 0; ai < 2; ++ai)
#pragma unroll
                for (int m = 0; m < 4; ++m) { bf16_t* rp = KN + (size_t)(row0 + ai * HALF + m * 16) * 2048 + pn * BM + colw;
#pragma unroll
                    for (int bj = 0; bj < 2; ++bj) { const float r = rstd[ai][m][bj]; const f32x4 v0 = acc[ai][bj][m][0] * g0 * r, v1 = acc[ai][bj][m][1] * g1 * r;
                        u32x4 w; w.x = cvt_pk_bf16(v0[0], v0[1]); w.y = cvt_pk_bf16(v0[2], v0[3]); w.z = cvt_pk_bf16(v1[0], v1[1]); w.w = cvt_pk_bf16(v1[2], v1[3]);
                        *(u32x4*)(rp + bj * HALF) = w; } }
        } else {
#pragma unroll
            for (int ai = 0; ai < 2; ++ai)
#pragma unroll
                for (int m = 0; m < 4; ++m) { bf16_t* rp = VB + (size_t)(row0 + ai * HALF + m * 16) * 2048 + (pn - 8) * BM + colw;
#pragma unroll
                    for (int bj = 0; bj < 2; ++bj) { const f32x4 v0 = acc[ai][bj][m][0], v1 = acc[ai][bj][m][1];
                        u32x4 w; w.x = cvt_pk_bf16(v0[0], v0[1]); w.y = cvt_pk_bf16(v0[2], v0[3]); w.z = cvt_pk_bf16(v1[0], v1[1]); w.w = cvt_pk_bf16(v1[2], v1[3]);
                        *(u32x4*)(rp + bj * HALF) = w; } }
        }
    }
};

template <bool NORM> struct EpiResP {
    static constexpr bool PERM = true, AFTER_DRAIN = false, MIDK = NORM;
    const float* resP; const float* resS; float* out; bf16_t* HB; float* ssq; const float* ssqm; const float* ssqs; float eps;
    bf16_t* YB;
    __device__ __forceinline__ void mid(f32x4 (&acc)[2][2][4][2], const Unit& u, int wr, int wc, int fr, int fq) const {
        const int row0 = u.pm * BM + wr * 64 + fr;
#pragma unroll
        for (int ai = 0; ai < 2; ++ai)
#pragma unroll
            for (int m = 0; m < 4; ++m) { const int row = row0 + ai * HALF + m * 16;
                const float a = __hip_atomic_load(ssqm + row, __ATOMIC_RELAXED, __HIP_MEMORY_SCOPE_AGENT), b = __hip_atomic_load(ssqs + row, __ATOMIC_RELAXED, __HIP_MEMORY_SCOPE_AGENT);
                const float ratio = sqrtf((b * (1.f / 2048.f) + eps) / (a * (1.f / 2048.f) + eps));
#pragma unroll
                for (int bj = 0; bj < 2; ++bj) { acc[ai][bj][m][0] *= ratio; acc[ai][bj][m][1] *= ratio; } }
    }
    __device__ __forceinline__ void operator()(const f32x4 (&acc)[2][2][4][2], const Unit& u, int wr, int wc, int fr, int fq) const {
        const int row0 = u.pm * BM + wr * 64 + fr, col0 = u.pn * BM + wc * 32 + 8 * fq;
        const bool samp = u.pm >= HY_NP / BM;
#pragma unroll
        for (int ai = 0; ai < 2; ++ai)
#pragma unroll
            for (int m = 0; m < 4; ++m) { const int row = row0 + ai * HALF + m * 16;
                if (NORM) {
                    const float* rp = samp ? resS + (size_t)(row - HY_NP) * 4096 + col0 : resP + (size_t)row * 4096 + col0; float s = 0.f;
                    const bf16_t* yp = YB + (size_t)row * 4096 + col0;
                    const float rs = 1.0f / sqrtf(__hip_atomic_load(ssqs + row, __ATOMIC_RELAXED, __HIP_MEMORY_SCOPE_AGENT) * (1.f / 2048.f) + eps);
#pragma unroll
                    for (int bj = 0; bj < 2; ++bj) { f32x4 r0, r1;
                        if (YB) { const u32x4 h = *(const u32x4*)(yp + bj * HALF);
                            r0 = (f32x4){__uint_as_float(h.x << 16), __uint_as_float(h.x & 0xffff0000u), __uint_as_float(h.y << 16), __uint_as_float(h.y & 0xffff0000u)};
                            r1 = (f32x4){__uint_as_float(h.z << 16), __uint_as_float(h.z & 0xffff0000u), __uint_as_float(h.w << 16), __uint_as_float(h.w & 0xffff0000u)}; }
                        else { r0 = *(const f32x4*)(rp + bj * HALF); r1 = *(const f32x4*)(rp + bj * HALF + 4); }
                        const f32x4 v0 = r0 + acc[ai][bj][m][0] * rs, v1 = r1 + acc[ai][bj][m][1] * rs;
                        s += ((v0[0] * v0[0] + v0[1] * v0[1]) + (v0[2] * v0[2] + v0[3] * v0[3])) + ((v1[0] * v1[0] + v1[1] * v1[1]) + (v1[2] * v1[2] + v1[3] * v1[3]));
                        u32x4 w; w.x = cvt_pk_bf16(v0[0], v0[1]); w.y = cvt_pk_bf16(v0[2], v0[3]); w.z = cvt_pk_bf16(v1[0], v1[1]); w.w = cvt_pk_bf16(v1[2], v1[3]);
                        *(u32x4*)(HB + (size_t)row * 4096 + col0 + bj * HALF) = w; }
                    s += __shfl_xor(s, 16); s += __shfl_xor(s, 32);
                    if (fq == 0) __hip_atomic_fetch_add(ssq + row, s, __ATOMIC_RELAXED, __HIP_MEMORY_SCOPE_AGENT);
                } else {
                    const bf16_t* hp = HB + (size_t)row * 4096 + col0; float* op = out + (size_t)row * 4096 + col0; float s = 0.f;
#pragma unroll
                    for (int bj = 0; bj < 2; ++bj) { const u32x4 h = *(const u32x4*)(hp + bj * HALF);
                        const f32x4 r0 = {__uint_as_float(h.x << 16), __uint_as_float(h.x & 0xffff0000u), __uint_as_float(h.y << 16), __uint_as_float(h.y & 0xffff0000u)};
                        const f32x4 r1 = {__uint_as_float(h.z << 16), __uint_as_float(h.z & 0xffff0000u), __uint_as_float(h.w << 16), __uint_as_float(h.w & 0xffff0000u)};
                        const f32x4 y0 = r0 + acc[ai][bj][m][0], y1 = r1 + acc[ai][bj][m][1];
                        if (YB) { u32x4 w; w.x = cvt_pk_bf16(y0[0], y0[1]); w.y = cvt_pk_bf16(y0[2], y0[3]); w.z = cvt_pk_bf16(y1[0], y1[1]); w.w = cvt_pk_bf16(y1[2], y1[3]);
                                  *(u32x4*)(YB + (size_t)row * 4096 + col0 + bj * HALF) = w;
                                  s += ((y0[0] * y0[0] + y0[1] * y0[1]) + (y0[2] * y0[2] + y0[3] * y0[3])) + ((y1[0] * y1[0] + y1[1] * y1[1]) + (y1[2] * y1[2] + y1[3] * y1[3])); }
                        else { __builtin_nontemporal_store(y0, (f32x4*)(op + bj * HALF)); __builtin_nontemporal_store(y1, (f32x4*)(op + bj * HALF + 4)); } }
                    if (YB) { s += __shfl_xor(s, 16); s += __shfl_xor(s, 32);
                        if (fq == 0) __hip_atomic_fetch_add(ssq + row, s, __ATOMIC_RELAXED, __HIP_MEMORY_SCOPE_AGENT); }
                } }
    }
};
struct EpiRelu2N {
    static constexpr bool PERM = true, AFTER_DRAIN = false;
    bf16_t* O; int ldc; const float* ssq; float eps;
    __device__ __forceinline__ void operator()(const f32x4 (&acc)[2][2][4][2], const Unit& u, int wr, int wc, int fr, int fq) const {
        const int row0 = u.pm * BM + wr * 64 + fr;
        bf16_t* const tile0 = O + ((size_t)u.pm * (ldc >> 6) + u.pn * 4 + (wc >> 1)) * 16384 + (wc & 1) * 32 + 8 * fq;
#pragma unroll
        for (int ai = 0; ai < 2; ++ai)
#pragma unroll
            for (int m = 0; m < 4; ++m) { const int row = row0 + ai * HALF + m * 16; bf16_t* rowp = tile0 + (wr * 64 + fr + ai * HALF + m * 16) * 64;
                const float r = 1.0f / sqrtf(__hip_atomic_load(ssq + row, __ATOMIC_RELAXED, __HIP_MEMORY_SCOPE_AGENT) * (1.f / 4096.f) + eps);
#pragma unroll
                for (int bj = 0; bj < 2; ++bj) { f32x4 v0 = acc[ai][bj][m][0], v1 = acc[ai][bj][m][1];
#pragma unroll
                    for (int e = 0; e < 4; ++e) { const float a = fmaxf(v0[e], 0.f) * r, b = fmaxf(v1[e], 0.f) * r; v0[e] = a * a; v1[e] = b * b; }
                    u32x4 w; w.x = cvt_pk_bf16(v0[0], v0[1]); w.y = cvt_pk_bf16(v0[2], v0[3]); w.z = cvt_pk_bf16(v1[0], v1[1]); w.w = cvt_pk_bf16(v1[2], v1[3]);
                    *(u32x4*)(rowp + bj * 2 * 16384) = w; } }
    }
};
template <class T, class = void> struct has_midk { static constexpr bool value = false; };
template <class T> struct has_midk<T, typename std::enable_if<T::MIDK>::type> { static constexpr bool value = true; };
template <class Epi, class Sched, bool ALIGN_EPI = false, bool SP2 = false>
__device__ __forceinline__ void gemm_phase(PG8_LAS unsigned char* lds, const Gemm g, const Sched& S, const Epi& E) {
    int tid_o = threadIdx.x; asm volatile("" : "+v"(tid_o));
    const int tid = tid_o, wid = __builtin_amdgcn_readfirstlane(tid >> 6), lane = tid & 63, wr = wid >> 2, wc = wid & 3, fr = lane & 15, fq = lane >> 4;
    const int nt = g.K / BK, K = g.blocked ? BK : g.K;
    unsigned voffA[2], voffB[2];
#pragma unroll
    for (int i = 0; i < 2; ++i) { int R, C; stage_rc(tid * 16 + i * 8192, R, C); const int Rb = Epi::PERM ? ((R & ~31) + perm32(R & 31)) : R;
        voffA[i] = (unsigned)(R * K + C) * 2u; voffB[i] = (unsigned)(Rb * K + C) * 2u; }
    const size_t kstep = g.blocked ? (size_t)(BM * BK * 2) : (size_t)(BK * 2);
    const size_t hstep = (size_t)HALF * K * 2;
    const size_t tstep = (size_t)BM * g.K * 2;
    const unsigned ldsw = (unsigned)wid * 1024u;
    const int aoff = lds_byte(wr * 64 + fr, fq * 8), boff = lds_byte(wc * 32 + fr, fq * 8);
#define PG8_SA(b, h) (((b) * 2 + (h)) * HTB)
#define PG8_SB(b, h) ((4 + (b) * 2 + (h)) * HTB)
#define PG8_STAGE(bufoff, gbase, voff) do { _Pragma("unroll") for (int _i = 0; _i < 2; ++_i) \
        __builtin_amdgcn_global_load_lds((const unsigned*)((const char*)(gbase) + (voff)[_i]), (PG8_LAS unsigned*)(lds + (bufoff) + ldsw + _i * 8192), 16, 0, 0); } while (0)
#define PG8_LDA(dst, b, h) do { _Pragma("unroll") for (int m = 0; m < 4; ++m) _Pragma("unroll") for (int k = 0; k < 2; ++k) dst[m][k] = *(const PG8_LAS bf16x8*)(lds + PG8_SA(b, h) + aoff + m * 2048 + k * 1024); } while (0)
#define PG8_LDB(dst, b, h) do { _Pragma("unroll") for (int n = 0; n < 2; ++n) _Pragma("unroll") for (int k = 0; k < 2; ++k) dst[n][k] = *(const PG8_LAS bf16x8*)(lds + PG8_SB(b, h) + boff + n * 2048 + k * 1024); } while (0)
#define PG8_MMA(ai, bj, At, Bt) do { __builtin_amdgcn_s_setprio(1); _Pragma("unroll") for (int m = 0; m < 4; ++m) _Pragma("unroll") for (int n = 0; n < 2; ++n) _Pragma("unroll") for (int k = 0; k < 2; ++k) \
        acc[ai][bj][m][n] = __builtin_amdgcn_mfma_f32_16x16x32_bf16(Bt[n][k], At[m][k], acc[ai][bj][m][n], 0, 0, 0); __builtin_amdgcn_s_setprio(0); } while (0)
#define PG8_WAIT_V(n) asm volatile("s_waitcnt vmcnt(" #n ")" ::: "memory")
#define PG8_WAIT_L(n) asm volatile("s_waitcnt lgkmcnt(" #n ")" ::: "memory")
#define PG8_BAR __builtin_amdgcn_s_barrier()
#define PG8_SCHED __builtin_amdgcn_sched_barrier(0)
    Unit cur, nxt; int ui = 0;
    if (!S.next(0, cur)) return;
    f32x4 acc[2][2][4][2];
#pragma unroll
    for (int a = 0; a < 2; ++a)
#pragma unroll
        for (int b = 0; b < 2; ++b)
#pragma unroll
            for (int m = 0; m < 4; ++m)
#pragma unroll
                for (int n = 0; n < 2; ++n) acc[a][b][m][n] = (f32x4){0.f, 0.f, 0.f, 0.f};
    bf16x8 At[4][2], B0[2][2], B1[2][2];
    const char* cA = (const char*)g.A + (size_t)cur.pm * tstep + (size_t)cur.kt0 * kstep; const char* cB = (const char*)g.Bt + (size_t)cur.pn * tstep + (size_t)cur.kt0 * kstep;
    int cnt = cur.nkt ? cur.nkt : nt;
    S.a_ready(cur);
    if constexpr (SP2) {
        PG8_STAGE(PG8_SB(0, 0), cB, voffB); PG8_STAGE(PG8_SB(0, 1), cB + hstep, voffB); PG8_STAGE(PG8_SA(0, 0), cA, voffA); PG8_STAGE(PG8_SA(0, 1), cA + hstep, voffA);
        if (wr == 1) PG8_BAR;
        PG8_WAIT_V(2); PG8_BAR;
        PG8_STAGE(PG8_SB(1, 0), cB + kstep, voffB); PG8_STAGE(PG8_SA(1, 0), cA + kstep, voffA); PG8_STAGE(PG8_SB(1, 1), cB + hstep + kstep, voffB);
        PG8_WAIT_V(6); PG8_BAR;
    } else {
        PG8_STAGE(PG8_SB(0, 0), cB, voffB); PG8_STAGE(PG8_SA(0, 0), cA, voffA); PG8_STAGE(PG8_SB(0, 1), cB + hstep, voffB); PG8_STAGE(PG8_SA(0, 1), cA + hstep, voffA);
        if (wr == 1) PG8_BAR;
        PG8_WAIT_V(4); PG8_BAR;
        PG8_STAGE(PG8_SB(1, 0), cB + kstep, voffB); PG8_STAGE(PG8_SA(1, 0), cA + kstep, voffA); PG8_STAGE(PG8_SB(1, 1), cB + hstep + kstep, voffB);
        PG8_WAIT_V(6); PG8_BAR;
    }
    for (;;) {
        const bool has_next = S.next(ui + 1, nxt);
        const char* nA = has_next ? (const char*)g.A + (size_t)nxt.pm * tstep + (size_t)nxt.kt0 * kstep : cA; const char* nB = has_next ? (const char*)g.Bt + (size_t)nxt.pn * tstep + (size_t)nxt.kt0 * kstep : cB;
        for (int t = 0; t < cnt; t += 2) {
            const bool last = (t == cnt - 2);
            const char* a1 = cA + (size_t)(t + 1) * kstep;
            const char* a2 = last ? nA : cA + (size_t)(t + 2) * kstep; const char* b2 = last ? nB : cB + (size_t)(t + 2) * kstep;
            const char* a3 = a2 + kstep; const char* b3 = b2 + kstep;
            if (last && has_next) S.a_ready(nxt);
            if constexpr (SP2) {
            PG8_LDB(B0, 0, 0); PG8_LDB(B1, 0, 1); PG8_SCHED; PG8_LDA(At, 0, 0); PG8_STAGE(PG8_SA(1, 1), a1 + hstep, voffA);
            PG8_WAIT_V(8); PG8_WAIT_L(0); PG8_BAR; PG8_MMA(0, 0, At, B0); PG8_MMA(0, 1, At, B1); PG8_BAR; PG8_SCHED;
            PG8_LDA(At, 0, 1); PG8_STAGE(PG8_SB(0, 0), b2, voffB); PG8_STAGE(PG8_SB(0, 1), b2 + hstep, voffB); PG8_STAGE(PG8_SA(0, 0), a2, voffA);
            PG8_WAIT_V(8); PG8_WAIT_L(0); PG8_BAR; PG8_MMA(1, 0, At, B0); PG8_MMA(1, 1, At, B1); PG8_BAR; PG8_SCHED;
            PG8_LDB(B0, 1, 0); PG8_LDB(B1, 1, 1); PG8_SCHED; PG8_LDA(At, 1, 0); PG8_STAGE(PG8_SA(0, 1), a2 + hstep, voffA);
            PG8_WAIT_V(8); PG8_WAIT_L(0); PG8_BAR; PG8_MMA(0, 0, At, B0); PG8_MMA(0, 1, At, B1); PG8_BAR; PG8_SCHED;
            PG8_LDA(At, 1, 1); PG8_STAGE(PG8_SB(1, 0), b3, voffB); PG8_STAGE(PG8_SB(1, 1), b3 + hstep, voffB); PG8_STAGE(PG8_SA(1, 0), a3, voffA);
            PG8_WAIT_V(8); PG8_WAIT_L(0); PG8_BAR; PG8_MMA(1, 0, At, B0); PG8_MMA(1, 1, At, B1); PG8_BAR; PG8_SCHED;
            } else {
            PG8_LDB(B0, 0, 0); PG8_SCHED; PG8_LDA(At, 0, 0); PG8_STAGE(PG8_SA(1, 1), a1 + hstep, voffA);
            PG8_WAIT_L(8); PG8_BAR; PG8_WAIT_L(0); PG8_MMA(0, 0, At, B0); PG8_BAR; PG8_SCHED;
            PG8_LDB(B1, 0, 1); PG8_STAGE(PG8_SB(0, 0), b2, voffB);
            PG8_BAR; PG8_WAIT_L(0); PG8_MMA(0, 1, At, B1); PG8_BAR;
            PG8_LDA(At, 0, 1); PG8_STAGE(PG8_SA(0, 0), a2, voffA);
            PG8_BAR; PG8_WAIT_L(0); PG8_MMA(1, 0, At, B0); PG8_BAR; PG8_SCHED;
            PG8_STAGE(PG8_SB(0, 1), b2 + hstep, voffB);
            PG8_WAIT_V(6); PG8_BAR; PG8_MMA(1, 1, At, B1); PG8_BAR;
            PG8_LDB(B0, 1, 0); PG8_SCHED; PG8_LDA(At, 1, 0); PG8_STAGE(PG8_SA(0, 1), a2 + hstep, voffA);
            PG8_WAIT_L(8); PG8_BAR; PG8_WAIT_L(0); PG8_MMA(0, 0, At, B0); PG8_BAR; PG8_SCHED;
            PG8_LDB(B1, 1, 1); PG8_STAGE(PG8_SB(1, 0), b3, voffB);
            PG8_BAR; PG8_WAIT_L(0); PG8_MMA(0, 1, At, B1); PG8_BAR;
            PG8_LDA(At, 1, 1); PG8_STAGE(PG8_SA(1, 0), a3, voffA);
            PG8_BAR; PG8_WAIT_L(0); PG8_MMA(1, 0, At, B0); PG8_BAR; PG8_SCHED;
            PG8_STAGE(PG8_SB(1, 1), b3 + hstep, voffB);
            PG8_WAIT_V(6); PG8_BAR; PG8_MMA(1, 1, At, B1); PG8_BAR;
            }
        }
        if constexpr (ALIGN_EPI) { if (wr == 0) PG8_BAR; }
        if constexpr (!Epi::AFTER_DRAIN) {
            if (cur.part == -2) { if constexpr (has_midk<Epi>::value) E.mid(acc, cur, wr, wc, fr, fq); }
            else if (cur.part >= 0) {
                f32x4* sp = (f32x4*)(g.slab + (size_t)cur.part * 65536) + (size_t)wid * 2048 + lane;
#pragma unroll
                for (int a = 0; a < 2; ++a)
#pragma unroll
                    for (int b = 0; b < 2; ++b)
#pragma unroll
                        for (int m = 0; m < 4; ++m)
#pragma unroll
                            for (int n = 0; n < 2; ++n) sp[(((a * 2 + b) * 4 + m) * 2 + n) * 64] = acc[a][b][m][n];
            } else E(acc, cur, wr, wc, fr, fq);
            S.done(cur); }
        if (!has_next) break;
        if (cur.part != -2) {
#pragma unroll
        for (int a = 0; a < 2; ++a)
#pragma unroll
            for (int b = 0; b < 2; ++b)
#pragma unroll
                for (int m = 0; m < 4; ++m)
#pragma unroll
                    for (int n = 0; n < 2; ++n) acc[a][b][m][n] = (f32x4){0.f, 0.f, 0.f, 0.f};
        }
        cur = nxt; cA = nA; cB = nB; ++ui; cnt = cur.nkt ? cur.nkt : nt;
        if constexpr (ALIGN_EPI) { if (wr == 1) PG8_BAR; }
    }
    PG8_WAIT_V(0);
    if constexpr (!ALIGN_EPI) { if (wr == 0) PG8_BAR; }
    PG8_BAR;
    if constexpr (Epi::AFTER_DRAIN) { E.fused(acc, cur, wr, wc, fr, fq, lds, wid, lane); S.done(cur); }
#undef PG8_SA
#undef PG8_SB
#undef PG8_STAGE
#undef PG8_LDA
#undef PG8_LDB
#undef PG8_MMA
#undef PG8_WAIT_V
#undef PG8_WAIT_L
#undef PG8_BAR
#undef PG8_SCHED
}
}
namespace att {
typedef short bf16x8 __attribute__((ext_vector_type(8)));
typedef short s16x4 __attribute__((ext_vector_type(4)));
typedef float f32x16 __attribute__((ext_vector_type(16)));
typedef unsigned u32x4 __attribute__((ext_vector_type(4)));
typedef float f32x4 __attribute__((ext_vector_type(4)));
typedef unsigned short bf16;
#define ALAS __attribute__((address_space(3)))
#ifndef ATT_SSQ_ATOMICS
#define ATT_SSQ_ATOMICS 0
#endif
constexpr int OFF_V = 0, OFF_K = 32768, OFF_R = 65536, OFF_WS = 81920, OFF_FLG = 81920 + 8 * 256, ATT_LDS_BYTES = OFF_FLG + 64;
constexpr float SB_DEAD = -150.f;
#define KSWZ(row, colB) ((row) * 256 + ((colB) ^ (((row) & 15) << 4)))
#define RSWZ(row, colB) ((row) * 128 + ((colB) ^ ((((row) >> 1) & 7) << 4)))
__device__ __forceinline__ int v_st(int k, int c) { const int kk = (k & ~0xC) | ((k & 4) << 1) | ((k & 8) >> 1); return ((kk >> 3) * 4 + (c >> 5)) * 512 + ((kk & 7) * 32 + (c & 31)) * 2; }
__device__ __forceinline__ int v_rd_base(int lane) { return ((lane & 3) << 3) | (((lane >> 2) & 3) << 6) | (((lane >> 4) & 1) << 5) | (((lane >> 5) & 1) << 8); }
__device__ __forceinline__ int crow(int r, int hi) { return (r & 3) + 8 * (r >> 2) + 4 * hi; }
__device__ __forceinline__ unsigned cvtpk(float lo, float hi) { unsigned r; asm volatile("v_cvt_pk_bf16_f32 %0, %1, %2" : "=v"(r) : "v"(lo), "v"(hi)); return r; }

struct Unit { const bf16* Q; int ldq; const bf16* K; const bf16* Kr; const bf16* V; bf16* O; int ldo; float* ssq; int P0; int NT; int nact;
              const float* Kf0; const float* Vf0; const float* Kf1; const float* Vf1; int split; };

__device__ __forceinline__ void qk128(f32x16& p0, f32x16& p1, ALAS const char* Kt, int r32, int hi, const bf16x8* qr) {
#pragma unroll
    for (int d0 = 0; d0 < 8; ++d0) { ALAS const char* a = Kt + KSWZ(r32, (d0 * 16 + hi * 8) * 2);
        const bf16x8 b0 = *(ALAS const bf16x8*)a; const bf16x8 b1 = *(ALAS const bf16x8*)(a + 32 * 256);
        p0 = __builtin_amdgcn_mfma_f32_32x32x16_bf16(b0, qr[d0], p0, 0, 0, 0);
        p1 = __builtin_amdgcn_mfma_f32_32x32x16_bf16(b1, qr[d0], p1, 0, 0, 0); }
}
__device__ __forceinline__ void qk64(f32x16& p0, f32x16& p1, ALAS const char* Kt, int r32, int hi, const bf16x8* qr) {
#pragma unroll
    for (int d0 = 0; d0 < 4; ++d0) { ALAS const char* a = Kt + RSWZ(r32, (d0 * 16 + hi * 8) * 2);
        const bf16x8 b0 = *(ALAS const bf16x8*)a; const bf16x8 b1 = *(ALAS const bf16x8*)(a + 32 * 128);
        p0 = __builtin_amdgcn_mfma_f32_32x32x16_bf16(b0, qr[d0], p0, 0, 0, 0);
        p1 = __builtin_amdgcn_mfma_f32_32x32x16_bf16(b1, qr[d0], p1, 0, 0, 0); }
}
__device__ __forceinline__ void pv_tile(f32x16* o, unsigned vb0, bf16x8 pa0, bf16x8 pa1, bf16x8 pa2, bf16x8 pa3) {
#define TRRD(dst, off) asm volatile("ds_read_b64_tr_b16 %0, %1 offset:%2" : "=&v"(dst) : "v"(vb0), "i"(off) : "memory")
#define PV_LD(S, d0) do { constexpr int b_ = (d0) * 512; \
        TRRD(S##l0, b_); TRRD(S##h0, b_ + 2048); TRRD(S##l1, b_ + 4096); TRRD(S##h1, b_ + 6144); TRRD(S##l2, b_ + 8192); TRRD(S##h2, b_ + 10240); TRRD(S##l3, b_ + 12288); TRRD(S##h3, b_ + 14336); } while (0)
#define PV_MM(S, d0) do { \
        o[d0] = __builtin_amdgcn_mfma_f32_32x32x16_bf16(pa0, (bf16x8){S##l0[0], S##l0[1], S##l0[2], S##l0[3], S##h0[0], S##h0[1], S##h0[2], S##h0[3]}, o[d0], 0, 0, 0); \
        o[d0] = __builtin_amdgcn_mfma_f32_32x32x16_bf16(pa1, (bf16x8){S##l1[0], S##l1[1], S##l1[2], S##l1[3], S##h1[0], S##h1[1], S##h1[2], S##h1[3]}, o[d0], 0, 0, 0); \
        o[d0] = __builtin_amdgcn_mfma_f32_32x32x16_bf16(pa2, (bf16x8){S##l2[0], S##l2[1], S##l2[2], S##l2[3], S##h2[0], S##h2[1], S##h2[2], S##h2[3]}, o[d0], 0, 0, 0); \
        o[d0] = __builtin_amdgcn_mfma_f32_32x32x16_bf16(pa3, (bf16x8){S##l3[0], S##l3[1], S##l3[2], S##l3[3], S##h3[0], S##h3[1], S##h3[2], S##h3[3]}, o[d0], 0, 0, 0); } while (0)
#define PV_WAIT(n) do { asm volatile("s_waitcnt lgkmcnt(" #n ")" ::: "memory"); __builtin_amdgcn_sched_barrier(0); } while (0)
    s16x4 Al0, Al1, Al2, Al3, Ah0, Ah1, Ah2, Ah3, Bl0, Bl1, Bl2, Bl3, Bh0, Bh1, Bh2, Bh3;
    PV_LD(A, 0); PV_LD(B, 1); PV_WAIT(8); PV_MM(A, 0);
    __builtin_amdgcn_sched_barrier(0); PV_LD(A, 2); PV_WAIT(8); PV_MM(B, 1);
    __builtin_amdgcn_sched_barrier(0); PV_LD(B, 3); PV_WAIT(8); PV_MM(A, 2);
    PV_WAIT(0); PV_MM(B, 3);
#undef PV_WAIT
#undef PV_MM
#undef PV_LD
#undef TRRD
}
#define PK4(P, B_, OUT) do { const unsigned a0_ = cvtpk(P[B_ + 0], P[B_ + 1]), a1_ = cvtpk(P[B_ + 2], P[B_ + 3]); \
        const unsigned b0_ = cvtpk(P[B_ + 4], P[B_ + 5]), b1_ = cvtpk(P[B_ + 6], P[B_ + 7]); \
        auto r0_ = __builtin_amdgcn_permlane32_swap(a0_, b0_, false, false); auto r1_ = __builtin_amdgcn_permlane32_swap(a1_, b1_, false, false); \
        u32x4 w_ = {r0_[0], r1_[0], r0_[1], r1_[1]}; OUT = __builtin_bit_cast(bf16x8, w_); } while (0)

__device__ __forceinline__ void store_o_staged(const f32x16* o, const float* rli, bf16* Ow, int ldo, ALAS char* stg, int lane, int r32, int hi, float* ssqp) {
    ALAS unsigned short* s16 = (ALAS unsigned short*)stg;
#pragma unroll
    for (int r = 0; r < 16; ++r) { const int orow = crow(r, hi);
#pragma unroll
        for (int d0 = 0; d0 < 4; ++d0) { const float v = o[d0][r] * rli[r]; s16[orow * 128 + d0 * 32 + r32] = (unsigned short)cvtpk(v, v); } }
    asm volatile("s_waitcnt lgkmcnt(0)" ::: "memory");
#pragma unroll
    for (int i = 0; i < 8; ++i) { const int idx = i * 64 + lane, row = idx >> 4, ch = idx & 15;
        const u32x4 w = *(ALAS const u32x4*)(stg + row * 256 + ch * 16);
        *(u32x4*)(Ow + (size_t)row * ldo + ch * 8) = w;
        float s = 0.f; { const unsigned ww[4] = {w.x, w.y, w.z, w.w};
#pragma unroll
            for (int e = 0; e < 4; ++e) { const float x0 = __uint_as_float(ww[e] << 16), x1 = __uint_as_float(ww[e] & 0xffff0000u); s += x0 * x0 + x1 * x1; } }
        s += __shfl_xor(s, 1); s += __shfl_xor(s, 2); s += __shfl_xor(s, 4); s += __shfl_xor(s, 8);
        if (ch == 0) ssqp[(size_t)row * 32] = s; }
}
template <bool MLA>
__device__ __forceinline__ void attn_unit(const Unit u, ALAS char* lds) {
    int tid_o = threadIdx.x; asm volatile("" : "+v"(tid_o));
    const int tid = tid_o, wid = __builtin_amdgcn_readfirstlane(tid >> 6), lane = tid & 63, r32 = lane & 31, hi = lane >> 5;
    const bool actw = wid < u.nact;
    const int sr = tid >> 4, sc = (tid & 15) * 8;
    const int vst0 = v_st(sr, sc), vst1 = v_st(32 + sr, sc), kws = KSWZ(sr, sc * 2);
    const int rk = tid >> 3, rc = (tid & 7) * 8, rws = RSWZ(rk, rc * 2);
    ALAS char* V_l = lds + OFF_V; ALAS char* K_l = lds + OFF_K; ALAS char* R_l = lds + OFF_R;
    ALAS float* al_l = (ALAS float*)(lds + OFF_WS) + wid * 64; ALAS float* li_l = al_l + 32;
    const unsigned vbase = (unsigned)(uintptr_t)V_l + (unsigned)v_rd_base(lane);
    constexpr int NQ = MLA ? 12 : 8;
    bf16x8 qr[NQ];
#pragma unroll
    for (int d0 = 0; d0 < NQ; ++d0) qr[d0] = (bf16x8){0, 0, 0, 0, 0, 0, 0, 0};
    if (actw) {
#pragma unroll
        for (int d0 = 0; d0 < NQ; ++d0) qr[d0] = *(const bf16x8*)(u.Q + (size_t)(wid * 32 + r32) * u.ldq + d0 * 16 + hi * 8);
    }
    const int cw = (u.P0 + wid * 32) >> 6;
    const int qpos = u.P0 + wid * 32 + r32;
    float m_reg = -1e30f, l_reg = 0.f, carry = 0.f; bool fin = false;
    ALAS unsigned* flg = (ALAS unsigned*)(lds + OFF_FLG);
    f32x16 o[4];
#pragma unroll
    for (int d = 0; d < 4; ++d)
#pragma unroll
        for (int r = 0; r < 16; ++r) o[d][r] = 0.f;
    bf16x8 st_k0, st_k1, st_v0, st_v1, st_r = (bf16x8){0, 0, 0, 0, 0, 0, 0, 0};
    f32x4 fk[4], fv[4];
#define LOADT(tt) do { if (!MLA) { const int t_ = (tt); const bool lo_ = t_ < u.split; const size_t ro_ = (size_t)(lo_ ? t_ : t_ - u.split) * 64 * 2048; \
            const float* kb_ = (lo_ ? u.Kf0 : u.Kf1) + ro_ + (size_t)sr * 2048 + sc; const float* vb_ = (lo_ ? u.Vf0 : u.Vf1) + ro_ + (size_t)sr * 2048 + sc; \
            fk[0] = *(const f32x4*)kb_; fk[1] = *(const f32x4*)(kb_ + 4); fk[2] = *(const f32x4*)(kb_ + 32 * 2048); fk[3] = *(const f32x4*)(kb_ + 32 * 2048 + 4); \
            fv[0] = *(const f32x4*)vb_; fv[1] = *(const f32x4*)(vb_ + 4); fv[2] = *(const f32x4*)(vb_ + 32 * 2048); fv[3] = *(const f32x4*)(vb_ + 32 * 2048 + 4); } else { \
        const size_t r0_ = (size_t)(tt) * 64; \
        st_k0 = *(const bf16x8*)(u.K + (r0_ + sr) * 2048 + sc); st_k1 = *(const bf16x8*)(u.K + (r0_ + 32 + sr) * 2048 + sc); \
        st_v0 = *(const bf16x8*)(u.V + (r0_ + sr) * 2048 + sc); st_v1 = *(const bf16x8*)(u.V + (r0_ + 32 + sr) * 2048 + sc); \
        if (MLA) st_r = *(const bf16x8*)(u.Kr + (r0_ + rk) * 64 + rc); } } while (0)
    LOADT(MLA ? 0 : (u.NT - 1));
    for (int i = 0; i < u.NT; ++i) {
        const int t = MLA ? i : (u.NT - 1 - i); const int buf = i & 1;
        if (!MLA) { u32x4 w_;
            w_ = (u32x4){cvtpk(fk[0][0], fk[0][1]), cvtpk(fk[0][2], fk[0][3]), cvtpk(fk[1][0], fk[1][1]), cvtpk(fk[1][2], fk[1][3])}; st_k0 = __builtin_bit_cast(bf16x8, w_);
            w_ = (u32x4){cvtpk(fk[2][0], fk[2][1]), cvtpk(fk[2][2], fk[2][3]), cvtpk(fk[3][0], fk[3][1]), cvtpk(fk[3][2], fk[3][3])}; st_k1 = __builtin_bit_cast(bf16x8, w_);
            w_ = (u32x4){cvtpk(fv[0][0], fv[0][1]), cvtpk(fv[0][2], fv[0][3]), cvtpk(fv[1][0], fv[1][1]), cvtpk(fv[1][2], fv[1][3])}; st_v0 = __builtin_bit_cast(bf16x8, w_);
            w_ = (u32x4){cvtpk(fv[2][0], fv[2][1]), cvtpk(fv[2][2], fv[2][3]), cvtpk(fv[3][0], fv[3][1]), cvtpk(fv[3][2], fv[3][3])}; st_v1 = __builtin_bit_cast(bf16x8, w_); }
        *(ALAS bf16x8*)(K_l + buf * 16384 + kws) = st_k0; *(ALAS bf16x8*)(K_l + buf * 16384 + kws + 32 * 256) = st_k1;
        *(ALAS bf16x8*)(V_l + buf * 16384 + vst0) = st_v0; *(ALAS bf16x8*)(V_l + buf * 16384 + vst1) = st_v1;
        if (MLA) *(ALAS bf16x8*)(R_l + buf * 8192 + rws) = st_r;
        if (!MLA) { if (lane == 0) flg[buf * 8 + wid] = (fin || !actw) ? 1u : 0u; }
        __syncthreads();
        if (!MLA) {
            const u32x4 fa = *(ALAS const u32x4*)(flg + buf * 8), fb = *(ALAS const u32x4*)(flg + buf * 8 + 4);
            if ((fa.x & fa.y & fa.z & fa.w & fb.x & fb.y & fb.z & fb.w) != 0u) break;
        }
        if (i + 1 < u.NT) LOADT(MLA ? (i + 1) : (u.NT - 2 - i));
        if (actw && t <= cw && !fin) {
            f32x16 p0, p1;
#pragma unroll
            for (int r = 0; r < 16; ++r) { p0[r] = 0.f; p1[r] = 0.f; }
            qk128(p0, p1, K_l + buf * 16384, r32, hi, qr);
            if (MLA) qk64(p0, p1, R_l + buf * 8192, r32, hi, qr + (MLA ? 8 : 0));
            bf16x8 pa0, pa1, pa2, pa3;
            if (MLA) {
                float pmax = p0[0];
#pragma unroll
                for (int r = 1; r < 16; ++r) pmax = fmaxf(pmax, p0[r]);
#pragma unroll
                for (int r = 0; r < 16; ++r) pmax = fmaxf(pmax, p1[r]);
                { auto rr = __builtin_amdgcn_permlane32_swap(__float_as_uint(pmax), __float_as_uint(pmax), false, false);
                  pmax = fmaxf(__uint_as_float(rr[0]), __uint_as_float(rr[1])); }
                const float mn = fmaxf(m_reg, pmax); const float alpha = __builtin_amdgcn_exp2f(m_reg - mn); m_reg = mn;
                float ps = 0.f;
#pragma unroll
                for (int r = 0; r < 16; ++r) { p0[r] = __builtin_amdgcn_exp2f(p0[r] - mn); ps += p0[r]; }
#pragma unroll
                for (int r = 0; r < 16; ++r) { p1[r] = __builtin_amdgcn_exp2f(p1[r] - mn); ps += p1[r]; }
                { auto rr = __builtin_amdgcn_permlane32_swap(__float_as_uint(ps), __float_as_uint(ps), false, false);
                  ps = __uint_as_float(rr[0]) + __uint_as_float(rr[1]); }
                l_reg = l_reg * alpha + ps;
                if (__any(alpha < 1.f)) {
                    if (hi == 0) al_l[r32] = alpha;
                    asm volatile("s_waitcnt lgkmcnt(0)" ::: "memory");
#pragma unroll
                    for (int r = 0; r < 16; ++r) { const float a = al_l[crow(r, hi)];
#pragma unroll
                        for (int d = 0; d < 4; ++d) o[d][r] *= a; }
                    asm volatile("s_waitcnt lgkmcnt(0)" ::: "memory");
                }
            } else {
                const bool diag = (t == cw); const int dq = qpos - 64 * t - 4 * hi; const float NEG = -__builtin_inff();
                float suf = carry;
#define SB_HALF(P, KOFF) do { f32x16 f_; \
                    _Pragma("unroll") for (int r = 0; r < 16; ++r) { const float y = P[r]; const float e = __builtin_amdgcn_exp2f(-fabsf(y)); const float l2 = __builtin_amdgcn_logf(1.f + e); \
                        const float lb = fminf(y, 0.f) - l2; P[r] = lb; f_[r] = lb - y; } \
                    if (diag) { _Pragma("unroll") for (int r = 0; r < 16; ++r) { const int c = (r & 3) + 8 * (r >> 2) + (KOFF); if (!(c < dq)) { P[r] = NEG; f_[r] = 0.f; } } } \
                    float tg_[4], pg_[4]; \
                    _Pragma("unroll") for (int g = 0; g < 4; ++g) { const float a = (f_[4 * g] + f_[4 * g + 1]) + (f_[4 * g + 2] + f_[4 * g + 3]); \
                        auto rr = __builtin_amdgcn_permlane32_swap(__float_as_uint(a), __float_as_uint(a), false, false); \
                        const float lo = __uint_as_float(rr[0]), hh = __uint_as_float(rr[1]); tg_[g] = lo + hh; pg_[g] = hi == 0 ? hh : 0.f; } \
                    _Pragma("unroll") for (int g = 3; g >= 0; --g) { const float base = suf + pg_[g]; \
                        const float s2 = f_[4 * g + 3], s1 = s2 + f_[4 * g + 2], s0 = s1 + f_[4 * g + 1]; \
                        P[4 * g + 3] = __builtin_amdgcn_exp2f(P[4 * g + 3] + base); P[4 * g + 2] = __builtin_amdgcn_exp2f(P[4 * g + 2] + (base + s2)); \
                        P[4 * g + 1] = __builtin_amdgcn_exp2f(P[4 * g + 1] + (base + s1)); P[4 * g] = __builtin_amdgcn_exp2f(P[4 * g] + (base + s0)); \
                        suf += tg_[g]; } } while (0)
                SB_HALF(p1, 32);
                PK4(p1, 0, pa2); PK4(p1, 8, pa3);
                SB_HALF(p0, 0);
                PK4(p0, 0, pa0); PK4(p0, 8, pa1);
#undef SB_HALF
                carry = suf;
                fin = __all(carry < SB_DEAD);
            }
            if (MLA) { PK4(p0, 0, pa0); PK4(p0, 8, pa1); PK4(p1, 0, pa2); PK4(p1, 8, pa3); }
            pv_tile(o, vbase + (unsigned)(buf * 16384), pa0, pa1, pa2, pa3);
        }
    }
    __syncthreads();
    if (actw) {
        float rli[16];
        if (MLA) {
            if (hi == 0) li_l[r32] = l_reg;
            asm volatile("s_waitcnt lgkmcnt(0)" ::: "memory");
#pragma unroll
            for (int r = 0; r < 16; ++r) rli[r] = 1.0f / li_l[crow(r, hi)];
        } else {
#pragma unroll
            for (int r = 0; r < 16; ++r) rli[r] = 1.0f;
        }
        store_o_staged(o, rli, u.O + (size_t)(wid * 32) * u.ldo, u.ldo, lds + wid * 8192, lane, r32, hi, u.ssq + (size_t)(wid * 32) * 32);
    }
    __syncthreads();
#undef LOADT
}

__device__ __forceinline__ void qk192_pipe(f32x16& p0, f32x16& p1, ALAS const char* Kt, ALAS const char* Rt, int r32, int hi, const bf16x8* qr, const f32x16* cinit = nullptr) {
    constexpr int PF = 2;
    bf16x8 fa[12], fb[12];
#define QK_ADDR(s) ((s) < 8 ? Kt + KSWZ(r32, ((s) * 16 + hi * 8) * 2) : Rt + RSWZ(r32, (((s) - 8) * 16 + hi * 8) * 2))
#define QK_LD(s) do { ALAS const char* a_ = QK_ADDR(s); fa[s] = *(ALAS const bf16x8*)a_; fb[s] = *(ALAS const bf16x8*)(a_ + ((s) < 8 ? 32 * 256 : 32 * 128)); } while (0)
#pragma unroll
    for (int s = 0; s < PF; ++s) QK_LD(s);
#pragma unroll
    for (int s = 0; s < 12; ++s) {
        if (s + PF < 12) QK_LD(s + PF);
        __builtin_amdgcn_sched_barrier(0);
        p0 = __builtin_amdgcn_mfma_f32_32x32x16_bf16(fa[s], qr[s], (s == 0 && cinit) ? *cinit : p0, 0, 0, 0);
        p1 = __builtin_amdgcn_mfma_f32_32x32x16_bf16(fb[s], qr[s], (s == 0 && cinit) ? *cinit : p1, 0, 0, 0);
        __builtin_amdgcn_sched_barrier(0);
    }
#undef QK_LD
#undef QK_ADDR
}
constexpr float MLA_THR = 8.f;
__device__ __forceinline__ void mla_softmax(f32x16& p0, f32x16& p1, float& m_reg, float& l_reg, f32x16* o, ALAS float* al_l, int r32, int hi, bf16x8& pa0, bf16x8& pa1, bf16x8& pa2, bf16x8& pa3) {
    float pmax = p0[0];
#pragma unroll
    for (int r = 1; r < 16; ++r) pmax = fmaxf(pmax, p0[r]);
#pragma unroll
    for (int r = 0; r < 16; ++r) pmax = fmaxf(pmax, p1[r]);
    { auto rr = __builtin_amdgcn_permlane32_swap(__float_as_uint(pmax), __float_as_uint(pmax), false, false);
      pmax = fmaxf(__uint_as_float(rr[0]), __uint_as_float(rr[1])); }
    float mn = m_reg, alpha = 1.f;
    if (!__all(pmax - m_reg <= MLA_THR)) { mn = fmaxf(m_reg, pmax); alpha = __builtin_amdgcn_exp2f(m_reg - mn); m_reg = mn; }
    float ps = 0.f;
#pragma unroll
    for (int r = 0; r < 16; ++r) { p0[r] = __builtin_amdgcn_exp2f(p0[r] - mn); ps += p0[r]; }
#pragma unroll
    for (int r = 0; r < 16; ++r) { p1[r] = __builtin_amdgcn_exp2f(p1[r] - mn); ps += p1[r]; }
    { auto rr = __builtin_amdgcn_permlane32_swap(__float_as_uint(ps), __float_as_uint(ps), false, false);
      ps = __uint_as_float(rr[0]) + __uint_as_float(rr[1]); }
    l_reg = l_reg * alpha + ps;
    if (__any(alpha < 1.f)) {
        if (hi == 0) al_l[r32] = alpha;
        asm volatile("s_waitcnt lgkmcnt(0)" ::: "memory");
#pragma unroll
        for (int r = 0; r < 16; ++r) { const float a = al_l[crow(r, hi)];
#pragma unroll
            for (int d = 0; d < 4; ++d) o[d][r] *= a; }
        asm volatile("s_waitcnt lgkmcnt(0)" ::: "memory");
    }
    PK4(p0, 0, pa0); PK4(p0, 8, pa1); PK4(p1, 0, pa2); PK4(p1, 8, pa3);
}
__device__ __forceinline__ void mla_softmax_rel(f32x16& p0, f32x16& p1, float& m_reg, f32x16& negm, bool first, float& l_reg, f32x16* o, ALAS float* al_l, int r32, int hi, bf16x8& pa0, bf16x8& pa1, bf16x8& pa2, bf16x8& pa3) {
    float pmax = p0[0];
#pragma unroll
    for (int r = 1; r < 16; ++r) pmax = fmaxf(pmax, p0[r]);
#pragma unroll
    for (int r = 0; r < 16; ++r) pmax = fmaxf(pmax, p1[r]);
    { auto rr = __builtin_amdgcn_permlane32_swap(__float_as_uint(pmax), __float_as_uint(pmax), false, false);
      pmax = fmaxf(__uint_as_float(rr[0]), __uint_as_float(rr[1])); }
    if (first || !__all(pmax <= MLA_THR)) {
        const float delta = first ? pmax : fmaxf(pmax, 0.f); const float alpha = first ? 1.f : __builtin_amdgcn_exp2f(-delta);
        m_reg += delta; l_reg *= alpha;
#pragma unroll
        for (int r = 0; r < 16; ++r) { p0[r] -= delta; p1[r] -= delta; negm[r] = -m_reg; }
        if (!first) {
            if (hi == 0) al_l[r32] = alpha;
            asm volatile("s_waitcnt lgkmcnt(0)" ::: "memory");
#pragma unroll
            for (int r = 0; r < 16; ++r) { const float a = al_l[crow(r, hi)];
#pragma unroll
                for (int d = 0; d < 4; ++d) o[d][r] *= a; }
            asm volatile("s_waitcnt lgkmcnt(0)" ::: "memory");
        }
    }
    float ps = 0.f;
#pragma unroll
    for (int r = 0; r < 16; ++r) { p0[r] = __builtin_amdgcn_exp2f(p0[r]); ps += p0[r]; }
#pragma unroll
    for (int r = 0; r < 16; ++r) { p1[r] = __builtin_amdgcn_exp2f(p1[r]); ps += p1[r]; }
    { auto rr = __builtin_amdgcn_permlane32_swap(__float_as_uint(ps), __float_as_uint(ps), false, false);
      ps = __uint_as_float(rr[0]) + __uint_as_float(rr[1]); }
    l_reg += ps;
    PK4(p0, 0, pa0); PK4(p0, 8, pa1); PK4(p1, 0, pa2); PK4(p1, 8, pa3);
}
constexpr int M_OFF_V = 0, M_OFF_K = 49152, M_OFF_R = 81920, M_OFF_WS = 98304, MLA_LDS_BYTES = 98304 + 8 * 256;
template <bool ROLEB, int VAR = 0> __device__ __forceinline__ void mla_body(const Unit u, ALAS char* lds) {
    int tid_o = threadIdx.x; asm volatile("" : "+v"(tid_o));
    const int tid = tid_o, wid = __builtin_amdgcn_readfirstlane(tid >> 6), lane = tid & 63, r32 = lane & 31, hi = lane >> 5;
    const bool actw = wid < u.nact; constexpr bool roleB = ROLEB;
    const int sr = tid >> 4, sc = (tid & 15) * 8;
    const int vst0 = v_st(sr, sc), vst1 = v_st(32 + sr, sc), kws = KSWZ(sr, sc * 2);
    const int rk = tid >> 3, rc = (tid & 7) * 8, rws = RSWZ(rk, rc * 2);
    ALAS char* V_l = lds + M_OFF_V; ALAS char* K_l = lds + M_OFF_K; ALAS char* R_l = lds + M_OFF_R;
    ALAS float* al_l = (ALAS float*)(lds + M_OFF_WS) + wid * 64; ALAS float* li_l = al_l + 32;
    const unsigned vbase = (unsigned)(uintptr_t)V_l + (unsigned)v_rd_base(lane);
    bf16x8 qr[12];
#pragma unroll
    for (int d0 = 0; d0 < 12; ++d0) qr[d0] = (bf16x8){0, 0, 0, 0, 0, 0, 0, 0};
    if (actw) {
#pragma unroll
        for (int d0 = 0; d0 < 12; ++d0) qr[d0] = *(const bf16x8*)(u.Q + (size_t)(wid * 32 + r32) * u.ldq + d0 * 16 + hi * 8);
    }
    const int cw = (u.P0 + wid * 32) >> 6;
    float m_reg = -1e30f, l_reg = 0.f;
    f32x16 o[4], p0, p1;
#pragma unroll
    for (int r = 0; r < 16; ++r) { p0[r] = 0.f; p1[r] = 0.f; }
#pragma unroll
    for (int d = 0; d < 4; ++d)
#pragma unroll
        for (int r = 0; r < 16; ++r) o[d][r] = 0.f;
    bf16x8 st_k0, st_k1, st_v0, st_v1, st_r;
#define LOADT(tt) do { const size_t r0_ = (size_t)(tt) * 64; \
        st_k0 = *(const bf16x8*)(u.K + (r0_ + sr) * 2048 + sc); st_k1 = *(const bf16x8*)(u.K + (r0_ + 32 + sr) * 2048 + sc); \
        st_v0 = *(const bf16x8*)(u.V + (r0_ + sr) * 2048 + sc); st_v1 = *(const bf16x8*)(u.V + (r0_ + 32 + sr) * 2048 + sc); \
        st_r = *(const bf16x8*)(u.Kr + (r0_ + rk) * 64 + rc); } while (0)
#define MLA_QK(kb) do { _Pragma("unroll") for (int r = 0; r < 16; ++r) { p0[r] = 0.f; p1[r] = 0.f; } \
        if (VAR == 4 || VAR == 0 || VAR == 5) qk192_pipe(p0, p1, K_l + (kb) * 16384, R_l + (kb) * 8192, r32, hi, qr); else if (VAR != 3) { qk128(p0, p1, K_l + (kb) * 16384, r32, hi, qr); qk64(p0, p1, R_l + (kb) * 8192, r32, hi, qr + 8); } } while (0)
#define MLA_SMPV(vs) do { bf16x8 pa0, pa1, pa2, pa3; \
        if (VAR == 1) { PK4(p0, 0, pa0); PK4(p0, 8, pa1); PK4(p1, 0, pa2); PK4(p1, 8, pa3); l_reg += p0[0]; } \
        else mla_softmax(p0, p1, m_reg, l_reg, o, al_l, r32, hi, pa0, pa1, pa2, pa3); \
        if (VAR != 2) pv_tile(o, vbase + (unsigned)((vs) * 16384), pa0, pa1, pa2, pa3); \
        else { _Pragma("unroll") for (int r = 0; r < 4; ++r) o[r][0] += __builtin_bit_cast(float, (unsigned)pa0[r] ^ (unsigned)pa1[r] ^ (unsigned)pa2[r] ^ (unsigned)pa3[r]); } } while (0)
    LOADT(0);
    int vs_cur = 0, vs_prev = 2;
    for (int i = 0; i <= u.NT; ++i) {
        const int kb = i & 1;
        if (i < u.NT && VAR != 5) {
            *(ALAS bf16x8*)(K_l + kb * 16384 + kws) = st_k0; *(ALAS bf16x8*)(K_l + kb * 16384 + kws + 32 * 256) = st_k1;
            *(ALAS bf16x8*)(V_l + vs_cur * 16384 + vst0) = st_v0; *(ALAS bf16x8*)(V_l + vs_cur * 16384 + vst1) = st_v1;
            *(ALAS bf16x8*)(R_l + kb * 8192 + rws) = st_r;
            __syncthreads();
            if (i + 1 < u.NT) LOADT(i + 1);
        }
        if (actw) {
            if constexpr (!roleB) { if (i < u.NT && i <= cw) { MLA_QK(kb); MLA_SMPV(vs_cur); } }
            else { if (i >= 1 && i - 1 <= cw) MLA_SMPV(vs_prev);
                   if (i < u.NT && i <= cw) MLA_QK(kb); }
        }
        vs_prev = vs_cur; vs_cur = (vs_cur == 2) ? 0 : vs_cur + 1;
    }
    if (actw) {
        if (hi == 0) li_l[r32] = l_reg;
        asm volatile("s_waitcnt lgkmcnt(0)" ::: "memory");
        float rli[16];
#pragma unroll
        for (int r = 0; r < 16; ++r) rli[r] = 1.0f / li_l[crow(r, hi)];
        bf16* Ow = u.O + (size_t)(wid * 32) * u.ldo;
#pragma unroll
        for (int r = 0; r < 16; ++r) { const int orow = crow(r, hi); float sq = 0.f;
#pragma unroll
            for (int d0 = 0; d0 < 4; ++d0) { const float v = o[d0][r] * rli[r]; const float vn = __shfl_xor(v, 1); sq += v * v;
                if ((r32 & 1) == 0) *(unsigned*)(Ow + (size_t)orow * u.ldo + d0 * 32 + r32) = cvtpk(v, vn); }
            sq += __shfl_xor(sq, 1); sq += __shfl_xor(sq, 2); sq += __shfl_xor(sq, 4); sq += __shfl_xor(sq, 8); sq += __shfl_xor(sq, 16);
            if (ATT_SSQ_ATOMICS && r32 == 0) __hip_atomic_fetch_add(u.ssq + wid * 32 + orow, sq, __ATOMIC_RELAXED, __HIP_MEMORY_SCOPE_AGENT); }
    }
    __syncthreads();
#undef LOADT
#undef MLA_QK
#undef MLA_SMPV
}
constexpr int D_OFF_K = 0, D_OFF_R = 49152, D_OFF_V = 73728, D_OFF_WS = 122880, DMA_LDS_BYTES = 122880 + 8 * 256;
template <int VAR = 0> __device__ __forceinline__ void mla_unit_dma(const Unit u, ALAS char* lds) {
    int tid_o = threadIdx.x; asm volatile("" : "+v"(tid_o));
    const int tid = tid_o, wid = __builtin_amdgcn_readfirstlane(tid >> 6), lane = tid & 63, r32 = lane & 31, hi = lane >> 5;
    const bool actw = wid < u.nact;
    if (false) __builtin_amdgcn_s_setprio(1);
    ALAS char* K_l = lds + D_OFF_K; ALAS char* R_l = lds + D_OFF_R; ALAS char* V_l = lds + D_OFF_V;
    ALAS float* al_l = (ALAS float*)(lds + D_OFF_WS) + wid * 64; ALAS float* li_l = al_l + 32;
    const unsigned vbase = (unsigned)(uintptr_t)V_l + (unsigned)v_rd_base(lane);
    unsigned offK[2], offV[2], offR;
#pragma unroll
    for (int j = 0; j < 2; ++j) {
        const int p = wid + 8 * j;
        { const int r = 4 * p + (lane >> 4), c = (lane & 15) ^ (r & 15); offK[j] = (unsigned)(r * 4096 + c * 16); }
        { const int sti = 2 * p + (lane >> 5), kk = (sti >> 2) * 8 + ((lane & 31) >> 2), k = (kk & ~0xC) | ((kk & 4) << 1) | ((kk & 8) >> 1), c = (sti & 3) * 32 + (lane & 3) * 8; offV[j] = (unsigned)(k * 4096 + c * 2); }
    }
    { const int r = 8 * wid + (lane >> 3), c = (lane & 7) ^ ((r >> 1) & 7); offR = (unsigned)(r * 128 + c * 16); }
    const char* gK = (const char*)u.K; const char* gV = (const char*)u.V; const char* gR = (const char*)u.Kr;
#define DMA_TILE(tt, slot) do { const size_t tb_ = (size_t)(tt) * 64; \
        __builtin_amdgcn_global_load_lds((const unsigned*)(gK + tb_ * 4096 + offK[0]), (ALAS unsigned*)(K_l + (slot) * 16384 + wid * 1024), 16, 0, 0); \
        __builtin_amdgcn_global_load_lds((const unsigned*)(gK + tb_ * 4096 + offK[1]), (ALAS unsigned*)(K_l + (slot) * 16384 + (wid + 8) * 1024), 16, 0, 0); \
        __builtin_amdgcn_global_load_lds((const unsigned*)(gR + tb_ * 128 + offR), (ALAS unsigned*)(R_l + (slot) * 8192 + wid * 1024), 16, 0, 0); \
        __builtin_amdgcn_global_load_lds((const unsigned*)(gV + tb_ * 4096 + offV[0]), (ALAS unsigned*)(V_l + (slot) * 16384 + wid * 1024), 16, 0, 0); \
        __builtin_amdgcn_global_load_lds((const unsigned*)(gV + tb_ * 4096 + offV[1]), (ALAS unsigned*)(V_l + (slot) * 16384 + (wid + 8) * 1024), 16, 0, 0); } while (0)
    bf16x8 qr[12];
#pragma unroll
    for (int d0 = 0; d0 < 12; ++d0) qr[d0] = (bf16x8){0, 0, 0, 0, 0, 0, 0, 0};
    if (actw) {
#pragma unroll
        for (int d0 = 0; d0 < 12; ++d0) qr[d0] = *(const bf16x8*)(u.Q + (size_t)(wid * 32 + r32) * u.ldq + d0 * 16 + hi * 8);
    }
#pragma unroll
    for (int d0 = 0; d0 < 12; ++d0) asm volatile("" : "+v"(qr[d0]));
    DMA_TILE(0, 0); if (u.NT > 1) DMA_TILE(1, 1);
    const int cw = (u.P0 + wid * 32) >> 6;
    float m_reg = 0.f, l_reg = 0.f;
    f32x16 o[4], p0, p1, negm;
#pragma unroll
    for (int r = 0; r < 16; ++r) negm[r] = 0.f;
#pragma unroll
    for (int d = 0; d < 4; ++d)
#pragma unroll
        for (int r = 0; r < 16; ++r) o[d][r] = 0.f;
    int sl = 0, sl2 = 2;
    for (int i = 0; i < u.NT; ++i) {
        if (i + 1 < u.NT) asm volatile("s_waitcnt vmcnt(5) lgkmcnt(0)" ::: "memory"); else asm volatile("s_waitcnt vmcnt(0) lgkmcnt(0)" ::: "memory");
        __builtin_amdgcn_s_barrier(); asm volatile("" ::: "memory");
        if (i + 2 < u.NT) DMA_TILE(i + 2, sl2);
        if (actw && i <= cw) {
            __builtin_amdgcn_s_setprio(1); qk192_pipe(p0, p1, K_l + sl * 16384, R_l + sl * 8192, r32, hi, qr, &negm); __builtin_amdgcn_s_setprio(0);
            bf16x8 pa0, pa1, pa2, pa3;
            mla_softmax_rel(p0, p1, m_reg, negm, i == 0, l_reg, o, al_l, r32, hi, pa0, pa1, pa2, pa3);
            __builtin_amdgcn_s_setprio(1); pv_tile(o, vbase + (unsigned)(sl * 16384), pa0, pa1, pa2, pa3); __builtin_amdgcn_s_setprio(0);
        }
        sl = (sl == 2) ? 0 : sl + 1; sl2 = (sl2 == 2) ? 0 : sl2 + 1;
    }
    asm volatile("s_waitcnt lgkmcnt(0)" ::: "memory"); __builtin_amdgcn_s_barrier(); asm volatile("" ::: "memory");
    if (actw) {
        if (hi == 0) li_l[r32] = l_reg;
        asm volatile("s_waitcnt lgkmcnt(0)" ::: "memory");
        float rli[16];
#pragma unroll
        for (int r = 0; r < 16; ++r) rli[r] = 1.0f / li_l[crow(r, hi)];
        store_o_staged(o, rli, u.O + (size_t)(wid * 32) * u.ldo, u.ldo, lds + wid * 8192, lane, r32, hi, u.ssq + (size_t)(wid * 32) * 32);
    }
    asm volatile("s_waitcnt lgkmcnt(0)" ::: "memory"); __builtin_amdgcn_s_barrier(); asm volatile("" ::: "memory");
    __builtin_amdgcn_s_setprio(0);
#undef DMA_TILE
}
template <int VAR = 0> __device__ __forceinline__ void mla_unit(const Unit u, ALAS char* lds) {
    int tid_o = threadIdx.x; asm volatile("" : "+v"(tid_o));
    if (__builtin_amdgcn_readfirstlane(tid_o >> 6) >= 4) mla_body<true, VAR>(u, lds); else mla_body<false, VAR>(u, lds);
}
#undef PK4
}
#define GAS __attribute__((address_space(1)))
#define LAS __attribute__((address_space(3)))
typedef unsigned short bf16;
typedef unsigned v4u __attribute__((ext_vector_type(4)));
typedef float f32x4 __attribute__((ext_vector_type(4)));
typedef short bf16x8 __attribute__((ext_vector_type(8)));
typedef GAS unsigned gu32;
typedef GAS unsigned long long gu64;
#define RLX_AGENT __ATOMIC_RELAXED, __HIP_MEMORY_SCOPE_AGENT
#define LDS_WAIT() asm volatile("s_waitcnt lgkmcnt(0)" ::: "memory")
#define VM_WAIT() asm volatile("s_waitcnt vmcnt(0)" ::: "memory")
__device__ __forceinline__ unsigned long long rt() { return __builtin_amdgcn_s_memrealtime(); }
__device__ __forceinline__ unsigned f2bf(float f) { unsigned u = __builtin_bit_cast(unsigned, f); return (u + 0x7fffu + ((u >> 16) & 1u)) >> 16; }
__device__ __forceinline__ unsigned pk2(float lo, float hi) { return f2bf(lo) | (f2bf(hi) << 16); }

#define XB_TMO      128
#define XB_XCNT(j)  (256  + 64 * (j))
#define XB_XSUB(j)  (1280 + 64 * (j))
#define XB_XGEN(j)  (2304 + 64 * (j))
#define XB_TOP      3328
#define XB_TOPGEN   3392
#define XCD_BAR_WORDS 3456
#define XB_SPIN_CAP (1u << 18)

__device__ __forceinline__ unsigned xb_ld(unsigned* p)              { return __hip_atomic_load(p, __ATOMIC_RELAXED, __HIP_MEMORY_SCOPE_AGENT); }
__device__ __forceinline__ unsigned xb_add(unsigned* p, unsigned v) { return __hip_atomic_fetch_add(p, v, __ATOMIC_RELAXED, __HIP_MEMORY_SCOPE_AGENT); }
__device__ __forceinline__ unsigned xb_xcc_id() { return (unsigned)__builtin_amdgcn_s_getreg((3 << 11) | 20) & 0xFu; }
#define XB_SPIN(cond, bar) do { unsigned _sp = 0; while (cond) { __builtin_amdgcn_s_sleep(1); \
    if ((++_sp & 255u) == 0u) { if (xb_ld(&(bar)[XB_TMO])) break; if (_sp > XB_SPIN_CAP) { atomicAdd(&(bar)[XB_TMO], 1u); break; } } } } while (0)

struct XcdBarrier {
    unsigned* bar; unsigned x;
    volatile LAS unsigned* st;
};

__device__ __forceinline__ XcdBarrier xcd_barrier_post(unsigned* bar, volatile LAS unsigned* st) {
    XcdBarrier b; b.bar = bar; b.x = xb_xcc_id(); b.st = st;
    if (threadIdx.x == 0) (void)xb_add(&bar[XB_XCNT(b.x)], 1u);
    return b;
}
__device__ __forceinline__ void xcd_barrier_complete(unsigned* bar, unsigned x, unsigned& nloc, unsigned& nx) {
    const unsigned G = gridDim.x * gridDim.y * gridDim.z;
    unsigned sum, cnt, mine, sp = 0u;
    for (;;) {
        sum = 0u; cnt = 0u; mine = 0u;
#pragma unroll
        for (unsigned j = 0; j < 16; ++j) { const unsigned c = xb_ld(&bar[XB_XCNT(j)]); sum += c; cnt += (c > 0u) ? 1u : 0u; mine = (j == x) ? c : mine; }
        if (sum == G) break;
        __builtin_amdgcn_s_sleep(1);
        if ((++sp & 255u) == 0u) { if (xb_ld(&bar[XB_TMO])) break; if (sp > XB_SPIN_CAP) { atomicAdd(&bar[XB_TMO], 1u); break; } }
    }
    nloc = mine > 0u ? mine : 1u; nx = cnt > 0u ? cnt : 1u;
}

__device__ __forceinline__ void xcd_barrier(const XcdBarrier& b) {
    asm volatile("s_waitcnt vmcnt(0)" ::: "memory");
    __syncthreads();
    if (threadIdx.x == 0) {
        unsigned* bar = b.bar;
        __builtin_amdgcn_s_waitcnt(0);
        unsigned nloc = b.st[0], nx = b.st[1];
        if (nloc == 0u) { xcd_barrier_complete(bar, b.x, nloc, nx); b.st[0] = nloc; b.st[1] = nx; }
        const unsigned old = xb_add(&bar[XB_XSUB(b.x)], 1u);
        const unsigned gen = old / nloc;
        if (old + 1u == (gen + 1u) * nloc) {
            __builtin_amdgcn_fence(__ATOMIC_RELEASE, "agent");
            asm volatile("s_waitcnt vmcnt(0)" ::: "memory");
            const unsigned og = xb_add(&bar[XB_TOP], 1u);
            const unsigned tg = og / nx;
            if (og + 1u == (tg + 1u) * nx) xb_add(&bar[XB_TOPGEN], 1u);
            else XB_SPIN(xb_ld(&bar[XB_TOPGEN]) == tg, bar);
            __builtin_amdgcn_fence(__ATOMIC_ACQUIRE, "agent");
            xb_add(&bar[XB_XGEN(b.x)], 1u);
            asm volatile("s_waitcnt vmcnt(0)" ::: "memory");
        } else {
            XB_SPIN(xb_ld(&bar[XB_XGEN(b.x)]) == gen, bar);
            __builtin_amdgcn_fence(__ATOMIC_ACQUIRE, "agent");
            asm volatile("s_waitcnt vmcnt(0)" ::: "memory");
        }
    }
    __syncthreads();
}
constexpr int NWAVES = 8;
constexpr int DM = 4096, NP = 16384, NS = 512, MTOK = NP + NS;
constexpr int SEQ = 4096, PAST = 1024, DSEQ = 64, SKVS = PAST + DSEQ;
constexpr int KVROWS = NP + 8 * SKVS;
constexpr int NINP = 7936;
constexpr int QLORA = 1024, KVLORA = 512, ROPE = 64, NOPE = 128, NH = 16, DFF = 16384;
constexpr float EPS = 1e-6f;
constexpr float LOG2E = 1.4426950408889634f;
constexpr float QS_MLA = 0.07216878364870322f * LOG2E;
constexpr float QS_SB = 0.08838834764831845f * LOG2E;

constexpr size_t O_Y = 0, O_CKV_P = 69206016, O_KR_P = 85983232, O_SBK_P = 88080384, O_SBV_P = 155189248,
                 O_CKV_S = 222298112, O_KR_S = 222822400, O_SBK_S = 222887936, O_SBV_S = 224985088, O_END = 227082240;

constexpr size_t MiB = 1u << 20;
constexpr size_t WS_CTL = 0, CTL_ZERO_BYTES = 1 * MiB;
constexpr size_t WS_SSQH = 512 * 1024;
constexpr size_t WS_TAB = 1 * MiB;
constexpr size_t WS_WIN = 2 * MiB;
constexpr size_t WS_WQB = 64 * MiB;
constexpr size_t WS_WKVB = 70 * MiB;
constexpr size_t WS_WO = 74 * MiB;
constexpr size_t WS_WUP = 106 * MiB;
constexpr size_t WS_WDN = 234 * MiB;
constexpr size_t WS_XN = 362 * MiB;
constexpr size_t WS_R = 494 * MiB;
constexpr size_t WS_U = WS_R;
constexpr size_t WS_QLAT = WS_R;
constexpr size_t WS_AKV = WS_QLAT + 33 * MiB;
constexpr size_t WS_KROPE = WS_AKV + 25 * MiB;
constexpr size_t WS_VB = WS_KROPE + 4 * MiB;
constexpr size_t WS_QB = WS_VB + 98 * MiB;
constexpr size_t WS_KN = WS_QB + 99 * MiB;
constexpr size_t WS_SBQ = WS_KN + 98 * MiB;
constexpr size_t WS_SBK = WS_SBQ + 66 * MiB;
constexpr size_t WS_SBV = WS_SBK + 98 * MiB;
constexpr size_t WS_R2 = WS_SBV + 98 * MiB;
constexpr size_t WS_LAT = WS_R2;
constexpr size_t WS_QRAW = WS_R2;
constexpr size_t WS_KNRAW = WS_R2 + 198 * MiB;
constexpr size_t WS_MLAO = WS_R2;
constexpr size_t WS_SBO = WS_R2 + 66 * MiB;
constexpr size_t WS_MERGED = WS_R2 + 132 * MiB;
constexpr size_t WS_SLAB = WS_R2;
constexpr size_t WS_Y0B = WS_R2 + 264 * MiB;
constexpr size_t WS_WDN1 = WS_R2 + 398 * MiB;
constexpr size_t WS_SSQP = WS_WDN1 + 128 * MiB;
constexpr size_t WS_END = WS_SSQP + 3 * MiB;
static_assert(WS_U + (size_t)MTOK * DFF * 2 <= WS_END, "U fits the overlay region");
static_assert(WS_XN + (size_t)MTOK * DM * 2 <= WS_R && WS_WDN + (size_t)DM * DFF * 2 <= WS_XN && WS_WIN + (size_t)NINP * DM * 2 <= WS_WQB, "ws map");
constexpr int CW_TMO = 0, CW_CODE = 1, CW_BAR = 4096;

constexpr int RING_OFF = 0, RING_BYTES = 131072;
constexpr int LDSCTL_OFF = RING_BYTES, MISC_OFF = LDSCTL_OFF + 320;
constexpr int XCH_OFF = LDSCTL_OFF + 1024;
constexpr int LDS_BYTES = 147456;
static_assert(XCH_OFF + 8192 <= LDS_BYTES, "LDS map");
static_assert(att::ATT_LDS_BYTES <= RING_BYTES && att::MLA_LDS_BYTES <= RING_BYTES && att::DMA_LDS_BYTES <= RING_BYTES, "attention scratch fits the ring region");

#if defined(__HIP_DEVICE_COMPILE__)
#define ASSUME_GLOBAL(p) do { __builtin_assume(!__builtin_amdgcn_is_shared((const __attribute__((address_space(0))) void*)(p))); __builtin_assume(!__builtin_amdgcn_is_private((const __attribute__((address_space(0))) void*)(p))); } while (0)
#else
#define ASSUME_GLOBAL(p) do { } while (0)
#endif
typedef float f32x2 __attribute__((ext_vector_type(2)));
__device__ __forceinline__ float wave_sum(float v) {
#pragma unroll
    for (int o = 1; o < 64; o <<= 1) v += __shfl_xor(v, o);
    return v;
}
__device__ __forceinline__ unsigned pkbf(float lo, float hi) { return pg8::cvt_pk_bf16(lo, hi); }
__device__ __forceinline__ float bf2f(unsigned short b) { return __uint_as_float(((unsigned)b) << 16); }
__device__ __forceinline__ int kvrow_of(int m) { return m < NP ? m : NP + ((m - NP) >> 6) * SKVS + PAST + ((m - NP) & 63); }
__device__ __forceinline__ int pos_of(int m) { return m < NP ? (m & (SEQ - 1)) : PAST + ((m - NP) & 63); }

__device__ __forceinline__ void sincos_acc(float ang, float& s, float& c) {
    const double a = (double)ang; const double q = rint(a * 0.63661977236758134308);
    double r = fma(-q, 1.57079632679489661923, a); r = fma(-q, 6.123233995736766e-17, r);
    const float rf = (float)r; const int qi = (int)q; const float r2 = rf * rf;
    const float sp = rf + rf * r2 * (-1.6666667163e-1f + r2 * (8.3333337680e-3f + r2 * (-1.9841270114e-4f + r2 * 2.7557314297e-6f)));
    const float cp = 1.f + r2 * (-0.5f + r2 * (4.1666667908e-2f + r2 * (-1.3888889225e-3f + r2 * (2.4801587642e-5f + r2 * (-2.7557314297e-7f)))));
    switch (qi & 3) { case 0: s = sp; c = cp; break; case 1: s = cp; c = -sp; break; case 2: s = -sp; c = -cp; break; default: s = -cp; c = sp; break; }
}

struct Frame {
    LAS unsigned char* lds; volatile LAS unsigned* MISC; gu32* ctl;
    int tid, lane, wave, vcu, G;
};
struct Args { const float* in[22]; float* out; unsigned char* ws; };

struct TItem { const float* src; bf16* dst; const float* gk; int N, K; };
__device__ __forceinline__ void ti_load(const TItem& P, float (&tv)[32], f32x4& g0, f32x4& g1, int lane) {
    if (P.gk) { g0 = *(const GAS f32x4*)(P.gk + 8 * (lane & 7)); g1 = *(const GAS f32x4*)(P.gk + 8 * (lane & 7) + 4); }
    else { g0 = f32x4{1.f, 1.f, 1.f, 1.f}; g1 = g0; }
    const GAS float* s = (const GAS float*)P.src + (size_t)(lane >> 5) * P.N + (lane & 31);
#pragma unroll
    for (int i = 0; i < 32; ++i) tv[i] = s[(size_t)(2 * i) * P.N];
}
__device__ __forceinline__ void ti_finish(const TItem& P, const float (&tv)[32], const f32x4 g0, const f32x4 g1, LAS float* scr, int lane) {
#pragma unroll
    for (int i = 0; i < 32; ++i) scr[(2 * i + (lane >> 5)) * 33 + (lane & 31)] = tv[i];
    LDS_WAIT(); asm volatile("" ::: "memory");
    const int c = lane & 7;
#pragma unroll
    for (int j = 0; j < 4; ++j) { const int n = (lane >> 3) + 8 * j; const LAS float* s = scr + (8 * c) * 33 + n;
        v4u o; o.x = pkbf(s[0 * 33] * g0.x, s[1 * 33] * g0.y); o.y = pkbf(s[2 * 33] * g0.z, s[3 * 33] * g0.w); o.z = pkbf(s[4 * 33] * g1.x, s[5 * 33] * g1.y); o.w = pkbf(s[6 * 33] * g1.z, s[7 * 33] * g1.w);
        *(GAS v4u*)(P.dst + (size_t)n * P.K + 8 * c) = o; }
    LDS_WAIT(); asm volatile("" ::: "memory");
}
__device__ __forceinline__ void rms_row_4096(const float* xrow, const float* g, bf16* orow, int lane) {
    const GAS f32x4* xr = (const GAS f32x4*)xrow + lane; const GAS f32x4* gr = (const GAS f32x4*)g + lane;
    f32x4 v[16]; float s = 0.f;
#pragma unroll
    for (int j = 0; j < 16; ++j) { v[j] = xr[64 * j]; s += (v[j].x * v[j].x + v[j].y * v[j].y) + (v[j].z * v[j].z + v[j].w * v[j].w); }
    const float rstd = 1.0f / sqrtf(wave_sum(s) * (1.f / 4096.f) + EPS);
    GAS unsigned long long* o8 = (GAS unsigned long long*)orow + lane;
#pragma unroll
    for (int j = 0; j < 16; ++j) { const f32x4 gg = gr[64 * j];
        o8[64 * j] = (unsigned long long)pkbf(v[j].x * rstd * gg.x, v[j].y * rstd * gg.y) | ((unsigned long long)pkbf(v[j].z * rstd * gg.z, v[j].w * rstd * gg.w) << 32); }
}
__device__ __forceinline__ void rms_row_4096_bf16(const bf16* xrow, const float* g, bf16* orow, int lane) {
    const GAS v4u* xr = (const GAS v4u*)xrow + lane; float x[64]; float s = 0.f;
#pragma unroll
    for (int j = 0; j < 8; ++j) { const v4u w = xr[64 * j]; const unsigned ww[4] = {w.x, w.y, w.z, w.w};
#pragma unroll
        for (int e = 0; e < 4; ++e) { x[8 * j + 2 * e] = __uint_as_float(ww[e] << 16); x[8 * j + 2 * e + 1] = __uint_as_float(ww[e] & 0xffff0000u); } }
#pragma unroll
    for (int i = 0; i < 64; ++i) s += x[i] * x[i];
    const float rstd = 1.0f / sqrtf(wave_sum(s) * (1.f / 4096.f) + EPS);
#pragma unroll
    for (int j = 0; j < 8; ++j) { const GAS f32x4* gp = (const GAS f32x4*)(g + 8 * (64 * j + lane)); const f32x4 g0 = gp[0], g1 = gp[1];
        v4u o; o.x = pkbf(x[8 * j] * rstd * g0.x, x[8 * j + 1] * rstd * g0.y); o.y = pkbf(x[8 * j + 2] * rstd * g0.z, x[8 * j + 3] * rstd * g0.w);
        o.z = pkbf(x[8 * j + 4] * rstd * g1.x, x[8 * j + 5] * rstd * g1.y); o.w = pkbf(x[8 * j + 6] * rstd * g1.z, x[8 * j + 7] * rstd * g1.w);
        *((GAS v4u*)orow + 64 * j + lane) = o; }
}
__device__ __forceinline__ void cache_rows_to_bf16(const float* src, bf16* dst, int W, int gthread, int nthreads) {
    const int per_row = W >> 2; const long total = (long)8 * PAST * per_row;
    for (long i = gthread; i < total; i += nthreads) {
        const int row = (int)(i / per_row), c4 = (int)(i % per_row), b = row >> 10, j = row & 1023;
        const f32x4 v = *(const GAS f32x4*)(src + (size_t)row * W + c4 * 4);
        *(GAS unsigned long long*)(dst + (size_t)(NP + b * SKVS + j) * W + c4 * 4) = (unsigned long long)pkbf(v.x, v.y) | ((unsigned long long)pkbf(v.z, v.w) << 32);
    }
}

template <bool NORM, class Order>
__device__ __forceinline__ void tail_reduce_res(const Order& S, const float* resP, const float* resS, float* out, bf16* HB, float* ssq, const float* ssqm, const float* ssqs, bf16* YB, int tid) {
    if (S.nsplit == 1) return;
    const int wid = __builtin_amdgcn_readfirstlane(tid >> 6), lane = tid & 63, wr = wid >> 2, wc = wid & 3, fr = lane & 15, fq = lane >> 4;
    const int j = S.c / S.nsplit, p = S.c % S.nsplit, per = 32 / S.nsplit;
    pg8::Unit u; S.map(S.nfull * S.G + j, u);
    for (int ii = 0; ii < per; ++ii) {
        const int idx = p * per + ii, a = idx >> 4, b = (idx >> 3) & 1, mm = (idx >> 1) & 3, n = idx & 1;
        const int row = u.pm * 256 + a * 128 + wr * 64 + mm * 16 + fr, col = u.pn * 256 + b * 128 + wc * 32 + 8 * fq + 4 * n;
        f32x4 s = {0.f, 0.f, 0.f, 0.f}, s2 = {0.f, 0.f, 0.f, 0.f};
        for (int sp = 0; sp < S.nsplit; ++sp) { const f32x4 v = *((const GAS f32x4*)(S.slab + (size_t)(j * S.nsplit + sp) * 65536) + (size_t)wid * 2048 + idx * 64 + lane); if (2 * sp < S.nsplit) s += v; else s2 += v; }
        if (NORM) {
            const float rm = 1.0f / sqrtf(__hip_atomic_load(ssqm + row, __ATOMIC_RELAXED, __HIP_MEMORY_SCOPE_AGENT) * (1.f / 2048.f) + EPS), rs = 1.0f / sqrtf(__hip_atomic_load(ssqs + row, __ATOMIC_RELAXED, __HIP_MEMORY_SCOPE_AGENT) * (1.f / 2048.f) + EPS);
            s = s * rm + s2 * rs; } else s += s2;
        f32x4 v;
        if (NORM) { if (YB) { const unsigned long long h = *(const GAS unsigned long long*)(YB + (size_t)row * DM + col); const unsigned h0 = (unsigned)h, h1 = (unsigned)(h >> 32);
                                v = (f32x4){__uint_as_float(h0 << 16), __uint_as_float(h0 & 0xffff0000u), __uint_as_float(h1 << 16), __uint_as_float(h1 & 0xffff0000u)} + s; }
                    else { const float* rp = (row >= NP) ? resS + (size_t)(row - NP) * DM + col : resP + (size_t)row * DM + col; v = *(const GAS f32x4*)rp + s; } }
        else { const unsigned long long h = *(const GAS unsigned long long*)(HB + (size_t)row * DM + col); const unsigned h0 = (unsigned)h, h1 = (unsigned)(h >> 32);
               v = (f32x4){__uint_as_float(h0 << 16), __uint_as_float(h0 & 0xffff0000u), __uint_as_float(h1 << 16), __uint_as_float(h1 & 0xffff0000u)} + s;
               if (YB) { *(GAS unsigned long long*)(YB + (size_t)row * DM + col) = (unsigned long long)pkbf(v.x, v.y) | ((unsigned long long)pkbf(v.z, v.w) << 32);
                         float q = (v.x * v.x + v.y * v.y) + (v.z * v.z + v.w * v.w); q += __shfl_xor(q, 16); q += __shfl_xor(q, 32);
                         if (fq == 0) __hip_atomic_fetch_add(ssq + row, q, __ATOMIC_RELAXED, __HIP_MEMORY_SCOPE_AGENT); }
               else *(GAS f32x4*)(out + (size_t)row * DM + col) = v; }
        if (NORM) {
            *(GAS unsigned long long*)(HB + (size_t)row * DM + col) = (unsigned long long)pkbf(v.x, v.y) | ((unsigned long long)pkbf(v.z, v.w) << 32);
            float q = (v.x * v.x + v.y * v.y) + (v.z * v.z + v.w * v.w); q += __shfl_xor(q, 16); q += __shfl_xor(q, 32);
            if (fq == 0) __hip_atomic_fetch_add(ssq + row, q, __ATOMIC_RELAXED, __HIP_MEMORY_SCOPE_AGENT);
        }
    }
}

__global__ void __launch_bounds__(NWAVES * 64, 2) hymba_fwd(Args args) {
    extern __shared__ __attribute__((aligned(16))) unsigned char lds[];
    Frame F;
    F.lds = (LAS unsigned char*)lds;
    F.MISC = (volatile LAS unsigned*)(F.lds + MISC_OFF);
    F.tid = threadIdx.x; F.lane = F.tid & 63; F.wave = __builtin_amdgcn_readfirstlane(F.tid >> 6);
    F.G = gridDim.x; { const int bx = blockIdx.x; F.vcu = (F.G % 8 == 0) ? (bx % 8) * (F.G / 8) + bx / 8 : bx; }
    unsigned char* ws = args.ws;
    F.ctl = (gu32*)(ws + WS_CTL);
    for (int u = F.tid; u < (LDS_BYTES - LDSCTL_OFF) / 4; u += NWAVES * 64) ((LAS unsigned*)(F.lds + LDSCTL_OFF))[u] = 0u;
    __syncthreads();
    XcdBarrier bar = xcd_barrier_post((unsigned*)(F.ctl + CW_BAR), F.MISC + 8);
#ifndef G5_WGM
#define G5_WGM 8
#endif
#ifndef PROBE_MASK
#define PROBE_MASK 0
#endif
#ifndef PROBE_BAR
#define PROBE_BAR 1
#endif
#ifndef PHMASK
#define PHMASK 0x3fff
#endif
#define GRID_BAR() do { for (int br_ = 0; br_ < PROBE_BAR; ++br_) xcd_barrier(bar); } while (0)
#define PHASE_PTRS() unsigned long long zoff_ = 0; asm volatile("" : "+s"(zoff_)); unsigned char* const wsb = args.ws + zoff_; float* const OUT = args.out + zoff_;     int ptid_ = threadIdx.x; asm volatile("" : "+v"(ptid_)); int bx_ = blockIdx.x, G_ = gridDim.x; asm volatile("" : "+s"(bx_), "+s"(G_)); const int VCU = (G_ % 8 == 0) ? (bx_ % 8) * (G_ / 8) + bx_ / 8 : bx_; (void)VCU; \
    const int LANE = ptid_ & 63, WAVE = __builtin_amdgcn_readfirstlane(ptid_ >> 6); const int gw = VCU * NWAVES + WAVE, NGW = G_ * NWAVES; const int gthread = gw * 64 + LANE, nthreads = NGW * 64; (void)gthread; (void)nthreads; (void)gw; (void)NGW; (void)LANE
#define WIN_T ((bf16*)(wsb + WS_WIN))
#define WQB_T ((bf16*)(wsb + WS_WQB))
#define WKVB_T ((bf16*)(wsb + WS_WKVB))
#define WO_T ((bf16*)(wsb + WS_WO))
#define WUP_T ((bf16*)(wsb + WS_WUP))
#define WDN_T0 ((bf16*)(wsb + WS_WDN))
#define WDN_T1 ((bf16*)(wsb + WS_WDN1))
#define XN ((bf16*)(wsb + WS_XN))
#define UB ((bf16*)(wsb + WS_U))
#define QLAT ((bf16*)(wsb + WS_QLAT))
#define AKV ((bf16*)(wsb + WS_AKV))
#define KROPE ((bf16*)(wsb + WS_KROPE))
#define VB ((bf16*)(wsb + WS_VB))
#define QB ((bf16*)(wsb + WS_QB))
#define KN ((bf16*)(wsb + WS_KN))
#define SBQ ((bf16*)(wsb + WS_SBQ))
#define SBK ((bf16*)(wsb + WS_SBK))
#define SBV ((bf16*)(wsb + WS_SBV))
#define LAT ((float*)(wsb + WS_LAT))
#define QRAW ((float*)(wsb + WS_QRAW))
#define KNRAW ((float*)(wsb + WS_KNRAW))
#define MLAO ((bf16*)(wsb + WS_MLAO))
#define SBO ((bf16*)(wsb + WS_SBO))
#define MERGED ((bf16*)(wsb + WS_MERGED))
#define TAB ((f32x2*)(wsb + WS_TAB))
#define SLAB ((float*)(wsb + WS_SLAB))
#define Y0B ((bf16*)(wsb + WS_Y0B))
#define SSQH ((float*)(wsb + WS_SSQH))
#define SSQM ((float*)(wsb + WS_SSQH + 128 * 1024))
#define SSQS ((float*)(wsb + WS_SSQH + 256 * 1024))
#define SSQP ((float*)(wsb + WS_SSQP))
#define SSQY ((float*)(wsb + WS_SSQH + 384 * 1024))

    { PHASE_PTRS(); (void)OUT;
    for (int i = gthread; i < SEQ * 32; i += nthreads) {
        const int pos = i >> 5, k = i & 31;
        const float inv_freq = exp2f(-(float)k * (13.287712379549449f / 32.f));
        float s, c; sincos_acc((float)pos * inv_freq, s, c); TAB[i] = (f32x2){c, s};
    } }

#define CONVERT_ITEMS(LW, R_LO, R_HI, GWV, NGWV) do { \
        const float* w_in = args.in[7] + (size_t)(LW) * DM * 7744; const float* w_qb = args.in[9] + (size_t)(LW) * QLORA * 3072; \
        const float* w_kvb = args.in[11] + (size_t)(LW) * KVLORA * 4096; const float* w_o = args.in[18] + (size_t)(LW) * DM * DM; \
        const float* w_up = args.in[20] + (size_t)(LW) * DM * DFF; const float* w_dn = args.in[21] + (size_t)(LW) * DFF * DM; const int lw_ = (LW); \
        auto dec_ = [&](int it) -> TItem { \
                int r = (R_HI) - 1 - it; \
                if (r < I_IN) { const int kb = r / 242, nb = r % 242, n0 = nb * 32; return TItem{w_in + (size_t)(kb * 64) * 7744 + n0, WIN_T + (size_t)(n0 + (n0 >= 1600 ? 192 : 0)) * DM + kb * 64, lw_ ? args.in[6] + (size_t)lw_ * DM + kb * 64 : nullptr, 7744, DM}; } r -= I_IN; \
                if (r < I_QB) { const int kb = r / 96, nb = r % 96, n0 = nb * 32, h = n0 / 192, dd = n0 % 192; \
                    return TItem{w_qb + (size_t)(kb * 64) * 3072 + n0, WQB_T + (size_t)(dd < 128 ? h * 128 + dd : 2048 + (h >> 2) * 256 + ((dd - 128) >> 5) * 128 + (h & 3) * 32) * QLORA + kb * 64, nullptr, 3072, QLORA}; } r -= I_QB; \
                if (r < I_KVB) { const int kb = r / 128, nb = r % 128, n0 = nb * 32, h = n0 >> 8, dd = n0 & 255; \
                    return TItem{w_kvb + (size_t)(kb * 64) * 4096 + n0, WKVB_T + (size_t)(dd < 128 ? h * 128 + dd : 2048 + h * 128 + (dd - 128)) * KVLORA + kb * 64, nullptr, 4096, KVLORA}; } r -= I_KVB; \
                if (r < I_O) { const int kb = r / 128, nb = r % 128; \
                    return TItem{w_o + (size_t)(kb * 64) * DM + nb * 32, WO_T + (size_t)(nb * 32) * DM + kb * 64, (kb < 32 ? args.in[16] + (size_t)lw_ * 2048 : args.in[17] + (size_t)lw_ * 2048 - 2048) + kb * 64, DM, DM}; } r -= I_O; \
                if (r < I_UP) { const int kb = r / 512, nb = r % 512; return TItem{w_up + (size_t)(kb * 64) * DFF + nb * 32, WUP_T + (size_t)(nb * 32) * DM + kb * 64, args.in[19] + (size_t)lw_ * DM + kb * 64, DFF, DM}; } r -= I_UP; \
                { const int kb = r / 128, nb = r % 128; return TItem{w_dn + (size_t)(kb * 64) * DM + nb * 32, (lw_ ? WDN_T1 : WDN_T0) + ((size_t)((nb >> 3) * 256 + kb) * 256 + (nb & 7) * 32) * 64, nullptr, DM, 64}; } }; \
        const int n_ = (R_HI) - (R_LO); int it = (GWV); \
        if (it < n_) { \
            float tA[32], tB[32]; f32x4 gA0, gA1, gB0, gB1; \
            TItem PA = dec_(it), PB; ti_load(PA, tA, gA0, gA1, LANE); \
            for (;;) {                                     \
                const int it1 = it + (NGWV); PB = dec_(it1 < n_ ? it1 : it); ti_load(PB, tB, gB0, gB1, LANE); \
                ti_finish(PA, tA, gA0, gA1, scr, LANE); \
                if (it1 >= n_) break; \
                const int it2 = it1 + (NGWV); PA = dec_(it2 < n_ ? it2 : it1); ti_load(PA, tA, gA0, gA1, LANE); \
                ti_finish(PB, tB, gB0, gB1, scr, LANE); \
                if (it2 >= n_) break; \
                it = it2; \
            } } } while (0)
    constexpr int I_IN = 64 * 242, I_QB = 16 * 96, I_KVB = 8 * 128, I_O = 64 * 128, I_UP = 64 * 512, I_DN = 256 * 128;
    constexpr int NITEMS = I_IN + I_QB + I_KVB + I_O + I_UP + I_DN, EARLY_ITEMS = I_IN + I_QB + I_KVB + I_O, EARLY0_ITEMS = I_IN + I_QB + I_KVB;
#pragma unroll 1
    for (int l = 0; l < 2; ++l) {
        if (l == 0 || gridDim.x != 256) {
        for (int rep_ = 0; rep_ < (((PROBE_MASK >> 0) & 1) ? 2 : 1); ++rep_) if constexpr ((PHMASK >> 0) & 1) {
            PHASE_PTRS(); (void)OUT;
            LAS float* scr = (LAS float*)(F.lds + RING_OFF + WAVE * 16384);
            const bool early_ok = (G_ == 256);
            CONVERT_ITEMS(l, (l > 0 && early_ok) ? NITEMS : 0, (l == 0 && early_ok) ? EARLY0_ITEMS : NITEMS, gw, NGW);
            if (l == 0) {
            { unsigned zz = 0u; asm volatile("" : "+v"(zz)); const v4u z4 = {zz, zz, zz, zz};
              for (int i = gthread; i < 192 * DM / 8; i += nthreads) *(GAS v4u*)(WIN_T + (size_t)1600 * DM + (size_t)i * 8) = z4; }
            cache_rows_to_bf16(args.in[2] + (size_t)l * 8 * PAST * KVLORA, AKV, KVLORA, gthread, nthreads);
            cache_rows_to_bf16(args.in[3] + (size_t)l * 8 * PAST * ROPE, KROPE, ROPE, gthread, nthreads);
            const float* g = args.in[6] + (size_t)l * DM;
            for (int m = gw; m < MTOK; m += NGW) rms_row_4096(m < NP ? args.in[0] + (size_t)m * DM : args.in[1] + (size_t)(m - NP) * DM, g, XN + (size_t)m * DM, LANE);
            }
        }
        GRID_BAR();
        }
        for (int rep_ = 0; rep_ < (((PROBE_MASK >> 1) & 1) ? 2 : 1); ++rep_) if constexpr ((PHMASK >> 1) & 1) {
            PHASE_PTRS(); (void)OUT;
            pg8::Gemm g{l == 0 ? XN : Y0B, WIN_T, MTOK, NINP, DM, nullptr}; pg8::InOrder S; S.init3(MTOK, NINP, G_, bx_);
            pg8::EpiIn E{LAT, SBQ, SBK, SBV, OUT + O_SBK_P + (size_t)l * NP * 2048, OUT + O_SBV_P + (size_t)l * NP * 2048,
                         OUT + O_SBK_S + (size_t)l * NS * 2048, OUT + O_SBV_S + (size_t)l * NS * 2048, QS_SB, l == 0 ? nullptr : SSQY, EPS};
            const bool bg = (l == 0 && G_ == 256);
            const int rsplit = bg ? ((bx_ & 7) >> 1) : 0;
#pragma unroll 1
            for (int seg = 0; seg < 2; ++seg) {
                pg8::SubRange<pg8::InOrder> SS{S, seg ? rsplit : 0, seg ? (1 << 30) : rsplit};
                pg8::gemm_phase<pg8::EpiIn, pg8::SubRange<pg8::InOrder>, true, true>(F.lds + RING_OFF, g, SS, E);
                if (seg == 0 && bg) {
                    LAS float* scr = (LAS float*)(F.lds + RING_OFF + WAVE * 16384);
                    CONVERT_ITEMS(0, EARLY0_ITEMS, NITEMS, gw, NGW);
                    __syncthreads();
                }
            }
        }
        GRID_BAR();
        for (int rep_ = 0; rep_ < (((PROBE_MASK >> 2) & 1) ? 2 : 1); ++rep_) if constexpr ((PHMASK >> 2) & 1) {
            PHASE_PTRS(); (void)OUT;
            for (int i = gthread; i < MTOK; i += nthreads) { SSQH[i] = 0.f; SSQM[i] = 0.f; SSQS[i] = 0.f; if (l == 0) SSQY[i] = 0.f; }
            const float* g_q_a = args.in[8] + (size_t)l * QLORA; const float* g_kv_a = args.in[10] + (size_t)l * KVLORA; const float* g_k_rope = args.in[15] + (size_t)l * ROPE;
            for (int m = gw; m < MTOK; m += NGW) {
                const float* lr = LAT + (size_t)m * 1792; const int kvr = kvrow_of(m), pos = pos_of(m);
                {
                    f32x4 v[4]; float s = 0.f;
#pragma unroll
                    for (int j = 0; j < 4; ++j) { v[j] = *(const GAS f32x4*)(lr + 4 * (64 * j + LANE)); s += (v[j].x * v[j].x + v[j].y * v[j].y) + (v[j].z * v[j].z + v[j].w * v[j].w); }
                    const float rstd = 1.0f / sqrtf(wave_sum(s) * (1.f / 1024.f) + EPS);
#pragma unroll
                    for (int j = 0; j < 4; ++j) { const f32x4 gg = *(const GAS f32x4*)(g_q_a + 4 * (64 * j + LANE));
                        *(GAS unsigned long long*)(QLAT + (size_t)m * QLORA + 4 * (64 * j + LANE)) =
                            (unsigned long long)pkbf(v[j].x * rstd * gg.x, v[j].y * rstd * gg.y) | ((unsigned long long)pkbf(v[j].z * rstd * gg.z, v[j].w * rstd * gg.w) << 32); }
                }
                {
                    f32x4 v[2]; float s = 0.f;
#pragma unroll
                    for (int j = 0; j < 2; ++j) { v[j] = *(const GAS f32x4*)(lr + 1024 + 4 * (64 * j + LANE)); s += (v[j].x * v[j].x + v[j].y * v[j].y) + (v[j].z * v[j].z + v[j].w * v[j].w); }
                    const float rstd = 1.0f / sqrtf(wave_sum(s) * (1.f / 512.f) + EPS);
                    float* oc = (m < NP) ? OUT + O_CKV_P + ((size_t)l * NP + m) * KVLORA : OUT + O_CKV_S + ((size_t)l * NS + (m - NP)) * KVLORA;
#pragma unroll
                    for (int j = 0; j < 2; ++j) { const f32x4 gg = *(const GAS f32x4*)(g_kv_a + 4 * (64 * j + LANE));
                        const f32x4 c = {v[j].x * rstd * gg.x, v[j].y * rstd * gg.y, v[j].z * rstd * gg.z, v[j].w * rstd * gg.w};
                        *(GAS f32x4*)(oc + 4 * (64 * j + LANE)) = c;
                        *(GAS unsigned long long*)(AKV + (size_t)kvr * KVLORA + 4 * (64 * j + LANE)) = (unsigned long long)pkbf(c.x, c.y) | ((unsigned long long)pkbf(c.z, c.w) << 32); }
                }
                {
                    const float x = lr[1536 + LANE];
                    const float rstd = 1.0f / sqrtf(wave_sum(x * x) * (1.f / 64.f) + EPS);
                    const float xn = x * rstd * g_k_rope[LANE]; const float xp = __shfl_xor(xn, 32);
                    const f32x2 cs = TAB[pos * 32 + (LANE & 31)];
                    const float o = (LANE < 32) ? xn * cs.x - xp * cs.y : xp * cs.y + xn * cs.x;
                    float* okr = (m < NP) ? OUT + O_KR_P + ((size_t)l * NP + m) * ROPE : OUT + O_KR_S + ((size_t)l * NS + (m - NP)) * ROPE;
                    okr[LANE] = o;
                    const float on = __shfl_xor(o, 1);
                    if ((LANE & 1) == 0) *(GAS unsigned*)(KROPE + (size_t)kvr * ROPE + LANE) = pkbf(o, on);
                }
            }
        }
        GRID_BAR();
        for (int rep_ = 0; rep_ < (((PROBE_MASK >> 3) & 1) ? 2 : 1); ++rep_) if constexpr ((PHMASK >> 3) & 1) {
            PHASE_PTRS(); (void)OUT;
            pg8::Gemm g{QLAT, WQB_T, MTOK, 3072, QLORA, nullptr}; pg8::StaticOrder S; S.init(MTOK, 3072, G_, bx_);
            pg8::EpiQb E{QB, args.in[12] + (size_t)l * NOPE, args.in[13] + (size_t)l * ROPE, TAB, (LAS float*)(F.lds + XCH_OFF), QS_MLA, EPS};
            pg8::gemm_phase<pg8::EpiQb, pg8::StaticOrder, true, true>(F.lds + RING_OFF, g, S, E);
        }
        for (int rep_ = 0; rep_ < (((PROBE_MASK >> 11) & 1) ? 2 : 1); ++rep_) if constexpr ((PHMASK >> 11) & 1) {
            PHASE_PTRS(); (void)OUT;
            pg8::Gemm g{AKV, WKVB_T, KVROWS, 4096, KVLORA, nullptr}; pg8::StaticOrder S; S.init(KVROWS, 4096, G_, (bx_ + G_ - 24) % G_);
            pg8::EpiKvbN E{KN, VB, args.in[14] + (size_t)l * NOPE, (LAS float*)(F.lds + XCH_OFF), EPS};
            pg8::gemm_phase<pg8::EpiKvbN, pg8::StaticOrder, true, true>(F.lds + RING_OFF, g, S, E);
        }
        GRID_BAR();
        for (int rep_ = 0; rep_ < (((PROBE_MASK >> 5) & 1) ? 2 : 1); ++rep_) if constexpr ((PHMASK >> 5) & 1) {
            PHASE_PTRS(); (void)OUT;
            const int v = VCU, bh = v >> 2, b = bh >> 4, h = bh & 15, s = v & 3;
            ALAS char* al = (ALAS char*)(F.lds + RING_OFF);
#pragma unroll 1
            for (int k = 0; k < 5; ++k) {
                att::Unit u;
                if (k < 4) { const int qb = (k == 0) ? s : (k == 1) ? 7 - s : (k == 2) ? 8 + s : 15 - s; const size_t m0 = (size_t)b * SEQ + (size_t)qb * 256, kv0 = (size_t)b * SEQ;
                    u.Q = QB + m0 * 3072 + h * 192; u.ldq = 3072; u.K = KN + kv0 * 2048 + h * 128; u.Kr = KROPE + kv0 * ROPE; u.V = VB + kv0 * 2048 + h * 128;
                    u.O = MERGED + m0 * 4096 + h * 128; u.ldo = 4096; u.ssq = SSQP + m0 * 32 + h; u.Kf0 = u.Vf0 = u.Kf1 = u.Vf1 = nullptr; u.split = 0; u.P0 = qb * 256; u.NT = 4 * qb + 4; u.nact = 8; }
                else { if (v >= 128) break; const int sb = v >> 4, sh = v & 15; const size_t m0 = (size_t)NP + (size_t)sb * 64, kv0 = (size_t)NP + (size_t)sb * SKVS;
                    u.Q = QB + m0 * 3072 + sh * 192; u.ldq = 3072; u.K = KN + kv0 * 2048 + sh * 128; u.Kr = KROPE + kv0 * ROPE; u.V = VB + kv0 * 2048 + sh * 128;
                    u.O = MERGED + m0 * 4096 + sh * 128; u.ldo = 4096; u.ssq = SSQP + m0 * 32 + sh; u.Kf0 = u.Vf0 = u.Kf1 = u.Vf1 = nullptr; u.split = 0; u.P0 = PAST; u.NT = 17; u.nact = 2; }
                if constexpr ((PHMASK >> 12) & 1) att::mla_unit_dma<0>(u, al);
            }
#pragma unroll 1
            for (int k = 0; k < 5; ++k) {
                att::Unit u;
                if (k < 4) { const int qb = (k == 0) ? s : (k == 1) ? 7 - s : (k == 2) ? 8 + s : 15 - s; const size_t m0 = (size_t)b * SEQ + (size_t)qb * 256, kv0 = (size_t)b * SEQ;
                    u.Q = SBQ + m0 * 2048 + h * 128; u.ldq = 2048; u.K = nullptr; u.Kr = nullptr; u.V = nullptr; u.split = 1 << 30;
                    u.Kf0 = OUT + O_SBK_P + ((size_t)l * NP + kv0) * 2048 + h * 128; u.Vf0 = OUT + O_SBV_P + ((size_t)l * NP + kv0) * 2048 + h * 128; u.Kf1 = u.Kf0; u.Vf1 = u.Vf0;
                    u.O = MERGED + m0 * 4096 + 2048 + h * 128; u.ldo = 4096; u.ssq = SSQP + m0 * 32 + 16 + h; u.P0 = qb * 256; u.NT = 4 * qb + 4; u.nact = 8; }
                else { if (v < 128) break; const int w = v - 128, sb = w >> 4, sh = w & 15; const size_t m0 = (size_t)NP + (size_t)sb * 64, kv0 = (size_t)NP + (size_t)sb * SKVS;
                    u.Q = SBQ + m0 * 2048 + sh * 128; u.ldq = 2048; u.K = nullptr; u.Kr = nullptr; u.V = nullptr; u.split = PAST / 64;
                    u.Kf0 = args.in[4] + ((size_t)(l * 8 + sb) * PAST) * 2048 + sh * 128; u.Vf0 = args.in[5] + ((size_t)(l * 8 + sb) * PAST) * 2048 + sh * 128;
                    u.Kf1 = OUT + O_SBK_S + ((size_t)l * NS + (size_t)sb * 64) * 2048 + sh * 128; u.Vf1 = OUT + O_SBV_S + ((size_t)l * NS + (size_t)sb * 64) * 2048 + sh * 128;
                    u.O = MERGED + m0 * 4096 + 2048 + sh * 128; u.ldo = 4096; u.ssq = SSQP + m0 * 32 + 16 + sh; u.P0 = PAST; u.NT = 17; u.nact = 2; }
                if constexpr ((PHMASK >> 13) & 1) att::attn_unit<false>(u, al);
            }
        }
        GRID_BAR();
#if !ATT_SSQ_ATOMICS
        {
            PHASE_PTRS(); (void)OUT;
            for (int i = gthread; i < MTOK * 2; i += nthreads) { const int m = i >> 1, half = i & 1; const GAS f32x4* p = (const GAS f32x4*)(SSQP + (size_t)m * 32 + half * 16);
                const f32x4 a = p[0], b = p[1], c = p[2], d = p[3];
                const float s = (((a.x + a.y) + (a.z + a.w)) + ((b.x + b.y) + (b.z + b.w))) + (((c.x + c.y) + (c.z + c.w)) + ((d.x + d.y) + (d.z + d.w)));
                (half ? SSQS : SSQM)[m] = s; }
        }
        GRID_BAR();
#endif
        for (int rep_ = 0; rep_ < (((PROBE_MASK >> 7) & 1) ? 2 : 1); ++rep_) if constexpr ((PHMASK >> 7) & 1) {
            PHASE_PTRS(); (void)OUT;
            pg8::Gemm g{MERGED, WO_T, MTOK, DM, DM, SLAB}; pg8::PanelOrder S; S.init3(MTOK, DM, DM, G_, bx_, SLAB, 2);
            pg8::EpiResP<true> E{args.in[0], args.in[1], nullptr, XN, SSQH, SSQM, SSQS, EPS, l == 0 ? nullptr : Y0B};
            pg8::gemm_phase<pg8::EpiResP<true>, pg8::PanelOrder, true, true>(F.lds + RING_OFF, g, S, E);
        }
        GRID_BAR();
        {
            PHASE_PTRS(); pg8::PanelOrder S; S.init3(MTOK, DM, DM, G_, bx_, SLAB, 2);
            tail_reduce_res<true>(S, args.in[0], args.in[1], nullptr, XN, SSQH, SSQM, SSQS, l == 0 ? nullptr : Y0B, ptid_);
        }
        GRID_BAR();
        for (int rep_ = 0; rep_ < (((PROBE_MASK >> 9) & 1) ? 2 : 1); ++rep_) if constexpr ((PHMASK >> 9) & 1) {
            PHASE_PTRS(); (void)OUT;
            pg8::Gemm g{XN, WUP_T, MTOK, DFF, DM, nullptr}; pg8::UpOrder S; S.init3(MTOK, DFF, G_, bx_);
            pg8::EpiRelu2N E{UB, DFF, SSQH, EPS};
            pg8::gemm_phase<pg8::EpiRelu2N, pg8::UpOrder, true, true>(F.lds + RING_OFF, g, S, E);
            if (l + 1 < 2 && G_ == 256 && bx_ >= 128) {
                LAS float* scr = (LAS float*)(F.lds + RING_OFF + WAVE * 16384);
                CONVERT_ITEMS(l + 1, 0, EARLY_ITEMS, (bx_ - 128) * NWAVES + WAVE, 128 * NWAVES);
            }
        }
        GRID_BAR();
        for (int rep_ = 0; rep_ < (((PROBE_MASK >> 10) & 1) ? 2 : 1); ++rep_) if constexpr ((PHMASK >> 10) & 1) {
            PHASE_PTRS(); (void)OUT;
            pg8::Gemm g{UB, l == 0 ? WDN_T0 : WDN_T1, MTOK, DM, DFF, SLAB, 1};     pg8::PanelOrder S; S.init3(MTOK, DM, DFF, G_, bx_, SLAB);
            pg8::EpiResP<false> E{nullptr, nullptr, OUT + O_Y, XN, SSQY, nullptr, nullptr, EPS, l == 1 ? nullptr : Y0B};
            const bool bg = (l + 1 < 2 && G_ == 256);
            const int rsplit = bg ? ((bx_ & 7) >> 1) : 0;
#pragma unroll 1
            for (int seg = 0; seg < 2; ++seg) {
                pg8::SubRange<pg8::PanelOrder> SS{S, seg ? rsplit : 0, seg ? (1 << 30) : rsplit};
                pg8::gemm_phase<pg8::EpiResP<false>, pg8::SubRange<pg8::PanelOrder>, true, true>(F.lds + RING_OFF, g, SS, E);
                if (seg == 0 && bg) {
                    LAS float* scr = (LAS float*)(F.lds + RING_OFF + WAVE * 16384);
                    CONVERT_ITEMS(l + 1, EARLY_ITEMS, NITEMS, gw, NGW);
                    __syncthreads();
                }
            }
        }
        GRID_BAR();
        {
            PHASE_PTRS(); pg8::PanelOrder S; S.init3(MTOK, DM, DFF, G_, bx_, SLAB);
            tail_reduce_res<false>(S, nullptr, nullptr, OUT + O_Y, XN, SSQY, nullptr, nullptr, l == 1 ? nullptr : Y0B, ptid_);
            if (l + 1 < 2) {
                cache_rows_to_bf16(args.in[2] + (size_t)(l + 1) * 8 * PAST * KVLORA, AKV, KVLORA, gthread, nthreads);
                cache_rows_to_bf16(args.in[3] + (size_t)(l + 1) * 8 * PAST * ROPE, KROPE, ROPE, gthread, nthreads);
            }
        }
        GRID_BAR();
    }
#undef GRID_BAR
}

extern "C" void kernel_launch(void* const* d_in, const int* in_sizes, int n_in, void* d_out, int out_size, void* d_ws, size_t ws_size, hipStream_t stream) {
    static int grid = 0;
    if (grid == 0) {
        if (n_in != 22 || (size_t)out_size != O_END || ws_size < WS_END) { fprintf(stderr, "kernel_launch: unexpected shapes: n_in %d out %d ws %zu (need %zu)\n", n_in, out_size, ws_size, (size_t)WS_END); grid = -1; return; }
        int dev = 0, cus = 0, per_cu = 0;
        if (hipGetDevice(&dev) != hipSuccess || hipDeviceGetAttribute(&cus, hipDeviceAttributeMultiprocessorCount, dev) != hipSuccess) { grid = -1; return; }
        if (hipFuncSetAttribute((const void*)hymba_fwd, hipFuncAttributeMaxDynamicSharedMemorySize, LDS_BYTES) != hipSuccess) { fprintf(stderr, "kernel_launch: hipFuncSetAttribute failed\n"); grid = -1; return; }
        if (hipOccupancyMaxActiveBlocksPerMultiprocessor(&per_cu, (const void*)hymba_fwd, NWAVES * 64, LDS_BYTES) != hipSuccess || per_cu < 1) { fprintf(stderr, "kernel_launch: occupancy query reports %d\n", per_cu); }
        (void)hipGetLastError();
        grid = cus;
        if (grid != 256) fprintf(stderr, "kernel_launch: %d CUs (the attention deal assumes 256 workgroups)\n", grid);
    }
    if (grid < 0) return;
    if (hipMemsetAsync((char*)d_ws + WS_CTL, 0, CTL_ZERO_BYTES, stream) != hipSuccess) return;
    Args a{};
    for (int i = 0; i < 22; ++i) a.in[i] = (const float*)d_in[i];
    a.out = (float*)d_out; a.ws = (unsigned char*)d_ws;
    hipLaunchKernelGGL(hymba_fwd, dim3(grid), dim3(NWAVES * 64), LDS_BYTES, stream, a);
}
```

```cpp
#include <hip/hip_runtime.h>
#include <cstdio>
#include <cstdint>
#include <type_traits>
namespace pg8 {
#define PG8_LAS __attribute__((address_space(3)))
typedef unsigned short bf16_t;
typedef short bf16x8 __attribute__((ext_vector_type(8)));
typedef float f32x4 __attribute__((ext_vector_type(4)));
typedef unsigned u32x4 __attribute__((ext_vector_type(4)));
constexpr int BM = 256, BK = 64, HALF = 128, HTB = HALF * BK * 2  , STAGE_BYTES = 8 * HTB, NXCD = 8, WGM = 8;

__host__ __device__ __forceinline__ int lds_byte(int r, int c) { const int st = (r >> 4) * 2 + (c >> 5), rr = r & 15, cc = c & 31, ob = rr * 64 + cc * 2; return st * 1024 + (ob ^ (((ob >> 9) & 1) << 5)); }
__host__ __device__ __forceinline__ void stage_rc(int b, int& R, int& C) { const int st = b / 1024, sb = b % 1024, swz = sb ^ (((sb >> 9) & 1) << 5); R = (st >> 1) * 16 + swz / 64; C = (st & 1) * 32 + (swz % 64) / 2; }
__host__ __device__ __forceinline__ int perm32(int rho) { const int n = rho >> 4, i = rho & 15; return 8 * (i >> 2) + 4 * n + (i & 3); }

struct Unit { int pm, pn, kt0, nkt, part; };
struct Gemm { const bf16_t* A; const bf16_t* Bt; int M, N, K; float* slab; int blocked = 0; };

struct StaticOrder {
    int nM, nN, nwg, G, c, wgm = WGM;
    __host__ __device__ __forceinline__ void init(int M, int N, int G_, int c_) { nM = M / BM; nN = N / BM; nwg = nM * nN; G = G_; c = c_; }
    __host__ __device__ __forceinline__ bool next(int i, Unit& u) const {
        const long L = (long)i * G + c; if (L >= nwg) return false;
        int wgid = (int)L; { const int q = nwg / NXCD, r = nwg % NXCD, xcd = wgid % NXCD, off = wgid / NXCD; wgid = (xcd < r ? xcd * (q + 1) : r * (q + 1) + (xcd - r) * q) + off; }
        const int nig = wgm * nN, gid = wgid / nig, fm = gid * wgm, gsz = (nM - fm) < wgm ? (nM - fm) : wgm;
        u.pm = fm + ((wgid % nig) % gsz); u.pn = (wgid % nig) / gsz; u.kt0 = 0; u.nkt = 0; u.part = -1; return true;
    }
    __host__ __device__ __forceinline__ void map(int L, Unit& u) const {
        int wgid = L; { const int q = nwg / NXCD, r = nwg % NXCD, xcd = wgid % NXCD, off = wgid / NXCD; wgid = (xcd < r ? xcd * (q + 1) : r * (q + 1) + (xcd - r) * q) + off; }
        const int nig = wgm * nN, gid = wgid / nig, fm = gid * wgm, gsz = (nM - fm) < wgm ? (nM - fm) : wgm;
        u.pm = fm + ((wgid % nig) % gsz); u.pn = (wgid % nig) / gsz; u.kt0 = 0; u.nkt = 0; u.part = -1;
    }
    __device__ __forceinline__ void a_ready(const Unit&) const {}
    __device__ __forceinline__ void done(const Unit&) const {}
};

struct InOrder : StaticOrder {
    bool panel;
    __host__ __device__ __forceinline__ void init3(int M, int N, int G_, int c_) { init(M, N, G_, c_); panel = (G_ == 256 && nM == 66 && nN == 31); }
    __host__ __device__ __forceinline__ bool next(int i, Unit& u) const {
        if (!panel) return StaticOrder::next(i, u);
        if (i >= 8) return false;
        const int x = c & 7, idx = c >> 3, g = x >> 2, q = x & 3, pmo = idx & 3, pn = 8 * q + (idx >> 2);
        if (pn < 31) { u.pm = 8 * i + 4 * g + pmo; u.pn = pn; }
        else { const int su = i * 8 + g * 4 + pmo; if (su >= 62) return false; const int hi31 = su >= 31 ? 1 : 0; u.pm = 64 + hi31; u.pn = su - 31 * hi31; }
        u.kt0 = 0; u.nkt = 0; u.part = -1; return true; }
};

struct UpOrder : StaticOrder {
    bool panel;
    __host__ __device__ __forceinline__ void init3(int M, int N, int G_, int c_) { init(M, N, G_, c_); panel = (G_ == 256 && nM == 66 && nN == 64); }
    __host__ __device__ __forceinline__ bool next(int i, Unit& u) const {
        if (!panel) return StaticOrder::next(i, u);
        const int x = c & 7, idx = c >> 3;
        if (i < 16) { u.pm = 4 * (15 - i) + (idx & 3); u.pn = 8 * x + (idx >> 2); }
        else if (i == 16 && c < 128) { u.pm = 64 + (idx & 1); u.pn = 8 * x + (idx >> 1); }
        else return false;
        u.kt0 = 0; u.nkt = 0; u.part = -1; return true; }
};

template <class S_> struct SubRange {
    const S_& s; int lo, hi;
    __device__ __forceinline__ bool next(int i, Unit& u) const { return (lo + i < hi) && s.next(lo + i, u); }
    __device__ __forceinline__ void a_ready(const Unit& u) const { s.a_ready(u); }
    __device__ __forceinline__ void done(const Unit& u) const { s.done(u); }
};

__device__ __forceinline__ unsigned cvt_pk_bf16(float lo, float hi) { unsigned r; asm volatile("v_cvt_pk_bf16_f32 %0, %1, %2" : "=v"(r) : "v"(lo), "v"(hi)); return r; }

struct TailSplitOrder : StaticOrder {
    int nfull, nsplit, nkt_full, halves; float* slab;
    __host__ __device__ __forceinline__ void init2(int M, int N, int K, int G_, int c_, float* slab_, int halves_ = 1) { init(M, N, G_, c_); nkt_full = K / BK; slab = slab_; halves = halves_; nfull = nwg / G; const int rem = nwg - nfull * G;
        nsplit = (rem > 0 && G % rem == 0 && (nkt_full % (2 * (G / rem))) == 0 && nkt_full / (G / rem) >= 4) ? G / rem : 1; }
    __host__ __device__ __forceinline__ bool next(int i, Unit& u) const {
        const int ii = i / halves, hh = i % halves;
        if (ii < nfull || nsplit == 1) { if (!StaticOrder::next(ii, u)) return false; if (halves == 2) { u.nkt = nkt_full / 2; u.kt0 = hh * u.nkt; u.part = hh == 0 ? -2 : -1; } return true; }
        if (ii > nfull || hh != 0) return false;
        const int j = c / nsplit, s = c % nsplit; map(nfull * G + j, u); u.nkt = nkt_full / nsplit; u.kt0 = s * u.nkt; u.part = j * nsplit + s; return true;
    }
};

struct PanelOrder : TailSplitOrder {
    bool panel;
    __host__ __device__ __forceinline__ void init3(int M, int N, int K, int G_, int c_, float* slab_, int halves_ = 1) { init2(M, N, K, G_, c_, slab_, halves_); panel = (G_ == 256 && nM == 66 && nN == 16 && nsplit == 8); }
    __host__ __device__ __forceinline__ void mapu(int L, Unit& u) const {
        if (L < 1024) { const int r = L >> 8, x = L & 7, idx = (L & 255) >> 3; u.pm = 16 * r + 4 * (x >> 1) + (idx & 3); u.pn = 8 * (x & 1) + (idx >> 2); }
        else { const int j = L - 1024; u.pm = 64 + (j & 1); u.pn = j >> 1; }
        u.kt0 = 0; u.nkt = 0; u.part = -1; }
    __host__ __device__ __forceinline__ bool next(int i, Unit& u) const {
        if (!panel) return TailSplitOrder::next(i, u);
        const int ii = i / halves, hh = i % halves;
        if (ii < nfull) { mapu(ii * G + c, u); if (halves == 2) { u.nkt = nkt_full / 2; u.kt0 = hh * u.nkt; u.part = hh == 0 ? -2 : -1; } return true; }
        if (ii > nfull || hh != 0) return false;
        const int j = c / nsplit, s = c % nsplit; mapu(nfull * G + j, u); u.nkt = nkt_full / nsplit; u.kt0 = s * u.nkt; u.part = j * nsplit + s; return true; }
    __host__ __device__ __forceinline__ void map(int L, Unit& u) const { if (panel) mapu(L, u); else TailSplitOrder::map(L, u); }
};

typedef unsigned u32x2 __attribute__((ext_vector_type(2)));
constexpr int HY_NP = 16384;
__device__ __forceinline__ int hy_kvrow(int m) { return m < HY_NP ? m : HY_NP + ((m - HY_NP) >> 6) * 1088 + 1024 + ((m - HY_NP) & 63); }

struct EpiIn {
    static constexpr bool PERM = true, AFTER_DRAIN = false;
    float* LAT; bf16_t* SBQ; bf16_t* SBK; bf16_t* SBV; float* outK_p; float* outV_p; float* outK_s; float* outV_s; float qscale;
    const float* ssq; float eps;
    __device__ __forceinline__ void operator()(const f32x4 (&acc)[2][2][4][2], const Unit& u, int wr, int wc, int fr, int fq) const {
        const int row0 = u.pm * BM + wr * 64 + fr, colw = wc * 32 + 8 * fq, pn = u.pn;
        float rs[2][4];
#pragma unroll
        for (int ai = 0; ai < 2; ++ai)
#pragma unroll
            for (int m = 0; m < 4; ++m) rs[ai][m] = ssq ? 1.0f / sqrtf(__hip_atomic_load(ssq + row0 + ai * HALF + m * 16, __ATOMIC_RELAXED, __HIP_MEMORY_SCOPE_AGENT) * (1.f / 4096.f) + eps) : 1.0f;
        if (pn < 7) {
#pragma unroll
            for (int ai = 0; ai < 2; ++ai)
#pragma unroll
                for (int m = 0; m < 4; ++m) { float* rp = LAT + (size_t)(row0 + ai * HALF + m * 16) * 1792 + pn * BM + colw;
#pragma unroll
                    for (int bj = 0; bj < 2; ++bj) { *(f32x4*)(rp + bj * HALF) = acc[ai][bj][m][0] * rs[ai][m]; *(f32x4*)(rp + bj * HALF + 4) = acc[ai][bj][m][1] * rs[ai][m]; } }
        } else if (pn < 15) {
#pragma unroll
            for (int ai = 0; ai < 2; ++ai)
#pragma unroll
                for (int m = 0; m < 4; ++m) { bf16_t* rp = SBQ + (size_t)(row0 + ai * HALF + m * 16) * 2048 + (pn - 7) * BM + colw;
#pragma unroll
                    for (int bj = 0; bj < 2; ++bj) { const float sc = qscale * rs[ai][m]; const f32x4 v0 = acc[ai][bj][m][0] * sc, v1 = acc[ai][bj][m][1] * sc;
                        u32x4 w; w.x = cvt_pk_bf16(v0[0], v0[1]); w.y = cvt_pk_bf16(v0[2], v0[3]); w.z = cvt_pk_bf16(v1[0], v1[1]); w.w = cvt_pk_bf16(v1[2], v1[3]);
                        *(u32x4*)(rp + bj * HALF) = w; } }
        } else {
            const bool isv = pn >= 23; const int c0 = (pn - (isv ? 23 : 15)) * BM + colw;
            float* fop = isv ? outV_p : outK_p; float* fos = isv ? outV_s : outK_s;
#pragma unroll
            for (int ai = 0; ai < 2; ++ai)
#pragma unroll
                for (int m = 0; m < 4; ++m) { const int row = row0 + ai * HALF + m * 16;
                    float* fo = (row < HY_NP) ? fop + (size_t)row * 2048 : fos + (size_t)(row - HY_NP) * 2048;
                    fo += c0;
#pragma unroll
                    for (int bj = 0; bj < 2; ++bj) { __builtin_nontemporal_store(acc[ai][bj][m][0] * rs[ai][m], (f32x4*)(fo + bj * HALF)); __builtin_nontemporal_store(acc[ai][bj][m][1] * rs[ai][m], (f32x4*)(fo + bj * HALF + 4)); } }
        }
    }
};
struct EpiF32 {
    static constexpr bool PERM = false, AFTER_DRAIN = false;
    float* C; int ldc;
    __device__ __forceinline__ void operator()(const f32x4 (&acc)[2][2][4][2], const Unit& u, int wr, int wc, int fr, int fq) const {
        const int row0 = u.pm * BM + wr * 64 + fr, col0 = u.pn * BM + wc * 32 + 4 * fq;
#pragma unroll
        for (int ai = 0; ai < 2; ++ai)
#pragma unroll
            for (int m = 0; m < 4; ++m) { float* rowp = C + (size_t)(row0 + ai * HALF + m * 16) * ldc + col0;
#pragma unroll
                for (int bj = 0; bj < 2; ++bj)
#pragma unroll
                    for (int n = 0; n < 2; ++n) *(f32x4*)(rowp + bj * HALF + n * 16) = acc[ai][bj][m][n]; }
    }
};
struct EpiKvb {
    static constexpr bool PERM = true, AFTER_DRAIN = false;
    float* KNRAW; bf16_t* VB;
    __device__ __forceinline__ void operator()(const f32x4 (&acc)[2][2][4][2], const Unit& u, int wr, int wc, int fr, int fq) const {
        const int row0 = u.pm * BM + wr * 64 + fr, colw = wc * 32 + 8 * fq, pn = u.pn;
        if (pn < 8) {
#pragma unroll
            for (int ai = 0; ai < 2; ++ai)
#pragma unroll
                for (int m = 0; m < 4; ++m) { float* rp = KNRAW + (size_t)(row0 + ai * HALF + m * 16) * 2048 + pn * BM + colw;
#pragma unroll
                    for (int bj = 0; bj < 2; ++bj) { *(f32x4*)(rp + bj * HALF) = acc[ai][bj][m][0]; *(f32x4*)(rp + bj * HALF + 4) = acc[ai][bj][m][1]; } }
        } else {
#pragma unroll
            for (int ai = 0; ai < 2; ++ai)
#pragma unroll
                for (int m = 0; m < 4; ++m) { bf16_t* rp = VB + (size_t)(row0 + ai * HALF + m * 16) * 2048 + (pn - 8) * BM + colw;
#pragma unroll
                    for (int bj = 0; bj < 2; ++bj) { const f32x4 v0 = acc[ai][bj][m][0], v1 = acc[ai][bj][m][1];
                        u32x4 w; w.x = cvt_pk_bf16(v0[0], v0[1]); w.y = cvt_pk_bf16(v0[2], v0[3]); w.z = cvt_pk_bf16(v1[0], v1[1]); w.w = cvt_pk_bf16(v1[2], v1[3]);
                        *(u32x4*)(rp + bj * HALF) = w; } }
        }
    }
};
struct EpiRes {
    static constexpr bool PERM = false, AFTER_DRAIN = false;
    const float* resP; const float* resS; float* out;
    __device__ __forceinline__ void operator()(const f32x4 (&acc)[2][2][4][2], const Unit& u, int wr, int wc, int fr, int fq) const {
        const int row0 = u.pm * BM + wr * 64 + fr, col0 = u.pn * BM + wc * 32 + 4 * fq;
        const bool samp = u.pm >= HY_NP / BM;
#pragma unroll
        for (int ai = 0; ai < 2; ++ai)
#pragma unroll
            for (int m = 0; m < 4; ++m) { const int row = row0 + ai * HALF + m * 16;
                const float* rp = samp ? resS + (size_t)(row - HY_NP) * 4096 + col0 : resP + (size_t)row * 4096 + col0;
                float* op = out + (size_t)row * 4096 + col0;
#pragma unroll
                for (int bj = 0; bj < 2; ++bj)
#pragma unroll
                    for (int n = 0; n < 2; ++n) { const f32x4 r = *(const f32x4*)(rp + bj * HALF + n * 16); *(f32x4*)(op + bj * HALF + n * 16) = r + acc[ai][bj][m][n]; } }
    }
};
struct EpiRelu2 {
    static constexpr bool PERM = true, AFTER_DRAIN = false;
    bf16_t* O; int ldc;
    __device__ __forceinline__ void operator()(const f32x4 (&acc)[2][2][4][2], const Unit& u, int wr, int wc, int fr, int fq) const {
        const int row0 = u.pm * BM + wr * 64 + fr, col0 = u.pn * BM + wc * 32 + 8 * fq;
#pragma unroll
        for (int ai = 0; ai < 2; ++ai)
#pragma unroll
            for (int m = 0; m < 4; ++m) { bf16_t* rowp = O + (size_t)(row0 + ai * HALF + m * 16) * ldc + col0;
#pragma unroll
                for (int bj = 0; bj < 2; ++bj) { f32x4 v0 = acc[ai][bj][m][0], v1 = acc[ai][bj][m][1];
#pragma unroll
                    for (int e = 0; e < 4; ++e) { const float a = fmaxf(v0[e], 0.f), b = fmaxf(v1[e], 0.f); v0[e] = a * a; v1[e] = b * b; }
                    u32x4 w; w.x = cvt_pk_bf16(v0[0], v0[1]); w.y = cvt_pk_bf16(v0[2], v0[3]); w.z = cvt_pk_bf16(v1[0], v1[1]); w.w = cvt_pk_bf16(v1[2], v1[3]);
                    *(u32x4*)(rowp + bj * HALF) = w; } }
    }
};

typedef float f32x2e __attribute__((ext_vector_type(2)));
__device__ __forceinline__ void head_ssq_exchange(const f32x4 (&acc)[2][2][4][2], PG8_LAS float* P, int wr, int wc, int fr, int fq, float (&rstd)[2][4][2], float inv_n, float eps) {
#pragma unroll
    for (int ai = 0; ai < 2; ++ai)
#pragma unroll
        for (int m = 0; m < 4; ++m)
#pragma unroll
            for (int bj = 0; bj < 2; ++bj) {
                const f32x4 a = acc[ai][bj][m][0], b = acc[ai][bj][m][1];
                float s = ((a[0] * a[0] + a[1] * a[1]) + (a[2] * a[2] + a[3] * a[3])) + ((b[0] * b[0] + b[1] * b[1]) + (b[2] * b[2] + b[3] * b[3]));
                s += __shfl_xor(s, 16); s += __shfl_xor(s, 32);
                if (fq == 0) P[(ai * HALF + wr * 64 + m * 16 + fr) * 8 + bj * 4 + wc] = s;
            }
    asm volatile("s_waitcnt lgkmcnt(0)" ::: "memory"); __builtin_amdgcn_s_barrier(); asm volatile("" ::: "memory");
#pragma unroll
    for (int ai = 0; ai < 2; ++ai)
#pragma unroll
        for (int m = 0; m < 4; ++m)
#pragma unroll
            for (int bj = 0; bj < 2; ++bj) {
                const f32x4 p = *(const PG8_LAS f32x4*)(P + (ai * HALF + wr * 64 + m * 16 + fr) * 8 + bj * 4);
                rstd[ai][m][bj] = 1.0f / sqrtf(((p[0] + p[1]) + (p[2] + p[3])) * inv_n + eps);
            }
}
struct EpiQb {
    static constexpr bool PERM = true, AFTER_DRAIN = false;
    bf16_t* QB; const float* g_nope; const float* g_rope; const f32x2e* tab; PG8_LAS float* P; float qs, eps;
    __device__ __forceinline__ void operator()(const f32x4 (&acc)[2][2][4][2], const Unit& u, int wr, int wc, int fr, int fq) const {
        const int row0 = u.pm * BM + wr * 64 + fr, pn = u.pn;
        if (pn < 8) {
            float rstd[2][4][2]; head_ssq_exchange(acc, P, wr, wc, fr, fq, rstd, 1.f / 128.f, eps);
            const f32x4 g0 = *(const f32x4*)(g_nope + wc * 32 + 8 * fq) * qs, g1 = *(const f32x4*)(g_nope + wc * 32 + 8 * fq + 4) * qs;
#pragma unroll
            for (int ai = 0; ai < 2; ++ai)
#pragma unroll
                for (int m = 0; m < 4; ++m) { bf16_t* rp = QB + (size_t)(row0 + ai * HALF + m * 16) * 3072 + (2 * pn) * 192 + wc * 32 + 8 * fq;
#pragma unroll
                    for (int bj = 0; bj < 2; ++bj) { const float r = rstd[ai][m][bj]; const f32x4 v0 = acc[ai][bj][m][0] * g0 * r, v1 = acc[ai][bj][m][1] * g1 * r;
                        u32x4 w; w.x = cvt_pk_bf16(v0[0], v0[1]); w.y = cvt_pk_bf16(v0[2], v0[3]); w.z = cvt_pk_bf16(v1[0], v1[1]); w.w = cvt_pk_bf16(v1[2], v1[3]);
                        *(u32x4*)(rp + bj * 192) = w; } }
        } else {
            const int h = 4 * (pn - 8) + wc;
            const f32x4 ga0 = *(const f32x4*)(g_rope + 8 * fq), ga1 = *(const f32x4*)(g_rope + 8 * fq + 4), gb0 = *(const f32x4*)(g_rope + 32 + 8 * fq), gb1 = *(const f32x4*)(g_rope + 32 + 8 * fq + 4);
#pragma unroll
            for (int ai = 0; ai < 2; ++ai)
#pragma unroll
                for (int m = 0; m < 4; ++m) { const int row = row0 + ai * HALF + m * 16;
                    const f32x4 a0 = acc[ai][0][m][0], a1 = acc[ai][0][m][1], b0 = acc[ai][1][m][0], b1 = acc[ai][1][m][1];
                    float s = (((a0[0] * a0[0] + a0[1] * a0[1]) + (a0[2] * a0[2] + a0[3] * a0[3])) + ((a1[0] * a1[0] + a1[1] * a1[1]) + (a1[2] * a1[2] + a1[3] * a1[3])))
                            + (((b0[0] * b0[0] + b0[1] * b0[1]) + (b0[2] * b0[2] + b0[3] * b0[3])) + ((b1[0] * b1[0] + b1[1] * b1[1]) + (b1[2] * b1[2] + b1[3] * b1[3])));
                    s += __shfl_xor(s, 16); s += __shfl_xor(s, 32);
                    const float r = 1.0f / sqrtf(s * (1.f / 64.f) + eps);
                    const int pos = row < HY_NP ? (row & 4095) : 1024 + ((row - HY_NP) & 63);
                    const f32x4* tp = (const f32x4*)(tab + pos * 32 + 8 * fq);
                    const f32x4 t0 = tp[0], t1 = tp[1], t2 = tp[2], t3 = tp[3];
                    const f32x4 x10 = a0 * ga0 * r, x11 = a1 * ga1 * r, x20 = b0 * gb0 * r, x21 = b1 * gb1 * r;
                    const f32x4 c0 = {t0[0], t0[2], t1[0], t1[2]}, s0 = {t0[1], t0[3], t1[1], t1[3]}, c1 = {t2[0], t2[2], t3[0], t3[2]}, s1 = {t2[1], t2[3], t3[1], t3[3]};
                    const f32x4 o10 = (x10 * c0 - x20 * s0) * qs, o11 = (x11 * c1 - x21 * s1) * qs, o20 = (x10 * s0 + x20 * c0) * qs, o21 = (x11 * s1 + x21 * c1) * qs;
                    bf16_t* rp = QB + (size_t)row * 3072 + h * 192 + 128 + 8 * fq;
                    u32x4 w; w.x = cvt_pk_bf16(o10[0], o10[1]); w.y = cvt_pk_bf16(o10[2], o10[3]); w.z = cvt_pk_bf16(o11[0], o11[1]); w.w = cvt_pk_bf16(o11[2], o11[3]);
                    *(u32x4*)rp = w;
                    w.x = cvt_pk_bf16(o20[0], o20[1]); w.y = cvt_pk_bf16(o20[2], o20[3]); w.z = cvt_pk_bf16(o21[0], o21[1]); w.w = cvt_pk_bf16(o21[2], o21[3]);
                    *(u32x4*)(rp + 32) = w; }
        }
    }
};
struct EpiKvbN {
    static constexpr bool PERM = true, AFTER_DRAIN = false;
    bf16_t* KN; bf16_t* VB; const float* g_nope; PG8_LAS float* P; float eps;
    __device__ __forceinline__ void operator()(const f32x4 (&acc)[2][2][4][2], const Unit& u, int wr, int wc, int fr, int fq) const {
        const int row0 = u.pm * BM + wr * 64 + fr, colw = wc * 32 + 8 * fq, pn = u.pn;
        if (pn < 8) {
            float rstd[2][4][2]; head_ssq_exchange(acc, P, wr, wc, fr, fq, rstd, 1.f / 128.f, eps);
            const f32x4 g0 = *(const f32x4*)(g_nope + colw), g1 = *(const f32x4*)(g_nope + colw + 4);
#pragma unroll
            for (int ai = 0; ai < 2; ++ai)
#pragma unroll
                for (int m = 0; m < 4; ++m) { bf16_t* rp = KN + (size_t)(row0 + ai * HALF + m * 16) * 2048 + pn * BM + colw;
#pragma unroll
                    for (int bj = 0; bj < 2; ++bj) { const float r = rstd[ai][m][bj]; const f32x4 v0 = acc[ai][bj][m][0] * g0 * r, v1 = acc[ai][bj][m][1] * g1 * r;
                        u32x4 w; w.x = cvt_pk_bf16(v0[0], v0[1]); w.y = cvt_pk_bf16(v0[2], v0[3]); w.z = cvt_pk_bf16(v1[0], v1[1]); w.w = cvt_pk_bf16(v1[2], v1[3]);
                        *(u32x4*)(rp + bj * HALF) = w; } }
        } else {
#pragma unroll
            for (int ai = 0; ai < 2; ++ai)
#pragma unroll
                for (int m = 0; m < 4; ++m) { bf16_t* rp = VB + (size_t)(row0 + ai * HALF + m * 16) * 2048 + (pn - 8) * BM + colw;
#pragma unroll
                    for (int bj = 0; bj < 2; ++bj) { const f32x4 v0 = acc[ai][bj][m][0], v1 = acc[ai][bj][m][1];
                        u32x4 w; w.x = cvt_pk_bf16(v0[0], v0[1]); w.y = cvt_pk_bf16(v0[2], v0[3]); w.z = cvt_pk_bf16(v1[0], v1[1]); w.w = cvt_pk_bf16(v1[2], v1[3]);
                        *(u32x4*)(rp + bj * HALF) = w; } }
        }
    }
};

template <bool NORM> struct EpiResP {
    static constexpr bool PERM = true, AFTER_DRAIN = false, MIDK = NORM;
    const float* resP; const float* resS; float* out; bf16_t* HB; float* ssq; const float* ssqm; const float* ssqs; float eps;
    bf16_t* YB;
    __device__ __forceinline__ void mid(f32x4 (&acc)[2][2][4][2], const Unit& u, int wr, int wc, int fr, int fq) const {
        const int row0 = u.pm * BM + wr * 64 + fr;
#pragma unroll
        for (int ai = 0; ai < 2; ++ai)
#pragma unroll
            for (int m = 0; m < 4; ++m) { const int row = row0 + ai * HALF + m * 16;
                const float a = __hip_atomic_load(ssqm + row, __ATOMIC_RELAXED, __HIP_MEMORY_SCOPE_AGENT), b = __hip_atomic_load(ssqs + row, __ATOMIC_RELAXED, __HIP_MEMORY_SCOPE_AGENT);
                const float ratio = sqrtf((b * (1.f / 2048.f) + eps) / (a * (1.f / 2048.f) + eps));
#pragma unroll
                for (int bj = 0; bj < 2; ++bj) { acc[ai][bj][m][0] *= ratio; acc[ai][bj][m][1] *= ratio; } }
    }
    __device__ __forceinline__ void operator()(const f32x4 (&acc)[2][2][4][2], const Unit& u, int wr, int wc, int fr, int fq) const {
        const int row0 = u.pm * BM + wr * 64 + fr, col0 = u.pn * BM + wc * 32 + 8 * fq;
        const bool samp = u.pm >= HY_NP / BM;
#pragma unroll
        for (int ai = 0; ai < 2; ++ai)
#pragma unroll
            for (int m = 0; m < 4; ++m) { const int row = row0 + ai * HALF + m * 16;
                if (NORM) {
                    const float* rp = samp ? resS + (size_t)(row - HY_NP) * 4096 + col0 : resP + (size_t)row * 4096 + col0; float s = 0.f;
                    const bf16_t* yp = YB + (size_t)row * 4096 + col0;
                    const float rs = 1.0f / sqrtf(__hip_atomic_load(ssqs + row, __ATOMIC_RELAXED, __HIP_MEMORY_SCOPE_AGENT) * (1.f / 2048.f) + eps);
#pragma unroll
                    for (int bj = 0; bj < 2; ++bj) { f32x4 r0, r1;
                        if (YB) { const u32x4 h = *(const u32x4*)(yp + bj * HALF);
                            r0 = (f32x4){__uint_as_float(h.x << 16), __uint_as_float(h.x & 0xffff0000u), __uint_as_float(h.y << 16), __uint_as_float(h.y & 0xffff0000u)};
                            r1 = (f32x4){__uint_as_float(h.z << 16), __uint_as_float(h.z & 0xffff0000u), __uint_as_float(h.w << 16), __uint_as_float(h.w & 0xffff0000u)}; }
                        else { r0 = *(const f32x4*)(rp + bj * HALF); r1 = *(const f32x4*)(rp + bj * HALF + 4); }
                        const f32x4 v0 = r0 + acc[ai][bj][m][0] * rs, v1 = r1 + acc[ai][bj][m][1] * rs;
                        s += ((v0[0] * v0[0] + v0[1] * v0[1]) + (v0[2] * v0[2] + v0[3] * v0[3])) + ((v1[0] * v1[0] + v1[1] * v1[1]) + (v1[2] * v1[2] + v1[3] * v1[3]));
                        u32x4 w; w.x = cvt_pk_bf16(v0[0], v0[1]); w.y = cvt_pk_bf16(v0[2], v0[3]); w.z = cvt_pk_bf16(v1[0], v1[1]); w.w = cvt_pk_bf16(v1[2], v1[3]);
                        *(u32x4*)(HB + (size_t)row * 4096 + col0 + bj * HALF) = w; }
                    s += __shfl_xor(s, 16); s += __shfl_xor(s, 32);
                    if (fq == 0) __hip_atomic_fetch_add(ssq + row, s, __ATOMIC_RELAXED, __HIP_MEMORY_SCOPE_AGENT);
                } else {
                    const bf16_t* hp = HB + (size_t)row * 4096 + col0; float* op = out + (size_t)row * 4096 + col0; float s = 0.f;
#pragma unroll
                    for (int bj = 0; bj < 2; ++bj) { const u32x4 h = *(const u32x4*)(hp + bj * HALF);
                        const f32x4 r0 = {__uint_as_float(h.x << 16), __uint_as_float(h.x & 0xffff0000u), __uint_as_float(h.y << 16), __uint_as_float(h.y & 0xffff0000u)};
                        const f32x4 r1 = {__uint_as_float(h.z << 16), __uint_as_float(h.z & 0xffff0000u), __uint_as_float(h.w << 16), __uint_as_float(h.w & 0xffff0000u)};
                        const f32x4 y0 = r0 + acc[ai][bj][m][0], y1 = r1 + acc[ai][bj][m][1];
                        if (YB) { u32x4 w; w.x = cvt_pk_bf16(y0[0], y0[1]); w.y = cvt_pk_bf16(y0[2], y0[3]); w.z = cvt_pk_bf16(y1[0], y1[1]); w.w = cvt_pk_bf16(y1[2], y1[3]);
                                  *(u32x4*)(YB + (size_t)row * 4096 + col0 + bj * HALF) = w;
                                  s += ((y0[0] * y0[0] + y0[1] * y0[1]) + (y0[2] * y0[2] + y0[3] * y0[3])) + ((y1[0] * y1[0] + y1[1] * y1[1]) + (y1[2] * y1[2] + y1[3] * y1[3])); }
                        else { __builtin_nontemporal_store(y0, (f32x4*)(op + bj * HALF)); __builtin_nontemporal_store(y1, (f32x4*)(op + bj * HALF + 4)); } }
                    if (YB) { s += __shfl_xor(s, 16); s += __shfl_xor(s, 32);
                        if (fq == 0) __hip_atomic_fetch_add(ssq + row, s, __ATOMIC_RELAXED, __HIP_MEMORY_SCOPE_AGENT); }
                } }
    }
};
struct EpiRelu2N {
    static constexpr bool PERM = true, AFTER_DRAIN = false;
    bf16_t* O; int ldc; const float* ssq; float eps;
    __device__ __forceinline__ void operator()(const f32x4 (&acc)[2][2][4][2], const Unit& u, int wr, int wc, int fr, int fq) const {
        const int row0 = u.pm * BM + wr * 64 + fr;
        bf16_t* const tile0 = O + ((size_t)u.pm * (ldc >> 6) + u.pn * 4 + (wc >> 1)) * 16384 + (wc & 1) * 32 + 8 * fq;
#pragma unroll
        for (int ai = 0; ai < 2; ++ai)
#pragma unroll
            for (int m = 0; m < 4; ++m) { const int row = row0 + ai * HALF + m * 16; bf16_t* rowp = tile0 + (wr * 64 + fr + ai * HALF + m * 16) * 64;
                const float r = 1.0f / sqrtf(__hip_atomic_load(ssq + row, __ATOMIC_RELAXED, __HIP_MEMORY_SCOPE_AGENT) * (1.f / 4096.f) + eps);
#pragma unroll
                for (int bj = 0; bj < 2; ++bj) { f32x4 v0 = acc[ai][bj][m][0], v1 = acc[ai][bj][m][1];
#pragma unroll
                    for (int e = 0; e < 4; ++e) { const float a = fmaxf(v0[e], 0.f) * r, b = fmaxf(v1[e], 0.f) * r; v0[e] = a * a; v1[e] = b * b; }
                    u32x4 w; w.x = cvt_pk_bf16(v0[0], v0[1]); w.y = cvt_pk_bf16(v0[2], v0[3]); w.z = cvt_pk_bf16(v1[0], v1[1]); w.w = cvt_pk_bf16(v1[2], v1[3]);
                    *(u32x4*)(rowp + bj * 2 * 16384) = w; } }
    }
};
template <class T, class = void> struct has_midk { static constexpr bool value = false; };
template <class T> struct has_midk<T, typename std::enable_if<T::MIDK>::type> { static constexpr bool value = true; };
template <class Epi, class Sched, bool ALIGN_EPI = false, bool SP2 = false>
__device__ __forceinline__ void gemm_phase(PG8_LAS unsigned char* lds, const Gemm g, const Sched& S, const Epi& E) {
    int tid_o = threadIdx.x; asm volatile("" : "+v"(tid_o));
    const int tid = tid_o, wid = __builtin_amdgcn_readfirstlane(tid >> 6), lane = tid & 63, wr = wid >> 2, wc = wid & 3, fr = lane & 15, fq = lane >> 4;
    const int nt = g.K / BK, K = g.blocked ? BK : g.K;
    unsigned voffA[2], voffB[2];
#pragma unroll
    for (int i = 0; i < 2; ++i) { int R, C; stage_rc(tid * 16 + i * 8192, R, C); const int Rb = Epi::PERM ? ((R & ~31) + perm32(R & 31)) : R;
        voffA[i] = (unsigned)(R * K + C) * 2u; voffB[i] = (unsigned)(Rb * K + C) * 2u; }
    const size_t kstep = g.blocked ? (size_t)(BM * BK * 2) : (size_t)(BK * 2);
    const size_t hstep = (size_t)HALF * K * 2;
    const size_t tstep = (size_t)BM * g.K * 2;
    const unsigned ldsw = (unsigned)wid * 1024u;
    const int aoff = lds_byte(wr * 64 + fr, fq * 8), boff = lds_byte(wc * 32 + fr, fq * 8);
#define PG8_SA(b, h) (((b) * 2 + (h)) * HTB)
#define PG8_SB(b, h) ((4 + (b) * 2 + (h)) * HTB)
#define PG8_STAGE(bufoff, gbase, voff) do { _Pragma("unroll") for (int _i = 0; _i < 2; ++_i) \
        __builtin_amdgcn_global_load_lds((const unsigned*)((const char*)(gbase) + (voff)[_i]), (PG8_LAS unsigned*)(lds + (bufoff) + ldsw + _i * 8192), 16, 0, 0); } while (0)
#define PG8_LDA(dst, b, h) do { _Pragma("unroll") for (int m = 0; m < 4; ++m) _Pragma("unroll") for (int k = 0; k < 2; ++k) dst[m][k] = *(const PG8_LAS bf16x8*)(lds + PG8_SA(b, h) + aoff + m * 2048 + k * 1024); } while (0)
#define PG8_LDB(dst, b, h) do { _Pragma("unroll") for (int n = 0; n < 2; ++n) _Pragma("unroll") for (int k = 0; k < 2; ++k) dst[n][k] = *(const PG8_LAS bf16x8*)(lds + PG8_SB(b, h) + boff + n * 2048 + k * 1024); } while (0)
#define PG8_MMA(ai, bj, At, Bt) do { __builtin_amdgcn_s_setprio(1); _Pragma("unroll") for (int m = 0; m < 4; ++m) _Pragma("unroll") for (int n = 0; n < 2; ++n) _Pragma("unroll") for (int k = 0; k < 2; ++k) \
        acc[ai][bj][m][n] = __builtin_amdgcn_mfma_f32_16x16x32_bf16(Bt[n][k], At[m][k], acc[ai][bj][m][n], 0, 0, 0); __builtin_amdgcn_s_setprio(0); } while (0)
#define PG8_WAIT_V(n) asm volatile("s_waitcnt vmcnt(" #n ")" ::: "memory")
#define PG8_WAIT_L(n) asm volatile("s_waitcnt lgkmcnt(" #n ")" ::: "memory")
#define PG8_BAR __builtin_amdgcn_s_barrier()
#define PG8_SCHED __builtin_amdgcn_sched_barrier(0)
    Unit cur, nxt; int ui = 0;
    if (!S.next(0, cur)) return;
    f32x4 acc[2][2][4][2];
#pragma unroll
    for (int a = 0; a < 2; ++a)
#pragma unroll
        for (int b = 0; b < 2; ++b)
#pragma unroll
            for (int m = 0; m < 4; ++m)
#pragma unroll
                for (int n = 0; n < 2; ++n) acc[a][b][m][n] = (f32x4){0.f, 0.f, 0.f, 0.f};
    bf16x8 At[4][2], B0[2][2], B1[2][2];
    const char* cA = (const char*)g.A + (size_t)cur.pm * tstep + (size_t)cur.kt0 * kstep; const char* cB = (const char*)g.Bt + (size_t)cur.pn * tstep + (size_t)cur.kt0 * kstep;
    int cnt = cur.nkt ? cur.nkt : nt;
    S.a_ready(cur);
    if constexpr (SP2) {
        PG8_STAGE(PG8_SB(0, 0), cB, voffB); PG8_STAGE(PG8_SB(0, 1), cB + hstep, voffB); PG8_STAGE(PG8_SA(0, 0), cA, voffA); PG8_STAGE(PG8_SA(0, 1), cA + hstep, voffA);
        if (wr == 1) PG8_BAR;
        PG8_WAIT_V(2); PG8_BAR;
        PG8_STAGE(PG8_SB(1, 0), cB + kstep, voffB); PG8_STAGE(PG8_SA(1, 0), cA + kstep, voffA); PG8_STAGE(PG8_SB(1, 1), cB + hstep + kstep, voffB);
        PG8_WAIT_V(6); PG8_BAR;
    } else {
        PG8_STAGE(PG8_SB(0, 0), cB, voffB); PG8_STAGE(PG8_SA(0, 0), cA, voffA); PG8_STAGE(PG8_SB(0, 1), cB + hstep, voffB); PG8_STAGE(PG8_SA(0, 1), cA + hstep, voffA);
        if (wr == 1) PG8_BAR;
        PG8_WAIT_V(4); PG8_BAR;
        PG8_STAGE(PG8_SB(1, 0), cB + kstep, voffB); PG8_STAGE(PG8_SA(1, 0), cA + kstep, voffA); PG8_STAGE(PG8_SB(1, 1), cB + hstep + kstep, voffB);
        PG8_WAIT_V(6); PG8_BAR;
    }
    for (;;) {
        const bool has_next = S.next(ui + 1, nxt);
        const char* nA = has_next ? (const char*)g.A + (size_t)nxt.pm * tstep + (size_t)nxt.kt0 * kstep : cA; const char* nB = has_next ? (const char*)g.Bt + (size_t)nxt.pn * tstep + (size_t)nxt.kt0 * kstep : cB;
        for (int t = 0; t < cnt; t += 2) {
            const bool last = (t == cnt - 2);
            const char* a1 = cA + (size_t)(t + 1) * kstep;
            const char* a2 = last ? nA : cA + (size_t)(t + 2) * kstep; const char* b2 = last ? nB : cB + (size_t)(t + 2) * kstep;
            const char* a3 = a2 + kstep; const char* b3 = b2 + kstep;
            if (last && has_next) S.a_ready(nxt);
            if constexpr (SP2) {
            PG8_LDB(B0, 0, 0); PG8_LDB(B1, 0, 1); PG8_SCHED; PG8_LDA(At, 0, 0); PG8_STAGE(PG8_SA(1, 1), a1 + hstep, voffA);
            PG8_WAIT_V(8); PG8_WAIT_L(0); PG8_BAR; PG8_MMA(0, 0, At, B0); PG8_MMA(0, 1, At, B1); PG8_BAR; PG8_SCHED;
            PG8_LDA(At, 0, 1); PG8_STAGE(PG8_SB(0, 0), b2, voffB); PG8_STAGE(PG8_SB(0, 1), b2 + hstep, voffB); PG8_STAGE(PG8_SA(0, 0), a2, voffA);
            PG8_WAIT_V(8); PG8_WAIT_L(0); PG8_BAR; PG8_MMA(1, 0, At, B0); PG8_MMA(1, 1, At, B1); PG8_BAR; PG8_SCHED;
            PG8_LDB(B0, 1, 0); PG8_LDB(B1, 1, 1); PG8_SCHED; PG8_LDA(At, 1, 0); PG8_STAGE(PG8_SA(0, 1), a2 + hstep, voffA);
            PG8_WAIT_V(8); PG8_WAIT_L(0); PG8_BAR; PG8_MMA(0, 0, At, B0); PG8_MMA(0, 1, At, B1); PG8_BAR; PG8_SCHED;
            PG8_LDA(At, 1, 1); PG8_STAGE(PG8_SB(1, 0), b3, voffB); PG8_STAGE(PG8_SB(1, 1), b3 + hstep, voffB); PG8_STAGE(PG8_SA(1, 0), a3, voffA);
            PG8_WAIT_V(8); PG8_WAIT_L(0); PG8_BAR; PG8_MMA(1, 0, At, B0); PG8_MMA(1, 1, At, B1); PG8_BAR; PG8_SCHED;
            } else {
            PG8_LDB(B0, 0, 0); PG8_SCHED; PG8_LDA(At, 0, 0); PG8_STAGE(PG8_SA(1, 1), a1 + hstep, voffA);
            PG8_WAIT_L(8); PG8_BAR; PG8_WAIT_L(0); PG8_MMA(0, 0, At, B0); PG8_BAR; PG8_SCHED;
            PG8_LDB(B1, 0, 1); PG8_STAGE(PG8_SB(0, 0), b2, voffB);
            PG8_BAR; PG8_WAIT_L(0); PG8_MMA(0, 1, At, B1); PG8_BAR;
            PG8_LDA(At, 0, 1); PG8_STAGE(PG8_SA(0, 0), a2, voffA);
            PG8_BAR; PG8_WAIT_L(0); PG8_MMA(1, 0, At, B0); PG8_BAR; PG8_SCHED;
            PG8_STAGE(PG8_SB(0, 1), b2 + hstep, voffB);
            PG8_WAIT_V(6); PG8_BAR; PG8_MMA(1, 1, At, B1); PG8_BAR;
            PG8_LDB(B0, 1, 0); PG8_SCHED; PG8_LDA(At, 1, 0); PG8_STAGE(PG8_SA(0, 1), a2 + hstep, voffA);
            PG8_WAIT_L(8); PG8_BAR; PG8_WAIT_L(0); PG8_MMA(0, 0, At, B0); PG8_BAR; PG8_SCHED;
            PG8_LDB(B1, 1, 1); PG8_STAGE(PG8_SB(1, 0), b3, voffB);
            PG8_BAR; PG8_WAIT_L(0); PG8_MMA(0, 1, At, B1); PG8_BAR;
            PG8_LDA(At, 1, 1); PG8_STAGE(PG8_SA(1, 0), a3, voffA);
            PG8_BAR; PG8_WAIT_L(0); PG8_MMA(1, 0, At, B0); PG8_BAR; PG8_SCHED;
            PG8_STAGE(PG8_SB(1, 1), b3 + hstep, voffB);
            PG8_WAIT_V(6); PG8_BAR; PG8_MMA(1, 1, At, B1); PG8_BAR;
            }
        }
        if constexpr (ALIGN_EPI) { if (wr == 0) PG8_BAR; }
        if constexpr (!Epi::AFTER_DRAIN) {
            if (cur.part == -2) { if constexpr (has_midk<Epi>::value) E.mid(acc, cur, wr, wc, fr, fq); }
            else if (cur.part >= 0) {
                f32x4* sp = (f32x4*)(g.slab + (size_t)cur.part * 65536) + (size_t)wid * 2048 + lane;
#pragma unroll
                for (int a = 0; a < 2; ++a)
#pragma unroll
                    for (int b = 0; b < 2; ++b)
#pragma unroll
                        for (int m = 0; m < 4; ++m)
#pragma unroll
                            for (int n = 0; n < 2; ++n) sp[(((a * 2 + b) * 4 + m) * 2 + n) * 64] = acc[a][b][m][n];
            } else E(acc, cur, wr, wc, fr, fq);
            S.done(cur); }
        if (!has_next) break;
        if (cur.part != -2) {
#pragma unroll
        for (int a = 0; a < 2; ++a)
#pragma unroll
            for (int b = 0; b < 2; ++b)
#pragma unroll
                for (int m = 0; m < 4; ++m)
#pragma unroll
                    for (int n = 0; n < 2; ++n) acc[a][b][m][n] = (f32x4){0.f, 0.f, 0.f, 0.f};
        }
        cur = nxt; cA = nA; cB = nB; ++ui; cnt = cur.nkt ? cur.nkt : nt;
        if constexpr (ALIGN_EPI) { if (wr == 1) PG8_BAR; }
    }
    PG8_WAIT_V(0);
    if constexpr (!ALIGN_EPI) { if (wr == 0) PG8_BAR; }
    PG8_BAR;
    if constexpr (Epi::AFTER_DRAIN) { E.fused(acc, cur, wr, wc, fr, fq, lds, wid, lane); S.done(cur); }
#undef PG8_SA
#undef PG8_SB
#undef PG8_STAGE
#undef PG8_LDA
#undef PG8_LDB
#undef PG8_MMA
#undef PG8_WAIT_V
#undef PG8_WAIT_L
#undef PG8_BAR
#undef PG8_SCHED
}
}
namespace att {
typedef short bf16x8 __attribute__((ext_vector_type(8)));
typedef short s16x4 __attribute__((ext_vector_type(4)));
typedef float f32x16 __attribute__((ext_vector_type(16)));
typedef unsigned u32x4 __attribute__((ext_vector_type(4)));
typedef float f32x4 __attribute__((ext_vector_type(4)));
typedef unsigned short bf16;
#define ALAS __attribute__((address_space(3)))
#ifndef ATT_SSQ_ATOMICS
#define ATT_SSQ_ATOMICS 0
#endif
constexpr int OFF_V = 0, OFF_K = 32768, OFF_R = 65536, OFF_WS = 81920, OFF_FLG = 81920 + 8 * 256, ATT_LDS_BYTES = OFF_FLG + 64;
constexpr float SB_DEAD = -150.f;
#define KSWZ(row, colB) ((row) * 256 + ((colB) ^ (((row) & 15) << 4)))
#define RSWZ(row, colB) ((row) * 128 + ((colB) ^ ((((row) >> 1) & 7) << 4)))
__device__ __forceinline__ int v_st(int k, int c) { const int kk = (k & ~0xC) | ((k & 4) << 1) | ((k & 8) >> 1); return ((kk >> 3) * 4 + (c >> 5)) * 512 + ((kk & 7) * 32 + (c & 31)) * 2; }
__device__ __forceinline__ int v_rd_base(int lane) { return ((lane & 3) << 3) | (((lane >> 2) & 3) << 6) | (((lane >> 4) & 1) << 5) | (((lane >> 5) & 1) << 8); }
__device__ __forceinline__ int crow(int r, int hi) { return (r & 3) + 8 * (r >> 2) + 4 * hi; }
__device__ __forceinline__ unsigned cvtpk(float lo, float hi) { unsigned r; asm volatile("v_cvt_pk_bf16_f32 %0, %1, %2" : "=v"(r) : "v"(lo), "v"(hi)); return r; }

struct Unit { const bf16* Q; int ldq; const bf16* K; const bf16* Kr; const bf16* V; bf16* O; int ldo; float* ssq; int P0; int NT; int nact;
              const float* Kf0; const float* Vf0; const float* Kf1; const float* Vf1; int split; };

__device__ __forceinline__ void qk128(f32x16& p0, f32x16& p1, ALAS const char* Kt, int r32, int hi, const bf16x8* qr) {
#pragma unroll
    for (int d0 = 0; d0 < 8; ++d0) { ALAS const char* a = Kt + KSWZ(r32, (d0 * 16 + hi * 8) * 2);
        const bf16x8 b0 = *(ALAS const bf16x8*)a; const bf16x8 b1 = *(ALAS const bf16x8*)(a + 32 * 256);
        p0 = __builtin_amdgcn_mfma_f32_32x32x16_bf16(b0, qr[d0], p0, 0, 0, 0);
        p1 = __builtin_amdgcn_mfma_f32_32x32x16_bf16(b1, qr[d0], p1, 0, 0, 0); }
}
__device__ __forceinline__ void qk64(f32x16& p0, f32x16& p1, ALAS const char* Kt, int r32, int hi, const bf16x8* qr) {
#pragma unroll
    for (int d0 = 0; d0 < 4; ++d0) { ALAS const char* a = Kt + RSWZ(r32, (d0 * 16 + hi * 8) * 2);
        const bf16x8 b0 = *(ALAS const bf16x8*)a; const bf16x8 b1 = *(ALAS const bf16x8*)(a + 32 * 128);
        p0 = __builtin_amdgcn_mfma_f32_32x32x16_bf16(b0, qr[d0], p0, 0, 0, 0);
        p1 = __builtin_amdgcn_mfma_f32_32x32x16_bf16(b1, qr[d0], p1, 0, 0, 0); }
}
__device__ __forceinline__ void pv_tile(f32x16* o, unsigned vb0, bf16x8 pa0, bf16x8 pa1, bf16x8 pa2, bf16x8 pa3) {
#define TRRD(dst, off) asm volatile("ds_read_b64_tr_b16 %0, %1 offset:%2" : "=&v"(dst) : "v"(vb0), "i"(off) : "memory")
#define PV_LD(S, d0) do { constexpr int b_ = (d0) * 512; \
        TRRD(S##l0, b_); TRRD(S##h0, b_ + 2048); TRRD(S##l1, b_ + 4096); TRRD(S##h1, b_ + 6144); TRRD(S##l2, b_ + 8192); TRRD(S##h2, b_ + 10240); TRRD(S##l3, b_ + 12288); TRRD(S##h3, b_ + 14336); } while (0)
#define PV_MM(S, d0) do { \
        o[d0] = __builtin_amdgcn_mfma_f32_32x32x16_bf16(pa0, (bf16x8){S##l0[0], S##l0[1], S##l0[2], S##l0[3], S##h0[0], S##h0[1], S##h0[2], S##h0[3]}, o[d0], 0, 0, 0); \
        o[d0] = __builtin_amdgcn_mfma_f32_32x32x16_bf16(pa1, (bf16x8){S##l1[0], S##l1[1], S##l1[2], S##l1[3], S##h1[0], S##h1[1], S##h1[2], S##h1[3]}, o[d0], 0, 0, 0); \
        o[d0] = __builtin_amdgcn_mfma_f32_32x32x16_bf16(pa2, (bf16x8){S##l2[0], S##l2[1], S##l2[2], S##l2[3], S##h2[0], S##h2[1], S##h2[2], S##h2[3]}, o[d0], 0, 0, 0); \
        o[d0] = __builtin_amdgcn_mfma_f32_32x32x16_bf16(pa3, (bf16x8){S##l3[0], S##l3[1], S##l3[2], S##l3[3], S##h3[0], S##h3[1], S##h3[2], S##h3[3]}, o[d0], 0, 0, 0); } while (0)
#define PV_WAIT(n) do { asm volatile("s_waitcnt lgkmcnt(" #n ")" ::: "memory"); __builtin_amdgcn_sched_barrier(0); } while (0)
    s16x4 Al0, Al1, Al2, Al3, Ah0, Ah1, Ah2, Ah3, Bl0, Bl1, Bl2, Bl3, Bh0, Bh1, Bh2, Bh3;
    PV_LD(A, 0); PV_LD(B, 1); PV_WAIT(8); PV_MM(A, 0);
    __builtin_amdgcn_sched_barrier(0); PV_LD(A, 2); PV_WAIT(8); PV_MM(B, 1);
    __builtin_amdgcn_sched_barrier(0); PV_LD(B, 3); PV_WAIT(8); PV_MM(A, 2);
    PV_WAIT(0); PV_MM(B, 3);
#undef PV_WAIT
#undef PV_MM
#undef PV_LD
#undef TRRD
}
#define PK4(P, B_, OUT) do { const unsigned a0_ = cvtpk(P[B_ + 0], P[B_ + 1]), a1_ = cvtpk(P[B_ + 2], P[B_ + 3]); \
        const unsigned b0_ = cvtpk(P[B_ + 4], P[B_ + 5]), b1_ = cvtpk(P[B_ + 6], P[B_ + 7]); \
        auto r0_ = __builtin_amdgcn_permlane32_swap(a0_, b0_, false, false); auto r1_ = __builtin_amdgcn_permlane32_swap(a1_, b1_, false, false); \
        u32x4 w_ = {r0_[0], r1_[0], r0_[1], r1_[1]}; OUT = __builtin_bit_cast(bf16x8, w_); } while (0)

__device__ __forceinline__ void store_o_staged(const f32x16* o, const float* rli, bf16* Ow, int ldo, ALAS char* stg, int lane, int r32, int hi, float* ssqp) {
    ALAS unsigned short* s16 = (ALAS unsigned short*)stg;
#pragma unroll
    for (int r = 0; r < 16; ++r) { const int orow = crow(r, hi);
#pragma unroll
        for (int d0 = 0; d0 < 4; ++d0) { const float v = o[d0][r] * rli[r]; s16[orow * 128 + d0 * 32 + r32] = (unsigned short)cvtpk(v, v); } }
    asm volatile("s_waitcnt lgkmcnt(0)" ::: "memory");
#pragma unroll
    for (int i = 0; i < 8; ++i) { const int idx = i * 64 + lane, row = idx >> 4, ch = idx & 15;
        const u32x4 w = *(ALAS const u32x4*)(stg + row * 256 + ch * 16);
        *(u32x4*)(Ow + (size_t)row * ldo + ch * 8) = w;
        float s = 0.f; { const unsigned ww[4] = {w.x, w.y, w.z, w.w};
#pragma unroll
            for (int e = 0; e < 4; ++e) { const float x0 = __uint_as_float(ww[e] << 16), x1 = __uint_as_float(ww[e] & 0xffff0000u); s += x0 * x0 + x1 * x1; } }
        s += __shfl_xor(s, 1); s += __shfl_xor(s, 2); s += __shfl_xor(s, 4); s += __shfl_xor(s, 8);
        if (ch == 0) ssqp[(size_t)row * 32] = s; }
}
template <bool MLA>
__device__ __forceinline__ void attn_unit(const Unit u, ALAS char* lds) {
    int tid_o = threadIdx.x; asm volatile("" : "+v"(tid_o));
    const int tid = tid_o, wid = __builtin_amdgcn_readfirstlane(tid >> 6), lane = tid & 63, r32 = lane & 31, hi = lane >> 5;
    const bool actw = wid < u.nact;
    const int sr = tid >> 4, sc = (tid & 15) * 8;
    const int vst0 = v_st(sr, sc), vst1 = v_st(32 + sr, sc), kws = KSWZ(sr, sc * 2);
    const int rk = tid >> 3, rc = (tid & 7) * 8, rws = RSWZ(rk, rc * 2);
    ALAS char* V_l = lds + OFF_V; ALAS char* K_l = lds + OFF_K; ALAS char* R_l = lds + OFF_R;
    ALAS float* al_l = (ALAS float*)(lds + OFF_WS) + wid * 64; ALAS float* li_l = al_l + 32;
    const unsigned vbase = (unsigned)(uintptr_t)V_l + (unsigned)v_rd_base(lane);
    constexpr int NQ = MLA ? 12 : 8;
    bf16x8 qr[NQ];
#pragma unroll
    for (int d0 = 0; d0 < NQ; ++d0) qr[d0] = (bf16x8){0, 0, 0, 0, 0, 0, 0, 0};
    if (actw) {
#pragma unroll
        for (int d0 = 0; d0 < NQ; ++d0) qr[d0] = *(const bf16x8*)(u.Q + (size_t)(wid * 32 + r32) * u.ldq + d0 * 16 + hi * 8);
    }
    const int cw = (u.P0 + wid * 32) >> 6;
    const int qpos = u.P0 + wid * 32 + r32;
    float m_reg = -1e30f, l_reg = 0.f, carry = 0.f; bool fin = false;
    ALAS unsigned* flg = (ALAS unsigned*)(lds + OFF_FLG);
    f32x16 o[4];
#pragma unroll
    for (int d = 0; d < 4; ++d)
#pragma unroll
        for (int r = 0; r < 16; ++r) o[d][r] = 0.f;
    bf16x8 st_k0, st_k1, st_v0, st_v1, st_r = (bf16x8){0, 0, 0, 0, 0, 0, 0, 0};
    f32x4 fk[4], fv[4];
#define LOADT(tt) do { if (!MLA) { const int t_ = (tt); const bool lo_ = t_ < u.split; const size_t ro_ = (size_t)(lo_ ? t_ : t_ - u.split) * 64 * 2048; \
            const float* kb_ = (lo_ ? u.Kf0 : u.Kf1) + ro_ + (size_t)sr * 2048 + sc; const float* vb_ = (lo_ ? u.Vf0 : u.Vf1) + ro_ + (size_t)sr * 2048 + sc; \
            fk[0] = *(const f32x4*)kb_; fk[1] = *(const f32x4*)(kb_ + 4); fk[2] = *(const f32x4*)(kb_ + 32 * 2048); fk[3] = *(const f32x4*)(kb_ + 32 * 2048 + 4); \
            fv[0] = *(const f32x4*)vb_; fv[1] = *(const f32x4*)(vb_ + 4); fv[2] = *(const f32x4*)(vb_ + 32 * 2048); fv[3] = *(const f32x4*)(vb_ + 32 * 2048 + 4); } else { \
        const size_t r0_ = (size_t)(tt) * 64; \
        st_k0 = *(const bf16x8*)(u.K + (r0_ + sr) * 2048 + sc); st_k1 = *(const bf16x8*)(u.K + (r0_ + 32 + sr) * 2048 + sc); \
        st_v0 = *(const bf16x8*)(u.V + (r0_ + sr) * 2048 + sc); st_v1 = *(const bf16x8*)(u.V + (r0_ + 32 + sr) * 2048 + sc); \
        if (MLA) st_r = *(const bf16x8*)(u.Kr + (r0_ + rk) * 64 + rc); } } while (0)
    LOADT(MLA ? 0 : (u.NT - 1));
    for (int i = 0; i < u.NT; ++i) {
        const int t = MLA ? i : (u.NT - 1 - i); const int buf = i & 1;
        if (!MLA) { u32x4 w_;
            w_ = (u32x4){cvtpk(fk[0][0], fk[0][1]), cvtpk(fk[0][2], fk[0][3]), cvtpk(fk[1][0], fk[1][1]), cvtpk(fk[1][2], fk[1][3])}; st_k0 = __builtin_bit_cast(bf16x8, w_);
            w_ = (u32x4){cvtpk(fk[2][0], fk[2][1]), cvtpk(fk[2][2], fk[2][3]), cvtpk(fk[3][0], fk[3][1]), cvtpk(fk[3][2], fk[3][3])}; st_k1 = __builtin_bit_cast(bf16x8, w_);
            w_ = (u32x4){cvtpk(fv[0][0], fv[0][1]), cvtpk(fv[0][2], fv[0][3]), cvtpk(fv[1][0], fv[1][1]), cvtpk(fv[1][2], fv[1][3])}; st_v0 = __builtin_bit_cast(bf16x8, w_);
            w_ = (u32x4){cvtpk(fv[2][0], fv[2][1]), cvtpk(fv[2][2], fv[2][3]), cvtpk(fv[3][0], fv[3][1]), cvtpk(fv[3][2], fv[3][3])}; st_v1 = __builtin_bit_cast(bf16x8, w_); }
        *(ALAS bf16x8*)(K_l + buf * 16384 + kws) = st_k0; *(ALAS bf16x8*)(K_l + buf * 16384 + kws + 32 * 256) = st_k1;
        *(ALAS bf16x8*)(V_l + buf * 16384 + vst0) = st_v0; *(ALAS bf16x8*)(V_l + buf * 16384 + vst1) = st_v1;
        if (MLA) *(ALAS bf16x8*)(R_l + buf * 8192 + rws) = st_r;
        if (!MLA) { if (lane == 0) flg[buf * 8 + wid] = (fin || !actw) ? 1u : 0u; }
        __syncthreads();
        if (!MLA) {
            const u32x4 fa = *(ALAS const u32x4*)(flg + buf * 8), fb = *(ALAS const u32x4*)(flg + buf * 8 + 4);
            if ((fa.x & fa.y & fa.z & fa.w & fb.x & fb.y & fb.z & fb.w) != 0u) break;
        }
        if (i + 1 < u.NT) LOADT(MLA ? (i + 1) : (u.NT - 2 - i));
        if (actw && t <= cw && !fin) {
            f32x16 p0, p1;
#pragma unroll
            for (int r = 0; r < 16; ++r) { p0[r] = 0.f; p1[r] = 0.f; }
            qk128(p0, p1, K_l + buf * 16384, r32, hi, qr);
            if (MLA) qk64(p0, p1, R_l + buf * 8192, r32, hi, qr + (MLA ? 8 : 0));
            bf16x8 pa0, pa1, pa2, pa3;
            if (MLA) {
                float pmax = p0[0];
#pragma unroll
                for (int r = 1; r < 16; ++r) pmax = fmaxf(pmax, p0[r]);
#pragma unroll
                for (int r = 0; r < 16; ++r) pmax = fmaxf(pmax, p1[r]);
                { auto rr = __builtin_amdgcn_permlane32_swap(__float_as_uint(pmax), __float_as_uint(pmax), false, false);
                  pmax = fmaxf(__uint_as_float(rr[0]), __uint_as_float(rr[1])); }
                const float mn = fmaxf(m_reg, pmax); const float alpha = __builtin_amdgcn_exp2f(m_reg - mn); m_reg = mn;
                float ps = 0.f;
#pragma unroll
                for (int r = 0; r < 16; ++r) { p0[r] = __builtin_amdgcn_exp2f(p0[r] - mn); ps += p0[r]; }
#pragma unroll
                for (int r = 0; r < 16; ++r) { p1[r] = __builtin_amdgcn_exp2f(p1[r] - mn); ps += p1[r]; }
                { auto rr = __builtin_amdgcn_permlane32_swap(__float_as_uint(ps), __float_as_uint(ps), false, false);
                  ps = __uint_as_float(rr[0]) + __uint_as_float(rr[1]); }
                l_reg = l_reg * alpha + ps;
                if (__any(alpha < 1.f)) {
                    if (hi == 0) al_l[r32] = alpha;
                    asm volatile("s_waitcnt lgkmcnt(0)" ::: "memory");
#pragma unroll
                    for (int r = 0; r < 16; ++r) { const float a = al_l[crow(r, hi)];
#pragma unroll
                        for (int d = 0; d < 4; ++d) o[d][r] *= a; }
                    asm volatile("s_waitcnt lgkmcnt(0)" ::: "memory");
                }
            } else {
                const bool diag = (t == cw); const int dq = qpos - 64 * t - 4 * hi; const float NEG = -__builtin_inff();
                float suf = carry;
#define SB_HALF(P, KOFF) do { f32x16 f_; \
                    _Pragma("unroll") for (int r = 0; r < 16; ++r) { const float y = P[r]; const float e = __builtin_amdgcn_exp2f(-fabsf(y)); const float l2 = __builtin_amdgcn_logf(1.f + e); \
                        const float lb = fminf(y, 0.f) - l2; P[r] = lb; f_[r] = lb - y; } \
                    if (diag) { _Pragma("unroll") for (int r = 0; r < 16; ++r) { const int c = (r & 3) + 8 * (r >> 2) + (KOFF); if (!(c < dq)) { P[r] = NEG; f_[r] = 0.f; } } } \
                    float tg_[4], pg_[4]; \
                    _Pragma("unroll") for (int g = 0; g < 4; ++g) { const float a = (f_[4 * g] + f_[4 * g + 1]) + (f_[4 * g + 2] + f_[4 * g + 3]); \
                        auto rr = __builtin_amdgcn_permlane32_swap(__float_as_uint(a), __float_as_uint(a), false, false); \
                        const float lo = __uint_as_float(rr[0]), hh = __uint_as_float(rr[1]); tg_[g] = lo + hh; pg_[g] = hi == 0 ? hh : 0.f; } \
                    _Pragma("unroll") for (int g = 3; g >= 0; --g) { const float base = suf + pg_[g]; \
                        const float s2 = f_[4 * g + 3], s1 = s2 + f_[4 * g + 2], s0 = s1 + f_[4 * g + 1]; \
                        P[4 * g + 3] = __builtin_amdgcn_exp2f(P[4 * g + 3] + base); P[4 * g + 2] = __builtin_amdgcn_exp2f(P[4 * g + 2] + (base + s2)); \
                        P[4 * g + 1] = __builtin_amdgcn_exp2f(P[4 * g + 1] + (base + s1)); P[4 * g] = __builtin_amdgcn_exp2f(P[4 * g] + (base + s0)); \
                        suf += tg_[g]; } } while (0)
                SB_HALF(p1, 32);
                PK4(p1, 0, pa2); PK4(p1, 8, pa3);
                SB_HALF(p0, 0);
                PK4(p0, 0, pa0); PK4(p0, 8, pa1);
#undef SB_HALF
                carry = suf;
                fin = __all(carry < SB_DEAD);
            }
            if (MLA) { PK4(p0, 0, pa0); PK4(p0, 8, pa1); PK4(p1, 0, pa2); PK4(p1, 8, pa3); }
            pv_tile(o, vbase + (unsigned)(buf * 16384), pa0, pa1, pa2, pa3);
        }
    }
    __syncthreads();
    if (actw) {
        float rli[16];
        if (MLA) {
            if (hi == 0) li_l[r32] = l_reg;
            asm volatile("s_waitcnt lgkmcnt(0)" ::: "memory");
#pragma unroll
            for (int r = 0; r < 16; ++r) rli[r] = 1.0f / li_l[crow(r, hi)];
        } else {
#pragma unroll
            for (int r = 0; r < 16; ++r) rli[r] = 1.0f;
        }
        store_o_staged(o, rli, u.O + (size_t)(wid * 32) * u.ldo, u.ldo, lds + wid * 8192, lane, r32, hi, u.ssq + (size_t)(wid * 32) * 32);
    }
    __syncthreads();
#undef LOADT
}

__device__ __forceinline__ void qk192_pipe(f32x16& p0, f32x16& p1, ALAS const char* Kt, ALAS const char* Rt, int r32, int hi, const bf16x8* qr, const f32x16* cinit = nullptr) {
    constexpr int PF = 2;
    bf16x8 fa[12], fb[12];
#define QK_ADDR(s) ((s) < 8 ? Kt + KSWZ(r32, ((s) * 16 + hi * 8) * 2) : Rt + RSWZ(r32, (((s) - 8) * 16 + hi * 8) * 2))
#define QK_LD(s) do { ALAS const char* a_ = QK_ADDR(s); fa[s] = *(ALAS const bf16x8*)a_; fb[s] = *(ALAS const bf16x8*)(a_ + ((s) < 8 ? 32 * 256 : 32 * 128)); } while (0)
#pragma unroll
    for (int s = 0; s < PF; ++s) QK_LD(s);
#pragma unroll
    for (int s = 0; s < 12; ++s) {
        if (s + PF < 12) QK_LD(s + PF);
        __builtin_amdgcn_sched_barrier(0);
        p0 = __builtin_amdgcn_mfma_f32_32x32x16_bf16(fa[s], qr[s], (s == 0 && cinit) ? *cinit : p0, 0, 0, 0);
        p1 = __builtin_amdgcn_mfma_f32_32x32x16_bf16(fb[s], qr[s], (s == 0 && cinit) ? *cinit : p1, 0, 0, 0);
        __builtin_amdgcn_sched_barrier(0);
    }
#undef QK_LD
#undef QK_ADDR
}
constexpr float MLA_THR = 8.f;
__device__ __forceinline__ void mla_softmax(f32x16& p0, f32x16& p1, float& m_reg, float& l_reg, f32x16* o, ALAS float* al_l, int r32, int hi, bf16x8& pa0, bf16x8& pa1, bf16x8& pa2, bf16x8& pa3) {
    float pmax = p0[0];
#pragma unroll
    for (int r = 1; r < 16; ++r) pmax = fmaxf(pmax, p0[r]);
#pragma unroll
    for (int r = 0; r < 16; ++r) pmax = fmaxf(pmax, p1[r]);
    { auto rr = __builtin_amdgcn_permlane32_swap(__float_as_uint(pmax), __float_as_uint(pmax), false, false);
      pmax = fmaxf(__uint_as_float(rr[0]), __uint_as_float(rr[1])); }
    float mn = m_reg, alpha = 1.f;
    if (!__all(pmax - m_reg <= MLA_THR)) { mn = fmaxf(m_reg, pmax); alpha = __builtin_amdgcn_exp2f(m_reg - mn); m_reg = mn; }
    float ps = 0.f;
#pragma unroll
    for (int r = 0; r < 16; ++r) { p0[r] = __builtin_amdgcn_exp2f(p0[r] - mn); ps += p0[r]; }
#pragma unroll
    for (int r = 0; r < 16; ++r) { p1[r] = __builtin_amdgcn_exp2f(p1[r] - mn); ps += p1[r]; }
    { auto rr = __builtin_amdgcn_permlane32_swap(__float_as_uint(ps), __float_as_uint(ps), false, false);
      ps = __uint_as_float(rr[0]) + __uint_as_float(rr[1]); }
    l_reg = l_reg * alpha + ps;
    if (__any(alpha < 1.f)) {
        if (hi == 0) al_l[r32] = alpha;
        asm volatile("s_waitcnt lgkmcnt(0)" ::: "memory");
#pragma unroll
        for (int r = 0; r < 16; ++r) { const float a = al_l[crow(r, hi)];
#pragma unroll
            for (int d = 0; d < 4; ++d) o[d][r] *= a; }
        asm volatile("s_waitcnt lgkmcnt(0)" ::: "memory");
    }
    PK4(p0, 0, pa0); PK4(p0, 8, pa1); PK4(p1, 0, pa2); PK4(p1, 8, pa3);
}
__device__ __forceinline__ void mla_softmax_rel(f32x16& p0, f32x16& p1, float& m_reg, f32x16& negm, bool first, float& l_reg, f32x16* o, ALAS float* al_l, int r32, int hi, bf16x8& pa0, bf16x8& pa1, bf16x8& pa2, bf16x8& pa3) {
    float pmax = p0[0];
#pragma unroll
    for (int r = 1; r < 16; ++r) pmax = fmaxf(pmax, p0[r]);
#pragma unroll
    for (int r = 0; r < 16; ++r) pmax = fmaxf(pmax, p1[r]);
    { auto rr = __builtin_amdgcn_permlane32_swap(__float_as_uint(pmax), __float_as_uint(pmax), false, false);
      pmax = fmaxf(__uint_as_float(rr[0]), __uint_as_float(rr[1])); }
    if (first || !__all(pmax <= MLA_THR)) {
        const float delta = first ? pmax : fmaxf(pmax, 0.f); const float alpha = first ? 1.f : __builtin_amdgcn_exp2f(-delta);
        m_reg += delta; l_reg *= alpha;
#pragma unroll
        for (int r = 0; r < 16; ++r) { p0[r] -= delta; p1[r] -= delta; negm[r] = -m_reg; }
        if (!first) {
            if (hi == 0) al_l[r32] = alpha;
            asm volatile("s_waitcnt lgkmcnt(0)" ::: "memory");
#pragma unroll
            for (int r = 0; r < 16; ++r) { const float a = al_l[crow(r, hi)];
#pragma unroll
                for (int d = 0; d < 4; ++d) o[d][r] *= a; }
            asm volatile("s_waitcnt lgkmcnt(0)" ::: "memory");
        }
    }
    float ps = 0.f;
#pragma unroll
    for (int r = 0; r < 16; ++r) { p0[r] = __builtin_amdgcn_exp2f(p0[r]); ps += p0[r]; }
#pragma unroll
    for (int r = 0; r < 16; ++r) { p1[r] = __builtin_amdgcn_exp2f(p1[r]); ps += p1[r]; }
    { auto rr = __builtin_amdgcn_permlane32_swap(__float_as_uint(ps), __float_as_uint(ps), false, false);
      ps = __uint_as_float(rr[0]) + __uint_as_float(rr[1]); }
    l_reg += ps;
    PK4(p0, 0, pa0); PK4(p0, 8, pa1); PK4(p1, 0, pa2); PK4(p1, 8, pa3);
}
constexpr int M_OFF_V = 0, M_OFF_K = 49152, M_OFF_R = 81920, M_OFF_WS = 98304, MLA_LDS_BYTES = 98304 + 8 * 256;
template <bool ROLEB, int VAR = 0> __device__ __forceinline__ void mla_body(const Unit u, ALAS char* lds) {
    int tid_o = threadIdx.x; asm volatile("" : "+v"(tid_o));
    const int tid = tid_o, wid = __builtin_amdgcn_readfirstlane(tid >> 6), lane = tid & 63, r32 = lane & 31, hi = lane >> 5;
    const bool actw = wid < u.nact; constexpr bool roleB = ROLEB;
    const int sr = tid >> 4, sc = (tid & 15) * 8;
    const int vst0 = v_st(sr, sc), vst1 = v_st(32 + sr, sc), kws = KSWZ(sr, sc * 2);
    const int rk = tid >> 3, rc = (tid & 7) * 8, rws = RSWZ(rk, rc * 2);
    ALAS char* V_l = lds + M_OFF_V; ALAS char* K_l = lds + M_OFF_K; ALAS char* R_l = lds + M_OFF_R;
    ALAS float* al_l = (ALAS float*)(lds + M_OFF_WS) + wid * 64; ALAS float* li_l = al_l + 32;
    const unsigned vbase = (unsigned)(uintptr_t)V_l + (unsigned)v_rd_base(lane);
    bf16x8 qr[12];
#pragma unroll
    for (int d0 = 0; d0 < 12; ++d0) qr[d0] = (bf16x8){0, 0, 0, 0, 0, 0, 0, 0};
    if (actw) {
#pragma unroll
        for (int d0 = 0; d0 < 12; ++d0) qr[d0] = *(const bf16x8*)(u.Q + (size_t)(wid * 32 + r32) * u.ldq + d0 * 16 + hi * 8);
    }
    const int cw = (u.P0 + wid * 32) >> 6;
    float m_reg = -1e30f, l_reg = 0.f;
    f32x16 o[4], p0, p1;
#pragma unroll
    for (int r = 0; r < 16; ++r) { p0[r] = 0.f; p1[r] = 0.f; }
#pragma unroll
    for (int d = 0; d < 4; ++d)
#pragma unroll
        for (int r = 0; r < 16; ++r) o[d][r] = 0.f;
    bf16x8 st_k0, st_k1, st_v0, st_v1, st_r;
#define LOADT(tt) do { const size_t r0_ = (size_t)(tt) * 64; \
        st_k0 = *(const bf16x8*)(u.K + (r0_ + sr) * 2048 + sc); st_k1 = *(const bf16x8*)(u.K + (r0_ + 32 + sr) * 2048 + sc); \
        st_v0 = *(const bf16x8*)(u.V + (r0_ + sr) * 2048 + sc); st_v1 = *(const bf16x8*)(u.V + (r0_ + 32 + sr) * 2048 + sc); \
        st_r = *(const bf16x8*)(u.Kr + (r0_ + rk) * 64 + rc); } while (0)
#define MLA_QK(kb) do { _Pragma("unroll") for (int r = 0; r < 16; ++r) { p0[r] = 0.f; p1[r] = 0.f; } \
        if (VAR == 4 || VAR == 0 || VAR == 5) qk192_pipe(p0, p1, K_l + (kb) * 16384, R_l + (kb) * 8192, r32, hi, qr); else if (VAR != 3) { qk128(p0, p1, K_l + (kb) * 16384, r32, hi, qr); qk64(p0, p1, R_l + (kb) * 8192, r32, hi, qr + 8); } } while (0)
#define MLA_SMPV(vs) do { bf16x8 pa0, pa1, pa2, pa3; \
        if (VAR == 1) { PK4(p0, 0, pa0); PK4(p0, 8, pa1); PK4(p1, 0, pa2); PK4(p1, 8, pa3); l_reg += p0[0]; } \
        else mla_softmax(p0, p1, m_reg, l_reg, o, al_l, r32, hi, pa0, pa1, pa2, pa3); \
        if (VAR != 2) pv_tile(o, vbase + (unsigned)((vs) * 16384), pa0, pa1, pa2, pa3); \
        else { _Pragma("unroll") for (int r = 0; r < 4; ++r) o[r][0] += __builtin_bit_cast(float, (unsigned)pa0[r] ^ (unsigned)pa1[r] ^ (unsigned)pa2[r] ^ (unsigned)pa3[r]); } } while (0)
    LOADT(0);
    int vs_cur = 0, vs_prev = 2;
    for (int i = 0; i <= u.NT; ++i) {
        const int kb = i & 1;
        if (i < u.NT && VAR != 5) {
            *(ALAS bf16x8*)(K_l + kb * 16384 + kws) = st_k0; *(ALAS bf16x8*)(K_l + kb * 16384 + kws + 32 * 256) = st_k1;
            *(ALAS bf16x8*)(V_l + vs_cur * 16384 + vst0) = st_v0; *(ALAS bf16x8*)(V_l + vs_cur * 16384 + vst1) = st_v1;
            *(ALAS bf16x8*)(R_l + kb * 8192 + rws) = st_r;
            __syncthreads();
            if (i + 1 < u.NT) LOADT(i + 1);
        }
        if (actw) {
            if constexpr (!roleB) { if (i < u.NT && i <= cw) { MLA_QK(kb); MLA_SMPV(vs_cur); } }
            else { if (i >= 1 && i - 1 <= cw) MLA_SMPV(vs_prev);
                   if (i < u.NT && i <= cw) MLA_QK(kb); }
        }
        vs_prev = vs_cur; vs_cur = (vs_cur == 2) ? 0 : vs_cur + 1;
    }
    if (actw) {
        if (hi == 0) li_l[r32] = l_reg;
        asm volatile("s_waitcnt lgkmcnt(0)" ::: "memory");
        float rli[16];
#pragma unroll
        for (int r = 0; r < 16; ++r) rli[r] = 1.0f / li_l[crow(r, hi)];
        bf16* Ow = u.O + (size_t)(wid * 32) * u.ldo;
#pragma unroll
        for (int r = 0; r < 16; ++r) { const int orow = crow(r, hi); float sq = 0.f;
#pragma unroll
            for (int d0 = 0; d0 < 4; ++d0) { const float v = o[d0][r] * rli[r]; const float vn = __shfl_xor(v, 1); sq += v * v;
                if ((r32 & 1) == 0) *(unsigned*)(Ow + (size_t)orow * u.ldo + d0 * 32 + r32) = cvtpk(v, vn); }
            sq += __shfl_xor(sq, 1); sq += __shfl_xor(sq, 2); sq += __shfl_xor(sq, 4); sq += __shfl_xor(sq, 8); sq += __shfl_xor(sq, 16);
            if (ATT_SSQ_ATOMICS && r32 == 0) __hip_atomic_fetch_add(u.ssq + wid * 32 + orow, sq, __ATOMIC_RELAXED, __HIP_MEMORY_SCOPE_AGENT); }
    }
    __syncthreads();
#undef LOADT
#undef MLA_QK
#undef MLA_SMPV
}
constexpr int D_OFF_K = 0, D_OFF_R = 49152, D_OFF_V = 73728, D_OFF_WS = 122880, DMA_LDS_BYTES = 122880 + 8 * 256;
template <int VAR = 0> __device__ __forceinline__ void mla_unit_dma(const Unit u, ALAS char* lds) {
    int tid_o = threadIdx.x; asm volatile("" : "+v"(tid_o));
    const int tid = tid_o, wid = __builtin_amdgcn_readfirstlane(tid >> 6), lane = tid & 63, r32 = lane & 31, hi = lane >> 5;
    const bool actw = wid < u.nact;
    if (false) __builtin_amdgcn_s_setprio(1);
    ALAS char* K_l = lds + D_OFF_K; ALAS char* R_l = lds + D_OFF_R; ALAS char* V_l = lds + D_OFF_V;
    ALAS float* al_l = (ALAS float*)(lds + D_OFF_WS) + wid * 64; ALAS float* li_l = al_l + 32;
    const unsigned vbase = (unsigned)(uintptr_t)V_l + (unsigned)v_rd_base(lane);
    unsigned offK[2], offV[2], offR;
#pragma unroll
    for (int j = 0; j < 2; ++j) {
        const int p = wid + 8 * j;
        { const int r = 4 * p + (lane >> 4), c = (lane & 15) ^ (r & 15); offK[j] = (unsigned)(r * 4096 + c * 16); }
        { const int sti = 2 * p + (lane >> 5), kk = (sti >> 2) * 8 + ((lane & 31) >> 2), k = (kk & ~0xC) | ((kk & 4) << 1) | ((kk & 8) >> 1), c = (sti & 3) * 32 + (lane & 3) * 8; offV[j] = (unsigned)(k * 4096 + c * 2); }
    }
    { const int r = 8 * wid + (lane >> 3), c = (lane & 7) ^ ((r >> 1) & 7); offR = (unsigned)(r * 128 + c * 16); }
    const char* gK = (const char*)u.K; const char* gV = (const char*)u.V; const char* gR = (const char*)u.Kr;
#define DMA_TILE(tt, slot) do { const size_t tb_ = (size_t)(tt) * 64; \
        __builtin_amdgcn_global_load_lds((const unsigned*)(gK + tb_ * 4096 + offK[0]), (ALAS unsigned*)(K_l + (slot) * 16384 + wid * 1024), 16, 0, 0); \
        __builtin_amdgcn_global_load_lds((const unsigned*)(gK + tb_ * 4096 + offK[1]), (ALAS unsigned*)(K_l + (slot) * 16384 + (wid + 8) * 1024), 16, 0, 0); \
        __builtin_amdgcn_global_load_lds((const unsigned*)(gR + tb_ * 128 + offR), (ALAS unsigned*)(R_l + (slot) * 8192 + wid * 1024), 16, 0, 0); \
        __builtin_amdgcn_global_load_lds((const unsigned*)(gV + tb_ * 4096 + offV[0]), (ALAS unsigned*)(V_l + (slot) * 16384 + wid * 1024), 16, 0, 0); \
        __builtin_amdgcn_global_load_lds((const unsigned*)(gV + tb_ * 4096 + offV[1]), (ALAS unsigned*)(V_l + (slot) * 16384 + (wid + 8) * 1024), 16, 0, 0); } while (0)
    bf16x8 qr[12];
#pragma unroll
    for (int d0 = 0; d0 < 12; ++d0) qr[d0] = (bf16x8){0, 0, 0, 0, 0, 0, 0, 0};
    if (actw) {
#pragma unroll
        for (int d0 = 0; d0 < 12; ++d0) qr[d0] = *(const bf16x8*)(u.Q + (size_t)(wid * 32 + r32) * u.ldq + d0 * 16 + hi * 8);
    }
#pragma unroll
    for (int d0 = 0; d0 < 12; ++d0) asm volatile("" : "+v"(qr[d0]));
    DMA_TILE(0, 0); if (u.NT > 1) DMA_TILE(1, 1);
    const int cw = (u.P0 + wid * 32) >> 6;
    float m_reg = 0.f, l_reg = 0.f;
    f32x16 o[4], p0, p1, negm;
#pragma unroll
    for (int r = 0; r < 16; ++r) negm[r] = 0.f;
#pragma unroll
    for (int d = 0; d < 4; ++d)
#pragma unroll
        for (int r = 0; r < 16; ++r) o[d][r] = 0.f;
    int sl = 0, sl2 = 2;
    for (int i = 0; i < u.NT; ++i) {
        if (i + 1 < u.NT) asm volatile("s_waitcnt vmcnt(5) lgkmcnt(0)" ::: "memory"); else asm volatile("s_waitcnt vmcnt(0) lgkmcnt(0)" ::: "memory");
        __builtin_amdgcn_s_barrier(); asm volatile("" ::: "memory");
        if (i + 2 < u.NT) DMA_TILE(i + 2, sl2);
        if (actw && i <= cw) {
            __builtin_amdgcn_s_setprio(1); qk192_pipe(p0, p1, K_l + sl * 16384, R_l + sl * 8192, r32, hi, qr, &negm); __builtin_amdgcn_s_setprio(0);
            bf16x8 pa0, pa1, pa2, pa3;
            mla_softmax_rel(p0, p1, m_reg, negm, i == 0, l_reg, o, al_l, r32, hi, pa0, pa1, pa2, pa3);
            __builtin_amdgcn_s_setprio(1); pv_tile(o, vbase + (unsigned)(sl * 16384), pa0, pa1, pa2, pa3); __builtin_amdgcn_s_setprio(0);
        }
        sl = (sl == 2) ? 0 : sl + 1; sl2 = (sl2 == 2) ? 0 : sl2 + 1;
    }
    asm volatile("s_waitcnt lgkmcnt(0)" ::: "memory"); __builtin_amdgcn_s_barrier(); asm volatile("" ::: "memory");
    if (actw) {
        if (hi == 0) li_l[r32] = l_reg;
        asm volatile("s_waitcnt lgkmcnt(0)" ::: "memory");
        float rli[16];
#pragma unroll
        for (int r = 0; r < 16; ++r) rli[r] = 1.0f / li_l[crow(r, hi)];
        store_o_staged(o, rli, u.O + (size_t)(wid * 32) * u.ldo, u.ldo, lds + wid * 8192, lane, r32, hi, u.ssq + (size_t)(wid * 32) * 32);
    }
    asm volatile("s_waitcnt lgkmcnt(0)" ::: "memory"); __builtin_amdgcn_s_barrier(); asm volatile("" ::: "memory");
    __builtin_amdgcn_s_setprio(0);
#undef DMA_TILE
}
template <int VAR = 0> __device__ __forceinline__ void mla_unit(const Unit u, ALAS char* lds) {
    int tid_o = threadIdx.x; asm volatile("" : "+v"(tid_o));
    if (__builtin_amdgcn_readfirstlane(tid_o >> 6) >= 4) mla_body<true, VAR>(u, lds); else mla_body<false, VAR>(u, lds);
}
#undef PK4
}
#define GAS __attribute__((address_space(1)))
#define LAS __attribute__((address_space(3)))
typedef unsigned short bf16;
typedef unsigned v4u __attribute__((ext_vector_type(4)));
typedef float f32x4 __attribute__((ext_vector_type(4)));
typedef short bf16x8 __attribute__((ext_vector_type(8)));
typedef GAS unsigned gu32;
typedef GAS unsigned long long gu64;
#define RLX_AGENT __ATOMIC_RELAXED, __HIP_MEMORY_SCOPE_AGENT
#define LDS_WAIT() asm volatile("s_waitcnt lgkmcnt(0)" ::: "memory")
#define VM_WAIT() asm volatile("s_waitcnt vmcnt(0)" ::: "memory")
__device__ __forceinline__ unsigned long long rt() { return __builtin_amdgcn_s_memrealtime(); }
__device__ __forceinline__ unsigned f2bf(float f) { unsigned u = __builtin_bit_cast(unsigned, f); return (u + 0x7fffu + ((u >> 16) & 1u)) >> 16; }
__device__ __forceinline__ unsigned pk2(float lo, float hi) { return f2bf(lo) | (f2bf(hi) << 16); }

#define XB_TMO      128
#define XB_XCNT(j)  (256  + 64 * (j))
#define XB_XSUB(j)  (1280 + 64 * (j))
#define XB_XGEN(j)  (2304 + 64 * (j))
#define XB_TOP      3328
#define XB_TOPGEN   3392
#define XCD_BAR_WORDS 3456
#define XB_SPIN_CAP (1u << 18)

__device__ __forceinline__ unsigned xb_ld(unsigned* p)              { return __hip_atomic_load(p, __ATOMIC_RELAXED, __HIP_MEMORY_SCOPE_AGENT); }
__device__ __forceinline__ unsigned xb_add(unsigned* p, unsigned v) { return __hip_atomic_fetch_add(p, v, __ATOMIC_RELAXED, __HIP_MEMORY_SCOPE_AGENT); }
__device__ __forceinline__ unsigned xb_xcc_id() { return (unsigned)__builtin_amdgcn_s_getreg((3 << 11) | 20) & 0xFu; }
#define XB_SPIN(cond, bar) do { unsigned _sp = 0; while (cond) { __builtin_amdgcn_s_sleep(1); \
    if ((++_sp & 255u) == 0u) { if (xb_ld(&(bar)[XB_TMO])) break; if (_sp > XB_SPIN_CAP) { atomicAdd(&(bar)[XB_TMO], 1u); break; } } } } while (0)

struct XcdBarrier {
    unsigned* bar; unsigned x;
    volatile LAS unsigned* st;
};

__device__ __forceinline__ XcdBarrier xcd_barrier_post(unsigned* bar, volatile LAS unsigned* st) {
    XcdBarrier b; b.bar = bar; b.x = xb_xcc_id(); b.st = st;
    if (threadIdx.x == 0) (void)xb_add(&bar[XB_XCNT(b.x)], 1u);
    return b;
}
__device__ __forceinline__ void xcd_barrier_complete(unsigned* bar, unsigned x, unsigned& nloc, unsigned& nx) {
    const unsigned G = gridDim.x * gridDim.y * gridDim.z;
    unsigned sum, cnt, mine, sp = 0u;
    for (;;) {
        sum = 0u; cnt = 0u; mine = 0u;
#pragma unroll
        for (unsigned j = 0; j < 16; ++j) { const unsigned c = xb_ld(&bar[XB_XCNT(j)]); sum += c; cnt += (c > 0u) ? 1u : 0u; mine = (j == x) ? c : mine; }
        if (sum == G) break;
        __builtin_amdgcn_s_sleep(1);
        if ((++sp & 255u) == 0u) { if (xb_ld(&bar[XB_TMO])) break; if (sp > XB_SPIN_CAP) { atomicAdd(&bar[XB_TMO], 1u); break; } }
    }
    nloc = mine > 0u ? mine : 1u; nx = cnt > 0u ? cnt : 1u;
}

__device__ __forceinline__ void xcd_barrier(const XcdBarrier& b) {
    asm volatile("s_waitcnt vmcnt(0)" ::: "memory");
    __syncthreads();
    if (threadIdx.x == 0) {
        unsigned* bar = b.bar;
        __builtin_amdgcn_s_waitcnt(0);
        unsigned nloc = b.st[0], nx = b.st[1];
        if (nloc == 0u) { xcd_barrier_complete(bar, b.x, nloc, nx); b.st[0] = nloc; b.st[1] = nx; }
        const unsigned old = xb_add(&bar[XB_XSUB(b.x)], 1u);
        const unsigned gen = old / nloc;
        if (old + 1u == (gen + 1u) * nloc) {
            __builtin_amdgcn_fence(__ATOMIC_RELEASE, "agent");
            asm volatile("s_waitcnt vmcnt(0)" ::: "memory");
            const unsigned og = xb_add(&bar[XB_TOP], 1u);
            const unsigned tg = og / nx;
            if (og + 1u == (tg + 1u) * nx) xb_add(&bar[XB_TOPGEN], 1u);
            else XB_SPIN(xb_ld(&bar[XB_TOPGEN]) == tg, bar);
            __builtin_amdgcn_fence(__ATOMIC_ACQUIRE, "agent");
            xb_add(&bar[XB_XGEN(b.x)], 1u);
            asm volatile("s_waitcnt vmcnt(0)" ::: "memory");
        } else {
            XB_SPIN(xb_ld(&bar[XB_XGEN(b.x)]) == gen, bar);
            __builtin_amdgcn_fence(__ATOMIC_ACQUIRE, "agent");
            asm volatile("s_waitcnt vmcnt(0)" ::: "memory");
        }
    }
    __syncthreads();
}
constexpr int NWAVES = 8;
constexpr int DM = 4096, NP = 16384, NS = 512, MTOK = NP + NS;
constexpr int SEQ = 4096, PAST = 1024, DSEQ = 64, SKVS = PAST + DSEQ;
constexpr int KVROWS = NP + 8 * SKVS;
constexpr int NINP = 7936;
constexpr int QLORA = 1024, KVLORA = 512, ROPE = 64, NOPE = 128, NH = 16, DFF = 16384;
constexpr float EPS = 1e-6f;
constexpr float LOG2E = 1.4426950408889634f;
constexpr float QS_MLA = 0.07216878364870322f * LOG2E;
constexpr float QS_SB = 0.08838834764831845f * LOG2E;

constexpr size_t O_Y = 0, O_CKV_P = 69206016, O_KR_P = 85983232, O_SBK_P = 88080384, O_SBV_P = 155189248,
                 O_CKV_S = 222298112, O_KR_S = 222822400, O_SBK_S = 222887936, O_SBV_S = 224985088, O_END = 227082240;

constexpr size_t MiB = 1u << 20;
constexpr size_t WS_CTL = 0, CTL_ZERO_BYTES = 1 * MiB;
constexpr size_t WS_SSQH = 512 * 1024;
constexpr size_t WS_TAB = 1 * MiB;
constexpr size_t WS_WIN = 2 * MiB;
constexpr size_t WS_WQB = 64 * MiB;
constexpr size_t WS_WKVB = 70 * MiB;
constexpr size_t WS_WO = 74 * MiB;
constexpr size_t WS_WUP = 106 * MiB;
constexpr size_t WS_WDN = 234 * MiB;
constexpr size_t WS_XN = 362 * MiB;
constexpr size_t WS_R = 494 * MiB;
constexpr size_t WS_U = WS_R;
constexpr size_t WS_QLAT = WS_R;
constexpr size_t WS_AKV = WS_QLAT + 33 * MiB;
constexpr size_t WS_KROPE = WS_AKV + 25 * MiB;
constexpr size_t WS_VB = WS_KROPE + 4 * MiB;
constexpr size_t WS_QB = WS_VB + 98 * MiB;
constexpr size_t WS_KN = WS_QB + 99 * MiB;
constexpr size_t WS_SBQ = WS_KN + 98 * MiB;
constexpr size_t WS_SBK = WS_SBQ + 66 * MiB;
constexpr size_t WS_SBV = WS_SBK + 98 * MiB;
constexpr size_t WS_R2 = WS_SBV + 98 * MiB;
constexpr size_t WS_LAT = WS_R2;
constexpr size_t WS_QRAW = WS_R2;
constexpr size_t WS_KNRAW = WS_R2 + 198 * MiB;
constexpr size_t WS_MLAO = WS_R2;
constexpr size_t WS_SBO = WS_R2 + 66 * MiB;
constexpr size_t WS_MERGED = WS_R2 + 132 * MiB;
constexpr size_t WS_SLAB = WS_R2;
constexpr size_t WS_Y0B = WS_R2 + 264 * MiB;
constexpr size_t WS_WDN1 = WS_R2 + 398 * MiB;
constexpr size_t WS_SSQP = WS_WDN1 + 128 * MiB;
constexpr size_t WS_END = WS_SSQP + 3 * MiB;
static_assert(WS_U + (size_t)MTOK * DFF * 2 <= WS_END, "U fits the overlay region");
static_assert(WS_XN + (size_t)MTOK * DM * 2 <= WS_R && WS_WDN + (size_t)DM * DFF * 2 <= WS_XN && WS_WIN + (size_t)NINP * DM * 2 <= WS_WQB, "ws map");
constexpr int CW_TMO = 0, CW_CODE = 1, CW_BAR = 4096;

constexpr int RING_OFF = 0, RING_BYTES = 131072;
constexpr int LDSCTL_OFF = RING_BYTES, MISC_OFF = LDSCTL_OFF + 320;
constexpr int XCH_OFF = LDSCTL_OFF + 1024;
constexpr int LDS_BYTES = 147456;
static_assert(XCH_OFF + 8192 <= LDS_BYTES, "LDS map");
static_assert(att::ATT_LDS_BYTES <= RING_BYTES && att::MLA_LDS_BYTES <= RING_BYTES && att::DMA_LDS_BYTES <= RING_BYTES, "attention scratch fits the ring region");

#if defined(__HIP_DEVICE_COMPILE__)
#define ASSUME_GLOBAL(p) do { __builtin_assume(!__builtin_amdgcn_is_shared((const __attribute__((address_space(0))) void*)(p))); __builtin_assume(!__builtin_amdgcn_is_private((const __attribute__((address_space(0))) void*)(p))); } while (0)
#else
#define ASSUME_GLOBAL(p) do { } while (0)
#endif
typedef float f32x2 __attribute__((ext_vector_type(2)));
__device__ __forceinline__ float wave_sum(float v) {
#pragma unroll
    for (int o = 1; o < 64; o <<= 1) v += __shfl_xor(v, o);
    return v;
}
__device__ __forceinline__ unsigned pkbf(float lo, float hi) { return pg8::cvt_pk_bf16(lo, hi); }
__device__ __forceinline__ float bf2f(unsigned short b) { return __uint_as_float(((unsigned)b) << 16); }
__device__ __forceinline__ int kvrow_of(int m) { return m < NP ? m : NP + ((m - NP) >> 6) * SKVS + PAST + ((m - NP) & 63); }
__device__ __forceinline__ int pos_of(int m) { return m < NP ? (m & (SEQ - 1)) : PAST + ((m - NP) & 63); }

__device__ __forceinline__ void sincos_acc(float ang, float& s, float& c) {
    const double a = (double)ang; const double q = rint(a * 0.63661977236758134308);
    double r = fma(-q, 1.57079632679489661923, a); r = fma(-q, 6.123233995736766e-17, r);
    const float rf = (float)r; const int qi = (int)q; const float r2 = rf * rf;
    const float sp = rf + rf * r2 * (-1.6666667163e-1f + r2 * (8.3333337680e-3f + r2 * (-1.9841270114e-4f + r2 * 2.7557314297e-6f)));
    const float cp = 1.f + r2 * (-0.5f + r2 * (4.1666667908e-2f + r2 * (-1.3888889225e-3f + r2 * (2.4801587642e-5f + r2 * (-2.7557314297e-7f)))));
    switch (qi & 3) { case 0: s = sp; c = cp; break; case 1: s = cp; c = -sp; break; case 2: s = -sp; c = -cp; break; default: s = -cp; c = sp; break; }
}

struct Frame {
    LAS unsigned char* lds; volatile LAS unsigned* MISC; gu32* ctl;
    int tid, lane, wave, vcu, G;
};
struct Args { const float* in[22]; float* out; unsigned char* ws; };

struct TItem { const float* src; bf16* dst; const float* gk; int N, K; };
__device__ __forceinline__ void ti_load(const TItem& P, float (&tv)[32], f32x4& g0, f32x4& g1, int lane) {
    if (P.gk) { g0 = *(const GAS f32x4*)(P.gk + 8 * (lane & 7)); g1 = *(const GAS f32x4*)(P.gk + 8 * (lane & 7) + 4); }
    else { g0 = f32x4{1.f, 1.f, 1.f, 1.f}; g1 = g0; }
    const GAS float* s = (const GAS float*)P.src + (size_t)(lane >> 5) * P.N + (lane & 31);
#pragma unroll
    for (int i = 0; i < 32; ++i) tv[i] = s[(size_t)(2 * i) * P.N];
}
__device__ __forceinline__ void ti_finish(const TItem& P, const float (&tv)[32], const f32x4 g0, const f32x4 g1, LAS float* scr, int lane) {
#pragma unroll
    for (int i = 0; i < 32; ++i) scr[(2 * i + (lane >> 5)) * 33 + (lane & 31)] = tv[i];
    LDS_WAIT(); asm volatile("" ::: "memory");
    const int c = lane & 7;
#pragma unroll
    for (int j = 0; j < 4; ++j) { const int n = (lane >> 3) + 8 * j; const LAS float* s = scr + (8 * c) * 33 + n;
        v4u o; o.x = pkbf(s[0 * 33] * g0.x, s[1 * 33] * g0.y); o.y = pkbf(s[2 * 33] * g0.z, s[3 * 33] * g0.w); o.z = pkbf(s[4 * 33] * g1.x, s[5 * 33] * g1.y); o.w = pkbf(s[6 * 33] * g1.z, s[7 * 33] * g1.w);
        *(GAS v4u*)(P.dst + (size_t)n * P.K + 8 * c) = o; }
    LDS_WAIT(); asm volatile("" ::: "memory");
}
__device__ __forceinline__ void rms_row_4096(const float* xrow, const float* g, bf16* orow, int lane) {
    const GAS f32x4* xr = (const GAS f32x4*)xrow + lane; const GAS f32x4* gr = (const GAS f32x4*)g + lane;
    f32x4 v[16]; float s = 0.f;
#pragma unroll
    for (int j = 0; j < 16; ++j) { v[j] = xr[64 * j]; s += (v[j].x * v[j].x + v[j].y * v[j].y) + (v[j].z * v[j].z + v[j].w * v[j].w); }
    const float rstd = 1.0f / sqrtf(wave_sum(s) * (1.f / 4096.f) + EPS);
    GAS unsigned long long* o8 = (GAS unsigned long long*)orow + lane;
#pragma unroll
    for (int j = 0; j < 16; ++j) { const f32x4 gg = gr[64 * j];
        o8[64 * j] = (unsigned long long)pkbf(v[j].x * rstd * gg.x, v[j].y * rstd * gg.y) | ((unsigned long long)pkbf(v[j].z * rstd * gg.z, v[j].w * rstd * gg.w) << 32); }
}
__device__ __forceinline__ void rms_row_4096_bf16(const bf16* xrow, const float* g, bf16* orow, int lane) {
    const GAS v4u* xr = (const GAS v4u*)xrow + lane; float x[64]; float s = 0.f;
#pragma unroll
    for (int j = 0; j < 8; ++j) { const v4u w = xr[64 * j]; const unsigned ww[4] = {w.x, w.y, w.z, w.w};
#pragma unroll
        for (int e = 0; e < 4; ++e) { x[8 * j + 2 * e] = __uint_as_float(ww[e] << 16); x[8 * j + 2 * e + 1] = __uint_as_float(ww[e] & 0xffff0000u); } }
#pragma unroll
    for (int i = 0; i < 64; ++i) s += x[i] * x[i];
    const float rstd = 1.0f / sqrtf(wave_sum(s) * (1.f / 4096.f) + EPS);
#pragma unroll
    for (int j = 0; j < 8; ++j) { const GAS f32x4* gp = (const GAS f32x4*)(g + 8 * (64 * j + lane)); const f32x4 g0 = gp[0], g1 = gp[1];
        v4u o; o.x = pkbf(x[8 * j] * rstd * g0.x, x[8 * j + 1] * rstd * g0.y); o.y = pkbf(x[8 * j + 2] * rstd * g0.z, x[8 * j + 3] * rstd * g0.w);
        o.z = pkbf(x[8 * j + 4] * rstd * g1.x, x[8 * j + 5] * rstd * g1.y); o.w = pkbf(x[8 * j + 6] * rstd * g1.z, x[8 * j + 7] * rstd * g1.w);
        *((GAS v4u*)orow + 64 * j + lane) = o; }
}
__device__ __forceinline__ void cache_rows_to_bf16(const float* src, bf16* dst, int W, int gthread, int nthreads) {
    const int per_row = W >> 2; const long total = (long)8 * PAST * per_row;
    for (long i = gthread; i < total; i += nthreads) {
        const int row = (int)(i / per_row), c4 = (int)(i % per_row), b = row >> 10, j = row & 1023;
        const f32x4 v = *(const GAS f32x4*)(src + (size_t)row * W + c4 * 4);
        *(GAS unsigned long long*)(dst + (size_t)(NP + b * SKVS + j) * W + c4 * 4) = (unsigned long long)pkbf(v.x, v.y) | ((unsigned long long)pkbf(v.z, v.w) << 32);
    }
}

template <bool NORM, class Order>
__device__ __forceinline__ void tail_reduce_res(const Order& S, const float* resP, const float* resS, float* out, bf16* HB, float* ssq, const float* ssqm, const float* ssqs, bf16* YB, int tid) {
    if (S.nsplit == 1) return;
    const int wid = __builtin_amdgcn_readfirstlane(tid >> 6), lane = tid & 63, wr = wid >> 2, wc = wid & 3, fr = lane & 15, fq = lane >> 4;
    const int j = S.c / S.nsplit, p = S.c % S.nsplit, per = 32 / S.nsplit;
    pg8::Unit u; S.map(S.nfull * S.G + j, u);
    for (int ii = 0; ii < per; ++ii) {
        const int idx = p * per + ii, a = idx >> 4, b = (idx >> 3) & 1, mm = (idx >> 1) & 3, n = idx & 1;
        const int row = u.pm * 256 + a * 128 + wr * 64 + mm * 16 + fr, col = u.pn * 256 + b * 128 + wc * 32 + 8 * fq + 4 * n;
        f32x4 s = {0.f, 0.f, 0.f, 0.f}, s2 = {0.f, 0.f, 0.f, 0.f};
        for (int sp = 0; sp < S.nsplit; ++sp) { const f32x4 v = *((const GAS f32x4*)(S.slab + (size_t)(j * S.nsplit + sp) * 65536) + (size_t)wid * 2048 + idx * 64 + lane); if (2 * sp < S.nsplit) s += v; else s2 += v; }
        if (NORM) {
            const float rm = 1.0f / sqrtf(__hip_atomic_load(ssqm + row, __ATOMIC_RELAXED, __HIP_MEMORY_SCOPE_AGENT) * (1.f / 2048.f) + EPS), rs = 1.0f / sqrtf(__hip_atomic_load(ssqs + row, __ATOMIC_RELAXED, __HIP_MEMORY_SCOPE_AGENT) * (1.f / 2048.f) + EPS);
            s = s * rm + s2 * rs; } else s += s2;
        f32x4 v;
        if (NORM) { if (YB) { const unsigned long long h = *(const GAS unsigned long long*)(YB + (size_t)row * DM + col); const unsigned h0 = (unsigned)h, h1 = (unsigned)(h >> 32);
                                v = (f32x4){__uint_as_float(h0 << 16), __uint_as_float(h0 & 0xffff0000u), __uint_as_float(h1 << 16), __uint_as_float(h1 & 0xffff0000u)} + s; }
                    else { const float* rp = (row >= NP) ? resS + (size_t)(row - NP) * DM + col : resP + (size_t)row * DM + col; v = *(const GAS f32x4*)rp + s; } }
        else { const unsigned long long h = *(const GAS unsigned long long*)(HB + (size_t)row * DM + col); const unsigned h0 = (unsigned)h, h1 = (unsigned)(h >> 32);
               v = (f32x4){__uint_as_float(h0 << 16), __uint_as_float(h0 & 0xffff0000u), __uint_as_float(h1 << 16), __uint_as_float(h1 & 0xffff0000u)} + s;
               if (YB) { *(GAS unsigned long long*)(YB + (size_t)row * DM + col) = (unsigned long long)pkbf(v.x, v.y) | ((unsigned long long)pkbf(v.z, v.w) << 32);
                         float q = (v.x * v.x + v.y * v.y) + (v.z * v.z + v.w * v.w); q += __shfl_xor(q, 16); q += __shfl_xor(q, 32);
                         if (fq == 0) __hip_atomic_fetch_add(ssq + row, q, __ATOMIC_RELAXED, __HIP_MEMORY_SCOPE_AGENT); }
               else *(GAS f32x4*)(out + (size_t)row * DM + col) = v; }
        if (NORM) {
            *(GAS unsigned long long*)(HB + (size_t)row * DM + col) = (unsigned long long)pkbf(v.x, v.y) | ((unsigned long long)pkbf(v.z, v.w) << 32);
            float q = (v.x * v.x + v.y * v.y) + (v.z * v.z + v.w * v.w); q += __shfl_xor(q, 16); q += __shfl_xor(q, 32);
            if (fq == 0) __hip_atomic_fetch_add(ssq + row, q, __ATOMIC_RELAXED, __HIP_MEMORY_SCOPE_AGENT);
        }
    }
}

__global__ void __launch_bounds__(NWAVES * 64, 2) hymba_fwd(Args args) {
    extern __shared__ __attribute__((aligned(16))) unsigned char lds[];
    Frame F;
    F.lds = (LAS unsigned char*)lds;
    F.MISC = (volatile LAS unsigned*)(F.lds + MISC_OFF);
    F.tid = threadIdx.x; F.lane = F.tid & 63; F.wave = __builtin_amdgcn_readfirstlane(F.tid >> 6);
    F.G = gridDim.x; { const int bx = blockIdx.x; F.vcu = (F.G % 8 == 0) ? (bx % 8) * (F.G / 8) + bx / 8 : bx; }
    unsigned char* ws = args.ws;
    F.ctl = (gu32*)(ws + WS_CTL);
    for (int u = F.tid; u < (LDS_BYTES - LDSCTL_OFF) / 4; u += NWAVES * 64) ((LAS unsigned*)(F.lds + LDSCTL_OFF))[u] = 0u;
    __syncthreads();
    XcdBarrier bar = xcd_barrier_post((unsigned*)(F.ctl + CW_BAR), F.MISC + 8);
#ifndef G5_WGM
#define G5_WGM 8
#endif
#ifndef PROBE_MASK
#define PROBE_MASK 0
#endif
#ifndef PROBE_BAR
#define PROBE_BAR 1
#endif
#ifndef PHMASK
#define PHMASK 0x3fff
#endif
#define GRID_BAR() do { for (int br_ = 0; br_ < PROBE_BAR; ++br_) xcd_barrier(bar); } while (0)
#define PHASE_PTRS() unsigned long long zoff_ = 0; asm volatile("" : "+s"(zoff_)); unsigned char* const wsb = args.ws + zoff_; float* const OUT = args.out + zoff_;     int ptid_ = threadIdx.x; asm volatile("" : "+v"(ptid_)); int bx_ = blockIdx.x, G_ = gridDim.x; asm volatile("" : "+s"(bx_), "+s"(G_)); const int VCU = (G_ % 8 == 0) ? (bx_ % 8) * (G_ / 8) + bx_ / 8 : bx_; (void)VCU; \
    const int LANE = ptid_ & 63, WAVE = __builtin_amdgcn_readfirstlane(ptid_ >> 6); const int gw = VCU * NWAVES + WAVE, NGW = G_ * NWAVES; const int gthread = gw * 64 + LANE, nthreads = NGW * 64; (void)gthread; (void)nthreads; (void)gw; (void)NGW; (void)LANE
#define WIN_T ((bf16*)(wsb + WS_WIN))
#define WQB_T ((bf16*)(wsb + WS_WQB))
#define WKVB_T ((bf16*)(wsb + WS_WKVB))
#define WO_T ((bf16*)(wsb + WS_WO))
#define WUP_T ((bf16*)(wsb + WS_WUP))
#define WDN_T0 ((bf16*)(wsb + WS_WDN))
#define WDN_T1 ((bf16*)(wsb + WS_WDN1))
#define XN ((bf16*)(wsb + WS_XN))
#define UB ((bf16*)(wsb + WS_U))
#define QLAT ((bf16*)(wsb + WS_QLAT))
#define AKV ((bf16*)(wsb + WS_AKV))
#define KROPE ((bf16*)(wsb + WS_KROPE))
#define VB ((bf16*)(wsb + WS_VB))
#define QB ((bf16*)(wsb + WS_QB))
#define KN ((bf16*)(wsb + WS_KN))
#define SBQ ((bf16*)(wsb + WS_SBQ))
#define SBK ((bf16*)(wsb + WS_SBK))
#define SBV ((bf16*)(wsb + WS_SBV))
#define LAT ((float*)(wsb + WS_LAT))
#define QRAW ((float*)(wsb + WS_QRAW))
#define KNRAW ((float*)(wsb + WS_KNRAW))
#define MLAO ((bf16*)(wsb + WS_MLAO))
#define SBO ((bf16*)(wsb + WS_SBO))
#define MERGED ((bf16*)(wsb + WS_MERGED))
#define TAB ((f32x2*)(wsb + WS_TAB))
#define SLAB ((float*)(wsb + WS_SLAB))
#define Y0B ((bf16*)(wsb + WS_Y0B))
#define SSQH ((float*)(wsb + WS_SSQH))
#define SSQM ((float*)(wsb + WS_SSQH + 128 * 1024))
#define SSQS ((float*)(wsb + WS_SSQH + 256 * 1024))
#define SSQP ((float*)(wsb + WS_SSQP))
#define SSQY ((float*)(wsb + WS_SSQH + 384 * 1024))

    { PHASE_PTRS(); (void)OUT;
    for (int i = gthread; i < SEQ * 32; i += nthreads) {
        const int pos = i >> 5, k = i & 31;
        const float inv_freq = exp2f(-(float)k * (13.287712379549449f / 32.f));
        float s, c; sincos_acc((float)pos * inv_freq, s, c); TAB[i] = (f32x2){c, s};
    } }

#define CONVERT_ITEMS(LW, R_LO, R_HI, GWV, NGWV) do { \
        const float* w_in = args.in[7] + (size_t)(LW) * DM * 7744; const float* w_qb = args.in[9] + (size_t)(LW) * QLORA * 3072; \
        const float* w_kvb = args.in[11] + (size_t)(LW) * KVLORA * 4096; const float* w_o = args.in[18] + (size_t)(LW) * DM * DM; \
        const float* w_up = args.in[20] + (size_t)(LW) * DM * DFF; const float* w_dn = args.in[21] + (size_t)(LW) * DFF * DM; const int lw_ = (LW); \
        auto dec_ = [&](int it) -> TItem { \
                int r = (R_HI) - 1 - it; \
                if (r < I_IN) { const int kb = r / 242, nb = r % 242, n0 = nb * 32; return TItem{w_in + (size_t)(kb * 64) * 7744 + n0, WIN_T + (size_t)(n0 + (n0 >= 1600 ? 192 : 0)) * DM + kb * 64, lw_ ? args.in[6] + (size_t)lw_ * DM + kb * 64 : nullptr, 7744, DM}; } r -= I_IN; \
                if (r < I_QB) { const int kb = r / 96, nb = r % 96, n0 = nb * 32, h = n0 / 192, dd = n0 % 192; \
                    return TItem{w_qb + (size_t)(kb * 64) * 3072 + n0, WQB_T + (size_t)(dd < 128 ? h * 128 + dd : 2048 + (h >> 2) * 256 + ((dd - 128) >> 5) * 128 + (h & 3) * 32) * QLORA + kb * 64, nullptr, 3072, QLORA}; } r -= I_QB; \
                if (r < I_KVB) { const int kb = r / 128, nb = r % 128, n0 = nb * 32, h = n0 >> 8, dd = n0 & 255; \
                    return TItem{w_kvb + (size_t)(kb * 64) * 4096 + n0, WKVB_T + (size_t)(dd < 128 ? h * 128 + dd : 2048 + h * 128 + (dd - 128)) * KVLORA + kb * 64, nullptr, 4096, KVLORA}; } r -= I_KVB; \
                if (r < I_O) { const int kb = r / 128, nb = r % 128; \
                    return TItem{w_o + (size_t)(kb * 64) * DM + nb * 32, WO_T + (size_t)(nb * 32) * DM + kb * 64, (kb < 32 ? args.in[16] + (size_t)lw_ * 2048 : args.in[17] + (size_t)lw_ * 2048 - 2048) + kb * 64, DM, DM}; } r -= I_O; \
                if (r < I_UP) { const int kb = r / 512, nb = r % 512; return TItem{w_up + (size_t)(kb * 64) * DFF + nb * 32, WUP_T + (size_t)(nb * 32) * DM + kb * 64, args.in[19] + (size_t)lw_ * DM + kb * 64, DFF, DM}; } r -= I_UP; \
                { const int kb = r / 128, nb = r % 128; return TItem{w_dn + (size_t)(kb * 64) * DM + nb * 32, (lw_ ? WDN_T1 : WDN_T0) + ((size_t)((nb >> 3) * 256 + kb) * 256 + (nb & 7) * 32) * 64, nullptr, DM, 64}; } }; \
        const int n_ = (R_HI) - (R_LO); int it = (GWV); \
        if (it < n_) { \
            float tA[32], tB[32]; f32x4 gA0, gA1, gB0, gB1; \
            TItem PA = dec_(it), PB; ti_load(PA, tA, gA0, gA1, LANE); \
            for (;;) {                                     \
                const int it1 = it + (NGWV); PB = dec_(it1 < n_ ? it1 : it); ti_load(PB, tB, gB0, gB1, LANE); \
                ti_finish(PA, tA, gA0, gA1, scr, LANE); \
                if (it1 >= n_) break; \
                const int it2 = it1 + (NGWV); PA = dec_(it2 < n_ ? it2 : it1); ti_load(PA, tA, gA0, gA1, LANE); \
                ti_finish(PB, tB, gB0, gB1, scr, LANE); \
                if (it2 >= n_) break; \
                it = it2; \
            } } } while (0)
    constexpr int I_IN = 64 * 242, I_QB = 16 * 96, I_KVB = 8 * 128, I_O = 64 * 128, I_UP = 64 * 512, I_DN = 256 * 128;
    constexpr int NITEMS = I_IN + I_QB + I_KVB + I_O + I_UP + I_DN, EARLY_ITEMS = I_IN + I_QB + I_KVB + I_O, EARLY0_ITEMS = I_IN + I_QB + I_KVB;
#pragma unroll 1
    for (int l = 0; l < 2; ++l) {
        if (l == 0 || gridDim.x != 256) {
        for (int rep_ = 0; rep_ < (((PROBE_MASK >> 0) & 1) ? 2 : 1); ++rep_) if constexpr ((PHMASK >> 0) & 1) {
            PHASE_PTRS(); (void)OUT;
            LAS float* scr = (LAS float*)(F.lds + RING_OFF + WAVE * 16384);
            const bool early_ok = (G_ == 256);
            CONVERT_ITEMS(l, (l > 0 && early_ok) ? NITEMS : 0, (l == 0 && early_ok) ? EARLY0_ITEMS : NITEMS, gw, NGW);
            if (l == 0) {
            { unsigned zz = 0u; asm volatile("" : "+v"(zz)); const v4u z4 = {zz, zz, zz, zz};
              for (int i = gthread; i < 192 * DM / 8; i += nthreads) *(GAS v4u*)(WIN_T + (size_t)1600 * DM + (size_t)i * 8) = z4; }
            cache_rows_to_bf16(args.in[2] + (size_t)l * 8 * PAST * KVLORA, AKV, KVLORA, gthread, nthreads);
            cache_rows_to_bf16(args.in[3] + (size_t)l * 8 * PAST * ROPE, KROPE, ROPE, gthread, nthreads);
            const float* g = args.in[6] + (size_t)l * DM;
            for (int m = gw; m < MTOK; m += NGW) rms_row_4096(m < NP ? args.in[0] + (size_t)m * DM : args.in[1] + (size_t)(m - NP) * DM, g, XN + (size_t)m * DM, LANE);
            }
        }
        GRID_BAR();
        }
        for (int rep_ = 0; rep_ < (((PROBE_MASK >> 1) & 1) ? 2 : 1); ++rep_) if constexpr ((PHMASK >> 1) & 1) {
            PHASE_PTRS(); (void)OUT;
            pg8::Gemm g{l == 0 ? XN : Y0B, WIN_T, MTOK, NINP, DM, nullptr}; pg8::InOrder S; S.init3(MTOK, NINP, G_, bx_);
            pg8::EpiIn E{LAT, SBQ, SBK, SBV, OUT + O_SBK_P + (size_t)l * NP * 2048, OUT + O_SBV_P + (size_t)l * NP * 2048,
                         OUT + O_SBK_S + (size_t)l * NS * 2048, OUT + O_SBV_S + (size_t)l * NS * 2048, QS_SB, l == 0 ? nullptr : SSQY, EPS};
            const bool bg = (l == 0 && G_ == 256);
            const int rsplit = bg ? ((bx_ & 7) >> 1) : 0;
#pragma unroll 1
            for (int seg = 0; seg < 2; ++seg) {
                pg8::SubRange<pg8::InOrder> SS{S, seg ? rsplit : 0, seg ? (1 << 30) : rsplit};
                pg8::gemm_phase<pg8::EpiIn, pg8::SubRange<pg8::InOrder>, true, true>(F.lds + RING_OFF, g, SS, E);
                if (seg == 0 && bg) {
                    LAS float* scr = (LAS float*)(F.lds + RING_OFF + WAVE * 16384);
                    CONVERT_ITEMS(0, EARLY0_ITEMS, NITEMS, gw, NGW);
                    __syncthreads();
                }
            }
        }
        GRID_BAR();
        for (int rep_ = 0; rep_ < (((PROBE_MASK >> 2) & 1) ? 2 : 1); ++rep_) if constexpr ((PHMASK >> 2) & 1) {
            PHASE_PTRS(); (void)OUT;
            for (int i = gthread; i < MTOK; i += nthreads) { SSQH[i] = 0.f; SSQM[i] = 0.f; SSQS[i] = 0.f; if (l == 0) SSQY[i] = 0.f; }
            const float* g_q_a = args.in[8] + (size_t)l * QLORA; const float* g_kv_a = args.in[10] + (size_t)l * KVLORA; const float* g_k_rope = args.in[15] + (size_t)l * ROPE;
            for (int m = gw; m < MTOK; m += NGW) {
                const float* lr = LAT + (size_t)m * 1792; const int kvr = kvrow_of(m), pos = pos_of(m);
                {
                    f32x4 v[4]; float s = 0.f;
#pragma unroll
                    for (int j = 0; j < 4; ++j) { v[j] = *(const GAS f32x4*)(lr + 4 * (64 * j + LANE)); s += (v[j].x * v[j].x + v[j].y * v[j].y) + (v[j].z * v[j].z + v[j].w * v[j].w); }
                    const float rstd = 1.0f / sqrtf(wave_sum(s) * (1.f / 1024.f) + EPS);
#pragma unroll
                    for (int j = 0; j < 4; ++j) { const f32x4 gg = *(const GAS f32x4*)(g_q_a + 4 * (64 * j + LANE));
                        *(GAS unsigned long long*)(QLAT + (size_t)m * QLORA + 4 * (64 * j + LANE)) =
                            (unsigned long long)pkbf(v[j].x * rstd * gg.x, v[j].y * rstd * gg.y) | ((unsigned long long)pkbf(v[j].z * rstd * gg.z, v[j].w * rstd * gg.w) << 32); }
                }
                {
                    f32x4 v[2]; float s = 0.f;
#pragma unroll
                    for (int j = 0; j < 2; ++j) { v[j] = *(const GAS f32x4*)(lr + 1024 + 4 * (64 * j + LANE)); s += (v[j].x * v[j].x + v[j].y * v[j].y) + (v[j].z * v[j].z + v[j].w * v[j].w); }
                    const float rstd = 1.0f / sqrtf(wave_sum(s) * (1.f / 512.f) + EPS);
                    float* oc = (m < NP) ? OUT + O_CKV_P + ((size_t)l * NP + m) * KVLORA : OUT + O_CKV_S + ((size_t)l * NS + (m - NP)) * KVLORA;
#pragma unroll
                    for (int j = 0; j < 2; ++j) { const f32x4 gg = *(const GAS f32x4*)(g_kv_a + 4 * (64 * j + LANE));
                        const f32x4 c = {v[j].x * rstd * gg.x, v[j].y * rstd * gg.y, v[j].z * rstd * gg.z, v[j].w * rstd * gg.w};
                        *(GAS f32x4*)(oc + 4 * (64 * j + LANE)) = c;
                        *(GAS unsigned long long*)(AKV + (size_t)kvr * KVLORA + 4 * (64 * j + LANE)) = (unsigned long long)pkbf(c.x, c.y) | ((unsigned long long)pkbf(c.z, c.w) << 32); }
                }
                {
                    const float x = lr[1536 + LANE];
                    const float rstd = 1.0f / sqrtf(wave_sum(x * x) * (1.f / 64.f) + EPS);
                    const float xn = x * rstd * g_k_rope[LANE]; const float xp = __shfl_xor(xn, 32);
                    const f32x2 cs = TAB[pos * 32 + (LANE & 31)];
                    const float o = (LANE < 32) ? xn * cs.x - xp * cs.y : xp * cs.y + xn * cs.x;
                    float* okr = (m < NP) ? OUT + O_KR_P + ((size_t)l * NP + m) * ROPE : OUT + O_KR_S + ((size_t)l * NS + (m - NP)) * ROPE;
                    okr[LANE] = o;
                    const float on = __shfl_xor(o, 1);
                    if ((LANE & 1) == 0) *(GAS unsigned*)(KROPE + (size_t)kvr * ROPE + LANE) = pkbf(o, on);
                }
            }
        }
        GRID_BAR();
        for (int rep_ = 0; rep_ < (((PROBE_MASK >> 3) & 1) ? 2 : 1); ++rep_) if constexpr ((PHMASK >> 3) & 1) {
            PHASE_PTRS(); (void)OUT;
            pg8::Gemm g{QLAT, WQB_T, MTOK, 3072, QLORA, nullptr}; pg8::StaticOrder S; S.init(MTOK, 3072, G_, bx_);
            pg8::EpiQb E{QB, args.in[12] + (size_t)l * NOPE, args.in[13] + (size_t)l * ROPE, TAB, (LAS float*)(F.lds + XCH_OFF), QS_MLA, EPS};
            pg8::gemm_phase<pg8::EpiQb, pg8::StaticOrder, true, true>(F.lds + RING_OFF, g, S, E);
        }
        for (int rep_ = 0; rep_ < (((PROBE_MASK >> 11) & 1) ? 2 : 1); ++rep_) if constexpr ((PHMASK >> 11) & 1) {
            PHASE_PTRS(); (void)OUT;
            pg8::Gemm g{AKV, WKVB_T, KVROWS, 4096, KVLORA, nullptr}; pg8::StaticOrder S; S.init(KVROWS, 4096, G_, (bx_ + G_ - 24) % G_);
            pg8::EpiKvbN E{KN, VB, args.in[14] + (size_t)l * NOPE, (LAS float*)(F.lds + XCH_OFF), EPS};
            pg8::gemm_phase<pg8::EpiKvbN, pg8::StaticOrder, true, true>(F.lds + RING_OFF, g, S, E);
        }
        GRID_BAR();
        for (int rep_ = 0; rep_ < (((PROBE_MASK >> 5) & 1) ? 2 : 1); ++rep_) if constexpr ((PHMASK >> 5) & 1) {
            PHASE_PTRS(); (void)OUT;
            const int v = VCU, bh = v >> 2, b = bh >> 4, h = bh & 15, s = v & 3;
            ALAS char* al = (ALAS char*)(F.lds + RING_OFF);
#pragma unroll 1
            for (int k = 0; k < 5; ++k) {
                att::Unit u;
                if (k < 4) { const int qb = (k == 0) ? s : (k == 1) ? 7 - s : (k == 2) ? 8 + s : 15 - s; const size_t m0 = (size_t)b * SEQ + (size_t)qb * 256, kv0 = (size_t)b * SEQ;
                    u.Q = QB + m0 * 3072 + h * 192; u.ldq = 3072; u.K = KN + kv0 * 2048 + h * 128; u.Kr = KROPE + kv0 * ROPE; u.V = VB + kv0 * 2048 + h * 128;
                    u.O = MERGED + m0 * 4096 + h * 128; u.ldo = 4096; u.ssq = SSQP + m0 * 32 + h; u.Kf0 = u.Vf0 = u.Kf1 = u.Vf1 = nullptr; u.split = 0; u.P0 = qb * 256; u.NT = 4 * qb + 4; u.nact = 8; }
                else { if (v >= 128) break; const int sb = v >> 4, sh = v & 15; const size_t m0 = (size_t)NP + (size_t)sb * 64, kv0 = (size_t)NP + (size_t)sb * SKVS;
                    u.Q = QB + m0 * 3072 + sh * 192; u.ldq = 3072; u.K = KN + kv0 * 2048 + sh * 128; u.Kr = KROPE + kv0 * ROPE; u.V = VB + kv0 * 2048 + sh * 128;
                    u.O = MERGED + m0 * 4096 + sh * 128; u.ldo = 4096; u.ssq = SSQP + m0 * 32 + sh; u.Kf0 = u.Vf0 = u.Kf1 = u.Vf1 = nullptr; u.split = 0; u.P0 = PAST; u.NT = 17; u.nact = 2; }
                if constexpr ((PHMASK >> 12) & 1) att::mla_unit_dma<0>(u, al);
            }
#pragma unroll 1
            for (int k = 0; k < 5; ++k) {
                att::Unit u;
                if (k < 4) { const int qb = (k == 0) ? s : (k == 1) ? 7 - s : (k == 2) ? 8 + s : 15 - s; const size_t m0 = (size_t)b * SEQ + (size_t)qb * 256, kv0 = (size_t)b * SEQ;
                    u.Q = SBQ + m0 * 2048 + h * 128; u.ldq = 2048; u.K = nullptr; u.Kr = nullptr; u.V = nullptr; u.split = 1 << 30;
                    u.Kf0 = OUT + O_SBK_P + ((size_t)l * NP + kv0) * 2048 + h * 128; u.Vf0 = OUT + O_SBV_P + ((size_t)l * NP + kv0) * 2048 + h * 128; u.Kf1 = u.Kf0; u.Vf1 = u.Vf0;
                    u.O = MERGED + m0 * 4096 + 2048 + h * 128; u.ldo = 4096; u.ssq = SSQP + m0 * 32 + 16 + h; u.P0 = qb * 256; u.NT = 4 * qb + 4; u.nact = 8; }
                else { if (v < 128) break; const int w = v - 128, sb = w >> 4, sh = w & 15; const size_t m0 = (size_t)NP + (size_t)sb * 64, kv0 = (size_t)NP + (size_t)sb * SKVS;
                    u.Q = SBQ + m0 * 2048 + sh * 128; u.ldq = 2048; u.K = nullptr; u.Kr = nullptr; u.V = nullptr; u.split = PAST / 64;
                    u.Kf0 = args.in[4] + ((size_t)(l * 8 + sb) * PAST) * 2048 + sh * 128; u.Vf0 = args.in[5] + ((size_t)(l * 8 + sb) * PAST) * 2048 + sh * 128;
                    u.Kf1 = OUT + O_SBK_S + ((size_t)l * NS + (size_t)sb * 64) * 2048 + sh * 128; u.Vf1 = OUT + O_SBV_S + ((size_t)l * NS + (size_t)sb * 64) * 2048 + sh * 128;
                    u.O = MERGED + m0 * 4096 + 2048 + sh * 128; u.ldo = 4096; u.ssq = SSQP + m0 * 32 + 16 + sh; u.P0 = PAST; u.NT = 17; u.nact = 2; }
                if constexpr ((PHMASK >> 13) & 1) att::attn_unit<false>(u, al);
            }
        }
        GRID_BAR();
#if !ATT_SSQ_ATOMICS
        {
            PHASE_PTRS(); (void)OUT;
            for (int i = gthread; i < MTOK * 2; i += nthreads) { const int m = i >> 1, half = i & 1; const GAS f32x4* p = (const GAS f32x4*)(SSQP + (size_t)m * 32 + half * 16);
                const f32x4 a = p[0], b = p[1], c = p[2], d = p[3];
                const float s = (((a.x + a.y) + (a.z + a.w)) + ((b.x + b.y) + (b.z + b.w))) + (((c.x + c.y) + (c.z + c.w)) + ((d.x + d.y) + (d.z + d.w)));
                (half ? SSQS : SSQM)[m] = s; }
        }
        GRID_BAR();
#endif
        for (int rep_ = 0; rep_ < (((PROBE_MASK >> 7) & 1) ? 2 : 1); ++rep_) if constexpr ((PHMASK >> 7) & 1) {
            PHASE_PTRS(); (void)OUT;
            pg8::Gemm g{MERGED, WO_T, MTOK, DM, DM, SLAB}; pg8::PanelOrder S; S.init3(MTOK, DM, DM, G_, bx_, SLAB, 2);
            pg8::EpiResP<true> E{args.in[0], args.in[1], nullptr, XN, SSQH, SSQM, SSQS, EPS, l == 0 ? nullptr : Y0B};
            pg8::gemm_phase<pg8::EpiResP<true>, pg8::PanelOrder, true, true>(F.lds + RING_OFF, g, S, E);
        }
        GRID_BAR();
        {
            PHASE_PTRS(); pg8::PanelOrder S; S.init3(MTOK, DM, DM, G_, bx_, SLAB, 2);
            tail_reduce_res<true>(S, args.in[0], args.in[1], nullptr, XN, SSQH, SSQM, SSQS, l == 0 ? nullptr : Y0B, ptid_);
        }
        GRID_BAR();
        for (int rep_ = 0; rep_ < (((PROBE_MASK >> 9) & 1) ? 2 : 1); ++rep_) if constexpr ((PHMASK >> 9) & 1) {
            PHASE_PTRS(); (void)OUT;
            pg8::Gemm g{XN, WUP_T, MTOK, DFF, DM, nullptr}; pg8::UpOrder S; S.init3(MTOK, DFF, G_, bx_);
            pg8::EpiRelu2N E{UB, DFF, SSQH, EPS};
            pg8::gemm_phase<pg8::EpiRelu2N, pg8::UpOrder, true, true>(F.lds + RING_OFF, g, S, E);
            if (l + 1 < 2 && G_ == 256 && bx_ >= 128) {
                LAS float* scr = (LAS float*)(F.lds + RING_OFF + WAVE * 16384);
                CONVERT_ITEMS(l + 1, 0, EARLY_ITEMS, (bx_ - 128) * NWAVES + WAVE, 128 * NWAVES);
            }
        }
        GRID_BAR();
        for (int rep_ = 0; rep_ < (((PROBE_MASK >> 10) & 1) ? 2 : 1); ++rep_) if constexpr ((PHMASK >> 10) & 1) {
            PHASE_PTRS(); (void)OUT;
            pg8::Gemm g{UB, l == 0 ? WDN_T0 : WDN_T1, MTOK, DM, DFF, SLAB, 1};     pg8::PanelOrder S; S.init3(MTOK, DM, DFF, G_, bx_, SLAB);
            pg8::EpiResP<false> E{nullptr, nullptr, OUT + O_Y, XN, SSQY, nullptr, nullptr, EPS, l == 1 ? nullptr : Y0B};
            const bool bg = (l + 1 < 2 && G_ == 256);
            const int rsplit = bg ? ((bx_ & 7) >> 1) : 0;
#pragma unroll 1
            for (int seg = 0; seg < 2; ++seg) {
                pg8::SubRange<pg8::PanelOrder> SS{S, seg ? rsplit : 0, seg ? (1 << 30) : rsplit};
                pg8::gemm_phase<pg8::EpiResP<false>, pg8::SubRange<pg8::PanelOrder>, true, true>(F.lds + RING_OFF, g, SS, E);
                if (seg == 0 && bg) {
                    LAS float* scr = (LAS float*)(F.lds + RING_OFF + WAVE * 16384);
                    CONVERT_ITEMS(l + 1, EARLY_ITEMS, NITEMS, gw, NGW);
                    __syncthreads();
                }
            }
        }
        GRID_BAR();
        {
            PHASE_PTRS(); pg8::PanelOrder S; S.init3(MTOK, DM, DFF, G_, bx_, SLAB);
            tail_reduce_res<false>(S, nullptr, nullptr, OUT + O_Y, XN, SSQY, nullptr, nullptr, l == 1 ? nullptr : Y0B, ptid_);
            if (l + 1 < 2) {
                cache_rows_to_bf16(args.in[2] + (size_t)(l + 1) * 8 * PAST * KVLORA, AKV, KVLORA, gthread, nthreads);
                cache_rows_to_bf16(args.in[3] + (size_t)(l + 1) * 8 * PAST * ROPE, KROPE, ROPE, gthread, nthreads);
            }
        }
        GRID_BAR();
    }
#undef GRID_BAR
}

extern "C" void kernel_launch(void* const* d_in, const int* in_sizes, int n_in, void* d_out, int out_size, void* d_ws, size_t ws_size, hipStream_t stream) {
    static int grid = 0;
    if (grid == 0) {
        if (n_in != 22 || (size_t)out_size != O_END || ws_size < WS_END) { fprintf(stderr, "kernel_launch: unexpected shapes: n_in %d out %d ws %zu (need %zu)\n", n_in, out_size, ws_size, (size_t)WS_END); grid = -1; return; }
        int dev = 0, cus = 0, per_cu = 0;
        if (hipGetDevice(&dev) != hipSuccess || hipDeviceGetAttribute(&cus, hipDeviceAttributeMultiprocessorCount, dev) != hipSuccess) { grid = -1; return; }
        if (hipFuncSetAttribute((const void*)hymba_fwd, hipFuncAttributeMaxDynamicSharedMemorySize, LDS_BYTES) != hipSuccess) { fprintf(stderr, "kernel_launch: hipFuncSetAttribute failed\n"); grid = -1; return; }
        if (hipOccupancyMaxActiveBlocksPerMultiprocessor(&per_cu, (const void*)hymba_fwd, NWAVES * 64, LDS_BYTES) != hipSuccess || per_cu < 1) { fprintf(stderr, "kernel_launch: occupancy query reports %d\n", per_cu); }
        (void)hipGetLastError();
        grid = cus;
        if (grid != 256) fprintf(stderr, "kernel_launch: %d CUs (the attention deal assumes 256 workgroups)\n", grid);
    }
    if (grid < 0) return;
    if (hipMemsetAsync((char*)d_ws + WS_CTL, 0, CTL_ZERO_BYTES, stream) != hipSuccess) return;
    Args a{};
    for (int i = 0; i < 22; ++i) a.in[i] = (const float*)d_in[i];
    a.out = (float*)d_out; a.ws = (unsigned char*)d_ws;
    hipLaunchKernelGGL(hymba_fwd, dim3(grid), dim3(NWAVES * 64), LDS_BYTES, stream, a);
}
```

```cpp
#include <hip/hip_runtime.h>
#include <cstdio>
#include <cstdint>
#include <type_traits>
namespace pg8 {
#define PG8_LAS __attribute__((address_space(3)))
typedef unsigned short bf16_t;
typedef short bf16x8 __attribute__((ext_vector_type(8)));
typedef float f32x4 __attribute__((ext_vector_type(4)));
typedef unsigned u32x4 __attribute__((ext_vector_type(4)));
constexpr int BM = 256, BK = 64, HALF = 128, HTB = HALF * BK * 2  , STAGE_BYTES = 8 * HTB, NXCD = 8, WGM = 8;

__host__ __device__ __forceinline__ int lds_byte(int r, int c) { const int st = (r >> 4) * 2 + (c >> 5), rr = r & 15, cc = c & 31, ob = rr * 64 + cc * 2; return st * 1024 + (ob ^ (((ob >> 9) & 1) << 5)); }
__host__ __device__ __forceinline__ void stage_rc(int b, int& R, int& C) { const int st = b / 1024, sb = b % 1024, swz = sb ^ (((sb >> 9) & 1) << 5); R = (st >> 1) * 16 + swz / 64; C = (st & 1) * 32 + (swz % 64) / 2; }
__host__ __device__ __forceinline__ int perm32(int rho) { const int n = rho >> 4, i = rho & 15; return 8 * (i >> 2) + 4 * n + (i & 3); }

struct Unit { int pm, pn, kt0, nkt, part; };
struct Gemm { const bf16_t* A; const bf16_t* Bt; int M, N, K; float* slab; int blocked = 0; };

struct StaticOrder {
    int nM, nN, nwg, G, c, wgm = WGM;
    __host__ __device__ __forceinline__ void init(int M, int N, int G_, int c_) { nM = M / BM; nN = N / BM; nwg = nM * nN; G = G_; c = c_; }
    __host__ __device__ __forceinline__ bool next(int i, Unit& u) const {
        const long L = (long)i * G + c; if (L >= nwg) return false;
        int wgid = (int)L; { const int q = nwg / NXCD, r = nwg % NXCD, xcd = wgid % NXCD, off = wgid / NXCD; wgid = (xcd < r ? xcd * (q + 1) : r * (q + 1) + (xcd - r) * q) + off; }
        const int nig = wgm * nN, gid = wgid / nig, fm = gid * wgm, gsz = (nM - fm) < wgm ? (nM - fm) : wgm;
        u.pm = fm + ((wgid % nig) % gsz); u.pn = (wgid % nig) / gsz; u.kt0 = 0; u.nkt = 0; u.part = -1; return true;
    }
    __host__ __device__ __forceinline__ void map(int L, Unit& u) const {
        int wgid = L; { const int q = nwg / NXCD, r = nwg % NXCD, xcd = wgid % NXCD, off = wgid / NXCD; wgid = (xcd < r ? xcd * (q + 1) : r * (q + 1) + (xcd - r) * q) + off; }
        const int nig = wgm * nN, gid = wgid / nig, fm = gid * wgm, gsz = (nM - fm) < wgm ? (nM - fm) : wgm;
        u.pm = fm + ((wgid % nig) % gsz); u.pn = (wgid % nig) / gsz; u.kt0 = 0; u.nkt = 0; u.part = -1;
    }
    __device__ __forceinline__ void a_ready(const Unit&) const {}
    __device__ __forceinline__ void done(const Unit&) const {}
};

struct InOrder : StaticOrder {
    bool panel;
    __host__ __device__ __forceinline__ void init3(int M, int N, int G_, int c_) { init(M, N, G_, c_); panel = (G_ == 256 && nM == 66 && nN == 31); }
    __host__ __device__ __forceinline__ bool next(int i, Unit& u) const {
        if (!panel) return StaticOrder::next(i, u);
        if (i >= 8) return false;
        const int x = c & 7, idx = c >> 3, g = x >> 2, q = x & 3, pmo = idx & 3, pn = 8 * q + (idx >> 2);
        if (pn < 31) { u.pm = 8 * i + 4 * g + pmo; u.pn = pn; }
        else { const int su = i * 8 + g * 4 + pmo; if (su >= 62) return false; const int hi31 = su >= 31 ? 1 : 0; u.pm = 64 + hi31; u.pn = su - 31 * hi31; }
        u.kt0 = 0; u.nkt = 0; u.part = -1; return true; }
};

struct UpOrder : StaticOrder {
    bool panel;
    __host__ __device__ __forceinline__ void init3(int M, int N, int G_, int c_) { init(M, N, G_, c_); panel = (G_ == 256 && nM == 66 && nN == 64); }
    __host__ __device__ __forceinline__ bool next(int i, Unit& u) const {
        if (!panel) return StaticOrder::next(i, u);
        const int x = c & 7, idx = c >> 3;
        if (i < 16) { u.pm = 4 * (15 - i) + (idx & 3); u.pn = 8 * x + (idx >> 2); }
        else if (i == 16 && c < 128) { u.pm = 64 + (idx & 1); u.pn = 8 * x + (idx >> 1); }
        else return false;
        u.kt0 = 0; u.nkt = 0; u.part = -1; return true; }
};

template <class S_> struct SubRange {
    const S_& s; int lo, hi;
    __device__ __forceinline__ bool next(int i, Unit& u) const { return (lo + i < hi) && s.next(lo + i, u); }
    __device__ __forceinline__ void a_ready(const Unit& u) const { s.a_ready(u); }
    __device__ __forceinline__ void done(const Unit& u) const { s.done(u); }
};

__device__ __forceinline__ unsigned cvt_pk_bf16(float lo, float hi) { unsigned r; asm volatile("v_cvt_pk_bf16_f32 %0, %1, %2" : "=v"(r) : "v"(lo), "v"(hi)); return r; }

struct TailSplitOrder : StaticOrder {
    int nfull, nsplit, nkt_full, halves; float* slab;
    __host__ __device__ __forceinline__ void init2(int M, int N, int K, int G_, int c_, float* slab_, int halves_ = 1) { init(M, N, G_, c_); nkt_full = K / BK; slab = slab_; halves = halves_; nfull = nwg / G; const int rem = nwg - nfull * G;
        nsplit = (rem > 0 && G % rem == 0 && (nkt_full % (2 * (G / rem))) == 0 && nkt_full / (G / rem) >= 4) ? G / rem : 1; }
    __host__ __device__ __forceinline__ bool next(int i, Unit& u) const {
        const int ii = i / halves, hh = i % halves;
        if (ii < nfull || nsplit == 1) { if (!StaticOrder::next(ii, u)) return false; if (halves == 2) { u.nkt = nkt_full / 2; u.kt0 = hh * u.nkt; u.part = hh == 0 ? -2 : -1; } return true; }
        if (ii > nfull || hh != 0) return false;
        const int j = c / nsplit, s = c % nsplit; map(nfull * G + j, u); u.nkt = nkt_full / nsplit; u.kt0 = s * u.nkt; u.part = j * nsplit + s; return true;
    }
};

struct PanelOrder : TailSplitOrder {
    bool panel;
    __host__ __device__ __forceinline__ void init3(int M, int N, int K, int G_, int c_, float* slab_, int halves_ = 1) { init2(M, N, K, G_, c_, slab_, halves_); panel = (G_ == 256 && nM == 66 && nN == 16 && nsplit == 8); }
    __host__ __device__ __forceinline__ void mapu(int L, Unit& u) const {
        if (L < 1024) { const int r = L >> 8, x = L & 7, idx = (L & 255) >> 3; u.pm = 16 * r + 4 * (x >> 1) + (idx & 3); u.pn = 8 * (x & 1) + (idx >> 2); }
        else { const int j = L - 1024; u.pm = 64 + (j & 1); u.pn = j >> 1; }
        u.kt0 = 0; u.nkt = 0; u.part = -1; }
    __host__ __device__ __forceinline__ bool next(int i, Unit& u) const {
        if (!panel) return TailSplitOrder::next(i, u);
        const int ii = i / halves, hh = i % halves;
        if (ii < nfull) { mapu(ii * G + c, u); if (halves == 2) { u.nkt = nkt_full / 2; u.kt0 = hh * u.nkt; u.part = hh == 0 ? -2 : -1; } return true; }
        if (ii > nfull || hh != 0) return false;
        const int j = c / nsplit, s = c % nsplit; mapu(nfull * G + j, u); u.nkt = nkt_full / nsplit; u.kt0 = s * u.nkt; u.part = j * nsplit + s; return true; }
    __host__ __device__ __forceinline__ void map(int L, Unit& u) const { if (panel) mapu(L, u); else TailSplitOrder::map(L, u); }
};

typedef unsigned u32x2 __attribute__((ext_vector_type(2)));
constexpr int HY_NP = 16384;
__device__ __forceinline__ int hy_kvrow(int m) { return m < HY_NP ? m : HY_NP + ((m - HY_NP) >> 6) * 1088 + 1024 + ((m - HY_NP) & 63); }

struct EpiIn {
    static constexpr bool PERM = true, AFTER_DRAIN = false;
    float* LAT; bf16_t* SBQ; bf16_t* SBK; bf16_t* SBV; float* outK_p; float* outV_p; float* outK_s; float* outV_s; float qscale;
    const float* ssq; float eps;
    __device__ __forceinline__ void operator()(const f32x4 (&acc)[2][2][4][2], const Unit& u, int wr, int wc, int fr, int fq) const {
        const int row0 = u.pm * BM + wr * 64 + fr, colw = wc * 32 + 8 * fq, pn = u.pn;
        float rs[2][4];
#pragma unroll
        for (int ai = 0; ai < 2; ++ai)
#pragma unroll
            for (int m = 0; m < 4; ++m) rs[ai][m] = ssq ? 1.0f / sqrtf(__hip_atomic_load(ssq + row0 + ai * HALF + m * 16, __ATOMIC_RELAXED, __HIP_MEMORY_SCOPE_AGENT) * (1.f / 4096.f) + eps) : 1.0f;
        if (pn < 7) {
#pragma unroll
            for (int ai = 0; ai < 2; ++ai)
#pragma unroll
                for (int m = 0; m < 4; ++m) { float* rp = LAT + (size_t)(row0 + ai * HALF + m * 16) * 1792 + pn * BM + colw;
#pragma unroll
                    for (int bj = 0; bj < 2; ++bj) { *(f32x4*)(rp + bj * HALF) = acc[ai][bj][m][0] * rs[ai][m]; *(f32x4*)(rp + bj * HALF + 4) = acc[ai][bj][m][1] * rs[ai][m]; } }
        } else if (pn < 15) {
#pragma unroll
            for (int ai = 0; ai < 2; ++ai)
#pragma unroll
                for (int m = 0; m < 4; ++m) { bf16_t* rp = SBQ + (size_t)(row0 + ai * HALF + m * 16) * 2048 + (pn - 7) * BM + colw;
#pragma unroll
                    for (int bj = 0; bj < 2; ++bj) { const float sc = qscale * rs[ai][m]; const f32x4 v0 = acc[ai][bj][m][0] * sc, v1 = acc[ai][bj][m][1] * sc;
                        u32x4 w; w.x = cvt_pk_bf16(v0[0], v0[1]); w.y = cvt_pk_bf16(v0[2], v0[3]); w.z = cvt_pk_bf16(v1[0], v1[1]); w.w = cvt_pk_bf16(v1[2], v1[3]);
                        *(u32x4*)(rp + bj * HALF) = w; } }
        } else {
            const bool isv = pn >= 23; const int c0 = (pn - (isv ? 23 : 15)) * BM + colw;
            float* fop = isv ? outV_p : outK_p; float* fos = isv ? outV_s : outK_s;
#pragma unroll
            for (int ai = 0; ai < 2; ++ai)
#pragma unroll
                for (int m = 0; m < 4; ++m) { const int row = row0 + ai * HALF + m * 16;
                    float* fo = (row < HY_NP) ? fop + (size_t)row * 2048 : fos + (size_t)(row - HY_NP) * 2048;
                    fo += c0;
#pragma unroll
                    for (int bj = 0; bj < 2; ++bj) { __builtin_nontemporal_store(acc[ai][bj][m][0] * rs[ai][m], (f32x4*)(fo + bj * HALF)); __builtin_nontemporal_store(acc[ai][bj][m][1] * rs[ai][m], (f32x4*)(fo + bj * HALF + 4)); } }
        }
    }
};
struct EpiF32 {
    static constexpr bool PERM = false, AFTER_DRAIN = false;
    float* C; int ldc;
    __device__ __forceinline__ void operator()(const f32x4 (&acc)[2][2][4][2], const Unit& u, int wr, int wc, int fr, int fq) const {
        const int row0 = u.pm * BM + wr * 64 + fr, col0 = u.pn * BM + wc * 32 + 4 * fq;
#pragma unroll
        for (int ai = 0; ai < 2; ++ai)
#pragma unroll
            for (int m = 0; m < 4; ++m) { float* rowp = C + (size_t)(row0 + ai * HALF + m * 16) * ldc + col0;
#pragma unroll
                for (int bj = 0; bj < 2; ++bj)
#pragma unroll
                    for (int n = 0; n < 2; ++n) *(f32x4*)(rowp + bj * HALF + n * 16) = acc[ai][bj][m][n]; }
    }
};
struct EpiKvb {
    static constexpr bool PERM = true, AFTER_DRAIN = false;
    float* KNRAW; bf16_t* VB;
    __device__ __forceinline__ void operator()(const f32x4 (&acc)[2][2][4][2], const Unit& u, int wr, int wc, int fr, int fq) const {
        const int row0 = u.pm * BM + wr * 64 + fr, colw = wc * 32 + 8 * fq, pn = u.pn;
        if (pn < 8) {
#pragma unroll
            for (int ai = 0; ai < 2; ++ai)
#pragma unroll
                for (int m = 0; m < 4; ++m) { float* rp = KNRAW + (size_t)(row0 + ai * HALF + m * 16) * 2048 + pn * BM + colw;
#pragma unroll
                    for (int bj = 0; bj < 2; ++bj) { *(f32x4*)(rp + bj * HALF) = acc[ai][bj][m][0]; *(f32x4*)(rp + bj * HALF + 4) = acc[ai][bj][m][1]; } }
        } else {
#pragma unroll
            for (int ai = 0; ai < 2; ++ai)
#pragma unroll
                for (int m = 0; m < 4; ++m) { bf16_t* rp = VB + (size_t)(row0 + ai * HALF + m * 16) * 2048 + (pn - 8) * BM + colw;
#pragma unroll
                    for (int bj = 0; bj < 2; ++bj) { const f32x4 v0 = acc[ai][bj][m][0], v1 = acc[ai][bj][m][1];
                        u32x4 w; w.x = cvt_pk_bf16(v0[0], v0[1]); w.y = cvt_pk_bf16(v0[2], v0[3]); w.z = cvt_pk_bf16(v1[0], v1[1]); w.w = cvt_pk_bf16(v1[2], v1[3]);
                        *(u32x4*)(rp + bj * HALF) = w; } }
        }
    }
};
struct EpiRes {
    static constexpr bool PERM = false, AFTER_DRAIN = false;
    const float* resP; const float* resS; float* out;
    __device__ __forceinline__ void operator()(const f32x4 (&acc)[2][2][4][2], const Unit& u, int wr, int wc, int fr, int fq) const {
        const int row0 = u.pm * BM + wr * 64 + fr, col0 = u.pn * BM + wc * 32 + 4 * fq;
        const bool samp = u.pm >= HY_NP / BM;
#pragma unroll
        for (int ai = 0; ai < 2; ++ai)
#pragma unroll
            for (int m = 0; m < 4; ++m) { const int row = row0 + ai * HALF + m * 16;
                const float* rp = samp ? resS + (size_t)(row - HY_NP) * 4096 + col0 : resP + (size_t)row * 4096 + col0;
                float* op = out + (size_t)row * 4096 + col0;
#pragma unroll
                for (int bj = 0; bj < 2; ++bj)
#pragma unroll
                    for (int n = 0; n < 2; ++n) { const f32x4 r = *(const f32x4*)(rp + bj * HALF + n * 16); *(f32x4*)(op + bj * HALF + n * 16) = r + acc[ai][bj][m][n]; } }
    }
};
struct EpiRelu2 {
    static constexpr bool PERM = true, AFTER_DRAIN = false;
    bf16_t* O; int ldc;
    __device__ __forceinline__ void operator()(const f32x4 (&acc)[2][2][4][2], const Unit& u, int wr, int wc, int fr, int fq) const {
        const int row0 = u.pm * BM + wr * 64 + fr, col0 = u.pn * BM + wc * 32 + 8 * fq;
#pragma unroll
        for (int ai = 0; ai < 2; ++ai)
#pragma unroll
            for (int m = 0; m < 4; ++m) { bf16_t* rowp = O + (size_t)(row0 + ai * HALF + m * 16) * ldc + col0;
#pragma unroll
                for (int bj = 0; bj < 2; ++bj) { f32x4 v0 = acc[ai][bj][m][0], v1 = acc[ai][bj][m][1];
#pragma unroll
                    for (int e = 0; e < 4; ++e) { const float a = fmaxf(v0[e], 0.f), b = fmaxf(v1[e], 0.f); v0[e] = a * a; v1[e] = b * b; }
                    u32x4 w; w.x = cvt_pk_bf16(v0[0], v0[1]); w.y = cvt_pk_bf16(v0[2], v0[3]); w.z = cvt_pk_bf16(v1[0], v1[1]); w.w = cvt_pk_bf16(v1[2], v1[3]);
                    *(u32x4*)(rowp + bj * HALF) = w; } }
    }
};

typedef float f32x2e __attribute__((ext_vector_type(2)));
__device__ __forceinline__ void head_ssq_exchange(const f32x4 (&acc)[2][2][4][2], PG8_LAS float* P, int wr, int wc, int fr, int fq, float (&rstd)[2][4][2], float inv_n, float eps) {
#pragma unroll
    for (int ai = 0; ai < 2; ++ai)
#pragma unroll
        for (int m = 0; m < 4; ++m)
#pragma unroll
            for (int bj = 0; bj < 2; ++bj) {
                const f32x4 a = acc[ai][bj][m][0], b = acc[ai][bj][m][1];
                float s = ((a[0] * a[0] + a[1] * a[1]) + (a[2] * a[2] + a[3] * a[3])) + ((b[0] * b[0] + b[1] * b[1]) + (b[2] * b[2] + b[3] * b[3]));
                s += __shfl_xor(s, 16); s += __shfl_xor(s, 32);
                if (fq == 0) P[(ai * HALF + wr * 64 + m * 16 + fr) * 8 + bj * 4 + wc] = s;
            }
    asm volatile("s_waitcnt lgkmcnt(0)" ::: "memory"); __builtin_amdgcn_s_barrier(); asm volatile("" ::: "memory");
#pragma unroll
    for (int ai = 0; ai < 2; ++ai)
#pragma unroll
        for (int m = 0; m < 4; ++m)
#pragma unroll
            for (int bj = 0; bj < 2; ++bj) {
                const f32x4 p = *(const PG8_LAS f32x4*)(P + (ai * HALF + wr * 64 + m * 16 + fr) * 8 + bj * 4);
                rstd[ai][m][bj] = 1.0f / sqrtf(((p[0] + p[1]) + (p[2] + p[3])) * inv_n + eps);
            }
}
struct EpiQb {
    static constexpr bool PERM = true, AFTER_DRAIN = false;
    bf16_t* QB; const float* g_nope; const float* g_rope; const f32x2e* tab; PG8_LAS float* P; float qs, eps;
    __device__ __forceinline__ void operator()(const f32x4 (&acc)[2][2][4][2], const Unit& u, int wr, int wc, int fr, int fq) const {
        const int row0 = u.pm * BM + wr * 64 + fr, pn = u.pn;
        if (pn < 8) {
            float rstd[2][4][2]; head_ssq_exchange(acc, P, wr, wc, fr, fq, rstd, 1.f / 128.f, eps);
            const f32x4 g0 = *(const f32x4*)(g_nope + wc * 32 + 8 * fq) * qs, g1 = *(const f32x4*)(g_nope + wc * 32 + 8 * fq + 4) * qs;
#pragma unroll
            for (int ai = 0; ai < 2; ++ai)
#pragma unroll
                for (int m = 0; m < 4; ++m) { bf16_t* rp = QB + (size_t)(row0 + ai * HALF + m * 16) * 3072 + (2 * pn) * 192 + wc * 32 + 8 * fq;
#pragma unroll
                    for (int bj = 0; bj < 2; ++bj) { const float r = rstd[ai][m][bj]; const f32x4 v0 = acc[ai][bj][m][0] * g0 * r, v1 = acc[ai][bj][m][1] * g1 * r;
                        u32x4 w; w.x = cvt_pk_bf16(v0[0], v0[1]); w.y = cvt_pk_bf16(v0[2], v0[3]); w.z = cvt_pk_bf16(v1[0], v1[1]); w.w = cvt_pk_bf16(v1[2], v1[3]);
                        *(u32x4*)(rp + bj * 192) = w; } }
        } else {
            const int h = 4 * (pn - 8) + wc;
            const f32x4 ga0 = *(const f32x4*)(g_rope + 8 * fq), ga1 = *(const f32x4*)(g_rope + 8 * fq + 4), gb0 = *(const f32x4*)(g_rope + 32 + 8 * fq), gb1 = *(const f32x4*)(g_rope + 32 + 8 * fq + 4);
#pragma unroll
            for (int ai = 0; ai < 2; ++ai)
#pragma unroll
                for (int m = 0; m < 4; ++m) { const int row = row0 + ai * HALF + m * 16;
                    const f32x4 a0 = acc[ai][0][m][0], a1 = acc[ai][0][m][1], b0 = acc[ai][1][m][0], b1 = acc[ai][1][m][1];
                    float s = (((a0[0] * a0[0] + a0[1] * a0[1]) + (a0[2] * a0[2] + a0[3] * a0[3])) + ((a1[0] * a1[0] + a1[1] * a1[1]) + (a1[2] * a1[2] + a1[3] * a1[3])))
                            + (((b0[0] * b0[0] + b0[1] * b0[1]) + (b0[2] * b0[2] + b0[3] * b0[3])) + ((b1[0] * b1[0] + b1[1] * b1[1]) + (b1[2] * b1[2] + b1[3] * b1[3])));
                    s += __shfl_xor(s, 16); s += __shfl_xor(s, 32);
                    const float r = 1.0f / sqrtf(s * (1.f / 64.f) + eps);
                    const int pos = row < HY_NP ? (row & 4095) : 1024 + ((row - HY_NP) & 63);
                    const f32x4* tp = (const f32x4*)(tab + pos * 32 + 8 * fq);
                    const f32x4 t0 = tp[0], t1 = tp[1], t2 = tp[2], t3 = tp[3];
                    const f32x4 x10 = a0 * ga0 * r, x11 = a1 * ga1 * r, x20 = b0 * gb0 * r, x21 = b1 * gb1 * r;
                    const f32x4 c0 = {t0[0], t0[2], t1[0], t1[2]}, s0 = {t0[1], t0[3], t1[1], t1[3]}, c1 = {t2[0], t2[2], t3[0], t3[2]}, s1 = {t2[1], t2[3], t3[1], t3[3]};
                    const f32x4 o10 = (x10 * c0 - x20 * s0) * qs, o11 = (x11 * c1 - x21 * s1) * qs, o20 = (x10 * s0 + x20 * c0) * qs, o21 = (x11 * s1 + x21 * c1) * qs;
                    bf16_t* rp = QB + (size_t)row * 3072 + h * 192 + 128 + 8 * fq;
                    u32x4 w; w.x = cvt_pk_bf16(o10[0], o10[1]); w.y = cvt_pk_bf16(o10[2], o10[3]); w.z = cvt_pk_bf16(o11[0], o11[1]); w.w = cvt_pk_bf16(o11[2], o11[3]);
                    *(u32x4*)rp = w;
                    w.x = cvt_pk_bf16(o20[0], o20[1]); w.y = cvt_pk_bf16(o20[2], o20[3]); w.z = cvt_pk_bf16(o21[0], o21[1]); w.w = cvt_pk_bf16(o21[2], o21[3]);
                    *(u32x4*)(rp + 32) = w; }
        }
    }
};
struct EpiKvbN {
    static constexpr bool PERM = true, AFTER_DRAIN = false;
    bf16_t* KN; bf16_t* VB; const float* g_nope; PG8_LAS float* P; float eps;
    __device__ __forceinline__ void operator()(const f32x4 (&acc)[2][2][4][2], const Unit& u, int wr, int wc, int fr, int fq) const {
        const int row0 = u.pm * BM + wr * 64 + fr, colw = wc * 32 + 8 * fq, pn = u.pn;
        if (pn < 8) {
            float rstd[2][4][2]; head_ssq_exchange(acc, P, wr, wc, fr, fq, rstd, 1.f / 128.f, eps);
            const f32x4 g0 = *(const f32x4*)(g_nope + colw), g1 = *(const f32x4*)(g_nope + colw + 4);
#pragma unroll
            for (int ai = 0; ai < 2; ++ai)
#pragma unroll
                for (int m = 0; m < 4; ++m) { bf16_t* rp = KN + (size_t)(row0 + ai * HALF + m * 16) * 2048 + pn * BM + colw;
#pragma unroll
                    for (int bj = 0; bj < 2; ++bj) { const float r = rstd[ai][m][bj]; const f32x4 v0 = acc[ai][bj][m][0] * g0 * r, v1 = acc[ai][bj][m][1] * g1 * r;
                        u32x4 w; w.x = cvt_pk_bf16(v0[0], v0[1]); w.y = cvt_pk_bf16(v0[2], v0[3]); w.z = cvt_pk_bf16(v1[0], v1[1]); w.w = cvt_pk_bf16(v1[2], v1[3]);
                        *(u32x4*)(rp + bj * HALF) = w; } }
        } else {
#pragma unroll
            for (int ai = 0; ai < 2; ++ai)
#pragma unroll
                for (int m = 0; m < 4; ++m) { bf16_t* rp = VB + (size_t)(row0 + ai * HALF + m * 16) * 2048 + (pn - 8) * BM + colw;
#pragma unroll
                    for (int bj = 0; bj < 2; ++bj) { const f32x4 v0 = acc[ai][bj][m][0], v1 = acc[ai][bj][m][1];
                        u32x4 w; w.x = cvt_pk_bf16(v0[0], v0[1]); w.y = cvt_pk_bf16(v0[2], v0[3]); w.z = cvt_pk_bf16(v1[0], v1[1]); w.w = cvt_pk_bf16(v1[2], v1[3]);
                        *(u32x4*)(rp + bj * HALF) = w; } }
        }
    }
};

template <bool NORM> struct EpiResP {
    static constexpr bool PERM = true, AFTER_DRAIN = false, MIDK = NORM;
    const float* resP; const float* resS; float* out; bf16_t* HB; float* ssq; const float* ssqm; const float* ssqs; float eps;
    bf16_t* YB;
    __device__ __forceinline__ void mid(f32x4 (&acc)[2][2][4][2], const Unit& u, int wr, int wc, int fr, int fq) const {
        const int row0 = u.pm * BM + wr * 64 + fr;
#pragma unroll
        for (int ai = 0; ai < 2; ++ai)
#pragma unroll
            for (int m = 0; m < 4; ++m) { const int row = row0 + ai * HALF + m * 16;
                const float a = __hip_atomic_load(ssqm + row, __ATOMIC_RELAXED, __HIP_MEMORY_SCOPE_AGENT), b = __hip_atomic_load(ssqs + row, __ATOMIC_RELAXED, __HIP_MEMORY_SCOPE_AGENT);
                const float ratio = sqrtf((b * (1.f / 2048.f) + eps) / (a * (1.f / 2048.f) + eps));
#pragma unroll
                for (int bj = 0; bj < 2; ++bj) { acc[ai][bj][m][0] *= ratio; acc[ai][bj][m][1] *= ratio; } }
    }
    __device__ __forceinline__ void operator()(const f32x4 (&acc)[2][2][4][2], const Unit& u, int wr, int wc, int fr, int fq) const {
        const int row0 = u.pm * BM + wr * 64 + fr, col0 = u.pn * BM + wc * 32 + 8 * fq;
        const bool samp = u.pm >= HY_NP / BM;
#pragma unroll
        for (int ai = 0; ai < 2; ++ai)
#pragma unroll
            for (int m = 0; m < 4; ++m) { const int row = row0 + ai * HALF + m * 16;
                if (NORM) {
                    const float* rp = samp ? resS + (size_t)(row - HY_NP) * 4096 + col0 : resP + (size_t)row * 4096 + col0; float s = 0.f;
                    const bf16_t* yp = YB + (size_t)row * 4096 + col0;
                    const float rs = 1.0f / sqrtf(__hip_atomic_load(ssqs + row, __ATOMIC_RELAXED, __HIP_MEMORY_SCOPE_AGENT) * (1.f / 2048.f) + eps);
#pragma unroll
                    for (int bj = 0; bj < 2; ++bj) { f32x4 r0, r1;
                        if (YB) { const u32x4 h = *(const u32x4*)(yp + bj * HALF);
                            r0 = (f32x4){__uint_as_float(h.x << 16), __uint_as_float(h.x & 0xffff0000u), __uint_as_float(h.y << 16), __uint_as_float(h.y & 0xffff0000u)};
                            r1 = (f32x4){__uint_as_float(h.z << 16), __uint_as_float(h.z & 0xffff0000u), __uint_as_float(h.w << 16), __uint_as_float(h.w & 0xffff0000u)}; }
                        else { r0 = *(const f32x4*)(rp + bj * HALF); r1 = *(const f32x4*)(rp + bj * HALF + 4); }
                        const f32x4 v0 = r0 + acc[ai][bj][m][0] * rs, v1 = r1 + acc[ai][bj][m][1] * rs;
                        s += ((v0[0] * v0[0] + v0[1] * v0[1]) + (v0[2] * v0[2] + v0[3] * v0[3])) + ((v1[0] * v1[0] + v1[1] * v1[1]) + (v1[2] * v1[2] + v1[3] * v1[3]));
                        u32x4 w; w.x = cvt_pk_bf16(v0[0], v0[1]); w.y = cvt_pk_bf16(v0[2], v0[3]); w.z = cvt_pk_bf16(v1[0], v1[1]); w.w = cvt_pk_bf16(v1[2], v1[3]);
                        *(u32x4*)(HB + (size_t)row * 4096 + col0 + bj * HALF) = w; }
                    s += __shfl_xor(s, 16); s += __shfl_xor(s, 32);
                    if (fq == 0) __hip_atomic_fetch_add(ssq + row, s, __ATOMIC_RELAXED, __HIP_MEMORY_SCOPE_AGENT);
                } else {
                    const bf16_t* hp = HB + (size_t)row * 4096 + col0; float* op = out + (size_t)row * 4096 + col0; float s = 0.f;
#pragma unroll
                    for (int bj = 0; bj < 2; ++bj) { const u32x4 h = *(const u32x4*)(hp + bj * HALF);
                        const f32x4 r0 = {__uint_as_float(h.x << 16), __uint_as_float(h.x & 0xffff0000u), __uint_as_float(h.y << 16), __uint_as_float(h.y & 0xffff0000u)};
                        const f32x4 r1 = {__uint_as_float(h.z << 16), __uint_as_float(h.z & 0xffff0000u), __uint_as_float(h.w << 16), __uint_as_float(h.w & 0xffff0000u)};
                        const f32x4 y0 = r0 + acc[ai][bj][m][0], y1 = r1 + acc[ai][bj][m][1];
                        if (YB) { u32x4 w; w.x = cvt_pk_bf16(y0[0], y0[1]); w.y = cvt_pk_bf16(y0[2], y0[3]); w.z = cvt_pk_bf16(y1[0], y1[1]); w.w = cvt_pk_bf16(y1[2], y1[3]);
                                  *(u32x4*)(YB + (size_t)row * 4096 + col0 + bj * HALF) = w;
                                  s += ((y0[0] * y0[0] + y0[1] * y0[1]) + (y0[2] * y0[2] + y0[3] * y0[3])) + ((y1[0] * y1[0] + y1[1] * y1[1]) + (y1[2] * y1[2] + y1[3] * y1[3])); }
                        else { __builtin_nontemporal_store(y0, (f32x4*)(op + bj * HALF)); __builtin_nontemporal_store(y1, (f32x4*)(op + bj * HALF + 4)); } }
                    if (YB) { s += __shfl_xor(s, 16); s += __shfl_xor(s, 32);
                        if (fq == 0) __hip_atomic_fetch_add(ssq + row, s, __ATOMIC_RELAXED, __HIP_MEMORY_SCOPE_AGENT); }
                } }
    }
};
struct EpiRelu2N {
    static constexpr bool PERM = true, AFTER_DRAIN = false;
    bf16_t* O; int ldc; const float* ssq; float eps;
    __device__ __forceinline__ void operator()(const f32x4 (&acc)[2][2][4][2], const Unit& u, int wr, int wc, int fr, int fq) const {
        const int row0 = u.pm * BM + wr * 64 + fr;
        bf16_t* const tile0 = O + ((size_t)u.pm * (ldc >> 6) + u.pn * 4 + (wc >> 1)) * 16384 + (wc & 1) * 32 + 8 * fq;
#pragma unroll
        for (int ai = 0; ai < 2; ++ai)
#pragma unroll
            for (int m = 0; m < 4; ++m) { const int row = row0 + ai * HALF + m * 16; bf16_t* rowp = tile0 + (wr * 64 + fr + ai * HALF + m * 16) * 64;
                const float r = 1.0f / sqrtf(__hip_atomic_load(ssq + row, __ATOMIC_RELAXED, __HIP_MEMORY_SCOPE_AGENT) * (1.f / 4096.f) + eps);
#pragma unroll
                for (int bj = 0; bj < 2; ++bj) { f32x4 v0 = acc[ai][bj][m][0], v1 = acc[ai][bj][m][1];
#pragma unroll
                    for (int e = 0; e < 4; ++e) { const float a = fmaxf(v0[e], 0.f) * r, b = fmaxf(v1[e], 0.f) * r; v0[e] = a * a; v1[e] = b * b; }
                    u32x4 w; w.x = cvt_pk_bf16(v0[0], v0[1]); w.y = cvt_pk_bf16(v0[2], v0[3]); w.z = cvt_pk_bf16(v1[0], v1[1]); w.w = cvt_pk_bf16(v1[2], v1[3]);
                    *(u32x4*)(rowp + bj * 2 * 16384) = w; } }
    }
};
template <class T, class = void> struct has_midk { static constexpr bool value = false; };
template <class T> struct has_midk<T, typename std::enable_if<T::MIDK>::type> { static constexpr bool value = true; };
template <class Epi, class Sched, bool ALIGN_EPI = false, bool SP2 = false>
__device__ __forceinline__ void gemm_phase(PG8_LAS unsigned char* lds, const Gemm g, const Sched& S, const Epi& E) {
    int tid_o = threadIdx.x; asm volatile("" : "+v"(tid_o));
    const int tid = tid_o, wid = __builtin_amdgcn_readfirstlane(tid >> 6), lane = tid & 63, wr = wid >> 2, wc = wid & 3, fr = lane & 15, fq = lane >> 4;
    const int nt = g.K / BK, K = g.blocked ? BK : g.K;
    unsigned voffA[2], voffB[2];
#pragma unroll
    for (int i = 0; i < 2; ++i) { int R, C; stage_rc(tid * 16 + i * 8192, R, C); const int Rb = Epi::PERM ? ((R & ~31) + perm32(R & 31)) : R;
        voffA[i] = (unsigned)(R * K + C) * 2u; voffB[i] = (unsigned)(Rb * K + C) * 2u; }
    const size_t kstep = g.blocked ? (size_t)(BM * BK * 2) : (size_t)(BK * 2);
    const size_t hstep = (size_t)HALF * K * 2;
    const size_t tstep = (size_t)BM * g.K * 2;
    const unsigned ldsw = (unsigned)wid * 1024u;
    const int aoff = lds_byte(wr * 64 + fr, fq * 8), boff = lds_byte(wc * 32 + fr, fq * 8);
#define PG8_SA(b, h) (((b) * 2 + (h)) * HTB)
#define PG8_SB(b, h) ((4 + (b) * 2 + (h)) * HTB)
#define PG8_STAGE(bufoff, gbase, voff) do { _Pragma("unroll") for (int _i = 0; _i < 2; ++_i) \
        __builtin_amdgcn_global_load_lds((const unsigned*)((const char*)(gbase) + (voff)[_i]), (PG8_LAS unsigned*)(lds + (bufoff) + ldsw + _i * 8192), 16, 0, 0); } while (0)
#define PG8_LDA(dst, b, h) do { _Pragma("unroll") for (int m = 0; m < 4; ++m) _Pragma("unroll") for (int k = 0; k < 2; ++k) dst[m][k] = *(const PG8_LAS bf16x8*)(lds + PG8_SA(b, h) + aoff + m * 2048 + k * 1024); } while (0)
#define PG8_LDB(dst, b, h) do { _Pragma("unroll") for (int n = 0; n < 2; ++n) _Pragma("unroll") for (int k = 0; k < 2; ++k) dst[n][k] = *(const PG8_LAS bf16x8*)(lds + PG8_SB(b, h) + boff + n * 2048 + k * 1024); } while (0)
#define PG8_MMA(ai, bj, At, Bt) do { __builtin_amdgcn_s_setprio(1); _Pragma("unroll") for (int m = 0; m < 4; ++m) _Pragma("unroll") for (int n = 0; n < 2; ++n) _Pragma("unroll") for (int k = 0; k < 2; ++k) \
        acc[ai][bj][m][n] = __builtin_amdgcn_mfma_f32_16x16x32_bf16(Bt[n][k], At[m][k], acc[ai][bj][m][n], 0, 0, 0); __builtin_amdgcn_s_setprio(0); } while (0)
#define PG8_WAIT_V(n) asm volatile("s_waitcnt vmcnt(" #n ")" ::: "memory")
#define PG8_WAIT_L(n) asm volatile("s_waitcnt lgkmcnt(" #n ")" ::: "memory")
#define PG8_BAR __builtin_amdgcn_s_barrier()
#define PG8_SCHED __builtin_amdgcn_sched_barrier(0)
    Unit cur, nxt; int ui = 0;
    if (!S.next(0, cur)) return;
    f32x4 acc[2][2][4][2];
#pragma unroll
    for (int a = 0; a < 2; ++a)
#pragma unroll
        for (int b = 0; b < 2; ++b)
#pragma unroll
            for (int m = 0; m < 4; ++m)
#pragma unroll
                for (int n = 0; n < 2; ++n) acc[a][b][m][n] = (f32x4){0.f, 0.f, 0.f, 0.f};
    bf16x8 At[4][2], B0[2][2], B1[2][2];
    const char* cA = (const char*)g.A + (size_t)cur.pm * tstep + (size_t)cur.kt0 * kstep; const char* cB = (const char*)g.Bt + (size_t)cur.pn * tstep + (size_t)cur.kt0 * kstep;
    int cnt = cur.nkt ? cur.nkt : nt;
    S.a_ready(cur);
    if constexpr (SP2) {
        PG8_STAGE(PG8_SB(0, 0), cB, voffB); PG8_STAGE(PG8_SB(0, 1), cB + hstep, voffB); PG8_STAGE(PG8_SA(0, 0), cA, voffA); PG8_STAGE(PG8_SA(0, 1), cA + hstep, voffA);
        if (wr == 1) PG8_BAR;
        PG8_WAIT_V(2); PG8_BAR;
        PG8_STAGE(PG8_SB(1, 0), cB + kstep, voffB); PG8_STAGE(PG8_SA(1, 0), cA + kstep, voffA); PG8_STAGE(PG8_SB(1, 1), cB + hstep + kstep, voffB);
        PG8_WAIT_V(6); PG8_BAR;
    } else {
        PG8_STAGE(PG8_SB(0, 0), cB, voffB); PG8_STAGE(PG8_SA(0, 0), cA, voffA); PG8_STAGE(PG8_SB(0, 1), cB + hstep, voffB); PG8_STAGE(PG8_SA(0, 1), cA + hstep, voffA);
        if (wr == 1) PG8_BAR;
        PG8_WAIT_V(4); PG8_BAR;
        PG8_STAGE(PG8_SB(1, 0), cB + kstep, voffB); PG8_STAGE(PG8_SA(1, 0), cA + kstep, voffA); PG8_STAGE(PG8_SB(1, 1), cB + hstep + kstep, voffB);
        PG8_WAIT_V(6); PG8_BAR;
    }
    for (;;) {
        const bool has_next = S.next(ui + 1, nxt);
        const char* nA = has_next ? (const char*)g.A + (size_t)nxt.pm * tstep + (size_t)nxt.kt0 * kstep : cA; const char* nB = has_next ? (const char*)g.Bt + (size_t)nxt.pn * tstep + (size_t)nxt.kt0 * kstep : cB;
        for (int t = 0; t < cnt; t += 2) {
            const bool last = (t == cnt - 2);
            const char* a1 = cA + (size_t)(t + 1) * kstep;
            const char* a2 = last ? nA : cA + (size_t)(t + 2) * kstep; const char* b2 = last ? nB : cB + (size_t)(t + 2) * kstep;
            const char* a3 = a2 + kstep; const char* b3 = b2 + kstep;
            if (last && has_next) S.a_ready(nxt);
            if constexpr (SP2) {
            PG8_LDB(B0, 0, 0); PG8_LDB(B1, 0, 1); PG8_SCHED; PG8_LDA(At, 0, 0); PG8_STAGE(PG8_SA(1, 1), a1 + hstep, voffA);
            PG8_WAIT_V(8); PG8_WAIT_L(0); PG8_BAR; PG8_MMA(0, 0, At, B0); PG8_MMA(0, 1, At, B1); PG8_BAR; PG8_SCHED;
            PG8_LDA(At, 0, 1); PG8_STAGE(PG8_SB(0, 0), b2, voffB); PG8_STAGE(PG8_SB(0, 1), b2 + hstep, voffB); PG8_STAGE(PG8_SA(0, 0), a2, voffA);
            PG8_WAIT_V(8); PG8_WAIT_L(0); PG8_BAR; PG8_MMA(1, 0, At, B0); PG8_MMA(1, 1, At, B1); PG8_BAR; PG8_SCHED;
            PG8_LDB(B0, 1, 0); PG8_LDB(B1, 1, 1); PG8_SCHED; PG8_LDA(At, 1, 0); PG8_STAGE(PG8_SA(0, 1), a2 + hstep, voffA);
            PG8_WAIT_V(8); PG8_WAIT_L(0); PG8_BAR; PG8_MMA(0, 0, At, B0); PG8_MMA(0, 1, At, B1); PG8_BAR; PG8_SCHED;
            PG8_LDA(At, 1, 1); PG8_STAGE(PG8_SB(1, 0), b3, voffB); PG8_STAGE(PG8_SB(1, 1), b3 + hstep, voffB); PG8_STAGE(PG8_SA(1, 0), a3, voffA);
            PG8_WAIT_V(8); PG8_WAIT_L(0); PG8_BAR; PG8_MMA(1, 0, At, B0); PG8_MMA(1, 1, At, B1); PG8_BAR; PG8_SCHED;
            } else {
            PG8_LDB(B0, 0, 0); PG8_SCHED; PG8_LDA(At, 0, 0); PG8_STAGE(PG8_SA(1, 1), a1 + hstep, voffA);
            PG8_WAIT_L(8); PG8_BAR; PG8_WAIT_L(0); PG8_MMA(0, 0, At, B0); PG8_BAR; PG8_SCHED;
            PG8_LDB(B1, 0, 1); PG8_STAGE(PG8_SB(0, 0), b2, voffB);
            PG8_BAR; PG8_WAIT_L(0); PG8_MMA(0, 1, At, B1); PG8_BAR;
            PG8_LDA(At, 0, 1); PG8_STAGE(PG8_SA(0, 0), a2, voffA);
            PG8_BAR; PG8_WAIT_L(0); PG8_MMA(1, 0, At, B0); PG8_BAR; PG8_SCHED;
            PG8_STAGE(PG8_SB(0, 1), b2 + hstep, voffB);
            PG8_WAIT_V(6); PG8_BAR; PG8_MMA(1, 1, At, B1); PG8_BAR;
            PG8_LDB(B0, 1, 0); PG8_SCHED; PG8_LDA(At, 1, 0); PG8_STAGE(PG8_SA(0, 1), a2 + hstep, voffA);
            PG8_WAIT_L(8); PG8_BAR; PG8_WAIT_L(0); PG8_MMA(0, 0, At, B0); PG8_BAR; PG8_SCHED;
            PG8_LDB(B1, 1, 1); PG8_STAGE(PG8_SB(1, 0), b3, voffB);
            PG8_BAR; PG8_WAIT_L(0); PG8_MMA(0, 1, At, B1); PG8_BAR;
            PG8_LDA(At, 1, 1); PG8_STAGE(PG8_SA(1, 0), a3, voffA);
            PG8_BAR; PG8_WAIT_L(0); PG8_MMA(1, 0, At, B0); PG8_BAR; PG8_SCHED;
            PG8_STAGE(PG8_SB(1, 1), b3 + hstep, voffB);
            PG8_WAIT_V(6); PG8_BAR; PG8_MMA(1, 1, At, B1); PG8_BAR;
            }
        }
        if constexpr (ALIGN_EPI) { if (wr == 0) PG8_BAR; }
        if constexpr (!Epi::AFTER_DRAIN) {
            if (cur.part == -2) { if constexpr (has_midk<Epi>::value) E.mid(acc, cur, wr, wc, fr, fq); }
            else if (cur.part >= 0) {
                f32x4* sp = (f32x4*)(g.slab + (size_t)cur.part * 65536) + (size_t)wid * 2048 + lane;
#pragma unroll
                for (int a = 0; a < 2; ++a)
#pragma unroll
                    for (int b = 0; b < 2; ++b)
#pragma unroll
                        for (int m = 0; m < 4; ++m)
#pragma unroll
                            for (int n = 0; n < 2; ++n) sp[(((a * 2 + b) * 4 + m) * 2 + n) * 64] = acc[a][b][m][n];
            } else E(acc, cur, wr, wc, fr, fq);
            S.done(cur); }
        if (!has_next) break;
        if (cur.part != -2) {
#pragma unroll
        for (int a = 0; a < 2; ++a)
#pragma unroll
            for (int b = 0; b < 2; ++b)
#pragma unroll
                for (int m = 0; m < 4; ++m)
#pragma unroll
                    for (int n = 0; n < 2; ++n) acc[a][b][m][n] = (f32x4){0.f, 0.f, 0.f, 0.f};
        }
        cur = nxt; cA = nA; cB = nB; ++ui; cnt = cur.nkt ? cur.nkt : nt;
        if constexpr (ALIGN_EPI) { if (wr == 1) PG8_BAR; }
    }
    PG8_WAIT_V(0);
    if constexpr (!ALIGN_EPI) { if (wr == 0) PG8_BAR; }
    PG8_BAR;
    if constexpr (Epi::AFTER_DRAIN) { E.fused(acc, cur, wr, wc, fr, fq, lds, wid, lane); S.done(cur); }
#undef PG8_SA
#undef PG8_SB
#undef PG8_STAGE
#undef PG8_LDA
#undef PG8_LDB
#undef PG8_MMA
#undef PG8_WAIT_V
#undef PG8_WAIT_L
#undef PG8_BAR
#undef PG8_SCHED
}
}
namespace att {
typedef short bf16x8 __attribute__((ext_vector_type(8)));
typedef short s16x4 __attribute__((ext_vector_type(4)));
typedef float f32x16 __attribute__((ext_vector_type(16)));
typedef unsigned u32x4 __attribute__((ext_vector_type(4)));
typedef float f32x4 __attribute__((ext_vector_type(4)));
typedef unsigned short bf16;
#define ALAS __attribute__((address_space(3)))
#ifndef ATT_SSQ_ATOMICS
#define ATT_SSQ_ATOMICS 0
#endif
constexpr int OFF_V = 0, OFF_K = 32768, OFF_R = 65536, OFF_WS = 81920, OFF_FLG = 81920 + 8 * 256, ATT_LDS_BYTES = OFF_FLG + 64;
constexpr float SB_DEAD = -150.f;
#define KSWZ(row, colB) ((row) * 256 + ((colB) ^ (((row) & 15) << 4)))
#define RSWZ(row, colB) ((row) * 128 + ((colB) ^ ((((row) >> 1) & 7) << 4)))
__device__ __forceinline__ int v_st(int k, int c) { const int kk = (k & ~0xC) | ((k & 4) << 1) | ((k & 8) >> 1); return ((kk >> 3) * 4 + (c >> 5)) * 512 + ((kk & 7) * 32 + (c & 31)) * 2; }
__device__ __forceinline__ int v_rd_base(int lane) { return ((lane & 3) << 3) | (((lane >> 2) & 3) << 6) | (((lane >> 4) & 1) << 5) | (((lane >> 5) & 1) << 8); }
__device__ __forceinline__ int crow(int r, int hi) { return (r & 3) + 8 * (r >> 2) + 4 * hi; }
__device__ __forceinline__ unsigned cvtpk(float lo, float hi) { unsigned r; asm volatile("v_cvt_pk_bf16_f32 %0, %1, %2" : "=v"(r) : "v"(lo), "v"(hi)); return r; }

struct Unit { const bf16* Q; int ldq; const bf16* K; const bf16* Kr; const bf16* V; bf16* O; int ldo; float* ssq; int P0; int NT; int nact;
              const float* Kf0; const float* Vf0; const float* Kf1; const float* Vf1; int split; };

__device__ __forceinline__ void qk128(f32x16& p0, f32x16& p1, ALAS const char* Kt, int r32, int hi, const bf16x8* qr) {
#pragma unroll
    for (int d0 = 0; d0 < 8; ++d0) { ALAS const char* a = Kt + KSWZ(r32, (d0 * 16 + hi * 8) * 2);
        const bf16x8 b0 = *(ALAS const bf16x8*)a; const bf16x8 b1 = *(ALAS const bf16x8*)(a + 32 * 256);
        p0 = __builtin_amdgcn_mfma_f32_32x32x16_bf16(b0, qr[d0], p0, 0, 0, 0);
        p1 = __builtin_amdgcn_mfma_f32_32x32x16_bf16(b1, qr[d0], p1, 0, 0, 0); }
}
__device__ __forceinline__ void qk64(f32x16& p0, f32x16& p1, ALAS const char* Kt, int r32, int hi, const bf16x8* qr) {
#pragma unroll
    for (int d0 = 0; d0 < 4; ++d0) { ALAS const char* a = Kt + RSWZ(r32, (d0 * 16 + hi * 8) * 2);
        const bf16x8 b0 = *(ALAS const bf16x8*)a; const bf16x8 b1 = *(ALAS const bf16x8*)(a + 32 * 128);
        p0 = __builtin_amdgcn_mfma_f32_32x32x16_bf16(b0, qr[d0], p0, 0, 0, 0);
        p1 = __builtin_amdgcn_mfma_f32_32x32x16_bf16(b1, qr[d0], p1, 0, 0, 0); }
}
__device__ __forceinline__ void pv_tile(f32x16* o, unsigned vb0, bf16x8 pa0, bf16x8 pa1, bf16x8 pa2, bf16x8 pa3) {
#define TRRD(dst, off) asm volatile("ds_read_b64_tr_b16 %0, %1 offset:%2" : "=&v"(dst) : "v"(vb0), "i"(off) : "memory")
#define PV_LD(S, d0) do { constexpr int b_ = (d0) * 512; \
        TRRD(S##l0, b_); TRRD(S##h0, b_ + 2048); TRRD(S##l1, b_ + 4096); TRRD(S##h1, b_ + 6144); TRRD(S##l2, b_ + 8192); TRRD(S##h2, b_ + 10240); TRRD(S##l3, b_ + 12288); TRRD(S##h3, b_ + 14336); } while (0)
#define PV_MM(S, d0) do { \
        o[d0] = __builtin_amdgcn_mfma_f32_32x32x16_bf16(pa0, (bf16x8){S##l0[0], S##l0[1], S##l0[2], S##l0[3], S##h0[0], S##h0[1], S##h0[2], S##h0[3]}, o[d0], 0, 0, 0); \
        o[d0] = __builtin_amdgcn_mfma_f32_32x32x16_bf16(pa1, (bf16x8){S##l1[0], S##l1[1], S##l1[2], S##l1[3], S##h1[0], S##h1[1], S##h1[2], S##h1[3]}, o[d0], 0, 0, 0); \
        o[d0] = __builtin_amdgcn_mfma_f32_32x32x16_bf16(pa2, (bf16x8){S##l2[0], S##l2[1], S##l2[2], S##l2[3], S##h2[0], S##h2[1], S##h2[2], S##h2[3]}, o[d0], 0, 0, 0); \
        o[d0] = __builtin_amdgcn_mfma_f32_32x32x16_bf16(pa3, (bf16x8){S##l3[0], S##l3[1], S##l3[2], S##l3[3], S##h3[0], S##h3[1], S##h3[2], S##h3[3]}, o[d0], 0, 0, 0); } while (0)
#define PV_WAIT(n) do { asm volatile("s_waitcnt lgkmcnt(" #n ")" ::: "memory"); __builtin_amdgcn_sched_barrier(0); } while (0)
    s16x4 Al0, Al1, Al2, Al3, Ah0, Ah1, Ah2, Ah3, Bl0, Bl1, Bl2, Bl3, Bh0, Bh1, Bh2, Bh3;
    PV_LD(A, 0); PV_LD(B, 1); PV_WAIT(8); PV_MM(A, 0);
    __builtin_amdgcn_sched_barrier(0); PV_LD(A, 2); PV_WAIT(8); PV_MM(B, 1);
    __builtin_amdgcn_sched_barrier(0); PV_LD(B, 3); PV_WAIT(8); PV_MM(A, 2);
    PV_WAIT(0); PV_MM(B, 3);
#undef PV_WAIT
#undef PV_MM
#undef PV_LD
#undef TRRD
}
#define PK4(P, B_, OUT) do { const unsigned a0_ = cvtpk(P[B_ + 0], P[B_ + 1]), a1_ = cvtpk(P[B_ + 2], P[B_ + 3]); \
        const unsigned b0_ = cvtpk(P[B_ + 4], P[B_ + 5]), b1_ = cvtpk(P[B_ + 6], P[B_ + 7]); \
        auto r0_ = __builtin_amdgcn_permlane32_swap(a0_, b0_, false, false); auto r1_ = __builtin_amdgcn_permlane32_swap(a1_, b1_, false, false); \
        u32x4 w_ = {r0_[0], r1_[0], r0_[1], r1_[1]}; OUT = __builtin_bit_cast(bf16x8, w_); } while (0)

__device__ __forceinline__ void store_o_staged(const f32x16* o, const float* rli, bf16* Ow, int ldo, ALAS char* stg, int lane, int r32, int hi, float* ssqp) {
    ALAS unsigned short* s16 = (ALAS unsigned short*)stg;
#pragma unroll
    for (int r = 0; r < 16; ++r) { const int orow = crow(r, hi);
#pragma unroll
        for (int d0 = 0; d0 < 4; ++d0) { const float v = o[d0][r] * rli[r]; s16[orow * 128 + d0 * 32 + r32] = (unsigned short)cvtpk(v, v); } }
    asm volatile("s_waitcnt lgkmcnt(0)" ::: "memory");
#pragma unroll
    for (int i = 0; i < 8; ++i) { const int idx = i * 64 + lane, row = idx >> 4, ch = idx & 15;
        const u32x4 w = *(ALAS const u32x4*)(stg + row * 256 + ch * 16);
        *(u32x4*)(Ow + (size_t)row * ldo + ch * 8) = w;
        float s = 0.f; { const unsigned ww[4] = {w.x, w.y, w.z, w.w};
#pragma unroll
            for (int e = 0; e < 4; ++e) { const float x0 = __uint_as_float(ww[e] << 16), x1 = __uint_as_float(ww[e] & 0xffff0000u); s += x0 * x0 + x1 * x1; } }
        s += __shfl_xor(s, 1); s += __shfl_xor(s, 2); s += __shfl_xor(s, 4); s += __shfl_xor(s, 8);
        if (ch == 0) ssqp[(size_t)row * 32] = s; }
}
template <bool MLA>
__device__ __forceinline__ void attn_unit(const Unit u, ALAS char* lds) {
    int tid_o = threadIdx.x; asm volatile("" : "+v"(tid_o));
    const int tid = tid_o, wid = __builtin_amdgcn_readfirstlane(tid >> 6), lane = tid & 63, r32 = lane & 31, hi = lane >> 5;
    const bool actw = wid < u.nact;
    const int sr = tid >> 4, sc = (tid & 15) * 8;
    const int vst0 = v_st(sr, sc), vst1 = v_st(32 + sr, sc), kws = KSWZ(sr, sc * 2);
    const int rk = tid >> 3, rc = (tid & 7) * 8, rws = RSWZ(rk, rc * 2);
    ALAS char* V_l = lds + OFF_V; ALAS char* K_l = lds + OFF_K; ALAS char* R_l = lds + OFF_R;
    ALAS float* al_l = (ALAS float*)(lds + OFF_WS) + wid * 64; ALAS float* li_l = al_l + 32;
    const unsigned vbase = (unsigned)(uintptr_t)V_l + (unsigned)v_rd_base(lane);
    constexpr int NQ = MLA ? 12 : 8;
    bf16x8 qr[NQ];
#pragma unroll
    for (int d0 = 0; d0 < NQ; ++d0) qr[d0] = (bf16x8){0, 0, 0, 0, 0, 0, 0, 0};
    if (actw) {
#pragma unroll
        for (int d0 = 0; d0 < NQ; ++d0) qr[d0] = *(const bf16x8*)(u.Q + (size_t)(wid * 32 + r32) * u.ldq + d0 * 16 + hi * 8);
    }
    const int cw = (u.P0 + wid * 32) >> 6;
    const int qpos = u.P0 + wid * 32 + r32;
    float m_reg = -1e30f, l_reg = 0.f, carry = 0.f; bool fin = false;
    ALAS unsigned* flg = (ALAS unsigned*)(lds + OFF_FLG);
    f32x16 o[4];
#pragma unroll
    for (int d = 0; d < 4; ++d)
#pragma unroll
        for (int r = 0; r < 16; ++r) o[d][r] = 0.f;
    bf16x8 st_k0, st_k1, st_v0, st_v1, st_r = (bf16x8){0, 0, 0, 0, 0, 0, 0, 0};
    f32x4 fk[4], fv[4];
#define LOADT(tt) do { if (!MLA) { const int t_ = (tt); const bool lo_ = t_ < u.split; const size_t ro_ = (size_t)(lo_ ? t_ : t_ - u.split) * 64 * 2048; \
            const float* kb_ = (lo_ ? u.Kf0 : u.Kf1) + ro_ + (size_t)sr * 2048 + sc; const float* vb_ = (lo_ ? u.Vf0 : u.Vf1) + ro_ + (size_t)sr * 2048 + sc; \
            fk[0] = *(const f32x4*)kb_; fk[1] = *(const f32x4*)(kb_ + 4); fk[2] = *(const f32x4*)(kb_ + 32 * 2048); fk[3] = *(const f32x4*)(kb_ + 32 * 2048 + 4); \
            fv[0] = *(const f32x4*)vb_; fv[1] = *(const f32x4*)(vb_ + 4); fv[2] = *(const f32x4*)(vb_ + 32 * 2048); fv[3] = *(const f32x4*)(vb_ + 32 * 2048 + 4); } else { \
        const size_t r0_ = (size_t)(tt) * 64; \
        st_k0 = *(const bf16x8*)(u.K + (r0_ + sr) * 2048 + sc); st_k1 = *(const bf16x8*)(u.K + (r0_ + 32 + sr) * 2048 + sc); \
        st_v0 = *(const bf16x8*)(u.V + (r0_ + sr) * 2048 + sc); st_v1 = *(const bf16x8*)(u.V + (r0_ + 32 + sr) * 2048 + sc); \
        if (MLA) st_r = *(const bf16x8*)(u.Kr + (r0_ + rk) * 64 + rc); } } while (0)
    LOADT(MLA ? 0 : (u.NT - 1));
    for (int i = 0; i < u.NT; ++i) {
        const int t = MLA ? i : (u.NT - 1 - i); const int buf = i & 1;
        if (!MLA) { u32x4 w_;
            w_ = (u32x4){cvtpk(fk[0][0], fk[0][1]), cvtpk(fk[0][2], fk[0][3]), cvtpk(fk[1][0], fk[1][1]), cvtpk(fk[1][2], fk[1][3])}; st_k0 = __builtin_bit_cast(bf16x8, w_);
            w_ = (u32x4){cvtpk(fk[2][0], fk[2][1]), cvtpk(fk[2][2], fk[2][3]), cvtpk(fk[3][0], fk[3][1]), cvtpk(fk[3][2], fk[3][3])}; st_k1 = __builtin_bit_cast(bf16x8, w_);
            w_ = (u32x4){cvtpk(fv[0][0], fv[0][1]), cvtpk(fv[0][2], fv[0][3]), cvtpk(fv[1][0], fv[1][1]), cvtpk(fv[1][2], fv[1][3])}; st_v0 = __builtin_bit_cast(bf16x8, w_);
            w_ = (u32x4){cvtpk(fv[2][0], fv[2][1]), cvtpk(fv[2][2], fv[2][3]), cvtpk(fv[3][0], fv[3][1]), cvtpk(fv[3][2], fv[3][3])}; st_v1 = __builtin_bit_cast(bf16x8, w_); }
        *(ALAS bf16x8*)(K_l + buf * 16384 + kws) = st_k0; *(ALAS bf16x8*)(K_l + buf * 16384 + kws + 32 * 256) = st_k1;
        *(ALAS bf16x8*)(V_l + buf * 16384 + vst0) = st_v0; *(ALAS bf16x8*)(V_l + buf * 16384 + vst1) = st_v1;
        if (MLA) *(ALAS bf16x8*)(R_l + buf * 8192 + rws) = st_r;
        if (!MLA) { if (lane == 0) flg[buf * 8 + wid] = (fin || !actw) ? 1u : 0u; }
        __syncthreads();
        if (!MLA) {
            const u32x4 fa = *(ALAS const u32x4*)(flg + buf * 8), fb = *(ALAS const u32x4*)(flg + buf * 8 + 4);
            if ((fa.x & fa.y & fa.z & fa.w & fb.x & fb.y & fb.z & fb.w) != 0u) break;
        }
        if (i + 1 < u.NT) LOADT(MLA ? (i + 1) : (u.NT - 2 - i));
        if (actw && t <= cw && !fin) {
            f32x16 p0, p1;
#pragma unroll
            for (int r = 0; r < 16; ++r) { p0[r] = 0.f; p1[r] = 0.f; }
            qk128(p0, p1, K_l + buf * 16384, r32, hi, qr);
            if (MLA) qk64(p0, p1, R_l + buf * 8192, r32, hi, qr + (MLA ? 8 : 0));
            bf16x8 pa0, pa1, pa2, pa3;
            if (MLA) {
                float pmax = p0[0];
#pragma unroll
                for (int r = 1; r < 16; ++r) pmax = fmaxf(pmax, p0[r]);
#pragma unroll
                for (int r = 0; r < 16; ++r) pmax = fmaxf(pmax, p1[r]);
                { auto rr = __builtin_amdgcn_permlane32_swap(__float_as_uint(pmax), __float_as_uint(pmax), false, false);
                  pmax = fmaxf(__uint_as_float(rr[0]), __uint_as_float(rr[1])); }
                const float mn = fmaxf(m_reg, pmax); const float alpha = __builtin_amdgcn_exp2f(m_reg - mn); m_reg = mn;
                float ps = 0.f;
#pragma unroll
                for (int r = 0; r < 16; ++r) { p0[r] = __builtin_amdgcn_exp2f(p0[r] - mn); ps += p0[r]; }
#pragma unroll
                for (int r = 0; r < 16; ++r) { p1[r] = __builtin_amdgcn_exp2f(p1[r] - mn); ps += p1[r]; }
                { auto rr = __builtin_amdgcn_permlane32_swap(__float_as_uint(ps), __float_as_uint(ps), false, false);
                  ps = __uint_as_float(rr[0]) + __uint_as_float(rr[1]); }
                l_reg = l_reg * alpha + ps;
                if (__any(alpha < 1.f)) {
                    if (hi == 0) al_l[r32] = alpha;
                    asm volatile("s_waitcnt lgkmcnt(0)" ::: "memory");
#pragma unroll
                    for (int r = 0; r < 16; ++r) { const float a = al_l[crow(r, hi)];
#pragma unroll
                        for (int d = 0; d < 4; ++d) o[d][r] *= a; }
                    asm volatile("s_waitcnt lgkmcnt(0)" ::: "memory");
                }
            } else {
                const bool diag = (t == cw); const int dq = qpos - 64 * t - 4 * hi; const float NEG = -__builtin_inff();
                float suf = carry;
#define SB_HALF(P, KOFF) do { f32x16 f_; \
                    _Pragma("unroll") for (int r = 0; r < 16; ++r) { const float y = P[r]; const float e = __builtin_amdgcn_exp2f(-fabsf(y)); const float l2 = __builtin_amdgcn_logf(1.f + e); \
                        const float lb = fminf(y, 0.f) - l2; P[r] = lb; f_[r] = lb - y; } \
                    if (diag) { _Pragma("unroll") for (int r = 0; r < 16; ++r) { const int c = (r & 3) + 8 * (r >> 2) + (KOFF); if (!(c < dq)) { P[r] = NEG; f_[r] = 0.f; } } } \
                    float tg_[4], pg_[4]; \
                    _Pragma("unroll") for (int g = 0; g < 4; ++g) { const float a = (f_[4 * g] + f_[4 * g + 1]) + (f_[4 * g + 2] + f_[4 * g + 3]); \
                        auto rr = __builtin_amdgcn_permlane32_swap(__float_as_uint(a), __float_as_uint(a), false, false); \
                        const float lo = __uint_as_float(rr[0]), hh = __uint_as_float(rr[1]); tg_[g] = lo + hh; pg_[g] = hi == 0 ? hh : 0.f; } \
                    _Pragma("unroll") for (int g = 3; g >= 0; --g) { const float base = suf + pg_[g]; \
                        const float s2 = f_[4 * g + 3], s1 = s2 + f_[4 * g + 2], s0 = s1 + f_[4 * g + 1]; \
                        P[4 * g + 3] = __builtin_amdgcn_exp2f(P[4 * g + 3] + base); P[4 * g + 2] = __builtin_amdgcn_exp2f(P[4 * g + 2] + (base + s2)); \
                        P[4 * g + 1] = __builtin_amdgcn_exp2f(P[4 * g + 1] + (base + s1)); P[4 * g] = __builtin_amdgcn_exp2f(P[4 * g] + (base + s0)); \
                        suf += tg_[g]; } } while (0)
                SB_HALF(p1, 32);
                PK4(p1, 0, pa2); PK4(p1, 8, pa3);
                SB_HALF(p0, 0);
                PK4(p0, 0, pa0); PK4(p0, 8, pa1);
#undef SB_HALF
                carry = suf;
                fin = __all(carry < SB_DEAD);
            }
            if (MLA) { PK4(p0, 0, pa0); PK4(p0, 8, pa1); PK4(p1, 0, pa2); PK4(p1, 8, pa3); }
            pv_tile(o, vbase + (unsigned)(buf * 16384), pa0, pa1, pa2, pa3);
        }
    }
    __syncthreads();
    if (actw) {
        float rli[16];
        if (MLA) {
            if (hi == 0) li_l[r32] = l_reg;
            asm volatile("s_waitcnt lgkmcnt(0)" ::: "memory");
#pragma unroll
            for (int r = 0; r < 16; ++r) rli[r] = 1.0f / li_l[crow(r, hi)];
        } else {
#pragma unroll
            for (int r = 0; r < 16; ++r) rli[r] = 1.0f;
        }
        store_o_staged(o, rli, u.O + (size_t)(wid * 32) * u.ldo, u.ldo, lds + wid * 8192, lane, r32, hi, u.ssq + (size_t)(wid * 32) * 32);
    }
    __syncthreads();
#undef LOADT
}

__device__ __forceinline__ void qk192_pipe(f32x16& p0, f32x16& p1, ALAS const char* Kt, ALAS const char* Rt, int r32, int hi, const bf16x8* qr, const f32x16* cinit = nullptr) {
    constexpr int PF = 2;
    bf16x8 fa[12], fb[12];
#define QK_ADDR(s) ((s) < 8 ? Kt + KSWZ(r32, ((s) * 16 + hi * 8) * 2) : Rt + RSWZ(r32, (((s) - 8) * 16 + hi * 8) * 2))
#define QK_LD(s) do { ALAS const char* a_ = QK_ADDR(s); fa[s] = *(ALAS const bf16x8*)a_; fb[s] = *(ALAS const bf16x8*)(a_ + ((s) < 8 ? 32 * 256 : 32 * 128)); } while (0)
#pragma unroll
    for (int s = 0; s < PF; ++s) QK_LD(s);
#pragma unroll
    for (int s = 0; s < 12; ++s) {
        if (s + PF < 12) QK_LD(s + PF);
        __builtin_amdgcn_sched_barrier(0);
        p0 = __builtin_amdgcn_mfma_f32_32x32x16_bf16(fa[s], qr[s], (s == 0 && cinit) ? *cinit : p0, 0, 0, 0);
        p1 = __builtin_amdgcn_mfma_f32_32x32x16_bf16(fb[s], qr[s], (s == 0 && cinit) ? *cinit : p1, 0, 0, 0);
        __builtin_amdgcn_sched_barrier(0);
    }
#undef QK_LD
#undef QK_ADDR
}
constexpr float MLA_THR = 8.f;
__device__ __forceinline__ void mla_softmax(f32x16& p0, f32x16& p1, float& m_reg, float& l_reg, f32x16* o, ALAS float* al_l, int r32, int hi, bf16x8& pa0, bf16x8& pa1, bf16x8& pa2, bf16x8& pa3) {
    float pmax = p0[0];
#pragma unroll
    for (int r = 1; r < 16; ++r) pmax = fmaxf(pmax, p0[r]);
#pragma unroll
    for (int r = 0; r < 16; ++r) pmax = fmaxf(pmax, p1[r]);
    { auto rr = __builtin_amdgcn_permlane32_swap(__float_as_uint(pmax), __float_as_uint(pmax), false, false);
      pmax = fmaxf(__uint_as_float(rr[0]), __uint_as_float(rr[1])); }
    float mn = m_reg, alpha = 1.f;
    if (!__all(pmax - m_reg <= MLA_THR)) { mn = fmaxf(m_reg, pmax); alpha = __builtin_amdgcn_exp2f(m_reg - mn); m_reg = mn; }
    float ps = 0.f;
#pragma unroll
    for (int r = 0; r < 16; ++r) { p0[r] = __builtin_amdgcn_exp2f(p0[r] - mn); ps += p0[r]; }
#pragma unroll
    for (int r = 0; r < 16; ++r) { p1[r] = __builtin_amdgcn_exp2f(p1[r] - mn); ps += p1[r]; }
    { auto rr = __builtin_amdgcn_permlane32_swap(__float_as_uint(ps), __float_as_uint(ps), false, false);
      ps = __uint_as_float(rr[0]) + __uint_as_float(rr[1]); }
    l_reg = l_reg * alpha + ps;
    if (__any(alpha < 1.f)) {
        if (hi == 0) al_l[r32] = alpha;
        asm volatile("s_waitcnt lgkmcnt(0)" ::: "memory");
#pragma unroll
        for (int r = 0; r < 16; ++r) { const float a = al_l[crow(r, hi)];
#pragma unroll
            for (int d = 0; d < 4; ++d) o[d][r] *= a; }
        asm volatile("s_waitcnt lgkmcnt(0)" ::: "memory");
    }
    PK4(p0, 0, pa0); PK4(p0, 8, pa1); PK4(p1, 0, pa2); PK4(p1, 8, pa3);
}
__device__ __forceinline__ void mla_softmax_rel(f32x16& p0, f32x16& p1, float& m_reg, f32x16& negm, bool first, float& l_reg, f32x16* o, ALAS float* al_l, int r32, int hi, bf16x8& pa0, bf16x8& pa1, bf16x8& pa2, bf16x8& pa3) {
    float pmax = p0[0];
#pragma unroll
    for (int r = 1; r < 16; ++r) pmax = fmaxf(pmax, p0[r]);
#pragma unroll
    for (int r = 0; r < 16; ++r) pmax = fmaxf(pmax, p1[r]);
    { auto rr = __builtin_amdgcn_permlane32_swap(__float_as_uint(pmax), __float_as_uint(pmax), false, false);
      pmax = fmaxf(__uint_as_float(rr[0]), __uint_as_float(rr[1])); }
    if (first || !__all(pmax <= MLA_THR)) {
        const float delta = first ? pmax : fmaxf(pmax, 0.f); const float alpha = first ? 1.f : __builtin_amdgcn_exp2f(-delta);
        m_reg += delta; l_reg *= alpha;
#pragma unroll
        for (int r = 0; r < 16; ++r) { p0[r] -= delta; p1[r] -= delta; negm[r] = -m_reg; }
        if (!first) {
            if (hi == 0) al_l[r32] = alpha;
            asm volatile("s_waitcnt lgkmcnt(0)" ::: "memory");
#pragma unroll
            for (int r = 0; r < 16; ++r) { const float a = al_l[crow(r, hi)];
#pragma unroll
                for (int d = 0; d < 4; ++d) o[d][r] *= a; }
            asm volatile("s_waitcnt lgkmcnt(0)" ::: "memory");
        }
    }
    float ps = 0.f;
#pragma unroll
    for (int r = 0; r < 16; ++r) { p0[r] = __builtin_amdgcn_exp2f(p0[r]); ps += p0[r]; }
#pragma unroll
    for (int r = 0; r < 16; ++r) { p1[r] = __builtin_amdgcn_exp2f(p1[r]); ps += p1[r]; }
    { auto rr = __builtin_amdgcn_permlane32_swap(__float_as_uint(ps), __float_as_uint(ps), false, false);
      ps = __uint_as_float(rr[0]) + __uint_as_float(rr[1]); }
    l_reg += ps;
    PK4(p0, 0, pa0); PK4(p0, 8, pa1); PK4(p1, 0, pa2); PK4(p1, 8, pa3);
}
constexpr int M_OFF_V = 0, M_OFF_K = 49152, M_OFF_R = 81920, M_OFF_WS = 98304, MLA_LDS_BYTES = 98304 + 8 * 256;
template <bool ROLEB, int VAR = 0> __device__ __forceinline__ void mla_body(const Unit u, ALAS char* lds) {
    int tid_o = threadIdx.x; asm volatile("" : "+v"(tid_o));
    const int tid = tid_o, wid = __builtin_amdgcn_readfirstlane(tid >> 6), lane = tid & 63, r32 = lane & 31, hi = lane >> 5;
    const bool actw = wid < u.nact; constexpr bool roleB = ROLEB;
    const int sr = tid >> 4, sc = (tid & 15) * 8;
    const int vst0 = v_st(sr, sc), vst1 = v_st(32 + sr, sc), kws = KSWZ(sr, sc * 2);
    const int rk = tid >> 3, rc = (tid & 7) * 8, rws = RSWZ(rk, rc * 2);
    ALAS char* V_l = lds + M_OFF_V; ALAS char* K_l = lds + M_OFF_K; ALAS char* R_l = lds + M_OFF_R;
    ALAS float* al_l = (ALAS float*)(lds + M_OFF_WS) + wid * 64; ALAS float* li_l = al_l + 32;
    const unsigned vbase = (unsigned)(uintptr_t)V_l + (unsigned)v_rd_base(lane);
    bf16x8 qr[12];
#pragma unroll
    for (int d0 = 0; d0 < 12; ++d0) qr[d0] = (bf16x8){0, 0, 0, 0, 0, 0, 0, 0};
    if (actw) {
#pragma unroll
        for (int d0 = 0; d0 < 12; ++d0) qr[d0] = *(const bf16x8*)(u.Q + (size_t)(wid * 32 + r32) * u.ldq + d0 * 16 + hi * 8);
    }
    const int cw = (u.P0 + wid * 32) >> 6;
    float m_reg = -1e30f, l_reg = 0.f;
    f32x16 o[4], p0, p1;
#pragma unroll
    for (int r = 0; r < 16; ++r) { p0[r] = 0.f; p1[r] = 0.f; }
#pragma unroll
    for (int d = 0; d < 4; ++d)
#pragma unroll
        for (int r = 0; r < 16; ++r) o[d][r] = 0.f;
    bf16x8 st_k0, st_k1, st_v0, st_v1, st_r;
#define LOADT(tt) do { const size_t r0_ = (size_t)(tt) * 64; \
        st_k0 = *(const bf16x8*)(u.K + (r0_ + sr) * 2048 + sc); st_k1 = *(const bf16x8*)(u.K + (r0_ + 32 + sr) * 2048 + sc); \
        st_v0 = *(const bf16x8*)(u.V + (r0_ + sr) * 2048 + sc); st_v1 = *(const bf16x8*)(u.V + (r0_ + 32 + sr) * 2048 + sc); \
        st_r = *(const bf16x8*)(u.Kr + (r0_ + rk) * 64 + rc); } while (0)
#define MLA_QK(kb) do { _Pragma("unroll") for (int r = 0; r < 16; ++r) { p0[r] = 0.f; p1[r] = 0.f; } \
        if (VAR == 4 || VAR == 0 || VAR == 5) qk192_pipe(p0, p1, K_l + (kb) * 16384, R_l + (kb) * 8192, r32, hi, qr); else if (VAR != 3) { qk128(p0, p1, K_l + (kb) * 16384, r32, hi, qr); qk64(p0, p1, R_l + (kb) * 8192, r32, hi, qr + 8); } } while (0)
#define MLA_SMPV(vs) do { bf16x8 pa0, pa1, pa2, pa3; \
        if (VAR == 1) { PK4(p0, 0, pa0); PK4(p0, 8, pa1); PK4(p1, 0, pa2); PK4(p1, 8, pa3); l_reg += p0[0]; } \
        else mla_softmax(p0, p1, m_reg, l_reg, o, al_l, r32, hi, pa0, pa1, pa2, pa3); \
        if (VAR != 2) pv_tile(o, vbase + (unsigned)((vs) * 16384), pa0, pa1, pa2, pa3); \
        else { _Pragma("unroll") for (int r = 0; r < 4; ++r) o[r][0] += __builtin_bit_cast(float, (unsigned)pa0[r] ^ (unsigned)pa1[r] ^ (unsigned)pa2[r] ^ (unsigned)pa3[r]); } } while (0)
    LOADT(0);
    int vs_cur = 0, vs_prev = 2;
    for (int i = 0; i <= u.NT; ++i) {
        const int kb = i & 1;
        if (i < u.NT && VAR != 5) {
            *(ALAS bf16x8*)(K_l + kb * 16384 + kws) = st_k0; *(ALAS bf16x8*)(K_l + kb * 16384 + kws + 32 * 256) = st_k1;
            *(ALAS bf16x8*)(V_l + vs_cur * 16384 + vst0) = st_v0; *(ALAS bf16x8*)(V_l + vs_cur * 16384 + vst1) = st_v1;
            *(ALAS bf16x8*)(R_l + kb * 8192 + rws) = st_r;
            __syncthreads();
            if (i + 1 < u.NT) LOADT(i + 1);
        }
        if (actw) {
            if constexpr (!roleB) { if (i < u.NT && i <= cw) { MLA_QK(kb); MLA_SMPV(vs_cur); } }
            else { if (i >= 1 && i - 1 <= cw) MLA_SMPV(vs_prev);
                   if (i < u.NT && i <= cw) MLA_QK(kb); }
        }
        vs_prev = vs_cur; vs_cur = (vs_cur == 2) ? 0 : vs_cur + 1;
    }
    if (actw) {
        if (hi == 0) li_l[r32] = l_reg;
        asm volatile("s_waitcnt lgkmcnt(0)" ::: "memory");
        float rli[16];
#pragma unroll
        for (int r = 0; r < 16; ++r) rli[r] = 1.0f / li_l[crow(r, hi)];
        bf16* Ow = u.O + (size_t)(wid * 32) * u.ldo;
#pragma unroll
        for (int r = 0; r < 16; ++r) { const int orow = crow(r, hi); float sq = 0.f;
#pragma unroll
            for (int d0 = 0; d0 < 4; ++d0) { const float v = o[d0][r] * rli[r]; const float vn = __shfl_xor(v, 1); sq += v * v;
                if ((r32 & 1) == 0) *(unsigned*)(Ow + (size_t)orow * u.ldo + d0 * 32 + r32) = cvtpk(v, vn); }
            sq += __shfl_xor(sq, 1); sq += __shfl_xor(sq, 2); sq += __shfl_xor(sq, 4); sq += __shfl_xor(sq, 8); sq += __shfl_xor(sq, 16);
            if (ATT_SSQ_ATOMICS && r32 == 0) __hip_atomic_fetch_add(u.ssq + wid * 32 + orow, sq, __ATOMIC_RELAXED, __HIP_MEMORY_SCOPE_AGENT); }
    }
    __syncthreads();
#undef LOADT
#undef MLA_QK
#undef MLA_SMPV
}
constexpr int D_OFF_K = 0, D_OFF_R = 49152, D_OFF_V = 73728, D_OFF_WS = 122880, DMA_LDS_BYTES = 122880 + 8 * 256;
template <int VAR = 0> __device__ __forceinline__ void mla_unit_dma(const Unit u, ALAS char* lds) {
    int tid_o = threadIdx.x; asm volatile("" : "+v"(tid_o));
    const int tid = tid_o, wid = __builtin_amdgcn_readfirstlane(tid >> 6), lane = tid & 63, r32 = lane & 31, hi = lane >> 5;
    const bool actw = wid < u.nact;
    if (false) __builtin_amdgcn_s_setprio(1);
    ALAS char* K_l = lds + D_OFF_K; ALAS char* R_l = lds + D_OFF_R; ALAS char* V_l = lds + D_OFF_V;
    ALAS float* al_l = (ALAS float*)(lds + D_OFF_WS) + wid * 64; ALAS float* li_l = al_l + 32;
    const unsigned vbase = (unsigned)(uintptr_t)V_l + (unsigned)v_rd_base(lane);
    unsigned offK[2], offV[2], offR;
#pragma unroll
    for (int j = 0; j < 2; ++j) {
        const int p = wid + 8 * j;
        { const int r = 4 * p + (lane >> 4), c = (lane & 15) ^ (r & 15); offK[j] = (unsigned)(r * 4096 + c * 16); }
        { const int sti = 2 * p + (lane >> 5), kk = (sti >> 2) * 8 + ((lane & 31) >> 2), k = (kk & ~0xC) | ((kk & 4) << 1) | ((kk & 8) >> 1), c = (sti & 3) * 32 + (lane & 3) * 8; offV[j] = (unsigned)(k * 4096 + c * 2); }
    }
    { const int r = 8 * wid + (lane >> 3), c = (lane & 7) ^ ((r >> 1) & 7); offR = (unsigned)(r * 128 + c * 16); }
    const char* gK = (const char*)u.K; const char* gV = (const char*)u.V; const char* gR = (const char*)u.Kr;
#define DMA_TILE(tt, slot) do { const size_t tb_ = (size_t)(tt) * 64; \
        __builtin_amdgcn_global_load_lds((const unsigned*)(gK + tb_ * 4096 + offK[0]), (ALAS unsigned*)(K_l + (slot) * 16384 + wid * 1024), 16, 0, 0); \
        __builtin_amdgcn_global_load_lds((const unsigned*)(gK + tb_ * 4096 + offK[1]), (ALAS unsigned*)(K_l + (slot) * 16384 + (wid + 8) * 1024), 16, 0, 0); \
        __builtin_amdgcn_global_load_lds((const unsigned*)(gR + tb_ * 128 + offR), (ALAS unsigned*)(R_l + (slot) * 8192 + wid * 1024), 16, 0, 0); \
        __builtin_amdgcn_global_load_lds((const unsigned*)(gV + tb_ * 4096 + offV[0]), (ALAS unsigned*)(V_l + (slot) * 16384 + wid * 1024), 16, 0, 0); \
        __builtin_amdgcn_global_load_lds((const unsigned*)(gV + tb_ * 4096 + offV[1]), (ALAS unsigned*)(V_l + (slot) * 16384 + (wid + 8) * 1024), 16, 0, 0); } while (0)
    bf16x8 qr[12];
#pragma unroll
    for (int d0 = 0; d0 < 12; ++d0) qr[d0] = (bf16x8){0, 0, 0, 0, 0, 0, 0, 0};
    if (actw) {
#pragma unroll
        for (int d0 = 0; d0 < 12; ++d0) qr[d0] = *(const bf16x8*)(u.Q + (size_t)(wid * 32 + r32) * u.ldq + d0 * 16 + hi * 8);
    }
#pragma unroll
    for (int d0 = 0; d0 < 12; ++d0) asm volatile("" : "+v"(qr[d0]));
    DMA_TILE(0, 0); if (u.NT > 1) DMA_TILE(1, 1);
    const int cw = (u.P0 + wid * 32) >> 6;
    float m_reg = 0.f, l_reg = 0.f;
    f32x16 o[4], p0, p1, negm;
#pragma unroll
    for (int r = 0; r < 16; ++r) negm[r] = 0.f;
#pragma unroll
    for (int d = 0; d < 4; ++d)
#pragma unroll
        for (int r = 0; r < 16; ++r) o[d][r] = 0.f;
    int sl = 0, sl2 = 2;
    for (int i = 0; i < u.NT; ++i) {
        if (i + 1 < u.NT) asm volatile("s_waitcnt vmcnt(5) lgkmcnt(0)" ::: "memory"); else asm volatile("s_waitcnt vmcnt(0) lgkmcnt(0)" ::: "memory");
        __builtin_amdgcn_s_barrier(); asm volatile("" ::: "memory");
        if (i + 2 < u.NT) DMA_TILE(i + 2, sl2);
        if (actw && i <= cw) {
            __builtin_amdgcn_s_setprio(1); qk192_pipe(p0, p1, K_l + sl * 16384, R_l + sl * 8192, r32, hi, qr, &negm); __builtin_amdgcn_s_setprio(0);
            bf16x8 pa0, pa1, pa2, pa3;
            mla_softmax_rel(p0, p1, m_reg, negm, i == 0, l_reg, o, al_l, r32, hi, pa0, pa1, pa2, pa3);
            __builtin_amdgcn_s_setprio(1); pv_tile(o, vbase + (unsigned)(sl * 16384), pa0, pa1, pa2, pa3); __builtin_amdgcn_s_setprio(0);
        }
        sl = (sl == 2) ? 0 : sl + 1; sl2 = (sl2 == 2) ? 0 : sl2 + 1;
    }
    asm volatile("s_waitcnt lgkmcnt(0)" ::: "memory"); __builtin_amdgcn_s_barrier(); asm volatile("" ::: "memory");
    if (actw) {
        if (hi == 0) li_l[r32] = l_reg;
        asm volatile("s_waitcnt lgkmcnt(0)" ::: "memory");
        float rli[16];
#pragma unroll
        for (int r = 0; r < 16; ++r) rli[r] = 1.0f / li_l[crow(r, hi)];
        store_o_staged(o, rli, u.O + (size_t)(wid * 32) * u.ldo, u.ldo, lds + wid * 8192, lane, r32, hi, u.ssq + (size_t)(wid * 32) * 32);
    }
    asm volatile("s_waitcnt lgkmcnt(0)" ::: "memory"); __builtin_amdgcn_s_barrier(); asm volatile("" ::: "memory");
    __builtin_amdgcn_s_setprio(0);
#undef DMA_TILE
}
template <int VAR = 0> __device__ __forceinline__ void mla_unit(const Unit u, ALAS char* lds) {
    int tid_o = threadIdx.x; asm volatile("" : "+v"(tid_o));
    if (__builtin_amdgcn_readfirstlane(tid_o >> 6) >= 4) mla_body<true, VAR>(u, lds); else mla_body<false, VAR>(u, lds);
}
#undef PK4
}
#define GAS __attribute__((address_space(1)))
#define LAS __attribute__((address_space(3)))
typedef unsigned short bf16;
typedef unsigned v4u __attribute__((ext_vector_type(4)));
typedef float f32x4 __attribute__((ext_vector_type(4)));
typedef short bf16x8 __attribute__((ext_vector_type(8)));
typedef GAS unsigned gu32;
typedef GAS unsigned long long gu64;
#define RLX_AGENT __ATOMIC_RELAXED, __HIP_MEMORY_SCOPE_AGENT
#define LDS_WAIT() asm volatile("s_waitcnt lgkmcnt(0)" ::: "memory")
#define VM_WAIT() asm volatile("s_waitcnt vmcnt(0)" ::: "memory")
__device__ __forceinline__ unsigned long long rt() { return __builtin_amdgcn_s_memrealtime(); }
__device__ __forceinline__ unsigned f2bf(float f) { unsigned u = __builtin_bit_cast(unsigned, f); return (u + 0x7fffu + ((u >> 16) & 1u)) >> 16; }
__device__ __forceinline__ unsigned pk2(float lo, float hi) { return f2bf(lo) | (f2bf(hi) << 16); }

#define XB_TMO      128
#define XB_XCNT(j)  (256  + 64 * (j))
#define XB_XSUB(j)  (1280 + 64 * (j))
#define XB_XGEN(j)  (2304 + 64 * (j))
#define XB_TOP      3328
#define XB_TOPGEN   3392
#define XCD_BAR_WORDS 3456
#define XB_SPIN_CAP (1u << 18)

__device__ __forceinline__ unsigned xb_ld(unsigned* p)              { return __hip_atomic_load(p, __ATOMIC_RELAXED, __HIP_MEMORY_SCOPE_AGENT); }
__device__ __forceinline__ unsigned xb_add(unsigned* p, unsigned v) { return __hip_atomic_fetch_add(p, v, __ATOMIC_RELAXED, __HIP_MEMORY_SCOPE_AGENT); }
__device__ __forceinline__ unsigned xb_xcc_id() { return (unsigned)__builtin_amdgcn_s_getreg((3 << 11) | 20) & 0xFu; }
#define XB_SPIN(cond, bar) do { unsigned _sp = 0; while (cond) { __builtin_amdgcn_s_sleep(1); \
    if ((++_sp & 255u) == 0u) { if (xb_ld(&(bar)[XB_TMO])) break; if (_sp > XB_SPIN_CAP) { atomicAdd(&(bar)[XB_TMO], 1u); break; } } } } while (0)

struct XcdBarrier {
    unsigned* bar; unsigned x;
    volatile LAS unsigned* st;
};

__device__ __forceinline__ XcdBarrier xcd_barrier_post(unsigned* bar, volatile LAS unsigned* st) {
    XcdBarrier b; b.bar = bar; b.x = xb_xcc_id(); b.st = st;
    if (threadIdx.x == 0) (void)xb_add(&bar[XB_XCNT(b.x)], 1u);
    return b;
}
__device__ __forceinline__ void xcd_barrier_complete(unsigned* bar, unsigned x, unsigned& nloc, unsigned& nx) {
    const unsigned G = gridDim.x * gridDim.y * gridDim.z;
    unsigned sum, cnt, mine, sp = 0u;
    for (;;) {
        sum = 0u; cnt = 0u; mine = 0u;
#pragma unroll
        for (unsigned j = 0; j < 16; ++j) { const unsigned c = xb_ld(&bar[XB_XCNT(j)]); sum += c; cnt += (c > 0u) ? 1u : 0u; mine = (j == x) ? c : mine; }
        if (sum == G) break;
        __builtin_amdgcn_s_sleep(1);
        if ((++sp & 255u) == 0u) { if (xb_ld(&bar[XB_TMO])) break; if (sp > XB_SPIN_CAP) { atomicAdd(&bar[XB_TMO], 1u); break; } }
    }
    nloc = mine > 0u ? mine : 1u; nx = cnt > 0u ? cnt : 1u;
}

__device__ __forceinline__ void xcd_barrier(const XcdBarrier& b) {
    asm volatile("s_waitcnt vmcnt(0)" ::: "memory");
    __syncthreads();
    if (threadIdx.x == 0) {
        unsigned* bar = b.bar;
        __builtin_amdgcn_s_waitcnt(0);
        unsigned nloc = b.st[0], nx = b.st[1];
        if (nloc == 0u) { xcd_barrier_complete(bar, b.x, nloc, nx); b.st[0] = nloc; b.st[1] = nx; }
        const unsigned old = xb_add(&bar[XB_XSUB(b.x)], 1u);
        const unsigned gen = old / nloc;
        if (old + 1u == (gen + 1u) * nloc) {
            __builtin_amdgcn_fence(__ATOMIC_RELEASE, "agent");
            asm volatile("s_waitcnt vmcnt(0)" ::: "memory");
            const unsigned og = xb_add(&bar[XB_TOP], 1u);
            const unsigned tg = og / nx;
            if (og + 1u == (tg + 1u) * nx) xb_add(&bar[XB_TOPGEN], 1u);
            else XB_SPIN(xb_ld(&bar[XB_TOPGEN]) == tg, bar);
            __builtin_amdgcn_fence(__ATOMIC_ACQUIRE, "agent");
            xb_add(&bar[XB_XGEN(b.x)], 1u);
            asm volatile("s_waitcnt vmcnt(0)" ::: "memory");
        } else {
            XB_SPIN(xb_ld(&bar[XB_XGEN(b.x)]) == gen, bar);
            __builtin_amdgcn_fence(__ATOMIC_ACQUIRE, "agent");
            asm volatile("s_waitcnt vmcnt(0)" ::: "memory");
        }
    }
    __syncthreads();
}
constexpr int NWAVES = 8;
constexpr int DM = 4096, NP = 16384, NS = 512, MTOK = NP + NS;
constexpr int SEQ = 4096, PAST = 1024, DSEQ = 64, SKVS = PAST + DSEQ;
constexpr int KVROWS = NP + 8 * SKVS;
constexpr int NINP = 7936;
constexpr int QLORA = 1024, KVLORA = 512, ROPE = 64, NOPE = 128, NH = 16, DFF = 16384;
constexpr float EPS = 1e-6f;
constexpr float LOG2E = 1.4426950408889634f;
constexpr float QS_MLA = 0.07216878364870322f * LOG2E;
constexpr float QS_SB = 0.08838834764831845f * LOG2E;

constexpr size_t O_Y = 0, O_CKV_P = 69206016, O_KR_P = 85983232, O_SBK_P = 88080384, O_SBV_P = 155189248,
                 O_CKV_S = 222298112, O_KR_S = 222822400, O_SBK_S = 222887936, O_SBV_S = 224985088, O_END = 227082240;

constexpr size_t MiB = 1u << 20;
constexpr size_t WS_CTL = 0, CTL_ZERO_BYTES = 1 * MiB;
constexpr size_t WS_SSQH = 512 * 1024;
constexpr size_t WS_TAB = 1 * MiB;
constexpr size_t WS_WIN = 2 * MiB;
constexpr size_t WS_WQB = 64 * MiB;
constexpr size_t WS_WKVB = 70 * MiB;
constexpr size_t WS_WO = 74 * MiB;
constexpr size_t WS_WUP = 106 * MiB;
constexpr size_t WS_WDN = 234 * MiB;
constexpr size_t WS_XN = 362 * MiB;
constexpr size_t WS_R = 494 * MiB;
constexpr size_t WS_U = WS_R;
constexpr size_t WS_QLAT = WS_R;
constexpr size_t WS_AKV = WS_QLAT + 33 * MiB;
constexpr size_t WS_KROPE = WS_AKV + 25 * MiB;
constexpr size_t WS_VB = WS_KROPE + 4 * MiB;
constexpr size_t WS_QB = WS_VB + 98 * MiB;
constexpr size_t WS_KN = WS_QB + 99 * MiB;
constexpr size_t WS_SBQ = WS_KN + 98 * MiB;
constexpr size_t WS_SBK = WS_SBQ + 66 * MiB;
constexpr size_t WS_SBV = WS_SBK + 98 * MiB;
constexpr size_t WS_R2 = WS_SBV + 98 * MiB;
constexpr size_t WS_LAT = WS_R2;
constexpr size_t WS_QRAW = WS_R2;
constexpr size_t WS_KNRAW = WS_R2 + 198 * MiB;
constexpr size_t WS_MLAO = WS_R2;
constexpr size_t WS_SBO = WS_R2 + 66 * MiB;
constexpr size_t WS_MERGED = WS_R2 + 132 * MiB;
constexpr size_t WS_SLAB = WS_R2;
constexpr size_t WS_Y0B = WS_R2 + 264 * MiB;
constexpr size_t WS_WDN1 = WS_R2 + 398 * MiB;
constexpr size_t WS_SSQP = WS_WDN1 + 128 * MiB;
constexpr size_t WS_END = WS_SSQP + 3 * MiB;
static_assert(WS_U + (size_t)MTOK * DFF * 2 <= WS_END, "U fits the overlay region");
static_assert(WS_XN + (size_t)MTOK * DM * 2 <= WS_R && WS_WDN + (size_t)DM * DFF * 2 <= WS_XN && WS_WIN + (size_t)NINP * DM * 2 <= WS_WQB, "ws map");
constexpr int CW_TMO = 0, CW_CODE = 1, CW_BAR = 4096;

constexpr int RING_OFF = 0, RING_BYTES = 131072;
constexpr int LDSCTL_OFF = RING_BYTES, MISC_OFF = LDSCTL_OFF + 320;
constexpr int XCH_OFF = LDSCTL_OFF + 1024;
constexpr int LDS_BYTES = 147456;
static_assert(XCH_OFF + 8192 <= LDS_BYTES, "LDS map");
static_assert(att::ATT_LDS_BYTES <= RING_BYTES && att::MLA_LDS_BYTES <= RING_BYTES && att::DMA_LDS_BYTES <= RING_BYTES, "attention scratch fits the ring region");

#if defined(__HIP_DEVICE_COMPILE__)
#define ASSUME_GLOBAL(p) do { __builtin_assume(!__builtin_amdgcn_is_shared((const __attribute__((address_space(0))) void*)(p))); __builtin_assume(!__builtin_amdgcn_is_private((const __attribute__((address_space(0))) void*)(p))); } while (0)
#else
#define ASSUME_GLOBAL(p) do { } while (0)
#endif
typedef float f32x2 __attribute__((ext_vector_type(2)));
__device__ __forceinline__ float wave_sum(float v) {
#pragma unroll
    for (int o = 1; o < 64; o <<= 1) v += __shfl_xor(v, o);
    return v;
}
__device__ __forceinline__ unsigned pkbf(float lo, float hi) { return pg8::cvt_pk_bf16(lo, hi); }
__device__ __forceinline__ float bf2f(unsigned short b) { return __uint_as_float(((unsigned)b) << 16); }
__device__ __forceinline__ int kvrow_of(int m) { return m < NP ? m : NP + ((m - NP) >> 6) * SKVS + PAST + ((m - NP) & 63); }
__device__ __forceinline__ int pos_of(int m) { return m < NP ? (m & (SEQ - 1)) : PAST + ((m - NP) & 63); }

__device__ __forceinline__ void sincos_acc(float ang, float& s, float& c) {
    const double a = (double)ang; const double q = rint(a * 0.63661977236758134308);
    double r = fma(-q, 1.57079632679489661923, a); r = fma(-q, 6.123233995736766e-17, r);
    const float rf = (float)r; const int qi = (int)q; const float r2 = rf * rf;
    const float sp = rf + rf * r2 * (-1.6666667163e-1f + r2 * (8.3333337680e-3f + r2 * (-1.9841270114e-4f + r2 * 2.7557314297e-6f)));
    const float cp = 1.f + r2 * (-0.5f + r2 * (4.1666667908e-2f + r2 * (-1.3888889225e-3f + r2 * (2.4801587642e-5f + r2 * (-2.7557314297e-7f)))));
    switch (qi & 3) { case 0: s = sp; c = cp; break; case 1: s = cp; c = -sp; break; case 2: s = -sp; c = -cp; break; default: s = -cp; c = sp; break; }
}

struct Frame {
    LAS unsigned char* lds; volatile LAS unsigned* MISC; gu32* ctl;
    int tid, lane, wave, vcu, G;
};
struct Args { const float* in[22]; float* out; unsigned char* ws; };

struct TItem { const float* src; bf16* dst; const float* gk; int N, K; };
__device__ __forceinline__ void ti_load(const TItem& P, float (&tv)[32], f32x4& g0, f32x4& g1, int lane) {
    if (P.gk) { g0 = *(const GAS f32x4*)(P.gk + 8 * (lane & 7)); g1 = *(const GAS f32x4*)(P.gk + 8 * (lane & 7) + 4); }
    else { g0 = f32x4{1.f, 1.f, 1.f, 1.f}; g1 = g0; }
    const GAS float* s = (const GAS float*)P.src + (size_t)(lane >> 5) * P.N + (lane & 31);
#pragma unroll
    for (int i = 0; i < 32; ++i) tv[i] = __builtin_nontemporal_load(s + (size_t)(2 * i) * P.N);
}
__device__ __forceinline__ void ti_finish(const TItem& P, const float (&tv)[32], const f32x4 g0, const f32x4 g1, LAS float* scr, int lane) {
#pragma unroll
    for (int i = 0; i < 32; ++i) scr[(2 * i + (lane >> 5)) * 33 + (lane & 31)] = tv[i];
    LDS_WAIT(); asm volatile("" ::: "memory");
    const int c = lane & 7;
#pragma unroll
    for (int j = 0; j < 4; ++j) { const int n = (lane >> 3) + 8 * j; const LAS float* s = scr + (8 * c) * 33 + n;
        v4u o; o.x = pkbf(s[0 * 33] * g0.x, s[1 * 33] * g0.y); o.y = pkbf(s[2 * 33] * g0.z, s[3 * 33] * g0.w); o.z = pkbf(s[4 * 33] * g1.x, s[5 * 33] * g1.y); o.w = pkbf(s[6 * 33] * g1.z, s[7 * 33] * g1.w);
        *(GAS v4u*)(P.dst + (size_t)n * P.K + 8 * c) = o; }
    LDS_WAIT(); asm volatile("" ::: "memory");
}
__device__ __forceinline__ void rms_row_4096(const float* xrow, const float* g, bf16* orow, int lane) {
    const GAS f32x4* xr = (const GAS f32x4*)xrow + lane; const GAS f32x4* gr = (const GAS f32x4*)g + lane;
    f32x4 v[16]; float s = 0.f;
#pragma unroll
    for (int j = 0; j < 16; ++j) { v[j] = xr[64 * j]; s += (v[j].x * v[j].x + v[j].y * v[j].y) + (v[j].z * v[j].z + v[j].w * v[j].w); }
    const float rstd = 1.0f / sqrtf(wave_sum(s) * (1.f / 4096.f) + EPS);
    GAS unsigned long long* o8 = (GAS unsigned long long*)orow + lane;
#pragma unroll
    for (int j = 0; j < 16; ++j) { const f32x4 gg = gr[64 * j];
        o8[64 * j] = (unsigned long long)pkbf(v[j].x * rstd * gg.x, v[j].y * rstd * gg.y) | ((unsigned long long)pkbf(v[j].z * rstd * gg.z, v[j].w * rstd * gg.w) << 32); }
}
__device__ __forceinline__ void rms_row_4096_bf16(const bf16* xrow, const float* g, bf16* orow, int lane) {
    const GAS v4u* xr = (const GAS v4u*)xrow + lane; float x[64]; float s = 0.f;
#pragma unroll
    for (int j = 0; j < 8; ++j) { const v4u w = xr[64 * j]; const unsigned ww[4] = {w.x, w.y, w.z, w.w};
#pragma unroll
        for (int e = 0; e < 4; ++e) { x[8 * j + 2 * e] = __uint_as_float(ww[e] << 16); x[8 * j + 2 * e + 1] = __uint_as_float(ww[e] & 0xffff0000u); } }
#pragma unroll
    for (int i = 0; i < 64; ++i) s += x[i] * x[i];
    const float rstd = 1.0f / sqrtf(wave_sum(s) * (1.f / 4096.f) + EPS);
#pragma unroll
    for (int j = 0; j < 8; ++j) { const GAS f32x4* gp = (const GAS f32x4*)(g + 8 * (64 * j + lane)); const f32x4 g0 = gp[0], g1 = gp[1];
        v4u o; o.x = pkbf(x[8 * j] * rstd * g0.x, x[8 * j + 1] * rstd * g0.y); o.y = pkbf(x[8 * j + 2] * rstd * g0.z, x[8 * j + 3] * rstd * g0.w);
        o.z = pkbf(x[8 * j + 4] * rstd * g1.x, x[8 * j + 5] * rstd * g1.y); o.w = pkbf(x[8 * j + 6] * rstd * g1.z, x[8 * j + 7] * rstd * g1.w);
        *((GAS v4u*)orow + 64 * j + lane) = o; }
}
__device__ __forceinline__ void cache_rows_to_bf16(const float* src, bf16* dst, int W, int gthread, int nthreads) {
    const int per_row = W >> 2; const long total = (long)8 * PAST * per_row;
    for (long i = gthread; i < total; i += nthreads) {
        const int row = (int)(i / per_row), c4 = (int)(i % per_row), b = row >> 10, j = row & 1023;
        const f32x4 v = *(const GAS f32x4*)(src + (size_t)row * W + c4 * 4);
        *(GAS unsigned long long*)(dst + (size_t)(NP + b * SKVS + j) * W + c4 * 4) = (unsigned long long)pkbf(v.x, v.y) | ((unsigned long long)pkbf(v.z, v.w) << 32);
    }
}

template <bool NORM, class Order>
__device__ __forceinline__ void tail_reduce_res(const Order& S, const float* resP, const float* resS, float* out, bf16* HB, float* ssq, const float* ssqm, const float* ssqs, bf16* YB, int tid) {
    if (S.nsplit == 1) return;
    const int wid = __builtin_amdgcn_readfirstlane(tid >> 6), lane = tid & 63, wr = wid >> 2, wc = wid & 3, fr = lane & 15, fq = lane >> 4;
    const int j = S.c / S.nsplit, p = S.c % S.nsplit, per = 32 / S.nsplit;
    pg8::Unit u; S.map(S.nfull * S.G + j, u);
    for (int ii = 0; ii < per; ++ii) {
        const int idx = p * per + ii, a = idx >> 4, b = (idx >> 3) & 1, mm = (idx >> 1) & 3, n = idx & 1;
        const int row = u.pm * 256 + a * 128 + wr * 64 + mm * 16 + fr, col = u.pn * 256 + b * 128 + wc * 32 + 8 * fq + 4 * n;
        f32x4 s = {0.f, 0.f, 0.f, 0.f}, s2 = {0.f, 0.f, 0.f, 0.f};
        for (int sp = 0; sp < S.nsplit; ++sp) { const f32x4 v = *((const GAS f32x4*)(S.slab + (size_t)(j * S.nsplit + sp) * 65536) + (size_t)wid * 2048 + idx * 64 + lane); if (2 * sp < S.nsplit) s += v; else s2 += v; }
        if (NORM) {
            const float rm = 1.0f / sqrtf(__hip_atomic_load(ssqm + row, __ATOMIC_RELAXED, __HIP_MEMORY_SCOPE_AGENT) * (1.f / 2048.f) + EPS), rs = 1.0f / sqrtf(__hip_atomic_load(ssqs + row, __ATOMIC_RELAXED, __HIP_MEMORY_SCOPE_AGENT) * (1.f / 2048.f) + EPS);
            s = s * rm + s2 * rs; } else s += s2;
        f32x4 v;
        if (NORM) { if (YB) { const unsigned long long h = *(const GAS unsigned long long*)(YB + (size_t)row * DM + col); const unsigned h0 = (unsigned)h, h1 = (unsigned)(h >> 32);
                                v = (f32x4){__uint_as_float(h0 << 16), __uint_as_float(h0 & 0xffff0000u), __uint_as_float(h1 << 16), __uint_as_float(h1 & 0xffff0000u)} + s; }
                    else { const float* rp = (row >= NP) ? resS + (size_t)(row - NP) * DM + col : resP + (size_t)row * DM + col; v = *(const GAS f32x4*)rp + s; } }
        else { const unsigned long long h = *(const GAS unsigned long long*)(HB + (size_t)row * DM + col); const unsigned h0 = (unsigned)h, h1 = (unsigned)(h >> 32);
               v = (f32x4){__uint_as_float(h0 << 16), __uint_as_float(h0 & 0xffff0000u), __uint_as_float(h1 << 16), __uint_as_float(h1 & 0xffff0000u)} + s;
               if (YB) { *(GAS unsigned long long*)(YB + (size_t)row * DM + col) = (unsigned long long)pkbf(v.x, v.y) | ((unsigned long long)pkbf(v.z, v.w) << 32);
                         float q = (v.x * v.x + v.y * v.y) + (v.z * v.z + v.w * v.w); q += __shfl_xor(q, 16); q += __shfl_xor(q, 32);
                         if (fq == 0) __hip_atomic_fetch_add(ssq + row, q, __ATOMIC_RELAXED, __HIP_MEMORY_SCOPE_AGENT); }
               else *(GAS f32x4*)(out + (size_t)row * DM + col) = v; }
        if (NORM) {
            *(GAS unsigned long long*)(HB + (size_t)row * DM + col) = (unsigned long long)pkbf(v.x, v.y) | ((unsigned long long)pkbf(v.z, v.w) << 32);
            float q = (v.x * v.x + v.y * v.y) + (v.z * v.z + v.w * v.w); q += __shfl_xor(q, 16); q += __shfl_xor(q, 32);
            if (fq == 0) __hip_atomic_fetch_add(ssq + row, q, __ATOMIC_RELAXED, __HIP_MEMORY_SCOPE_AGENT);
        }
    }
}

__global__ void __launch_bounds__(NWAVES * 64, 2) hymba_fwd(Args args) {
    extern __shared__ __attribute__((aligned(16))) unsigned char lds[];
    Frame F;
    F.lds = (LAS unsigned char*)lds;
    F.MISC = (volatile LAS unsigned*)(F.lds + MISC_OFF);
    F.tid = threadIdx.x; F.lane = F.tid & 63; F.wave = __builtin_amdgcn_readfirstlane(F.tid >> 6);
    F.G = gridDim.x; { const int bx = blockIdx.x; F.vcu = (F.G % 8 == 0) ? (bx % 8) * (F.G / 8) + bx / 8 : bx; }
    unsigned char* ws = args.ws;
    F.ctl = (gu32*)(ws + WS_CTL);
    for (int u = F.tid; u < (LDS_BYTES - LDSCTL_OFF) / 4; u += NWAVES * 64) ((LAS unsigned*)(F.lds + LDSCTL_OFF))[u] = 0u;
    __syncthreads();
    XcdBarrier bar = xcd_barrier_post((unsigned*)(F.ctl + CW_BAR), F.MISC + 8);
#ifndef G5_WGM
#define G5_WGM 8
#endif
#ifndef PROBE_MASK
#define PROBE_MASK 0
#endif
#ifndef PROBE_BAR
#define PROBE_BAR 1
#endif
#ifndef PHMASK
#define PHMASK 0x3fff
#endif
#define GRID_BAR() do { for (int br_ = 0; br_ < PROBE_BAR; ++br_) xcd_barrier(bar); } while (0)
#define PHASE_PTRS() unsigned long long zoff_ = 0; asm volatile("" : "+s"(zoff_)); unsigned char* const wsb = args.ws + zoff_; float* const OUT = args.out + zoff_;     int ptid_ = threadIdx.x; asm volatile("" : "+v"(ptid_)); int bx_ = blockIdx.x, G_ = gridDim.x; asm volatile("" : "+s"(bx_), "+s"(G_)); const int VCU = (G_ % 8 == 0) ? (bx_ % 8) * (G_ / 8) + bx_ / 8 : bx_; (void)VCU; \
    const int LANE = ptid_ & 63, WAVE = __builtin_amdgcn_readfirstlane(ptid_ >> 6); const int gw = VCU * NWAVES + WAVE, NGW = G_ * NWAVES; const int gthread = gw * 64 + LANE, nthreads = NGW * 64; (void)gthread; (void)nthreads; (void)gw; (void)NGW; (void)LANE
#define WIN_T ((bf16*)(wsb + WS_WIN))
#define WQB_T ((bf16*)(wsb + WS_WQB))
#define WKVB_T ((bf16*)(wsb + WS_WKVB))
#define WO_T ((bf16*)(wsb + WS_WO))
#define WUP_T ((bf16*)(wsb + WS_WUP))
#define WDN_T0 ((bf16*)(wsb + WS_WDN))
#define WDN_T1 ((bf16*)(wsb + WS_WDN1))
#define XN ((bf16*)(wsb + WS_XN))
#define UB ((bf16*)(wsb + WS_U))
#define QLAT ((bf16*)(wsb + WS_QLAT))
#define AKV ((bf16*)(wsb + WS_AKV))
#define KROPE ((bf16*)(wsb + WS_KROPE))
#define VB ((bf16*)(wsb + WS_VB))
#define QB ((bf16*)(wsb + WS_QB))
#define KN ((bf16*)(wsb + WS_KN))
#define SBQ ((bf16*)(wsb + WS_SBQ))
#define SBK ((bf16*)(wsb + WS_SBK))
#define SBV ((bf16*)(wsb + WS_SBV))
#define LAT ((float*)(wsb + WS_LAT))
#define QRAW ((float*)(wsb + WS_QRAW))
#define KNRAW ((float*)(wsb + WS_KNRAW))
#define MLAO ((bf16*)(wsb + WS_MLAO))
#define SBO ((bf16*)(wsb + WS_SBO))
#define MERGED ((bf16*)(wsb + WS_MERGED))
#define TAB ((f32x2*)(wsb + WS_TAB))
#define SLAB ((float*)(wsb + WS_SLAB))
#define Y0B ((bf16*)(wsb + WS_Y0B))
#define SSQH ((float*)(wsb + WS_SSQH))
#define SSQM ((float*)(wsb + WS_SSQH + 128 * 1024))
#define SSQS ((float*)(wsb + WS_SSQH + 256 * 1024))
#define SSQP ((float*)(wsb + WS_SSQP))
#define SSQY ((float*)(wsb + WS_SSQH + 384 * 1024))

    { PHASE_PTRS(); (void)OUT;
    for (int i = gthread; i < SEQ * 32; i += nthreads) {
        const int pos = i >> 5, k = i & 31;
        const float inv_freq = exp2f(-(float)k * (13.287712379549449f / 32.f));
        float s, c; sincos_acc((float)pos * inv_freq, s, c); TAB[i] = (f32x2){c, s};
    } }

#define CONVERT_ITEMS(LW, R_LO, R_HI, GWV, NGWV) do { \
        const float* w_in = args.in[7] + (size_t)(LW) * DM * 7744; const float* w_qb = args.in[9] + (size_t)(LW) * QLORA * 3072; \
        const float* w_kvb = args.in[11] + (size_t)(LW) * KVLORA * 4096; const float* w_o = args.in[18] + (size_t)(LW) * DM * DM; \
        const float* w_up = args.in[20] + (size_t)(LW) * DM * DFF; const float* w_dn = args.in[21] + (size_t)(LW) * DFF * DM; const int lw_ = (LW); \
        auto dec_ = [&](int it) -> TItem { \
                int r = (R_HI) - 1 - it; \
                if (r < I_IN) { const int kb = r / 242, nb = r % 242, n0 = nb * 32; return TItem{w_in + (size_t)(kb * 64) * 7744 + n0, WIN_T + (size_t)(n0 + (n0 >= 1600 ? 192 : 0)) * DM + kb * 64, lw_ ? args.in[6] + (size_t)lw_ * DM + kb * 64 : nullptr, 7744, DM}; } r -= I_IN; \
                if (r < I_QB) { const int kb = r / 96, nb = r % 96, n0 = nb * 32, h = n0 / 192, dd = n0 % 192; \
                    return TItem{w_qb + (size_t)(kb * 64) * 3072 + n0, WQB_T + (size_t)(dd < 128 ? h * 128 + dd : 2048 + (h >> 2) * 256 + ((dd - 128) >> 5) * 128 + (h & 3) * 32) * QLORA + kb * 64, nullptr, 3072, QLORA}; } r -= I_QB; \
                if (r < I_KVB) { const int kb = r / 128, nb = r % 128, n0 = nb * 32, h = n0 >> 8, dd = n0 & 255; \
                    return TItem{w_kvb + (size_t)(kb * 64) * 4096 + n0, WKVB_T + (size_t)(dd < 128 ? h * 128 + dd : 2048 + h * 128 + (dd - 128)) * KVLORA + kb * 64, nullptr, 4096, KVLORA}; } r -= I_KVB; \
                if (r < I_O) { const int kb = r / 128, nb = r % 128; \
                    return TItem{w_o + (size_t)(kb * 64) * DM + nb * 32, WO_T + (size_t)(nb * 32) * DM + kb * 64, (kb < 32 ? args.in[16] + (size_t)lw_ * 2048 : args.in[17] + (size_t)lw_ * 2048 - 2048) + kb * 64, DM, DM}; } r -= I_O; \
                if (r < I_UP) { const int kb = r / 512, nb = r % 512; return TItem{w_up + (size_t)(kb * 64) * DFF + nb * 32, WUP_T + (size_t)(nb * 32) * DM + kb * 64, args.in[19] + (size_t)lw_ * DM + kb * 64, DFF, DM}; } r -= I_UP; \
                { const int kb = r / 128, nb = r % 128; return TItem{w_dn + (size_t)(kb * 64) * DM + nb * 32, (lw_ ? WDN_T1 : WDN_T0) + ((size_t)((nb >> 3) * 256 + kb) * 256 + (nb & 7) * 32) * 64, nullptr, DM, 64}; } }; \
        const int n_ = (R_HI) - (R_LO); int it = (GWV); \
        if (it < n_) { \
            float tA[32], tB[32]; f32x4 gA0, gA1, gB0, gB1; \
            TItem PA = dec_(it), PB; ti_load(PA, tA, gA0, gA1, LANE); \
            for (;;) {                                     \
                const int it1 = it + (NGWV); PB = dec_(it1 < n_ ? it1 : it); ti_load(PB, tB, gB0, gB1, LANE); \
                ti_finish(PA, tA, gA0, gA1, scr, LANE); \
                if (it1 >= n_) break; \
                const int it2 = it1 + (NGWV); PA = dec_(it2 < n_ ? it2 : it1); ti_load(PA, tA, gA0, gA1, LANE); \
                ti_finish(PB, tB, gB0, gB1, scr, LANE); \
                if (it2 >= n_) break; \
                it = it2; \
            } } } while (0)
    constexpr int I_IN = 64 * 242, I_QB = 16 * 96, I_KVB = 8 * 128, I_O = 64 * 128, I_UP = 64 * 512, I_DN = 256 * 128;
    constexpr int NITEMS = I_IN + I_QB + I_KVB + I_O + I_UP + I_DN, EARLY_ITEMS = I_IN + I_QB + I_KVB + I_O, EARLY0_ITEMS = I_IN + I_QB + I_KVB;
#pragma unroll 1
    for (int l = 0; l < 2; ++l) {
        if (l == 0 || gridDim.x != 256) {
        for (int rep_ = 0; rep_ < (((PROBE_MASK >> 0) & 1) ? 2 : 1); ++rep_) if constexpr ((PHMASK >> 0) & 1) {
            PHASE_PTRS(); (void)OUT;
            LAS float* scr = (LAS float*)(F.lds + RING_OFF + WAVE * 16384);
            const bool early_ok = (G_ == 256);
            CONVERT_ITEMS(l, (l > 0 && early_ok) ? NITEMS : 0, (l == 0 && early_ok) ? EARLY0_ITEMS : NITEMS, gw, NGW);
            if (l == 0) {
            { unsigned zz = 0u; asm volatile("" : "+v"(zz)); const v4u z4 = {zz, zz, zz, zz};
              for (int i = gthread; i < 192 * DM / 8; i += nthreads) *(GAS v4u*)(WIN_T + (size_t)1600 * DM + (size_t)i * 8) = z4; }
            cache_rows_to_bf16(args.in[2] + (size_t)l * 8 * PAST * KVLORA, AKV, KVLORA, gthread, nthreads);
            cache_rows_to_bf16(args.in[3] + (size_t)l * 8 * PAST * ROPE, KROPE, ROPE, gthread, nthreads);
            const float* g = args.in[6] + (size_t)l * DM;
            for (int m = gw; m < MTOK; m += NGW) rms_row_4096(m < NP ? args.in[0] + (size_t)m * DM : args.in[1] + (size_t)(m - NP) * DM, g, XN + (size_t)m * DM, LANE);
            }
        }
        GRID_BAR();
        }
        for (int rep_ = 0; rep_ < (((PROBE_MASK >> 1) & 1) ? 2 : 1); ++rep_) if constexpr ((PHMASK >> 1) & 1) {
            PHASE_PTRS(); (void)OUT;
            pg8::Gemm g{l == 0 ? XN : Y0B, WIN_T, MTOK, NINP, DM, nullptr}; pg8::InOrder S; S.init3(MTOK, NINP, G_, bx_);
            pg8::EpiIn E{LAT, SBQ, SBK, SBV, OUT + O_SBK_P + (size_t)l * NP * 2048, OUT + O_SBV_P + (size_t)l * NP * 2048,
                         OUT + O_SBK_S + (size_t)l * NS * 2048, OUT + O_SBV_S + (size_t)l * NS * 2048, QS_SB, l == 0 ? nullptr : SSQY, EPS};
            const bool bg = (l == 0 && G_ == 256);
            const int rsplit = bg ? ((bx_ & 7) >> 1) : 0;
#pragma unroll 1
            for (int seg = 0; seg < 2; ++seg) {
                pg8::SubRange<pg8::InOrder> SS{S, seg ? rsplit : 0, seg ? (1 << 30) : rsplit};
                pg8::gemm_phase<pg8::EpiIn, pg8::SubRange<pg8::InOrder>, true, true>(F.lds + RING_OFF, g, SS, E);
                if (seg == 0 && bg) {
                    LAS float* scr = (LAS float*)(F.lds + RING_OFF + WAVE * 16384);
                    CONVERT_ITEMS(0, EARLY0_ITEMS, NITEMS, gw, NGW);
                    __syncthreads();
                }
            }
        }
        GRID_BAR();
        for (int rep_ = 0; rep_ < (((PROBE_MASK >> 2) & 1) ? 2 : 1); ++rep_) if constexpr ((PHMASK >> 2) & 1) {
            PHASE_PTRS(); (void)OUT;
            for (int i = gthread; i < MTOK; i += nthreads) { SSQH[i] = 0.f; SSQM[i] = 0.f; SSQS[i] = 0.f; if (l == 0) SSQY[i] = 0.f; }
            const float* g_q_a = args.in[8] + (size_t)l * QLORA; const float* g_kv_a = args.in[10] + (size_t)l * KVLORA; const float* g_k_rope = args.in[15] + (size_t)l * ROPE;
            for (int m = gw; m < MTOK; m += NGW) {
                const float* lr = LAT + (size_t)m * 1792; const int kvr = kvrow_of(m), pos = pos_of(m);
                {
                    f32x4 v[4]; float s = 0.f;
#pragma unroll
                    for (int j = 0; j < 4; ++j) { v[j] = *(const GAS f32x4*)(lr + 4 * (64 * j + LANE)); s += (v[j].x * v[j].x + v[j].y * v[j].y) + (v[j].z * v[j].z + v[j].w * v[j].w); }
                    const float rstd = 1.0f / sqrtf(wave_sum(s) * (1.f / 1024.f) + EPS);
#pragma unroll
                    for (int j = 0; j < 4; ++j) { const f32x4 gg = *(const GAS f32x4*)(g_q_a + 4 * (64 * j + LANE));
                        *(GAS unsigned long long*)(QLAT + (size_t)m * QLORA + 4 * (64 * j + LANE)) =
                            (unsigned long long)pkbf(v[j].x * rstd * gg.x, v[j].y * rstd * gg.y) | ((unsigned long long)pkbf(v[j].z * rstd * gg.z, v[j].w * rstd * gg.w) << 32); }
                }
                {
                    f32x4 v[2]; float s = 0.f;
#pragma unroll
                    for (int j = 0; j < 2; ++j) { v[j] = *(const GAS f32x4*)(lr + 1024 + 4 * (64 * j + LANE)); s += (v[j].x * v[j].x + v[j].y * v[j].y) + (v[j].z * v[j].z + v[j].w * v[j].w); }
                    const float rstd = 1.0f / sqrtf(wave_sum(s) * (1.f / 512.f) + EPS);
                    float* oc = (m < NP) ? OUT + O_CKV_P + ((size_t)l * NP + m) * KVLORA : OUT + O_CKV_S + ((size_t)l * NS + (m - NP)) * KVLORA;
#pragma unroll
                    for (int j = 0; j < 2; ++j) { const f32x4 gg = *(const GAS f32x4*)(g_kv_a + 4 * (64 * j + LANE));
                        const f32x4 c = {v[j].x * rstd * gg.x, v[j].y * rstd * gg.y, v[j].z * rstd * gg.z, v[j].w * rstd * gg.w};
                        *(GAS f32x4*)(oc + 4 * (64 * j + LANE)) = c;
                        *(GAS unsigned long long*)(AKV + (size_t)kvr * KVLORA + 4 * (64 * j + LANE)) = (unsigned long long)pkbf(c.x, c.y) | ((unsigned long long)pkbf(c.z, c.w) << 32); }
                }
                {
                    const float x = lr[1536 + LANE];
                    const float rstd = 1.0f / sqrtf(wave_sum(x * x) * (1.f / 64.f) + EPS);
                    const float xn = x * rstd * g_k_rope[LANE]; const float xp = __shfl_xor(xn, 32);
                    const f32x2 cs = TAB[pos * 32 + (LANE & 31)];
                    const float o = (LANE < 32) ? xn * cs.x - xp * cs.y : xp * cs.y + xn * cs.x;
                    float* okr = (m < NP) ? OUT + O_KR_P + ((size_t)l * NP + m) * ROPE : OUT + O_KR_S + ((size_t)l * NS + (m - NP)) * ROPE;
                    okr[LANE] = o;
                    const float on = __shfl_xor(o, 1);
                    if ((LANE & 1) == 0) *(GAS unsigned*)(KROPE + (size_t)kvr * ROPE + LANE) = pkbf(o, on);
                }
            }
        }
        GRID_BAR();
        for (int rep_ = 0; rep_ < (((PROBE_MASK >> 3) & 1) ? 2 : 1); ++rep_) if constexpr ((PHMASK >> 3) & 1) {
            PHASE_PTRS(); (void)OUT;
            pg8::Gemm g{QLAT, WQB_T, MTOK, 3072, QLORA, nullptr}; pg8::StaticOrder S; S.init(MTOK, 3072, G_, bx_);
            pg8::EpiQb E{QB, args.in[12] + (size_t)l * NOPE, args.in[13] + (size_t)l * ROPE, TAB, (LAS float*)(F.lds + XCH_OFF), QS_MLA, EPS};
            pg8::gemm_phase<pg8::EpiQb, pg8::StaticOrder, true, true>(F.lds + RING_OFF, g, S, E);
        }
        for (int rep_ = 0; rep_ < (((PROBE_MASK >> 11) & 1) ? 2 : 1); ++rep_) if constexpr ((PHMASK >> 11) & 1) {
            PHASE_PTRS(); (void)OUT;
            pg8::Gemm g{AKV, WKVB_T, KVROWS, 4096, KVLORA, nullptr}; pg8::StaticOrder S; S.init(KVROWS, 4096, G_, (bx_ + G_ - 24) % G_);
            pg8::EpiKvbN E{KN, VB, args.in[14] + (size_t)l * NOPE, (LAS float*)(F.lds + XCH_OFF), EPS};
            pg8::gemm_phase<pg8::EpiKvbN, pg8::StaticOrder, true, true>(F.lds + RING_OFF, g, S, E);
        }
        GRID_BAR();
        for (int rep_ = 0; rep_ < (((PROBE_MASK >> 5) & 1) ? 2 : 1); ++rep_) if constexpr ((PHMASK >> 5) & 1) {
            PHASE_PTRS(); (void)OUT;
            const int v = VCU, bh = v >> 2, b = bh >> 4, h = bh & 15, s = v & 3;
            ALAS char* al = (ALAS char*)(F.lds + RING_OFF);
#pragma unroll 1
            for (int k = 0; k < 5; ++k) {
                att::Unit u;
                if (k < 4) { const int qb = (k == 0) ? s : (k == 1) ? 7 - s : (k == 2) ? 8 + s : 15 - s; const size_t m0 = (size_t)b * SEQ + (size_t)qb * 256, kv0 = (size_t)b * SEQ;
                    u.Q = QB + m0 * 3072 + h * 192; u.ldq = 3072; u.K = KN + kv0 * 2048 + h * 128; u.Kr = KROPE + kv0 * ROPE; u.V = VB + kv0 * 2048 + h * 128;
                    u.O = MERGED + m0 * 4096 + h * 128; u.ldo = 4096; u.ssq = SSQP + m0 * 32 + h; u.Kf0 = u.Vf0 = u.Kf1 = u.Vf1 = nullptr; u.split = 0; u.P0 = qb * 256; u.NT = 4 * qb + 4; u.nact = 8; }
                else { if (v >= 128) break; const int sb = v >> 4, sh = v & 15; const size_t m0 = (size_t)NP + (size_t)sb * 64, kv0 = (size_t)NP + (size_t)sb * SKVS;
                    u.Q = QB + m0 * 3072 + sh * 192; u.ldq = 3072; u.K = KN + kv0 * 2048 + sh * 128; u.Kr = KROPE + kv0 * ROPE; u.V = VB + kv0 * 2048 + sh * 128;
                    u.O = MERGED + m0 * 4096 + sh * 128; u.ldo = 4096; u.ssq = SSQP + m0 * 32 + sh; u.Kf0 = u.Vf0 = u.Kf1 = u.Vf1 = nullptr; u.split = 0; u.P0 = PAST; u.NT = 17; u.nact = 2; }
                if constexpr ((PHMASK >> 12) & 1) att::mla_unit_dma<0>(u, al);
            }
#pragma unroll 1
            for (int k = 0; k < 5; ++k) {
                att::Unit u;
                if (k < 4) { const int qb = (k == 0) ? s : (k == 1) ? 7 - s : (k == 2) ? 8 + s : 15 - s; const size_t m0 = (size_t)b * SEQ + (size_t)qb * 256, kv0 = (size_t)b * SEQ;
                    u.Q = SBQ + m0 * 2048 + h * 128; u.ldq = 2048; u.K = nullptr; u.Kr = nullptr; u.V = nullptr; u.split = 1 << 30;
                    u.Kf0 = OUT + O_SBK_P + ((size_t)l * NP + kv0) * 2048 + h * 128; u.Vf0 = OUT + O_SBV_P + ((size_t)l * NP + kv0) * 2048 + h * 128; u.Kf1 = u.Kf0; u.Vf1 = u.Vf0;
                    u.O = MERGED + m0 * 4096 + 2048 + h * 128; u.ldo = 4096; u.ssq = SSQP + m0 * 32 + 16 + h; u.P0 = qb * 256; u.NT = 4 * qb + 4; u.nact = 8; }
                else { if (v < 128) break; const int w = v - 128, sb = w >> 4, sh = w & 15; const size_t m0 = (size_t)NP + (size_t)sb * 64, kv0 = (size_t)NP + (size_t)sb * SKVS;
                    u.Q = SBQ + m0 * 2048 + sh * 128; u.ldq = 2048; u.K = nullptr; u.Kr = nullptr; u.V = nullptr; u.split = PAST / 64;
                    u.Kf0 = args.in[4] + ((size_t)(l * 8 + sb) * PAST) * 2048 + sh * 128; u.Vf0 = args.in[5] + ((size_t)(l * 8 + sb) * PAST) * 2048 + sh * 128;
                    u.Kf1 = OUT + O_SBK_S + ((size_t)l * NS + (size_t)sb * 64) * 2048 + sh * 128; u.Vf1 = OUT + O_SBV_S + ((size_t)l * NS + (size_t)sb * 64) * 2048 + sh * 128;
                    u.O = MERGED + m0 * 4096 + 2048 + sh * 128; u.ldo = 4096; u.ssq = SSQP + m0 * 32 + 16 + sh; u.P0 = PAST; u.NT = 17; u.nact = 2; }
                if constexpr ((PHMASK >> 13) & 1) att::attn_unit<false>(u, al);
            }
        }
        GRID_BAR();
#if !ATT_SSQ_ATOMICS
        {
            PHASE_PTRS(); (void)OUT;
            for (int i = gthread; i < MTOK * 2; i += nthreads) { const int m = i >> 1, half = i & 1; const GAS f32x4* p = (const GAS f32x4*)(SSQP + (size_t)m * 32 + half * 16);
                const f32x4 a = p[0], b = p[1], c = p[2], d = p[3];
                const float s = (((a.x + a.y) + (a.z + a.w)) + ((b.x + b.y) + (b.z + b.w))) + (((c.x + c.y) + (c.z + c.w)) + ((d.x + d.y) + (d.z + d.w)));
                (half ? SSQS : SSQM)[m] = s; }
        }
        GRID_BAR();
#endif
        for (int rep_ = 0; rep_ < (((PROBE_MASK >> 7) & 1) ? 2 : 1); ++rep_) if constexpr ((PHMASK >> 7) & 1) {
            PHASE_PTRS(); (void)OUT;
            pg8::Gemm g{MERGED, WO_T, MTOK, DM, DM, SLAB}; pg8::PanelOrder S; S.init3(MTOK, DM, DM, G_, bx_, SLAB, 2);
            pg8::EpiResP<true> E{args.in[0], args.in[1], nullptr, XN, SSQH, SSQM, SSQS, EPS, l == 0 ? nullptr : Y0B};
            pg8::gemm_phase<pg8::EpiResP<true>, pg8::PanelOrder, true, true>(F.lds + RING_OFF, g, S, E);
        }
        GRID_BAR();
        {
            PHASE_PTRS(); pg8::PanelOrder S; S.init3(MTOK, DM, DM, G_, bx_, SLAB, 2);
            tail_reduce_res<true>(S, args.in[0], args.in[1], nullptr, XN, SSQH, SSQM, SSQS, l == 0 ? nullptr : Y0B, ptid_);
        }
        GRID_BAR();
        for (int rep_ = 0; rep_ < (((PROBE_MASK >> 9) & 1) ? 2 : 1); ++rep_) if constexpr ((PHMASK >> 9) & 1) {
            PHASE_PTRS(); (void)OUT;
            pg8::Gemm g{XN, WUP_T, MTOK, DFF, DM, nullptr}; pg8::UpOrder S; S.init3(MTOK, DFF, G_, bx_);
            pg8::EpiRelu2N E{UB, DFF, SSQH, EPS};
            pg8::gemm_phase<pg8::EpiRelu2N, pg8::UpOrder, true, true>(F.lds + RING_OFF, g, S, E);
            if (l + 1 < 2 && G_ == 256 && bx_ >= 128) {
                LAS float* scr = (LAS float*)(F.lds + RING_OFF + WAVE * 16384);
                CONVERT_ITEMS(l + 1, 0, EARLY_ITEMS, (bx_ - 128) * NWAVES + WAVE, 128 * NWAVES);
            }
        }
        GRID_BAR();
        for (int rep_ = 0; rep_ < (((PROBE_MASK >> 10) & 1) ? 2 : 1); ++rep_) if constexpr ((PHMASK >> 10) & 1) {
            PHASE_PTRS(); (void)OUT;
            pg8::Gemm g{UB, l == 0 ? WDN_T0 : WDN_T1, MTOK, DM, DFF, SLAB, 1};     pg8::PanelOrder S; S.init3(MTOK, DM, DFF, G_, bx_, SLAB);
            pg8::EpiResP<false> E{nullptr, nullptr, OUT + O_Y, XN, SSQY, nullptr, nullptr, EPS, l == 1 ? nullptr : Y0B};
            const bool bg = (l + 1 < 2 && G_ == 256);
            const int rsplit = bg ? ((bx_ & 7) >> 1) : 0;
#pragma unroll 1
            for (int seg = 0; seg < 2; ++seg) {
                pg8::SubRange<pg8::PanelOrder> SS{S, seg ? rsplit : 0, seg ? (1 << 30) : rsplit};
                pg8::gemm_phase<pg8::EpiResP<false>, pg8::SubRange<pg8::PanelOrder>, true, true>(F.lds + RING_OFF, g, SS, E);
                if (seg == 0 && bg) {
                    LAS float* scr = (LAS float*)(F.lds + RING_OFF + WAVE * 16384);
                    CONVERT_ITEMS(l + 1, EARLY_ITEMS, NITEMS, gw, NGW);
                    __syncthreads();
                }
            }
        }
        GRID_BAR();
        {
            PHASE_PTRS(); pg8::PanelOrder S; S.init3(MTOK, DM, DFF, G_, bx_, SLAB);
            tail_reduce_res<false>(S, nullptr, nullptr, OUT + O_Y, XN, SSQY, nullptr, nullptr, l == 1 ? nullptr : Y0B, ptid_);
            if (l + 1 < 2) {
                cache_rows_to_bf16(args.in[2] + (size_t)(l + 1) * 8 * PAST * KVLORA, AKV, KVLORA, gthread, nthreads);
                cache_rows_to_bf16(args.in[3] + (size_t)(l + 1) * 8 * PAST * ROPE, KROPE, ROPE, gthread, nthreads);
            }
        }
        GRID_BAR();
    }
#undef GRID_BAR
}

extern "C" void kernel_launch(void* const* d_in, const int* in_sizes, int n_in, void* d_out, int out_size, void* d_ws, size_t ws_size, hipStream_t stream) {
    static int grid = 0;
    if (grid == 0) {
        if (n_in != 22 || (size_t)out_size != O_END || ws_size < WS_END) { fprintf(stderr, "kernel_launch: unexpected shapes: n_in %d out %d ws %zu (need %zu)\n", n_in, out_size, ws_size, (size_t)WS_END); grid = -1; return; }
        int dev = 0, cus = 0, per_cu = 0;
        if (hipGetDevice(&dev) != hipSuccess || hipDeviceGetAttribute(&cus, hipDeviceAttributeMultiprocessorCount, dev) != hipSuccess) { grid = -1; return; }
        if (hipFuncSetAttribute((const void*)hymba_fwd, hipFuncAttributeMaxDynamicSharedMemorySize, LDS_BYTES) != hipSuccess) { fprintf(stderr, "kernel_launch: hipFuncSetAttribute failed\n"); grid = -1; return; }
        if (hipOccupancyMaxActiveBlocksPerMultiprocessor(&per_cu, (const void*)hymba_fwd, NWAVES * 64, LDS_BYTES) != hipSuccess || per_cu < 1) { fprintf(stderr, "kernel_launch: occupancy query reports %d\n", per_cu); }
        (void)hipGetLastError();
        grid = cus;
        if (grid != 256) fprintf(stderr, "kernel_launch: %d CUs (the attention deal assumes 256 workgroups)\n", grid);
    }
    if (grid < 0) return;
    if (hipMemsetAsync((char*)d_ws + WS_CTL, 0, CTL_ZERO_BYTES, stream) != hipSuccess) return;
    Args a{};
    for (int i = 0; i < 22; ++i) a.in[i] = (const float*)d_in[i];
    a.out = (float*)d_out; a.ws = (unsigned char*)d_ws;
    hipLaunchKernelGGL(hymba_fwd, dim3(grid), dim3(NWAVES * 64), LDS_BYTES, stream, a);
}
```

```cpp
#include <hip/hip_runtime.h>
#include <cstdio>
#include <cstdint>
#include <type_traits>
namespace pg8 {
#define PG8_LAS __attribute__((address_space(3)))
typedef unsigned short bf16_t;
typedef short bf16x8 __attribute__((ext_vector_type(8)));
typedef float f32x4 __attribute__((ext_vector_type(4)));
typedef unsigned u32x4 __attribute__((ext_vector_type(4)));
constexpr int BM = 256, BK = 64, HALF = 128, HTB = HALF * BK * 2  , STAGE_BYTES = 8 * HTB, NXCD = 8, WGM = 8;

__host__ __device__ __forceinline__ int lds_byte(int r, int c) { const int st = (r >> 4) * 2 + (c >> 5), rr = r & 15, cc = c & 31, ob = rr * 64 + cc * 2; return st * 1024 + (ob ^ (((ob >> 9) & 1) << 5)); }
__host__ __device__ __forceinline__ void stage_rc(int b, int& R, int& C) { const int st = b / 1024, sb = b % 1024, swz = sb ^ (((sb >> 9) & 1) << 5); R = (st >> 1) * 16 + swz / 64; C = (st & 1) * 32 + (swz % 64) / 2; }
__host__ __device__ __forceinline__ int perm32(int rho) { const int n = rho >> 4, i = rho & 15; return 8 * (i >> 2) + 4 * n + (i & 3); }

struct Unit { int pm, pn, kt0, nkt, part; };
struct Gemm { const bf16_t* A; const bf16_t* Bt; int M, N, K; float* slab; int blocked = 0; };

struct StaticOrder {
    int nM, nN, nwg, G, c, wgm = WGM;
    __host__ __device__ __forceinline__ void init(int M, int N, int G_, int c_) { nM = M / BM; nN = N / BM; nwg = nM * nN; G = G_; c = c_; }
    __host__ __device__ __forceinline__ bool next(int i, Unit& u) const {
        const long L = (long)i * G + c; if (L >= nwg) return false;
        int wgid = (int)L; { const int q = nwg / NXCD, r = nwg % NXCD, xcd = wgid % NXCD, off = wgid / NXCD; wgid = (xcd < r ? xcd * (q + 1) : r * (q + 1) + (xcd - r) * q) + off; }
        const int nig = wgm * nN, gid = wgid / nig, fm = gid * wgm, gsz = (nM - fm) < wgm ? (nM - fm) : wgm;
        u.pm = fm + ((wgid % nig) % gsz); u.pn = (wgid % nig) / gsz; u.kt0 = 0; u.nkt = 0; u.part = -1; return true;
    }
    __host__ __device__ __forceinline__ void map(int L, Unit& u) const {
        int wgid = L; { const int q = nwg / NXCD, r = nwg % NXCD, xcd = wgid % NXCD, off = wgid / NXCD; wgid = (xcd < r ? xcd * (q + 1) : r * (q + 1) + (xcd - r) * q) + off; }
        const int nig = wgm * nN, gid = wgid / nig, fm = gid * wgm, gsz = (nM - fm) < wgm ? (nM - fm) : wgm;
        u.pm = fm + ((wgid % nig) % gsz); u.pn = (wgid % nig) / gsz; u.kt0 = 0; u.nkt = 0; u.part = -1;
    }
    __device__ __forceinline__ void a_ready(const Unit&) const {}
    __device__ __forceinline__ void done(const Unit&) const {}
};

struct InOrder : StaticOrder {
    bool panel;
    __host__ __device__ __forceinline__ void init3(int M, int N, int G_, int c_) { init(M, N, G_, c_); panel = (G_ == 256 && nM == 66 && nN == 31); }
    __host__ __device__ __forceinline__ bool next(int i, Unit& u) const {
        if (!panel) return StaticOrder::next(i, u);
        if (i >= 8) return false;
        const int x = c & 7, idx = c >> 3, g = x >> 2, q = x & 3, pmo = idx & 3, pn = 8 * q + (idx >> 2);
        if (pn < 31) { u.pm = 8 * i + 4 * g + pmo; u.pn = pn; }
        else { const int su = i * 8 + g * 4 + pmo; if (su >= 62) return false; const int hi31 = su >= 31 ? 1 : 0; u.pm = 64 + hi31; u.pn = su - 31 * hi31; }
        u.kt0 = 0; u.nkt = 0; u.part = -1; return true; }
};

struct UpOrder : StaticOrder {
    bool panel;
    __host__ __device__ __forceinline__ void init3(int M, int N, int G_, int c_) { init(M, N, G_, c_); panel = (G_ == 256 && nM == 66 && nN == 64); }
    __host__ __device__ __forceinline__ bool next(int i, Unit& u) const {
        if (!panel) return StaticOrder::next(i, u);
        const int x = c & 7, idx = c >> 3;
        if (i < 16) { u.pm = 4 * (15 - i) + (idx & 3); u.pn = 8 * x + (idx >> 2); }
        else if (i == 16 && c < 128) { u.pm = 64 + (idx & 1); u.pn = 8 * x + (idx >> 1); }
        else return false;
        u.kt0 = 0; u.nkt = 0; u.part = -1; return true; }
};

template <class S_> struct SubRange {
    const S_& s; int lo, hi;
    __device__ __forceinline__ bool next(int i, Unit& u) const { return (lo + i < hi) && s.next(lo + i, u); }
    __device__ __forceinline__ void a_ready(const Unit& u) const { s.a_ready(u); }
    __device__ __forceinline__ void done(const Unit& u) const { s.done(u); }
};

__device__ __forceinline__ unsigned cvt_pk_bf16(float lo, float hi) { unsigned r; asm volatile("v_cvt_pk_bf16_f32 %0, %1, %2" : "=v"(r) : "v"(lo), "v"(hi)); return r; }

struct TailSplitOrder : StaticOrder {
    int nfull, nsplit, nkt_full, halves; float* slab;
    __host__ __device__ __forceinline__ void init2(int M, int N, int K, int G_, int c_, float* slab_, int halves_ = 1) { init(M, N, G_, c_); nkt_full = K / BK; slab = slab_; halves = halves_; nfull = nwg / G; const int rem = nwg - nfull * G;
        nsplit = (rem > 0 && G % rem == 0 && (nkt_full % (2 * (G / rem))) == 0 && nkt_full / (G / rem) >= 4) ? G / rem : 1; }
    __host__ __device__ __forceinline__ bool next(int i, Unit& u) const {
        const int ii = i / halves, hh = i % halves;
        if (ii < nfull || nsplit == 1) { if (!StaticOrder::next(ii, u)) return false; if (halves == 2) { u.nkt = nkt_full / 2; u.kt0 = hh * u.nkt; u.part = hh == 0 ? -2 : -1; } return true; }
        if (ii > nfull || hh != 0) return false;
        const int j = c / nsplit, s = c % nsplit; map(nfull * G + j, u); u.nkt = nkt_full / nsplit; u.kt0 = s * u.nkt; u.part = j * nsplit + s; return true;
    }
};

struct PanelOrder : TailSplitOrder {
    bool panel;
    __host__ __device__ __forceinline__ void init3(int M, int N, int K, int G_, int c_, float* slab_, int halves_ = 1) { init2(M, N, K, G_, c_, slab_, halves_); panel = (G_ == 256 && nM == 66 && nN == 16 && nsplit == 8); }
    __host__ __device__ __forceinline__ void mapu(int L, Unit& u) const {
        if (L < 1024) { const int r = L >> 8, x = L & 7, idx = (L & 255) >> 3; u.pm = 16 * r + 4 * (x >> 1) + (idx & 3); u.pn = 8 * (x & 1) + (idx >> 2); }
        else { const int j = L - 1024; u.pm = 64 + (j & 1); u.pn = j >> 1; }
        u.kt0 = 0; u.nkt = 0; u.part = -1; }
    __host__ __device__ __forceinline__ bool next(int i, Unit& u) const {
        if (!panel) return TailSplitOrder::next(i, u);
        const int ii = i / halves, hh = i % halves;
        if (ii < nfull) { mapu(ii * G + c, u); if (halves == 2) { u.nkt = nkt_full / 2; u.kt0 = hh * u.nkt; u.part = hh == 0 ? -2 : -1; } return true; }
        if (ii > nfull || hh != 0) return false;
        const int j = c / nsplit, s = c % nsplit; mapu(nfull * G + j, u); u.nkt = nkt_full / nsplit; u.kt0 = s * u.nkt; u.part = j * nsplit + s; return true; }
    __host__ __device__ __forceinline__ void map(int L, Unit& u) const { if (panel) mapu(L, u); else TailSplitOrder::map(L, u); }
};

typedef unsigned u32x2 __attribute__((ext_vector_type(2)));
constexpr int HY_NP = 16384;
__device__ __forceinline__ int hy_kvrow(int m) { return m < HY_NP ? m : HY_NP + ((m - HY_NP) >> 6) * 1088 + 1024 + ((m - HY_NP) & 63); }

struct EpiIn {
    static constexpr bool PERM = true, AFTER_DRAIN = false;
    float* LAT; bf16_t* SBQ; bf16_t* SBK; bf16_t* SBV; float* outK_p; float* outV_p; float* outK_s; float* outV_s; float qscale;
    const float* ssq; float eps;
    __device__ __forceinline__ void operator()(const f32x4 (&acc)[2][2][4][2], const Unit& u, int wr, int wc, int fr, int fq) const {
        const int row0 = u.pm * BM + wr * 64 + fr, colw = wc * 32 + 8 * fq, pn = u.pn;
        float rs[2][4];
#pragma unroll
        for (int ai = 0; ai < 2; ++ai)
#pragma unroll
            for (int m = 0; m < 4; ++m) rs[ai][m] = ssq ? 1.0f / sqrtf(__hip_atomic_load(ssq + row0 + ai * HALF + m * 16, __ATOMIC_RELAXED, __HIP_MEMORY_SCOPE_AGENT) * (1.f / 4096.f) + eps) : 1.0f;
        if (pn < 7) {
#pragma unroll
            for (int ai = 0; ai < 2; ++ai)
#pragma unroll
                for (int m = 0; m < 4; ++m) { float* rp = LAT + (size_t)(row0 + ai * HALF + m * 16) * 1792 + pn * BM + colw;
#pragma unroll
                    for (int bj = 0; bj < 2; ++bj) { *(f32x4*)(rp + bj * HALF) = acc[ai][bj][m][0] * rs[ai][m]; *(f32x4*)(rp + bj * HALF + 4) = acc[ai][bj][m][1] * rs[ai][m]; } }
        } else if (pn < 15) {
#pragma unroll
            for (int ai = 0; ai < 2; ++ai)
#pragma unroll
                for (int m = 0; m < 4; ++m) { bf16_t* rp = SBQ + (size_t)(row0 + ai * HALF + m * 16) * 2048 + (pn - 7) * BM + colw;
#pragma unroll
                    for (int bj = 0; bj < 2; ++bj) { const float sc = qscale * rs[ai][m]; const f32x4 v0 = acc[ai][bj][m][0] * sc, v1 = acc[ai][bj][m][1] * sc;
                        u32x4 w; w.x = cvt_pk_bf16(v0[0], v0[1]); w.y = cvt_pk_bf16(v0[2], v0[3]); w.z = cvt_pk_bf16(v1[0], v1[1]); w.w = cvt_pk_bf16(v1[2], v1[3]);
                        *(u32x4*)(rp + bj * HALF) = w; } }
        } else {
            const bool isv = pn >= 23; const int c0 = (pn - (isv ? 23 : 15)) * BM + colw;
            float* fop = isv ? outV_p : outK_p; float* fos = isv ? outV_s : outK_s;
#pragma unroll
            for (int ai = 0; ai < 2; ++ai)
#pragma unroll
                for (int m = 0; m < 4; ++m) { const int row = row0 + ai * HALF + m * 16;
                    float* fo = (row < HY_NP) ? fop + (size_t)row * 2048 : fos + (size_t)(row - HY_NP) * 2048;
                    fo += c0;
#pragma unroll
                    for (int bj = 0; bj < 2; ++bj) { __builtin_nontemporal_store(acc[ai][bj][m][0] * rs[ai][m], (f32x4*)(fo + bj * HALF)); __builtin_nontemporal_store(acc[ai][bj][m][1] * rs[ai][m], (f32x4*)(fo + bj * HALF + 4)); } }
        }
    }
};
struct EpiF32 {
    static constexpr bool PERM = false, AFTER_DRAIN = false;
    float* C; int ldc;
    __device__ __forceinline__ void operator()(const f32x4 (&acc)[2][2][4][2], const Unit& u, int wr, int wc, int fr, int fq) const {
        const int row0 = u.pm * BM + wr * 64 + fr, col0 = u.pn * BM + wc * 32 + 4 * fq;
#pragma unroll
        for (int ai = 0; ai < 2; ++ai)
#pragma unroll
            for (int m = 0; m < 4; ++m) { float* rowp = C + (size_t)(row0 + ai * HALF + m * 16) * ldc + col0;
#pragma unroll
                for (int bj = 0; bj < 2; ++bj)
#pragma unroll
                    for (int n = 0; n < 2; ++n) *(f32x4*)(rowp + bj * HALF + n * 16) = acc[ai][bj][m][n]; }
    }
};
struct EpiKvb {
    static constexpr bool PERM = true, AFTER_DRAIN = false;
    float* KNRAW; bf16_t* VB;
    __device__ __forceinline__ void operator()(const f32x4 (&acc)[2][2][4][2], const Unit& u, int wr, int wc, int fr, int fq) const {
        const int row0 = u.pm * BM + wr * 64 + fr, colw = wc * 32 + 8 * fq, pn = u.pn;
        if (pn < 8) {
#pragma unroll
            for (int ai = 0; ai < 2; ++ai)
#pragma unroll
                for (int m = 0; m < 4; ++m) { float* rp = KNRAW + (size_t)(row0 + ai * HALF + m * 16) * 2048 + pn * BM + colw;
#pragma unroll
                    for (int bj = 0; bj < 2; ++bj) { *(f32x4*)(rp + bj * HALF) = acc[ai][bj][m][0]; *(f32x4*)(rp + bj * HALF + 4) = acc[ai][bj][m][1]; } }
        } else {
#pragma unroll
            for (int ai = 0; ai < 2; ++ai)
#pragma unroll
                for (int m = 0; m < 4; ++m) { bf16_t* rp = VB + (size_t)(row0 + ai * HALF + m * 16) * 2048 + (pn - 8) * BM + colw;
#pragma unroll
                    for (int bj = 0; bj < 2; ++bj) { const f32x4 v0 = acc[ai][bj][m][0], v1 = acc[ai][bj][m][1];
                        u32x4 w; w.x = cvt_pk_bf16(v0[0], v0[1]); w.y = cvt_pk_bf16(v0[2], v0[3]); w.z = cvt_pk_bf16(v1[0], v1[1]); w.w = cvt_pk_bf16(v1[2], v1[3]);
                        *(u32x4*)(rp + bj * HALF) = w; } }
        }
    }
};
struct EpiRes {
    static constexpr bool PERM = false, AFTER_DRAIN = false;
    const float* resP; const float* resS; float* out;
    __device__ __forceinline__ void operator()(const f32x4 (&acc)[2][2][4][2], const Unit& u, int wr, int wc, int fr, int fq) const {
        const int row0 = u.pm * BM + wr * 64 + fr, col0 = u.pn * BM + wc * 32 + 4 * fq;
        const bool samp = u.pm >= HY_NP / BM;
#pragma unroll
        for (int ai = 0; ai < 2; ++ai)
#pragma unroll
            for (int m = 0; m < 4; ++m) { const int row = row0 + ai * HALF + m * 16;
                const float* rp = samp ? resS + (size_t)(row - HY_NP) * 4096 + col0 : resP + (size_t)row * 4096 + col0;
                float* op = out + (size_t)row * 4096 + col0;
#pragma unroll
                for (int bj = 0; bj < 2; ++bj)
#pragma unroll
                    for (int n = 0; n < 2; ++n) { const f32x4 r = *(const f32x4*)(rp + bj * HALF + n * 16); *(f32x4*)(op + bj * HALF + n * 16) = r + acc[ai][bj][m][n]; } }
    }
};
struct EpiRelu2 {
    static constexpr bool PERM = true, AFTER_DRAIN = false;
    bf16_t* O; int ldc;
    __device__ __forceinline__ void operator()(const f32x4 (&acc)[2][2][4][2], const Unit& u, int wr, int wc, int fr, int fq) const {
        const int row0 = u.pm * BM + wr * 64 + fr, col0 = u.pn * BM + wc * 32 + 8 * fq;
#pragma unroll
        for (int ai = 0; ai < 2; ++ai)
#pragma unroll
            for (int m = 0; m < 4; ++m) { bf16_t* rowp = O + (size_t)(row0 + ai * HALF + m * 16) * ldc + col0;
#pragma unroll
                for (int bj = 0; bj < 2; ++bj) { f32x4 v0 = acc[ai][bj][m][0], v1 = acc[ai][bj][m][1];
#pragma unroll
                    for (int e = 0; e < 4; ++e) { const float a = fmaxf(v0[e], 0.f), b = fmaxf(v1[e], 0.f); v0[e] = a * a; v1[e] = b * b; }
                    u32x4 w; w.x = cvt_pk_bf16(v0[0], v0[1]); w.y = cvt_pk_bf16(v0[2], v0[3]); w.z = cvt_pk_bf16(v1[0], v1[1]); w.w = cvt_pk_bf16(v1[2], v1[3]);
                    *(u32x4*)(rowp + bj * HALF) = w; } }
    }
};

typedef float f32x2e __attribute__((ext_vector_type(2)));
__device__ __forceinline__ void head_ssq_exchange(const f32x4 (&acc)[2][2][4][2], PG8_LAS float* P, int wr, int wc, int fr, int fq, float (&rstd)[2][4][2], float inv_n, float eps) {
#pragma unroll
    for (int ai = 0; ai < 2; ++ai)
#pragma unroll
        for (int m = 0; m < 4; ++m)
#pragma unroll
            for (int bj = 0; bj < 2; ++bj) {
                const f32x4 a = acc[ai][bj][m][0], b = acc[ai][bj][m][1];
                float s = ((a[0] * a[0] + a[1] * a[1]) + (a[2] * a[2] + a[3] * a[3])) + ((b[0] * b[0] + b[1] * b[1]) + (b[2] * b[2] + b[3] * b[3]));
                s += __shfl_xor(s, 16); s += __shfl_xor(s, 32);
                if (fq == 0) P[(ai * HALF + wr * 64 + m * 16 + fr) * 8 + bj * 4 + wc] = s;
            }
    asm volatile("s_waitcnt lgkmcnt(0)" ::: "memory"); __builtin_amdgcn_s_barrier(); asm volatile("" ::: "memory");
#pragma unroll
    for (int ai = 0; ai < 2; ++ai)
#pragma unroll
        for (int m = 0; m < 4; ++m)
#pragma unroll
            for (int bj = 0; bj < 2; ++bj) {
                const f32x4 p = *(const PG8_LAS f32x4*)(P + (ai * HALF + wr * 64 + m * 16 + fr) * 8 + bj * 4);
                rstd[ai][m][bj] = 1.0f / sqrtf(((p[0] + p[1]) + (p[2] + p[3])) * inv_n + eps);
            }
}
struct EpiQb {
    static constexpr bool PERM = true, AFTER_DRAIN = false;
    bf16_t* QB; const float* g_nope; const float* g_rope; const f32x2e* tab; PG8_LAS float* P; float qs, eps;
    __device__ __forceinline__ void operator()(const f32x4 (&acc)[2][2][4][2], const Unit& u, int wr, int wc, int fr, int fq) const {
        const int row0 = u.pm * BM + wr * 64 + fr, pn = u.pn;
        if (pn < 8) {
            float rstd[2][4][2]; head_ssq_exchange(acc, P, wr, wc, fr, fq, rstd, 1.f / 128.f, eps);
            const f32x4 g0 = *(const f32x4*)(g_nope + wc * 32 + 8 * fq) * qs, g1 = *(const f32x4*)(g_nope + wc * 32 + 8 * fq + 4) * qs;
#pragma unroll
            for (int ai = 0; ai < 2; ++ai)
#pragma unroll
                for (int m = 0; m < 4; ++m) { bf16_t* rp = QB + (size_t)(row0 + ai * HALF + m * 16) * 3072 + (2 * pn) * 192 + wc * 32 + 8 * fq;
#pragma unroll
                    for (int bj = 0; bj < 2; ++bj) { const float r = rstd[ai][m][bj]; const f32x4 v0 = acc[ai][bj][m][0] * g0 * r, v1 = acc[ai][bj][m][1] * g1 * r;
                        u32x4 w; w.x = cvt_pk_bf16(v0[0], v0[1]); w.y = cvt_pk_bf16(v0[2], v0[3]); w.z = cvt_pk_bf16(v1[0], v1[1]); w.w = cvt_pk_bf16(v1[2], v1[3]);
                        *(u32x4*)(rp + bj * 192) = w; } }
        } else {
            const int h = 4 * (pn - 8) + wc;
            const f32x4 ga0 = *(const f32x4*)(g_rope + 8 * fq), ga1 = *(const f32x4*)(g_rope + 8 * fq + 4), gb0 = *(const f32x4*)(g_rope + 32 + 8 * fq), gb1 = *(const f32x4*)(g_rope + 32 + 8 * fq + 4);
#pragma unroll
            for (int ai = 0; ai < 2; ++ai)
#pragma unroll
                for (int m = 0; m < 4; ++m) { const int row = row0 + ai * HALF + m * 16;
                    const f32x4 a0 = acc[ai][0][m][0], a1 = acc[ai][0][m][1], b0 = acc[ai][1][m][0], b1 = acc[ai][1][m][1];
                    float s = (((a0[0] * a0[0] + a0[1] * a0[1]) + (a0[2] * a0[2] + a0[3] * a0[3])) + ((a1[0] * a1[0] + a1[1] * a1[1]) + (a1[2] * a1[2] + a1[3] * a1[3])))
                            + (((b0[0] * b0[0] + b0[1] * b0[1]) + (b0[2] * b0[2] + b0[3] * b0[3])) + ((b1[0] * b1[0] + b1[1] * b1[1]) + (b1[2] * b1[2] + b1[3] * b1[3])));
                    s += __shfl_xor(s, 16); s += __shfl_xor(s, 32);
                    const float r = 1.0f / sqrtf(s * (1.f / 64.f) + eps);
                    const int pos = row < HY_NP ? (row & 4095) : 1024 + ((row - HY_NP) & 63);
                    const f32x4* tp = (const f32x4*)(tab + pos * 32 + 8 * fq);
                    const f32x4 t0 = tp[0], t1 = tp[1], t2 = tp[2], t3 = tp[3];
                    const f32x4 x10 = a0 * ga0 * r, x11 = a1 * ga1 * r, x20 = b0 * gb0 * r, x21 = b1 * gb1 * r;
                    const f32x4 c0 = {t0[0], t0[2], t1[0], t1[2]}, s0 = {t0[1], t0[3], t1[1], t1[3]}, c1 = {t2[0], t2[2], t3[0], t3[2]}, s1 = {t2[1], t2[3], t3[1], t3[3]};
                    const f32x4 o10 = (x10 * c0 - x20 * s0) * qs, o11 = (x11 * c1 - x21 * s1) * qs, o20 = (x10 * s0 + x20 * c0) * qs, o21 = (x11 * s1 + x21 * c1) * qs;
                    bf16_t* rp = QB + (size_t)row * 3072 + h * 192 + 128 + 8 * fq;
                    u32x4 w; w.x = cvt_pk_bf16(o10[0], o10[1]); w.y = cvt_pk_bf16(o10[2], o10[3]); w.z = cvt_pk_bf16(o11[0], o11[1]); w.w = cvt_pk_bf16(o11[2], o11[3]);
                    *(u32x4*)rp = w;
                    w.x = cvt_pk_bf16(o20[0], o20[1]); w.y = cvt_pk_bf16(o20[2], o20[3]); w.z = cvt_pk_bf16(o21[0], o21[1]); w.w = cvt_pk_bf16(o21[2], o21[3]);
                    *(u32x4*)(rp + 32) = w; }
        }
    }
};
struct EpiKvbN {
    static constexpr bool PERM = true, AFTER_DRAIN = false;
    bf16_t* KN; bf16_t* VB; const float* g_nope; PG8_LAS float* P; float eps;
    __device__ __forceinline__ void operator()(const f32x4 (&acc)[2][2][4][2], const Unit& u, int wr, int wc, int fr, int fq) const {
        const int row0 = u.pm * BM + wr * 64 + fr, colw = wc * 32 + 8 * fq, pn = u.pn;
        if (pn < 8) {
            float rstd[2][4][2]; head_ssq_exchange(acc, P, wr, wc, fr, fq, rstd, 1.f / 128.f, eps);
            const f32x4 g0 = *(const f32x4*)(g_nope + colw), g1 = *(const f32x4*)(g_nope + colw + 4);
#pragma unroll
            for (int ai = 0; ai < 2; ++ai)
#pragma unroll
                for (int m = 0; m < 4; ++m) { bf16_t* rp = KN + (size_t)(row0 + ai * HALF + m * 16) * 2048 + pn * BM + colw;
#pragma unroll
                    for (int bj = 0; bj < 2; ++bj) { const float r = rstd[ai][m][bj]; const f32x4 v0 = acc[ai][bj][m][0] * g0 * r, v1 = acc[ai][bj][m][1] * g1 * r;
                        u32x4 w; w.x = cvt_pk_bf16(v0[0], v0[1]); w.y = cvt_pk_bf16(v0[2], v0[3]); w.z = cvt_pk_bf16(v1[0], v1[1]); w.w = cvt_pk_bf16(v1[2], v1[3]);
                        *(u32x4*)(rp + bj * HALF) = w; } }
        } else {
#pragma unroll
            for (int ai = 0; ai < 2; ++ai)
#pragma unroll
                for (int m = 0; m < 4; ++m) { bf16_t* rp = VB + (size_t)(row0 + ai * HALF + m * 16) * 2048 + (pn - 8) * BM + colw;
#pragma unroll
                    for (int bj = 0; bj < 2; ++bj) { const f32x4 v0 = acc[ai][bj][m][0], v1 = acc[ai][bj][m][1];
                        u32x4 w; w.x = cvt_pk_bf16(v0[0], v0[1]); w.y = cvt_pk_bf16(v0[2], v0[3]); w.z = cvt_pk_bf16(v1[0], v1[1]); w.w = cvt_pk_bf16(v1[2], v1[3]);
                        *(u32x4*)(rp + bj * HALF) = w; } }
        }
    }
};

template <bool NORM> struct EpiResP {
    static constexpr bool PERM = true, AFTER_DRAIN = false, MIDK = NORM;
    const float* resP; const float* resS; float* out; bf16_t* HB; float* ssq; const float* ssqm; const float* ssqs; float eps;
    bf16_t* YB;
    __device__ __forceinline__ void mid(f32x4 (&acc)[2][2][4][2], const Unit& u, int wr, int wc, int fr, int fq) const {
        const int row0 = u.pm * BM + wr * 64 + fr;
#pragma unroll
        for (int ai = 0; ai < 2; ++ai)
#pragma unroll
            for (int m = 0; m < 4; ++m) { const int row = row0 + ai * HALF + m * 16;
                const float a = __hip_atomic_load(ssqm + row, __ATOMIC_RELAXED, __HIP_MEMORY_SCOPE_AGENT), b = __hip_atomic_load(ssqs + row, __ATOMIC_RELAXED, __HIP_MEMORY_SCOPE_AGENT);
                const float ratio = sqrtf((b * (1.f / 2048.f) + eps) / (a * (1.f / 2048.f) + eps));
#pragma unroll
                for (int bj = 0; bj < 2; ++bj) { acc[ai][bj][m][0] *= ratio; acc[ai][bj][m][1] *= ratio; } }
    }
    __device__ __forceinline__ void operator()(const f32x4 (&acc)[2][2][4][2], const Unit& u, int wr, int wc, int fr, int fq) const {
        const int row0 = u.pm * BM + wr * 64 + fr, col0 = u.pn * BM + wc * 32 + 8 * fq;
        const bool samp = u.pm >= HY_NP / BM;
#pragma unroll
        for (int ai = 0; ai < 2; ++ai)
#pragma unroll
            for (int m = 0; m < 4; ++m) { const int row = row0 + ai * HALF + m * 16;
                if (NORM) {
                    const float* rp = samp ? resS + (size_t)(row - HY_NP) * 4096 + col0 : resP + (size_t)row * 4096 + col0; float s = 0.f;
                    const bf16_t* yp = YB + (size_t)row * 4096 + col0;
                    const float rs = 1.0f / sqrtf(__hip_atomic_load(ssqs + row, __ATOMIC_RELAXED, __HIP_MEMORY_SCOPE_AGENT) * (1.f / 2048.f) + eps);
#pragma unroll
                    for (int bj = 0; bj < 2; ++bj) { f32x4 r0, r1;
                        if (YB) { const u32x4 h = *(const u32x4*)(yp + bj * HALF);
                            r0 = (f32x4){__uint_as_float(h.x << 16), __uint_as_float(h.x & 0xffff0000u), __uint_as_float(h.y << 16), __uint_as_float(h.y & 0xffff0000u)};
                            r1 = (f32x4){__uint_as_float(h.z << 16), __uint_as_float(h.z & 0xffff0000u), __uint_as_float(h.w << 16), __uint_as_float(h.w & 0xffff0000u)}; }
                        else { r0 = *(const f32x4*)(rp + bj * HALF); r1 = *(const f32x4*)(rp + bj * HALF + 4); }
                        const f32x4 v0 = r0 + acc[ai][bj][m][0] * rs, v1 = r1 + acc[ai][bj][m][1] * rs;
                        s += ((v0[0] * v0[0] + v0[1] * v0[1]) + (v0[2] * v0[2] + v0[3] * v0[3])) + ((v1[0] * v1[0] + v1[1] * v1[1]) + (v1[2] * v1[2] + v1[3] * v1[3]));
                        u32x4 w; w.x = cvt_pk_bf16(v0[0], v0[1]); w.y = cvt_pk_bf16(v0[2], v0[3]); w.z = cvt_pk_bf16(v1[0], v1[1]); w.w = cvt_pk_bf16(v1[2], v1[3]);
                        *(u32x4*)(HB + (size_t)row * 4096 + col0 + bj * HALF) = w; }
                    s += __shfl_xor(s, 16); s += __shfl_xor(s, 32);
                    if (fq == 0) __hip_atomic_fetch_add(ssq + row, s, __ATOMIC_RELAXED, __HIP_MEMORY_SCOPE_AGENT);
                } else {
                    const bf16_t* hp = HB + (size_t)row * 4096 + col0; float* op = out + (size_t)row * 4096 + col0; float s = 0.f;
#pragma unroll
                    for (int bj = 0; bj < 2; ++bj) { const u32x4 h = *(const u32x4*)(hp + bj * HALF);
                        const f32x4 r0 = {__uint_as_float(h.x << 16), __uint_as_float(h.x & 0xffff0000u), __uint_as_float(h.y << 16), __uint_as_float(h.y & 0xffff0000u)};
                        const f32x4 r1 = {__uint_as_float(h.z << 16), __uint_as_float(h.z & 0xffff0000u), __uint_as_float(h.w << 16), __uint_as_float(h.w & 0xffff0000u)};
                        const f32x4 y0 = r0 + acc[ai][bj][m][0], y1 = r1 + acc[ai][bj][m][1];
                        if (YB) { u32x4 w; w.x = cvt_pk_bf16(y0[0], y0[1]); w.y = cvt_pk_bf16(y0[2], y0[3]); w.z = cvt_pk_bf16(y1[0], y1[1]); w.w = cvt_pk_bf16(y1[2], y1[3]);
                                  *(u32x4*)(YB + (size_t)row * 4096 + col0 + bj * HALF) = w;
                                  s += ((y0[0] * y0[0] + y0[1] * y0[1]) + (y0[2] * y0[2] + y0[3] * y0[3])) + ((y1[0] * y1[0] + y1[1] * y1[1]) + (y1[2] * y1[2] + y1[3] * y1[3])); }
                        else { __builtin_nontemporal_store(y0, (f32x4*)(op + bj * HALF)); __builtin_nontemporal_store(y1, (f32x4*)(op + bj * HALF + 4)); } }
                    if (YB) { s += __shfl_xor(s, 16); s += __shfl_xor(s, 32);
                        if (fq == 0) __hip_atomic_fetch_add(ssq + row, s, __ATOMIC_RELAXED, __HIP_MEMORY_SCOPE_AGENT); }
                } }
    }
};
struct EpiRelu2N {
    static constexpr bool PERM = true, AFTER_DRAIN = false;
    bf16_t* O; int ldc; const float* ssq; float eps;
    __device__ __forceinline__ void operator()(const f32x4 (&acc)[2][2][4][2], const Unit& u, int wr, int wc, int fr, int fq) const {
        const int row0 = u.pm * BM + wr * 64 + fr;
        bf16_t* const tile0 = O + ((size_t)u.pm * (ldc >> 6) + u.pn * 4 + (wc >> 1)) * 16384 + (wc & 1) * 32 + 8 * fq;
#pragma unroll
        for (int ai = 0; ai < 2; ++ai)
#pragma unroll
            for (int m = 0; m < 4; ++m) { const int row = row0 + ai * HALF + m * 16; bf16_t* rowp = tile0 + (wr * 64 + fr + ai * HALF + m * 16) * 64;
                const float r = 1.0f / sqrtf(__hip_atomic_load(ssq + row, __ATOMIC_RELAXED, __HIP_MEMORY_SCOPE_AGENT) * (1.f / 4096.f) + eps);
#pragma unroll
                for (int bj = 0; bj < 2; ++bj) { f32x4 v0 = acc[ai][bj][m][0], v1 = acc[ai][bj][m][1];
#pragma unroll
                    for (int e = 0; e < 4; ++e) { const float a = fmaxf(v0[e], 0.f) * r, b = fmaxf(v1[e], 0.f) * r; v0[e] = a * a; v1[e] = b * b; }
                    u32x4 w; w.x = cvt_pk_bf16(v0[0], v0[1]); w.y = cvt_pk_bf16(v0[2], v0[3]); w.z = cvt_pk_bf16(v1[0], v1[1]); w.w = cvt_pk_bf16(v1[2], v1[3]);
                    *(u32x4*)(rowp + bj * 2 * 16384) = w; } }
    }
};
template <class T, class = void> struct has_midk { static constexpr bool value = false; };
template <class T> struct has_midk<T, typename std::enable_if<T::MIDK>::type> { static constexpr bool value = true; };
template <class Epi, class Sched, bool ALIGN_EPI = false, bool SP2 = false>
__device__ __forceinline__ void gemm_phase(PG8_LAS unsigned char* lds, const Gemm g, const Sched& S, const Epi& E) {
    int tid_o = threadIdx.x; asm volatile("" : "+v"(tid_o));
    const int tid = tid_o, wid = __builtin_amdgcn_readfirstlane(tid >> 6), lane = tid & 63, wr = wid >> 2, wc = wid & 3, fr = lane & 15, fq = lane >> 4;
    const int nt = g.K / BK, K = g.blocked ? BK : g.K;
    unsigned voffA[2], voffB[2];
#pragma unroll
    for (int i = 0; i < 2; ++i) { int R, C; stage_rc(tid * 16 + i * 8192, R, C); const int Rb = Epi::PERM ? ((R & ~31) + perm32(R & 31)) : R;
        voffA[i] = (unsigned)(R * K + C) * 2u; voffB[i] = (unsigned)(Rb * K + C) * 2u; }
    const size_t kstep = g.blocked ? (size_t)(BM * BK * 2) : (size_t)(BK * 2);
    const size_t hstep = (size_t)HALF * K * 2;
    const size_t tstep = (size_t)BM * g.K * 2;
    const unsigned ldsw = (unsigned)wid * 1024u;
    const int aoff = lds_byte(wr * 64 + fr, fq * 8), boff = lds_byte(wc * 32 + fr, fq * 8);
#define PG8_SA(b, h) (((b) * 2 + (h)) * HTB)
#define PG8_SB(b, h) ((4 + (b) * 2 + (h)) * HTB)
#define PG8_STAGE(bufoff, gbase, voff) do { _Pragma("unroll") for (int _i = 0; _i < 2; ++_i) \
        __builtin_amdgcn_global_load_lds((const unsigned*)((const char*)(gbase) + (voff)[_i]), (PG8_LAS unsigned*)(lds + (bufoff) + ldsw + _i * 8192), 16, 0, 0); } while (0)
#define PG8_LDA(dst, b, h) do { _Pragma("unroll") for (int m = 0; m < 4; ++m) _Pragma("unroll") for (int k = 0; k < 2; ++k) dst[m][k] = *(const PG8_LAS bf16x8*)(lds + PG8_SA(b, h) + aoff + m * 2048 + k * 1024); } while (0)
#define PG8_LDB(dst, b, h) do { _Pragma("unroll") for (int n = 0; n < 2; ++n) _Pragma("unroll") for (int k = 0; k < 2; ++k) dst[n][k] = *(const PG8_LAS bf16x8*)(lds + PG8_SB(b, h) + boff + n * 2048 + k * 1024); } while (0)
#define PG8_MMA(ai, bj, At, Bt) do { __builtin_amdgcn_s_setprio(1); _Pragma("unroll") for (int m = 0; m < 4; ++m) _Pragma("unroll") for (int n = 0; n < 2; ++n) _Pragma("unroll") for (int k = 0; k < 2; ++k) \
        acc[ai][bj][m][n] = __builtin_amdgcn_mfma_f32_16x16x32_bf16(Bt[n][k], At[m][k], acc[ai][bj][m][n], 0, 0, 0); __builtin_amdgcn_s_setprio(0); } while (0)
#define PG8_WAIT_V(n) asm volatile("s_waitcnt vmcnt(" #n ")" ::: "memory")
#define PG8_WAIT_L(n) asm volatile("s_waitcnt lgkmcnt(" #n ")" ::: "memory")
#define PG8_BAR __builtin_amdgcn_s_barrier()
#define PG8_SCHED __builtin_amdgcn_sched_barrier(0)
    Unit cur, nxt; int ui = 0;
    if (!S.next(0, cur)) return;
    f32x4 acc[2][2][4][2];
#pragma unroll
    for (int a = 0; a < 2; ++a)
#pragma unroll
        for (int b = 0; b < 2; ++b)
#pragma unroll
            for (int m = 0; m < 4; ++m)
#pragma unroll
                for (int n = 0; n < 2; ++n) acc[a][b][m][n] = (f32x4){0.f, 0.f, 0.f, 0.f};
    bf16x8 At[4][2], B0[2][2], B1[2][2];
    const char* cA = (const char*)g.A + (size_t)cur.pm * tstep + (size_t)cur.kt0 * kstep; const char* cB = (const char*)g.Bt + (size_t)cur.pn * tstep + (size_t)cur.kt0 * kstep;
    int cnt = cur.nkt ? cur.nkt : nt;
    S.a_ready(cur);
    if constexpr (SP2) {
        PG8_STAGE(PG8_SB(0, 0), cB, voffB); PG8_STAGE(PG8_SB(0, 1), cB + hstep, voffB); PG8_STAGE(PG8_SA(0, 0), cA, voffA); PG8_STAGE(PG8_SA(0, 1), cA + hstep, voffA);
        if (wr == 1) PG8_BAR;
        PG8_WAIT_V(2); PG8_BAR;
        PG8_STAGE(PG8_SB(1, 0), cB + kstep, voffB); PG8_STAGE(PG8_SA(1, 0), cA + kstep, voffA); PG8_STAGE(PG8_SB(1, 1), cB + hstep + kstep, voffB);
        PG8_WAIT_V(6); PG8_BAR;
    } else {
        PG8_STAGE(PG8_SB(0, 0), cB, voffB); PG8_STAGE(PG8_SA(0, 0), cA, voffA); PG8_STAGE(PG8_SB(0, 1), cB + hstep, voffB); PG8_STAGE(PG8_SA(0, 1), cA + hstep, voffA);
        if (wr == 1) PG8_BAR;
        PG8_WAIT_V(4); PG8_BAR;
        PG8_STAGE(PG8_SB(1, 0), cB + kstep, voffB); PG8_STAGE(PG8_SA(1, 0), cA + kstep, voffA); PG8_STAGE(PG8_SB(1, 1), cB + hstep + kstep, voffB);
        PG8_WAIT_V(6); PG8_BAR;
    }
    for (;;) {
        const bool has_next = S.next(ui + 1, nxt);
        const char* nA = has_next ? (const char*)g.A + (size_t)nxt.pm * tstep + (size_t)nxt.kt0 * kstep : cA; const char* nB = has_next ? (const char*)g.Bt + (size_t)nxt.pn * tstep + (size_t)nxt.kt0 * kstep : cB;
        for (int t = 0; t < cnt; t += 2) {
            const bool last = (t == cnt - 2);
            const char* a1 = cA + (size_t)(t + 1) * kstep;
            const char* a2 = last ? nA : cA + (size_t)(t + 2) * kstep; const char* b2 = last ? nB : cB + (size_t)(t + 2) * kstep;
            const char* a3 = a2 + kstep; const char* b3 = b2 + kstep;
            if (last && has_next) S.a_ready(nxt);
            if constexpr (SP2) {
            PG8_LDB(B0, 0, 0); PG8_LDB(B1, 0, 1); PG8_SCHED; PG8_LDA(At, 0, 0); PG8_STAGE(PG8_SA(1, 1), a1 + hstep, voffA);
            PG8_WAIT_V(8); PG8_WAIT_L(0); PG8_BAR; PG8_MMA(0, 0, At, B0); PG8_MMA(0, 1, At, B1); PG8_BAR; PG8_SCHED;
            PG8_LDA(At, 0, 1); PG8_STAGE(PG8_SB(0, 0), b2, voffB); PG8_STAGE(PG8_SB(0, 1), b2 + hstep, voffB); PG8_STAGE(PG8_SA(0, 0), a2, voffA);
            PG8_WAIT_V(8); PG8_WAIT_L(0); PG8_BAR; PG8_MMA(1, 0, At, B0); PG8_MMA(1, 1, At, B1); PG8_BAR; PG8_SCHED;
            PG8_LDB(B0, 1, 0); PG8_LDB(B1, 1, 1); PG8_SCHED; PG8_LDA(At, 1, 0); PG8_STAGE(PG8_SA(0, 1), a2 + hstep, voffA);
            PG8_WAIT_V(8); PG8_WAIT_L(0); PG8_BAR; PG8_MMA(0, 0, At, B0); PG8_MMA(0, 1, At, B1); PG8_BAR; PG8_SCHED;
            PG8_LDA(At, 1, 1); PG8_STAGE(PG8_SB(1, 0), b3, voffB); PG8_STAGE(PG8_SB(1, 1), b3 + hstep, voffB); PG8_STAGE(PG8_SA(1, 0), a3, voffA);
            PG8_WAIT_V(8); PG8_WAIT_L(0); PG8_BAR; PG8_MMA(1, 0, At, B0); PG8_MMA(1, 1, At, B1); PG8_BAR; PG8_SCHED;
            } else {
            PG8_LDB(B0, 0, 0); PG8_SCHED; PG8_LDA(At, 0, 0); PG8_STAGE(PG8_SA(1, 1), a1 + hstep, voffA);
            PG8_WAIT_L(8); PG8_BAR; PG8_WAIT_L(0); PG8_MMA(0, 0, At, B0); PG8_BAR; PG8_SCHED;
            PG8_LDB(B1, 0, 1); PG8_STAGE(PG8_SB(0, 0), b2, voffB);
            PG8_BAR; PG8_WAIT_L(0); PG8_MMA(0, 1, At, B1); PG8_BAR;
            PG8_LDA(At, 0, 1); PG8_STAGE(PG8_SA(0, 0), a2, voffA);
            PG8_BAR; PG8_WAIT_L(0); PG8_MMA(1, 0, At, B0); PG8_BAR; PG8_SCHED;
            PG8_STAGE(PG8_SB(0, 1), b2 + hstep, voffB);
            PG8_WAIT_V(6); PG8_BAR; PG8_MMA(1, 1, At, B1); PG8_BAR;
            PG8_LDB(B0, 1, 0); PG8_SCHED; PG8_LDA(At, 1, 0); PG8_STAGE(PG8_SA(0, 1), a2 + hstep, voffA);
            PG8_WAIT_L(8); PG8_BAR; PG8_WAIT_L(0); PG8_MMA(0, 0, At, B0); PG8_BAR; PG8_SCHED;
            PG8_LDB(B1, 1, 1); PG8_STAGE(PG8_SB(1, 0), b3, voffB);
            PG8_BAR; PG8_WAIT_L(0); PG8_MMA(0, 1, At, B1); PG8_BAR;
            PG8_LDA(At, 1, 1); PG8_STAGE(PG8_SA(1, 0), a3, voffA);
            PG8_BAR; PG8_WAIT_L(0); PG8_MMA(1, 0, At, B0); PG8_BAR; PG8_SCHED;
            PG8_STAGE(PG8_SB(1, 1), b3 + hstep, voffB);
            PG8_WAIT_V(6); PG8_BAR; PG8_MMA(1, 1, At, B1); PG8_BAR;
            }
        }
        if constexpr (ALIGN_EPI) { if (wr == 0) PG8_BAR; }
        if constexpr (!Epi::AFTER_DRAIN) {
            if (cur.part == -2) { if constexpr (has_midk<Epi>::value) E.mid(acc, cur, wr, wc, fr, fq); }
            else if (cur.part >= 0) {
                f32x4* sp = (f32x4*)(g.slab + (size_t)cur.part * 65536) + (size_t)wid * 2048 + lane;
#pragma unroll
                for (int a = 0; a < 2; ++a)
#pragma unroll
                    for (int b = 0; b < 2; ++b)
#pragma unroll
                        for (int m = 0; m < 4; ++m)
#pragma unroll
                            for (int n = 0; n < 2; ++n) sp[(((a * 2 + b) * 4 + m) * 2 + n) * 64] = acc[a][b][m][n];
            } else E(acc, cur, wr, wc, fr, fq);
            S.done(cur); }
        if (!has_next) break;
        if (cur.part != -2) {
#pragma unroll
        for (int a = 0; a < 2; ++a)
#pragma unroll
            for (int b = 0; b < 2; ++b)
#pragma unroll
                for (int m = 0; m < 4; ++m)
#pragma unroll
                    for (int n = 0; n < 2; ++n) acc[a][b][m][n] = (f32x4){0.f, 0.f, 0.f, 0.f};
        }
        cur = nxt; cA = nA; cB = nB; ++ui; cnt = cur.nkt ? cur.nkt : nt;
        if constexpr (ALIGN_EPI) { if (wr == 1) PG8_BAR; }
    }
    PG8_WAIT_V(0);
    if constexpr (!ALIGN_EPI) { if (wr == 0) PG8_BAR; }
    PG8_BAR;
    if constexpr (Epi::AFTER_DRAIN) { E.fused(acc, cur, wr, wc, fr, fq, lds, wid, lane); S.done(cur); }
#undef PG8_SA
#undef PG8_SB
#undef PG8_STAGE
#undef PG8_LDA
#undef PG8_LDB
#undef PG8_MMA
#undef PG8_WAIT_V
#undef PG8_WAIT_L
#undef PG8_BAR
#undef PG8_SCHED
}
}
namespace att {
typedef short bf16x8 __attribute__((ext_vector_type(8)));
typedef short s16x4 __attribute__((ext_vector_type(4)));
typedef float f32x16 __attribute__((ext_vector_type(16)));
typedef unsigned u32x4 __attribute__((ext_vector_type(4)));
typedef float f32x4 __attribute__((ext_vector_type(4)));
typedef unsigned short bf16;
#define ALAS __attribute__((address_space(3)))
#ifndef ATT_SSQ_ATOMICS
#define ATT_SSQ_ATOMICS 0
#endif
constexpr int OFF_V = 0, OFF_K = 32768, OFF_R = 65536, OFF_WS = 81920, OFF_FLG = 81920 + 8 * 256, ATT_LDS_BYTES = OFF_FLG + 64;
constexpr float SB_DEAD = -150.f;
#define KSWZ(row, colB) ((row) * 256 + ((colB) ^ (((row) & 15) << 4)))
#define RSWZ(row, colB) ((row) * 128 + ((colB) ^ ((((row) >> 1) & 7) << 4)))
__device__ __forceinline__ int v_st(int k, int c) { const int kk = (k & ~0xC) | ((k & 4) << 1) | ((k & 8) >> 1); return ((kk >> 3) * 4 + (c >> 5)) * 512 + ((kk & 7) * 32 + (c & 31)) * 2; }
__device__ __forceinline__ int v_rd_base(int lane) { return ((lane & 3) << 3) | (((lane >> 2) & 3) << 6) | (((lane >> 4) & 1) << 5) | (((lane >> 5) & 1) << 8); }
__device__ __forceinline__ int crow(int r, int hi) { return (r & 3) + 8 * (r >> 2) + 4 * hi; }
__device__ __forceinline__ unsigned cvtpk(float lo, float hi) { unsigned r; asm volatile("v_cvt_pk_bf16_f32 %0, %1, %2" : "=v"(r) : "v"(lo), "v"(hi)); return r; }

struct Unit { const bf16* Q; int ldq; const bf16* K; const bf16* Kr; const bf16* V; bf16* O; int ldo; float* ssq; int P0; int NT; int nact;
              const float* Kf0; const float* Vf0; const float* Kf1; const float* Vf1; int split; };

__device__ __forceinline__ void qk128(f32x16& p0, f32x16& p1, ALAS const char* Kt, int r32, int hi, const bf16x8* qr) {
#pragma unroll
    for (int d0 = 0; d0 < 8; ++d0) { ALAS const char* a = Kt + KSWZ(r32, (d0 * 16 + hi * 8) * 2);
        const bf16x8 b0 = *(ALAS const bf16x8*)a; const bf16x8 b1 = *(ALAS const bf16x8*)(a + 32 * 256);
        p0 = __builtin_amdgcn_mfma_f32_32x32x16_bf16(b0, qr[d0], p0, 0, 0, 0);
        p1 = __builtin_amdgcn_mfma_f32_32x32x16_bf16(b1, qr[d0], p1, 0, 0, 0); }
}
__device__ __forceinline__ void qk64(f32x16& p0, f32x16& p1, ALAS const char* Kt, int r32, int hi, const bf16x8* qr) {
#pragma unroll
    for (int d0 = 0; d0 < 4; ++d0) { ALAS const char* a = Kt + RSWZ(r32, (d0 * 16 + hi * 8) * 2);
        const bf16x8 b0 = *(ALAS const bf16x8*)a; const bf16x8 b1 = *(ALAS const bf16x8*)(a + 32 * 128);
        p0 = __builtin_amdgcn_mfma_f32_32x32x16_bf16(b0, qr[d0], p0, 0, 0, 0);
        p1 = __builtin_amdgcn_mfma_f32_32x32x16_bf16(b1, qr[d0], p1, 0, 0, 0); }
}
__device__ __forceinline__ void pv_tile(f32x16* o, unsigned vb0, bf16x8 pa0, bf16x8 pa1, bf16x8 pa2, bf16x8 pa3) {
#define TRRD(dst, off) asm volatile("ds_read_b64_tr_b16 %0, %1 offset:%2" : "=&v"(dst) : "v"(vb0), "i"(off) : "memory")
#define PV_LD(S, d0) do { constexpr int b_ = (d0) * 512; \
        TRRD(S##l0, b_); TRRD(S##h0, b_ + 2048); TRRD(S##l1, b_ + 4096); TRRD(S##h1, b_ + 6144); TRRD(S##l2, b_ + 8192); TRRD(S##h2, b_ + 10240); TRRD(S##l3, b_ + 12288); TRRD(S##h3, b_ + 14336); } while (0)
#define PV_MM(S, d0) do { \
        o[d0] = __builtin_amdgcn_mfma_f32_32x32x16_bf16(pa0, (bf16x8){S##l0[0], S##l0[1], S##l0[2], S##l0[3], S##h0[0], S##h0[1], S##h0[2], S##h0[3]}, o[d0], 0, 0, 0); \
        o[d0] = __builtin_amdgcn_mfma_f32_32x32x16_bf16(pa1, (bf16x8){S##l1[0], S##l1[1], S##l1[2], S##l1[3], S##h1[0], S##h1[1], S##h1[2], S##h1[3]}, o[d0], 0, 0, 0); \
        o[d0] = __builtin_amdgcn_mfma_f32_32x32x16_bf16(pa2, (bf16x8){S##l2[0], S##l2[1], S##l2[2], S##l2[3], S##h2[0], S##h2[1], S##h2[2], S##h2[3]}, o[d0], 0, 0, 0); \
        o[d0] = __builtin_amdgcn_mfma_f32_32x32x16_bf16(pa3, (bf16x8){S##l3[0], S##l3[1], S##l3[2], S##l3[3], S##h3[0], S##h3[1], S##h3[2], S##h3[3]}, o[d0], 0, 0, 0); } while (0)
#define PV_WAIT(n) do { asm volatile("s_waitcnt lgkmcnt(" #n ")" ::: "memory"); __builtin_amdgcn_sched_barrier(0); } while (0)
    s16x4 Al0, Al1, Al2, Al3, Ah0, Ah1, Ah2, Ah3, Bl0, Bl1, Bl2, Bl3, Bh0, Bh1, Bh2, Bh3;
    PV_LD(A, 0); PV_LD(B, 1); PV_WAIT(8); PV_MM(A, 0);
    __builtin_amdgcn_sched_barrier(0); PV_LD(A, 2); PV_WAIT(8); PV_MM(B, 1);
    __builtin_amdgcn_sched_barrier(0); PV_LD(B, 3); PV_WAIT(8); PV_MM(A, 2);
    PV_WAIT(0); PV_MM(B, 3);
#undef PV_WAIT
#undef PV_MM
#undef PV_LD
#undef TRRD
}
#define PK4(P, B_, OUT) do { const unsigned a0_ = cvtpk(P[B_ + 0], P[B_ + 1]), a1_ = cvtpk(P[B_ + 2], P[B_ + 3]); \
        const unsigned b0_ = cvtpk(P[B_ + 4], P[B_ + 5]), b1_ = cvtpk(P[B_ + 6], P[B_ + 7]); \
        auto r0_ = __builtin_amdgcn_permlane32_swap(a0_, b0_, false, false); auto r1_ = __builtin_amdgcn_permlane32_swap(a1_, b1_, false, false); \
        u32x4 w_ = {r0_[0], r1_[0], r0_[1], r1_[1]}; OUT = __builtin_bit_cast(bf16x8, w_); } while (0)

__device__ __forceinline__ void store_o_staged(const f32x16* o, const float* rli, bf16* Ow, int ldo, ALAS char* stg, int lane, int r32, int hi, float* ssqp) {
    ALAS unsigned short* s16 = (ALAS unsigned short*)stg;
#pragma unroll
    for (int r = 0; r < 16; ++r) { const int orow = crow(r, hi);
#pragma unroll
        for (int d0 = 0; d0 < 4; ++d0) { const float v = o[d0][r] * rli[r]; s16[orow * 128 + d0 * 32 + r32] = (unsigned short)cvtpk(v, v); } }
    asm volatile("s_waitcnt lgkmcnt(0)" ::: "memory");
#pragma unroll
    for (int i = 0; i < 8; ++i) { const int idx = i * 64 + lane, row = idx >> 4, ch = idx & 15;
        const u32x4 w = *(ALAS const u32x4*)(stg + row * 256 + ch * 16);
        *(u32x4*)(Ow + (size_t)row * ldo + ch * 8) = w;
        float s = 0.f; { const unsigned ww[4] = {w.x, w.y, w.z, w.w};
#pragma unroll
            for (int e = 0; e < 4; ++e) { const float x0 = __uint_as_float(ww[e] << 16), x1 = __uint_as_float(ww[e] & 0xffff0000u); s += x0 * x0 + x1 * x1; } }
        s += __shfl_xor(s, 1); s += __shfl_xor(s, 2); s += __shfl_xor(s, 4); s += __shfl_xor(s, 8);
        if (ch == 0) ssqp[(size_t)row * 32] = s; }
}
template <bool MLA>
__device__ __forceinline__ void attn_unit(const Unit u, ALAS char* lds) {
    int tid_o = threadIdx.x; asm volatile("" : "+v"(tid_o));
    const int tid = tid_o, wid = __builtin_amdgcn_readfirstlane(tid >> 6), lane = tid & 63, r32 = lane & 31, hi = lane >> 5;
    const bool actw = wid < u.nact;
    const int sr = tid >> 4, sc = (tid & 15) * 8;
    const int vst0 = v_st(sr, sc), vst1 = v_st(32 + sr, sc), kws = KSWZ(sr, sc * 2);
    const int rk = tid >> 3, rc = (tid & 7) * 8, rws = RSWZ(rk, rc * 2);
    ALAS char* V_l = lds + OFF_V; ALAS char* K_l = lds + OFF_K; ALAS char* R_l = lds + OFF_R;
    ALAS float* al_l = (ALAS float*)(lds + OFF_WS) + wid * 64; ALAS float* li_l = al_l + 32;
    const unsigned vbase = (unsigned)(uintptr_t)V_l + (unsigned)v_rd_base(lane);
    constexpr int NQ = MLA ? 12 : 8;
    bf16x8 qr[NQ];
#pragma unroll
    for (int d0 = 0; d0 < NQ; ++d0) qr[d0] = (bf16x8){0, 0, 0, 0, 0, 0, 0, 0};
    if (actw) {
#pragma unroll
        for (int d0 = 0; d0 < NQ; ++d0) qr[d0] = *(const bf16x8*)(u.Q + (size_t)(wid * 32 + r32) * u.ldq + d0 * 16 + hi * 8);
    }
    const int cw = (u.P0 + wid * 32) >> 6;
    const int qpos = u.P0 + wid * 32 + r32;
    float m_reg = -1e30f, l_reg = 0.f, carry = 0.f; bool fin = false;
    ALAS unsigned* flg = (ALAS unsigned*)(lds + OFF_FLG);
    f32x16 o[4];
#pragma unroll
    for (int d = 0; d < 4; ++d)
#pragma unroll
        for (int r = 0; r < 16; ++r) o[d][r] = 0.f;
    bf16x8 st_k0, st_k1, st_v0, st_v1, st_r = (bf16x8){0, 0, 0, 0, 0, 0, 0, 0};
    f32x4 fk[4], fv[4];
#define LOADT(tt) do { if (!MLA) { const int t_ = (tt); const bool lo_ = t_ < u.split; const size_t ro_ = (size_t)(lo_ ? t_ : t_ - u.split) * 64 * 2048; \
            const float* kb_ = (lo_ ? u.Kf0 : u.Kf1) + ro_ + (size_t)sr * 2048 + sc; const float* vb_ = (lo_ ? u.Vf0 : u.Vf1) + ro_ + (size_t)sr * 2048 + sc; \
            fk[0] = *(const f32x4*)kb_; fk[1] = *(const f32x4*)(kb_ + 4); fk[2] = *(const f32x4*)(kb_ + 32 * 2048); fk[3] = *(const f32x4*)(kb_ + 32 * 2048 + 4); \
            fv[0] = *(const f32x4*)vb_; fv[1] = *(const f32x4*)(vb_ + 4); fv[2] = *(const f32x4*)(vb_ + 32 * 2048); fv[3] = *(const f32x4*)(vb_ + 32 * 2048 + 4); } else { \
        const size_t r0_ = (size_t)(tt) * 64; \
        st_k0 = *(const bf16x8*)(u.K + (r0_ + sr) * 2048 + sc); st_k1 = *(const bf16x8*)(u.K + (r0_ + 32 + sr) * 2048 + sc); \
        st_v0 = *(const bf16x8*)(u.V + (r0_ + sr) * 2048 + sc); st_v1 = *(const bf16x8*)(u.V + (r0_ + 32 + sr) * 2048 + sc); \
        if (MLA) st_r = *(const bf16x8*)(u.Kr + (r0_ + rk) * 64 + rc); } } while (0)
    LOADT(MLA ? 0 : (u.NT - 1));
    for (int i = 0; i < u.NT; ++i) {
        const int t = MLA ? i : (u.NT - 1 - i); const int buf = i & 1;
        if (!MLA) { u32x4 w_;
            w_ = (u32x4){cvtpk(fk[0][0], fk[0][1]), cvtpk(fk[0][2], fk[0][3]), cvtpk(fk[1][0], fk[1][1]), cvtpk(fk[1][2], fk[1][3])}; st_k0 = __builtin_bit_cast(bf16x8, w_);
            w_ = (u32x4){cvtpk(fk[2][0], fk[2][1]), cvtpk(fk[2][2], fk[2][3]), cvtpk(fk[3][0], fk[3][1]), cvtpk(fk[3][2], fk[3][3])}; st_k1 = __builtin_bit_cast(bf16x8, w_);
            w_ = (u32x4){cvtpk(fv[0][0], fv[0][1]), cvtpk(fv[0][2], fv[0][3]), cvtpk(fv[1][0], fv[1][1]), cvtpk(fv[1][2], fv[1][3])}; st_v0 = __builtin_bit_cast(bf16x8, w_);
            w_ = (u32x4){cvtpk(fv[2][0], fv[2][1]), cvtpk(fv[2][2], fv[2][3]), cvtpk(fv[3][0], fv[3][1]), cvtpk(fv[3][2], fv[3][3])}; st_v1 = __builtin_bit_cast(bf16x8, w_); }
        *(ALAS bf16x8*)(K_l + buf * 16384 + kws) = st_k0; *(ALAS bf16x8*)(K_l + buf * 16384 + kws + 32 * 256) = st_k1;
        *(ALAS bf16x8*)(V_l + buf * 16384 + vst0) = st_v0; *(ALAS bf16x8*)(V_l + buf * 16384 + vst1) = st_v1;
        if (MLA) *(ALAS bf16x8*)(R_l + buf * 8192 + rws) = st_r;
        if (!MLA) { if (lane == 0) flg[buf * 8 + wid] = (fin || !actw) ? 1u : 0u; }
        __syncthreads();
        if (!MLA) {
            const u32x4 fa = *(ALAS const u32x4*)(flg + buf * 8), fb = *(ALAS const u32x4*)(flg + buf * 8 + 4);
            if ((fa.x & fa.y & fa.z & fa.w & fb.x & fb.y & fb.z & fb.w) != 0u) break;
        }
        if (i + 1 < u.NT) LOADT(MLA ? (i + 1) : (u.NT - 2 - i));
        if (actw && t <= cw && !fin) {
            f32x16 p0, p1;
#pragma unroll
            for (int r = 0; r < 16; ++r) { p0[r] = 0.f; p1[r] = 0.f; }
            qk128(p0, p1, K_l + buf * 16384, r32, hi, qr);
            if (MLA) qk64(p0, p1, R_l + buf * 8192, r32, hi, qr + (MLA ? 8 : 0));
            bf16x8 pa0, pa1, pa2, pa3;
            if (MLA) {
                float pmax = p0[0];
#pragma unroll
                for (int r = 1; r < 16; ++r) pmax = fmaxf(pmax, p0[r]);
#pragma unroll
                for (int r = 0; r < 16; ++r) pmax = fmaxf(pmax, p1[r]);
                { auto rr = __builtin_amdgcn_permlane32_swap(__float_as_uint(pmax), __float_as_uint(pmax), false, false);
                  pmax = fmaxf(__uint_as_float(rr[0]), __uint_as_float(rr[1])); }
                const float mn = fmaxf(m_reg, pmax); const float alpha = __builtin_amdgcn_exp2f(m_reg - mn); m_reg = mn;
                float ps = 0.f;
#pragma unroll
                for (int r = 0; r < 16; ++r) { p0[r] = __builtin_amdgcn_exp2f(p0[r] - mn); ps += p0[r]; }
#pragma unroll
                for (int r = 0; r < 16; ++r) { p1[r] = __builtin_amdgcn_exp2f(p1[r] - mn); ps += p1[r]; }
                { auto rr = __builtin_amdgcn_permlane32_swap(__float_as_uint(ps), __float_as_uint(ps), false, false);
                  ps = __uint_as_float(rr[0]) + __uint_as_float(rr[1]); }
                l_reg = l_reg * alpha + ps;
                if (__any(alpha < 1.f)) {
                    if (hi == 0) al_l[r32] = alpha;
                    asm volatile("s_waitcnt lgkmcnt(0)" ::: "memory");
#pragma unroll
                    for (int r = 0; r < 16; ++r) { const float a = al_l[crow(r, hi)];
#pragma unroll
                        for (int d = 0; d < 4; ++d) o[d][r] *= a; }
                    asm volatile("s_waitcnt lgkmcnt(0)" ::: "memory");
                }
            } else {
                const bool diag = (t == cw); const int dq = qpos - 64 * t - 4 * hi; const float NEG = -__builtin_inff();
                float suf = carry;
#define SB_HALF(P, KOFF) do { f32x16 f_; \
                    _Pragma("unroll") for (int r = 0; r < 16; ++r) { const float y = P[r]; const float e = __builtin_amdgcn_exp2f(-fabsf(y)); const float l2 = __builtin_amdgcn_logf(1.f + e); \
                        const float lb = fminf(y, 0.f) - l2; P[r] = lb; f_[r] = lb - y; } \
                    if (diag) { _Pragma("unroll") for (int r = 0; r < 16; ++r) { const int c = (r & 3) + 8 * (r >> 2) + (KOFF); if (!(c < dq)) { P[r] = NEG; f_[r] = 0.f; } } } \
                    float tg_[4], pg_[4]; \
                    _Pragma("unroll") for (int g = 0; g < 4; ++g) { const float a = (f_[4 * g] + f_[4 * g + 1]) + (f_[4 * g + 2] + f_[4 * g + 3]); \
                        auto rr = __builtin_amdgcn_permlane32_swap(__float_as_uint(a), __float_as_uint(a), false, false); \
                        const float lo = __uint_as_float(rr[0]), hh = __uint_as_float(rr[1]); tg_[g] = lo + hh; pg_[g] = hi == 0 ? hh : 0.f; } \
                    _Pragma("unroll") for (int g = 3; g >= 0; --g) { const float base = suf + pg_[g]; \
                        const float s2 = f_[4 * g + 3], s1 = s2 + f_[4 * g + 2], s0 = s1 + f_[4 * g + 1]; \
                        P[4 * g + 3] = __builtin_amdgcn_exp2f(P[4 * g + 3] + base); P[4 * g + 2] = __builtin_amdgcn_exp2f(P[4 * g + 2] + (base + s2)); \
                        P[4 * g + 1] = __builtin_amdgcn_exp2f(P[4 * g + 1] + (base + s1)); P[4 * g] = __builtin_amdgcn_exp2f(P[4 * g] + (base + s0)); \
                        suf += tg_[g]; } } while (0)
                SB_HALF(p1, 32);
                PK4(p1, 0, pa2); PK4(p1, 8, pa3);
                SB_HALF(p0, 0);
                PK4(p0, 0, pa0); PK4(p0, 8, pa1);
#undef SB_HALF
                carry = suf;
                fin = __all(carry < SB_DEAD);
            }
            if (MLA) { PK4(p0, 0, pa0); PK4(p0, 8, pa1); PK4(p1, 0, pa2); PK4(p1, 8, pa3); }
            pv_tile(o, vbase + (unsigned)(buf * 16384), pa0, pa1, pa2, pa3);
        }
    }
    __syncthreads();
    if (actw) {
        float rli[16];
        if (MLA) {
            if (hi == 0) li_l[r32] = l_reg;
            asm volatile("s_waitcnt lgkmcnt(0)" ::: "memory");
#pragma unroll
            for (int r = 0; r < 16; ++r) rli[r] = 1.0f / li_l[crow(r, hi)];
        } else {
#pragma unroll
            for (int r = 0; r < 16; ++r) rli[r] = 1.0f;
        }
        store_o_staged(o, rli, u.O + (size_t)(wid * 32) * u.ldo, u.ldo, lds + wid * 8192, lane, r32, hi, u.ssq + (size_t)(wid * 32) * 32);
    }
    __syncthreads();
#undef LOADT
}

__device__ __forceinline__ void qk192_pipe(f32x16& p0, f32x16& p1, ALAS const char* Kt, ALAS const char* Rt, int r32, int hi, const bf16x8* qr, const f32x16* cinit = nullptr) {
    constexpr int PF = 2;
    bf16x8 fa[12], fb[12];
#define QK_ADDR(s) ((s) < 8 ? Kt + KSWZ(r32, ((s) * 16 + hi * 8) * 2) : Rt + RSWZ(r32, (((s) - 8) * 16 + hi * 8) * 2))
#define QK_LD(s) do { ALAS const char* a_ = QK_ADDR(s); fa[s] = *(ALAS const bf16x8*)a_; fb[s] = *(ALAS const bf16x8*)(a_ + ((s) < 8 ? 32 * 256 : 32 * 128)); } while (0)
#pragma unroll
    for (int s = 0; s < PF; ++s) QK_LD(s);
#pragma unroll
    for (int s = 0; s < 12; ++s) {
        if (s + PF < 12) QK_LD(s + PF);
        __builtin_amdgcn_sched_barrier(0);
        p0 = __builtin_amdgcn_mfma_f32_32x32x16_bf16(fa[s], qr[s], (s == 0 && cinit) ? *cinit : p0, 0, 0, 0);
        p1 = __builtin_amdgcn_mfma_f32_32x32x16_bf16(fb[s], qr[s], (s == 0 && cinit) ? *cinit : p1, 0, 0, 0);
        __builtin_amdgcn_sched_barrier(0);
    }
#undef QK_LD
#undef QK_ADDR
}
constexpr float MLA_THR = 8.f;
__device__ __forceinline__ void mla_softmax(f32x16& p0, f32x16& p1, float& m_reg, float& l_reg, f32x16* o, ALAS float* al_l, int r32, int hi, bf16x8& pa0, bf16x8& pa1, bf16x8& pa2, bf16x8& pa3) {
    float pmax = p0[0];
#pragma unroll
    for (int r = 1; r < 16; ++r) pmax = fmaxf(pmax, p0[r]);
#pragma unroll
    for (int r = 0; r < 16; ++r) pmax = fmaxf(pmax, p1[r]);
    { auto rr = __builtin_amdgcn_permlane32_swap(__float_as_uint(pmax), __float_as_uint(pmax), false, false);
      pmax = fmaxf(__uint_as_float(rr[0]), __uint_as_float(rr[1])); }
    float mn = m_reg, alpha = 1.f;
    if (!__all(pmax - m_reg <= MLA_THR)) { mn = fmaxf(m_reg, pmax); alpha = __builtin_amdgcn_exp2f(m_reg - mn); m_reg = mn; }
    float ps = 0.f;
#pragma unroll
    for (int r = 0; r < 16; ++r) { p0[r] = __builtin_amdgcn_exp2f(p0[r] - mn); ps += p0[r]; }
#pragma unroll
    for (int r = 0; r < 16; ++r) { p1[r] = __builtin_amdgcn_exp2f(p1[r] - mn); ps += p1[r]; }
    { auto rr = __builtin_amdgcn_permlane32_swap(__float_as_uint(ps), __float_as_uint(ps), false, false);
      ps = __uint_as_float(rr[0]) + __uint_as_float(rr[1]); }
    l_reg = l_reg * alpha + ps;
    if (__any(alpha < 1.f)) {
        if (hi == 0) al_l[r32] = alpha;
        asm volatile("s_waitcnt lgkmcnt(0)" ::: "memory");
#pragma unroll
        for (int r = 0; r < 16; ++r) { const float a = al_l[crow(r, hi)];
#pragma unroll
            for (int d = 0; d < 4; ++d) o[d][r] *= a; }
        asm volatile("s_waitcnt lgkmcnt(0)" ::: "memory");
    }
    PK4(p0, 0, pa0); PK4(p0, 8, pa1); PK4(p1, 0, pa2); PK4(p1, 8, pa3);
}
__device__ __forceinline__ void mla_softmax_rel(f32x16& p0, f32x16& p1, float& m_reg, f32x16& negm, bool first, float& l_reg, f32x16* o, ALAS float* al_l, int r32, int hi, bf16x8& pa0, bf16x8& pa1, bf16x8& pa2, bf16x8& pa3) {
    float pmax = p0[0];
#pragma unroll
    for (int r = 1; r < 16; ++r) pmax = fmaxf(pmax, p0[r]);
#pragma unroll
    for (int r = 0; r < 16; ++r) pmax = fmaxf(pmax, p1[r]);
    { auto rr = __builtin_amdgcn_permlane32_swap(__float_as_uint(pmax), __float_as_uint(pmax), false, false);
      pmax = fmaxf(__uint_as_float(rr[0]), __uint_as_float(rr[1])); }
    if (first || !__all(pmax <= MLA_THR)) {
        const float delta = first ? pmax : fmaxf(pmax, 0.f); const float alpha = first ? 1.f : __builtin_amdgcn_exp2f(-delta);
        m_reg += delta; l_reg *= alpha;
#pragma unroll
        for (int r = 0; r < 16; ++r) { p0[r] -= delta; p1[r] -= delta; negm[r] = -m_reg; }
        if (!first) {
            if (hi == 0) al_l[r32] = alpha;
            asm volatile("s_waitcnt lgkmcnt(0)" ::: "memory");
#pragma unroll
            for (int r = 0; r < 16; ++r) { const float a = al_l[crow(r, hi)];
#pragma unroll
                for (int d = 0; d < 4; ++d) o[d][r] *= a; }
            asm volatile("s_waitcnt lgkmcnt(0)" ::: "memory");
        }
    }
    float ps = 0.f;
#pragma unroll
    for (int r = 0; r < 16; ++r) { p0[r] = __builtin_amdgcn_exp2f(p0[r]); ps += p0[r]; }
#pragma unroll
    for (int r = 0; r < 16; ++r) { p1[r] = __builtin_amdgcn_exp2f(p1[r]); ps += p1[r]; }
    { auto rr = __builtin_amdgcn_permlane32_swap(__float_as_uint(ps), __float_as_uint(ps), false, false);
      ps = __uint_as_float(rr[0]) + __uint_as_float(rr[1]); }
    l_reg += ps;
    PK4(p0, 0, pa0); PK4(p0, 8, pa1); PK4(p1, 0, pa2); PK4(p1, 8, pa3);
}
constexpr int M_OFF_V = 0, M_OFF_K = 49152, M_OFF_R = 81920, M_OFF_WS = 98304, MLA_LDS_BYTES = 98304 + 8 * 256;
template <bool ROLEB, int VAR = 0> __device__ __forceinline__ void mla_body(const Unit u, ALAS char* lds) {
    int tid_o = threadIdx.x; asm volatile("" : "+v"(tid_o));
    const int tid = tid_o, wid = __builtin_amdgcn_readfirstlane(tid >> 6), lane = tid & 63, r32 = lane & 31, hi = lane >> 5;
    const bool actw = wid < u.nact; constexpr bool roleB = ROLEB;
    const int sr = tid >> 4, sc = (tid & 15) * 8;
    const int vst0 = v_st(sr, sc), vst1 = v_st(32 + sr, sc), kws = KSWZ(sr, sc * 2);
    const int rk = tid >> 3, rc = (tid & 7) * 8, rws = RSWZ(rk, rc * 2);
    ALAS char* V_l = lds + M_OFF_V; ALAS char* K_l = lds + M_OFF_K; ALAS char* R_l = lds + M_OFF_R;
    ALAS float* al_l = (ALAS float*)(lds + M_OFF_WS) + wid * 64; ALAS float* li_l = al_l + 32;
    const unsigned vbase = (unsigned)(uintptr_t)V_l + (unsigned)v_rd_base(lane);
    bf16x8 qr[12];
#pragma unroll
    for (int d0 = 0; d0 < 12; ++d0) qr[d0] = (bf16x8){0, 0, 0, 0, 0, 0, 0, 0};
    if (actw) {
#pragma unroll
        for (int d0 = 0; d0 < 12; ++d0) qr[d0] = *(const bf16x8*)(u.Q + (size_t)(wid * 32 + r32) * u.ldq + d0 * 16 + hi * 8);
    }
    const int cw = (u.P0 + wid * 32) >> 6;
    float m_reg = -1e30f, l_reg = 0.f;
    f32x16 o[4], p0, p1;
#pragma unroll
    for (int r = 0; r < 16; ++r) { p0[r] = 0.f; p1[r] = 0.f; }
#pragma unroll
    for (int d = 0; d < 4; ++d)
#pragma unroll
        for (int r = 0; r < 16; ++r) o[d][r] = 0.f;
    bf16x8 st_k0, st_k1, st_v0, st_v1, st_r;
#define LOADT(tt) do { const size_t r0_ = (size_t)(tt) * 64; \
        st_k0 = *(const bf16x8*)(u.K + (r0_ + sr) * 2048 + sc); st_k1 = *(const bf16x8*)(u.K + (r0_ + 32 + sr) * 2048 + sc); \
        st_v0 = *(const bf16x8*)(u.V + (r0_ + sr) * 2048 + sc); st_v1 = *(const bf16x8*)(u.V + (r0_ + 32 + sr) * 2048 + sc); \
        st_r = *(const bf16x8*)(u.Kr + (r0_ + rk) * 64 + rc); } while (0)
#define MLA_QK(kb) do { _Pragma("unroll") for (int r = 0; r < 16; ++r) { p0[r] = 0.f; p1[r] = 0.f; } \
        if (VAR == 4 || VAR == 0 || VAR == 5) qk192_pipe(p0, p1, K_l + (kb) * 16384, R_l + (kb) * 8192, r32, hi, qr); else if (VAR != 3) { qk128(p0, p1, K_l + (kb) * 16384, r32, hi, qr); qk64(p0, p1, R_l + (kb) * 8192, r32, hi, qr + 8); } } while (0)
#define MLA_SMPV(vs) do { bf16x8 pa0, pa1, pa2, pa3; \
        if (VAR == 1) { PK4(p0, 0, pa0); PK4(p0, 8, pa1); PK4(p1, 0, pa2); PK4(p1, 8, pa3); l_reg += p0[0]; } \
        else mla_softmax(p0, p1, m_reg, l_reg, o, al_l, r32, hi, pa0, pa1, pa2, pa3); \
        if (VAR != 2) pv_tile(o, vbase + (unsigned)((vs) * 16384), pa0, pa1, pa2, pa3); \
        else { _Pragma("unroll") for (int r = 0; r < 4; ++r) o[r][0] += __builtin_bit_cast(float, (unsigned)pa0[r] ^ (unsigned)pa1[r] ^ (unsigned)pa2[r] ^ (unsigned)pa3[r]); } } while (0)
    LOADT(0);
    int vs_cur = 0, vs_prev = 2;
    for (int i = 0; i <= u.NT; ++i) {
        const int kb = i & 1;
        if (i < u.NT && VAR != 5) {
            *(ALAS bf16x8*)(K_l + kb * 16384 + kws) = st_k0; *(ALAS bf16x8*)(K_l + kb * 16384 + kws + 32 * 256) = st_k1;
            *(ALAS bf16x8*)(V_l + vs_cur * 16384 + vst0) = st_v0; *(ALAS bf16x8*)(V_l + vs_cur * 16384 + vst1) = st_v1;
            *(ALAS bf16x8*)(R_l + kb * 8192 + rws) = st_r;
            __syncthreads();
            if (i + 1 < u.NT) LOADT(i + 1);
        }
        if (actw) {
            if constexpr (!roleB) { if (i < u.NT && i <= cw) { MLA_QK(kb); MLA_SMPV(vs_cur); } }
            else { if (i >= 1 && i - 1 <= cw) MLA_SMPV(vs_prev);
                   if (i < u.NT && i <= cw) MLA_QK(kb); }
        }
        vs_prev = vs_cur; vs_cur = (vs_cur == 2) ? 0 : vs_cur + 1;
    }
    if (actw) {
        if (hi == 0) li_l[r32] = l_reg;
        asm volatile("s_waitcnt lgkmcnt(0)" ::: "memory");
        float rli[16];
#pragma unroll
        for (int r = 0; r < 16; ++r) rli[r] = 1.0f / li_l[crow(r, hi)];
        bf16* Ow = u.O + (size_t)(wid * 32) * u.ldo;
#pragma unroll
        for (int r = 0; r < 16; ++r) { const int orow = crow(r, hi); float sq = 0.f;
#pragma unroll
            for (int d0 = 0; d0 < 4; ++d0) { const float v = o[d0][r] * rli[r]; const float vn = __shfl_xor(v, 1); sq += v * v;
                if ((r32 & 1) == 0) *(unsigned*)(Ow + (size_t)orow * u.ldo + d0 * 32 + r32) = cvtpk(v, vn); }
            sq += __shfl_xor(sq, 1); sq += __shfl_xor(sq, 2); sq += __shfl_xor(sq, 4); sq += __shfl_xor(sq, 8); sq += __shfl_xor(sq, 16);
            if (ATT_SSQ_ATOMICS && r32 == 0) __hip_atomic_fetch_add(u.ssq + wid * 32 + orow, sq, __ATOMIC_RELAXED, __HIP_MEMORY_SCOPE_AGENT); }
    }
    __syncthreads();
#undef LOADT
#undef MLA_QK
#undef MLA_SMPV
}
constexpr int D_OFF_K = 0, D_OFF_R = 49152, D_OFF_V = 73728, D_OFF_WS = 122880, DMA_LDS_BYTES = 122880 + 8 * 256;
template <int VAR = 0> __device__ __forceinline__ void mla_unit_dma(const Unit u, ALAS char* lds) {
    int tid_o = threadIdx.x; asm volatile("" : "+v"(tid_o));
    const int tid = tid_o, wid = __builtin_amdgcn_readfirstlane(tid >> 6), lane = tid & 63, r32 = lane & 31, hi = lane >> 5;
    const bool actw = wid < u.nact;
    if (false) __builtin_amdgcn_s_setprio(1);
    ALAS char* K_l = lds + D_OFF_K; ALAS char* R_l = lds + D_OFF_R; ALAS char* V_l = lds + D_OFF_V;
    ALAS float* al_l = (ALAS float*)(lds + D_OFF_WS) + wid * 64; ALAS float* li_l = al_l + 32;
    const unsigned vbase = (unsigned)(uintptr_t)V_l + (unsigned)v_rd_base(lane);
    unsigned offK[2], offV[2], offR;
#pragma unroll
    for (int j = 0; j < 2; ++j) {
        const int p = wid + 8 * j;
        { const int r = 4 * p + (lane >> 4), c = (lane & 15) ^ (r & 15); offK[j] = (unsigned)(r * 4096 + c * 16); }
        { const int sti = 2 * p + (lane >> 5), kk = (sti >> 2) * 8 + ((lane & 31) >> 2), k = (kk & ~0xC) | ((kk & 4) << 1) | ((kk & 8) >> 1), c = (sti & 3) * 32 + (lane & 3) * 8; offV[j] = (unsigned)(k * 4096 + c * 2); }
    }
    { const int r = 8 * wid + (lane >> 3), c = (lane & 7) ^ ((r >> 1) & 7); offR = (unsigned)(r * 128 + c * 16); }
    const char* gK = (const char*)u.K; const char* gV = (const char*)u.V; const char* gR = (const char*)u.Kr;
#define DMA_TILE(tt, slot) do { const size_t tb_ = (size_t)(tt) * 64; \
        __builtin_amdgcn_global_load_lds((const unsigned*)(gK + tb_ * 4096 + offK[0]), (ALAS unsigned*)(K_l + (slot) * 16384 + wid * 1024), 16, 0, 0); \
        __builtin_amdgcn_global_load_lds((const unsigned*)(gK + tb_ * 4096 + offK[1]), (ALAS unsigned*)(K_l + (slot) * 16384 + (wid + 8) * 1024), 16, 0, 0); \
        __builtin_amdgcn_global_load_lds((const unsigned*)(gR + tb_ * 128 + offR), (ALAS unsigned*)(R_l + (slot) * 8192 + wid * 1024), 16, 0, 0); \
        __builtin_amdgcn_global_load_lds((const unsigned*)(gV + tb_ * 4096 + offV[0]), (ALAS unsigned*)(V_l + (slot) * 16384 + wid * 1024), 16, 0, 0); \
        __builtin_amdgcn_global_load_lds((const unsigned*)(gV + tb_ * 4096 + offV[1]), (ALAS unsigned*)(V_l + (slot) * 16384 + (wid + 8) * 1024), 16, 0, 0); } while (0)
    bf16x8 qr[12];
#pragma unroll
    for (int d0 = 0; d0 < 12; ++d0) qr[d0] = (bf16x8){0, 0, 0, 0, 0, 0, 0, 0};
    if (actw) {
#pragma unroll
        for (int d0 = 0; d0 < 12; ++d0) qr[d0] = *(const bf16x8*)(u.Q + (size_t)(wid * 32 + r32) * u.ldq + d0 * 16 + hi * 8);
    }
#pragma unroll
    for (int d0 = 0; d0 < 12; ++d0) asm volatile("" : "+v"(qr[d0]));
    DMA_TILE(0, 0); if (u.NT > 1) DMA_TILE(1, 1);
    const int cw = (u.P0 + wid * 32) >> 6;
    float m_reg = 0.f, l_reg = 0.f;
    f32x16 o[4], p0, p1, negm;
#pragma unroll
    for (int r = 0; r < 16; ++r) negm[r] = 0.f;
#pragma unroll
    for (int d = 0; d < 4; ++d)
#pragma unroll
        for (int r = 0; r < 16; ++r) o[d][r] = 0.f;
    int sl = 0, sl2 = 2;
    for (int i = 0; i < u.NT; ++i) {
        if (i + 1 < u.NT) asm volatile("s_waitcnt vmcnt(5) lgkmcnt(0)" ::: "memory"); else asm volatile("s_waitcnt vmcnt(0) lgkmcnt(0)" ::: "memory");
        __builtin_amdgcn_s_barrier(); asm volatile("" ::: "memory");
        if (i + 2 < u.NT) DMA_TILE(i + 2, sl2);
        if (actw && i <= cw) {
            __builtin_amdgcn_s_setprio(1); qk192_pipe(p0, p1, K_l + sl * 16384, R_l + sl * 8192, r32, hi, qr, &negm); __builtin_amdgcn_s_setprio(0);
            bf16x8 pa0, pa1, pa2, pa3;
            mla_softmax_rel(p0, p1, m_reg, negm, i == 0, l_reg, o, al_l, r32, hi, pa0, pa1, pa2, pa3);
            __builtin_amdgcn_s_setprio(1); pv_tile(o, vbase + (unsigned)(sl * 16384), pa0, pa1, pa2, pa3); __builtin_amdgcn_s_setprio(0);
        }
        sl = (sl == 2) ? 0 : sl + 1; sl2 = (sl2 == 2) ? 0 : sl2 + 1;
    }
    asm volatile("s_waitcnt lgkmcnt(0)" ::: "memory"); __builtin_amdgcn_s_barrier(); asm volatile("" ::: "memory");
    if (actw) {
        if (hi == 0) li_l[r32] = l_reg;
        asm volatile("s_waitcnt lgkmcnt(0)" ::: "memory");
        float rli[16];
#pragma unroll
        for (int r = 0; r < 16; ++r) rli[r] = 1.0f / li_l[crow(r, hi)];
        store_o_staged(o, rli, u.O + (size_t)(wid * 32) * u.ldo, u.ldo, lds + wid * 8192, lane, r32, hi, u.ssq + (size_t)(wid * 32) * 32);
    }
    asm volatile("s_waitcnt lgkmcnt(0)" ::: "memory"); __builtin_amdgcn_s_barrier(); asm volatile("" ::: "memory");
    __builtin_amdgcn_s_setprio(0);
#undef DMA_TILE
}
template <int VAR = 0> __device__ __forceinline__ void mla_unit(const Unit u, ALAS char* lds) {
    int tid_o = threadIdx.x; asm volatile("" : "+v"(tid_o));
    if (__builtin_amdgcn_readfirstlane(tid_o >> 6) >= 4) mla_body<true, VAR>(u, lds); else mla_body<false, VAR>(u, lds);
}
#undef PK4
}
#define GAS __attribute__((address_space(1)))
#define LAS __attribute__((address_space(3)))
typedef unsigned short bf16;
typedef unsigned v4u __attribute__((ext_vector_type(4)));
typedef float f32x4 __attribute__((ext_vector_type(4)));
typedef short bf16x8 __attribute__((ext_vector_type(8)));
typedef GAS unsigned gu32;
typedef GAS unsigned long long gu64;
#define RLX_AGENT __ATOMIC_RELAXED, __HIP_MEMORY_SCOPE_AGENT
#define LDS_WAIT() asm volatile("s_waitcnt lgkmcnt(0)" ::: "memory")
#define VM_WAIT() asm volatile("s_waitcnt vmcnt(0)" ::: "memory")
__device__ __forceinline__ unsigned long long rt() { return __builtin_amdgcn_s_memrealtime(); }
__device__ __forceinline__ unsigned f2bf(float f) { unsigned u = __builtin_bit_cast(unsigned, f); return (u + 0x7fffu + ((u >> 16) & 1u)) >> 16; }
__device__ __forceinline__ unsigned pk2(float lo, float hi) { return f2bf(lo) | (f2bf(hi) << 16); }

#define XB_TMO      128
#define XB_XCNT(j)  (256  + 64 * (j))
#define XB_XSUB(j)  (1280 + 64 * (j))
#define XB_XGEN(j)  (2304 + 64 * (j))
#define XB_TOP      3328
#define XB_TOPGEN   3392
#define XCD_BAR_WORDS 3456
#define XB_SPIN_CAP (1u << 18)

__device__ __forceinline__ unsigned xb_ld(unsigned* p)              { return __hip_atomic_load(p, __ATOMIC_RELAXED, __HIP_MEMORY_SCOPE_AGENT); }
__device__ __forceinline__ unsigned xb_add(unsigned* p, unsigned v) { return __hip_atomic_fetch_add(p, v, __ATOMIC_RELAXED, __HIP_MEMORY_SCOPE_AGENT); }
__device__ __forceinline__ unsigned xb_xcc_id() { return (unsigned)__builtin_amdgcn_s_getreg((3 << 11) | 20) & 0xFu; }
#define XB_SPIN(cond, bar) do { unsigned _sp = 0; while (cond) { __builtin_amdgcn_s_sleep(1); \
    if ((++_sp & 255u) == 0u) { if (xb_ld(&(bar)[XB_TMO])) break; if (_sp > XB_SPIN_CAP) { atomicAdd(&(bar)[XB_TMO], 1u); break; } } } } while (0)

struct XcdBarrier {
    unsigned* bar; unsigned x;
    volatile LAS unsigned* st;
};

__device__ __forceinline__ XcdBarrier xcd_barrier_post(unsigned* bar, volatile LAS unsigned* st) {
    XcdBarrier b; b.bar = bar; b.x = xb_xcc_id(); b.st = st;
    if (threadIdx.x == 0) (void)xb_add(&bar[XB_XCNT(b.x)], 1u);
    return b;
}
__device__ __forceinline__ void xcd_barrier_complete(unsigned* bar, unsigned x, unsigned& nloc, unsigned& nx) {
    const unsigned G = gridDim.x * gridDim.y * gridDim.z;
    unsigned sum, cnt, mine, sp = 0u;
    for (;;) {
        sum = 0u; cnt = 0u; mine = 0u;
#pragma unroll
        for (unsigned j = 0; j < 16; ++j) { const unsigned c = xb_ld(&bar[XB_XCNT(j)]); sum += c; cnt += (c > 0u) ? 1u : 0u; mine = (j == x) ? c : mine; }
        if (sum == G) break;
        __builtin_amdgcn_s_sleep(1);
        if ((++sp & 255u) == 0u) { if (xb_ld(&bar[XB_TMO])) break; if (sp > XB_SPIN_CAP) { atomicAdd(&bar[XB_TMO], 1u); break; } }
    }
    nloc = mine > 0u ? mine : 1u; nx = cnt > 0u ? cnt : 1u;
}

__device__ __forceinline__ void xcd_barrier(const XcdBarrier& b) {
    asm volatile("s_waitcnt vmcnt(0)" ::: "memory");
    __syncthreads();
    if (threadIdx.x == 0) {
        unsigned* bar = b.bar;
        __builtin_amdgcn_s_waitcnt(0);
        unsigned nloc = b.st[0], nx = b.st[1];
        if (nloc == 0u) { xcd_barrier_complete(bar, b.x, nloc, nx); b.st[0] = nloc; b.st[1] = nx; }
        const unsigned old = xb_add(&bar[XB_XSUB(b.x)], 1u);
        const unsigned gen = old / nloc;
        if (old + 1u == (gen + 1u) * nloc) {
            __builtin_amdgcn_fence(__ATOMIC_RELEASE, "agent");
            asm volatile("s_waitcnt vmcnt(0)" ::: "memory");
            const unsigned og = xb_add(&bar[XB_TOP], 1u);
            const unsigned tg = og / nx;
            if (og + 1u == (tg + 1u) * nx) xb_add(&bar[XB_TOPGEN], 1u);
            else XB_SPIN(xb_ld(&bar[XB_TOPGEN]) == tg, bar);
            __builtin_amdgcn_fence(__ATOMIC_ACQUIRE, "agent");
            xb_add(&bar[XB_XGEN(b.x)], 1u);
            asm volatile("s_waitcnt vmcnt(0)" ::: "memory");
        } else {
            XB_SPIN(xb_ld(&bar[XB_XGEN(b.x)]) == gen, bar);
            __builtin_amdgcn_fence(__ATOMIC_ACQUIRE, "agent");
            asm volatile("s_waitcnt vmcnt(0)" ::: "memory");
        }
    }
    __syncthreads();
}
constexpr int NWAVES = 8;
constexpr int DM = 4096, NP = 16384, NS = 512, MTOK = NP + NS;
constexpr int SEQ = 4096, PAST = 1024, DSEQ = 64, SKVS = PAST + DSEQ;
constexpr int KVROWS = NP + 8 * SKVS;
constexpr int NINP = 7936;
constexpr int QLORA = 1024, KVLORA = 512, ROPE = 64, NOPE = 128, NH = 16, DFF = 16384;
constexpr float EPS = 1e-6f;
constexpr float LOG2E = 1.4426950408889634f;
constexpr float QS_MLA = 0.07216878364870322f * LOG2E;
constexpr float QS_SB = 0.08838834764831845f * LOG2E;

constexpr size_t O_Y = 0, O_CKV_P = 69206016, O_KR_P = 85983232, O_SBK_P = 88080384, O_SBV_P = 155189248,
                 O_CKV_S = 222298112, O_KR_S = 222822400, O_SBK_S = 222887936, O_SBV_S = 224985088, O_END = 227082240;

constexpr size_t MiB = 1u << 20;
constexpr size_t WS_CTL = 0, CTL_ZERO_BYTES = 1 * MiB;
constexpr size_t WS_SSQH = 512 * 1024;
constexpr size_t WS_TAB = 1 * MiB;
constexpr size_t WS_WIN = 2 * MiB;
constexpr size_t WS_WQB = 64 * MiB;
constexpr size_t WS_WKVB = 70 * MiB;
constexpr size_t WS_WO = 74 * MiB;
constexpr size_t WS_WUP = 106 * MiB;
constexpr size_t WS_WDN = 234 * MiB;
constexpr size_t WS_XN = 362 * MiB;
constexpr size_t WS_R = 494 * MiB;
constexpr size_t WS_U = WS_R;
constexpr size_t WS_QLAT = WS_R;
constexpr size_t WS_AKV = WS_QLAT + 33 * MiB;
constexpr size_t WS_KROPE = WS_AKV + 25 * MiB;
constexpr size_t WS_VB = WS_KROPE + 4 * MiB;
constexpr size_t WS_QB = WS_VB + 98 * MiB;
constexpr size_t WS_KN = WS_QB + 99 * MiB;
constexpr size_t WS_SBQ = WS_KN + 98 * MiB;
constexpr size_t WS_SBK = WS_SBQ + 66 * MiB;
constexpr size_t WS_SBV = WS_SBK + 98 * MiB;
constexpr size_t WS_R2 = WS_SBV + 98 * MiB;
constexpr size_t WS_LAT = WS_R2;
constexpr size_t WS_QRAW = WS_R2;
constexpr size_t WS_KNRAW = WS_R2 + 198 * MiB;
constexpr size_t WS_MLAO = WS_R2;
constexpr size_t WS_SBO = WS_R2 + 66 * MiB;
constexpr size_t WS_MERGED = WS_R2 + 132 * MiB;
constexpr size_t WS_SLAB = WS_R2;
constexpr size_t WS_Y0B = WS_R2 + 264 * MiB;
constexpr size_t WS_WDN1 = WS_R2 + 398 * MiB;
constexpr size_t WS_SSQP = WS_WDN1 + 128 * MiB;
constexpr size_t WS_END = WS_SSQP + 3 * MiB;
static_assert(WS_U + (size_t)MTOK * DFF * 2 <= WS_END, "U fits the overlay region");
static_assert(WS_XN + (size_t)MTOK * DM * 2 <= WS_R && WS_WDN + (size_t)DM * DFF * 2 <= WS_XN && WS_WIN + (size_t)NINP * DM * 2 <= WS_WQB, "ws map");
constexpr int CW_TMO = 0, CW_CODE = 1, CW_BAR = 4096;

constexpr int RING_OFF = 0, RING_BYTES = 131072;
constexpr int LDSCTL_OFF = RING_BYTES, MISC_OFF = LDSCTL_OFF + 320;
constexpr int XCH_OFF = LDSCTL_OFF + 1024;
constexpr int LDS_BYTES = 147456;
static_assert(XCH_OFF + 8192 <= LDS_BYTES, "LDS map");
static_assert(att::ATT_LDS_BYTES <= RING_BYTES && att::MLA_LDS_BYTES <= RING_BYTES && att::DMA_LDS_BYTES <= RING_BYTES, "attention scratch fits the ring region");

#if defined(__HIP_DEVICE_COMPILE__)
#define ASSUME_GLOBAL(p) do { __builtin_assume(!__builtin_amdgcn_is_shared((const __attribute__((address_space(0))) void*)(p))); __builtin_assume(!__builtin_amdgcn_is_private((const __attribute__((address_space(0))) void*)(p))); } while (0)
#else
#define ASSUME_GLOBAL(p) do { } while (0)
#endif
typedef float f32x2 __attribute__((ext_vector_type(2)));
__device__ __forceinline__ float wave_sum(float v) {
#pragma unroll
    for (int o = 1; o < 64; o <<= 1) v += __shfl_xor(v, o);
    return v;
}
__device__ __forceinline__ unsigned pkbf(float lo, float hi) { return pg8::cvt_pk_bf16(lo, hi); }
__device__ __forceinline__ float bf2f(unsigned short b) { return __uint_as_float(((unsigned)b) << 16); }
__device__ __forceinline__ int kvrow_of(int m) { return m < NP ? m : NP + ((m - NP) >> 6) * SKVS + PAST + ((m - NP) & 63); }
__device__ __forceinline__ int pos_of(int m) { return m < NP ? (m & (SEQ - 1)) : PAST + ((m - NP) & 63); }

__device__ __forceinline__ void sincos_acc(float ang, float& s, float& c) {
    const double a = (double)ang; const double q = rint(a * 0.63661977236758134308);
    double r = fma(-q, 1.57079632679489661923, a); r = fma(-q, 6.123233995736766e-17, r);
    const float rf = (float)r; const int qi = (int)q; const float r2 = rf * rf;
    const float sp = rf + rf * r2 * (-1.6666667163e-1f + r2 * (8.3333337680e-3f + r2 * (-1.9841270114e-4f + r2 * 2.7557314297e-6f)));
    const float cp = 1.f + r2 * (-0.5f + r2 * (4.1666667908e-2f + r2 * (-1.3888889225e-3f + r2 * (2.4801587642e-5f + r2 * (-2.7557314297e-7f)))));
    switch (qi & 3) { case 0: s = sp; c = cp; break; case 1: s = cp; c = -sp; break; case 2: s = -sp; c = -cp; break; default: s = -cp; c = sp; break; }
}

struct Frame {
    LAS unsigned char* lds; volatile LAS unsigned* MISC; gu32* ctl;
    int tid, lane, wave, vcu, G;
};
struct Args { const float* in[22]; float* out; unsigned char* ws; };

struct TItem { const float* src; bf16* dst; const float* gk; int N, K; };
__device__ __forceinline__ void ti_load(const TItem& P, float (&tv)[32], f32x4& g0, f32x4& g1, int lane) {
    if (P.gk) { g0 = *(const GAS f32x4*)(P.gk + 8 * (lane & 7)); g1 = *(const GAS f32x4*)(P.gk + 8 * (lane & 7) + 4); }
    else { g0 = f32x4{1.f, 1.f, 1.f, 1.f}; g1 = g0; }
    const GAS float* s = (const GAS float*)P.src + (size_t)(lane >> 5) * P.N + (lane & 31);
#pragma unroll
    for (int i = 0; i < 32; ++i) tv[i] = __builtin_nontemporal_load(s + (size_t)(2 * i) * P.N);
}
__device__ __forceinline__ void ti_finish(const TItem& P, const float (&tv)[32], const f32x4 g0, const f32x4 g1, LAS float* scr, int lane) {
#pragma unroll
    for (int i = 0; i < 32; ++i) scr[(2 * i + (lane >> 5)) * 33 + (lane & 31)] = tv[i];
    LDS_WAIT(); asm volatile("" ::: "memory");
    const int c = lane & 7;
#pragma unroll
    for (int j = 0; j < 4; ++j) { const int n = (lane >> 3) + 8 * j; const LAS float* s = scr + (8 * c) * 33 + n;
        v4u o; o.x = pkbf(s[0 * 33] * g0.x, s[1 * 33] * g0.y); o.y = pkbf(s[2 * 33] * g0.z, s[3 * 33] * g0.w); o.z = pkbf(s[4 * 33] * g1.x, s[5 * 33] * g1.y); o.w = pkbf(s[6 * 33] * g1.z, s[7 * 33] * g1.w);
        __builtin_nontemporal_store(o, (GAS v4u*)(P.dst + (size_t)n * P.K + 8 * c)); }
    LDS_WAIT(); asm volatile("" ::: "memory");
}
__device__ __forceinline__ void rms_row_4096(const float* xrow, const float* g, bf16* orow, int lane) {
    const GAS f32x4* xr = (const GAS f32x4*)xrow + lane; const GAS f32x4* gr = (const GAS f32x4*)g + lane;
    f32x4 v[16]; float s = 0.f;
#pragma unroll
    for (int j = 0; j < 16; ++j) { v[j] = xr[64 * j]; s += (v[j].x * v[j].x + v[j].y * v[j].y) + (v[j].z * v[j].z + v[j].w * v[j].w); }
    const float rstd = 1.0f / sqrtf(wave_sum(s) * (1.f / 4096.f) + EPS);
    GAS unsigned long long* o8 = (GAS unsigned long long*)orow + lane;
#pragma unroll
    for (int j = 0; j < 16; ++j) { const f32x4 gg = gr[64 * j];
        o8[64 * j] = (unsigned long long)pkbf(v[j].x * rstd * gg.x, v[j].y * rstd * gg.y) | ((unsigned long long)pkbf(v[j].z * rstd * gg.z, v[j].w * rstd * gg.w) << 32); }
}
__device__ __forceinline__ void rms_row_4096_bf16(const bf16* xrow, const float* g, bf16* orow, int lane) {
    const GAS v4u* xr = (const GAS v4u*)xrow + lane; float x[64]; float s = 0.f;
#pragma unroll
    for (int j = 0; j < 8; ++j) { const v4u w = xr[64 * j]; const unsigned ww[4] = {w.x, w.y, w.z, w.w};
#pragma unroll
        for (int e = 0; e < 4; ++e) { x[8 * j + 2 * e] = __uint_as_float(ww[e] << 16); x[8 * j + 2 * e + 1] = __uint_as_float(ww[e] & 0xffff0000u); } }
#pragma unroll
    for (int i = 0; i < 64; ++i) s += x[i] * x[i];
    const float rstd = 1.0f / sqrtf(wave_sum(s) * (1.f / 4096.f) + EPS);
#pragma unroll
    for (int j = 0; j < 8; ++j) { const GAS f32x4* gp = (const GAS f32x4*)(g + 8 * (64 * j + lane)); const f32x4 g0 = gp[0], g1 = gp[1];
        v4u o; o.x = pkbf(x[8 * j] * rstd * g0.x, x[8 * j + 1] * rstd * g0.y); o.y = pkbf(x[8 * j + 2] * rstd * g0.z, x[8 * j + 3] * rstd * g0.w);
        o.z = pkbf(x[8 * j + 4] * rstd * g1.x, x[8 * j + 5] * rstd * g1.y); o.w = pkbf(x[8 * j + 6] * rstd * g1.z, x[8 * j + 7] * rstd * g1.w);
        *((GAS v4u*)orow + 64 * j + lane) = o; }
}
__device__ __forceinline__ void cache_rows_to_bf16(const float* src, bf16* dst, int W, int gthread, int nthreads) {
    const int per_row = W >> 2; const long total = (long)8 * PAST * per_row;
    for (long i = gthread; i < total; i += nthreads) {
        const int row = (int)(i / per_row), c4 = (int)(i % per_row), b = row >> 10, j = row & 1023;
        const f32x4 v = *(const GAS f32x4*)(src + (size_t)row * W + c4 * 4);
        *(GAS unsigned long long*)(dst + (size_t)(NP + b * SKVS + j) * W + c4 * 4) = (unsigned long long)pkbf(v.x, v.y) | ((unsigned long long)pkbf(v.z, v.w) << 32);
    }
}

template <bool NORM, class Order>
__device__ __forceinline__ void tail_reduce_res(const Order& S, const float* resP, const float* resS, float* out, bf16* HB, float* ssq, const float* ssqm, const float* ssqs, bf16* YB, int tid) {
    if (S.nsplit == 1) return;
    const int wid = __builtin_amdgcn_readfirstlane(tid >> 6), lane = tid & 63, wr = wid >> 2, wc = wid & 3, fr = lane & 15, fq = lane >> 4;
    const int j = S.c / S.nsplit, p = S.c % S.nsplit, per = 32 / S.nsplit;
    pg8::Unit u; S.map(S.nfull * S.G + j, u);
    for (int ii = 0; ii < per; ++ii) {
        const int idx = p * per + ii, a = idx >> 4, b = (idx >> 3) & 1, mm = (idx >> 1) & 3, n = idx & 1;
        const int row = u.pm * 256 + a * 128 + wr * 64 + mm * 16 + fr, col = u.pn * 256 + b * 128 + wc * 32 + 8 * fq + 4 * n;
        f32x4 s = {0.f, 0.f, 0.f, 0.f}, s2 = {0.f, 0.f, 0.f, 0.f};
        for (int sp = 0; sp < S.nsplit; ++sp) { const f32x4 v = *((const GAS f32x4*)(S.slab + (size_t)(j * S.nsplit + sp) * 65536) + (size_t)wid * 2048 + idx * 64 + lane); if (2 * sp < S.nsplit) s += v; else s2 += v; }
        if (NORM) {
            const float rm = 1.0f / sqrtf(__hip_atomic_load(ssqm + row, __ATOMIC_RELAXED, __HIP_MEMORY_SCOPE_AGENT) * (1.f / 2048.f) + EPS), rs = 1.0f / sqrtf(__hip_atomic_load(ssqs + row, __ATOMIC_RELAXED, __HIP_MEMORY_SCOPE_AGENT) * (1.f / 2048.f) + EPS);
            s = s * rm + s2 * rs; } else s += s2;
        f32x4 v;
        if (NORM) { if (YB) { const unsigned long long h = *(const GAS unsigned long long*)(YB + (size_t)row * DM + col); const unsigned h0 = (unsigned)h, h1 = (unsigned)(h >> 32);
                                v = (f32x4){__uint_as_float(h0 << 16), __uint_as_float(h0 & 0xffff0000u), __uint_as_float(h1 << 16), __uint_as_float(h1 & 0xffff0000u)} + s; }
                    else { const float* rp = (row >= NP) ? resS + (size_t)(row - NP) * DM + col : resP + (size_t)row * DM + col; v = *(const GAS f32x4*)rp + s; } }
        else { const unsigned long long h = *(const GAS unsigned long long*)(HB + (size_t)row * DM + col); const unsigned h0 = (unsigned)h, h1 = (unsigned)(h >> 32);
               v = (f32x4){__uint_as_float(h0 << 16), __uint_as_float(h0 & 0xffff0000u), __uint_as_float(h1 << 16), __uint_as_float(h1 & 0xffff0000u)} + s;
               if (YB) { *(GAS unsigned long long*)(YB + (size_t)row * DM + col) = (unsigned long long)pkbf(v.x, v.y) | ((unsigned long long)pkbf(v.z, v.w) << 32);
                         float q = (v.x * v.x + v.y * v.y) + (v.z * v.z + v.w * v.w); q += __shfl_xor(q, 16); q += __shfl_xor(q, 32);
                         if (fq == 0) __hip_atomic_fetch_add(ssq + row, q, __ATOMIC_RELAXED, __HIP_MEMORY_SCOPE_AGENT); }
               else *(GAS f32x4*)(out + (size_t)row * DM + col) = v; }
        if (NORM) {
            *(GAS unsigned long long*)(HB + (size_t)row * DM + col) = (unsigned long long)pkbf(v.x, v.y) | ((unsigned long long)pkbf(v.z, v.w) << 32);
            float q = (v.x * v.x + v.y * v.y) + (v.z * v.z + v.w * v.w); q += __shfl_xor(q, 16); q += __shfl_xor(q, 32);
            if (fq == 0) __hip_atomic_fetch_add(ssq + row, q, __ATOMIC_RELAXED, __HIP_MEMORY_SCOPE_AGENT);
        }
    }
}

__global__ void __launch_bounds__(NWAVES * 64, 2) hymba_fwd(Args args) {
    extern __shared__ __attribute__((aligned(16))) unsigned char lds[];
    Frame F;
    F.lds = (LAS unsigned char*)lds;
    F.MISC = (volatile LAS unsigned*)(F.lds + MISC_OFF);
    F.tid = threadIdx.x; F.lane = F.tid & 63; F.wave = __builtin_amdgcn_readfirstlane(F.tid >> 6);
    F.G = gridDim.x; { const int bx = blockIdx.x; F.vcu = (F.G % 8 == 0) ? (bx % 8) * (F.G / 8) + bx / 8 : bx; }
    unsigned char* ws = args.ws;
    F.ctl = (gu32*)(ws + WS_CTL);
    for (int u = F.tid; u < (LDS_BYTES - LDSCTL_OFF) / 4; u += NWAVES * 64) ((LAS unsigned*)(F.lds + LDSCTL_OFF))[u] = 0u;
    __syncthreads();
    XcdBarrier bar = xcd_barrier_post((unsigned*)(F.ctl + CW_BAR), F.MISC + 8);
#ifndef G5_WGM
#define G5_WGM 8
#endif
#ifndef PROBE_MASK
#define PROBE_MASK 0
#endif
#ifndef PROBE_BAR
#define PROBE_BAR 1
#endif
#ifndef PHMASK
#define PHMASK 0x3fff
#endif
#define GRID_BAR() do { for (int br_ = 0; br_ < PROBE_BAR; ++br_) xcd_barrier(bar); } while (0)
#define PHASE_PTRS() unsigned long long zoff_ = 0; asm volatile("" : "+s"(zoff_)); unsigned char* const wsb = args.ws + zoff_; float* const OUT = args.out + zoff_;     int ptid_ = threadIdx.x; asm volatile("" : "+v"(ptid_)); int bx_ = blockIdx.x, G_ = gridDim.x; asm volatile("" : "+s"(bx_), "+s"(G_)); const int VCU = (G_ % 8 == 0) ? (bx_ % 8) * (G_ / 8) + bx_ / 8 : bx_; (void)VCU; \
    const int LANE = ptid_ & 63, WAVE = __builtin_amdgcn_readfirstlane(ptid_ >> 6); const int gw = VCU * NWAVES + WAVE, NGW = G_ * NWAVES; const int gthread = gw * 64 + LANE, nthreads = NGW * 64; (void)gthread; (void)nthreads; (void)gw; (void)NGW; (void)LANE
#define WIN_T ((bf16*)(wsb + WS_WIN))
#define WQB_T ((bf16*)(wsb + WS_WQB))
#define WKVB_T ((bf16*)(wsb + WS_WKVB))
#define WO_T ((bf16*)(wsb + WS_WO))
#define WUP_T ((bf16*)(wsb + WS_WUP))
#define WDN_T0 ((bf16*)(wsb + WS_WDN))
#define WDN_T1 ((bf16*)(wsb + WS_WDN1))
#define XN ((bf16*)(wsb + WS_XN))
#define UB ((bf16*)(wsb + WS_U))
#define QLAT ((bf16*)(wsb + WS_QLAT))
#define AKV ((bf16*)(wsb + WS_AKV))
#define KROPE ((bf16*)(wsb + WS_KROPE))
#define VB ((bf16*)(wsb + WS_VB))
#define QB ((bf16*)(wsb + WS_QB))
#define KN ((bf16*)(wsb + WS_KN))
#define SBQ ((bf16*)(wsb + WS_SBQ))
#define SBK ((bf16*)(wsb + WS_SBK))
#define SBV ((bf16*)(wsb + WS_SBV))
#define LAT ((float*)(wsb + WS_LAT))
#define QRAW ((float*)(wsb + WS_QRAW))
#define KNRAW ((float*)(wsb + WS_KNRAW))
#define MLAO ((bf16*)(wsb + WS_MLAO))
#define SBO ((bf16*)(wsb + WS_SBO))
#define MERGED ((bf16*)(wsb + WS_MERGED))
#define TAB ((f32x2*)(wsb + WS_TAB))
#define SLAB ((float*)(wsb + WS_SLAB))
#define Y0B ((bf16*)(wsb + WS_Y0B))
#define SSQH ((float*)(wsb + WS_SSQH))
#define SSQM ((float*)(wsb + WS_SSQH + 128 * 1024))
#define SSQS ((float*)(wsb + WS_SSQH + 256 * 1024))
#define SSQP ((float*)(wsb + WS_SSQP))
#define SSQY ((float*)(wsb + WS_SSQH + 384 * 1024))

    { PHASE_PTRS(); (void)OUT;
    for (int i = gthread; i < SEQ * 32; i += nthreads) {
        const int pos = i >> 5, k = i & 31;
        const float inv_freq = exp2f(-(float)k * (13.287712379549449f / 32.f));
        float s, c; sincos_acc((float)pos * inv_freq, s, c); TAB[i] = (f32x2){c, s};
    } }

#define CONVERT_ITEMS(LW, R_LO, R_HI, GWV, NGWV) do { \
        const float* w_in = args.in[7] + (size_t)(LW) * DM * 7744; const float* w_qb = args.in[9] + (size_t)(LW) * QLORA * 3072; \
        const float* w_kvb = args.in[11] + (size_t)(LW) * KVLORA * 4096; const float* w_o = args.in[18] + (size_t)(LW) * DM * DM; \
        const float* w_up = args.in[20] + (size_t)(LW) * DM * DFF; const float* w_dn = args.in[21] + (size_t)(LW) * DFF * DM; const int lw_ = (LW); \
        auto dec_ = [&](int it) -> TItem { \
                int r = (R_HI) - 1 - it; \
                if (r < I_IN) { const int kb = r / 242, nb = r % 242, n0 = nb * 32; return TItem{w_in + (size_t)(kb * 64) * 7744 + n0, WIN_T + (size_t)(n0 + (n0 >= 1600 ? 192 : 0)) * DM + kb * 64, lw_ ? args.in[6] + (size_t)lw_ * DM + kb * 64 : nullptr, 7744, DM}; } r -= I_IN; \
                if (r < I_QB) { const int kb = r / 96, nb = r % 96, n0 = nb * 32, h = n0 / 192, dd = n0 % 192; \
                    return TItem{w_qb + (size_t)(kb * 64) * 3072 + n0, WQB_T + (size_t)(dd < 128 ? h * 128 + dd : 2048 + (h >> 2) * 256 + ((dd - 128) >> 5) * 128 + (h & 3) * 32) * QLORA + kb * 64, nullptr, 3072, QLORA}; } r -= I_QB; \
                if (r < I_KVB) { const int kb = r / 128, nb = r % 128, n0 = nb * 32, h = n0 >> 8, dd = n0 & 255; \
                    return TItem{w_kvb + (size_t)(kb * 64) * 4096 + n0, WKVB_T + (size_t)(dd < 128 ? h * 128 + dd : 2048 + h * 128 + (dd - 128)) * KVLORA + kb * 64, nullptr, 4096, KVLORA}; } r -= I_KVB; \
                if (r < I_O) { const int kb = r / 128, nb = r % 128; \
                    return TItem{w_o + (size_t)(kb * 64) * DM + nb * 32, WO_T + (size_t)(nb * 32) * DM + kb * 64, (kb < 32 ? args.in[16] + (size_t)lw_ * 2048 : args.in[17] + (size_t)lw_ * 2048 - 2048) + kb * 64, DM, DM}; } r -= I_O; \
                if (r < I_UP) { const int kb = r / 512, nb = r % 512; return TItem{w_up + (size_t)(kb * 64) * DFF + nb * 32, WUP_T + (size_t)(nb * 32) * DM + kb * 64, args.in[19] + (size_t)lw_ * DM + kb * 64, DFF, DM}; } r -= I_UP; \
                { const int kb = r / 128, nb = r % 128; return TItem{w_dn + (size_t)(kb * 64) * DM + nb * 32, (lw_ ? WDN_T1 : WDN_T0) + ((size_t)((nb >> 3) * 256 + kb) * 256 + (nb & 7) * 32) * 64, nullptr, DM, 64}; } }; \
        const int n_ = (R_HI) - (R_LO); int it = (GWV); \
        if (it < n_) { \
            float tA[32], tB[32]; f32x4 gA0, gA1, gB0, gB1; \
            TItem PA = dec_(it), PB; ti_load(PA, tA, gA0, gA1, LANE); \
            for (;;) {                                     \
                const int it1 = it + (NGWV); PB = dec_(it1 < n_ ? it1 : it); ti_load(PB, tB, gB0, gB1, LANE); \
                ti_finish(PA, tA, gA0, gA1, scr, LANE); \
                if (it1 >= n_) break; \
                const int it2 = it1 + (NGWV); PA = dec_(it2 < n_ ? it2 : it1); ti_load(PA, tA, gA0, gA1, LANE); \
                ti_finish(PB, tB, gB0, gB1, scr, LANE); \
                if (it2 >= n_) break; \
                it = it2; \
            } } } while (0)
    constexpr int I_IN = 64 * 242, I_QB = 16 * 96, I_KVB = 8 * 128, I_O = 64 * 128, I_UP = 64 * 512, I_DN = 256 * 128;
    constexpr int NITEMS = I_IN + I_QB + I_KVB + I_O + I_UP + I_DN, EARLY_ITEMS = I_IN + I_QB + I_KVB + I_O, EARLY0_ITEMS = I_IN + I_QB + I_KVB;
#pragma unroll 1
    for (int l = 0; l < 2; ++l) {
        if (l == 0 || gridDim.x != 256) {
        for (int rep_ = 0; rep_ < (((PROBE_MASK >> 0) & 1) ? 2 : 1); ++rep_) if constexpr ((PHMASK >> 0) & 1) {
            PHASE_PTRS(); (void)OUT;
            LAS float* scr = (LAS float*)(F.lds + RING_OFF + WAVE * 16384);
            const bool early_ok = (G_ == 256);
            CONVERT_ITEMS(l, (l > 0 && early_ok) ? NITEMS : 0, (l == 0 && early_ok) ? EARLY0_ITEMS : NITEMS, gw, NGW);
            if (l == 0) {
            { unsigned zz = 0u; asm volatile("" : "+v"(zz)); const v4u z4 = {zz, zz, zz, zz};
              for (int i = gthread; i < 192 * DM / 8; i += nthreads) *(GAS v4u*)(WIN_T + (size_t)1600 * DM + (size_t)i * 8) = z4; }
            cache_rows_to_bf16(args.in[2] + (size_t)l * 8 * PAST * KVLORA, AKV, KVLORA, gthread, nthreads);
            cache_rows_to_bf16(args.in[3] + (size_t)l * 8 * PAST * ROPE, KROPE, ROPE, gthread, nthreads);
            const float* g = args.in[6] + (size_t)l * DM;
            for (int m = gw; m < MTOK; m += NGW) rms_row_4096(m < NP ? args.in[0] + (size_t)m * DM : args.in[1] + (size_t)(m - NP) * DM, g, XN + (size_t)m * DM, LANE);
            }
        }
        GRID_BAR();
        }
        for (int rep_ = 0; rep_ < (((PROBE_MASK >> 1) & 1) ? 2 : 1); ++rep_) if constexpr ((PHMASK >> 1) & 1) {
            PHASE_PTRS(); (void)OUT;
            pg8::Gemm g{l == 0 ? XN : Y0B, WIN_T, MTOK, NINP, DM, nullptr}; pg8::InOrder S; S.init3(MTOK, NINP, G_, bx_);
            pg8::EpiIn E{LAT, SBQ, SBK, SBV, OUT + O_SBK_P + (size_t)l * NP * 2048, OUT + O_SBV_P + (size_t)l * NP * 2048,
                         OUT + O_SBK_S + (size_t)l * NS * 2048, OUT + O_SBV_S + (size_t)l * NS * 2048, QS_SB, l == 0 ? nullptr : SSQY, EPS};
            const bool bg = (l == 0 && G_ == 256);
            const int rsplit = bg ? ((bx_ & 7) >> 1) : 0;
#pragma unroll 1
            for (int seg = 0; seg < 2; ++seg) {
                pg8::SubRange<pg8::InOrder> SS{S, seg ? rsplit : 0, seg ? (1 << 30) : rsplit};
                pg8::gemm_phase<pg8::EpiIn, pg8::SubRange<pg8::InOrder>, true, true>(F.lds + RING_OFF, g, SS, E);
                if (seg == 0 && bg) {
                    LAS float* scr = (LAS float*)(F.lds + RING_OFF + WAVE * 16384);
                    CONVERT_ITEMS(0, EARLY0_ITEMS, NITEMS, gw, NGW);
                    __syncthreads();
                }
            }
        }
        GRID_BAR();
        for (int rep_ = 0; rep_ < (((PROBE_MASK >> 2) & 1) ? 2 : 1); ++rep_) if constexpr ((PHMASK >> 2) & 1) {
            PHASE_PTRS(); (void)OUT;
            for (int i = gthread; i < MTOK; i += nthreads) { SSQH[i] = 0.f; SSQM[i] = 0.f; SSQS[i] = 0.f; if (l == 0) SSQY[i] = 0.f; }
            const float* g_q_a = args.in[8] + (size_t)l * QLORA; const float* g_kv_a = args.in[10] + (size_t)l * KVLORA; const float* g_k_rope = args.in[15] + (size_t)l * ROPE;
            for (int m = gw; m < MTOK; m += NGW) {
                const float* lr = LAT + (size_t)m * 1792; const int kvr = kvrow_of(m), pos = pos_of(m);
                {
                    f32x4 v[4]; float s = 0.f;
#pragma unroll
                    for (int j = 0; j < 4; ++j) { v[j] = *(const GAS f32x4*)(lr + 4 * (64 * j + LANE)); s += (v[j].x * v[j].x + v[j].y * v[j].y) + (v[j].z * v[j].z + v[j].w * v[j].w); }
                    const float rstd = 1.0f / sqrtf(wave_sum(s) * (1.f / 1024.f) + EPS);
#pragma unroll
                    for (int j = 0; j < 4; ++j) { const f32x4 gg = *(const GAS f32x4*)(g_q_a + 4 * (64 * j + LANE));
                        *(GAS unsigned long long*)(QLAT + (size_t)m * QLORA + 4 * (64 * j + LANE)) =
                            (unsigned long long)pkbf(v[j].x * rstd * gg.x, v[j].y * rstd * gg.y) | ((unsigned long long)pkbf(v[j].z * rstd * gg.z, v[j].w * rstd * gg.w) << 32); }
                }
                {
                    f32x4 v[2]; float s = 0.f;
#pragma unroll
                    for (int j = 0; j < 2; ++j) { v[j] = *(const GAS f32x4*)(lr + 1024 + 4 * (64 * j + LANE)); s += (v[j].x * v[j].x + v[j].y * v[j].y) + (v[j].z * v[j].z + v[j].w * v[j].w); }
                    const float rstd = 1.0f / sqrtf(wave_sum(s) * (1.f / 512.f) + EPS);
                    float* oc = (m < NP) ? OUT + O_CKV_P + ((size_t)l * NP + m) * KVLORA : OUT + O_CKV_S + ((size_t)l * NS + (m - NP)) * KVLORA;
#pragma unroll
                    for (int j = 0; j < 2; ++j) { const f32x4 gg = *(const GAS f32x4*)(g_kv_a + 4 * (64 * j + LANE));
                        const f32x4 c = {v[j].x * rstd * gg.x, v[j].y * rstd * gg.y, v[j].z * rstd * gg.z, v[j].w * rstd * gg.w};
                        *(GAS f32x4*)(oc + 4 * (64 * j + LANE)) = c;
                        *(GAS unsigned long long*)(AKV + (size_t)kvr * KVLORA + 4 * (64 * j + LANE)) = (unsigned long long)pkbf(c.x, c.y) | ((unsigned long long)pkbf(c.z, c.w) << 32); }
                }
                {
                    const float x = lr[1536 + LANE];
                    const float rstd = 1.0f / sqrtf(wave_sum(x * x) * (1.f / 64.f) + EPS);
                    const float xn = x * rstd * g_k_rope[LANE]; const float xp = __shfl_xor(xn, 32);
                    const f32x2 cs = TAB[pos * 32 + (LANE & 31)];
                    const float o = (LANE < 32) ? xn * cs.x - xp * cs.y : xp * cs.y + xn * cs.x;
                    float* okr = (m < NP) ? OUT + O_KR_P + ((size_t)l * NP + m) * ROPE : OUT + O_KR_S + ((size_t)l * NS + (m - NP)) * ROPE;
                    okr[LANE] = o;
                    const float on = __shfl_xor(o, 1);
                    if ((LANE & 1) == 0) *(GAS unsigned*)(KROPE + (size_t)kvr * ROPE + LANE) = pkbf(o, on);
                }
            }
        }
        GRID_BAR();
        for (int rep_ = 0; rep_ < (((PROBE_MASK >> 3) & 1) ? 2 : 1); ++rep_) if constexpr ((PHMASK >> 3) & 1) {
            PHASE_PTRS(); (void)OUT;
            pg8::Gemm g{QLAT, WQB_T, MTOK, 3072, QLORA, nullptr}; pg8::StaticOrder S; S.init(MTOK, 3072, G_, bx_);
            pg8::EpiQb E{QB, args.in[12] + (size_t)l * NOPE, args.in[13] + (size_t)l * ROPE, TAB, (LAS float*)(F.lds + XCH_OFF), QS_MLA, EPS};
            pg8::gemm_phase<pg8::EpiQb, pg8::StaticOrder, true, true>(F.lds + RING_OFF, g, S, E);
        }
        for (int rep_ = 0; rep_ < (((PROBE_MASK >> 11) & 1) ? 2 : 1); ++rep_) if constexpr ((PHMASK >> 11) & 1) {
            PHASE_PTRS(); (void)OUT;
            pg8::Gemm g{AKV, WKVB_T, KVROWS, 4096, KVLORA, nullptr}; pg8::StaticOrder S; S.init(KVROWS, 4096, G_, (bx_ + G_ - 24) % G_);
            pg8::EpiKvbN E{KN, VB, args.in[14] + (size_t)l * NOPE, (LAS float*)(F.lds + XCH_OFF), EPS};
            pg8::gemm_phase<pg8::EpiKvbN, pg8::StaticOrder, true, true>(F.lds + RING_OFF, g, S, E);
        }
        GRID_BAR();
        for (int rep_ = 0; rep_ < (((PROBE_MASK >> 5) & 1) ? 2 : 1); ++rep_) if constexpr ((PHMASK >> 5) & 1) {
            PHASE_PTRS(); (void)OUT;
            const int v = VCU, bh = v >> 2, b = bh >> 4, h = bh & 15, s = v & 3;
            ALAS char* al = (ALAS char*)(F.lds + RING_OFF);
#pragma unroll 1
            for (int k = 0; k < 5; ++k) {
                att::Unit u;
                if (k < 4) { const int qb = (k == 0) ? s : (k == 1) ? 7 - s : (k == 2) ? 8 + s : 15 - s; const size_t m0 = (size_t)b * SEQ + (size_t)qb * 256, kv0 = (size_t)b * SEQ;
                    u.Q = QB + m0 * 3072 + h * 192; u.ldq = 3072; u.K = KN + kv0 * 2048 + h * 128; u.Kr = KROPE + kv0 * ROPE; u.V = VB + kv0 * 2048 + h * 128;
                    u.O = MERGED + m0 * 4096 + h * 128; u.ldo = 4096; u.ssq = SSQP + m0 * 32 + h; u.Kf0 = u.Vf0 = u.Kf1 = u.Vf1 = nullptr; u.split = 0; u.P0 = qb * 256; u.NT = 4 * qb + 4; u.nact = 8; }
                else { if (v >= 128) break; const int sb = v >> 4, sh = v & 15; const size_t m0 = (size_t)NP + (size_t)sb * 64, kv0 = (size_t)NP + (size_t)sb * SKVS;
                    u.Q = QB + m0 * 3072 + sh * 192; u.ldq = 3072; u.K = KN + kv0 * 2048 + sh * 128; u.Kr = KROPE + kv0 * ROPE; u.V = VB + kv0 * 2048 + sh * 128;
                    u.O = MERGED + m0 * 4096 + sh * 128; u.ldo = 4096; u.ssq = SSQP + m0 * 32 + sh; u.Kf0 = u.Vf0 = u.Kf1 = u.Vf1 = nullptr; u.split = 0; u.P0 = PAST; u.NT = 17; u.nact = 2; }
                if constexpr ((PHMASK >> 12) & 1) att::mla_unit_dma<0>(u, al);
            }
#pragma unroll 1
            for (int k = 0; k < 5; ++k) {
                att::Unit u;
                if (k < 4) { const int qb = (k == 0) ? s : (k == 1) ? 7 - s : (k == 2) ? 8 + s : 15 - s; const size_t m0 = (size_t)b * SEQ + (size_t)qb * 256, kv0 = (size_t)b * SEQ;
                    u.Q = SBQ + m0 * 2048 + h * 128; u.ldq = 2048; u.K = nullptr; u.Kr = nullptr; u.V = nullptr; u.split = 1 << 30;
                    u.Kf0 = OUT + O_SBK_P + ((size_t)l * NP + kv0) * 2048 + h * 128; u.Vf0 = OUT + O_SBV_P + ((size_t)l * NP + kv0) * 2048 + h * 128; u.Kf1 = u.Kf0; u.Vf1 = u.Vf0;
                    u.O = MERGED + m0 * 4096 + 2048 + h * 128; u.ldo = 4096; u.ssq = SSQP + m0 * 32 + 16 + h; u.P0 = qb * 256; u.NT = 4 * qb + 4; u.nact = 8; }
                else { if (v < 128) break; const int w = v - 128, sb = w >> 4, sh = w & 15; const size_t m0 = (size_t)NP + (size_t)sb * 64, kv0 = (size_t)NP + (size_t)sb * SKVS;
                    u.Q = SBQ + m0 * 2048 + sh * 128; u.ldq = 2048; u.K = nullptr; u.Kr = nullptr; u.V = nullptr; u.split = PAST / 64;
                    u.Kf0 = args.in[4] + ((size_t)(l * 8 + sb) * PAST) * 2048 + sh * 128; u.Vf0 = args.in[5] + ((size_t)(l * 8 + sb) * PAST) * 2048 + sh * 128;
                    u.Kf1 = OUT + O_SBK_S + ((size_t)l * NS + (size_t)sb * 64) * 2048 + sh * 128; u.Vf1 = OUT + O_SBV_S + ((size_t)l * NS + (size_t)sb * 64) * 2048 + sh * 128;
                    u.O = MERGED + m0 * 4096 + 2048 + sh * 128; u.ldo = 4096; u.ssq = SSQP + m0 * 32 + 16 + sh; u.P0 = PAST; u.NT = 17; u.nact = 2; }
                if constexpr ((PHMASK >> 13) & 1) att::attn_unit<false>(u, al);
            }
        }
        GRID_BAR();
#if !ATT_SSQ_ATOMICS
        {
            PHASE_PTRS(); (void)OUT;
            for (int i = gthread; i < MTOK * 2; i += nthreads) { const int m = i >> 1, half = i & 1; const GAS f32x4* p = (const GAS f32x4*)(SSQP + (size_t)m * 32 + half * 16);
                const f32x4 a = p[0], b = p[1], c = p[2], d = p[3];
                const float s = (((a.x + a.y) + (a.z + a.w)) + ((b.x + b.y) + (b.z + b.w))) + (((c.x + c.y) + (c.z + c.w)) + ((d.x + d.y) + (d.z + d.w)));
                (half ? SSQS : SSQM)[m] = s; }
        }
        GRID_BAR();
#endif
        for (int rep_ = 0; rep_ < (((PROBE_MASK >> 7) & 1) ? 2 : 1); ++rep_) if constexpr ((PHMASK >> 7) & 1) {
            PHASE_PTRS(); (void)OUT;
            pg8::Gemm g{MERGED, WO_T, MTOK, DM, DM, SLAB}; pg8::PanelOrder S; S.init3(MTOK, DM, DM, G_, bx_, SLAB, 2);
            pg8::EpiResP<true> E{args.in[0], args.in[1], nullptr, XN, SSQH, SSQM, SSQS, EPS, l == 0 ? nullptr : Y0B};
            pg8::gemm_phase<pg8::EpiResP<true>, pg8::PanelOrder, true, true>(F.lds + RING_OFF, g, S, E);
        }
        GRID_BAR();
        {
            PHASE_PTRS(); pg8::PanelOrder S; S.init3(MTOK, DM, DM, G_, bx_, SLAB, 2);
            tail_reduce_res<true>(S, args.in[0], args.in[1], nullptr, XN, SSQH, SSQM, SSQS, l == 0 ? nullptr : Y0B, ptid_);
        }
        GRID_BAR();
        for (int rep_ = 0; rep_ < (((PROBE_MASK >> 9) & 1) ? 2 : 1); ++rep_) if constexpr ((PHMASK >> 9) & 1) {
            PHASE_PTRS(); (void)OUT;
            pg8::Gemm g{XN, WUP_T, MTOK, DFF, DM, nullptr}; pg8::UpOrder S; S.init3(MTOK, DFF, G_, bx_);
            pg8::EpiRelu2N E{UB, DFF, SSQH, EPS};
            pg8::gemm_phase<pg8::EpiRelu2N, pg8::UpOrder, true, true>(F.lds + RING_OFF, g, S, E);
            if (l + 1 < 2 && G_ == 256 && bx_ >= 128) {
                LAS float* scr = (LAS float*)(F.lds + RING_OFF + WAVE * 16384);
                CONVERT_ITEMS(l + 1, 0, EARLY_ITEMS, (bx_ - 128) * NWAVES + WAVE, 128 * NWAVES);
            }
        }
        GRID_BAR();
        for (int rep_ = 0; rep_ < (((PROBE_MASK >> 10) & 1) ? 2 : 1); ++rep_) if constexpr ((PHMASK >> 10) & 1) {
            PHASE_PTRS(); (void)OUT;
            pg8::Gemm g{UB, l == 0 ? WDN_T0 : WDN_T1, MTOK, DM, DFF, SLAB, 1};     pg8::PanelOrder S; S.init3(MTOK, DM, DFF, G_, bx_, SLAB);
            pg8::EpiResP<false> E{nullptr, nullptr, OUT + O_Y, XN, SSQY, nullptr, nullptr, EPS, l == 1 ? nullptr : Y0B};
            const bool bg = (l + 1 < 2 && G_ == 256);
            const int rsplit = bg ? ((bx_ & 7) >> 1) : 0;
#pragma unroll 1
            for (int seg = 0; seg < 2; ++seg) {
                pg8::SubRange<pg8::PanelOrder> SS{S, seg ? rsplit : 0, seg ? (1 << 30) : rsplit};
                pg8::gemm_phase<pg8::EpiResP<false>, pg8::SubRange<pg8::PanelOrder>, true, true>(F.lds + RING_OFF, g, SS, E);
                if (seg == 0 && bg) {
                    LAS float* scr = (LAS float*)(F.lds + RING_OFF + WAVE * 16384);
                    CONVERT_ITEMS(l + 1, EARLY_ITEMS, NITEMS, gw, NGW);
                    __syncthreads();
                }
            }
        }
        GRID_BAR();
        {
            PHASE_PTRS(); pg8::PanelOrder S; S.init3(MTOK, DM, DFF, G_, bx_, SLAB);
            tail_reduce_res<false>(S, nullptr, nullptr, OUT + O_Y, XN, SSQY, nullptr, nullptr, l == 1 ? nullptr : Y0B, ptid_);
            if (l + 1 < 2) {
                cache_rows_to_bf16(args.in[2] + (size_t)(l + 1) * 8 * PAST * KVLORA, AKV, KVLORA, gthread, nthreads);
                cache_rows_to_bf16(args.in[3] + (size_t)(l + 1) * 8 * PAST * ROPE, KROPE, ROPE, gthread, nthreads);
            }
        }
        GRID_BAR();
    }
#undef GRID_BAR
}

extern "C" void kernel_launch(void* const* d_in, const int* in_sizes, int n_in, void* d_out, int out_size, void* d_ws, size_t ws_size, hipStream_t stream) {
    static int grid = 0;
    if (grid == 0) {
        if (n_in != 22 || (size_t)out_size != O_END || ws_size < WS_END) { fprintf(stderr, "kernel_launch: unexpected shapes: n_in %d out %d ws %zu (need %zu)\n", n_in, out_size, ws_size, (size_t)WS_END); grid = -1; return; }
        int dev = 0, cus = 0, per_cu = 0;
        if (hipGetDevice(&dev) != hipSuccess || hipDeviceGetAttribute(&cus, hipDeviceAttributeMultiprocessorCount, dev) != hipSuccess) { grid = -1; return; }
        if (hipFuncSetAttribute((const void*)hymba_fwd, hipFuncAttributeMaxDynamicSharedMemorySize, LDS_BYTES) != hipSuccess) { fprintf(stderr, "kernel_launch: hipFuncSetAttribute failed\n"); grid = -1; return; }
        if (hipOccupancyMaxActiveBlocksPerMultiprocessor(&per_cu, (const void*)hymba_fwd, NWAVES * 64, LDS_BYTES) != hipSuccess || per_cu < 1) { fprintf(stderr, "kernel_launch: occupancy query reports %d\n", per_cu); }
        (void)hipGetLastError();
        grid = cus;
        if (grid != 256) fprintf(stderr, "kernel_launch: %d CUs (the attention deal assumes 256 workgroups)\n", grid);
    }
    if (grid < 0) return;
    if (hipMemsetAsync((char*)d_ws + WS_CTL, 0, CTL_ZERO_BYTES, stream) != hipSuccess) return;
    Args a{};
    for (int i = 0; i < 22; ++i) a.in[i] = (const float*)d_in[i];
    a.out = (float*)d_out; a.ws = (unsigned char*)d_ws;
    hipLaunchKernelGGL(hymba_fwd, dim3(grid), dim3(NWAVES * 64), LDS_BYTES, stream, a);
}
```
